# Optimizing an MI355X kernel written in HIP

```python
import math
import jax
import jax.numpy as jnp
from jax import lax
import numpy as np

D_MODEL = 1024
BATCH = 4
SEQ = 8192
DEPTH = 2

HEAD_DIM = 64
EPS = 1e-6
NEG_INF = -1e30
GRID_W = 64
A_HEADS = 8
A_KV_HEADS = 2
A_GROUP = A_HEADS // A_KV_HEADS
Q_BLOCK = 128
ROPE_THETA = 10000.0
B_GROUPS = 3
B_HEADS_PER_GROUP = 4
B_HEADS = B_GROUPS * B_HEADS_PER_GROUP
B_WINDOWS = (128, 512, 2048)
B_DILATIONS = (1, 4, 16)
N_BUCKETS = 32
MAX_DISTANCE = 1024
C_HEADS = 8
C_HEAD_DIM = 64
C_INNER = C_HEADS * C_HEAD_DIM
C_GROUPS = 2
C_STATE = 128
C_CONV = 5
C_CHUNK = 128
A_Q = A_HEADS * HEAD_DIM
A_KV = A_KV_HEADS * HEAD_DIM
A_OUT = A_Q
B_QKV = B_HEADS * HEAD_DIM
B_OUT = B_HEADS_PER_GROUP * HEAD_DIM
C_BC = C_GROUPS * C_STATE
C_XBC = C_INNER + 2 * C_BC
N_BRANCH = 3
SPLIT_WIDTHS = (A_Q, A_KV, A_KV, A_OUT,
                B_QKV, B_QKV, B_QKV, B_OUT,
                C_INNER, C_INNER, C_BC, C_BC, C_HEADS, C_HEADS,
                N_BRANCH * D_MODEL)
D_IN_PROJ = sum(SPLIT_WIDTHS)
SPLIT_POINTS = tuple(int(v) for v in np.cumsum(SPLIT_WIDTHS)[:-1])

kernel_name = "hybrid_gated_parallel_encoder"


def rms_norm(x, w):
    xf = x.astype(jnp.float32)
    y = xf * lax.rsqrt(jnp.mean(xf * xf, axis=-1, keepdims=True) + EPS)
    return y.astype(x.dtype) * w.astype(x.dtype)


def axial_rope(x, row_idx, col_idx):
    half = x.shape[-1] // 2
    quarter = half // 2
    freqs = ROPE_THETA ** (-jnp.arange(quarter, dtype=jnp.float32) / quarter)

    def rotate(seg, pos):
        ang = pos.astype(jnp.float32)[:, None] * freqs
        cos = jnp.cos(ang)[:, None, :].astype(seg.dtype)
        sin = jnp.sin(ang)[:, None, :].astype(seg.dtype)
        a, b = seg[..., :quarter], seg[..., quarter:]
        return jnp.concatenate([a * cos - b * sin, b * cos + a * sin], axis=-1)

    return jnp.concatenate([rotate(x[..., :half], row_idx), rotate(x[..., half:], col_idx)], axis=-1)


def t5_bucket(rel):
    nb = N_BUCKETS // 2
    max_exact = nb // 2
    ret = jnp.where(rel > 0, nb, 0)
    n = jnp.abs(rel)
    nf = jnp.maximum(n, 1).astype(jnp.float32)
    large = max_exact + (jnp.log(nf / max_exact) / math.log(MAX_DISTANCE / max_exact)
                         * (nb - max_exact)).astype(jnp.int32)
    large = jnp.minimum(large, nb - 1)
    return ret + jnp.where(n < max_exact, n, large)


def mixer_a(q, k, v, q_norm, k_norm, row_idx, col_idx):
    Bsz, S, _ = q.shape
    q = axial_rope(rms_norm(q.reshape(Bsz, S, A_HEADS, HEAD_DIM), q_norm), row_idx, col_idx)
    k = axial_rope(rms_norm(k.reshape(Bsz, S, A_KV_HEADS, HEAD_DIM), k_norm), row_idx, col_idx)
    v = v.reshape(Bsz, S, A_KV_HEADS, HEAD_DIM)
    n_qb = S // Q_BLOCK
    qb = q.reshape(Bsz, n_qb, Q_BLOCK, A_KV_HEADS, A_GROUP, HEAD_DIM).transpose(1, 0, 3, 4, 2, 5)
    k = k.transpose(0, 2, 1, 3)
    v = v.transpose(0, 2, 1, 3)
    scale = HEAD_DIM ** -0.5

    def block(qblk):
        s = jnp.einsum('bkgqe,bkse->bkgqs', qblk, k, preferred_element_type=jnp.float32) * scale
        p = jax.nn.softmax(s, axis=-1)
        return jnp.einsum('bkgqs,bkse->bkgqe', p.astype(v.dtype), v)

    o = lax.map(block, qb)
    return o.transpose(1, 0, 4, 2, 3, 5).reshape(Bsz, S, A_OUT)


def dilated_group_attention(q, k, v, bias_table, dilation, side):
    Bsz, S, H, E = q.shape
    M = S // dilation
    nb = -(-M // side)
    Mp = nb * side

    def phases(t):
        return t.reshape(Bsz, M, dilation, H, E).transpose(0, 2, 3, 1, 4)

    qd = jnp.pad(phases(q), ((0, 0), (0, 0), (0, 0), (0, Mp - M), (0, 0)))
    qd = qd.reshape(Bsz, dilation, H, nb, side, E)

    def band(t):
        t = jnp.pad(phases(t), ((0, 0), (0, 0), (0, 0), (side, side + Mp - M), (0, 0)))
        t = t.reshape(Bsz, dilation, H, nb + 2, side, E)
        return jnp.concatenate([t[:, :, :, :-2], t[:, :, :, 1:-1], t[:, :, :, 2:]], axis=4)

    kw, vw = band(k), band(v)
    qi = jnp.arange(side)[:, None]
    kk = jnp.arange(3 * side)[None, :]
    rel = kk - side - qi
    m_k = jnp.arange(nb)[:, None, None] * side + kk[None] - side
    valid = (jnp.abs(rel) <= side)[None] & (m_k >= 0) & (m_k < M)
    bias = bias_table[t5_bucket(rel * dilation)].transpose(2, 0, 1)
    s = jnp.einsum('bdhnqe,bdhnke->bdhnqk', qd, kw, preferred_element_type=jnp.float32) * (E ** -0.5)
    s = s + bias[None, None, :, None].astype(jnp.float32)
    s = jnp.where(valid, s, NEG_INF)
    mx = jnp.max(s, axis=-1, keepdims=True)
    e = jnp.exp(s - mx)
    den = jnp.sum(e, axis=-1, keepdims=True)
    p = e / den
    lse = (mx + jnp.log(den))[..., 0]
    o = jnp.einsum('bdhnqk,bdhnke->bdhnqe', p.astype(v.dtype), vw)
    o = o.reshape(Bsz, dilation, H, Mp, E)[:, :, :, :M].transpose(0, 3, 1, 2, 4).reshape(Bsz, S, H, E)
    lse = lse.reshape(Bsz, dilation, H, Mp)[..., :M].transpose(0, 3, 1, 2).reshape(Bsz, S, H)
    return o, lse


def mixer_b(q, k, v, q_norm, k_norm, rel_bias):
    Bsz, S, _ = q.shape
    shp = (Bsz, S, B_GROUPS, B_HEADS_PER_GROUP, HEAD_DIM)
    q = rms_norm(q.reshape(shp), q_norm)
    k = rms_norm(k.reshape(shp), k_norm)
    v = v.reshape(shp)
    outs, lses = [], []
    for g in range(B_GROUPS):
        d = B_DILATIONS[g]
        side = B_WINDOWS[g] // (2 * d)
        tbl = rel_bias[:, g * B_HEADS_PER_GROUP:(g + 1) * B_HEADS_PER_GROUP]
        o, l = dilated_group_attention(q[:, :, g], k[:, :, g], v[:, :, g], tbl, d, side)
        outs.append(o)
        lses.append(l)
    w = jax.nn.softmax(jnp.stack(lses, axis=0), axis=0)
    o = jnp.sum(w[..., None].astype(outs[0].dtype) * jnp.stack(outs, axis=0), axis=0)
    return o.reshape(Bsz, S, B_OUT)


def segsum(x):
    T = x.shape[-1]
    xr = jnp.broadcast_to(x[..., None], x.shape + (T,))
    strict = jnp.tril(jnp.ones((T, T), dtype=bool), -1)
    cs = jnp.cumsum(jnp.where(strict, xr, 0.0), axis=-2)
    return jnp.where(jnp.tril(jnp.ones((T, T), dtype=bool)), cs, -jnp.inf)


def ssd_chunked(xdt, a, Bm, Cm):
    b, l, h, p = xdt.shape
    n = Bm.shape[-1]
    c = l // C_CHUNK
    x = xdt.astype(jnp.float32).reshape(b, c, C_CHUNK, h, p)
    Bc = Bm.astype(jnp.float32).reshape(b, c, C_CHUNK, h, n)
    Cc = Cm.astype(jnp.float32).reshape(b, c, C_CHUNK, h, n)
    A = a.astype(jnp.float32).reshape(b, c, C_CHUNK, h).transpose(0, 3, 1, 2)
    A_cs = jnp.cumsum(A, axis=-1)
    Lm = jnp.exp(segsum(A))
    CB = jnp.einsum('bclhn,bcshn->bhcls', Cc, Bc)
    y_diag = jnp.einsum('bhcls,bcshp->bclhp', CB * Lm, x)
    decay_states = jnp.exp(A_cs[..., -1:] - A_cs)
    states = jnp.einsum('bclhn,bhcl,bclhp->bchpn', Bc, decay_states, x)
    states = jnp.concatenate([jnp.zeros_like(states[:, :1]), states], axis=1)
    decay_chunk = jnp.exp(segsum(jnp.pad(A_cs[..., -1], ((0, 0), (0, 0), (1, 0)))))
    states = jnp.einsum('bhzc,bchpn->bzhpn', decay_chunk, states)[:, :-1]
    y_off = jnp.einsum('bclhn,bchpn,bhcl->bclhp', Cc, states, jnp.exp(A_cs))
    return (y_diag + y_off).reshape(b, l, h, p)


def mixer_c(xc, zc, bc, cc, dtf, dtb, conv_w, conv_b, a_log, dt_bias, d_skip, norm_w):
    Bsz, S, _ = xc.shape
    xbc = jnp.concatenate([xc, bc, cc], axis=-1)
    xbc = lax.conv_general_dilated(xbc, conv_w[:, None, :].astype(xbc.dtype), (1,),
                                   [(C_CONV // 2, C_CONV // 2)],
                                   dimension_numbers=('NWC', 'WIO', 'NWC'),
                                   feature_group_count=C_XBC)
    xbc = jax.nn.silu(xbc + conv_b.astype(xbc.dtype))
    xs, Bm, Cm = jnp.split(xbc, [C_INNER, C_INNER + C_BC], axis=-1)
    xs = xs.reshape(Bsz, S, C_HEADS, C_HEAD_DIM)
    rep = C_HEADS // C_GROUPS
    Bm = jnp.repeat(Bm.reshape(Bsz, S, C_GROUPS, C_STATE), rep, axis=2)
    Cm = jnp.repeat(Cm.reshape(Bsz, S, C_GROUPS, C_STATE), rep, axis=2)
    A = -jnp.exp(a_log.astype(jnp.float32))
    dt_f = jax.nn.softplus(dtf.astype(jnp.float32) + dt_bias[0].astype(jnp.float32))
    dt_b = jax.nn.softplus(dtb.astype(jnp.float32) + dt_bias[1].astype(jnp.float32))
    y_f = ssd_chunked(xs * dt_f[..., None], dt_f * A[0], Bm, Cm)
    flip = lambda t: jnp.flip(t, axis=1)
    y_b = flip(ssd_chunked(flip(xs * dt_b[..., None]), flip(dt_b * A[1]), flip(Bm), flip(Cm)))
    y = y_f + y_b + d_skip.astype(jnp.float32)[:, None] * xs
    y = y.reshape(Bsz, S, C_INNER).astype(xc.dtype)
    return rms_norm(y * jax.nn.silu(zc), norm_w)


def setup_inputs(seed: int = 0) -> dict:
    key = jax.random.key(seed)
    ks = jax.random.split(key, 24)
    f32 = jnp.float32

    def nrm(k, shape, s):
        return jax.random.normal(k, shape, f32) * s

    x = nrm(ks[0], (BATCH, SEQ, D_MODEL), 1.0)
    c = nrm(ks[1], (BATCH, D_MODEL), 1.0)
    norm_w = 1.0 + nrm(ks[2], (DEPTH, D_MODEL), 0.1)
    w_ada = nrm(ks[3], (DEPTH, D_MODEL, 3 * D_MODEL), 0.5 * D_MODEL ** -0.5)
    b_ada = nrm(ks[4], (DEPTH, 3 * D_MODEL), 0.02)
    w_in = nrm(ks[5], (DEPTH, D_MODEL, D_IN_PROJ), D_MODEL ** -0.5)
    b_gate = nrm(ks[6], (DEPTH, N_BRANCH * D_MODEL), 0.1)
    q_norm_a = 1.0 + nrm(ks[7], (DEPTH, HEAD_DIM), 0.1)
    k_norm_a = 1.0 + nrm(ks[8], (DEPTH, HEAD_DIM), 0.1)
    q_norm_b = 1.0 + nrm(ks[9], (DEPTH, HEAD_DIM), 0.1)
    k_norm_b = 1.0 + nrm(ks[10], (DEPTH, HEAD_DIM), 0.1)
    rel_bias = nrm(ks[11], (N_BUCKETS, B_HEADS), 0.5)
    conv_w = nrm(ks[12], (DEPTH, C_CONV, C_XBC), C_CONV ** -0.5)
    conv_b = nrm(ks[13], (DEPTH, C_XBC), 0.02)
    a_log = jnp.log(jax.random.uniform(ks[14], (DEPTH, 2, C_HEADS), f32, 1.0, 16.0))
    dt0 = jnp.exp(jax.random.uniform(ks[15], (DEPTH, 2, C_HEADS), f32, math.log(1e-3), math.log(1e-1)))
    dt_bias = dt0 + jnp.log(-jnp.expm1(-dt0))
    d_skip = 1.0 + nrm(ks[16], (DEPTH, C_HEADS), 0.1)
    ssm_norm_w = 1.0 + nrm(ks[17], (DEPTH, C_INNER), 0.1)
    w_proj_a = nrm(ks[18], (DEPTH, A_OUT, D_MODEL), A_OUT ** -0.5)
    w_proj_b = nrm(ks[19], (DEPTH, B_OUT, D_MODEL), B_OUT ** -0.5)
    w_proj_c = nrm(ks[20], (DEPTH, C_INNER, D_MODEL), C_INNER ** -0.5)
    w_out = nrm(ks[21], (DEPTH, D_MODEL, D_MODEL), D_MODEL ** -0.5)
    return {"x": x, "c": c, "norm_w": norm_w, "w_ada": w_ada, "b_ada": b_ada,
            "w_in": w_in, "b_gate": b_gate, "q_norm_a": q_norm_a, "k_norm_a": k_norm_a,
            "q_norm_b": q_norm_b, "k_norm_b": k_norm_b, "rel_bias": rel_bias,
            "conv_w": conv_w, "conv_b": conv_b, "a_log": a_log, "dt_bias": dt_bias,
            "d_skip": d_skip, "ssm_norm_w": ssm_norm_w, "w_proj_a": w_proj_a,
            "w_proj_b": w_proj_b, "w_proj_c": w_proj_c, "w_out": w_out}


def reference(x, c, norm_w, w_ada, b_ada, w_in, b_gate, q_norm_a, k_norm_a, q_norm_b,
              k_norm_b, rel_bias, conv_w, conv_b, a_log, dt_bias, d_skip, ssm_norm_w,
              w_proj_a, w_proj_b, w_proj_c, w_out):
    Bsz, S, _ = x.shape
    rows = S // GRID_W
    row_idx = jnp.repeat(jnp.arange(rows), GRID_W)
    col_idx = jnp.tile(jnp.arange(GRID_W), rows)
    c_act = jax.nn.silu(c)
    for l in range(DEPTH):
        mod = c_act @ w_ada[l] + b_ada[l]
        shift, scale, gate = jnp.split(mod, 3, axis=-1)
        h = rms_norm(x, norm_w[l]) * (1.0 + scale[:, None, :]) + shift[:, None, :]
        proj = h @ w_in[l]
        (qa, ka, va, ga, qb, kb, vb, gb, xc, zc, bc, cc, dtf, dtb,
         mg) = jnp.split(proj, SPLIT_POINTS, axis=-1)
        ya = mixer_a(qa, ka, va, q_norm_a[l], k_norm_a[l], row_idx, col_idx) * jax.nn.silu(ga)
        yb = mixer_b(qb, kb, vb, q_norm_b[l], k_norm_b[l], rel_bias) * jax.nn.silu(gb)
        yc = mixer_c(xc, zc, bc, cc, dtf, dtb, conv_w[l], conv_b[l], a_log[l], dt_bias[l],
                     d_skip[l], ssm_norm_w[l])
        g_a, g_b, g_c = jnp.split(jax.nn.sigmoid(mg + b_gate[l]), N_BRANCH, axis=-1)
        merged = (g_a * (ya @ w_proj_a[l]) + g_b * (yb @ w_proj_b[l])
                  + g_c * (yc @ w_proj_c[l]))
        x = x + gate[:, None, :] * (merged @ w_out[l])
    return x
```

```cpp
#include <hip/hip_runtime.h>
#include <hip/hip_cooperative_groups.h>
#include <cstdint>
#include <cstdio>
namespace cg = cooperative_groups;

typedef unsigned short bf16_t;
typedef short bf16x8 __attribute__((ext_vector_type(8)));
typedef short v4i16 __attribute__((ext_vector_type(4)));
typedef float f32x2 __attribute__((ext_vector_type(2)));
typedef float f32x4 __attribute__((ext_vector_type(4)));
typedef float f32x16 __attribute__((ext_vector_type(16)));
typedef unsigned u32x2 __attribute__((ext_vector_type(2)));
typedef unsigned u32x4 __attribute__((ext_vector_type(4)));
typedef __bf16 bf16x2_t __attribute__((ext_vector_type(2)));
#define LDSAS __attribute__((address_space(3)))

constexpr int SEQ = 8192, DM = 1024, NBATCH = 4, NBH = 2, TP = NBH * SEQ, DEPTH = 2;
constexpr int NP = 8576;
constexpr float EPS = 1e-6f;
constexpr float LOG2E = 1.4426950408889634f, LN2 = 0.6931471805599453f;
constexpr int NSEG = 16, SEGLEN = 512, TSUB = 32, NSUB = SEGLEN / TSUB;

constexpr size_t MiB = 1u << 20;
constexpr size_t WS_WIN = 0;
constexpr size_t WS_WPA = 34 * MiB;
constexpr size_t WS_WPB = 36 * MiB;
constexpr size_t WS_WPC = 37 * MiB;
constexpr size_t WS_WOUT = 39 * MiB;
constexpr size_t WS_MOD = 43 * MiB;
constexpr size_t WS_ROPE = 43 * MiB + 128 * 1024;
constexpr size_t WS_BND = 43 * MiB + 160 * 1024;
constexpr size_t WS_RSTD = 43 * MiB + 256 * 1024;
constexpr size_t WS_SEGT = 43 * MiB + 512 * 1024;
constexpr size_t WS_LSE = 44 * MiB;
constexpr size_t WS_DT = 45 * MiB;
constexpr size_t WS_H = 48 * MiB;
constexpr size_t WS_QA = 80 * MiB;
constexpr size_t WS_KA = 96 * MiB;
constexpr size_t WS_VA = 100 * MiB;
constexpr size_t WS_GA = 104 * MiB;
constexpr size_t WS_QB = 120 * MiB;
constexpr size_t WS_KB = 144 * MiB;
constexpr size_t WS_VB = 168 * MiB;
constexpr size_t WS_GB = 192 * MiB;
constexpr size_t WS_XBC = 200 * MiB;
constexpr size_t WS_ZS = 232 * MiB;
constexpr size_t WS_MG = 248 * MiB;
constexpr size_t WS_YF = 344 * MiB;
constexpr size_t WS_YS = 360 * MiB;
constexpr size_t WS_YBM = 376 * MiB;
constexpr size_t WS_YC = 384 * MiB;
constexpr size_t WS_MRG = 400 * MiB;
constexpr size_t WS_ST = 432 * MiB;

struct Params {
    const float *x, *c, *norm_w, *w_ada, *b_ada, *w_in, *b_gate, *q_norm_a, *k_norm_a, *q_norm_b, *k_norm_b, *rel_bias,
        *conv_w, *conv_b, *a_log, *dt_bias, *d_skip, *ssm_norm_w, *w_proj_a, *w_proj_b, *w_proj_c, *w_out;
    float* out;
    unsigned char* ws;
};


__device__ __forceinline__ Params launder(const Params& p) {
    Params q = p;
    asm volatile("" : "+s"(q.x), "+s"(q.c), "+s"(q.norm_w), "+s"(q.w_ada), "+s"(q.b_ada), "+s"(q.w_in), "+s"(q.b_gate), "+s"(q.q_norm_a), "+s"(q.k_norm_a), "+s"(q.q_norm_b), "+s"(q.k_norm_b), "+s"(q.rel_bias));
    asm volatile("" : "+s"(q.conv_w), "+s"(q.conv_b), "+s"(q.a_log), "+s"(q.dt_bias), "+s"(q.d_skip), "+s"(q.ssm_norm_w), "+s"(q.w_proj_a), "+s"(q.w_proj_b), "+s"(q.w_proj_c), "+s"(q.w_out), "+s"(q.out), "+s"(q.ws));
    return q;
}
__device__ __forceinline__ unsigned pk2(float lo, float hi) { f32x2 v = {lo, hi}; bf16x2_t b = __builtin_convertvector(v, bf16x2_t); return __builtin_bit_cast(unsigned, b); }
__device__ __forceinline__ float bf2f(unsigned short b) { return __uint_as_float(((unsigned)b) << 16); }
__device__ __forceinline__ float bflo(unsigned u) { return __uint_as_float(u << 16); }
__device__ __forceinline__ float bfhi(unsigned u) { return __uint_as_float(u & 0xffff0000u); }
__device__ __forceinline__ float siluf(float v) { return v / (1.f + __expf(-v)); }
__device__ __forceinline__ float sigmf(float v) { return 1.f / (1.f + __expf(-v)); }
__device__ __forceinline__ float wave_sum(float v) {
#pragma unroll
    for (int o = 1; o < 64; o <<= 1) v += __shfl_xor(v, o);
    return v;
}
__device__ __forceinline__ v4i16 tr16(const unsigned char* p) { return __builtin_amdgcn_ds_read_tr16_b64_v4i16((LDSAS v4i16*)p); }
__device__ __forceinline__ bf16x8 cat8(v4i16 a, v4i16 b) { return (bf16x8){a[0], a[1], a[2], a[3], b[0], b[1], b[2], b[3]}; }
__device__ __forceinline__ int crow(int r, int hi) { return (r & 3) + 8 * (r >> 2) + 4 * hi; }

__device__ __forceinline__ void p0_transpose(const float* __restrict__ W, int ldw, int K, bf16_t* __restrict__ Wt, int k0, int n0, int mode,
                                             const float* __restrict__ rowscale, float* tile) {
    const int tid = threadIdx.x, tx = tid & 63, ty = tid >> 6;
    const int np = n0 + tx; int n = np; bool valid = true;
    if (mode == 1) {
        if (np < 4352) n = np; else if (np < 4864) n = np + 512; else if (np < 5376) n = np - 512;
        else if (np < 8448) n = np + 16; else if (np < 8464) n = np - 3072; else { valid = false; n = 0; }
    }
#pragma unroll 4
    for (int i = 0; i < 16; ++i) {
        const int k = ty + 4 * i; float v = valid ? W[(size_t)(k0 + k) * ldw + n] : 0.f;
        if (rowscale) v *= rowscale[k0 + k];
        tile[k * 65 + tx] = v;
    }
    __syncthreads();
    const int r = tid >> 2, kc = (tid & 3) * 16;
    u32x4 o0, o1;
    o0.x = pk2(tile[(kc + 0) * 65 + r], tile[(kc + 1) * 65 + r]); o0.y = pk2(tile[(kc + 2) * 65 + r], tile[(kc + 3) * 65 + r]);
    o0.z = pk2(tile[(kc + 4) * 65 + r], tile[(kc + 5) * 65 + r]); o0.w = pk2(tile[(kc + 6) * 65 + r], tile[(kc + 7) * 65 + r]);
    o1.x = pk2(tile[(kc + 8) * 65 + r], tile[(kc + 9) * 65 + r]); o1.y = pk2(tile[(kc + 10) * 65 + r], tile[(kc + 11) * 65 + r]);
    o1.z = pk2(tile[(kc + 12) * 65 + r], tile[(kc + 13) * 65 + r]); o1.w = pk2(tile[(kc + 14) * 65 + r], tile[(kc + 15) * 65 + r]);
    bf16_t* dst = Wt + (size_t)(n0 + r) * K + k0 + kc;
    *(u32x4*)dst = o0; *(u32x4*)(dst + 8) = o1;
    __syncthreads();
}

__device__ void phase0(const Params& p, unsigned char* smem) {
    const int tid = threadIdx.x;
    float* tile = (float*)smem;
    constexpr int I_IN = 16 * 134, I_PA = 8 * 16, I_PB = 4 * 16, I_PC = 8 * 16, I_OUT = 16 * 16, I_L = I_IN + I_PA + I_PB + I_PC + I_OUT;
    constexpr int I_T = 2 * I_L, I_MOD = 192, I_ALL = I_T + I_MOD + 1;
    for (int item = blockIdx.x; item < I_ALL; item += gridDim.x) {
        if (item < I_T) {
            const int l = item / I_L; int r = item % I_L;
            if (r < I_IN) { const int kt = r / 134, nt = r % 134;
                p0_transpose(p.w_in + (size_t)l * 1024 * 8464, 8464, 1024, (bf16_t*)(p.ws + WS_WIN) + (size_t)l * NP * 1024, kt * 64, nt * 64, 1, nullptr, tile); continue; }
            r -= I_IN;
            if (r < I_PA) { const int kt = r / 16, nt = r % 16;
                p0_transpose(p.w_proj_a + (size_t)l * 512 * 1024, 1024, 512, (bf16_t*)(p.ws + WS_WPA) + (size_t)l * 1024 * 512, kt * 64, nt * 64, 0, nullptr, tile); continue; }
            r -= I_PA;
            if (r < I_PB) { const int kt = r / 16, nt = r % 16;
                p0_transpose(p.w_proj_b + (size_t)l * 256 * 1024, 1024, 256, (bf16_t*)(p.ws + WS_WPB) + (size_t)l * 1024 * 256, kt * 64, nt * 64, 0, nullptr, tile); continue; }
            r -= I_PB;
            if (r < I_PC) { const int kt = r / 16, nt = r % 16;
                p0_transpose(p.w_proj_c + (size_t)l * 512 * 1024, 1024, 512, (bf16_t*)(p.ws + WS_WPC) + (size_t)l * 1024 * 512, kt * 64, nt * 64, 0, p.ssm_norm_w + l * 512, tile); continue; }
            r -= I_PC;
            { const int kt = r / 16, nt = r % 16;
                p0_transpose(p.w_out + (size_t)l * 1024 * 1024, 1024, 1024, (bf16_t*)(p.ws + WS_WOUT) + (size_t)l * 1024 * 1024, kt * 64, nt * 64, 0, nullptr, tile); }
        } else if (item < I_T + I_MOD) {
            const int it = item - I_T, l = it / 96, col0 = (it % 96) * 32, cl = tid & 31, ks = tid >> 5;
            float a0 = 0.f, a1 = 0.f, a2 = 0.f, a3 = 0.f;
            const float* wp = p.w_ada + ((size_t)l * 1024 + ks * 128) * 3072 + col0 + cl;
#pragma unroll 8
            for (int k = 0; k < 128; ++k) {
                const float wv = wp[(size_t)k * 3072]; const int kk = ks * 128 + k;
                a0 += siluf(p.c[kk]) * wv; a1 += siluf(p.c[1024 + kk]) * wv; a2 += siluf(p.c[2048 + kk]) * wv; a3 += siluf(p.c[3072 + kk]) * wv;
            }
            float* red = (float*)smem;
            red[(ks * 32 + cl) * 4 + 0] = a0; red[(ks * 32 + cl) * 4 + 1] = a1; red[(ks * 32 + cl) * 4 + 2] = a2; red[(ks * 32 + cl) * 4 + 3] = a3;
            __syncthreads();
            if (tid < 128) { const int b = tid >> 5, c2 = tid & 31; float s = 0.f;
#pragma unroll
                for (int k = 0; k < 8; ++k) s += red[(k * 32 + c2) * 4 + b];
                ((float*)(p.ws + WS_MOD))[(l * 4 + b) * 3072 + col0 + c2] = s + p.b_ada[l * 3072 + col0 + c2]; }
            __syncthreads();
        } else {
            float* rc = (float*)(p.ws + WS_ROPE); float* rs = rc + 128 * 16;
            for (int e = tid; e < 2048; e += 256) {
                const int pos = e >> 4, i = e & 15;
                const float freq = powf(10000.0f, -(float)i / 16.0f);
                const float ang = (float)pos * freq;
                const double rev = (double)ang * 0.15915494309189535; const double fr = rev - rint(rev);
                const float a = (float)(fr * 6.283185307179586);
                rc[e] = cosf(a); rs[e] = sinf(a);
            }
            if (tid < 2) {
                const int l = tid; float mqa = 0.f, mka = 0.f, mqb = 0.f, mkb = 0.f, mb = 0.f;
                for (int i = 0; i < 64; ++i) { mqa = fmaxf(mqa, fabsf(p.q_norm_a[l * 64 + i])); mka = fmaxf(mka, fabsf(p.k_norm_a[l * 64 + i]));
                    mqb = fmaxf(mqb, fabsf(p.q_norm_b[l * 64 + i])); mkb = fmaxf(mkb, fabsf(p.k_norm_b[l * 64 + i])); }
                for (int i = 0; i < 32 * 12; ++i) mb = fmaxf(mb, p.rel_bias[i]);
                float* bd = (float*)(p.ws + WS_BND);
                bd[l] = 8.f * mqa * mka * LOG2E; bd[2 + l] = (8.f * mqb * mkb + mb) * LOG2E;
            }
        }
    }
}

__device__ void norm_phase(const Params& p, int l, int hb, const float* xsrc) {
    const int lane = threadIdx.x & 63, gw = blockIdx.x * 4 + (threadIdx.x >> 6), nw = gridDim.x * 4;
    bf16_t* H = (bf16_t*)(p.ws + WS_H);
    const float* nwp = p.norm_w + l * 1024;
    for (int row = gw; row < TP; row += nw) {
        const size_t rg = (size_t)hb * TP + row; const int b = (int)(rg / SEQ);
        const f32x4* xr = (const f32x4*)(xsrc + rg * 1024);
        const float* md = (const float*)(p.ws + WS_MOD) + (size_t)(l * 4 + b) * 3072;
        f32x4 v[4]; float ss = 0.f;
#pragma unroll
        for (int j = 0; j < 4; ++j) { v[j] = xr[lane + 64 * j]; ss += v[j].x * v[j].x + v[j].y * v[j].y + v[j].z * v[j].z + v[j].w * v[j].w; }
        ss = wave_sum(ss); const float rstd = rsqrtf(ss * (1.f / 1024.f) + EPS);
#pragma unroll
        for (int j = 0; j < 4; ++j) {
            const int col = 4 * (lane + 64 * j);
            const f32x4 w4 = *(const f32x4*)(nwp + col), sh = *(const f32x4*)(md + col), sc = *(const f32x4*)(md + 1024 + col);
            const f32x4 o = v[j] * rstd * w4 * (1.f + sc) + sh;
            u32x2 pk; pk.x = pk2(o.x, o.y); pk.y = pk2(o.z, o.w);
            *(u32x2*)(H + (size_t)row * 1024 + col) = pk;
        }
    }
}

constexpr int GP = 72;
__device__ __forceinline__ void gemm_core(const bf16_t* __restrict__ A, int lda, const bf16_t* __restrict__ Bt, int ldb, int K, f32x4 (&acc)[4][4], unsigned char* smem, int tid) {
    bf16_t* As = (bf16_t*)smem; bf16_t* Bs = As + 128 * GP;
    asm volatile("" : "+v"(tid));
    const int lane = tid & 63, w = tid >> 6, wm = w >> 1, wn = w & 1, idx = lane & 15, kq = lane >> 4;
    u32x4 ra[4], rb[4];
#pragma unroll
    for (int mi = 0; mi < 4; ++mi)
#pragma unroll
        for (int ni = 0; ni < 4; ++ni) acc[mi][ni] = (f32x4){0.f, 0.f, 0.f, 0.f};
#pragma unroll
    for (int i = 0; i < 4; ++i) { const int c = tid + 256 * i, row = c >> 3, ch = c & 7;
        ra[i] = *(const u32x4*)(A + (size_t)row * lda + ch * 8); rb[i] = *(const u32x4*)(Bt + (size_t)row * ldb + ch * 8); }
    const int nk = K >> 6;
    for (int kt = 0; kt < nk; ++kt) {
        __syncthreads();
#pragma unroll
        for (int i = 0; i < 4; ++i) { const int c = tid + 256 * i, row = c >> 3, ch = c & 7;
            *(u32x4*)(As + row * GP + ch * 8) = ra[i]; *(u32x4*)(Bs + row * GP + ch * 8) = rb[i]; }
        __syncthreads();
        if (kt + 1 < nk) {
#pragma unroll
            for (int i = 0; i < 4; ++i) { const int c = tid + 256 * i, row = c >> 3, ch = c & 7;
                ra[i] = *(const u32x4*)(A + (size_t)row * lda + (kt + 1) * 64 + ch * 8); rb[i] = *(const u32x4*)(Bt + (size_t)row * ldb + (kt + 1) * 64 + ch * 8); }
        }
#pragma unroll
        for (int ks = 0; ks < 2; ++ks) {
            bf16x8 af[4], bfr[4];
#pragma unroll
            for (int mi = 0; mi < 4; ++mi) af[mi] = *(const bf16x8*)(As + (wm * 64 + mi * 16 + idx) * GP + ks * 32 + kq * 8);
#pragma unroll
            for (int ni = 0; ni < 4; ++ni) bfr[ni] = *(const bf16x8*)(Bs + (wn * 64 + ni * 16 + idx) * GP + ks * 32 + kq * 8);
#pragma unroll
            for (int mi = 0; mi < 4; ++mi)
#pragma unroll
                for (int ni = 0; ni < 4; ++ni) acc[mi][ni] = __builtin_amdgcn_mfma_f32_16x16x32_bf16(bfr[ni], af[mi], acc[mi][ni], 0, 0, 0);
        }
    }
}

__device__ __forceinline__ void st4bf(bf16_t* dst, f32x4 v) { u32x2 pk; pk.x = pk2(v.x, v.y); pk.y = pk2(v.z, v.w); *(u32x2*)dst = pk; }

__device__ void gemm1_phase(const Params& p, int l, int hb, unsigned char* smem) {
    const bf16_t* H = (const bf16_t*)(p.ws + WS_H);
    const bf16_t* Wt = (const bf16_t*)(p.ws + WS_WIN) + (size_t)l * NP * 1024;
    const float* ropec = (const float*)(p.ws + WS_ROPE); const float* ropes = ropec + 2048;
    constexpr int NT = 67, NTILES = 128 * NT, GRP = 8 * NT;
    for (int t = blockIdx.x; t < NTILES; t += gridDim.x) {
        const int grp = t / GRP, r = t % GRP, mt = grp * 8 + (r & 7), nt = r >> 3;
        const int m0 = mt * 128, n0 = nt * 128;
        f32x4 acc[4][4];
        int tid = threadIdx.x;
        gemm_core(H + (size_t)m0 * 1024, 1024, Wt + (size_t)n0 * 1024, 1024, 1024, acc, smem, tid);
        asm volatile("" : "+v"(tid));
        const int lane = tid & 63, w = tid >> 6, wm = w >> 1, wn = w & 1, idx = lane & 15, kq = lane >> 4;
        const int cw = n0 + wn * 64;
        const int lc = 4 * kq;
        if (cw < 768 && (cw < 640)) {
            const bool isq = cw < 512;
            const float* nwp = (isq ? p.q_norm_a : p.k_norm_a) + l * 64;
            bf16_t* dst = isq ? (bf16_t*)(p.ws + WS_QA) : (bf16_t*)(p.ws + WS_KA);
            const int pitch = isq ? 512 : 128, c0 = isq ? cw : cw - 512;
            const float qs = isq ? 0.125f * LOG2E : 1.f;
#pragma unroll
            for (int mi = 0; mi < 4; ++mi) {
                const int row = m0 + wm * 64 + mi * 16 + idx;
                float ss = 0.f;
#pragma unroll
                for (int ni = 0; ni < 4; ++ni) { const f32x4 v = acc[mi][ni]; ss += v.x * v.x + v.y * v.y + v.z * v.z + v.w * v.w; }
                ss += __shfl_xor(ss, 16); ss += __shfl_xor(ss, 32);
                const float rstd = rsqrtf(ss * (1.f / 64.f) + EPS);
                f32x4 y[4];
#pragma unroll
                for (int ni = 0; ni < 4; ++ni) y[ni] = acc[mi][ni] * rstd * *(const f32x4*)(nwp + ni * 16 + lc);
                const int tt = row & (SEQ - 1), prow = tt >> 6, pcol = tt & 63;
#pragma unroll
                for (int hf = 0; hf < 2; ++hf) {
                    const int pos = hf ? pcol : prow;
                    const f32x4 cs = *(const f32x4*)(ropec + pos * 16 + lc), sn = *(const f32x4*)(ropes + pos * 16 + lc);
                    const f32x4 a = y[2 * hf], b = y[2 * hf + 1];
                    y[2 * hf] = a * cs - b * sn; y[2 * hf + 1] = b * cs + a * sn;
                }
#pragma unroll
                for (int ni = 0; ni < 4; ++ni) st4bf(dst + (size_t)row * pitch + c0 + ni * 16 + lc, y[ni] * qs);
            }
        } else if (cw >= 1280 && cw < 2816) {
            const bool isq = cw < 2048;
            const float* nwp = (isq ? p.q_norm_b : p.k_norm_b) + l * 64;
            const int gc = isq ? cw - 1280 : cw - 2048, g = gc >> 8, c0 = gc & 255;
            const int sh = 2 * g;
            bf16_t* dst = (bf16_t*)(p.ws + (isq ? WS_QB : WS_KB));
            const float qs = isq ? 0.125f * LOG2E : 1.f;
#pragma unroll
            for (int mi = 0; mi < 4; ++mi) {
                const int row = m0 + wm * 64 + mi * 16 + idx;
                float ss = 0.f;
#pragma unroll
                for (int ni = 0; ni < 4; ++ni) { const f32x4 v = acc[mi][ni]; ss += v.x * v.x + v.y * v.y + v.z * v.z + v.w * v.w; }
                ss += __shfl_xor(ss, 16); ss += __shfl_xor(ss, 32);
                const float rstd = rsqrtf(ss * (1.f / 64.f) + EPS) * qs;
                const int bl = row >> 13, tt = row & (SEQ - 1);
                const int pp = (tt & ((1 << sh) - 1)) * (SEQ >> sh) + (tt >> sh);
                bf16_t* drow = dst + ((size_t)(bl * 3 + g) * SEQ + pp) * 256 + c0 + lc;
#pragma unroll
                for (int ni = 0; ni < 4; ++ni) st4bf(drow + ni * 16, acc[mi][ni] * rstd * *(const f32x4*)(nwp + ni * 16 + lc));
            }
        } else if (cw >= 2816 && cw < 3584) {
            const int gc = cw - 2816, g = gc >> 8, c0 = gc & 255, sh = 2 * g;
            bf16_t* dst = (bf16_t*)(p.ws + WS_VB);
#pragma unroll
            for (int mi = 0; mi < 4; ++mi) {
                const int row = m0 + wm * 64 + mi * 16 + idx;
                const int bl = row >> 13, tt = row & (SEQ - 1);
                const int pp = (tt & ((1 << sh) - 1)) * (SEQ >> sh) + (tt >> sh);
                bf16_t* drow = dst + ((size_t)(bl * 3 + g) * SEQ + pp) * 256 + c0 + lc;
#pragma unroll
                for (int ni = 0; ni < 4; ++ni) st4bf(drow + ni * 16, acc[mi][ni]);
            }
        } else if (cw >= 8448) {
            if (wn == 0) {
                float* dst = (float*)(p.ws + WS_DT);
                const f32x4 bias = *(const f32x4*)(p.dt_bias + l * 16 + lc);
#pragma unroll
                for (int mi = 0; mi < 4; ++mi) {
                    const int row = m0 + wm * 64 + mi * 16 + idx;
                    f32x4 v = acc[mi][0] + bias, o;
                    o.x = v.x > 20.f ? v.x : log1pf(__expf(v.x)); o.y = v.y > 20.f ? v.y : log1pf(__expf(v.y));
                    o.z = v.z > 20.f ? v.z : log1pf(__expf(v.z)); o.w = v.w > 20.f ? v.w : log1pf(__expf(v.w));
                    *(f32x4*)(dst + (size_t)row * 16 + lc) = o;
                }
            }
        } else {
            bf16_t* dst; int pitch, c0, mode;
            if (cw < 768) { dst = (bf16_t*)(p.ws + WS_VA); pitch = 128; c0 = cw - 640; mode = 0; }
            else if (cw < 1280) { dst = (bf16_t*)(p.ws + WS_GA); pitch = 512; c0 = cw - 768; mode = 1; }
            else if (cw < 3840) { dst = (bf16_t*)(p.ws + WS_GB); pitch = 256; c0 = cw - 3584; mode = 1; }
            else if (cw < 4864) { dst = (bf16_t*)(p.ws + WS_XBC); pitch = 1024; c0 = cw - 3840; mode = 0; }
            else if (cw < 5376) { dst = (bf16_t*)(p.ws + WS_ZS); pitch = 512; c0 = cw - 4864; mode = 1; }
            else { dst = (bf16_t*)(p.ws + WS_MG); pitch = 3072; c0 = cw - 5376; mode = 2; }
            const float* bg = p.b_gate + l * 3072 + c0 + lc;
#pragma unroll
            for (int mi = 0; mi < 4; ++mi) {
                const int row = m0 + wm * 64 + mi * 16 + idx;
#pragma unroll
                for (int ni = 0; ni < 4; ++ni) {
                    f32x4 v = acc[mi][ni];
                    if (mode == 1) { v.x = siluf(v.x); v.y = siluf(v.y); v.z = siluf(v.z); v.w = siluf(v.w); }
                    else if (mode == 2) { const f32x4 bb = *(const f32x4*)(bg + ni * 16); v.x = sigmf(v.x + bb.x); v.y = sigmf(v.y + bb.y); v.z = sigmf(v.z + bb.z); v.w = sigmf(v.w + bb.w); }
                    st4bf(dst + (size_t)row * pitch + c0 + ni * 16 + lc, v);
                }
            }
        }
    }
}

__device__ void merge_phase(const Params& p, int l, unsigned char* smem) {
    const bf16_t* MG = (const bf16_t*)(p.ws + WS_MG);
    const float* rstd = (const float*)(p.ws + WS_RSTD);
    bf16_t* MR = (bf16_t*)(p.ws + WS_MRG);
    for (int t = blockIdx.x; t < 128 * 8; t += gridDim.x) {
        const int mt = t >> 3, nt = t & 7, m0 = mt * 128, n0 = nt * 128;
#pragma unroll 1
        for (int br = 0; br < 3; ++br) {
            f32x4 acc[4][4];
            const bf16_t* A; const bf16_t* Bt; int K;
            if (br == 0) { A = (const bf16_t*)(p.ws + WS_QA); K = 512; Bt = (const bf16_t*)(p.ws + WS_WPA) + (size_t)l * 1024 * 512; }
            else if (br == 1) { A = (const bf16_t*)(p.ws + WS_YBM); K = 256; Bt = (const bf16_t*)(p.ws + WS_WPB) + (size_t)l * 1024 * 256; }
            else { A = (const bf16_t*)(p.ws + WS_YC); K = 512; Bt = (const bf16_t*)(p.ws + WS_WPC) + (size_t)l * 1024 * 512; }
            int tid = threadIdx.x;
            gemm_core(A + (size_t)m0 * K, K, Bt + (size_t)n0 * K, K, K, acc, smem, tid);
            asm volatile("" : "+v"(tid));
            const int lane = tid & 63, w = tid >> 6, wm = w >> 1, wn = w & 1, idx = lane & 15, kq = lane >> 4;
#pragma unroll
            for (int mi = 0; mi < 4; ++mi) {
                const int row = m0 + wm * 64 + mi * 16 + idx;
                const float rs = (br == 2) ? rstd[row] : 1.f;
#pragma unroll
                for (int ni = 0; ni < 4; ++ni) {
                    const int col = n0 + wn * 64 + ni * 16 + 4 * kq;
                    const u32x2 g = *(const u32x2*)(MG + (size_t)row * 3072 + br * 1024 + col);
                    f32x4 gv; gv.x = bflo(g.x); gv.y = bfhi(g.x); gv.z = bflo(g.y); gv.w = bfhi(g.y);
                    f32x4 v = gv * rs * acc[mi][ni];
                    bf16_t* mp = MR + (size_t)row * 1024 + col;
                    if (br > 0) { const u32x2 o = *(const u32x2*)mp; v.x += bflo(o.x); v.y += bfhi(o.x); v.z += bflo(o.y); v.w += bfhi(o.y); }
                    st4bf(mp, v);
                }
            }
        }
    }
}

__device__ void out_phase(const Params& p, int l, int hb, const float* xsrc, unsigned char* smem) {
    const bf16_t* MR = (const bf16_t*)(p.ws + WS_MRG);
    const bf16_t* Wt = (const bf16_t*)(p.ws + WS_WOUT) + (size_t)l * 1024 * 1024;
    for (int t = blockIdx.x; t < 128 * 8; t += gridDim.x) {
        const int mt = t >> 3, nt = t & 7, m0 = mt * 128, n0 = nt * 128;
        f32x4 acc[4][4];
        int tid = threadIdx.x;
        gemm_core(MR + (size_t)m0 * 1024, 1024, Wt + (size_t)n0 * 1024, 1024, 1024, acc, smem, tid);
        asm volatile("" : "+v"(tid));
        const int lane = tid & 63, w = tid >> 6, wm = w >> 1, wn = w & 1, idx = lane & 15, kq = lane >> 4;
#pragma unroll
        for (int mi = 0; mi < 4; ++mi) {
            const int row = m0 + wm * 64 + mi * 16 + idx; const size_t rg = (size_t)hb * TP + row; const int b = (int)(rg / SEQ);
            const float* gate = (const float*)(p.ws + WS_MOD) + (size_t)(l * 4 + b) * 3072 + 2048;
#pragma unroll
            for (int ni = 0; ni < 4; ++ni) {
                const int col = n0 + wn * 64 + ni * 16 + 4 * kq;
                const f32x4 xv = *(const f32x4*)(xsrc + rg * 1024 + col), gv = *(const f32x4*)(gate + col);
                *(f32x4*)(p.out + rg * 1024 + col) = xv + gv * acc[mi][ni];
            }
        }
    }
}

constexpr int AT_KS = 0, AT_VS = 9216, AT_LQ = 9216 + 8192, AT_LUT = AT_LQ + 512;

#define AT_STAGE_STORE() do { _Pragma("unroll") for (int i = 0; i < 2; ++i) { const int c = tid + 256 * i, row = c >> 3, ch = c & 7; \
        *(u32x4*)(Ks + row * 72 + ch * 8) = rk[i]; *(u32x4*)(Vs + (ch >> 2) * 4096 + row * 64 + (ch & 3) * 16) = rv[i]; } } while (0)

__device__ __forceinline__ void at_qk(f32x16& p0, f32x16& p1, const bf16_t* Ks, const bf16x8* qr, int r32, int hi) {
#pragma unroll
    for (int ds = 0; ds < 4; ++ds) {
        const bf16x8 k0 = *(const bf16x8*)(Ks + r32 * 72 + ds * 16 + hi * 8);
        const bf16x8 k1 = *(const bf16x8*)(Ks + (r32 + 32) * 72 + ds * 16 + hi * 8);
        p0 = __builtin_amdgcn_mfma_f32_32x32x16_bf16(k0, qr[ds], p0, 0, 0, 0);
        p1 = __builtin_amdgcn_mfma_f32_32x32x16_bf16(k1, qr[ds], p1, 0, 0, 0);
    }
}
__device__ __forceinline__ void at_pv(f32x16& o0, f32x16& o1, const f32x16& p0, const f32x16& p1, const unsigned char* Vs, int lane) {
    const int hi = lane >> 5;
    const unsigned char* vb = Vs + ((lane >> 4) & 1) * 32 + (lane & 3) * 8 + (4 * hi + ((lane & 15) >> 2)) * 64;
#pragma unroll
    for (int s = 0; s < 4; ++s) {
        u32x4 pw;
        if (s < 2) { pw.x = pk2(p0[8 * s + 0], p0[8 * s + 1]); pw.y = pk2(p0[8 * s + 2], p0[8 * s + 3]); pw.z = pk2(p0[8 * s + 4], p0[8 * s + 5]); pw.w = pk2(p0[8 * s + 6], p0[8 * s + 7]); }
        else { const int q = s - 2; pw.x = pk2(p1[8 * q + 0], p1[8 * q + 1]); pw.y = pk2(p1[8 * q + 2], p1[8 * q + 3]); pw.z = pk2(p1[8 * q + 4], p1[8 * q + 5]); pw.w = pk2(p1[8 * q + 6], p1[8 * q + 7]); }
        const bf16x8 pa = __builtin_bit_cast(bf16x8, pw);
        const bf16x8 v0 = cat8(tr16(vb + s * 1024), tr16(vb + s * 1024 + 512));
        const bf16x8 v1 = cat8(tr16(vb + 4096 + s * 1024), tr16(vb + 4096 + s * 1024 + 512));
        o0 = __builtin_amdgcn_mfma_f32_32x32x16_bf16(pa, v0, o0, 0, 0, 0);
        o1 = __builtin_amdgcn_mfma_f32_32x32x16_bf16(pa, v1, o1, 0, 0, 0);
    }
}

__device__ void attn_a_item(const Params& p, int item, int l, unsigned char* smem) {
    int tid_ = threadIdx.x; asm volatile("" : "+v"(tid_));
    const int tid = tid_, lane = tid & 63, w = tid >> 6, r32 = lane & 31, hi = lane >> 5;
    const int b = item >> 9, r = item & 511, kvh = r >> 8, qblk = (r >> 2) & 63, hq = kvh * 4 + (r & 3);
    bf16_t* Ks = (bf16_t*)(smem + AT_KS); unsigned char* Vs = smem + AT_VS; float* lq = (float*)(smem + AT_LQ) + w * 32;
    bf16_t* QA = (bf16_t*)(p.ws + WS_QA);
    const bf16_t* GA = (const bf16_t*)(p.ws + WS_GA);
    const size_t tokq = (size_t)b * SEQ + qblk * 128 + w * 32;
    bf16x8 qr[4];
#pragma unroll
    for (int ds = 0; ds < 4; ++ds) qr[ds] = *(const bf16x8*)(QA + (tokq + r32) * 512 + hq * 64 + ds * 16 + hi * 8);
    const bf16_t* Kb = (const bf16_t*)(p.ws + WS_KA) + (size_t)b * SEQ * 128 + kvh * 64;
    const bf16_t* Vb = (const bf16_t*)(p.ws + WS_VA) + (size_t)b * SEQ * 128 + kvh * 64;
    const float nshift = -((const float*)(p.ws + WS_BND))[l];
    f32x16 o0, o1;
#pragma unroll
    for (int i = 0; i < 16; ++i) { o0[i] = 0.f; o1[i] = 0.f; }
    float lacc = 0.f;
    u32x4 rk[2], rv[2];
#pragma unroll
    for (int i = 0; i < 2; ++i) { const int c = tid + 256 * i, row = c >> 3, ch = c & 7;
        rk[i] = *(const u32x4*)(Kb + (size_t)row * 128 + ch * 8); rv[i] = *(const u32x4*)(Vb + (size_t)row * 128 + ch * 8); }
    for (int kt = 0; kt < SEQ / 64; ++kt) {
        __syncthreads();
        AT_STAGE_STORE();
        __syncthreads();
        if (kt + 1 < SEQ / 64) {
#pragma unroll
            for (int i = 0; i < 2; ++i) { const int c = tid + 256 * i, row = c >> 3, ch = c & 7;
                rk[i] = *(const u32x4*)(Kb + (size_t)((kt + 1) * 64 + row) * 128 + ch * 8); rv[i] = *(const u32x4*)(Vb + (size_t)((kt + 1) * 64 + row) * 128 + ch * 8); }
        }
        f32x16 p0, p1;
#pragma unroll
        for (int i = 0; i < 16; ++i) { p0[i] = nshift; p1[i] = nshift; }
        at_qk(p0, p1, Ks, qr, r32, hi);
#pragma unroll
        for (int i = 0; i < 16; ++i) { p0[i] = __builtin_amdgcn_exp2f(p0[i]); p1[i] = __builtin_amdgcn_exp2f(p1[i]); lacc += p0[i] + p1[i]; }
        at_pv(o0, o1, p0, p1, Vs, lane);
    }
    lacc += __shfl_xor(lacc, 32);
    if (hi == 0) lq[r32] = lacc;
    asm volatile("s_waitcnt lgkmcnt(0)" ::: "memory");
#pragma unroll
    for (int rr = 0; rr < 16; ++rr) {
        const int q = crow(rr, hi); const float inv = 1.f / lq[q];
        const size_t off = (tokq + q) * 512 + hq * 64 + r32;
        const float g0 = bf2f(GA[off]), g1 = bf2f(GA[off + 32]);
        QA[off] = (bf16_t)(pk2(o0[rr] * inv * g0, 0.f) & 0xffffu);
        QA[off + 32] = (bf16_t)(pk2(o1[rr] * inv * g1, 0.f) & 0xffffu);
    }
}

__device__ void attn_b_item(const Params& p, int item, int l, unsigned char* smem) {
    int tid_ = threadIdx.x; asm volatile("" : "+v"(tid_));
    const int tid = tid_, lane = tid & 63, w = tid >> 6, r32 = lane & 31, hi = lane >> 5;
    const int blk = item & 63, j = (item >> 6) & 3, bg = item >> 8, g = bg % 3, b = bg / 3;
    const int sh = 2 * g, dil = 1 << sh, Mlen = SEQ >> sh;
    bf16_t* Ks = (bf16_t*)(smem + AT_KS); unsigned char* Vs = smem + AT_VS; float* lq = (float*)(smem + AT_LQ) + w * 32; float* lut = (float*)(smem + AT_LUT);
    bf16_t* QB = (bf16_t*)(p.ws + WS_QB) + (size_t)bg * SEQ * 256 + j * 64;
    const bf16_t* KB = (const bf16_t*)(p.ws + WS_KB) + (size_t)bg * SEQ * 256 + j * 64;
    const bf16_t* VB = (const bf16_t*)(p.ws + WS_VB) + (size_t)bg * SEQ * 256 + j * 64;
    float* LSE = (float*)(p.ws + WS_LSE) + (size_t)bg * SEQ * 4 + j;
    const int p0r = blk * 128, seq_lo = (p0r / Mlen) * Mlen, seq_hi = seq_lo + Mlen;
    __syncthreads();
    if (tid < 129) {
        const int rel = tid - 64, n = (rel < 0 ? -rel : rel) * dil;
        int bk;
        if (n < 8) bk = n; else { bk = 8 + (n >= 15) + (n >= 27) + (n >= 50) + (n >= 91) + (n >= 166) + (n >= 305) + (n >= 559); }
        if (rel > 0) bk += 16;
        lut[tid] = p.rel_bias[bk * 12 + g * 4 + j] * LOG2E;
    }
    const int qpos = p0r + w * 32 + r32;
    bf16x8 qr[4];
#pragma unroll
    for (int ds = 0; ds < 4; ++ds) qr[ds] = *(const bf16x8*)(QB + (size_t)qpos * 256 + ds * 16 + hi * 8);
    const float nshift = -((const float*)(p.ws + WS_BND))[2 + l];
    f32x16 o0, o1;
#pragma unroll
    for (int i = 0; i < 16; ++i) { o0[i] = 0.f; o1[i] = 0.f; }
    float lacc = 0.f;
    u32x4 rk[2], rv[2];
    for (int kt = 0; kt < 4; ++kt) {
        const int kbase = p0r - 64 + 64 * kt;
#pragma unroll
        for (int i = 0; i < 2; ++i) { const int c = tid + 256 * i, row = c >> 3, ch = c & 7;
            int pr = kbase + row; pr = pr < 0 ? 0 : (pr > SEQ - 1 ? SEQ - 1 : pr);
            rk[i] = *(const u32x4*)(KB + (size_t)pr * 256 + ch * 8); rv[i] = *(const u32x4*)(VB + (size_t)pr * 256 + ch * 8); }
        __syncthreads();
        AT_STAGE_STORE();
        __syncthreads();
        f32x16 p0, p1;
#pragma unroll
        for (int i = 0; i < 16; ++i) { p0[i] = nshift; p1[i] = nshift; }
        at_qk(p0, p1, Ks, qr, r32, hi);
#pragma unroll
        for (int i = 0; i < 16; ++i) {
            const int kv0 = kbase + crow(i, hi), kv1 = kv0 + 32;
            const int rel0 = kv0 - qpos, rel1 = kv1 - qpos;
            const bool ok0 = rel0 >= -64 && rel0 <= 64 && kv0 >= seq_lo && kv0 < seq_hi;
            const bool ok1 = rel1 >= -64 && rel1 <= 64 && kv1 >= seq_lo && kv1 < seq_hi;
            const float e0 = __builtin_amdgcn_exp2f(p0[i] + lut[ok0 ? rel0 + 64 : 64]);
            const float e1 = __builtin_amdgcn_exp2f(p1[i] + lut[ok1 ? rel1 + 64 : 64]);
            p0[i] = ok0 ? e0 : 0.f; p1[i] = ok1 ? e1 : 0.f; lacc += p0[i] + p1[i];
        }
        at_pv(o0, o1, p0, p1, Vs, lane);
    }
    lacc += __shfl_xor(lacc, 32);
    if (hi == 0) { lq[r32] = lacc; LSE[(size_t)qpos * 4] = (-nshift + log2f(lacc)) * LN2; }
    asm volatile("s_waitcnt lgkmcnt(0)" ::: "memory");
#pragma unroll
    for (int rr = 0; rr < 16; ++rr) {
        const int q = crow(rr, hi); const float inv = 1.f / lq[q];
        const size_t off = (size_t)(p0r + w * 32 + q) * 256 + r32;
        QB[off] = (bf16_t)(pk2(o0[rr] * inv, 0.f) & 0xffffu);
        QB[off + 32] = (bf16_t)(pk2(o1[rr] * inv, 0.f) & 0xffffu);
    }
}

constexpr int SS_BS = 0, SS_CS = 8704, SS_XS = 17408, SS_XWS = 22016, SS_GS = 26624, SS_SB = 29184, SS_CW = 46592, SS_SC = 54272, SS_END = 55296;

template <int PASS>
__device__ void ssd_item(const Params& p, int item, int l, unsigned char* smem) {
    int tid_ = threadIdx.x; asm volatile("" : "+v"(tid_));
    const int tid = tid_, lane = tid & 63, w = tid >> 6, idx = lane & 15, kq = lane >> 4;
    const int seg = item & 15, h = (item >> 4) & 7, dir = (item >> 7) & 1, b = item >> 8, grp = h >> 2;
    bf16_t* Bs = (bf16_t*)(smem + SS_BS); bf16_t* Cs = (bf16_t*)(smem + SS_CS); bf16_t* Xs = (bf16_t*)(smem + SS_XS); bf16_t* Xws = (bf16_t*)(smem + SS_XWS);
    bf16_t* Gs = (bf16_t*)(smem + SS_GS); bf16_t* Sb = (bf16_t*)(smem + SS_SB); float* cwl = (float*)(smem + SS_CW); float* sc = (float*)(smem + SS_SC);
    float* s_dt = sc, *s_c = sc + 32, *s_rs = sc + 64, *s_wl = sc + 96, *s_tot = sc + 128;
    const bf16_t* XBC = (const bf16_t*)(p.ws + WS_XBC);
    const float* DT = (const float*)(p.ws + WS_DT);
    float* ST = (float*)(p.ws + WS_ST); float* SEGT = (float*)(p.ws + WS_SEGT);
    bf16_t* Y = (bf16_t*)(p.ws + (dir ? WS_YS : WS_YF));
    const float Aneg = -__expf(p.a_log[l * 16 + dir * 8 + h]);
    const float Dh = p.d_skip[l * 8 + h];
    __syncthreads();
    for (int e = tid; e < 6 * 320; e += 256) {
        const int tap = e / 320, lc = e % 320;
        const int ch = lc < 64 ? h * 64 + lc : (lc < 192 ? 512 + grp * 128 + (lc - 64) : 768 + grp * 128 + (lc - 192));
        cwl[e] = tap < 5 ? p.conv_w[(size_t)l * 5 * 1024 + tap * 1024 + ch] : p.conv_b[l * 1024 + ch];
    }
    f32x4 S[8];
#pragma unroll
    for (int nt = 0; nt < 8; ++nt) S[nt] = (f32x4){0.f, 0.f, 0.f, 0.f};
    const int ibase = item & ~15;
    if (PASS == 3) {
        if (dir == 0) {
            for (int e = 0; e < seg; ++e) { const float dc = __expf(SEGT[ibase + e]); const f32x4* src = (const f32x4*)(ST + (size_t)(ibase + e) * 8192);
#pragma unroll
                for (int nt = 0; nt < 8; ++nt) S[nt] = S[nt] * dc + src[(w * 8 + nt) * 64 + lane]; }
        } else {
            for (int e = NSEG - 1; e > seg; --e) { const float dc = __expf(SEGT[ibase + e]); const f32x4* src = (const f32x4*)(ST + (size_t)(ibase + e) * 8192);
#pragma unroll
                for (int nt = 0; nt < 8; ++nt) S[nt] = S[nt] * dc + src[(w * 8 + nt) * 64 + lane]; }
        }
#pragma unroll
        for (int nt = 0; nt < 8; ++nt) st4bf(Sb + (16 * w + idx) * 136 + 16 * nt + 4 * kq, S[nt]);
    }
    float segtot = 0.f;
    for (int si = 0; si < NSUB; ++si) {
        const int scn = dir ? (NSUB - 1 - si) : si;
        const int t0 = seg * SEGLEN + scn * TSUB;
        const size_t tokb = (size_t)b * SEQ;
        __syncthreads();
        if (w == 0) {
            float dtv = 0.f, av = 0.f;
            if (lane < 32) { dtv = DT[(tokb + t0 + lane) * 16 + dir * 8 + h]; av = dtv * Aneg; }
            float pre = av;
#pragma unroll
            for (int o = 1; o < 32; o <<= 1) { const float t = __shfl_up(pre, o); if (lane >= o) pre += t; }
            const float tot = __shfl(pre, 31);
            const float cc = dir ? (tot - pre + av) : pre;
            if (lane < 32) { s_dt[lane] = dtv; s_c[lane] = cc; s_rs[lane] = __expf(cc); s_wl[lane] = dtv * __expf(tot - cc); }
            if (lane == 0) s_tot[0] = tot;
        }
        __syncthreads();
        segtot += s_tot[0];
#pragma unroll 1
        for (int i = 0; i < 5; ++i) {
            const int u = tid + 256 * i, lrow = u / 40, ci = u % 40, lc = ci * 8;
            const int scol = ci < 8 ? h * 64 + lc : (ci < 24 ? 512 + grp * 128 + (lc - 64) : 768 + grp * 128 + (lc - 192));
            float a[8];
#pragma unroll
            for (int e = 0; e < 8; ++e) a[e] = cwl[5 * 320 + lc + e];
#pragma unroll
            for (int tap = 0; tap < 5; ++tap) {
                const int tt = t0 + lrow + tap - 2;
                if (tt >= 0 && tt < SEQ) {
                    const u32x4 v = *(const u32x4*)(XBC + (tokb + tt) * 1024 + scol);
                    const float* wv = cwl + tap * 320 + lc;
                    a[0] += bflo(v.x) * wv[0]; a[1] += bfhi(v.x) * wv[1]; a[2] += bflo(v.y) * wv[2]; a[3] += bfhi(v.y) * wv[3];
                    a[4] += bflo(v.z) * wv[4]; a[5] += bfhi(v.z) * wv[5]; a[6] += bflo(v.w) * wv[6]; a[7] += bfhi(v.w) * wv[7];
                }
            }
#pragma unroll
            for (int e = 0; e < 8; ++e) a[e] = siluf(a[e]);
            u32x4 o; o.x = pk2(a[0], a[1]); o.y = pk2(a[2], a[3]); o.z = pk2(a[4], a[5]); o.w = pk2(a[6], a[7]);
            if (ci < 8) {
                *(u32x4*)(Xs + lrow * 72 + lc) = o;
                const float wl = s_wl[lrow];
                u32x4 o2; o2.x = pk2(a[0] * wl, a[1] * wl); o2.y = pk2(a[2] * wl, a[3] * wl); o2.z = pk2(a[4] * wl, a[5] * wl); o2.w = pk2(a[6] * wl, a[7] * wl);
                *(u32x4*)(Xws + lrow * 72 + lc) = o2;
            } else if (ci < 24) *(u32x4*)(Bs + lrow * 136 + (lc - 64)) = o;
            else *(u32x4*)(Cs + lrow * 136 + (lc - 192)) = o;
        }
        __syncthreads();
        if (PASS == 3) {
            const int it = w >> 1, jt = w & 1;
            f32x4 cb = (f32x4){0.f, 0.f, 0.f, 0.f};
#pragma unroll
            for (int ks = 0; ks < 4; ++ks) {
                const bf16x8 fb = *(const bf16x8*)(Bs + (16 * jt + idx) * 136 + ks * 32 + kq * 8);
                const bf16x8 fc = *(const bf16x8*)(Cs + (16 * it + idx) * 136 + ks * 32 + kq * 8);
                cb = __builtin_amdgcn_mfma_f32_16x16x32_bf16(fb, fc, cb, 0, 0, 0);
            }
            {
                const int ii = 16 * it + idx; const float ci_ = s_c[ii];
                f32x4 gv;
#pragma unroll
                for (int rg = 0; rg < 4; ++rg) {
                    const int jj = 16 * jt + 4 * kq + rg;
                    const bool ok = dir ? (jj >= ii) : (jj <= ii);
                    const float e = __expf(ci_ - s_c[jj]) * s_dt[jj];
                    gv[rg] = ok ? cb[rg] * e : 0.f;
                }
                st4bf(Gs + ii * 40 + 16 * jt + 4 * kq, gv);
            }
            __syncthreads();
            const unsigned char* xtr = (const unsigned char*)Xs + (8 * kq + (idx >> 2)) * 144 + (16 * w + 4 * (idx & 3)) * 2;
            const bf16x8 xf = cat8(tr16(xtr), tr16(xtr + 4 * 144));
#pragma unroll
            for (int it2 = 0; it2 < 2; ++it2) {
                const int ii = 16 * it2 + idx;
                const bf16x8 gf = *(const bf16x8*)(Gs + ii * 40 + 8 * kq);
                f32x4 yd = (f32x4){0.f, 0.f, 0.f, 0.f}, yo = (f32x4){0.f, 0.f, 0.f, 0.f};
                yd = __builtin_amdgcn_mfma_f32_16x16x32_bf16(xf, gf, yd, 0, 0, 0);
#pragma unroll
                for (int ks = 0; ks < 4; ++ks) {
                    const bf16x8 sf = *(const bf16x8*)(Sb + (16 * w + idx) * 136 + ks * 32 + kq * 8);
                    const bf16x8 cf = *(const bf16x8*)(Cs + ii * 136 + ks * 32 + kq * 8);
                    yo = __builtin_amdgcn_mfma_f32_16x16x32_bf16(sf, cf, yo, 0, 0, 0);
                }
                f32x4 y = yd + yo * s_rs[ii];
                if (dir == 0) { const u32x2 xv = *(const u32x2*)(Xs + ii * 72 + 16 * w + 4 * kq);
                    y.x += Dh * bflo(xv.x); y.y += Dh * bfhi(xv.x); y.z += Dh * bflo(xv.y); y.w += Dh * bfhi(xv.y); }
                st4bf(Y + (tokb + t0 + ii) * 512 + h * 64 + 16 * w + 4 * kq, y);
            }
        }
        {
            const float dc = __expf(s_tot[0]);
            const unsigned char* xw = (const unsigned char*)Xws + (8 * kq + (idx >> 2)) * 144 + (16 * w + 4 * (idx & 3)) * 2;
            const bf16x8 xwf = cat8(tr16(xw), tr16(xw + 4 * 144));
#pragma unroll
            for (int nt = 0; nt < 8; ++nt) {
                const unsigned char* bt = (const unsigned char*)Bs + (8 * kq + (idx >> 2)) * 272 + (16 * nt + 4 * (idx & 3)) * 2;
                const bf16x8 bf = cat8(tr16(bt), tr16(bt + 4 * 272));
                S[nt] = __builtin_amdgcn_mfma_f32_16x16x32_bf16(bf, xwf, S[nt] * dc, 0, 0, 0);
            }
            if (PASS == 3) {
#pragma unroll
                for (int nt = 0; nt < 8; ++nt) st4bf(Sb + (16 * w + idx) * 136 + 16 * nt + 4 * kq, S[nt]);
            }
        }
    }
    if (PASS == 1) {
        f32x4* dst = (f32x4*)(ST + (size_t)item * 8192);
#pragma unroll
        for (int nt = 0; nt < 8; ++nt) dst[(w * 8 + nt) * 64 + lane] = S[nt];
        if (tid == 0) SEGT[item] = segtot;
    }
}

__device__ void post2_phase(const Params& p) {
    const int lane = threadIdx.x & 63, gw = blockIdx.x * 4 + (threadIdx.x >> 6), nw = gridDim.x * 4;
    const bf16_t* OB = (const bf16_t*)(p.ws + WS_QB); const float* LSE = (const float*)(p.ws + WS_LSE);
    const bf16_t* GB = (const bf16_t*)(p.ws + WS_GB);
    bf16_t* YBM = (bf16_t*)(p.ws + WS_YBM);
    const bf16_t* YF = (const bf16_t*)(p.ws + WS_YF); const bf16_t* YS = (const bf16_t*)(p.ws + WS_YS); const bf16_t* ZS = (const bf16_t*)(p.ws + WS_ZS);
    bf16_t* YC = (bf16_t*)(p.ws + WS_YC); float* RS = (float*)(p.ws + WS_RSTD);
    for (int row = gw; row < TP; row += nw) {
        const int bl = row >> 13, tt = row & (SEQ - 1), j = lane >> 4;
        float ls[3]; size_t ro[3];
#pragma unroll
        for (int g = 0; g < 3; ++g) { const int sh = 2 * g; const int pp = (tt & ((1 << sh) - 1)) * (SEQ >> sh) + (tt >> sh);
            ro[g] = (size_t)(bl * 3 + g) * SEQ + pp; ls[g] = LSE[ro[g] * 4 + j]; }
        const float mx = fmaxf(ls[0], fmaxf(ls[1], ls[2]));
        float wg[3]; float ws = 0.f;
#pragma unroll
        for (int g = 0; g < 3; ++g) { wg[g] = __expf(ls[g] - mx); ws += wg[g]; }
        const float inv = 1.f / ws;
        f32x4 acc = (f32x4){0.f, 0.f, 0.f, 0.f};
#pragma unroll
        for (int g = 0; g < 3; ++g) { const u32x2 v = *(const u32x2*)(OB + ro[g] * 256 + 4 * lane); const float wv = wg[g] * inv;
            acc.x += wv * bflo(v.x); acc.y += wv * bfhi(v.x); acc.z += wv * bflo(v.y); acc.w += wv * bfhi(v.y); }
        { const u32x2 gt = *(const u32x2*)(GB + (size_t)row * 256 + 4 * lane);
          acc.x *= bflo(gt.x); acc.y *= bfhi(gt.x); acc.z *= bflo(gt.y); acc.w *= bfhi(gt.y); }
        st4bf(YBM + (size_t)row * 256 + 4 * lane, acc);
        const u32x4 a = *(const u32x4*)(YF + (size_t)row * 512 + 8 * lane), bq = *(const u32x4*)(YS + (size_t)row * 512 + 8 * lane), z = *(const u32x4*)(ZS + (size_t)row * 512 + 8 * lane);
        float y[8];
        y[0] = (bflo(a.x) + bflo(bq.x)) * bflo(z.x); y[1] = (bfhi(a.x) + bfhi(bq.x)) * bfhi(z.x);
        y[2] = (bflo(a.y) + bflo(bq.y)) * bflo(z.y); y[3] = (bfhi(a.y) + bfhi(bq.y)) * bfhi(z.y);
        y[4] = (bflo(a.z) + bflo(bq.z)) * bflo(z.z); y[5] = (bfhi(a.z) + bfhi(bq.z)) * bfhi(z.z);
        y[6] = (bflo(a.w) + bflo(bq.w)) * bflo(z.w); y[7] = (bfhi(a.w) + bfhi(bq.w)) * bfhi(z.w);
        float ss = 0.f;
#pragma unroll
        for (int e = 0; e < 8; ++e) ss += y[e] * y[e];
        ss = wave_sum(ss);
        u32x4 o; o.x = pk2(y[0], y[1]); o.y = pk2(y[2], y[3]); o.z = pk2(y[4], y[5]); o.w = pk2(y[6], y[7]);
        *(u32x4*)(YC + (size_t)row * 512 + 8 * lane) = o;
        if (lane == 0) RS[row] = rsqrtf(ss * (1.f / 512.f) + EPS);
    }
}

constexpr int SMEM_BYTES = 55296;
__global__ void __launch_bounds__(256, 2) hybrid_fwd(Params p) {
    cg::grid_group grid = cg::this_grid();
    __shared__ __attribute__((aligned(16))) unsigned char smem[SMEM_BYTES];
    { const Params q = launder(p); phase0(q, smem); }
    grid.sync();
#pragma unroll 1
    for (int l = 0; l < DEPTH; ++l) {
#pragma unroll 1
        for (int hb = 0; hb < 2; ++hb) {
            { const Params q = launder(p); norm_phase(q, l, hb, (l == 0) ? q.x : q.out); }
            grid.sync();
            { const Params q = launder(p); gemm1_phase(q, l, hb, smem); }
            grid.sync();
            { const Params q = launder(p);
#pragma unroll 1
              for (int it = blockIdx.x; it < 512 + 1536; it += gridDim.x) { if (it < 512) ssd_item<1>(q, it, l, smem); else attn_b_item(q, it - 512, l, smem); } }
            grid.sync();
            { const Params q = launder(p);
#pragma unroll 1
              for (int it = blockIdx.x; it < 1024 + 512; it += gridDim.x) { if (it < 1024) attn_a_item(q, it, l, smem); else ssd_item<3>(q, it - 1024, l, smem); } }
            grid.sync();
            { const Params q = launder(p); post2_phase(q); }
            grid.sync();
            { const Params q = launder(p); merge_phase(q, l, smem); }
            grid.sync();
            { const Params q = launder(p); out_phase(q, l, hb, (l == 0) ? q.x : q.out, smem); }
            grid.sync();
        }
    }
}

extern "C" void kernel_launch(void* const* d_in, const int* in_sizes, int n_in, void* d_out, int out_size, void* d_ws, size_t ws_size, hipStream_t stream) {
    static int grid_blocks = 0;
    if (!grid_blocks) {
        int dev = 0, cus = 0, per_cu = 0;
        hipGetDevice(&dev);
        hipDeviceGetAttribute(&cus, hipDeviceAttributeMultiprocessorCount, dev);
        hipOccupancyMaxActiveBlocksPerMultiprocessor(&per_cu, hybrid_fwd, 256, 0);
        if (per_cu > 2) per_cu = 2;
        if (per_cu < 1) per_cu = 1;
        grid_blocks = cus * per_cu;
    }
    Params p{};
    const float** pp = (const float**)&p;
    for (int i = 0; i < 22; ++i) pp[i] = (const float*)d_in[i];
    p.out = (float*)d_out; p.ws = (unsigned char*)d_ws;
    void* args[] = {&p};
    hipError_t e = hipLaunchCooperativeKernel((void*)hybrid_fwd, dim3(grid_blocks), dim3(256), args, 0, stream);
    if (e != hipSuccess) fprintf(stderr, "cooperative launch failed: %s (grid %d)\n", hipGetErrorString(e), grid_blocks);
}
```

```cpp
#include <hip/hip_runtime.h>
#include <hip/hip_cooperative_groups.h>
#include <cstdint>
#include <cstdio>
namespace cg = cooperative_groups;

typedef unsigned short bf16_t;
typedef short bf16x8 __attribute__((ext_vector_type(8)));
typedef short v4i16 __attribute__((ext_vector_type(4)));
typedef float f32x2 __attribute__((ext_vector_type(2)));
typedef float f32x4 __attribute__((ext_vector_type(4)));
typedef float f32x16 __attribute__((ext_vector_type(16)));
typedef unsigned u32x2 __attribute__((ext_vector_type(2)));
typedef unsigned u32x4 __attribute__((ext_vector_type(4)));
typedef __bf16 bf16x2_t __attribute__((ext_vector_type(2)));
#define LDSAS __attribute__((address_space(3)))

constexpr int SEQ = 8192, DM = 1024, NBATCH = 4, NBH = 2, TP = NBH * SEQ, DEPTH = 2;
constexpr int NP = 8576;
constexpr float EPS = 1e-6f;
constexpr float LOG2E = 1.4426950408889634f, LN2 = 0.6931471805599453f;
constexpr int NSEG = 16, SEGLEN = 512, TSUB = 32, NSUB = SEGLEN / TSUB;

constexpr size_t MiB = 1u << 20;
constexpr size_t WS_WIN = 0;
constexpr size_t WS_WPA = 34 * MiB;
constexpr size_t WS_WPB = 36 * MiB;
constexpr size_t WS_WPC = 37 * MiB;
constexpr size_t WS_WOUT = 39 * MiB;
constexpr size_t WS_MOD = 43 * MiB;
constexpr size_t WS_ROPE = 43 * MiB + 128 * 1024;
constexpr size_t WS_BND = 43 * MiB + 160 * 1024;
constexpr size_t WS_RSTD = 43 * MiB + 256 * 1024;
constexpr size_t WS_SEGT = 43 * MiB + 512 * 1024;
constexpr size_t WS_LSE = 44 * MiB;
constexpr size_t WS_DT = 45 * MiB;
constexpr size_t WS_H = 48 * MiB;
constexpr size_t WS_QA = 80 * MiB;
constexpr size_t WS_KA = 96 * MiB;
constexpr size_t WS_VA = 100 * MiB;
constexpr size_t WS_GA = 104 * MiB;
constexpr size_t WS_QB = 120 * MiB;
constexpr size_t WS_KB = 144 * MiB;
constexpr size_t WS_VB = 168 * MiB;
constexpr size_t WS_GB = 192 * MiB;
constexpr size_t WS_XBC = 200 * MiB;
constexpr size_t WS_ZS = 232 * MiB;
constexpr size_t WS_MG = 248 * MiB;
constexpr size_t WS_YF = 344 * MiB;
constexpr size_t WS_YS = 360 * MiB;
constexpr size_t WS_YBM = 376 * MiB;
constexpr size_t WS_YC = 384 * MiB;
constexpr size_t WS_MRG = 400 * MiB;
constexpr size_t WS_ST = 432 * MiB;

struct Params {
    const float *x, *c, *norm_w, *w_ada, *b_ada, *w_in, *b_gate, *q_norm_a, *k_norm_a, *q_norm_b, *k_norm_b, *rel_bias,
        *conv_w, *conv_b, *a_log, *dt_bias, *d_skip, *ssm_norm_w, *w_proj_a, *w_proj_b, *w_proj_c, *w_out;
    float* out;
    unsigned char* ws;
};


__device__ __forceinline__ Params launder(const Params& p) {
    Params q = p;
    asm volatile("" : "+s"(q.x), "+s"(q.c), "+s"(q.norm_w), "+s"(q.w_ada), "+s"(q.b_ada), "+s"(q.w_in), "+s"(q.b_gate), "+s"(q.q_norm_a), "+s"(q.k_norm_a), "+s"(q.q_norm_b), "+s"(q.k_norm_b), "+s"(q.rel_bias));
    asm volatile("" : "+s"(q.conv_w), "+s"(q.conv_b), "+s"(q.a_log), "+s"(q.dt_bias), "+s"(q.d_skip), "+s"(q.ssm_norm_w), "+s"(q.w_proj_a), "+s"(q.w_proj_b), "+s"(q.w_proj_c), "+s"(q.w_out), "+s"(q.out), "+s"(q.ws));
    return q;
}
__device__ __forceinline__ unsigned pk2(float lo, float hi) { f32x2 v = {lo, hi}; bf16x2_t b = __builtin_convertvector(v, bf16x2_t); return __builtin_bit_cast(unsigned, b); }
__device__ __forceinline__ float bf2f(unsigned short b) { return __uint_as_float(((unsigned)b) << 16); }
__device__ __forceinline__ float bflo(unsigned u) { return __uint_as_float(u << 16); }
__device__ __forceinline__ float bfhi(unsigned u) { return __uint_as_float(u & 0xffff0000u); }
__device__ __forceinline__ float siluf(float v) { return v / (1.f + __expf(-v)); }
__device__ __forceinline__ float sigmf(float v) { return 1.f / (1.f + __expf(-v)); }
__device__ __forceinline__ float wave_sum(float v) {
#pragma unroll
    for (int o = 1; o < 64; o <<= 1) v += __shfl_xor(v, o);
    return v;
}
__device__ __forceinline__ v4i16 tr16(const unsigned char* p) { return __builtin_amdgcn_ds_read_tr16_b64_v4i16((LDSAS v4i16*)p); }
__device__ __forceinline__ bf16x8 cat8(v4i16 a, v4i16 b) { return (bf16x8){a[0], a[1], a[2], a[3], b[0], b[1], b[2], b[3]}; }
__device__ __forceinline__ int crow(int r, int hi) { return (r & 3) + 8 * (r >> 2) + 4 * hi; }

__device__ __forceinline__ void p0_transpose(const float* __restrict__ W, int ldw, int K, bf16_t* __restrict__ Wt, int k0, int n0, int mode,
                                             const float* __restrict__ rowscale, float* tile) {
    const int tid = threadIdx.x, tx = tid & 63, ty = tid >> 6;
    const int np = n0 + tx; int n = np; bool valid = true;
    if (mode == 1) {
        if (np < 4352) n = np; else if (np < 4864) n = np + 512; else if (np < 5376) n = np - 512;
        else if (np < 8448) n = np + 16; else if (np < 8464) n = np - 3072; else { valid = false; n = 0; }
    }
#pragma unroll 4
    for (int i = 0; i < 16; ++i) {
        const int k = ty + 4 * i; float v = valid ? W[(size_t)(k0 + k) * ldw + n] : 0.f;
        if (rowscale) v *= rowscale[k0 + k];
        tile[k * 65 + tx] = v;
    }
    __syncthreads();
    const int r = tid >> 2, kc = (tid & 3) * 16;
    u32x4 o0, o1;
    o0.x = pk2(tile[(kc + 0) * 65 + r], tile[(kc + 1) * 65 + r]); o0.y = pk2(tile[(kc + 2) * 65 + r], tile[(kc + 3) * 65 + r]);
    o0.z = pk2(tile[(kc + 4) * 65 + r], tile[(kc + 5) * 65 + r]); o0.w = pk2(tile[(kc + 6) * 65 + r], tile[(kc + 7) * 65 + r]);
    o1.x = pk2(tile[(kc + 8) * 65 + r], tile[(kc + 9) * 65 + r]); o1.y = pk2(tile[(kc + 10) * 65 + r], tile[(kc + 11) * 65 + r]);
    o1.z = pk2(tile[(kc + 12) * 65 + r], tile[(kc + 13) * 65 + r]); o1.w = pk2(tile[(kc + 14) * 65 + r], tile[(kc + 15) * 65 + r]);
    bf16_t* dst = Wt + (size_t)(n0 + r) * K + k0 + kc;
    *(u32x4*)dst = o0; *(u32x4*)(dst + 8) = o1;
    __syncthreads();
}

__device__ void phase0(const Params& p, unsigned char* smem) {
    const int tid = threadIdx.x;
    float* tile = (float*)smem;
    constexpr int I_IN = 16 * 134, I_PA = 8 * 16, I_PB = 4 * 16, I_PC = 8 * 16, I_OUT = 16 * 16, I_L = I_IN + I_PA + I_PB + I_PC + I_OUT;
    constexpr int I_T = 2 * I_L, I_MOD = 192, I_ALL = I_T + I_MOD + 1;
    for (int item = blockIdx.x; item < I_ALL; item += gridDim.x) {
        if (item < I_T) {
            const int l = item / I_L; int r = item % I_L;
            if (r < I_IN) { const int kt = r / 134, nt = r % 134;
                p0_transpose(p.w_in + (size_t)l * 1024 * 8464, 8464, 1024, (bf16_t*)(p.ws + WS_WIN) + (size_t)l * NP * 1024, kt * 64, nt * 64, 1, nullptr, tile); continue; }
            r -= I_IN;
            if (r < I_PA) { const int kt = r / 16, nt = r % 16;
                p0_transpose(p.w_proj_a + (size_t)l * 512 * 1024, 1024, 512, (bf16_t*)(p.ws + WS_WPA) + (size_t)l * 1024 * 512, kt * 64, nt * 64, 0, nullptr, tile); continue; }
            r -= I_PA;
            if (r < I_PB) { const int kt = r / 16, nt = r % 16;
                p0_transpose(p.w_proj_b + (size_t)l * 256 * 1024, 1024, 256, (bf16_t*)(p.ws + WS_WPB) + (size_t)l * 1024 * 256, kt * 64, nt * 64, 0, nullptr, tile); continue; }
            r -= I_PB;
            if (r < I_PC) { const int kt = r / 16, nt = r % 16;
                p0_transpose(p.w_proj_c + (size_t)l * 512 * 1024, 1024, 512, (bf16_t*)(p.ws + WS_WPC) + (size_t)l * 1024 * 512, kt * 64, nt * 64, 0, p.ssm_norm_w + l * 512, tile); continue; }
            r -= I_PC;
            { const int kt = r / 16, nt = r % 16;
                p0_transpose(p.w_out + (size_t)l * 1024 * 1024, 1024, 1024, (bf16_t*)(p.ws + WS_WOUT) + (size_t)l * 1024 * 1024, kt * 64, nt * 64, 0, nullptr, tile); }
        } else if (item < I_T + I_MOD) {
            const int it = item - I_T, l = it / 96, col0 = (it % 96) * 32, cl = tid & 31, ks = tid >> 5;
            float a0 = 0.f, a1 = 0.f, a2 = 0.f, a3 = 0.f;
            const float* wp = p.w_ada + ((size_t)l * 1024 + ks * 128) * 3072 + col0 + cl;
#pragma unroll 8
            for (int k = 0; k < 128; ++k) {
                const float wv = wp[(size_t)k * 3072]; const int kk = ks * 128 + k;
                a0 += siluf(p.c[kk]) * wv; a1 += siluf(p.c[1024 + kk]) * wv; a2 += siluf(p.c[2048 + kk]) * wv; a3 += siluf(p.c[3072 + kk]) * wv;
            }
            float* red = (float*)smem;
            red[(ks * 32 + cl) * 4 + 0] = a0; red[(ks * 32 + cl) * 4 + 1] = a1; red[(ks * 32 + cl) * 4 + 2] = a2; red[(ks * 32 + cl) * 4 + 3] = a3;
            __syncthreads();
            if (tid < 128) { const int b = tid >> 5, c2 = tid & 31; float s = 0.f;
#pragma unroll
                for (int k = 0; k < 8; ++k) s += red[(k * 32 + c2) * 4 + b];
                ((float*)(p.ws + WS_MOD))[(l * 4 + b) * 3072 + col0 + c2] = s + p.b_ada[l * 3072 + col0 + c2]; }
            __syncthreads();
        } else {
            float* rc = (float*)(p.ws + WS_ROPE); float* rs = rc + 128 * 16;
            for (int e = tid; e < 2048; e += 256) {
                const int pos = e >> 4, i = e & 15;
                const float freq = powf(10000.0f, -(float)i / 16.0f);
                const float ang = (float)pos * freq;
                const double rev = (double)ang * 0.15915494309189535; const double fr = rev - rint(rev);
                const float a = (float)(fr * 6.283185307179586);
                rc[e] = cosf(a); rs[e] = sinf(a);
            }
            if (tid < 2) {
                const int l = tid; float mqa = 0.f, mka = 0.f, mqb = 0.f, mkb = 0.f, mb = 0.f;
                for (int i = 0; i < 64; ++i) { mqa = fmaxf(mqa, fabsf(p.q_norm_a[l * 64 + i])); mka = fmaxf(mka, fabsf(p.k_norm_a[l * 64 + i]));
                    mqb = fmaxf(mqb, fabsf(p.q_norm_b[l * 64 + i])); mkb = fmaxf(mkb, fabsf(p.k_norm_b[l * 64 + i])); }
                for (int i = 0; i < 32 * 12; ++i) mb = fmaxf(mb, p.rel_bias[i]);
                float* bd = (float*)(p.ws + WS_BND);
                bd[l] = 8.f * mqa * mka * LOG2E; bd[2 + l] = (8.f * mqb * mkb + mb) * LOG2E;
            }
        }
    }
}

__device__ void norm_phase(const Params& p, int l, int hb, const float* xsrc) {
    const int lane = threadIdx.x & 63, gw = blockIdx.x * 4 + (threadIdx.x >> 6), nw = gridDim.x * 4;
    bf16_t* H = (bf16_t*)(p.ws + WS_H);
    const float* nwp = p.norm_w + l * 1024;
    for (int row = gw; row < TP; row += nw) {
        const size_t rg = (size_t)hb * TP + row; const int b = (int)(rg / SEQ);
        const f32x4* xr = (const f32x4*)(xsrc + rg * 1024);
        const float* md = (const float*)(p.ws + WS_MOD) + (size_t)(l * 4 + b) * 3072;
        f32x4 v[4]; float ss = 0.f;
#pragma unroll
        for (int j = 0; j < 4; ++j) { v[j] = xr[lane + 64 * j]; ss += v[j].x * v[j].x + v[j].y * v[j].y + v[j].z * v[j].z + v[j].w * v[j].w; }
        ss = wave_sum(ss); const float rstd = rsqrtf(ss * (1.f / 1024.f) + EPS);
#pragma unroll
        for (int j = 0; j < 4; ++j) {
            const int col = 4 * (lane + 64 * j);
            const f32x4 w4 = *(const f32x4*)(nwp + col), sh = *(const f32x4*)(md + col), sc = *(const f32x4*)(md + 1024 + col);
            const f32x4 o = v[j] * rstd * w4 * (1.f + sc) + sh;
            u32x2 pk; pk.x = pk2(o.x, o.y); pk.y = pk2(o.z, o.w);
            *(u32x2*)(H + (size_t)row * 1024 + col) = pk;
        }
    }
}

constexpr int G_STAGE = 32768, G_AB = 16384;
__device__ __forceinline__ void gemm_core(const bf16_t* __restrict__ A, int lda, const bf16_t* __restrict__ Bt, int ldb, int K, f32x4 (&acc)[4][4], unsigned char* smem, int tid) {
    asm volatile("" : "+v"(tid));
    const int lane = tid & 63, w = __builtin_amdgcn_readfirstlane(tid >> 6), wm = w >> 1, wn = w & 1, idx = lane & 15, kq = lane >> 4;
    unsigned offA[4], offB[4];
#pragma unroll
    for (int j = 0; j < 4; ++j) { const int row = (j * 4 + w) * 8 + (lane >> 3), c = (lane & 7) ^ ((row >> 1) & 7);
        offA[j] = (unsigned)(row * lda + c * 8) * 2u; offB[j] = (unsigned)(row * ldb + c * 8) * 2u; }
#pragma unroll
    for (int mi = 0; mi < 4; ++mi)
#pragma unroll
        for (int ni = 0; ni < 4; ++ni) acc[mi][ni] = (f32x4){0.f, 0.f, 0.f, 0.f};
    LDSAS unsigned char* lds = (LDSAS unsigned char*)smem;
#define G_ISSUE(kt, st) do { _Pragma("unroll") for (int j = 0; j < 4; ++j) { \
        __builtin_amdgcn_global_load_lds((const unsigned*)((const char*)A + offA[j] + (kt) * 128), (LDSAS unsigned*)(lds + (st) * G_STAGE + (j * 4 + w) * 1024), 16, 0, 0); \
        __builtin_amdgcn_global_load_lds((const unsigned*)((const char*)Bt + offB[j] + (kt) * 128), (LDSAS unsigned*)(lds + (st) * G_STAGE + G_AB + (j * 4 + w) * 1024), 16, 0, 0); } } while (0)
    const int nk = K >> 6;
    G_ISSUE(0, 0);
    asm volatile("s_waitcnt vmcnt(0)" ::: "memory");
    __syncthreads();
    const int swz = (idx >> 1) & 7;
    const int aoff = (wm * 64 + idx) * 128, boff = G_AB + (wn * 64 + idx) * 128;
    for (int kt = 0; kt < nk; ++kt) {
        const int st = kt & 1;
        if (kt + 1 < nk) G_ISSUE(kt + 1, st ^ 1);
        const unsigned char* sb = smem + st * G_STAGE;
#pragma unroll
        for (int ks = 0; ks < 2; ++ks) {
            bf16x8 af[4], bfr[4];
            const int co = ((ks * 4 + kq) ^ swz) * 16;
#pragma unroll
            for (int mi = 0; mi < 4; ++mi) af[mi] = *(const bf16x8*)(sb + aoff + mi * 2048 + co);
#pragma unroll
            for (int ni = 0; ni < 4; ++ni) bfr[ni] = *(const bf16x8*)(sb + boff + ni * 2048 + co);
#pragma unroll
            for (int mi = 0; mi < 4; ++mi)
#pragma unroll
                for (int ni = 0; ni < 4; ++ni) acc[mi][ni] = __builtin_amdgcn_mfma_f32_16x16x32_bf16(bfr[ni], af[mi], acc[mi][ni], 0, 0, 0);
        }
        asm volatile("s_waitcnt vmcnt(0)" ::: "memory");
        __syncthreads();
    }
#undef G_ISSUE
}

__device__ __forceinline__ void st4bf(bf16_t* dst, f32x4 v) { u32x2 pk; pk.x = pk2(v.x, v.y); pk.y = pk2(v.z, v.w); *(u32x2*)dst = pk; }

__device__ void gemm1_phase(const Params& p, int l, int hb, unsigned char* smem) {
    const bf16_t* H = (const bf16_t*)(p.ws + WS_H);
    const bf16_t* Wt = (const bf16_t*)(p.ws + WS_WIN) + (size_t)l * NP * 1024;
    const float* ropec = (const float*)(p.ws + WS_ROPE); const float* ropes = ropec + 2048;
    constexpr int NT = 67, NTILES = 128 * NT, GRP = 8 * NT;
    for (int t = blockIdx.x; t < NTILES; t += gridDim.x) {
        const int grp = t / GRP, r = t % GRP, mt = grp * 8 + (r & 7), nt = r >> 3;
        const int m0 = mt * 128, n0 = nt * 128;
        f32x4 acc[4][4];
        int tid = threadIdx.x;
        gemm_core(H + (size_t)m0 * 1024, 1024, Wt + (size_t)n0 * 1024, 1024, 1024, acc, smem, tid);
        asm volatile("" : "+v"(tid));
        const int lane = tid & 63, w = tid >> 6, wm = w >> 1, wn = w & 1, idx = lane & 15, kq = lane >> 4;
        const int cw = n0 + wn * 64;
        const int lc = 4 * kq;
        if (cw < 768 && (cw < 640)) {
            const bool isq = cw < 512;
            const float* nwp = (isq ? p.q_norm_a : p.k_norm_a) + l * 64;
            bf16_t* dst = isq ? (bf16_t*)(p.ws + WS_QA) : (bf16_t*)(p.ws + WS_KA);
            const int pitch = isq ? 512 : 128, c0 = isq ? cw : cw - 512;
            const float qs = isq ? 0.125f * LOG2E : 1.f;
#pragma unroll
            for (int mi = 0; mi < 4; ++mi) {
                const int row = m0 + wm * 64 + mi * 16 + idx;
                float ss = 0.f;
#pragma unroll
                for (int ni = 0; ni < 4; ++ni) { const f32x4 v = acc[mi][ni]; ss += v.x * v.x + v.y * v.y + v.z * v.z + v.w * v.w; }
                ss += __shfl_xor(ss, 16); ss += __shfl_xor(ss, 32);
                const float rstd = rsqrtf(ss * (1.f / 64.f) + EPS);
                f32x4 y[4];
#pragma unroll
                for (int ni = 0; ni < 4; ++ni) y[ni] = acc[mi][ni] * rstd * *(const f32x4*)(nwp + ni * 16 + lc);
                const int tt = row & (SEQ - 1), prow = tt >> 6, pcol = tt & 63;
#pragma unroll
                for (int hf = 0; hf < 2; ++hf) {
                    const int pos = hf ? pcol : prow;
                    const f32x4 cs = *(const f32x4*)(ropec + pos * 16 + lc), sn = *(const f32x4*)(ropes + pos * 16 + lc);
                    const f32x4 a = y[2 * hf], b = y[2 * hf + 1];
                    y[2 * hf] = a * cs - b * sn; y[2 * hf + 1] = b * cs + a * sn;
                }
#pragma unroll
                for (int ni = 0; ni < 4; ++ni) st4bf(dst + (size_t)row * pitch + c0 + ni * 16 + lc, y[ni] * qs);
            }
        } else if (cw >= 1280 && cw < 2816) {
            const bool isq = cw < 2048;
            const float* nwp = (isq ? p.q_norm_b : p.k_norm_b) + l * 64;
            const int gc = isq ? cw - 1280 : cw - 2048, g = gc >> 8, c0 = gc & 255;
            const int sh = 2 * g;
            bf16_t* dst = (bf16_t*)(p.ws + (isq ? WS_QB : WS_KB));
            const float qs = isq ? 0.125f * LOG2E : 1.f;
#pragma unroll
            for (int mi = 0; mi < 4; ++mi) {
                const int row = m0 + wm * 64 + mi * 16 + idx;
                float ss = 0.f;
#pragma unroll
                for (int ni = 0; ni < 4; ++ni) { const f32x4 v = acc[mi][ni]; ss += v.x * v.x + v.y * v.y + v.z * v.z + v.w * v.w; }
                ss += __shfl_xor(ss, 16); ss += __shfl_xor(ss, 32);
                const float rstd = rsqrtf(ss * (1.f / 64.f) + EPS) * qs;
                const int bl = row >> 13, tt = row & (SEQ - 1);
                const int pp = (tt & ((1 << sh) - 1)) * (SEQ >> sh) + (tt >> sh);
                bf16_t* drow = dst + ((size_t)(bl * 3 + g) * SEQ + pp) * 256 + c0 + lc;
#pragma unroll
                for (int ni = 0; ni < 4; ++ni) st4bf(drow + ni * 16, acc[mi][ni] * rstd * *(const f32x4*)(nwp + ni * 16 + lc));
            }
        } else if (cw >= 2816 && cw < 3584) {
            const int gc = cw - 2816, g = gc >> 8, c0 = gc & 255, sh = 2 * g;
            bf16_t* dst = (bf16_t*)(p.ws + WS_VB);
#pragma unroll
            for (int mi = 0; mi < 4; ++mi) {
                const int row = m0 + wm * 64 + mi * 16 + idx;
                const int bl = row >> 13, tt = row & (SEQ - 1);
                const int pp = (tt & ((1 << sh) - 1)) * (SEQ >> sh) + (tt >> sh);
                bf16_t* drow = dst + ((size_t)(bl * 3 + g) * SEQ + pp) * 256 + c0 + lc;
#pragma unroll
                for (int ni = 0; ni < 4; ++ni) st4bf(drow + ni * 16, acc[mi][ni]);
            }
        } else if (cw >= 8448) {
            if (wn == 0) {
                float* dst = (float*)(p.ws + WS_DT);
                const f32x4 bias = *(const f32x4*)(p.dt_bias + l * 16 + lc);
#pragma unroll
                for (int mi = 0; mi < 4; ++mi) {
                    const int row = m0 + wm * 64 + mi * 16 + idx;
                    f32x4 v = acc[mi][0] + bias, o;
                    o.x = v.x > 20.f ? v.x : log1pf(__expf(v.x)); o.y = v.y > 20.f ? v.y : log1pf(__expf(v.y));
                    o.z = v.z > 20.f ? v.z : log1pf(__expf(v.z)); o.w = v.w > 20.f ? v.w : log1pf(__expf(v.w));
                    *(f32x4*)(dst + (size_t)row * 16 + lc) = o;
                }
            }
        } else {
            bf16_t* dst; int pitch, c0, mode;
            if (cw < 768) { dst = (bf16_t*)(p.ws + WS_VA); pitch = 128; c0 = cw - 640; mode = 0; }
            else if (cw < 1280) { dst = (bf16_t*)(p.ws + WS_GA); pitch = 512; c0 = cw - 768; mode = 1; }
            else if (cw < 3840) { dst = (bf16_t*)(p.ws + WS_GB); pitch = 256; c0 = cw - 3584; mode = 1; }
            else if (cw < 4864) { dst = (bf16_t*)(p.ws + WS_XBC); pitch = 1024; c0 = cw - 3840; mode = 0; }
            else if (cw < 5376) { dst = (bf16_t*)(p.ws + WS_ZS); pitch = 512; c0 = cw - 4864; mode = 1; }
            else { dst = (bf16_t*)(p.ws + WS_MG); pitch = 3072; c0 = cw - 5376; mode = 2; }
            const float* bg = p.b_gate + l * 3072 + c0 + lc;
#pragma unroll
            for (int mi = 0; mi < 4; ++mi) {
                const int row = m0 + wm * 64 + mi * 16 + idx;
#pragma unroll
                for (int ni = 0; ni < 4; ++ni) {
                    f32x4 v = acc[mi][ni];
                    if (mode == 1) { v.x = siluf(v.x); v.y = siluf(v.y); v.z = siluf(v.z); v.w = siluf(v.w); }
                    else if (mode == 2) { const f32x4 bb = *(const f32x4*)(bg + ni * 16); v.x = sigmf(v.x + bb.x); v.y = sigmf(v.y + bb.y); v.z = sigmf(v.z + bb.z); v.w = sigmf(v.w + bb.w); }
                    st4bf(dst + (size_t)row * pitch + c0 + ni * 16 + lc, v);
                }
            }
        }
    }
}

__device__ void merge_phase(const Params& p, int l, unsigned char* smem) {
    const bf16_t* MG = (const bf16_t*)(p.ws + WS_MG);
    const float* rstd = (const float*)(p.ws + WS_RSTD);
    bf16_t* MR = (bf16_t*)(p.ws + WS_MRG);
    for (int t = blockIdx.x; t < 128 * 8; t += gridDim.x) {
        const int mt = t >> 3, nt = t & 7, m0 = mt * 128, n0 = nt * 128;
#pragma unroll 1
        for (int br = 0; br < 3; ++br) {
            f32x4 acc[4][4];
            const bf16_t* A; const bf16_t* Bt; int K;
            if (br == 0) { A = (const bf16_t*)(p.ws + WS_QA); K = 512; Bt = (const bf16_t*)(p.ws + WS_WPA) + (size_t)l * 1024 * 512; }
            else if (br == 1) { A = (const bf16_t*)(p.ws + WS_YBM); K = 256; Bt = (const bf16_t*)(p.ws + WS_WPB) + (size_t)l * 1024 * 256; }
            else { A = (const bf16_t*)(p.ws + WS_YC); K = 512; Bt = (const bf16_t*)(p.ws + WS_WPC) + (size_t)l * 1024 * 512; }
            int tid = threadIdx.x;
            gemm_core(A + (size_t)m0 * K, K, Bt + (size_t)n0 * K, K, K, acc, smem, tid);
            asm volatile("" : "+v"(tid));
            const int lane = tid & 63, w = tid >> 6, wm = w >> 1, wn = w & 1, idx = lane & 15, kq = lane >> 4;
#pragma unroll
            for (int mi = 0; mi < 4; ++mi) {
                const int row = m0 + wm * 64 + mi * 16 + idx;
                const float rs = (br == 2) ? rstd[row] : 1.f;
#pragma unroll
                for (int ni = 0; ni < 4; ++ni) {
                    const int col = n0 + wn * 64 + ni * 16 + 4 * kq;
                    const u32x2 g = *(const u32x2*)(MG + (size_t)row * 3072 + br * 1024 + col);
                    f32x4 gv; gv.x = bflo(g.x); gv.y = bfhi(g.x); gv.z = bflo(g.y); gv.w = bfhi(g.y);
                    f32x4 v = gv * rs * acc[mi][ni];
                    bf16_t* mp = MR + (size_t)row * 1024 + col;
                    if (br > 0) { const u32x2 o = *(const u32x2*)mp; v.x += bflo(o.x); v.y += bfhi(o.x); v.z += bflo(o.y); v.w += bfhi(o.y); }
                    st4bf(mp, v);
                }
            }
        }
    }
}

__device__ void out_phase(const Params& p, int l, int hb, const float* xsrc, unsigned char* smem) {
    const bf16_t* MR = (const bf16_t*)(p.ws + WS_MRG);
    const bf16_t* Wt = (const bf16_t*)(p.ws + WS_WOUT) + (size_t)l * 1024 * 1024;
    for (int t = blockIdx.x; t < 128 * 8; t += gridDim.x) {
        const int mt = t >> 3, nt = t & 7, m0 = mt * 128, n0 = nt * 128;
        f32x4 acc[4][4];
        int tid = threadIdx.x;
        gemm_core(MR + (size_t)m0 * 1024, 1024, Wt + (size_t)n0 * 1024, 1024, 1024, acc, smem, tid);
        asm volatile("" : "+v"(tid));
        const int lane = tid & 63, w = tid >> 6, wm = w >> 1, wn = w & 1, idx = lane & 15, kq = lane >> 4;
#pragma unroll
        for (int mi = 0; mi < 4; ++mi) {
            const int row = m0 + wm * 64 + mi * 16 + idx; const size_t rg = (size_t)hb * TP + row; const int b = (int)(rg / SEQ);
            const float* gate = (const float*)(p.ws + WS_MOD) + (size_t)(l * 4 + b) * 3072 + 2048;
#pragma unroll
            for (int ni = 0; ni < 4; ++ni) {
                const int col = n0 + wn * 64 + ni * 16 + 4 * kq;
                const f32x4 xv = *(const f32x4*)(xsrc + rg * 1024 + col), gv = *(const f32x4*)(gate + col);
                *(f32x4*)(p.out + rg * 1024 + col) = xv + gv * acc[mi][ni];
            }
        }
    }
}

constexpr int AT_KS = 0, AT_VS = 9216, AT_LQ = 9216 + 8192, AT_LUT = AT_LQ + 512;

#define AT_STAGE_STORE() do { _Pragma("unroll") for (int i = 0; i < 2; ++i) { const int c = tid + 256 * i, row = c >> 3, ch = c & 7; \
        *(u32x4*)(Ks + row * 72 + ch * 8) = rk[i]; *(u32x4*)(Vs + (ch >> 2) * 4096 + row * 64 + (ch & 3) * 16) = rv[i]; } } while (0)

__device__ __forceinline__ void at_qk(f32x16& p0, f32x16& p1, const bf16_t* Ks, const bf16x8* qr, int r32, int hi) {
#pragma unroll
    for (int ds = 0; ds < 4; ++ds) {
        const bf16x8 k0 = *(const bf16x8*)(Ks + r32 * 72 + ds * 16 + hi * 8);
        const bf16x8 k1 = *(const bf16x8*)(Ks + (r32 + 32) * 72 + ds * 16 + hi * 8);
        p0 = __builtin_amdgcn_mfma_f32_32x32x16_bf16(k0, qr[ds], p0, 0, 0, 0);
        p1 = __builtin_amdgcn_mfma_f32_32x32x16_bf16(k1, qr[ds], p1, 0, 0, 0);
    }
}
__device__ __forceinline__ void at_pv(f32x16& o0, f32x16& o1, const f32x16& p0, const f32x16& p1, const unsigned char* Vs, int lane) {
    const int hi = lane >> 5;
    const unsigned char* vb = Vs + ((lane >> 4) & 1) * 32 + (lane & 3) * 8 + (4 * hi + ((lane & 15) >> 2)) * 64;
#pragma unroll
    for (int s = 0; s < 4; ++s) {
        u32x4 pw;
        if (s < 2) { pw.x = pk2(p0[8 * s + 0], p0[8 * s + 1]); pw.y = pk2(p0[8 * s + 2], p0[8 * s + 3]); pw.z = pk2(p0[8 * s + 4], p0[8 * s + 5]); pw.w = pk2(p0[8 * s + 6], p0[8 * s + 7]); }
        else { const int q = s - 2; pw.x = pk2(p1[8 * q + 0], p1[8 * q + 1]); pw.y = pk2(p1[8 * q + 2], p1[8 * q + 3]); pw.z = pk2(p1[8 * q + 4], p1[8 * q + 5]); pw.w = pk2(p1[8 * q + 6], p1[8 * q + 7]); }
        const bf16x8 pa = __builtin_bit_cast(bf16x8, pw);
        const bf16x8 v0 = cat8(tr16(vb + s * 1024), tr16(vb + s * 1024 + 512));
        const bf16x8 v1 = cat8(tr16(vb + 4096 + s * 1024), tr16(vb + 4096 + s * 1024 + 512));
        o0 = __builtin_amdgcn_mfma_f32_32x32x16_bf16(pa, v0, o0, 0, 0, 0);
        o1 = __builtin_amdgcn_mfma_f32_32x32x16_bf16(pa, v1, o1, 0, 0, 0);
    }
}

__device__ void attn_a_item(const Params& p, int item, int l, unsigned char* smem) {
    int tid_ = threadIdx.x; asm volatile("" : "+v"(tid_));
    const int tid = tid_, lane = tid & 63, w = tid >> 6, r32 = lane & 31, hi = lane >> 5;
    const int b = item >> 9, r = item & 511, kvh = r >> 8, qblk = (r >> 2) & 63, hq = kvh * 4 + (r & 3);
    bf16_t* Ks = (bf16_t*)(smem + AT_KS); unsigned char* Vs = smem + AT_VS; float* lq = (float*)(smem + AT_LQ) + w * 32;
    bf16_t* QA = (bf16_t*)(p.ws + WS_QA);
    const bf16_t* GA = (const bf16_t*)(p.ws + WS_GA);
    const size_t tokq = (size_t)b * SEQ + qblk * 128 + w * 32;
    bf16x8 qr[4];
#pragma unroll
    for (int ds = 0; ds < 4; ++ds) qr[ds] = *(const bf16x8*)(QA + (tokq + r32) * 512 + hq * 64 + ds * 16 + hi * 8);
    const bf16_t* Kb = (const bf16_t*)(p.ws + WS_KA) + (size_t)b * SEQ * 128 + kvh * 64;
    const bf16_t* Vb = (const bf16_t*)(p.ws + WS_VA) + (size_t)b * SEQ * 128 + kvh * 64;
    const float nshift = -((const float*)(p.ws + WS_BND))[l];
    f32x16 o0, o1;
#pragma unroll
    for (int i = 0; i < 16; ++i) { o0[i] = 0.f; o1[i] = 0.f; }
    float lacc = 0.f;
    u32x4 rk[2], rv[2];
#pragma unroll
    for (int i = 0; i < 2; ++i) { const int c = tid + 256 * i, row = c >> 3, ch = c & 7;
        rk[i] = *(const u32x4*)(Kb + (size_t)row * 128 + ch * 8); rv[i] = *(const u32x4*)(Vb + (size_t)row * 128 + ch * 8); }
    for (int kt = 0; kt < SEQ / 64; ++kt) {
        __syncthreads();
        AT_STAGE_STORE();
        __syncthreads();
        if (kt + 1 < SEQ / 64) {
#pragma unroll
            for (int i = 0; i < 2; ++i) { const int c = tid + 256 * i, row = c >> 3, ch = c & 7;
                rk[i] = *(const u32x4*)(Kb + (size_t)((kt + 1) * 64 + row) * 128 + ch * 8); rv[i] = *(const u32x4*)(Vb + (size_t)((kt + 1) * 64 + row) * 128 + ch * 8); }
        }
        f32x16 p0, p1;
#pragma unroll
        for (int i = 0; i < 16; ++i) { p0[i] = nshift; p1[i] = nshift; }
        at_qk(p0, p1, Ks, qr, r32, hi);
#pragma unroll
        for (int i = 0; i < 16; ++i) { p0[i] = __builtin_amdgcn_exp2f(p0[i]); p1[i] = __builtin_amdgcn_exp2f(p1[i]); lacc += p0[i] + p1[i]; }
        at_pv(o0, o1, p0, p1, Vs, lane);
    }
    lacc += __shfl_xor(lacc, 32);
    if (hi == 0) lq[r32] = lacc;
    asm volatile("s_waitcnt lgkmcnt(0)" ::: "memory");
#pragma unroll
    for (int rr = 0; rr < 16; ++rr) {
        const int q = crow(rr, hi); const float inv = 1.f / lq[q];
        const size_t off = (tokq + q) * 512 + hq * 64 + r32;
        const float g0 = bf2f(GA[off]), g1 = bf2f(GA[off + 32]);
        QA[off] = (bf16_t)(pk2(o0[rr] * inv * g0, 0.f) & 0xffffu);
        QA[off + 32] = (bf16_t)(pk2(o1[rr] * inv * g1, 0.f) & 0xffffu);
    }
}

__device__ void attn_b_item(const Params& p, int item, int l, unsigned char* smem) {
    int tid_ = threadIdx.x; asm volatile("" : "+v"(tid_));
    const int tid = tid_, lane = tid & 63, w = tid >> 6, r32 = lane & 31, hi = lane >> 5;
    const int blk = item & 63, j = (item >> 6) & 3, bg = item >> 8, g = bg % 3, b = bg / 3;
    const int sh = 2 * g, dil = 1 << sh, Mlen = SEQ >> sh;
    bf16_t* Ks = (bf16_t*)(smem + AT_KS); unsigned char* Vs = smem + AT_VS; float* lq = (float*)(smem + AT_LQ) + w * 32; float* lut = (float*)(smem + AT_LUT);
    bf16_t* QB = (bf16_t*)(p.ws + WS_QB) + (size_t)bg * SEQ * 256 + j * 64;
    const bf16_t* KB = (const bf16_t*)(p.ws + WS_KB) + (size_t)bg * SEQ * 256 + j * 64;
    const bf16_t* VB = (const bf16_t*)(p.ws + WS_VB) + (size_t)bg * SEQ * 256 + j * 64;
    float* LSE = (float*)(p.ws + WS_LSE) + (size_t)bg * SEQ * 4 + j;
    const int p0r = blk * 128, seq_lo = (p0r / Mlen) * Mlen, seq_hi = seq_lo + Mlen;
    __syncthreads();
    if (tid < 129) {
        const int rel = tid - 64, n = (rel < 0 ? -rel : rel) * dil;
        int bk;
        if (n < 8) bk = n; else { bk = 8 + (n >= 15) + (n >= 27) + (n >= 50) + (n >= 91) + (n >= 166) + (n >= 305) + (n >= 559); }
        if (rel > 0) bk += 16;
        lut[tid] = p.rel_bias[bk * 12 + g * 4 + j] * LOG2E;
    }
    const int qpos = p0r + w * 32 + r32;
    bf16x8 qr[4];
#pragma unroll
    for (int ds = 0; ds < 4; ++ds) qr[ds] = *(const bf16x8*)(QB + (size_t)qpos * 256 + ds * 16 + hi * 8);
    const float nshift = -((const float*)(p.ws + WS_BND))[2 + l];
    f32x16 o0, o1;
#pragma unroll
    for (int i = 0; i < 16; ++i) { o0[i] = 0.f; o1[i] = 0.f; }
    float lacc = 0.f;
    u32x4 rk[2], rv[2];
    for (int kt = 0; kt < 4; ++kt) {
        const int kbase = p0r - 64 + 64 * kt;
#pragma unroll
        for (int i = 0; i < 2; ++i) { const int c = tid + 256 * i, row = c >> 3, ch = c & 7;
            int pr = kbase + row; pr = pr < 0 ? 0 : (pr > SEQ - 1 ? SEQ - 1 : pr);
            rk[i] = *(const u32x4*)(KB + (size_t)pr * 256 + ch * 8); rv[i] = *(const u32x4*)(VB + (size_t)pr * 256 + ch * 8); }
        __syncthreads();
        AT_STAGE_STORE();
        __syncthreads();
        f32x16 p0, p1;
#pragma unroll
        for (int i = 0; i < 16; ++i) { p0[i] = nshift; p1[i] = nshift; }
        at_qk(p0, p1, Ks, qr, r32, hi);
#pragma unroll
        for (int i = 0; i < 16; ++i) {
            const int kv0 = kbase + crow(i, hi), kv1 = kv0 + 32;
            const int rel0 = kv0 - qpos, rel1 = kv1 - qpos;
            const bool ok0 = rel0 >= -64 && rel0 <= 64 && kv0 >= seq_lo && kv0 < seq_hi;
            const bool ok1 = rel1 >= -64 && rel1 <= 64 && kv1 >= seq_lo && kv1 < seq_hi;
            const float e0 = __builtin_amdgcn_exp2f(p0[i] + lut[ok0 ? rel0 + 64 : 64]);
            const float e1 = __builtin_amdgcn_exp2f(p1[i] + lut[ok1 ? rel1 + 64 : 64]);
            p0[i] = ok0 ? e0 : 0.f; p1[i] = ok1 ? e1 : 0.f; lacc += p0[i] + p1[i];
        }
        at_pv(o0, o1, p0, p1, Vs, lane);
    }
    lacc += __shfl_xor(lacc, 32);
    if (hi == 0) { lq[r32] = lacc; LSE[(size_t)qpos * 4] = (-nshift + log2f(lacc)) * LN2; }
    asm volatile("s_waitcnt lgkmcnt(0)" ::: "memory");
#pragma unroll
    for (int rr = 0; rr < 16; ++rr) {
        const int q = crow(rr, hi); const float inv = 1.f / lq[q];
        const size_t off = (size_t)(p0r + w * 32 + q) * 256 + r32;
        QB[off] = (bf16_t)(pk2(o0[rr] * inv, 0.f) & 0xffffu);
        QB[off + 32] = (bf16_t)(pk2(o1[rr] * inv, 0.f) & 0xffffu);
    }
}

constexpr int SS_BS = 0, SS_CS = 8704, SS_XS = 17408, SS_XWS = 22016, SS_GS = 26624, SS_SB = 29184, SS_CW = 46592, SS_SC = 54272, SS_END = 55296;

template <int PASS>
__device__ void ssd_item(const Params& p, int item, int l, unsigned char* smem) {
    int tid_ = threadIdx.x; asm volatile("" : "+v"(tid_));
    const int tid = tid_, lane = tid & 63, w = tid >> 6, idx = lane & 15, kq = lane >> 4;
    const int seg = item & 15, h = (item >> 4) & 7, dir = (item >> 7) & 1, b = item >> 8, grp = h >> 2;
    bf16_t* Bs = (bf16_t*)(smem + SS_BS); bf16_t* Cs = (bf16_t*)(smem + SS_CS); bf16_t* Xs = (bf16_t*)(smem + SS_XS); bf16_t* Xws = (bf16_t*)(smem + SS_XWS);
    bf16_t* Gs = (bf16_t*)(smem + SS_GS); bf16_t* Sb = (bf16_t*)(smem + SS_SB); float* cwl = (float*)(smem + SS_CW); float* sc = (float*)(smem + SS_SC);
    float* s_dt = sc, *s_c = sc + 32, *s_rs = sc + 64, *s_wl = sc + 96, *s_tot = sc + 128;
    const bf16_t* XBC = (const bf16_t*)(p.ws + WS_XBC);
    const float* DT = (const float*)(p.ws + WS_DT);
    float* ST = (float*)(p.ws + WS_ST); float* SEGT = (float*)(p.ws + WS_SEGT);
    bf16_t* Y = (bf16_t*)(p.ws + (dir ? WS_YS : WS_YF));
    const float Aneg = -__expf(p.a_log[l * 16 + dir * 8 + h]);
    const float Dh = p.d_skip[l * 8 + h];
    __syncthreads();
    for (int e = tid; e < 6 * 320; e += 256) {
        const int tap = e / 320, lc = e % 320;
        const int ch = lc < 64 ? h * 64 + lc : (lc < 192 ? 512 + grp * 128 + (lc - 64) : 768 + grp * 128 + (lc - 192));
        cwl[e] = tap < 5 ? p.conv_w[(size_t)l * 5 * 1024 + tap * 1024 + ch] : p.conv_b[l * 1024 + ch];
    }
    f32x4 S[8];
#pragma unroll
    for (int nt = 0; nt < 8; ++nt) S[nt] = (f32x4){0.f, 0.f, 0.f, 0.f};
    const int ibase = item & ~15;
    if (PASS == 3) {
        if (dir == 0) {
            for (int e = 0; e < seg; ++e) { const float dc = __expf(SEGT[ibase + e]); const f32x4* src = (const f32x4*)(ST + (size_t)(ibase + e) * 8192);
#pragma unroll
                for (int nt = 0; nt < 8; ++nt) S[nt] = S[nt] * dc + src[(w * 8 + nt) * 64 + lane]; }
        } else {
            for (int e = NSEG - 1; e > seg; --e) { const float dc = __expf(SEGT[ibase + e]); const f32x4* src = (const f32x4*)(ST + (size_t)(ibase + e) * 8192);
#pragma unroll
                for (int nt = 0; nt < 8; ++nt) S[nt] = S[nt] * dc + src[(w * 8 + nt) * 64 + lane]; }
        }
#pragma unroll
        for (int nt = 0; nt < 8; ++nt) st4bf(Sb + (16 * w + idx) * 136 + 16 * nt + 4 * kq, S[nt]);
    }
    float segtot = 0.f;
    for (int si = 0; si < NSUB; ++si) {
        const int scn = dir ? (NSUB - 1 - si) : si;
        const int t0 = seg * SEGLEN + scn * TSUB;
        const size_t tokb = (size_t)b * SEQ;
        __syncthreads();
        if (w == 0) {
            float dtv = 0.f, av = 0.f;
            if (lane < 32) { dtv = DT[(tokb + t0 + lane) * 16 + dir * 8 + h]; av = dtv * Aneg; }
            float pre = av;
#pragma unroll
            for (int o = 1; o < 32; o <<= 1) { const float t = __shfl_up(pre, o); if (lane >= o) pre += t; }
            const float tot = __shfl(pre, 31);
            const float cc = dir ? (tot - pre + av) : pre;
            if (lane < 32) { s_dt[lane] = dtv; s_c[lane] = cc; s_rs[lane] = __expf(cc); s_wl[lane] = dtv * __expf(tot - cc); }
            if (lane == 0) s_tot[0] = tot;
        }
        __syncthreads();
        segtot += s_tot[0];
#pragma unroll 1
        for (int i = 0; i < 5; ++i) {
            const int u = tid + 256 * i, lrow = u / 40, ci = u % 40, lc = ci * 8;
            const int scol = ci < 8 ? h * 64 + lc : (ci < 24 ? 512 + grp * 128 + (lc - 64) : 768 + grp * 128 + (lc - 192));
            float a[8];
#pragma unroll
            for (int e = 0; e < 8; ++e) a[e] = cwl[5 * 320 + lc + e];
#pragma unroll
            for (int tap = 0; tap < 5; ++tap) {
                const int tt = t0 + lrow + tap - 2;
                if (tt >= 0 && tt < SEQ) {
                    const u32x4 v = *(const u32x4*)(XBC + (tokb + tt) * 1024 + scol);
                    const float* wv = cwl + tap * 320 + lc;
                    a[0] += bflo(v.x) * wv[0]; a[1] += bfhi(v.x) * wv[1]; a[2] += bflo(v.y) * wv[2]; a[3] += bfhi(v.y) * wv[3];
                    a[4] += bflo(v.z) * wv[4]; a[5] += bfhi(v.z) * wv[5]; a[6] += bflo(v.w) * wv[6]; a[7] += bfhi(v.w) * wv[7];
                }
            }
#pragma unroll
            for (int e = 0; e < 8; ++e) a[e] = siluf(a[e]);
            u32x4 o; o.x = pk2(a[0], a[1]); o.y = pk2(a[2], a[3]); o.z = pk2(a[4], a[5]); o.w = pk2(a[6], a[7]);
            if (ci < 8) {
                *(u32x4*)(Xs + lrow * 72 + lc) = o;
                const float wl = s_wl[lrow];
                u32x4 o2; o2.x = pk2(a[0] * wl, a[1] * wl); o2.y = pk2(a[2] * wl, a[3] * wl); o2.z = pk2(a[4] * wl, a[5] * wl); o2.w = pk2(a[6] * wl, a[7] * wl);
                *(u32x4*)(Xws + lrow * 72 + lc) = o2;
            } else if (ci < 24) *(u32x4*)(Bs + lrow * 136 + (lc - 64)) = o;
            else *(u32x4*)(Cs + lrow * 136 + (lc - 192)) = o;
        }
        __syncthreads();
        if (PASS == 3) {
            const int it = w >> 1, jt = w & 1;
            f32x4 cb = (f32x4){0.f, 0.f, 0.f, 0.f};
#pragma unroll
            for (int ks = 0; ks < 4; ++ks) {
                const bf16x8 fb = *(const bf16x8*)(Bs + (16 * jt + idx) * 136 + ks * 32 + kq * 8);
                const bf16x8 fc = *(const bf16x8*)(Cs + (16 * it + idx) * 136 + ks * 32 + kq * 8);
                cb = __builtin_amdgcn_mfma_f32_16x16x32_bf16(fb, fc, cb, 0, 0, 0);
            }
            {
                const int ii = 16 * it + idx; const float ci_ = s_c[ii];
                f32x4 gv;
#pragma unroll
                for (int rg = 0; rg < 4; ++rg) {
                    const int jj = 16 * jt + 4 * kq + rg;
                    const bool ok = dir ? (jj >= ii) : (jj <= ii);
                    const float e = __expf(ci_ - s_c[jj]) * s_dt[jj];
                    gv[rg] = ok ? cb[rg] * e : 0.f;
                }
                st4bf(Gs + ii * 40 + 16 * jt + 4 * kq, gv);
            }
            __syncthreads();
            const unsigned char* xtr = (const unsigned char*)Xs + (8 * kq + (idx >> 2)) * 144 + (16 * w + 4 * (idx & 3)) * 2;
            const bf16x8 xf = cat8(tr16(xtr), tr16(xtr + 4 * 144));
#pragma unroll
            for (int it2 = 0; it2 < 2; ++it2) {
                const int ii = 16 * it2 + idx;
                const bf16x8 gf = *(const bf16x8*)(Gs + ii * 40 + 8 * kq);
                f32x4 yd = (f32x4){0.f, 0.f, 0.f, 0.f}, yo = (f32x4){0.f, 0.f, 0.f, 0.f};
                yd = __builtin_amdgcn_mfma_f32_16x16x32_bf16(xf, gf, yd, 0, 0, 0);
#pragma unroll
                for (int ks = 0; ks < 4; ++ks) {
                    const bf16x8 sf = *(const bf16x8*)(Sb + (16 * w + idx) * 136 + ks * 32 + kq * 8);
                    const bf16x8 cf = *(const bf16x8*)(Cs + ii * 136 + ks * 32 + kq * 8);
                    yo = __builtin_amdgcn_mfma_f32_16x16x32_bf16(sf, cf, yo, 0, 0, 0);
                }
                f32x4 y = yd + yo * s_rs[ii];
                if (dir == 0) { const u32x2 xv = *(const u32x2*)(Xs + ii * 72 + 16 * w + 4 * kq);
                    y.x += Dh * bflo(xv.x); y.y += Dh * bfhi(xv.x); y.z += Dh * bflo(xv.y); y.w += Dh * bfhi(xv.y); }
                st4bf(Y + (tokb + t0 + ii) * 512 + h * 64 + 16 * w + 4 * kq, y);
            }
        }
        {
            const float dc = __expf(s_tot[0]);
            const unsigned char* xw = (const unsigned char*)Xws + (8 * kq + (idx >> 2)) * 144 + (16 * w + 4 * (idx & 3)) * 2;
            const bf16x8 xwf = cat8(tr16(xw), tr16(xw + 4 * 144));
#pragma unroll
            for (int nt = 0; nt < 8; ++nt) {
                const unsigned char* bt = (const unsigned char*)Bs + (8 * kq + (idx >> 2)) * 272 + (16 * nt + 4 * (idx & 3)) * 2;
                const bf16x8 bf = cat8(tr16(bt), tr16(bt + 4 * 272));
                S[nt] = __builtin_amdgcn_mfma_f32_16x16x32_bf16(bf, xwf, S[nt] * dc, 0, 0, 0);
            }
            if (PASS == 3) {
#pragma unroll
                for (int nt = 0; nt < 8; ++nt) st4bf(Sb + (16 * w + idx) * 136 + 16 * nt + 4 * kq, S[nt]);
            }
        }
    }
    if (PASS == 1) {
        f32x4* dst = (f32x4*)(ST + (size_t)item * 8192);
#pragma unroll
        for (int nt = 0; nt < 8; ++nt) dst[(w * 8 + nt) * 64 + lane] = S[nt];
        if (tid == 0) SEGT[item] = segtot;
    }
}

__device__ void post2_phase(const Params& p) {
    const int lane = threadIdx.x & 63, gw = blockIdx.x * 4 + (threadIdx.x >> 6), nw = gridDim.x * 4;
    const bf16_t* OB = (const bf16_t*)(p.ws + WS_QB); const float* LSE = (const float*)(p.ws + WS_LSE);
    const bf16_t* GB = (const bf16_t*)(p.ws + WS_GB);
    bf16_t* YBM = (bf16_t*)(p.ws + WS_YBM);
    const bf16_t* YF = (const bf16_t*)(p.ws + WS_YF); const bf16_t* YS = (const bf16_t*)(p.ws + WS_YS); const bf16_t* ZS = (const bf16_t*)(p.ws + WS_ZS);
    bf16_t* YC = (bf16_t*)(p.ws + WS_YC); float* RS = (float*)(p.ws + WS_RSTD);
    for (int row = gw; row < TP; row += nw) {
        const int bl = row >> 13, tt = row & (SEQ - 1), j = lane >> 4;
        float ls[3]; size_t ro[3];
#pragma unroll
        for (int g = 0; g < 3; ++g) { const int sh = 2 * g; const int pp = (tt & ((1 << sh) - 1)) * (SEQ >> sh) + (tt >> sh);
            ro[g] = (size_t)(bl * 3 + g) * SEQ + pp; ls[g] = LSE[ro[g] * 4 + j]; }
        const float mx = fmaxf(ls[0], fmaxf(ls[1], ls[2]));
        float wg[3]; float ws = 0.f;
#pragma unroll
        for (int g = 0; g < 3; ++g) { wg[g] = __expf(ls[g] - mx); ws += wg[g]; }
        const float inv = 1.f / ws;
        f32x4 acc = (f32x4){0.f, 0.f, 0.f, 0.f};
#pragma unroll
        for (int g = 0; g < 3; ++g) { const u32x2 v = *(const u32x2*)(OB + ro[g] * 256 + 4 * lane); const float wv = wg[g] * inv;
            acc.x += wv * bflo(v.x); acc.y += wv * bfhi(v.x); acc.z += wv * bflo(v.y); acc.w += wv * bfhi(v.y); }
        { const u32x2 gt = *(const u32x2*)(GB + (size_t)row * 256 + 4 * lane);
          acc.x *= bflo(gt.x); acc.y *= bfhi(gt.x); acc.z *= bflo(gt.y); acc.w *= bfhi(gt.y); }
        st4bf(YBM + (size_t)row * 256 + 4 * lane, acc);
        const u32x4 a = *(const u32x4*)(YF + (size_t)row * 512 + 8 * lane), bq = *(const u32x4*)(YS + (size_t)row * 512 + 8 * lane), z = *(const u32x4*)(ZS + (size_t)row * 512 + 8 * lane);
        float y[8];
        y[0] = (bflo(a.x) + bflo(bq.x)) * bflo(z.x); y[1] = (bfhi(a.x) + bfhi(bq.x)) * bfhi(z.x);
        y[2] = (bflo(a.y) + bflo(bq.y)) * bflo(z.y); y[3] = (bfhi(a.y) + bfhi(bq.y)) * bfhi(z.y);
        y[4] = (bflo(a.z) + bflo(bq.z)) * bflo(z.z); y[5] = (bfhi(a.z) + bfhi(bq.z)) * bfhi(z.z);
        y[6] = (bflo(a.w) + bflo(bq.w)) * bflo(z.w); y[7] = (bfhi(a.w) + bfhi(bq.w)) * bfhi(z.w);
        float ss = 0.f;
#pragma unroll
        for (int e = 0; e < 8; ++e) ss += y[e] * y[e];
        ss = wave_sum(ss);
        u32x4 o; o.x = pk2(y[0], y[1]); o.y = pk2(y[2], y[3]); o.z = pk2(y[4], y[5]); o.w = pk2(y[6], y[7]);
        *(u32x4*)(YC + (size_t)row * 512 + 8 * lane) = o;
        if (lane == 0) RS[row] = rsqrtf(ss * (1.f / 512.f) + EPS);
    }
}

constexpr int SMEM_BYTES = 65536;
__global__ void __launch_bounds__(256, 2) hybrid_fwd(Params p) {
    cg::grid_group grid = cg::this_grid();
    __shared__ __attribute__((aligned(16))) unsigned char smem[SMEM_BYTES];
    { const Params q = launder(p); phase0(q, smem); }
    grid.sync();
#pragma unroll 1
    for (int l = 0; l < DEPTH; ++l) {
#pragma unroll 1
        for (int hb = 0; hb < 2; ++hb) {
            { const Params q = launder(p); norm_phase(q, l, hb, (l == 0) ? q.x : q.out); }
            grid.sync();
            { const Params q = launder(p); gemm1_phase(q, l, hb, smem); }
            grid.sync();
            { const Params q = launder(p);
#pragma unroll 1
              for (int it = blockIdx.x; it < 512 + 1536; it += gridDim.x) { if (it < 512) ssd_item<1>(q, it, l, smem); else attn_b_item(q, it - 512, l, smem); } }
            grid.sync();
            { const Params q = launder(p);
#pragma unroll 1
              for (int it = blockIdx.x; it < 1024 + 512; it += gridDim.x) { if (it < 1024) attn_a_item(q, it, l, smem); else ssd_item<3>(q, it - 1024, l, smem); } }
            grid.sync();
            { const Params q = launder(p); post2_phase(q); }
            grid.sync();
            { const Params q = launder(p); merge_phase(q, l, smem); }
            grid.sync();
            { const Params q = launder(p); out_phase(q, l, hb, (l == 0) ? q.x : q.out, smem); }
            grid.sync();
        }
    }
}

extern "C" void kernel_launch(void* const* d_in, const int* in_sizes, int n_in, void* d_out, int out_size, void* d_ws, size_t ws_size, hipStream_t stream) {
    static int grid_blocks = 0;
    if (!grid_blocks) {
        int dev = 0, cus = 0, per_cu = 0;
        hipGetDevice(&dev);
        hipDeviceGetAttribute(&cus, hipDeviceAttributeMultiprocessorCount, dev);
        hipOccupancyMaxActiveBlocksPerMultiprocessor(&per_cu, hybrid_fwd, 256, 0);
        if (per_cu > 2) per_cu = 2;
        if (per_cu < 1) per_cu = 1;
        grid_blocks = cus * per_cu;
    }
    Params p{};
    const float** pp = (const float**)&p;
    for (int i = 0; i < 22; ++i) pp[i] = (const float*)d_in[i];
    p.out = (float*)d_out; p.ws = (unsigned char*)d_ws;
    void* args[] = {&p};
    hipError_t e = hipLaunchCooperativeKernel((void*)hybrid_fwd, dim3(grid_blocks), dim3(256), args, 0, stream);
    if (e != hipSuccess) fprintf(stderr, "cooperative launch failed: %s (grid %d)\n", hipGetErrorString(e), grid_blocks);
}
```

```cpp
#include <hip/hip_runtime.h>
#include <hip/hip_cooperative_groups.h>
#include <cstdint>
#include <cstdio>
namespace cg = cooperative_groups;

typedef unsigned short bf16_t;
typedef short bf16x8 __attribute__((ext_vector_type(8)));
typedef short v4i16 __attribute__((ext_vector_type(4)));
typedef float f32x2 __attribute__((ext_vector_type(2)));
typedef float f32x4 __attribute__((ext_vector_type(4)));
typedef float f32x16 __attribute__((ext_vector_type(16)));
typedef unsigned u32x2 __attribute__((ext_vector_type(2)));
typedef unsigned u32x4 __attribute__((ext_vector_type(4)));
typedef __bf16 bf16x2_t __attribute__((ext_vector_type(2)));
#define LDSAS __attribute__((address_space(3)))

constexpr int SEQ = 8192, DM = 1024, NBATCH = 4, NBH = 2, TP = NBH * SEQ, DEPTH = 2;
constexpr int NP = 8576;
constexpr float EPS = 1e-6f;
constexpr float LOG2E = 1.4426950408889634f, LN2 = 0.6931471805599453f;
constexpr int NSEG = 16, SEGLEN = 512, TSUB = 32, NSUB = SEGLEN / TSUB;

constexpr size_t MiB = 1u << 20;
constexpr size_t WS_WIN = 0;
constexpr size_t WS_WPA = 34 * MiB;
constexpr size_t WS_WPB = 36 * MiB;
constexpr size_t WS_WPC = 37 * MiB;
constexpr size_t WS_WOUT = 39 * MiB;
constexpr size_t WS_MOD = 43 * MiB;
constexpr size_t WS_ROPE = 43 * MiB + 128 * 1024;
constexpr size_t WS_BND = 43 * MiB + 160 * 1024;
constexpr size_t WS_RSTD = 43 * MiB + 256 * 1024;
constexpr size_t WS_SEGT = 43 * MiB + 512 * 1024;
constexpr size_t WS_LSE = 44 * MiB;
constexpr size_t WS_DT = 45 * MiB;
constexpr size_t WS_BAR = 46 * MiB;
constexpr size_t WS_H = 48 * MiB;
constexpr size_t WS_QA = 80 * MiB;
constexpr size_t WS_KA = 96 * MiB;
constexpr size_t WS_VA = 100 * MiB;
constexpr size_t WS_GA = 104 * MiB;
constexpr size_t WS_QB = 120 * MiB;
constexpr size_t WS_KB = 144 * MiB;
constexpr size_t WS_VB = 168 * MiB;
constexpr size_t WS_GB = 192 * MiB;
constexpr size_t WS_XBC = 200 * MiB;
constexpr size_t WS_ZS = 232 * MiB;
constexpr size_t WS_MG = 248 * MiB;
constexpr size_t WS_YF = 344 * MiB;
constexpr size_t WS_YS = 360 * MiB;
constexpr size_t WS_YBM = 376 * MiB;
constexpr size_t WS_YC = 384 * MiB;
constexpr size_t WS_MRG = 400 * MiB;
constexpr size_t WS_ST = 432 * MiB;

struct Params {
    const float *x, *c, *norm_w, *w_ada, *b_ada, *w_in, *b_gate, *q_norm_a, *k_norm_a, *q_norm_b, *k_norm_b, *rel_bias,
        *conv_w, *conv_b, *a_log, *dt_bias, *d_skip, *ssm_norm_w, *w_proj_a, *w_proj_b, *w_proj_c, *w_out;
    float* out;
    unsigned char* ws;
};


__device__ __forceinline__ Params launder(const Params& p) {
    Params q = p;
    asm volatile("" : "+s"(q.x), "+s"(q.c), "+s"(q.norm_w), "+s"(q.w_ada), "+s"(q.b_ada), "+s"(q.w_in), "+s"(q.b_gate), "+s"(q.q_norm_a), "+s"(q.k_norm_a), "+s"(q.q_norm_b), "+s"(q.k_norm_b), "+s"(q.rel_bias));
    asm volatile("" : "+s"(q.conv_w), "+s"(q.conv_b), "+s"(q.a_log), "+s"(q.dt_bias), "+s"(q.d_skip), "+s"(q.ssm_norm_w), "+s"(q.w_proj_a), "+s"(q.w_proj_b), "+s"(q.w_proj_c), "+s"(q.w_out), "+s"(q.out), "+s"(q.ws));
    return q;
}
__device__ __forceinline__ unsigned pk2(float lo, float hi) { f32x2 v = {lo, hi}; bf16x2_t b = __builtin_convertvector(v, bf16x2_t); return __builtin_bit_cast(unsigned, b); }
__device__ __forceinline__ float bf2f(unsigned short b) { return __uint_as_float(((unsigned)b) << 16); }
__device__ __forceinline__ float bflo(unsigned u) { return __uint_as_float(u << 16); }
__device__ __forceinline__ float bfhi(unsigned u) { return __uint_as_float(u & 0xffff0000u); }
__device__ __forceinline__ float siluf(float v) { return v / (1.f + __expf(-v)); }
__device__ __forceinline__ float sigmf(float v) { return 1.f / (1.f + __expf(-v)); }
__device__ __forceinline__ float wave_sum(float v) {
#pragma unroll
    for (int o = 1; o < 64; o <<= 1) v += __shfl_xor(v, o);
    return v;
}
__device__ __forceinline__ v4i16 tr16(const unsigned char* p) { return __builtin_amdgcn_ds_read_tr16_b64_v4i16((LDSAS v4i16*)p); }
__device__ __forceinline__ bf16x8 cat8(v4i16 a, v4i16 b) { return (bf16x8){a[0], a[1], a[2], a[3], b[0], b[1], b[2], b[3]}; }
__device__ __forceinline__ int crow(int r, int hi) { return (r & 3) + 8 * (r >> 2) + 4 * hi; }

__device__ __forceinline__ void p0_transpose(const float* __restrict__ W, int ldw, int K, bf16_t* __restrict__ Wt, int k0, int n0, int mode,
                                             const float* __restrict__ rowscale, float* tile) {
    const int tid = threadIdx.x, tx = tid & 63, ty = tid >> 6;
    const int np = n0 + tx; int n = np; bool valid = true;
    if (mode == 1) {
        if (np < 4352) n = np; else if (np < 4864) n = np + 512; else if (np < 5376) n = np - 512;
        else if (np < 8448) n = np + 16; else if (np < 8464) n = np - 3072; else { valid = false; n = 0; }
    }
#pragma unroll 4
    for (int i = 0; i < 16; ++i) {
        const int k = ty + 4 * i; float v = valid ? W[(size_t)(k0 + k) * ldw + n] : 0.f;
        if (rowscale) v *= rowscale[k0 + k];
        tile[k * 65 + tx] = v;
    }
    __syncthreads();
    const int r = tid >> 2, kc = (tid & 3) * 16;
    u32x4 o0, o1;
    o0.x = pk2(tile[(kc + 0) * 65 + r], tile[(kc + 1) * 65 + r]); o0.y = pk2(tile[(kc + 2) * 65 + r], tile[(kc + 3) * 65 + r]);
    o0.z = pk2(tile[(kc + 4) * 65 + r], tile[(kc + 5) * 65 + r]); o0.w = pk2(tile[(kc + 6) * 65 + r], tile[(kc + 7) * 65 + r]);
    o1.x = pk2(tile[(kc + 8) * 65 + r], tile[(kc + 9) * 65 + r]); o1.y = pk2(tile[(kc + 10) * 65 + r], tile[(kc + 11) * 65 + r]);
    o1.z = pk2(tile[(kc + 12) * 65 + r], tile[(kc + 13) * 65 + r]); o1.w = pk2(tile[(kc + 14) * 65 + r], tile[(kc + 15) * 65 + r]);
    bf16_t* dst = Wt + (size_t)(n0 + r) * K + k0 + kc;
    *(u32x4*)dst = o0; *(u32x4*)(dst + 8) = o1;
    __syncthreads();
}

__device__ void phase0(const Params& p, unsigned char* smem) {
    const int tid = threadIdx.x;
    float* tile = (float*)smem;
    constexpr int I_IN = 16 * 134, I_PA = 8 * 16, I_PB = 4 * 16, I_PC = 8 * 16, I_OUT = 16 * 16, I_L = I_IN + I_PA + I_PB + I_PC + I_OUT;
    constexpr int I_T = 2 * I_L, I_MOD = 192, I_ALL = I_T + I_MOD + 1;
    for (int item = blockIdx.x; item < I_ALL; item += gridDim.x) {
        if (item < I_T) {
            const int l = item / I_L; int r = item % I_L;
            if (r < I_IN) { const int kt = r / 134, nt = r % 134;
                p0_transpose(p.w_in + (size_t)l * 1024 * 8464, 8464, 1024, (bf16_t*)(p.ws + WS_WIN) + (size_t)l * NP * 1024, kt * 64, nt * 64, 1, nullptr, tile); continue; }
            r -= I_IN;
            if (r < I_PA) { const int kt = r / 16, nt = r % 16;
                p0_transpose(p.w_proj_a + (size_t)l * 512 * 1024, 1024, 512, (bf16_t*)(p.ws + WS_WPA) + (size_t)l * 1024 * 512, kt * 64, nt * 64, 0, nullptr, tile); continue; }
            r -= I_PA;
            if (r < I_PB) { const int kt = r / 16, nt = r % 16;
                p0_transpose(p.w_proj_b + (size_t)l * 256 * 1024, 1024, 256, (bf16_t*)(p.ws + WS_WPB) + (size_t)l * 1024 * 256, kt * 64, nt * 64, 0, nullptr, tile); continue; }
            r -= I_PB;
            if (r < I_PC) { const int kt = r / 16, nt = r % 16;
                p0_transpose(p.w_proj_c + (size_t)l * 512 * 1024, 1024, 512, (bf16_t*)(p.ws + WS_WPC) + (size_t)l * 1024 * 512, kt * 64, nt * 64, 0, p.ssm_norm_w + l * 512, tile); continue; }
            r -= I_PC;
            { const int kt = r / 16, nt = r % 16;
                p0_transpose(p.w_out + (size_t)l * 1024 * 1024, 1024, 1024, (bf16_t*)(p.ws + WS_WOUT) + (size_t)l * 1024 * 1024, kt * 64, nt * 64, 0, nullptr, tile); }
        } else if (item < I_T + I_MOD) {
            const int it = item - I_T, l = it / 96, col0 = (it % 96) * 32, cl = tid & 31, ks = tid >> 5;
            float a0 = 0.f, a1 = 0.f, a2 = 0.f, a3 = 0.f;
            const float* wp = p.w_ada + ((size_t)l * 1024 + ks * 128) * 3072 + col0 + cl;
#pragma unroll 8
            for (int k = 0; k < 128; ++k) {
                const float wv = wp[(size_t)k * 3072]; const int kk = ks * 128 + k;
                a0 += siluf(p.c[kk]) * wv; a1 += siluf(p.c[1024 + kk]) * wv; a2 += siluf(p.c[2048 + kk]) * wv; a3 += siluf(p.c[3072 + kk]) * wv;
            }
            float* red = (float*)smem;
            red[(ks * 32 + cl) * 4 + 0] = a0; red[(ks * 32 + cl) * 4 + 1] = a1; red[(ks * 32 + cl) * 4 + 2] = a2; red[(ks * 32 + cl) * 4 + 3] = a3;
            __syncthreads();
            if (tid < 128) { const int b = tid >> 5, c2 = tid & 31; float s = 0.f;
#pragma unroll
                for (int k = 0; k < 8; ++k) s += red[(k * 32 + c2) * 4 + b];
                ((float*)(p.ws + WS_MOD))[(l * 4 + b) * 3072 + col0 + c2] = s + p.b_ada[l * 3072 + col0 + c2]; }
            __syncthreads();
        } else {
            float* rc = (float*)(p.ws + WS_ROPE); float* rs = rc + 128 * 16;
            for (int e = tid; e < 2048; e += 256) {
                const int pos = e >> 4, i = e & 15;
                const float freq = powf(10000.0f, -(float)i / 16.0f);
                const float ang = (float)pos * freq;
                const double rev = (double)ang * 0.15915494309189535; const double fr = rev - rint(rev);
                const float a = (float)(fr * 6.283185307179586);
                rc[e] = cosf(a); rs[e] = sinf(a);
            }
            if (tid < 2) {
                const int l = tid; float mqa = 0.f, mka = 0.f, mqb = 0.f, mkb = 0.f, mb = 0.f;
                for (int i = 0; i < 64; ++i) { mqa = fmaxf(mqa, fabsf(p.q_norm_a[l * 64 + i])); mka = fmaxf(mka, fabsf(p.k_norm_a[l * 64 + i]));
                    mqb = fmaxf(mqb, fabsf(p.q_norm_b[l * 64 + i])); mkb = fmaxf(mkb, fabsf(p.k_norm_b[l * 64 + i])); }
                for (int i = 0; i < 32 * 12; ++i) mb = fmaxf(mb, p.rel_bias[i]);
                float* bd = (float*)(p.ws + WS_BND);
                bd[l] = 8.f * mqa * mka * LOG2E; bd[2 + l] = (8.f * mqb * mkb + mb) * LOG2E;
            }
        }
    }
}

__device__ void norm_phase(const Params& p, int l, int hb, const float* xsrc) {
    const int lane = threadIdx.x & 63, gw = blockIdx.x * 4 + (threadIdx.x >> 6), nw = gridDim.x * 4;
    bf16_t* H = (bf16_t*)(p.ws + WS_H);
    const float* nwp = p.norm_w + l * 1024;
    for (int row = gw; row < TP; row += nw) {
        const size_t rg = (size_t)hb * TP + row; const int b = (int)(rg / SEQ);
        const f32x4* xr = (const f32x4*)(xsrc + rg * 1024);
        const float* md = (const float*)(p.ws + WS_MOD) + (size_t)(l * 4 + b) * 3072;
        f32x4 v[4]; float ss = 0.f;
#pragma unroll
        for (int j = 0; j < 4; ++j) { v[j] = xr[lane + 64 * j]; ss += v[j].x * v[j].x + v[j].y * v[j].y + v[j].z * v[j].z + v[j].w * v[j].w; }
        ss = wave_sum(ss); const float rstd = rsqrtf(ss * (1.f / 1024.f) + EPS);
#pragma unroll
        for (int j = 0; j < 4; ++j) {
            const int col = 4 * (lane + 64 * j);
            const f32x4 w4 = *(const f32x4*)(nwp + col), sh = *(const f32x4*)(md + col), sc = *(const f32x4*)(md + 1024 + col);
            const f32x4 o = v[j] * rstd * w4 * (1.f + sc) + sh;
            u32x2 pk; pk.x = pk2(o.x, o.y); pk.y = pk2(o.z, o.w);
            *(u32x2*)(H + (size_t)row * 1024 + col) = pk;
        }
    }
}

constexpr int G_STAGE = 32768, G_AB = 16384;
__device__ __forceinline__ void gemm_core(const bf16_t* __restrict__ A, int lda, const bf16_t* __restrict__ Bt, int ldb, int K, f32x4 (&acc)[4][4], unsigned char* smem, int tid) {
    asm volatile("" : "+v"(tid));
    const int lane = tid & 63, w = __builtin_amdgcn_readfirstlane(tid >> 6), wm = w >> 1, wn = w & 1, idx = lane & 15, kq = lane >> 4;
    unsigned offA[4], offB[4];
#pragma unroll
    for (int j = 0; j < 4; ++j) { const int row = (j * 4 + w) * 8 + (lane >> 3), c = (lane & 7) ^ ((row >> 1) & 7);
        offA[j] = (unsigned)(row * lda + c * 8) * 2u; offB[j] = (unsigned)(row * ldb + c * 8) * 2u; }
#pragma unroll
    for (int mi = 0; mi < 4; ++mi)
#pragma unroll
        for (int ni = 0; ni < 4; ++ni) acc[mi][ni] = (f32x4){0.f, 0.f, 0.f, 0.f};
    LDSAS unsigned char* lds = (LDSAS unsigned char*)smem;
#define G_ISSUE(kt, st) do { _Pragma("unroll") for (int j = 0; j < 4; ++j) { \
        __builtin_amdgcn_global_load_lds((const unsigned*)((const char*)A + offA[j] + (kt) * 128), (LDSAS unsigned*)(lds + (st) * G_STAGE + (j * 4 + w) * 1024), 16, 0, 0); \
        __builtin_amdgcn_global_load_lds((const unsigned*)((const char*)Bt + offB[j] + (kt) * 128), (LDSAS unsigned*)(lds + (st) * G_STAGE + G_AB + (j * 4 + w) * 1024), 16, 0, 0); } } while (0)
    const int nk = K >> 6;
    G_ISSUE(0, 0);
    asm volatile("s_waitcnt vmcnt(0)" ::: "memory");
    __syncthreads();
    const int swz = (idx >> 1) & 7;
    const int aoff = (wm * 64 + idx) * 128, boff = G_AB + (wn * 64 + idx) * 128;
    for (int kt = 0; kt < nk; ++kt) {
        const int st = kt & 1;
        if (kt + 1 < nk) G_ISSUE(kt + 1, st ^ 1);
        const unsigned char* sb = smem + st * G_STAGE;
#pragma unroll
        for (int ks = 0; ks < 2; ++ks) {
            bf16x8 af[4], bfr[4];
            const int co = ((ks * 4 + kq) ^ swz) * 16;
#pragma unroll
            for (int mi = 0; mi < 4; ++mi) af[mi] = *(const bf16x8*)(sb + aoff + mi * 2048 + co);
#pragma unroll
            for (int ni = 0; ni < 4; ++ni) bfr[ni] = *(const bf16x8*)(sb + boff + ni * 2048 + co);
#pragma unroll
            for (int mi = 0; mi < 4; ++mi)
#pragma unroll
                for (int ni = 0; ni < 4; ++ni) acc[mi][ni] = __builtin_amdgcn_mfma_f32_16x16x32_bf16(bfr[ni], af[mi], acc[mi][ni], 0, 0, 0);
        }
        asm volatile("s_waitcnt vmcnt(0)" ::: "memory");
        __syncthreads();
    }
#undef G_ISSUE
}

__device__ __forceinline__ void st4bf(bf16_t* dst, f32x4 v) { u32x2 pk; pk.x = pk2(v.x, v.y); pk.y = pk2(v.z, v.w); *(u32x2*)dst = pk; }

__device__ void gemm1_phase(const Params& p, int l, int hb, unsigned char* smem) {
    const bf16_t* H = (const bf16_t*)(p.ws + WS_H);
    const bf16_t* Wt = (const bf16_t*)(p.ws + WS_WIN) + (size_t)l * NP * 1024;
    const float* ropec = (const float*)(p.ws + WS_ROPE); const float* ropes = ropec + 2048;
    constexpr int NT = 67, NTILES = 128 * NT, GRP = 8 * NT;
    for (int t = blockIdx.x; t < NTILES; t += gridDim.x) {
        const int grp = t / GRP, r = t % GRP, mt = grp * 8 + (r & 7), nt = r >> 3;
        const int m0 = mt * 128, n0 = nt * 128;
        f32x4 acc[4][4];
        int tid = threadIdx.x;
        gemm_core(H + (size_t)m0 * 1024, 1024, Wt + (size_t)n0 * 1024, 1024, 1024, acc, smem, tid);
        asm volatile("" : "+v"(tid));
        const int lane = tid & 63, w = tid >> 6, wm = w >> 1, wn = w & 1, idx = lane & 15, kq = lane >> 4;
        const int cw = n0 + wn * 64;
        const int lc = 4 * kq;
        if (cw < 768 && (cw < 640)) {
            const bool isq = cw < 512;
            const float* nwp = (isq ? p.q_norm_a : p.k_norm_a) + l * 64;
            bf16_t* dst = isq ? (bf16_t*)(p.ws + WS_QA) : (bf16_t*)(p.ws + WS_KA);
            const int pitch = isq ? 512 : 128, c0 = isq ? cw : cw - 512;
            const float qs = isq ? 0.125f * LOG2E : 1.f;
#pragma unroll
            for (int mi = 0; mi < 4; ++mi) {
                const int row = m0 + wm * 64 + mi * 16 + idx;
                float ss = 0.f;
#pragma unroll
                for (int ni = 0; ni < 4; ++ni) { const f32x4 v = acc[mi][ni]; ss += v.x * v.x + v.y * v.y + v.z * v.z + v.w * v.w; }
                ss += __shfl_xor(ss, 16); ss += __shfl_xor(ss, 32);
                const float rstd = rsqrtf(ss * (1.f / 64.f) + EPS);
                f32x4 y[4];
#pragma unroll
                for (int ni = 0; ni < 4; ++ni) y[ni] = acc[mi][ni] * rstd * *(const f32x4*)(nwp + ni * 16 + lc);
                const int tt = row & (SEQ - 1), prow = tt >> 6, pcol = tt & 63;
#pragma unroll
                for (int hf = 0; hf < 2; ++hf) {
                    const int pos = hf ? pcol : prow;
                    const f32x4 cs = *(const f32x4*)(ropec + pos * 16 + lc), sn = *(const f32x4*)(ropes + pos * 16 + lc);
                    const f32x4 a = y[2 * hf], b = y[2 * hf + 1];
                    y[2 * hf] = a * cs - b * sn; y[2 * hf + 1] = b * cs + a * sn;
                }
#pragma unroll
                for (int ni = 0; ni < 4; ++ni) st4bf(dst + (size_t)row * pitch + c0 + ni * 16 + lc, y[ni] * qs);
            }
        } else if (cw >= 1280 && cw < 2816) {
            const bool isq = cw < 2048;
            const float* nwp = (isq ? p.q_norm_b : p.k_norm_b) + l * 64;
            const int gc = isq ? cw - 1280 : cw - 2048, g = gc >> 8, c0 = gc & 255;
            const int sh = 2 * g;
            bf16_t* dst = (bf16_t*)(p.ws + (isq ? WS_QB : WS_KB));
            const float qs = isq ? 0.125f * LOG2E : 1.f;
#pragma unroll
            for (int mi = 0; mi < 4; ++mi) {
                const int row = m0 + wm * 64 + mi * 16 + idx;
                float ss = 0.f;
#pragma unroll
                for (int ni = 0; ni < 4; ++ni) { const f32x4 v = acc[mi][ni]; ss += v.x * v.x + v.y * v.y + v.z * v.z + v.w * v.w; }
                ss += __shfl_xor(ss, 16); ss += __shfl_xor(ss, 32);
                const float rstd = rsqrtf(ss * (1.f / 64.f) + EPS) * qs;
                const int bl = row >> 13, tt = row & (SEQ - 1);
                const int pp = (tt & ((1 << sh) - 1)) * (SEQ >> sh) + (tt >> sh);
                bf16_t* drow = dst + ((size_t)(bl * 3 + g) * SEQ + pp) * 256 + c0 + lc;
#pragma unroll
                for (int ni = 0; ni < 4; ++ni) st4bf(drow + ni * 16, acc[mi][ni] * rstd * *(const f32x4*)(nwp + ni * 16 + lc));
            }
        } else if (cw >= 2816 && cw < 3584) {
            const int gc = cw - 2816, g = gc >> 8, c0 = gc & 255, sh = 2 * g;
            bf16_t* dst = (bf16_t*)(p.ws + WS_VB);
#pragma unroll
            for (int mi = 0; mi < 4; ++mi) {
                const int row = m0 + wm * 64 + mi * 16 + idx;
                const int bl = row >> 13, tt = row & (SEQ - 1);
                const int pp = (tt & ((1 << sh) - 1)) * (SEQ >> sh) + (tt >> sh);
                bf16_t* drow = dst + ((size_t)(bl * 3 + g) * SEQ + pp) * 256 + c0 + lc;
#pragma unroll
                for (int ni = 0; ni < 4; ++ni) st4bf(drow + ni * 16, acc[mi][ni]);
            }
        } else if (cw >= 8448) {
            if (wn == 0) {
                float* dst = (float*)(p.ws + WS_DT);
                const f32x4 bias = *(const f32x4*)(p.dt_bias + l * 16 + lc);
#pragma unroll
                for (int mi = 0; mi < 4; ++mi) {
                    const int row = m0 + wm * 64 + mi * 16 + idx;
                    f32x4 v = acc[mi][0] + bias, o;
                    o.x = v.x > 20.f ? v.x : log1pf(__expf(v.x)); o.y = v.y > 20.f ? v.y : log1pf(__expf(v.y));
                    o.z = v.z > 20.f ? v.z : log1pf(__expf(v.z)); o.w = v.w > 20.f ? v.w : log1pf(__expf(v.w));
                    *(f32x4*)(dst + (size_t)row * 16 + lc) = o;
                }
            }
        } else {
            bf16_t* dst; int pitch, c0, mode;
            if (cw < 768) { dst = (bf16_t*)(p.ws + WS_VA); pitch = 128; c0 = cw - 640; mode = 0; }
            else if (cw < 1280) { dst = (bf16_t*)(p.ws + WS_GA); pitch = 512; c0 = cw - 768; mode = 1; }
            else if (cw < 3840) { dst = (bf16_t*)(p.ws + WS_GB); pitch = 256; c0 = cw - 3584; mode = 1; }
            else if (cw < 4864) { dst = (bf16_t*)(p.ws + WS_XBC); pitch = 1024; c0 = cw - 3840; mode = 0; }
            else if (cw < 5376) { dst = (bf16_t*)(p.ws + WS_ZS); pitch = 512; c0 = cw - 4864; mode = 1; }
            else { dst = (bf16_t*)(p.ws + WS_MG); pitch = 3072; c0 = cw - 5376; mode = 2; }
            const float* bg = p.b_gate + l * 3072 + c0 + lc;
#pragma unroll
            for (int mi = 0; mi < 4; ++mi) {
                const int row = m0 + wm * 64 + mi * 16 + idx;
#pragma unroll
                for (int ni = 0; ni < 4; ++ni) {
                    f32x4 v = acc[mi][ni];
                    if (mode == 1) { v.x = siluf(v.x); v.y = siluf(v.y); v.z = siluf(v.z); v.w = siluf(v.w); }
                    else if (mode == 2) { const f32x4 bb = *(const f32x4*)(bg + ni * 16); v.x = sigmf(v.x + bb.x); v.y = sigmf(v.y + bb.y); v.z = sigmf(v.z + bb.z); v.w = sigmf(v.w + bb.w); }
                    st4bf(dst + (size_t)row * pitch + c0 + ni * 16 + lc, v);
                }
            }
        }
    }
}

__device__ void merge_phase(const Params& p, int l, unsigned char* smem) {
    const bf16_t* MG = (const bf16_t*)(p.ws + WS_MG);
    const float* rstd = (const float*)(p.ws + WS_RSTD);
    bf16_t* MR = (bf16_t*)(p.ws + WS_MRG);
    for (int t = blockIdx.x; t < 128 * 8; t += gridDim.x) {
        const int mt = t >> 3, nt = t & 7, m0 = mt * 128, n0 = nt * 128;
#pragma unroll 1
        for (int br = 0; br < 3; ++br) {
            f32x4 acc[4][4];
            const bf16_t* A; const bf16_t* Bt; int K;
            if (br == 0) { A = (const bf16_t*)(p.ws + WS_QA); K = 512; Bt = (const bf16_t*)(p.ws + WS_WPA) + (size_t)l * 1024 * 512; }
            else if (br == 1) { A = (const bf16_t*)(p.ws + WS_YBM); K = 256; Bt = (const bf16_t*)(p.ws + WS_WPB) + (size_t)l * 1024 * 256; }
            else { A = (const bf16_t*)(p.ws + WS_YC); K = 512; Bt = (const bf16_t*)(p.ws + WS_WPC) + (size_t)l * 1024 * 512; }
            int tid = threadIdx.x;
            gemm_core(A + (size_t)m0 * K, K, Bt + (size_t)n0 * K, K, K, acc, smem, tid);
            asm volatile("" : "+v"(tid));
            const int lane = tid & 63, w = tid >> 6, wm = w >> 1, wn = w & 1, idx = lane & 15, kq = lane >> 4;
#pragma unroll
            for (int mi = 0; mi < 4; ++mi) {
                const int row = m0 + wm * 64 + mi * 16 + idx;
                const float rs = (br == 2) ? rstd[row] : 1.f;
#pragma unroll
                for (int ni = 0; ni < 4; ++ni) {
                    const int col = n0 + wn * 64 + ni * 16 + 4 * kq;
                    const u32x2 g = *(const u32x2*)(MG + (size_t)row * 3072 + br * 1024 + col);
                    f32x4 gv; gv.x = bflo(g.x); gv.y = bfhi(g.x); gv.z = bflo(g.y); gv.w = bfhi(g.y);
                    f32x4 v = gv * rs * acc[mi][ni];
                    bf16_t* mp = MR + (size_t)row * 1024 + col;
                    if (br > 0) { const u32x2 o = *(const u32x2*)mp; v.x += bflo(o.x); v.y += bfhi(o.x); v.z += bflo(o.y); v.w += bfhi(o.y); }
                    st4bf(mp, v);
                }
            }
        }
    }
}

__device__ void out_phase(const Params& p, int l, int hb, const float* xsrc, unsigned char* smem) {
    const bf16_t* MR = (const bf16_t*)(p.ws + WS_MRG);
    const bf16_t* Wt = (const bf16_t*)(p.ws + WS_WOUT) + (size_t)l * 1024 * 1024;
    for (int t = blockIdx.x; t < 128 * 8; t += gridDim.x) {
        const int mt = t >> 3, nt = t & 7, m0 = mt * 128, n0 = nt * 128;
        f32x4 acc[4][4];
        int tid = threadIdx.x;
        gemm_core(MR + (size_t)m0 * 1024, 1024, Wt + (size_t)n0 * 1024, 1024, 1024, acc, smem, tid);
        asm volatile("" : "+v"(tid));
        const int lane = tid & 63, w = tid >> 6, wm = w >> 1, wn = w & 1, idx = lane & 15, kq = lane >> 4;
#pragma unroll
        for (int mi = 0; mi < 4; ++mi) {
            const int row = m0 + wm * 64 + mi * 16 + idx; const size_t rg = (size_t)hb * TP + row; const int b = (int)(rg / SEQ);
            const float* gate = (const float*)(p.ws + WS_MOD) + (size_t)(l * 4 + b) * 3072 + 2048;
#pragma unroll
            for (int ni = 0; ni < 4; ++ni) {
                const int col = n0 + wn * 64 + ni * 16 + 4 * kq;
                const f32x4 xv = *(const f32x4*)(xsrc + rg * 1024 + col), gv = *(const f32x4*)(gate + col);
                *(f32x4*)(p.out + rg * 1024 + col) = xv + gv * acc[mi][ni];
            }
        }
    }
}

constexpr int AT_KS = 0, AT_VS = 9216, AT_LQ = 9216 + 8192, AT_LUT = AT_LQ + 512;

#define AT_STAGE_STORE() do { _Pragma("unroll") for (int i = 0; i < 2; ++i) { const int c = tid + 256 * i, row = c >> 3, ch = c & 7; \
        *(u32x4*)(Ks + row * 72 + ch * 8) = rk[i]; *(u32x4*)(Vs + (ch >> 2) * 4096 + row * 64 + (ch & 3) * 16) = rv[i]; } } while (0)

__device__ __forceinline__ void at_qk(f32x16& p0, f32x16& p1, const bf16_t* Ks, const bf16x8* qr, int r32, int hi) {
#pragma unroll
    for (int ds = 0; ds < 4; ++ds) {
        const bf16x8 k0 = *(const bf16x8*)(Ks + r32 * 72 + ds * 16 + hi * 8);
        const bf16x8 k1 = *(const bf16x8*)(Ks + (r32 + 32) * 72 + ds * 16 + hi * 8);
        p0 = __builtin_amdgcn_mfma_f32_32x32x16_bf16(k0, qr[ds], p0, 0, 0, 0);
        p1 = __builtin_amdgcn_mfma_f32_32x32x16_bf16(k1, qr[ds], p1, 0, 0, 0);
    }
}
__device__ __forceinline__ void at_pv(f32x16& o0, f32x16& o1, const f32x16& p0, const f32x16& p1, const unsigned char* Vs, int lane) {
    const int hi = lane >> 5;
    const unsigned char* vb = Vs + ((lane >> 4) & 1) * 32 + (lane & 3) * 8 + (4 * hi + ((lane & 15) >> 2)) * 64;
#pragma unroll
    for (int s = 0; s < 4; ++s) {
        u32x4 pw;
        if (s < 2) { pw.x = pk2(p0[8 * s + 0], p0[8 * s + 1]); pw.y = pk2(p0[8 * s + 2], p0[8 * s + 3]); pw.z = pk2(p0[8 * s + 4], p0[8 * s + 5]); pw.w = pk2(p0[8 * s + 6], p0[8 * s + 7]); }
        else { const int q = s - 2; pw.x = pk2(p1[8 * q + 0], p1[8 * q + 1]); pw.y = pk2(p1[8 * q + 2], p1[8 * q + 3]); pw.z = pk2(p1[8 * q + 4], p1[8 * q + 5]); pw.w = pk2(p1[8 * q + 6], p1[8 * q + 7]); }
        const bf16x8 pa = __builtin_bit_cast(bf16x8, pw);
        const bf16x8 v0 = cat8(tr16(vb + s * 1024), tr16(vb + s * 1024 + 512));
        const bf16x8 v1 = cat8(tr16(vb + 4096 + s * 1024), tr16(vb + 4096 + s * 1024 + 512));
        o0 = __builtin_amdgcn_mfma_f32_32x32x16_bf16(pa, v0, o0, 0, 0, 0);
        o1 = __builtin_amdgcn_mfma_f32_32x32x16_bf16(pa, v1, o1, 0, 0, 0);
    }
}

__device__ void attn_a_item(const Params& p, int item, int l, unsigned char* smem) {
    int tid_ = threadIdx.x; asm volatile("" : "+v"(tid_));
    const int tid = tid_, lane = tid & 63, w = tid >> 6, r32 = lane & 31, hi = lane >> 5;
    const int b = item >> 9, r = item & 511, kvh = r >> 8, qblk = (r >> 2) & 63, hq = kvh * 4 + (r & 3);
    bf16_t* Ks = (bf16_t*)(smem + AT_KS); unsigned char* Vs = smem + AT_VS; float* lq = (float*)(smem + AT_LQ) + w * 32;
    bf16_t* QA = (bf16_t*)(p.ws + WS_QA);
    const bf16_t* GA = (const bf16_t*)(p.ws + WS_GA);
    const size_t tokq = (size_t)b * SEQ + qblk * 128 + w * 32;
    bf16x8 qr[4];
#pragma unroll
    for (int ds = 0; ds < 4; ++ds) qr[ds] = *(const bf16x8*)(QA + (tokq + r32) * 512 + hq * 64 + ds * 16 + hi * 8);
    const bf16_t* Kb = (const bf16_t*)(p.ws + WS_KA) + (size_t)b * SEQ * 128 + kvh * 64;
    const bf16_t* Vb = (const bf16_t*)(p.ws + WS_VA) + (size_t)b * SEQ * 128 + kvh * 64;
    const float nshift = -((const float*)(p.ws + WS_BND))[l];
    f32x16 o0, o1;
#pragma unroll
    for (int i = 0; i < 16; ++i) { o0[i] = 0.f; o1[i] = 0.f; }
    float lacc = 0.f;
    u32x4 rk[2], rv[2];
#pragma unroll
    for (int i = 0; i < 2; ++i) { const int c = tid + 256 * i, row = c >> 3, ch = c & 7;
        rk[i] = *(const u32x4*)(Kb + (size_t)row * 128 + ch * 8); rv[i] = *(const u32x4*)(Vb + (size_t)row * 128 + ch * 8); }
    for (int kt = 0; kt < SEQ / 64; ++kt) {
        __syncthreads();
        AT_STAGE_STORE();
        __syncthreads();
        if (kt + 1 < SEQ / 64) {
#pragma unroll
            for (int i = 0; i < 2; ++i) { const int c = tid + 256 * i, row = c >> 3, ch = c & 7;
                rk[i] = *(const u32x4*)(Kb + (size_t)((kt + 1) * 64 + row) * 128 + ch * 8); rv[i] = *(const u32x4*)(Vb + (size_t)((kt + 1) * 64 + row) * 128 + ch * 8); }
        }
        f32x16 p0, p1;
#pragma unroll
        for (int i = 0; i < 16; ++i) { p0[i] = nshift; p1[i] = nshift; }
        at_qk(p0, p1, Ks, qr, r32, hi);
#pragma unroll
        for (int i = 0; i < 16; ++i) { p0[i] = __builtin_amdgcn_exp2f(p0[i]); p1[i] = __builtin_amdgcn_exp2f(p1[i]); lacc += p0[i] + p1[i]; }
        at_pv(o0, o1, p0, p1, Vs, lane);
    }
    lacc += __shfl_xor(lacc, 32);
    if (hi == 0) lq[r32] = lacc;
    asm volatile("s_waitcnt lgkmcnt(0)" ::: "memory");
#pragma unroll
    for (int rr = 0; rr < 16; ++rr) {
        const int q = crow(rr, hi); const float inv = 1.f / lq[q];
        const size_t off = (tokq + q) * 512 + hq * 64 + r32;
        const float g0 = bf2f(GA[off]), g1 = bf2f(GA[off + 32]);
        QA[off] = (bf16_t)(pk2(o0[rr] * inv * g0, 0.f) & 0xffffu);
        QA[off + 32] = (bf16_t)(pk2(o1[rr] * inv * g1, 0.f) & 0xffffu);
    }
}

__device__ void attn_b_item(const Params& p, int item, int l, unsigned char* smem) {
    int tid_ = threadIdx.x; asm volatile("" : "+v"(tid_));
    const int tid = tid_, lane = tid & 63, w = tid >> 6, r32 = lane & 31, hi = lane >> 5;
    const int blk = item & 63, j = (item >> 6) & 3, bg = item >> 8, g = bg % 3, b = bg / 3;
    const int sh = 2 * g, dil = 1 << sh, Mlen = SEQ >> sh;
    bf16_t* Ks = (bf16_t*)(smem + AT_KS); unsigned char* Vs = smem + AT_VS; float* lq = (float*)(smem + AT_LQ) + w * 32; float* lut = (float*)(smem + AT_LUT);
    bf16_t* QB = (bf16_t*)(p.ws + WS_QB) + (size_t)bg * SEQ * 256 + j * 64;
    const bf16_t* KB = (const bf16_t*)(p.ws + WS_KB) + (size_t)bg * SEQ * 256 + j * 64;
    const bf16_t* VB = (const bf16_t*)(p.ws + WS_VB) + (size_t)bg * SEQ * 256 + j * 64;
    float* LSE = (float*)(p.ws + WS_LSE) + (size_t)bg * SEQ * 4 + j;
    const int p0r = blk * 128, seq_lo = (p0r / Mlen) * Mlen, seq_hi = seq_lo + Mlen;
    __syncthreads();
    if (tid < 129) {
        const int rel = tid - 64, n = (rel < 0 ? -rel : rel) * dil;
        int bk;
        if (n < 8) bk = n; else { bk = 8 + (n >= 15) + (n >= 27) + (n >= 50) + (n >= 91) + (n >= 166) + (n >= 305) + (n >= 559); }
        if (rel > 0) bk += 16;
        lut[tid] = p.rel_bias[bk * 12 + g * 4 + j] * LOG2E;
    }
    const int qpos = p0r + w * 32 + r32;
    bf16x8 qr[4];
#pragma unroll
    for (int ds = 0; ds < 4; ++ds) qr[ds] = *(const bf16x8*)(QB + (size_t)qpos * 256 + ds * 16 + hi * 8);
    const float nshift = -((const float*)(p.ws + WS_BND))[2 + l];
    f32x16 o0, o1;
#pragma unroll
    for (int i = 0; i < 16; ++i) { o0[i] = 0.f; o1[i] = 0.f; }
    float lacc = 0.f;
    u32x4 rk[2], rv[2];
    for (int kt = 0; kt < 4; ++kt) {
        const int kbase = p0r - 64 + 64 * kt;
#pragma unroll
        for (int i = 0; i < 2; ++i) { const int c = tid + 256 * i, row = c >> 3, ch = c & 7;
            int pr = kbase + row; pr = pr < 0 ? 0 : (pr > SEQ - 1 ? SEQ - 1 : pr);
            rk[i] = *(const u32x4*)(KB + (size_t)pr * 256 + ch * 8); rv[i] = *(const u32x4*)(VB + (size_t)pr * 256 + ch * 8); }
        __syncthreads();
        AT_STAGE_STORE();
        __syncthreads();
        f32x16 p0, p1;
#pragma unroll
        for (int i = 0; i < 16; ++i) { p0[i] = nshift; p1[i] = nshift; }
        at_qk(p0, p1, Ks, qr, r32, hi);
#pragma unroll
        for (int i = 0; i < 16; ++i) {
            const int kv0 = kbase + crow(i, hi), kv1 = kv0 + 32;
            const int rel0 = kv0 - qpos, rel1 = kv1 - qpos;
            const bool ok0 = rel0 >= -64 && rel0 <= 64 && kv0 >= seq_lo && kv0 < seq_hi;
            const bool ok1 = rel1 >= -64 && rel1 <= 64 && kv1 >= seq_lo && kv1 < seq_hi;
            const float e0 = __builtin_amdgcn_exp2f(p0[i] + lut[ok0 ? rel0 + 64 : 64]);
            const float e1 = __builtin_amdgcn_exp2f(p1[i] + lut[ok1 ? rel1 + 64 : 64]);
            p0[i] = ok0 ? e0 : 0.f; p1[i] = ok1 ? e1 : 0.f; lacc += p0[i] + p1[i];
        }
        at_pv(o0, o1, p0, p1, Vs, lane);
    }
    lacc += __shfl_xor(lacc, 32);
    if (hi == 0) { lq[r32] = lacc; LSE[(size_t)qpos * 4] = (-nshift + log2f(lacc)) * LN2; }
    asm volatile("s_waitcnt lgkmcnt(0)" ::: "memory");
#pragma unroll
    for (int rr = 0; rr < 16; ++rr) {
        const int q = crow(rr, hi); const float inv = 1.f / lq[q];
        const size_t off = (size_t)(p0r + w * 32 + q) * 256 + r32;
        QB[off] = (bf16_t)(pk2(o0[rr] * inv, 0.f) & 0xffffu);
        QB[off + 32] = (bf16_t)(pk2(o1[rr] * inv, 0.f) & 0xffffu);
    }
}

constexpr int SS_BS = 0, SS_CS = 8704, SS_XS = 17408, SS_XWS = 22016, SS_GS = 26624, SS_SB = 29184, SS_CW = 46592, SS_SC = 54272, SS_END = 55296;

template <int PASS>
__device__ void ssd_item(const Params& p, int item, int l, unsigned char* smem) {
    int tid_ = threadIdx.x; asm volatile("" : "+v"(tid_));
    const int tid = tid_, lane = tid & 63, w = tid >> 6, idx = lane & 15, kq = lane >> 4;
    const int seg = item & 15, h = (item >> 4) & 7, dir = (item >> 7) & 1, b = item >> 8, grp = h >> 2;
    bf16_t* Bs = (bf16_t*)(smem + SS_BS); bf16_t* Cs = (bf16_t*)(smem + SS_CS); bf16_t* Xs = (bf16_t*)(smem + SS_XS); bf16_t* Xws = (bf16_t*)(smem + SS_XWS);
    bf16_t* Gs = (bf16_t*)(smem + SS_GS); bf16_t* Sb = (bf16_t*)(smem + SS_SB); float* cwl = (float*)(smem + SS_CW); float* sc = (float*)(smem + SS_SC);
    float* s_dt = sc, *s_c = sc + 32, *s_rs = sc + 64, *s_wl = sc + 96, *s_tot = sc + 128;
    const bf16_t* XBC = (const bf16_t*)(p.ws + WS_XBC);
    const float* DT = (const float*)(p.ws + WS_DT);
    float* ST = (float*)(p.ws + WS_ST); float* SEGT = (float*)(p.ws + WS_SEGT);
    bf16_t* Y = (bf16_t*)(p.ws + (dir ? WS_YS : WS_YF));
    const float Aneg = -__expf(p.a_log[l * 16 + dir * 8 + h]);
    const float Dh = p.d_skip[l * 8 + h];
    __syncthreads();
    for (int e = tid; e < 6 * 320; e += 256) {
        const int tap = e / 320, lc = e % 320;
        const int ch = lc < 64 ? h * 64 + lc : (lc < 192 ? 512 + grp * 128 + (lc - 64) : 768 + grp * 128 + (lc - 192));
        cwl[e] = tap < 5 ? p.conv_w[(size_t)l * 5 * 1024 + tap * 1024 + ch] : p.conv_b[l * 1024 + ch];
    }
    f32x4 S[8];
#pragma unroll
    for (int nt = 0; nt < 8; ++nt) S[nt] = (f32x4){0.f, 0.f, 0.f, 0.f};
    const int ibase = item & ~15;
    if (PASS == 3) {
        if (dir == 0) {
            for (int e = 0; e < seg; ++e) { const float dc = __expf(SEGT[ibase + e]); const f32x4* src = (const f32x4*)(ST + (size_t)(ibase + e) * 8192);
#pragma unroll
                for (int nt = 0; nt < 8; ++nt) S[nt] = S[nt] * dc + src[(w * 8 + nt) * 64 + lane]; }
        } else {
            for (int e = NSEG - 1; e > seg; --e) { const float dc = __expf(SEGT[ibase + e]); const f32x4* src = (const f32x4*)(ST + (size_t)(ibase + e) * 8192);
#pragma unroll
                for (int nt = 0; nt < 8; ++nt) S[nt] = S[nt] * dc + src[(w * 8 + nt) * 64 + lane]; }
        }
#pragma unroll
        for (int nt = 0; nt < 8; ++nt) st4bf(Sb + (16 * w + idx) * 136 + 16 * nt + 4 * kq, S[nt]);
    }
    float segtot = 0.f;
    for (int si = 0; si < NSUB; ++si) {
        const int scn = dir ? (NSUB - 1 - si) : si;
        const int t0 = seg * SEGLEN + scn * TSUB;
        const size_t tokb = (size_t)b * SEQ;
        __syncthreads();
        if (w == 0) {
            float dtv = 0.f, av = 0.f;
            if (lane < 32) { dtv = DT[(tokb + t0 + lane) * 16 + dir * 8 + h]; av = dtv * Aneg; }
            float pre = av;
#pragma unroll
            for (int o = 1; o < 32; o <<= 1) { const float t = __shfl_up(pre, o); if (lane >= o) pre += t; }
            const float tot = __shfl(pre, 31);
            const float cc = dir ? (tot - pre + av) : pre;
            if (lane < 32) { s_dt[lane] = dtv; s_c[lane] = cc; s_rs[lane] = __expf(cc); s_wl[lane] = dtv * __expf(tot - cc); }
            if (lane == 0) s_tot[0] = tot;
        }
        __syncthreads();
        segtot += s_tot[0];
#pragma unroll 1
        for (int i = 0; i < 5; ++i) {
            const int u = tid + 256 * i, lrow = u / 40, ci = u % 40, lc = ci * 8;
            const int scol = ci < 8 ? h * 64 + lc : (ci < 24 ? 512 + grp * 128 + (lc - 64) : 768 + grp * 128 + (lc - 192));
            float a[8];
#pragma unroll
            for (int e = 0; e < 8; ++e) a[e] = cwl[5 * 320 + lc + e];
#pragma unroll
            for (int tap = 0; tap < 5; ++tap) {
                const int tt = t0 + lrow + tap - 2;
                if (tt >= 0 && tt < SEQ) {
                    const u32x4 v = *(const u32x4*)(XBC + (tokb + tt) * 1024 + scol);
                    const float* wv = cwl + tap * 320 + lc;
                    a[0] += bflo(v.x) * wv[0]; a[1] += bfhi(v.x) * wv[1]; a[2] += bflo(v.y) * wv[2]; a[3] += bfhi(v.y) * wv[3];
                    a[4] += bflo(v.z) * wv[4]; a[5] += bfhi(v.z) * wv[5]; a[6] += bflo(v.w) * wv[6]; a[7] += bfhi(v.w) * wv[7];
                }
            }
#pragma unroll
            for (int e = 0; e < 8; ++e) a[e] = siluf(a[e]);
            u32x4 o; o.x = pk2(a[0], a[1]); o.y = pk2(a[2], a[3]); o.z = pk2(a[4], a[5]); o.w = pk2(a[6], a[7]);
            if (ci < 8) {
                *(u32x4*)(Xs + lrow * 72 + lc) = o;
                const float wl = s_wl[lrow];
                u32x4 o2; o2.x = pk2(a[0] * wl, a[1] * wl); o2.y = pk2(a[2] * wl, a[3] * wl); o2.z = pk2(a[4] * wl, a[5] * wl); o2.w = pk2(a[6] * wl, a[7] * wl);
                *(u32x4*)(Xws + lrow * 72 + lc) = o2;
            } else if (ci < 24) *(u32x4*)(Bs + lrow * 136 + (lc - 64)) = o;
            else *(u32x4*)(Cs + lrow * 136 + (lc - 192)) = o;
        }
        __syncthreads();
        if (PASS == 3) {
            const int it = w >> 1, jt = w & 1;
            f32x4 cb = (f32x4){0.f, 0.f, 0.f, 0.f};
#pragma unroll
            for (int ks = 0; ks < 4; ++ks) {
                const bf16x8 fb = *(const bf16x8*)(Bs + (16 * jt + idx) * 136 + ks * 32 + kq * 8);
                const bf16x8 fc = *(const bf16x8*)(Cs + (16 * it + idx) * 136 + ks * 32 + kq * 8);
                cb = __builtin_amdgcn_mfma_f32_16x16x32_bf16(fb, fc, cb, 0, 0, 0);
            }
            {
                const int ii = 16 * it + idx; const float ci_ = s_c[ii];
                f32x4 gv;
#pragma unroll
                for (int rg = 0; rg < 4; ++rg) {
                    const int jj = 16 * jt + 4 * kq + rg;
                    const bool ok = dir ? (jj >= ii) : (jj <= ii);
                    const float e = __expf(ci_ - s_c[jj]) * s_dt[jj];
                    gv[rg] = ok ? cb[rg] * e : 0.f;
                }
                st4bf(Gs + ii * 40 + 16 * jt + 4 * kq, gv);
            }
            __syncthreads();
            const unsigned char* xtr = (const unsigned char*)Xs + (8 * kq + (idx >> 2)) * 144 + (16 * w + 4 * (idx & 3)) * 2;
            const bf16x8 xf = cat8(tr16(xtr), tr16(xtr + 4 * 144));
#pragma unroll
            for (int it2 = 0; it2 < 2; ++it2) {
                const int ii = 16 * it2 + idx;
                const bf16x8 gf = *(const bf16x8*)(Gs + ii * 40 + 8 * kq);
                f32x4 yd = (f32x4){0.f, 0.f, 0.f, 0.f}, yo = (f32x4){0.f, 0.f, 0.f, 0.f};
                yd = __builtin_amdgcn_mfma_f32_16x16x32_bf16(xf, gf, yd, 0, 0, 0);
#pragma unroll
                for (int ks = 0; ks < 4; ++ks) {
                    const bf16x8 sf = *(const bf16x8*)(Sb + (16 * w + idx) * 136 + ks * 32 + kq * 8);
                    const bf16x8 cf = *(const bf16x8*)(Cs + ii * 136 + ks * 32 + kq * 8);
                    yo = __builtin_amdgcn_mfma_f32_16x16x32_bf16(sf, cf, yo, 0, 0, 0);
                }
                f32x4 y = yd + yo * s_rs[ii];
                if (dir == 0) { const u32x2 xv = *(const u32x2*)(Xs + ii * 72 + 16 * w + 4 * kq);
                    y.x += Dh * bflo(xv.x); y.y += Dh * bfhi(xv.x); y.z += Dh * bflo(xv.y); y.w += Dh * bfhi(xv.y); }
                st4bf(Y + (tokb + t0 + ii) * 512 + h * 64 + 16 * w + 4 * kq, y);
            }
        }
        {
            const float dc = __expf(s_tot[0]);
            const unsigned char* xw = (const unsigned char*)Xws + (8 * kq + (idx >> 2)) * 144 + (16 * w + 4 * (idx & 3)) * 2;
            const bf16x8 xwf = cat8(tr16(xw), tr16(xw + 4 * 144));
#pragma unroll
            for (int nt = 0; nt < 8; ++nt) {
                const unsigned char* bt = (const unsigned char*)Bs + (8 * kq + (idx >> 2)) * 272 + (16 * nt + 4 * (idx & 3)) * 2;
                const bf16x8 bf = cat8(tr16(bt), tr16(bt + 4 * 272));
                S[nt] = __builtin_amdgcn_mfma_f32_16x16x32_bf16(bf, xwf, S[nt] * dc, 0, 0, 0);
            }
            if (PASS == 3) {
#pragma unroll
                for (int nt = 0; nt < 8; ++nt) st4bf(Sb + (16 * w + idx) * 136 + 16 * nt + 4 * kq, S[nt]);
            }
        }
    }
    if (PASS == 1) {
        f32x4* dst = (f32x4*)(ST + (size_t)item * 8192);
#pragma unroll
        for (int nt = 0; nt < 8; ++nt) dst[(w * 8 + nt) * 64 + lane] = S[nt];
        if (tid == 0) SEGT[item] = segtot;
    }
}

__device__ void post2_phase(const Params& p) {
    const int lane = threadIdx.x & 63, gw = blockIdx.x * 4 + (threadIdx.x >> 6), nw = gridDim.x * 4;
    const bf16_t* OB = (const bf16_t*)(p.ws + WS_QB); const float* LSE = (const float*)(p.ws + WS_LSE);
    const bf16_t* GB = (const bf16_t*)(p.ws + WS_GB);
    bf16_t* YBM = (bf16_t*)(p.ws + WS_YBM);
    const bf16_t* YF = (const bf16_t*)(p.ws + WS_YF); const bf16_t* YS = (const bf16_t*)(p.ws + WS_YS); const bf16_t* ZS = (const bf16_t*)(p.ws + WS_ZS);
    bf16_t* YC = (bf16_t*)(p.ws + WS_YC); float* RS = (float*)(p.ws + WS_RSTD);
    for (int row = gw; row < TP; row += nw) {
        const int bl = row >> 13, tt = row & (SEQ - 1), j = lane >> 4;
        float ls[3]; size_t ro[3];
#pragma unroll
        for (int g = 0; g < 3; ++g) { const int sh = 2 * g; const int pp = (tt & ((1 << sh) - 1)) * (SEQ >> sh) + (tt >> sh);
            ro[g] = (size_t)(bl * 3 + g) * SEQ + pp; ls[g] = LSE[ro[g] * 4 + j]; }
        const float mx = fmaxf(ls[0], fmaxf(ls[1], ls[2]));
        float wg[3]; float ws = 0.f;
#pragma unroll
        for (int g = 0; g < 3; ++g) { wg[g] = __expf(ls[g] - mx); ws += wg[g]; }
        const float inv = 1.f / ws;
        f32x4 acc = (f32x4){0.f, 0.f, 0.f, 0.f};
#pragma unroll
        for (int g = 0; g < 3; ++g) { const u32x2 v = *(const u32x2*)(OB + ro[g] * 256 + 4 * lane); const float wv = wg[g] * inv;
            acc.x += wv * bflo(v.x); acc.y += wv * bfhi(v.x); acc.z += wv * bflo(v.y); acc.w += wv * bfhi(v.y); }
        { const u32x2 gt = *(const u32x2*)(GB + (size_t)row * 256 + 4 * lane);
          acc.x *= bflo(gt.x); acc.y *= bfhi(gt.x); acc.z *= bflo(gt.y); acc.w *= bfhi(gt.y); }
        st4bf(YBM + (size_t)row * 256 + 4 * lane, acc);
        const u32x4 a = *(const u32x4*)(YF + (size_t)row * 512 + 8 * lane), bq = *(const u32x4*)(YS + (size_t)row * 512 + 8 * lane), z = *(const u32x4*)(ZS + (size_t)row * 512 + 8 * lane);
        float y[8];
        y[0] = (bflo(a.x) + bflo(bq.x)) * bflo(z.x); y[1] = (bfhi(a.x) + bfhi(bq.x)) * bfhi(z.x);
        y[2] = (bflo(a.y) + bflo(bq.y)) * bflo(z.y); y[3] = (bfhi(a.y) + bfhi(bq.y)) * bfhi(z.y);
        y[4] = (bflo(a.z) + bflo(bq.z)) * bflo(z.z); y[5] = (bfhi(a.z) + bfhi(bq.z)) * bfhi(z.z);
        y[6] = (bflo(a.w) + bflo(bq.w)) * bflo(z.w); y[7] = (bfhi(a.w) + bfhi(bq.w)) * bfhi(z.w);
        float ss = 0.f;
#pragma unroll
        for (int e = 0; e < 8; ++e) ss += y[e] * y[e];
        ss = wave_sum(ss);
        u32x4 o; o.x = pk2(y[0], y[1]); o.y = pk2(y[2], y[3]); o.z = pk2(y[4], y[5]); o.w = pk2(y[6], y[7]);
        *(u32x4*)(YC + (size_t)row * 512 + 8 * lane) = o;
        if (lane == 0) RS[row] = rsqrtf(ss * (1.f / 512.f) + EPS);
    }
}


#define XB_TMO      128
#define XB_XCNT(j)  (256  + 64 * (j))
#define XB_XSUB(j)  (1280 + 64 * (j))
#define XB_XGEN(j)  (2304 + 64 * (j))
#define XB_TOP      3328
#define XB_TOPGEN   3392
#define XCD_BAR_WORDS 3456
#define XB_SPIN_CAP (1u << 20)
__device__ __forceinline__ unsigned xb_ld(unsigned* p)              { return __hip_atomic_load(p, __ATOMIC_RELAXED, __HIP_MEMORY_SCOPE_AGENT); }
__device__ __forceinline__ unsigned xb_add(unsigned* p, unsigned v) { return __hip_atomic_fetch_add(p, v, __ATOMIC_RELAXED, __HIP_MEMORY_SCOPE_AGENT); }
__device__ __forceinline__ unsigned xb_xcc_id() { return (unsigned)__builtin_amdgcn_s_getreg((3 << 11) | 20) & 0xFu; }
#define XB_SPIN(cond, bar) do { unsigned _sp = 0; while (cond) { __builtin_amdgcn_s_sleep(1); \
    if ((++_sp & 255u) == 0u) { if (xb_ld(&(bar)[XB_TMO])) break; if (_sp > XB_SPIN_CAP) { atomicAdd(&(bar)[XB_TMO], 1u); break; } } } } while (0)
struct XcdBarrier { unsigned* bar; unsigned x; volatile LDSAS unsigned* st; };
__device__ __forceinline__ XcdBarrier xcd_barrier_post(unsigned* bar, volatile LDSAS unsigned* st) {
    XcdBarrier b; b.bar = bar; b.x = xb_xcc_id(); b.st = st;
    if (threadIdx.x == 0) (void)xb_add(&bar[XB_XCNT(b.x)], 1u);
    return b;
}
__device__ __forceinline__ void xcd_barrier_complete(unsigned* bar, unsigned x, unsigned& nloc, unsigned& nx) {
    const unsigned G = gridDim.x * gridDim.y * gridDim.z;
    unsigned sum, cnt, mine, sp = 0u;
    for (;;) {
        sum = 0u; cnt = 0u; mine = 0u;
#pragma unroll
        for (unsigned j = 0; j < 16; ++j) { const unsigned c = xb_ld(&bar[XB_XCNT(j)]); sum += c; cnt += (c > 0u) ? 1u : 0u; mine = (j == x) ? c : mine; }
        if (sum == G) break;
        __builtin_amdgcn_s_sleep(1);
        if ((++sp & 255u) == 0u) { if (xb_ld(&bar[XB_TMO])) break; if (sp > XB_SPIN_CAP) { atomicAdd(&bar[XB_TMO], 1u); break; } }
    }
    nloc = mine > 0u ? mine : 1u; nx = cnt > 0u ? cnt : 1u;
}
__device__ __forceinline__ void xcd_barrier(const XcdBarrier& b) {
    asm volatile("s_waitcnt vmcnt(0)" ::: "memory");
    __syncthreads();
    if (threadIdx.x == 0) {
        unsigned* bar = b.bar;
        __builtin_amdgcn_s_waitcnt(0);
        unsigned nloc = b.st[0], nx = b.st[1];
        if (nloc == 0u) { xcd_barrier_complete(bar, b.x, nloc, nx); b.st[0] = nloc; b.st[1] = nx; }
        const unsigned old = xb_add(&bar[XB_XSUB(b.x)], 1u);
        const unsigned gen = old / nloc;
        if (old + 1u == (gen + 1u) * nloc) {
            __builtin_amdgcn_fence(__ATOMIC_RELEASE, "agent");
            asm volatile("s_waitcnt vmcnt(0)" ::: "memory");
            const unsigned og = xb_add(&bar[XB_TOP], 1u);
            const unsigned tg = og / nx;
            if (og + 1u == (tg + 1u) * nx) xb_add(&bar[XB_TOPGEN], 1u);
            else XB_SPIN(xb_ld(&bar[XB_TOPGEN]) == tg, bar);
            __builtin_amdgcn_fence(__ATOMIC_ACQUIRE, "agent");
            xb_add(&bar[XB_XGEN(b.x)], 1u);
            asm volatile("s_waitcnt vmcnt(0)" ::: "memory");
        } else {
            XB_SPIN(xb_ld(&bar[XB_XGEN(b.x)]) == gen, bar);
            __builtin_amdgcn_fence(__ATOMIC_ACQUIRE, "agent");
            asm volatile("s_waitcnt vmcnt(0)" ::: "memory");
        }
    }
    __syncthreads();
}

constexpr int SMEM_BYTES = 65536;
__global__ void __launch_bounds__(256, 2) hybrid_fwd(Params p) {
    cg::grid_group grid = cg::this_grid();
    __shared__ __attribute__((aligned(16))) unsigned char smem[SMEM_BYTES + 16];
    volatile LDSAS unsigned* bst = (volatile LDSAS unsigned*)(smem + SMEM_BYTES);
    if (threadIdx.x < 4) bst[threadIdx.x] = 0u;
    __syncthreads();
    const XcdBarrier xbar = xcd_barrier_post((unsigned*)(p.ws + WS_BAR), bst);
    { const Params q = launder(p); phase0(q, smem); }
    grid.sync();
#pragma unroll 1
    for (int l = 0; l < DEPTH; ++l) {
#pragma unroll 1
        for (int hb = 0; hb < 2; ++hb) {
            { const Params q = launder(p); norm_phase(q, l, hb, (l == 0) ? q.x : q.out); }
            xcd_barrier(xbar);
            { const Params q = launder(p); gemm1_phase(q, l, hb, smem); }
            xcd_barrier(xbar);
            { const Params q = launder(p);
#pragma unroll 1
              for (int it = blockIdx.x; it < 512 + 1536; it += gridDim.x) { if (it < 512) ssd_item<1>(q, it, l, smem); else attn_b_item(q, it - 512, l, smem); } }
            xcd_barrier(xbar);
            { const Params q = launder(p);
#pragma unroll 1
              for (int it = blockIdx.x; it < 1024 + 512; it += gridDim.x) { if (it < 1024) attn_a_item(q, it, l, smem); else ssd_item<3>(q, it - 1024, l, smem); } }
            xcd_barrier(xbar);
            { const Params q = launder(p); post2_phase(q); }
            xcd_barrier(xbar);
            { const Params q = launder(p); merge_phase(q, l, smem); }
            xcd_barrier(xbar);
            { const Params q = launder(p); out_phase(q, l, hb, (l == 0) ? q.x : q.out, smem); }
            xcd_barrier(xbar);
        }
    }
}

extern "C" void kernel_launch(void* const* d_in, const int* in_sizes, int n_in, void* d_out, int out_size, void* d_ws, size_t ws_size, hipStream_t stream) {
    static int grid_blocks = 0;
    if (!grid_blocks) {
        int dev = 0, cus = 0, per_cu = 0;
        hipGetDevice(&dev);
        hipDeviceGetAttribute(&cus, hipDeviceAttributeMultiprocessorCount, dev);
        hipOccupancyMaxActiveBlocksPerMultiprocessor(&per_cu, hybrid_fwd, 256, 0);
        if (per_cu > 2) per_cu = 2;
        if (per_cu < 1) per_cu = 1;
        grid_blocks = cus * per_cu;
    }
    Params p{};
    const float** pp = (const float**)&p;
    for (int i = 0; i < 22; ++i) pp[i] = (const float*)d_in[i];
    p.out = (float*)d_out; p.ws = (unsigned char*)d_ws;
    hipMemsetAsync((unsigned char*)d_ws + WS_BAR, 0, XCD_BAR_WORDS * 4, stream);
    void* args[] = {&p};
    hipError_t e = hipLaunchCooperativeKernel((void*)hybrid_fwd, dim3(grid_blocks), dim3(256), args, 0, stream);
    if (e != hipSuccess) fprintf(stderr, "cooperative launch failed: %s (grid %d)\n", hipGetErrorString(e), grid_blocks);
}
```

```cpp
#include <hip/hip_runtime.h>
#include <hip/hip_cooperative_groups.h>
#include <cstdint>
#include <cstdio>
namespace cg = cooperative_groups;

typedef unsigned short bf16_t;
typedef short bf16x8 __attribute__((ext_vector_type(8)));
typedef short v4i16 __attribute__((ext_vector_type(4)));
typedef float f32x2 __attribute__((ext_vector_type(2)));
typedef float f32x4 __attribute__((ext_vector_type(4)));
typedef float f32x16 __attribute__((ext_vector_type(16)));
typedef unsigned u32x2 __attribute__((ext_vector_type(2)));
typedef unsigned u32x4 __attribute__((ext_vector_type(4)));
typedef __bf16 bf16x2_t __attribute__((ext_vector_type(2)));
#define LDSAS __attribute__((address_space(3)))

constexpr int SEQ = 8192, DM = 1024, NBATCH = 4, NBH = 2, TP = NBH * SEQ, DEPTH = 2;
constexpr int NP = 8576;
constexpr float EPS = 1e-6f;
constexpr float LOG2E = 1.4426950408889634f, LN2 = 0.6931471805599453f;
constexpr int NSEG = 16, SEGLEN = 512, TSUB = 32, NSUB = SEGLEN / TSUB;

constexpr size_t MiB = 1u << 20;
constexpr size_t WS_WIN = 0;
constexpr size_t WS_WPA = 34 * MiB;
constexpr size_t WS_WPB = 36 * MiB;
constexpr size_t WS_WPC = 37 * MiB;
constexpr size_t WS_WOUT = 39 * MiB;
constexpr size_t WS_MOD = 43 * MiB;
constexpr size_t WS_ROPE = 43 * MiB + 128 * 1024;
constexpr size_t WS_BND = 43 * MiB + 160 * 1024;
constexpr size_t WS_RSTD = 43 * MiB + 256 * 1024;
constexpr size_t WS_SEGT = 43 * MiB + 512 * 1024;
constexpr size_t WS_LSE = 44 * MiB;
constexpr size_t WS_DT = 45 * MiB;
constexpr size_t WS_BAR = 46 * MiB;
constexpr size_t WS_H = 48 * MiB;
constexpr size_t WS_QA = 80 * MiB;
constexpr size_t WS_KA = 96 * MiB;
constexpr size_t WS_VA = 100 * MiB;
constexpr size_t WS_GA = 104 * MiB;
constexpr size_t WS_QB = 120 * MiB;
constexpr size_t WS_KB = 144 * MiB;
constexpr size_t WS_VB = 168 * MiB;
constexpr size_t WS_GB = 192 * MiB;
constexpr size_t WS_XBC = 200 * MiB;
constexpr size_t WS_ZS = 232 * MiB;
constexpr size_t WS_MG = 248 * MiB;
constexpr size_t WS_YF = 344 * MiB;
constexpr size_t WS_YS = 360 * MiB;
constexpr size_t WS_YBM = 376 * MiB;
constexpr size_t WS_YC = 384 * MiB;
constexpr size_t WS_MRG = 400 * MiB;
constexpr size_t WS_ST = 432 * MiB;

struct Params {
    const float *x, *c, *norm_w, *w_ada, *b_ada, *w_in, *b_gate, *q_norm_a, *k_norm_a, *q_norm_b, *k_norm_b, *rel_bias,
        *conv_w, *conv_b, *a_log, *dt_bias, *d_skip, *ssm_norm_w, *w_proj_a, *w_proj_b, *w_proj_c, *w_out;
    float* out;
    unsigned char* ws;
};


#define AS1 __attribute__((address_space(1)))
#define GLOBF(f) do { AS1 const float* g_ = (AS1 const float*)p.f; asm volatile("" : "+s"(g_)); q.f = (const float*)g_; } while (0)
__device__ __forceinline__ Params launder(const Params& p) {
    Params q;
    GLOBF(x); GLOBF(c); GLOBF(norm_w); GLOBF(w_ada); GLOBF(b_ada); GLOBF(w_in); GLOBF(b_gate); GLOBF(q_norm_a); GLOBF(k_norm_a); GLOBF(q_norm_b); GLOBF(k_norm_b); GLOBF(rel_bias);
    GLOBF(conv_w); GLOBF(conv_b); GLOBF(a_log); GLOBF(dt_bias); GLOBF(d_skip); GLOBF(ssm_norm_w); GLOBF(w_proj_a); GLOBF(w_proj_b); GLOBF(w_proj_c); GLOBF(w_out);
    { AS1 float* g_ = (AS1 float*)p.out; asm volatile("" : "+s"(g_)); q.out = (float*)g_; }
    { AS1 unsigned char* g_ = (AS1 unsigned char*)p.ws; asm volatile("" : "+s"(g_)); q.ws = (unsigned char*)g_; }
    return q;
}
__device__ __forceinline__ unsigned pk2(float lo, float hi) { f32x2 v = {lo, hi}; bf16x2_t b = __builtin_convertvector(v, bf16x2_t); return __builtin_bit_cast(unsigned, b); }
__device__ __forceinline__ float bf2f(unsigned short b) { return __uint_as_float(((unsigned)b) << 16); }
__device__ __forceinline__ float bflo(unsigned u) { return __uint_as_float(u << 16); }
__device__ __forceinline__ float bfhi(unsigned u) { return __uint_as_float(u & 0xffff0000u); }
__device__ __forceinline__ float siluf(float v) { return v / (1.f + __expf(-v)); }
__device__ __forceinline__ float sigmf(float v) { return 1.f / (1.f + __expf(-v)); }
__device__ __forceinline__ float wave_sum(float v) {
#pragma unroll
    for (int o = 1; o < 64; o <<= 1) v += __shfl_xor(v, o);
    return v;
}
__device__ __forceinline__ v4i16 tr16(const unsigned char* p) { return __builtin_amdgcn_ds_read_tr16_b64_v4i16((LDSAS v4i16*)p); }
__device__ __forceinline__ bf16x8 cat8(v4i16 a, v4i16 b) { return (bf16x8){a[0], a[1], a[2], a[3], b[0], b[1], b[2], b[3]}; }
__device__ __forceinline__ int crow(int r, int hi) { return (r & 3) + 8 * (r >> 2) + 4 * hi; }

__device__ __forceinline__ void p0_transpose(const float* __restrict__ W, int ldw, int K, bf16_t* __restrict__ Wt, int k0, int n0, int mode,
                                             const float* __restrict__ rowscale, float* tile) {
    const int tid = threadIdx.x, tx = tid & 63, ty = tid >> 6;
    const int np = n0 + tx; int n = np; bool valid = true;
    if (mode == 1) {
        if (np < 4352) n = np; else if (np < 4864) n = np + 512; else if (np < 5376) n = np - 512;
        else if (np < 8448) n = np + 16; else if (np < 8464) n = np - 3072; else { valid = false; n = 0; }
    }
#pragma unroll 4
    for (int i = 0; i < 16; ++i) {
        const int k = ty + 4 * i; float v = valid ? W[(size_t)(k0 + k) * ldw + n] : 0.f;
        if (rowscale) v *= rowscale[k0 + k];
        tile[k * 65 + tx] = v;
    }
    __syncthreads();
    const int r = tid >> 2, kc = (tid & 3) * 16;
    u32x4 o0, o1;
    o0.x = pk2(tile[(kc + 0) * 65 + r], tile[(kc + 1) * 65 + r]); o0.y = pk2(tile[(kc + 2) * 65 + r], tile[(kc + 3) * 65 + r]);
    o0.z = pk2(tile[(kc + 4) * 65 + r], tile[(kc + 5) * 65 + r]); o0.w = pk2(tile[(kc + 6) * 65 + r], tile[(kc + 7) * 65 + r]);
    o1.x = pk2(tile[(kc + 8) * 65 + r], tile[(kc + 9) * 65 + r]); o1.y = pk2(tile[(kc + 10) * 65 + r], tile[(kc + 11) * 65 + r]);
    o1.z = pk2(tile[(kc + 12) * 65 + r], tile[(kc + 13) * 65 + r]); o1.w = pk2(tile[(kc + 14) * 65 + r], tile[(kc + 15) * 65 + r]);
    bf16_t* dst = Wt + (size_t)(n0 + r) * K + k0 + kc;
    *(u32x4*)dst = o0; *(u32x4*)(dst + 8) = o1;
    __syncthreads();
}

__device__ void phase0(const Params& p, unsigned char* smem) {
    const int tid = threadIdx.x;
    float* tile = (float*)smem;
    constexpr int I_IN = 16 * 134, I_PA = 8 * 16, I_PB = 4 * 16, I_PC = 8 * 16, I_OUT = 16 * 16, I_L = I_IN + I_PA + I_PB + I_PC + I_OUT;
    constexpr int I_T = 2 * I_L, I_MOD = 192, I_ALL = I_T + I_MOD + 1;
    for (int item = blockIdx.x; item < I_ALL; item += gridDim.x) {
        if (item < I_T) {
            const int l = item / I_L; int r = item % I_L;
            if (r < I_IN) { const int kt = r / 134, nt = r % 134;
                p0_transpose(p.w_in + (size_t)l * 1024 * 8464, 8464, 1024, (bf16_t*)(p.ws + WS_WIN) + (size_t)l * NP * 1024, kt * 64, nt * 64, 1, nullptr, tile); continue; }
            r -= I_IN;
            if (r < I_PA) { const int kt = r / 16, nt = r % 16;
                p0_transpose(p.w_proj_a + (size_t)l * 512 * 1024, 1024, 512, (bf16_t*)(p.ws + WS_WPA) + (size_t)l * 1024 * 512, kt * 64, nt * 64, 0, nullptr, tile); continue; }
            r -= I_PA;
            if (r < I_PB) { const int kt = r / 16, nt = r % 16;
                p0_transpose(p.w_proj_b + (size_t)l * 256 * 1024, 1024, 256, (bf16_t*)(p.ws + WS_WPB) + (size_t)l * 1024 * 256, kt * 64, nt * 64, 0, nullptr, tile); continue; }
            r -= I_PB;
            if (r < I_PC) { const int kt = r / 16, nt = r % 16;
                p0_transpose(p.w_proj_c + (size_t)l * 512 * 1024, 1024, 512, (bf16_t*)(p.ws + WS_WPC) + (size_t)l * 1024 * 512, kt * 64, nt * 64, 0, p.ssm_norm_w + l * 512, tile); continue; }
            r -= I_PC;
            { const int kt = r / 16, nt = r % 16;
                p0_transpose(p.w_out + (size_t)l * 1024 * 1024, 1024, 1024, (bf16_t*)(p.ws + WS_WOUT) + (size_t)l * 1024 * 1024, kt * 64, nt * 64, 0, nullptr, tile); }
        } else if (item < I_T + I_MOD) {
            const int it = item - I_T, l = it / 96, col0 = (it % 96) * 32, cl = tid & 31, ks = tid >> 5;
            float a0 = 0.f, a1 = 0.f, a2 = 0.f, a3 = 0.f;
            const float* wp = p.w_ada + ((size_t)l * 1024 + ks * 128) * 3072 + col0 + cl;
#pragma unroll 8
            for (int k = 0; k < 128; ++k) {
                const float wv = wp[(size_t)k * 3072]; const int kk = ks * 128 + k;
                a0 += siluf(p.c[kk]) * wv; a1 += siluf(p.c[1024 + kk]) * wv; a2 += siluf(p.c[2048 + kk]) * wv; a3 += siluf(p.c[3072 + kk]) * wv;
            }
            float* red = (float*)smem;
            red[(ks * 32 + cl) * 4 + 0] = a0; red[(ks * 32 + cl) * 4 + 1] = a1; red[(ks * 32 + cl) * 4 + 2] = a2; red[(ks * 32 + cl) * 4 + 3] = a3;
            __syncthreads();
            if (tid < 128) { const int b = tid >> 5, c2 = tid & 31; float s = 0.f;
#pragma unroll
                for (int k = 0; k < 8; ++k) s += red[(k * 32 + c2) * 4 + b];
                ((float*)(p.ws + WS_MOD))[(l * 4 + b) * 3072 + col0 + c2] = s + p.b_ada[l * 3072 + col0 + c2]; }
            __syncthreads();
        } else {
            float* rc = (float*)(p.ws + WS_ROPE); float* rs = rc + 128 * 16;
            for (int e = tid; e < 2048; e += 256) {
                const int pos = e >> 4, i = e & 15;
                const float freq = powf(10000.0f, -(float)i / 16.0f);
                const float ang = (float)pos * freq;
                const double rev = (double)ang * 0.15915494309189535; const double fr = rev - rint(rev);
                const float a = (float)(fr * 6.283185307179586);
                rc[e] = cosf(a); rs[e] = sinf(a);
            }
            if (tid < 2) {
                const int l = tid; float mqa = 0.f, mka = 0.f, mqb = 0.f, mkb = 0.f, mb = 0.f;
                for (int i = 0; i < 64; ++i) { mqa = fmaxf(mqa, fabsf(p.q_norm_a[l * 64 + i])); mka = fmaxf(mka, fabsf(p.k_norm_a[l * 64 + i]));
                    mqb = fmaxf(mqb, fabsf(p.q_norm_b[l * 64 + i])); mkb = fmaxf(mkb, fabsf(p.k_norm_b[l * 64 + i])); }
                for (int i = 0; i < 32 * 12; ++i) mb = fmaxf(mb, p.rel_bias[i]);
                float* bd = (float*)(p.ws + WS_BND);
                bd[l] = 8.f * mqa * mka * LOG2E; bd[2 + l] = (8.f * mqb * mkb + mb) * LOG2E;
            }
        }
    }
}

__device__ void norm_phase(const Params& p, int l, int hb, const float* xsrc) {
    const int lane = threadIdx.x & 63, gw = blockIdx.x * 4 + (threadIdx.x >> 6), nw = gridDim.x * 4;
    bf16_t* H = (bf16_t*)(p.ws + WS_H);
    const float* nwp = p.norm_w + l * 1024;
    for (int row = gw; row < TP; row += nw) {
        const size_t rg = (size_t)hb * TP + row; const int b = (int)(rg / SEQ);
        const f32x4* xr = (const f32x4*)(xsrc + rg * 1024);
        const float* md = (const float*)(p.ws + WS_MOD) + (size_t)(l * 4 + b) * 3072;
        f32x4 v[4]; float ss = 0.f;
#pragma unroll
        for (int j = 0; j < 4; ++j) { v[j] = xr[lane + 64 * j]; ss += v[j].x * v[j].x + v[j].y * v[j].y + v[j].z * v[j].z + v[j].w * v[j].w; }
        ss = wave_sum(ss); const float rstd = rsqrtf(ss * (1.f / 1024.f) + EPS);
#pragma unroll
        for (int j = 0; j < 4; ++j) {
            const int col = 4 * (lane + 64 * j);
            const f32x4 w4 = *(const f32x4*)(nwp + col), sh = *(const f32x4*)(md + col), sc = *(const f32x4*)(md + 1024 + col);
            const f32x4 o = v[j] * rstd * w4 * (1.f + sc) + sh;
            u32x2 pk; pk.x = pk2(o.x, o.y); pk.y = pk2(o.z, o.w);
            *(u32x2*)(H + (size_t)row * 1024 + col) = pk;
        }
    }
}

constexpr int G_STAGE = 32768, G_AB = 16384;
__device__ __forceinline__ void gemm_core(const bf16_t* __restrict__ A, int lda, const bf16_t* __restrict__ Bt, int ldb, int K, f32x4 (&acc)[4][4], unsigned char* smem, int tid) {
    asm volatile("" : "+v"(tid));
    const int lane = tid & 63, w = __builtin_amdgcn_readfirstlane(tid >> 6), wm = w >> 1, wn = w & 1, idx = lane & 15, kq = lane >> 4;
    unsigned offA[4], offB[4];
#pragma unroll
    for (int j = 0; j < 4; ++j) { const int row = (j * 4 + w) * 8 + (lane >> 3), c = (lane & 7) ^ ((row >> 1) & 7);
        offA[j] = (unsigned)(row * lda + c * 8) * 2u; offB[j] = (unsigned)(row * ldb + c * 8) * 2u; }
#pragma unroll
    for (int mi = 0; mi < 4; ++mi)
#pragma unroll
        for (int ni = 0; ni < 4; ++ni) acc[mi][ni] = (f32x4){0.f, 0.f, 0.f, 0.f};
    LDSAS unsigned char* lds = (LDSAS unsigned char*)smem;
#define G_ISSUE(kt, st) do { _Pragma("unroll") for (int j = 0; j < 4; ++j) { \
        __builtin_amdgcn_global_load_lds((const unsigned*)((const char*)A + offA[j] + (kt) * 128), (LDSAS unsigned*)(lds + (st) * G_STAGE + (j * 4 + w) * 1024), 16, 0, 0); \
        __builtin_amdgcn_global_load_lds((const unsigned*)((const char*)Bt + offB[j] + (kt) * 128), (LDSAS unsigned*)(lds + (st) * G_STAGE + G_AB + (j * 4 + w) * 1024), 16, 0, 0); } } while (0)
    const int nk = K >> 6;
    G_ISSUE(0, 0);
    asm volatile("s_waitcnt vmcnt(0)" ::: "memory");
    __syncthreads();
    const int swz = (idx >> 1) & 7;
    const int aoff = (wm * 64 + idx) * 128, boff = G_AB + (wn * 64 + idx) * 128;
    for (int kt = 0; kt < nk; ++kt) {
        const int st = kt & 1;
        if (kt + 1 < nk) G_ISSUE(kt + 1, st ^ 1);
        const unsigned char* sb = smem + st * G_STAGE;
#pragma unroll
        for (int ks = 0; ks < 2; ++ks) {
            bf16x8 af[4], bfr[4];
            const int co = ((ks * 4 + kq) ^ swz) * 16;
#pragma unroll
            for (int mi = 0; mi < 4; ++mi) af[mi] = *(const bf16x8*)(sb + aoff + mi * 2048 + co);
#pragma unroll
            for (int ni = 0; ni < 4; ++ni) bfr[ni] = *(const bf16x8*)(sb + boff + ni * 2048 + co);
#pragma unroll
            for (int mi = 0; mi < 4; ++mi)
#pragma unroll
                for (int ni = 0; ni < 4; ++ni) acc[mi][ni] = __builtin_amdgcn_mfma_f32_16x16x32_bf16(bfr[ni], af[mi], acc[mi][ni], 0, 0, 0);
        }
        asm volatile("s_waitcnt vmcnt(0)" ::: "memory");
        __syncthreads();
    }
#undef G_ISSUE
}

__device__ __forceinline__ void st4bf(bf16_t* dst, f32x4 v) { u32x2 pk; pk.x = pk2(v.x, v.y); pk.y = pk2(v.z, v.w); *(u32x2*)dst = pk; }

__device__ void gemm1_phase(const Params& p, int l, int hb, unsigned char* smem) {
    const bf16_t* H = (const bf16_t*)(p.ws + WS_H);
    const bf16_t* Wt = (const bf16_t*)(p.ws + WS_WIN) + (size_t)l * NP * 1024;
    const float* ropec = (const float*)(p.ws + WS_ROPE); const float* ropes = ropec + 2048;
    constexpr int NT = 67, NTILES = 128 * NT, GRP = 8 * NT;
    for (int t = blockIdx.x; t < NTILES; t += gridDim.x) {
        const int grp = t / GRP, r = t % GRP, mt = grp * 8 + (r & 7), nt = r >> 3;
        const int m0 = mt * 128, n0 = nt * 128;
        f32x4 acc[4][4];
        int tid = threadIdx.x;
        gemm_core(H + (size_t)m0 * 1024, 1024, Wt + (size_t)n0 * 1024, 1024, 1024, acc, smem, tid);
        asm volatile("" : "+v"(tid));
        const int lane = tid & 63, w = tid >> 6, wm = w >> 1, wn = w & 1, idx = lane & 15, kq = lane >> 4;
        const int cw = n0 + wn * 64;
        const int lc = 4 * kq;
        if (cw < 768 && (cw < 640)) {
            const bool isq = cw < 512;
            const float* nwp = (isq ? p.q_norm_a : p.k_norm_a) + l * 64;
            bf16_t* dst = isq ? (bf16_t*)(p.ws + WS_QA) : (bf16_t*)(p.ws + WS_KA);
            const int pitch = isq ? 512 : 128, c0 = isq ? cw : cw - 512;
            const float qs = isq ? 0.125f * LOG2E : 1.f;
#pragma unroll
            for (int mi = 0; mi < 4; ++mi) {
                const int row = m0 + wm * 64 + mi * 16 + idx;
                float ss = 0.f;
#pragma unroll
                for (int ni = 0; ni < 4; ++ni) { const f32x4 v = acc[mi][ni]; ss += v.x * v.x + v.y * v.y + v.z * v.z + v.w * v.w; }
                ss += __shfl_xor(ss, 16); ss += __shfl_xor(ss, 32);
                const float rstd = rsqrtf(ss * (1.f / 64.f) + EPS);
                f32x4 y[4];
#pragma unroll
                for (int ni = 0; ni < 4; ++ni) y[ni] = acc[mi][ni] * rstd * *(const f32x4*)(nwp + ni * 16 + lc);
                const int tt = row & (SEQ - 1), prow = tt >> 6, pcol = tt & 63;
#pragma unroll
                for (int hf = 0; hf < 2; ++hf) {
                    const int pos = hf ? pcol : prow;
                    const f32x4 cs = *(const f32x4*)(ropec + pos * 16 + lc), sn = *(const f32x4*)(ropes + pos * 16 + lc);
                    const f32x4 a = y[2 * hf], b = y[2 * hf + 1];
                    y[2 * hf] = a * cs - b * sn; y[2 * hf + 1] = b * cs + a * sn;
                }
#pragma unroll
                for (int ni = 0; ni < 4; ++ni) st4bf(dst + (size_t)row * pitch + c0 + ni * 16 + lc, y[ni] * qs);
            }
        } else if (cw >= 1280 && cw < 2816) {
            const bool isq = cw < 2048;
            const float* nwp = (isq ? p.q_norm_b : p.k_norm_b) + l * 64;
            const int gc = isq ? cw - 1280 : cw - 2048, g = gc >> 8, c0 = gc & 255;
            const int sh = 2 * g;
            bf16_t* dst = (bf16_t*)(p.ws + (isq ? WS_QB : WS_KB));
            const float qs = isq ? 0.125f * LOG2E : 1.f;
#pragma unroll
            for (int mi = 0; mi < 4; ++mi) {
                const int row = m0 + wm * 64 + mi * 16 + idx;
                float ss = 0.f;
#pragma unroll
                for (int ni = 0; ni < 4; ++ni) { const f32x4 v = acc[mi][ni]; ss += v.x * v.x + v.y * v.y + v.z * v.z + v.w * v.w; }
                ss += __shfl_xor(ss, 16); ss += __shfl_xor(ss, 32);
                const float rstd = rsqrtf(ss * (1.f / 64.f) + EPS) * qs;
                const int bl = row >> 13, tt = row & (SEQ - 1);
                const int pp = (tt & ((1 << sh) - 1)) * (SEQ >> sh) + (tt >> sh);
                bf16_t* drow = dst + ((size_t)(bl * 3 + g) * SEQ + pp) * 256 + c0 + lc;
#pragma unroll
                for (int ni = 0; ni < 4; ++ni) st4bf(drow + ni * 16, acc[mi][ni] * rstd * *(const f32x4*)(nwp + ni * 16 + lc));
            }
        } else if (cw >= 2816 && cw < 3584) {
            const int gc = cw - 2816, g = gc >> 8, c0 = gc & 255, sh = 2 * g;
            bf16_t* dst = (bf16_t*)(p.ws + WS_VB);
#pragma unroll
            for (int mi = 0; mi < 4; ++mi) {
                const int row = m0 + wm * 64 + mi * 16 + idx;
                const int bl = row >> 13, tt = row & (SEQ - 1);
                const int pp = (tt & ((1 << sh) - 1)) * (SEQ >> sh) + (tt >> sh);
                bf16_t* drow = dst + ((size_t)(bl * 3 + g) * SEQ + pp) * 256 + c0 + lc;
#pragma unroll
                for (int ni = 0; ni < 4; ++ni) st4bf(drow + ni * 16, acc[mi][ni]);
            }
        } else if (cw >= 8448) {
            if (wn == 0) {
                float* dst = (float*)(p.ws + WS_DT);
                const f32x4 bias = *(const f32x4*)(p.dt_bias + l * 16 + lc);
#pragma unroll
                for (int mi = 0; mi < 4; ++mi) {
                    const int row = m0 + wm * 64 + mi * 16 + idx;
                    f32x4 v = acc[mi][0] + bias, o;
                    o.x = v.x > 20.f ? v.x : log1pf(__expf(v.x)); o.y = v.y > 20.f ? v.y : log1pf(__expf(v.y));
                    o.z = v.z > 20.f ? v.z : log1pf(__expf(v.z)); o.w = v.w > 20.f ? v.w : log1pf(__expf(v.w));
                    *(f32x4*)(dst + (size_t)row * 16 + lc) = o;
                }
            }
        } else {
            bf16_t* dst; int pitch, c0, mode;
            if (cw < 768) { dst = (bf16_t*)(p.ws + WS_VA); pitch = 128; c0 = cw - 640; mode = 0; }
            else if (cw < 1280) { dst = (bf16_t*)(p.ws + WS_GA); pitch = 512; c0 = cw - 768; mode = 1; }
            else if (cw < 3840) { dst = (bf16_t*)(p.ws + WS_GB); pitch = 256; c0 = cw - 3584; mode = 1; }
            else if (cw < 4864) { dst = (bf16_t*)(p.ws + WS_XBC); pitch = 1024; c0 = cw - 3840; mode = 0; }
            else if (cw < 5376) { dst = (bf16_t*)(p.ws + WS_ZS); pitch = 512; c0 = cw - 4864; mode = 1; }
            else { dst = (bf16_t*)(p.ws + WS_MG); pitch = 3072; c0 = cw - 5376; mode = 2; }
            const float* bg = p.b_gate + l * 3072 + c0 + lc;
#pragma unroll
            for (int mi = 0; mi < 4; ++mi) {
                const int row = m0 + wm * 64 + mi * 16 + idx;
#pragma unroll
                for (int ni = 0; ni < 4; ++ni) {
                    f32x4 v = acc[mi][ni];
                    if (mode == 1) { v.x = siluf(v.x); v.y = siluf(v.y); v.z = siluf(v.z); v.w = siluf(v.w); }
                    else if (mode == 2) { const f32x4 bb = *(const f32x4*)(bg + ni * 16); v.x = sigmf(v.x + bb.x); v.y = sigmf(v.y + bb.y); v.z = sigmf(v.z + bb.z); v.w = sigmf(v.w + bb.w); }
                    st4bf(dst + (size_t)row * pitch + c0 + ni * 16 + lc, v);
                }
            }
        }
    }
}

__device__ void merge_phase(const Params& p, int l, unsigned char* smem) {
    const bf16_t* MG = (const bf16_t*)(p.ws + WS_MG);
    const float* rstd = (const float*)(p.ws + WS_RSTD);
    bf16_t* MR = (bf16_t*)(p.ws + WS_MRG);
    for (int t = blockIdx.x; t < 128 * 8; t += gridDim.x) {
        const int mt = t >> 3, nt = t & 7, m0 = mt * 128, n0 = nt * 128;
#pragma unroll 1
        for (int br = 0; br < 3; ++br) {
            f32x4 acc[4][4];
            const bf16_t* A; const bf16_t* Bt; int K;
            if (br == 0) { A = (const bf16_t*)(p.ws + WS_QA); K = 512; Bt = (const bf16_t*)(p.ws + WS_WPA) + (size_t)l * 1024 * 512; }
            else if (br == 1) { A = (const bf16_t*)(p.ws + WS_YBM); K = 256; Bt = (const bf16_t*)(p.ws + WS_WPB) + (size_t)l * 1024 * 256; }
            else { A = (const bf16_t*)(p.ws + WS_YC); K = 512; Bt = (const bf16_t*)(p.ws + WS_WPC) + (size_t)l * 1024 * 512; }
            int tid = threadIdx.x;
            gemm_core(A + (size_t)m0 * K, K, Bt + (size_t)n0 * K, K, K, acc, smem, tid);
            asm volatile("" : "+v"(tid));
            const int lane = tid & 63, w = tid >> 6, wm = w >> 1, wn = w & 1, idx = lane & 15, kq = lane >> 4;
#pragma unroll
            for (int mi = 0; mi < 4; ++mi) {
                const int row = m0 + wm * 64 + mi * 16 + idx;
                const float rs = (br == 2) ? rstd[row] : 1.f;
#pragma unroll
                for (int ni = 0; ni < 4; ++ni) {
                    const int col = n0 + wn * 64 + ni * 16 + 4 * kq;
                    const u32x2 g = *(const u32x2*)(MG + (size_t)row * 3072 + br * 1024 + col);
                    f32x4 gv; gv.x = bflo(g.x); gv.y = bfhi(g.x); gv.z = bflo(g.y); gv.w = bfhi(g.y);
                    f32x4 v = gv * rs * acc[mi][ni];
                    bf16_t* mp = MR + (size_t)row * 1024 + col;
                    if (br > 0) { const u32x2 o = *(const u32x2*)mp; v.x += bflo(o.x); v.y += bfhi(o.x); v.z += bflo(o.y); v.w += bfhi(o.y); }
                    st4bf(mp, v);
                }
            }
        }
    }
}

__device__ void out_phase(const Params& p, int l, int hb, const float* xsrc, unsigned char* smem) {
    const bf16_t* MR = (const bf16_t*)(p.ws + WS_MRG);
    const bf16_t* Wt = (const bf16_t*)(p.ws + WS_WOUT) + (size_t)l * 1024 * 1024;
    for (int t = blockIdx.x; t < 128 * 8; t += gridDim.x) {
        const int mt = t >> 3, nt = t & 7, m0 = mt * 128, n0 = nt * 128;
        f32x4 acc[4][4];
        int tid = threadIdx.x;
        gemm_core(MR + (size_t)m0 * 1024, 1024, Wt + (size_t)n0 * 1024, 1024, 1024, acc, smem, tid);
        asm volatile("" : "+v"(tid));
        const int lane = tid & 63, w = tid >> 6, wm = w >> 1, wn = w & 1, idx = lane & 15, kq = lane >> 4;
#pragma unroll
        for (int mi = 0; mi < 4; ++mi) {
            const int row = m0 + wm * 64 + mi * 16 + idx; const size_t rg = (size_t)hb * TP + row; const int b = (int)(rg / SEQ);
            const float* gate = (const float*)(p.ws + WS_MOD) + (size_t)(l * 4 + b) * 3072 + 2048;
#pragma unroll
            for (int ni = 0; ni < 4; ++ni) {
                const int col = n0 + wn * 64 + ni * 16 + 4 * kq;
                const f32x4 xv = *(const f32x4*)(xsrc + rg * 1024 + col), gv = *(const f32x4*)(gate + col);
                *(f32x4*)(p.out + rg * 1024 + col) = xv + gv * acc[mi][ni];
            }
        }
    }
}

constexpr int AT_KS = 0, AT_VS = 9216, AT_LQ = 9216 + 8192, AT_LUT = AT_LQ + 512;

#define AT_STAGE_STORE() do { _Pragma("unroll") for (int i = 0; i < 2; ++i) { const int c = tid + 256 * i, row = c >> 3, ch = c & 7; \
        *(u32x4*)(Ks + row * 72 + ch * 8) = rk[i]; *(u32x4*)(Vs + (ch >> 2) * 4096 + row * 64 + (ch & 3) * 16) = rv[i]; } } while (0)

__device__ __forceinline__ void at_qk(f32x16& p0, f32x16& p1, const bf16_t* Ks, const bf16x8* qr, int r32, int hi) {
#pragma unroll
    for (int ds = 0; ds < 4; ++ds) {
        const bf16x8 k0 = *(const bf16x8*)(Ks + r32 * 72 + ds * 16 + hi * 8);
        const bf16x8 k1 = *(const bf16x8*)(Ks + (r32 + 32) * 72 + ds * 16 + hi * 8);
        p0 = __builtin_amdgcn_mfma_f32_32x32x16_bf16(k0, qr[ds], p0, 0, 0, 0);
        p1 = __builtin_amdgcn_mfma_f32_32x32x16_bf16(k1, qr[ds], p1, 0, 0, 0);
    }
}
__device__ __forceinline__ void at_pv(f32x16& o0, f32x16& o1, const f32x16& p0, const f32x16& p1, const unsigned char* Vs, int lane) {
    const int hi = lane >> 5;
    const unsigned char* vb = Vs + ((lane >> 4) & 1) * 32 + (lane & 3) * 8 + (4 * hi + ((lane & 15) >> 2)) * 64;
#pragma unroll
    for (int s = 0; s < 4; ++s) {
        u32x4 pw;
        if (s < 2) { pw.x = pk2(p0[8 * s + 0], p0[8 * s + 1]); pw.y = pk2(p0[8 * s + 2], p0[8 * s + 3]); pw.z = pk2(p0[8 * s + 4], p0[8 * s + 5]); pw.w = pk2(p0[8 * s + 6], p0[8 * s + 7]); }
        else { const int q = s - 2; pw.x = pk2(p1[8 * q + 0], p1[8 * q + 1]); pw.y = pk2(p1[8 * q + 2], p1[8 * q + 3]); pw.z = pk2(p1[8 * q + 4], p1[8 * q + 5]); pw.w = pk2(p1[8 * q + 6], p1[8 * q + 7]); }
        const bf16x8 pa = __builtin_bit_cast(bf16x8, pw);
        const bf16x8 v0 = cat8(tr16(vb + s * 1024), tr16(vb + s * 1024 + 512));
        const bf16x8 v1 = cat8(tr16(vb + 4096 + s * 1024), tr16(vb + 4096 + s * 1024 + 512));
        o0 = __builtin_amdgcn_mfma_f32_32x32x16_bf16(pa, v0, o0, 0, 0, 0);
        o1 = __builtin_amdgcn_mfma_f32_32x32x16_bf16(pa, v1, o1, 0, 0, 0);
    }
}

constexpr int ATA_STAGE = 17408, ATA_LQ = 2 * ATA_STAGE;
__device__ void attn_a_item(const Params& p, int item, int l, unsigned char* smem) {
    int tid_ = threadIdx.x; asm volatile("" : "+v"(tid_));
    const int tid = tid_, lane = tid & 63, w = tid >> 6, r32 = lane & 31, hi = lane >> 5;
    const int b = item >> 9, r = item & 511, kvh = r >> 8, qblk = (r >> 2) & 63, hq = kvh * 4 + (r & 3);
    float* lq = (float*)(smem + ATA_LQ) + w * 32;
    bf16_t* QA = (bf16_t*)(p.ws + WS_QA);
    const bf16_t* GA = (const bf16_t*)(p.ws + WS_GA);
    const size_t tokq = (size_t)b * SEQ + qblk * 128 + w * 32;
    bf16x8 qr[4];
#pragma unroll
    for (int ds = 0; ds < 4; ++ds) qr[ds] = *(const bf16x8*)(QA + (tokq + r32) * 512 + hq * 64 + ds * 16 + hi * 8);
    const bf16_t* Kb = (const bf16_t*)(p.ws + WS_KA) + (size_t)b * SEQ * 128 + kvh * 64;
    const bf16_t* Vb = (const bf16_t*)(p.ws + WS_VA) + (size_t)b * SEQ * 128 + kvh * 64;
    const float nshift = -((const float*)(p.ws + WS_BND))[l];
    f32x16 o0, o1;
#pragma unroll
    for (int i = 0; i < 16; ++i) { o0[i] = 0.f; o1[i] = 0.f; }
    float lacc = 0.f;
    constexpr int NT = SEQ / 64;
    const int row0 = tid >> 3, ch0 = tid & 7;
    const size_t goff0 = (size_t)row0 * 128 + ch0 * 8, goff1 = goff0 + (size_t)32 * 128;
    const int ko0 = row0 * 144 + ch0 * 16, ko1 = ko0 + 32 * 144;
    const int vo0 = 9216 + (ch0 >> 2) * 4096 + row0 * 64 + (ch0 & 3) * 16, vo1 = vo0 + 32 * 64;
    u32x4 rkA[2], rvA[2], rkB[2], rvB[2];
#define ATA_LOAD(RK, RV, t) do { const size_t tb = (size_t)(t) * 64 * 128; RK[0] = *(const u32x4*)(Kb + tb + goff0); RK[1] = *(const u32x4*)(Kb + tb + goff1); \
        RV[0] = *(const u32x4*)(Vb + tb + goff0); RV[1] = *(const u32x4*)(Vb + tb + goff1); } while (0)
#define ATA_STORE(RK, RV, st) do { unsigned char* sb_ = smem + (st) * ATA_STAGE; *(u32x4*)(sb_ + ko0) = RK[0]; *(u32x4*)(sb_ + ko1) = RK[1]; \
        *(u32x4*)(sb_ + vo0) = RV[0]; *(u32x4*)(sb_ + vo1) = RV[1]; } while (0)
#define ATA_COMPUTE(st) do { const unsigned char* sb_ = smem + (st) * ATA_STAGE; f32x16 p0, p1; \
        _Pragma("unroll") for (int i = 0; i < 16; ++i) { p0[i] = nshift; p1[i] = nshift; } \
        at_qk(p0, p1, (const bf16_t*)sb_, qr, r32, hi); \
        _Pragma("unroll") for (int i = 0; i < 16; ++i) { p0[i] = __builtin_amdgcn_exp2f(p0[i]); p1[i] = __builtin_amdgcn_exp2f(p1[i]); lacc += p0[i] + p1[i]; } \
        at_pv(o0, o1, p0, p1, sb_ + 9216, lane); } while (0)
    __syncthreads();
    ATA_LOAD(rkA, rvA, 0); ATA_LOAD(rkB, rvB, 1);
    ATA_STORE(rkA, rvA, 0);
    ATA_LOAD(rkA, rvA, 2);
    __syncthreads();
    for (int kt = 0; kt < NT; kt += 2) {
        ATA_COMPUTE(0);
        ATA_STORE(rkB, rvB, 1);
        if (kt + 3 < NT) ATA_LOAD(rkB, rvB, kt + 3);
        __syncthreads();
        ATA_COMPUTE(1);
        if (kt + 2 < NT) { ATA_STORE(rkA, rvA, 0); if (kt + 4 < NT) ATA_LOAD(rkA, rvA, kt + 4); }
        __syncthreads();
    }
#undef ATA_LOAD
#undef ATA_STORE
#undef ATA_COMPUTE
    lacc += __shfl_xor(lacc, 32);
    if (hi == 0) lq[r32] = lacc;
    asm volatile("s_waitcnt lgkmcnt(0)" ::: "memory");
#pragma unroll
    for (int rr = 0; rr < 16; ++rr) {
        const int q = crow(rr, hi); const float inv = 1.f / lq[q];
        const size_t off = (tokq + q) * 512 + hq * 64 + r32;
        const float g0 = bf2f(GA[off]), g1 = bf2f(GA[off + 32]);
        QA[off] = (bf16_t)(pk2(o0[rr] * inv * g0, 0.f) & 0xffffu);
        QA[off + 32] = (bf16_t)(pk2(o1[rr] * inv * g1, 0.f) & 0xffffu);
    }
}

__device__ void attn_b_item(const Params& p, int item, int l, unsigned char* smem) {
    int tid_ = threadIdx.x; asm volatile("" : "+v"(tid_));
    const int tid = tid_, lane = tid & 63, w = tid >> 6, r32 = lane & 31, hi = lane >> 5;
    const int blk = item & 63, j = (item >> 6) & 3, bg = item >> 8, g = bg % 3, b = bg / 3;
    const int sh = 2 * g, dil = 1 << sh, Mlen = SEQ >> sh;
    bf16_t* Ks = (bf16_t*)(smem + AT_KS); unsigned char* Vs = smem + AT_VS; float* lq = (float*)(smem + AT_LQ) + w * 32; float* lut = (float*)(smem + AT_LUT);
    bf16_t* QB = (bf16_t*)(p.ws + WS_QB) + (size_t)bg * SEQ * 256 + j * 64;
    const bf16_t* KB = (const bf16_t*)(p.ws + WS_KB) + (size_t)bg * SEQ * 256 + j * 64;
    const bf16_t* VB = (const bf16_t*)(p.ws + WS_VB) + (size_t)bg * SEQ * 256 + j * 64;
    float* LSE = (float*)(p.ws + WS_LSE) + (size_t)bg * SEQ * 4 + j;
    const int p0r = blk * 128, seq_lo = (p0r / Mlen) * Mlen, seq_hi = seq_lo + Mlen;
    __syncthreads();
    if (tid < 129) {
        const int rel = tid - 64, n = (rel < 0 ? -rel : rel) * dil;
        int bk;
        if (n < 8) bk = n; else { bk = 8 + (n >= 15) + (n >= 27) + (n >= 50) + (n >= 91) + (n >= 166) + (n >= 305) + (n >= 559); }
        if (rel > 0) bk += 16;
        lut[tid] = p.rel_bias[bk * 12 + g * 4 + j] * LOG2E;
    }
    const int qpos = p0r + w * 32 + r32;
    bf16x8 qr[4];
#pragma unroll
    for (int ds = 0; ds < 4; ++ds) qr[ds] = *(const bf16x8*)(QB + (size_t)qpos * 256 + ds * 16 + hi * 8);
    const float nshift = -((const float*)(p.ws + WS_BND))[2 + l];
    f32x16 o0, o1;
#pragma unroll
    for (int i = 0; i < 16; ++i) { o0[i] = 0.f; o1[i] = 0.f; }
    float lacc = 0.f;
    u32x4 rk[2], rv[2];
    for (int kt = 0; kt < 4; ++kt) {
        const int kbase = p0r - 64 + 64 * kt;
#pragma unroll
        for (int i = 0; i < 2; ++i) { const int c = tid + 256 * i, row = c >> 3, ch = c & 7;
            int pr = kbase + row; pr = pr < 0 ? 0 : (pr > SEQ - 1 ? SEQ - 1 : pr);
            rk[i] = *(const u32x4*)(KB + (size_t)pr * 256 + ch * 8); rv[i] = *(const u32x4*)(VB + (size_t)pr * 256 + ch * 8); }
        __syncthreads();
        AT_STAGE_STORE();
        __syncthreads();
        f32x16 p0, p1;
#pragma unroll
        for (int i = 0; i < 16; ++i) { p0[i] = nshift; p1[i] = nshift; }
        at_qk(p0, p1, Ks, qr, r32, hi);
#pragma unroll
        for (int i = 0; i < 16; ++i) {
            const int kv0 = kbase + crow(i, hi), kv1 = kv0 + 32;
            const int rel0 = kv0 - qpos, rel1 = kv1 - qpos;
            const bool ok0 = rel0 >= -64 && rel0 <= 64 && kv0 >= seq_lo && kv0 < seq_hi;
            const bool ok1 = rel1 >= -64 && rel1 <= 64 && kv1 >= seq_lo && kv1 < seq_hi;
            const float e0 = __builtin_amdgcn_exp2f(p0[i] + lut[ok0 ? rel0 + 64 : 64]);
            const float e1 = __builtin_amdgcn_exp2f(p1[i] + lut[ok1 ? rel1 + 64 : 64]);
            p0[i] = ok0 ? e0 : 0.f; p1[i] = ok1 ? e1 : 0.f; lacc += p0[i] + p1[i];
        }
        at_pv(o0, o1, p0, p1, Vs, lane);
    }
    lacc += __shfl_xor(lacc, 32);
    if (hi == 0) { lq[r32] = lacc; LSE[(size_t)qpos * 4] = (-nshift + log2f(lacc)) * LN2; }
    asm volatile("s_waitcnt lgkmcnt(0)" ::: "memory");
#pragma unroll
    for (int rr = 0; rr < 16; ++rr) {
        const int q = crow(rr, hi); const float inv = 1.f / lq[q];
        const size_t off = (size_t)(p0r + w * 32 + q) * 256 + r32;
        QB[off] = (bf16_t)(pk2(o0[rr] * inv, 0.f) & 0xffffu);
        QB[off + 32] = (bf16_t)(pk2(o1[rr] * inv, 0.f) & 0xffffu);
    }
}

constexpr int SS_BS = 0, SS_CS = 8704, SS_XS = 17408, SS_XWS = 22016, SS_GS = 26624, SS_SB = 29184, SS_CW = 46592, SS_SC = 54272, SS_DTA = 55296, SS_END = 57344;

template <int PASS>
__device__ void ssd_item(const Params& p, int item, int l, unsigned char* smem) {
    int tid_ = threadIdx.x; asm volatile("" : "+v"(tid_));
    const int tid = tid_, lane = tid & 63, w = tid >> 6, idx = lane & 15, kq = lane >> 4;
    const int seg = item & 15, h = (item >> 4) & 7, dir = (item >> 7) & 1, b = item >> 8, grp = h >> 2;
    bf16_t* Bs = (bf16_t*)(smem + SS_BS); bf16_t* Cs = (bf16_t*)(smem + SS_CS); bf16_t* Xs = (bf16_t*)(smem + SS_XS); bf16_t* Xws = (bf16_t*)(smem + SS_XWS);
    bf16_t* Gs = (bf16_t*)(smem + SS_GS); bf16_t* Sb = (bf16_t*)(smem + SS_SB); float* cwl = (float*)(smem + SS_CW); float* sc = (float*)(smem + SS_SC);
    float* s_dt = sc, *s_c = sc + 32, *s_rs = sc + 64, *s_wl = sc + 96, *s_tot = sc + 128;
    const bf16_t* XBC = (const bf16_t*)(p.ws + WS_XBC);
    const float* DT = (const float*)(p.ws + WS_DT);
    float* ST = (float*)(p.ws + WS_ST); float* SEGT = (float*)(p.ws + WS_SEGT);
    bf16_t* Y = (bf16_t*)(p.ws + (dir ? WS_YS : WS_YF));
    const float Aneg = -__expf(p.a_log[l * 16 + dir * 8 + h]);
    const float Dh = p.d_skip[l * 8 + h];
    __syncthreads();
    for (int e = tid; e < 6 * 320; e += 256) {
        const int tap = e / 320, lc = e % 320;
        const int ch = lc < 64 ? h * 64 + lc : (lc < 192 ? 512 + grp * 128 + (lc - 64) : 768 + grp * 128 + (lc - 192));
        cwl[e] = tap < 5 ? p.conv_w[(size_t)l * 5 * 1024 + tap * 1024 + ch] : p.conv_b[l * 1024 + ch];
    }
    f32x4 S[8];
#pragma unroll
    for (int nt = 0; nt < 8; ++nt) S[nt] = (f32x4){0.f, 0.f, 0.f, 0.f};
    const int ibase = item & ~15;
    if (PASS == 3) {
        if (dir == 0) {
            for (int e = 0; e < seg; ++e) { const float dc = __expf(SEGT[ibase + e]); const f32x4* src = (const f32x4*)(ST + (size_t)(ibase + e) * 8192);
#pragma unroll
                for (int nt = 0; nt < 8; ++nt) S[nt] = S[nt] * dc + src[(w * 8 + nt) * 64 + lane]; }
        } else {
            for (int e = NSEG - 1; e > seg; --e) { const float dc = __expf(SEGT[ibase + e]); const f32x4* src = (const f32x4*)(ST + (size_t)(ibase + e) * 8192);
#pragma unroll
                for (int nt = 0; nt < 8; ++nt) S[nt] = S[nt] * dc + src[(w * 8 + nt) * 64 + lane]; }
        }
#pragma unroll
        for (int nt = 0; nt < 8; ++nt) st4bf(Sb + (16 * w + idx) * 136 + 16 * nt + 4 * kq, S[nt]);
    }
    float* s_dta = (float*)(smem + SS_DTA);
    for (int e = tid; e < SEGLEN; e += 256) s_dta[e] = DT[((size_t)b * SEQ + seg * SEGLEN + e) * 16 + dir * 8 + h];
    float segtot = 0.f;
    const int ci0 = tid % 40, tg0 = tid / 40, ci1 = (tid + 64) % 40, tg1 = (tid + 64) / 40;
    const int sc0 = ci0 < 8 ? h * 64 + ci0 * 8 : (ci0 < 24 ? 512 + grp * 128 + (ci0 * 8 - 64) : 768 + grp * 128 + (ci0 * 8 - 192));
    const int sc1 = ci1 < 8 ? h * 64 + ci1 * 8 : (ci1 < 24 ? 512 + grp * 128 + (ci1 * 8 - 64) : 768 + grp * 128 + (ci1 * 8 - 192));
    const bool has1 = tid >= 192;
#define SS_CONV(RAW, CI, TG) do { const int lc_ = (CI) * 8; float ac_[4][8]; \
        { const f32x4 a_ = *(const f32x4*)(cwl + 5 * 320 + lc_), b_ = *(const f32x4*)(cwl + 5 * 320 + lc_ + 4); \
          _Pragma("unroll") for (int l_ = 0; l_ < 4; ++l_) { ac_[l_][0] = a_.x; ac_[l_][1] = a_.y; ac_[l_][2] = a_.z; ac_[l_][3] = a_.w; ac_[l_][4] = b_.x; ac_[l_][5] = b_.y; ac_[l_][6] = b_.z; ac_[l_][7] = b_.w; } } \
        _Pragma("unroll") for (int k_ = 0; k_ < 5; ++k_) { const f32x4 wa_ = *(const f32x4*)(cwl + k_ * 320 + lc_), wb_ = *(const f32x4*)(cwl + k_ * 320 + lc_ + 4); \
            _Pragma("unroll") for (int l_ = 0; l_ < 4; ++l_) { const u32x4 v_ = RAW[l_ + k_]; \
                ac_[l_][0] += bflo(v_.x) * wa_.x; ac_[l_][1] += bfhi(v_.x) * wa_.y; ac_[l_][2] += bflo(v_.y) * wa_.z; ac_[l_][3] += bfhi(v_.y) * wa_.w; \
                ac_[l_][4] += bflo(v_.z) * wb_.x; ac_[l_][5] += bfhi(v_.z) * wb_.y; ac_[l_][6] += bflo(v_.w) * wb_.z; ac_[l_][7] += bfhi(v_.w) * wb_.w; } \
            asm volatile("" ::: "memory"); } \
        _Pragma("unroll") for (int l_ = 0; l_ < 4; ++l_) { const int lrow_ = 4 * (TG) + l_; float* a_ = ac_[l_]; \
            _Pragma("unroll") for (int e_ = 0; e_ < 8; ++e_) a_[e_] = siluf(a_[e_]); \
            u32x4 o_; o_.x = pk2(a_[0], a_[1]); o_.y = pk2(a_[2], a_[3]); o_.z = pk2(a_[4], a_[5]); o_.w = pk2(a_[6], a_[7]); \
            if ((CI) < 8) { *(u32x4*)(Xs + lrow_ * 72 + lc_) = o_; const float wl_ = s_wl[lrow_]; \
                u32x4 o2_; o2_.x = pk2(a_[0] * wl_, a_[1] * wl_); o2_.y = pk2(a_[2] * wl_, a_[3] * wl_); o2_.z = pk2(a_[4] * wl_, a_[5] * wl_); o2_.w = pk2(a_[6] * wl_, a_[7] * wl_); \
                *(u32x4*)(Xws + lrow_ * 72 + lc_) = o2_; } \
            else if ((CI) < 24) *(u32x4*)(Bs + lrow_ * 136 + (lc_ - 64)) = o_; \
            else *(u32x4*)(Cs + lrow_ * 136 + (lc_ - 192)) = o_; } } while (0)
    for (int si = 0; si < NSUB; ++si) {
        const int scn = dir ? (NSUB - 1 - si) : si;
        const int t0 = seg * SEGLEN + scn * TSUB;
        const size_t tokb = (size_t)b * SEQ;
        __syncthreads();
        u32x4 raw0[8];
        const unsigned char* xb_ = (const unsigned char*)(XBC + tokb * 1024);
        {
            const unsigned o0_ = (unsigned)(((t0 + 4 * tg0 - 2) * 1024 + sc0) * 2);
#pragma unroll
            for (int r_ = 0; r_ < 8; ++r_) {
                const int tt0 = t0 + 4 * tg0 - 2 + r_;
                raw0[r_] = (u32x4){0u, 0u, 0u, 0u};
                if (tt0 >= 0 && tt0 < SEQ) raw0[r_] = *(const u32x4*)(xb_ + (o0_ + (unsigned)(r_ * 2048)));
            }
        }
        if (w == 0) {
            float dtv = 0.f, av = 0.f;
            if (lane < 32) { dtv = s_dta[scn * TSUB + lane]; av = dtv * Aneg; }
            float pre = av;
#pragma unroll
            for (int o = 1; o < 32; o <<= 1) { const float t = __shfl_up(pre, o); if (lane >= o) pre += t; }
            const float tot = __shfl(pre, 31);
            const float cc = dir ? (tot - pre + av) : pre;
            if (lane < 32) { s_dt[lane] = dtv; s_c[lane] = cc; s_rs[lane] = __expf(cc); s_wl[lane] = dtv * __expf(tot - cc); }
            if (lane == 0) s_tot[0] = tot;
        }
        __syncthreads();
        segtot += s_tot[0];
        SS_CONV(raw0, ci0, tg0);
        if (has1) {
            const unsigned o1_ = (unsigned)(((t0 + 4 * tg1 - 2) * 1024 + sc1) * 2);
#pragma unroll
            for (int r_ = 0; r_ < 8; ++r_) {
                const int tt1 = t0 + 4 * tg1 - 2 + r_;
                raw0[r_] = (u32x4){0u, 0u, 0u, 0u};
                if (tt1 >= 0 && tt1 < SEQ) raw0[r_] = *(const u32x4*)(xb_ + (o1_ + (unsigned)(r_ * 2048)));
            }
            SS_CONV(raw0, ci1, tg1);
        }
        __syncthreads();
        if (PASS == 3) {
            const int it = w >> 1, jt = w & 1;
            f32x4 cb = (f32x4){0.f, 0.f, 0.f, 0.f};
#pragma unroll
            for (int ks = 0; ks < 4; ++ks) {
                const bf16x8 fb = *(const bf16x8*)(Bs + (16 * jt + idx) * 136 + ks * 32 + kq * 8);
                const bf16x8 fc = *(const bf16x8*)(Cs + (16 * it + idx) * 136 + ks * 32 + kq * 8);
                cb = __builtin_amdgcn_mfma_f32_16x16x32_bf16(fb, fc, cb, 0, 0, 0);
            }
            {
                const int ii = 16 * it + idx; const float ci_ = s_c[ii];
                f32x4 gv;
#pragma unroll
                for (int rg = 0; rg < 4; ++rg) {
                    const int jj = 16 * jt + 4 * kq + rg;
                    const bool ok = dir ? (jj >= ii) : (jj <= ii);
                    const float e = __expf(ci_ - s_c[jj]) * s_dt[jj];
                    gv[rg] = ok ? cb[rg] * e : 0.f;
                }
                st4bf(Gs + ii * 40 + 16 * jt + 4 * kq, gv);
            }
            __syncthreads();
            const unsigned char* xtr = (const unsigned char*)Xs + (8 * kq + (idx >> 2)) * 144 + (16 * w + 4 * (idx & 3)) * 2;
            const bf16x8 xf = cat8(tr16(xtr), tr16(xtr + 4 * 144));
#pragma unroll
            for (int it2 = 0; it2 < 2; ++it2) {
                const int ii = 16 * it2 + idx;
                const bf16x8 gf = *(const bf16x8*)(Gs + ii * 40 + 8 * kq);
                f32x4 yd = (f32x4){0.f, 0.f, 0.f, 0.f}, yo = (f32x4){0.f, 0.f, 0.f, 0.f};
                yd = __builtin_amdgcn_mfma_f32_16x16x32_bf16(xf, gf, yd, 0, 0, 0);
#pragma unroll
                for (int ks = 0; ks < 4; ++ks) {
                    const bf16x8 sf = *(const bf16x8*)(Sb + (16 * w + idx) * 136 + ks * 32 + kq * 8);
                    const bf16x8 cf = *(const bf16x8*)(Cs + ii * 136 + ks * 32 + kq * 8);
                    yo = __builtin_amdgcn_mfma_f32_16x16x32_bf16(sf, cf, yo, 0, 0, 0);
                }
                f32x4 y = yd + yo * s_rs[ii];
                if (dir == 0) { const u32x2 xv = *(const u32x2*)(Xs + ii * 72 + 16 * w + 4 * kq);
                    y.x += Dh * bflo(xv.x); y.y += Dh * bfhi(xv.x); y.z += Dh * bflo(xv.y); y.w += Dh * bfhi(xv.y); }
                st4bf(Y + (tokb + t0 + ii) * 512 + h * 64 + 16 * w + 4 * kq, y);
            }
        }
        {
            const float dc = __expf(s_tot[0]);
            const unsigned char* xw = (const unsigned char*)Xws + (8 * kq + (idx >> 2)) * 144 + (16 * w + 4 * (idx & 3)) * 2;
            const bf16x8 xwf = cat8(tr16(xw), tr16(xw + 4 * 144));
#pragma unroll
            for (int nt = 0; nt < 8; ++nt) {
                const unsigned char* bt = (const unsigned char*)Bs + (8 * kq + (idx >> 2)) * 272 + (16 * nt + 4 * (idx & 3)) * 2;
                const bf16x8 bf = cat8(tr16(bt), tr16(bt + 4 * 272));
                S[nt] = __builtin_amdgcn_mfma_f32_16x16x32_bf16(bf, xwf, S[nt] * dc, 0, 0, 0);
            }
            if (PASS == 3) {
#pragma unroll
                for (int nt = 0; nt < 8; ++nt) st4bf(Sb + (16 * w + idx) * 136 + 16 * nt + 4 * kq, S[nt]);
            }
        }
    }
    if (PASS == 1) {
        f32x4* dst = (f32x4*)(ST + (size_t)item * 8192);
#pragma unroll
        for (int nt = 0; nt < 8; ++nt) dst[(w * 8 + nt) * 64 + lane] = S[nt];
        if (tid == 0) SEGT[item] = segtot;
    }
}

__device__ void post2_phase(const Params& p) {
    const int lane = threadIdx.x & 63, gw = blockIdx.x * 4 + (threadIdx.x >> 6), nw = gridDim.x * 4;
    const bf16_t* OB = (const bf16_t*)(p.ws + WS_QB); const float* LSE = (const float*)(p.ws + WS_LSE);
    const bf16_t* GB = (const bf16_t*)(p.ws + WS_GB);
    bf16_t* YBM = (bf16_t*)(p.ws + WS_YBM);
    const bf16_t* YF = (const bf16_t*)(p.ws + WS_YF); const bf16_t* YS = (const bf16_t*)(p.ws + WS_YS); const bf16_t* ZS = (const bf16_t*)(p.ws + WS_ZS);
    bf16_t* YC = (bf16_t*)(p.ws + WS_YC); float* RS = (float*)(p.ws + WS_RSTD);
    for (int row = gw; row < TP; row += nw) {
        const int bl = row >> 13, tt = row & (SEQ - 1), j = lane >> 4;
        float ls[3]; size_t ro[3];
#pragma unroll
        for (int g = 0; g < 3; ++g) { const int sh = 2 * g; const int pp = (tt & ((1 << sh) - 1)) * (SEQ >> sh) + (tt >> sh);
            ro[g] = (size_t)(bl * 3 + g) * SEQ + pp; ls[g] = LSE[ro[g] * 4 + j]; }
        const float mx = fmaxf(ls[0], fmaxf(ls[1], ls[2]));
        float wg[3]; float ws = 0.f;
#pragma unroll
        for (int g = 0; g < 3; ++g) { wg[g] = __expf(ls[g] - mx); ws += wg[g]; }
        const float inv = 1.f / ws;
        f32x4 acc = (f32x4){0.f, 0.f, 0.f, 0.f};
#pragma unroll
        for (int g = 0; g < 3; ++g) { const u32x2 v = *(const u32x2*)(OB + ro[g] * 256 + 4 * lane); const float wv = wg[g] * inv;
            acc.x += wv * bflo(v.x); acc.y += wv * bfhi(v.x); acc.z += wv * bflo(v.y); acc.w += wv * bfhi(v.y); }
        { const u32x2 gt = *(const u32x2*)(GB + (size_t)row * 256 + 4 * lane);
          acc.x *= bflo(gt.x); acc.y *= bfhi(gt.x); acc.z *= bflo(gt.y); acc.w *= bfhi(gt.y); }
        st4bf(YBM + (size_t)row * 256 + 4 * lane, acc);
        const u32x4 a = *(const u32x4*)(YF + (size_t)row * 512 + 8 * lane), bq = *(const u32x4*)(YS + (size_t)row * 512 + 8 * lane), z = *(const u32x4*)(ZS + (size_t)row * 512 + 8 * lane);
        float y[8];
        y[0] = (bflo(a.x) + bflo(bq.x)) * bflo(z.x); y[1] = (bfhi(a.x) + bfhi(bq.x)) * bfhi(z.x);
        y[2] = (bflo(a.y) + bflo(bq.y)) * bflo(z.y); y[3] = (bfhi(a.y) + bfhi(bq.y)) * bfhi(z.y);
        y[4] = (bflo(a.z) + bflo(bq.z)) * bflo(z.z); y[5] = (bfhi(a.z) + bfhi(bq.z)) * bfhi(z.z);
        y[6] = (bflo(a.w) + bflo(bq.w)) * bflo(z.w); y[7] = (bfhi(a.w) + bfhi(bq.w)) * bfhi(z.w);
        float ss = 0.f;
#pragma unroll
        for (int e = 0; e < 8; ++e) ss += y[e] * y[e];
        ss = wave_sum(ss);
        u32x4 o; o.x = pk2(y[0], y[1]); o.y = pk2(y[2], y[3]); o.z = pk2(y[4], y[5]); o.w = pk2(y[6], y[7]);
        *(u32x4*)(YC + (size_t)row * 512 + 8 * lane) = o;
        if (lane == 0) RS[row] = rsqrtf(ss * (1.f / 512.f) + EPS);
    }
}


#define XB_TMO      128
#define XB_XCNT(j)  (256  + 64 * (j))
#define XB_XSUB(j)  (1280 + 64 * (j))
#define XB_XGEN(j)  (2304 + 64 * (j))
#define XB_TOP      3328
#define XB_TOPGEN   3392
#define XCD_BAR_WORDS 3456
#define XB_SPIN_CAP (1u << 20)
__device__ __forceinline__ unsigned xb_ld(unsigned* p)              { return __hip_atomic_load(p, __ATOMIC_RELAXED, __HIP_MEMORY_SCOPE_AGENT); }
__device__ __forceinline__ unsigned xb_add(unsigned* p, unsigned v) { return __hip_atomic_fetch_add(p, v, __ATOMIC_RELAXED, __HIP_MEMORY_SCOPE_AGENT); }
__device__ __forceinline__ unsigned xb_xcc_id() { return (unsigned)__builtin_amdgcn_s_getreg((3 << 11) | 20) & 0xFu; }
#define XB_SPIN(cond, bar) do { unsigned _sp = 0; while (cond) { __builtin_amdgcn_s_sleep(1); \
    if ((++_sp & 255u) == 0u) { if (xb_ld(&(bar)[XB_TMO])) break; if (_sp > XB_SPIN_CAP) { atomicAdd(&(bar)[XB_TMO], 1u); break; } } } } while (0)
struct XcdBarrier { unsigned* bar; unsigned x; volatile LDSAS unsigned* st; };
__device__ __forceinline__ XcdBarrier xcd_barrier_post(unsigned* bar, volatile LDSAS unsigned* st) {
    XcdBarrier b; b.bar = bar; b.x = xb_xcc_id(); b.st = st;
    if (threadIdx.x == 0) (void)xb_add(&bar[XB_XCNT(b.x)], 1u);
    return b;
}
__device__ __forceinline__ void xcd_barrier_complete(unsigned* bar, unsigned x, unsigned& nloc, unsigned& nx) {
    const unsigned G = gridDim.x * gridDim.y * gridDim.z;
    unsigned sum, cnt, mine, sp = 0u;
    for (;;) {
        sum = 0u; cnt = 0u; mine = 0u;
#pragma unroll
        for (unsigned j = 0; j < 16; ++j) { const unsigned c = xb_ld(&bar[XB_XCNT(j)]); sum += c; cnt += (c > 0u) ? 1u : 0u; mine = (j == x) ? c : mine; }
        if (sum == G) break;
        __builtin_amdgcn_s_sleep(1);
        if ((++sp & 255u) == 0u) { if (xb_ld(&bar[XB_TMO])) break; if (sp > XB_SPIN_CAP) { atomicAdd(&bar[XB_TMO], 1u); break; } }
    }
    nloc = mine > 0u ? mine : 1u; nx = cnt > 0u ? cnt : 1u;
}
__device__ __forceinline__ void xcd_barrier(const XcdBarrier& b) {
    asm volatile("s_waitcnt vmcnt(0)" ::: "memory");
    __syncthreads();
    if (threadIdx.x == 0) {
        unsigned* bar = b.bar;
        __builtin_amdgcn_s_waitcnt(0);
        unsigned nloc = b.st[0], nx = b.st[1];
        if (nloc == 0u) { xcd_barrier_complete(bar, b.x, nloc, nx); b.st[0] = nloc; b.st[1] = nx; }
        const unsigned old = xb_add(&bar[XB_XSUB(b.x)], 1u);
        const unsigned gen = old / nloc;
        if (old + 1u == (gen + 1u) * nloc) {
            __builtin_amdgcn_fence(__ATOMIC_RELEASE, "agent");
            asm volatile("s_waitcnt vmcnt(0)" ::: "memory");
            const unsigned og = xb_add(&bar[XB_TOP], 1u);
            const unsigned tg = og / nx;
            if (og + 1u == (tg + 1u) * nx) xb_add(&bar[XB_TOPGEN], 1u);
            else XB_SPIN(xb_ld(&bar[XB_TOPGEN]) == tg, bar);
            __builtin_amdgcn_fence(__ATOMIC_ACQUIRE, "agent");
            xb_add(&bar[XB_XGEN(b.x)], 1u);
            asm volatile("s_waitcnt vmcnt(0)" ::: "memory");
        } else {
            XB_SPIN(xb_ld(&bar[XB_XGEN(b.x)]) == gen, bar);
            __builtin_amdgcn_fence(__ATOMIC_ACQUIRE, "agent");
            asm volatile("s_waitcnt vmcnt(0)" ::: "memory");
        }
    }
    __syncthreads();
}

constexpr int SMEM_BYTES = 65536;
__global__ void __launch_bounds__(256, 2) hybrid_fwd(Params p) {
    cg::grid_group grid = cg::this_grid();
    __shared__ __attribute__((aligned(16))) unsigned char smem[SMEM_BYTES + 16];
    volatile LDSAS unsigned* bst = (volatile LDSAS unsigned*)(smem + SMEM_BYTES);
    if (threadIdx.x < 4) bst[threadIdx.x] = 0u;
    __syncthreads();
    const XcdBarrier xbar = xcd_barrier_post((unsigned*)(p.ws + WS_BAR), bst);
    { const Params q = launder(p); phase0(q, smem); }
    grid.sync();
#pragma unroll 1
    for (int l = 0; l < DEPTH; ++l) {
#pragma unroll 1
        for (int hb = 0; hb < 2; ++hb) {
            { const Params q = launder(p); norm_phase(q, l, hb, (l == 0) ? q.x : q.out); }
            xcd_barrier(xbar);
            { const Params q = launder(p); gemm1_phase(q, l, hb, smem); }
            xcd_barrier(xbar);
            { const Params q = launder(p);
#pragma unroll 1
              for (int it = blockIdx.x; it < 512 + 1536; it += gridDim.x) { if (it < 512) ssd_item<1>(q, it, l, smem); else attn_b_item(q, it - 512, l, smem); } }
            xcd_barrier(xbar);
            { const Params q = launder(p);
#pragma unroll 1
              for (int it = blockIdx.x; it < 1024 + 512; it += gridDim.x) { if (it < 1024) attn_a_item(q, it, l, smem); else ssd_item<3>(q, it - 1024, l, smem); } }
            xcd_barrier(xbar);
            { const Params q = launder(p); post2_phase(q); }
            xcd_barrier(xbar);
            { const Params q = launder(p); merge_phase(q, l, smem); }
            xcd_barrier(xbar);
            { const Params q = launder(p); out_phase(q, l, hb, (l == 0) ? q.x : q.out, smem); }
            xcd_barrier(xbar);
        }
    }
}

extern "C" void kernel_launch(void* const* d_in, const int* in_sizes, int n_in, void* d_out, int out_size, void* d_ws, size_t ws_size, hipStream_t stream) {
    static int grid_blocks = 0;
    if (!grid_blocks) {
        int dev = 0, cus = 0, per_cu = 0;
        hipGetDevice(&dev);
        hipDeviceGetAttribute(&cus, hipDeviceAttributeMultiprocessorCount, dev);
        hipOccupancyMaxActiveBlocksPerMultiprocessor(&per_cu, hybrid_fwd, 256, 0);
        if (per_cu > 2) per_cu = 2;
        if (per_cu < 1) per_cu = 1;
        grid_blocks = cus * per_cu;
    }
    Params p{};
    const float** pp = (const float**)&p;
    for (int i = 0; i < 22; ++i) pp[i] = (const float*)d_in[i];
    p.out = (float*)d_out; p.ws = (unsigned char*)d_ws;
    hipMemsetAsync((unsigned char*)d_ws + WS_BAR, 0, XCD_BAR_WORDS * 4, stream);
    void* args[] = {&p};
    hipError_t e = hipLaunchCooperativeKernel((void*)hybrid_fwd, dim3(grid_blocks), dim3(256), args, 0, stream);
    if (e != hipSuccess) fprintf(stderr, "cooperative launch failed: %s (grid %d)\n", hipGetErrorString(e), grid_blocks);
}
```

```cpp
#include <hip/hip_runtime.h>
#include <hip/hip_cooperative_groups.h>
#include <cstdint>
#include <cstdio>
namespace cg = cooperative_groups;

typedef unsigned short bf16_t;
typedef short bf16x8 __attribute__((ext_vector_type(8)));
typedef short v4i16 __attribute__((ext_vector_type(4)));
typedef float f32x2 __attribute__((ext_vector_type(2)));
typedef float f32x4 __attribute__((ext_vector_type(4)));
typedef float f32x16 __attribute__((ext_vector_type(16)));
typedef unsigned u32x2 __attribute__((ext_vector_type(2)));
typedef unsigned u32x4 __attribute__((ext_vector_type(4)));
typedef __bf16 bf16x2_t __attribute__((ext_vector_type(2)));
#define LDSAS __attribute__((address_space(3)))
#define VTID ((int)(threadIdx.x & 255u))
__device__ __forceinline__ int vblk_() { int h_ = threadIdx.x >> 8; asm volatile("" : "+v"(h_)); return __builtin_amdgcn_readfirstlane(2 * (int)blockIdx.x + h_); }
#define VBLK vblk_()
#define VGRID ((int)(2u * gridDim.x))
constexpr int HALF_LDS = 73728, LDS_TOTAL = 147456;

constexpr int SEQ = 8192, DM = 1024, NBATCH = 4, NBH = 2, TP = NBH * SEQ, DEPTH = 2;
constexpr int NP = 8704;
constexpr float EPS = 1e-6f;
constexpr float LOG2E = 1.4426950408889634f, LN2 = 0.6931471805599453f;
constexpr int NSEG = 16, SEGLEN = 512, TSUB = 32, NSUB = SEGLEN / TSUB;

constexpr size_t MiB = 1u << 20;
constexpr size_t WS_WIN = 0;
constexpr size_t WS_WPA = 34 * MiB;
constexpr size_t WS_WPB = 36 * MiB;
constexpr size_t WS_WPC = 37 * MiB;
constexpr size_t WS_WOUT = 39 * MiB;
constexpr size_t WS_MOD = 43 * MiB;
constexpr size_t WS_ROPE = 43 * MiB + 128 * 1024;
constexpr size_t WS_BND = 43 * MiB + 160 * 1024;
constexpr size_t WS_RSTD = 43 * MiB + 256 * 1024;
constexpr size_t WS_SEGT = 43 * MiB + 512 * 1024;
constexpr size_t WS_LSE = 44 * MiB;
constexpr size_t WS_DT = 45 * MiB;
constexpr size_t WS_BAR = 46 * MiB;
constexpr size_t WS_H = 48 * MiB;
constexpr size_t WS_QA = 80 * MiB;
constexpr size_t WS_KA = 96 * MiB;
constexpr size_t WS_VA = 100 * MiB;
constexpr size_t WS_GA = 104 * MiB;
constexpr size_t WS_QB = 120 * MiB;
constexpr size_t WS_KB = 144 * MiB;
constexpr size_t WS_VB = 168 * MiB;
constexpr size_t WS_GB = 192 * MiB;
constexpr size_t WS_XBC = 200 * MiB;
constexpr size_t WS_ZS = 232 * MiB;
constexpr size_t WS_MG = 248 * MiB;
constexpr size_t WS_YF = 344 * MiB;
constexpr size_t WS_YS = 360 * MiB;
constexpr size_t WS_YBM = 376 * MiB;
constexpr size_t WS_YC = 384 * MiB;
constexpr size_t WS_MRG = 400 * MiB;
constexpr size_t WS_ST = 432 * MiB;

struct Params {
    const float *x, *c, *norm_w, *w_ada, *b_ada, *w_in, *b_gate, *q_norm_a, *k_norm_a, *q_norm_b, *k_norm_b, *rel_bias,
        *conv_w, *conv_b, *a_log, *dt_bias, *d_skip, *ssm_norm_w, *w_proj_a, *w_proj_b, *w_proj_c, *w_out;
    float* out;
    unsigned char* ws;
};


#define AS1 __attribute__((address_space(1)))
#define GLOBF(f) do { AS1 const float* g_ = (AS1 const float*)p.f; asm volatile("" : "+s"(g_)); q.f = (const float*)g_; } while (0)
__device__ __forceinline__ Params launder(const Params& p) {
    Params q;
    GLOBF(x); GLOBF(c); GLOBF(norm_w); GLOBF(w_ada); GLOBF(b_ada); GLOBF(w_in); GLOBF(b_gate); GLOBF(q_norm_a); GLOBF(k_norm_a); GLOBF(q_norm_b); GLOBF(k_norm_b); GLOBF(rel_bias);
    GLOBF(conv_w); GLOBF(conv_b); GLOBF(a_log); GLOBF(dt_bias); GLOBF(d_skip); GLOBF(ssm_norm_w); GLOBF(w_proj_a); GLOBF(w_proj_b); GLOBF(w_proj_c); GLOBF(w_out);
    { AS1 float* g_ = (AS1 float*)p.out; asm volatile("" : "+s"(g_)); q.out = (float*)g_; }
    { AS1 unsigned char* g_ = (AS1 unsigned char*)p.ws; asm volatile("" : "+s"(g_)); q.ws = (unsigned char*)g_; }
    return q;
}
__device__ __forceinline__ unsigned pk2(float lo, float hi) { f32x2 v = {lo, hi}; bf16x2_t b = __builtin_convertvector(v, bf16x2_t); return __builtin_bit_cast(unsigned, b); }
__device__ __forceinline__ float bf2f(unsigned short b) { return __uint_as_float(((unsigned)b) << 16); }
__device__ __forceinline__ float bflo(unsigned u) { return __uint_as_float(u << 16); }
__device__ __forceinline__ float bfhi(unsigned u) { return __uint_as_float(u & 0xffff0000u); }
__device__ __forceinline__ float siluf(float v) { return v / (1.f + __expf(-v)); }
__device__ __forceinline__ float sigmf(float v) { return 1.f / (1.f + __expf(-v)); }
__device__ __forceinline__ float wave_sum(float v) {
#pragma unroll
    for (int o = 1; o < 64; o <<= 1) v += __shfl_xor(v, o);
    return v;
}
__device__ __forceinline__ v4i16 tr16(const unsigned char* p) { return __builtin_amdgcn_ds_read_tr16_b64_v4i16((LDSAS v4i16*)p); }
__device__ __forceinline__ bf16x8 cat8(v4i16 a, v4i16 b) { return (bf16x8){a[0], a[1], a[2], a[3], b[0], b[1], b[2], b[3]}; }
__device__ __forceinline__ int crow(int r, int hi) { return (r & 3) + 8 * (r >> 2) + 4 * hi; }

__device__ __forceinline__ void p0_transpose(const float* __restrict__ W, int ldw, int K, bf16_t* __restrict__ Wt, int k0, int n0, int mode,
                                             const float* __restrict__ rowscale, float* tile) {
    const int tid = VTID, tx = tid & 63, ty = tid >> 6;
    const int np = n0 + tx; int n = np; bool valid = true;
    if (mode == 1) {
        if (np < 4352) n = np; else if (np < 4864) n = np + 512; else if (np < 5376) n = np - 512;
        else if (np < 8448) n = np + 16; else if (np < 8464) n = np - 3072; else { valid = false; n = 0; }
    }
#pragma unroll 4
    for (int i = 0; i < 16; ++i) {
        const int k = ty + 4 * i; float v = valid ? W[(size_t)(k0 + k) * ldw + n] : 0.f;
        if (rowscale) v *= rowscale[k0 + k];
        tile[k * 65 + tx] = v;
    }
    __syncthreads();
    const int r = tid >> 2, kc = (tid & 3) * 16;
    u32x4 o0, o1;
    o0.x = pk2(tile[(kc + 0) * 65 + r], tile[(kc + 1) * 65 + r]); o0.y = pk2(tile[(kc + 2) * 65 + r], tile[(kc + 3) * 65 + r]);
    o0.z = pk2(tile[(kc + 4) * 65 + r], tile[(kc + 5) * 65 + r]); o0.w = pk2(tile[(kc + 6) * 65 + r], tile[(kc + 7) * 65 + r]);
    o1.x = pk2(tile[(kc + 8) * 65 + r], tile[(kc + 9) * 65 + r]); o1.y = pk2(tile[(kc + 10) * 65 + r], tile[(kc + 11) * 65 + r]);
    o1.z = pk2(tile[(kc + 12) * 65 + r], tile[(kc + 13) * 65 + r]); o1.w = pk2(tile[(kc + 14) * 65 + r], tile[(kc + 15) * 65 + r]);
    bf16_t* dst = Wt + (size_t)(n0 + r) * K + k0 + kc;
    *(u32x4*)dst = o0; *(u32x4*)(dst + 8) = o1;
    __syncthreads();
}

__device__ void phase0(const Params& p, unsigned char* smem) {
    const int tid = VTID;
    float* tile = (float*)smem;
    constexpr int I_IN = 16 * 136, I_PA = 8 * 16, I_PB = 4 * 16, I_PC = 8 * 16, I_OUT = 16 * 16, I_L = I_IN + I_PA + I_PB + I_PC + I_OUT;
    constexpr int I_T = 2 * I_L, I_MOD = 192, I_ALL = I_T + I_MOD + 1;
    for (int item = VBLK; item < I_ALL; item += VGRID) {
        if (item < I_T) {
            const int l = item / I_L; int r = item % I_L;
            if (r < I_IN) { const int kt = r / 136, nt = r % 136;
                p0_transpose(p.w_in + (size_t)l * 1024 * 8464, 8464, 1024, (bf16_t*)(p.ws + WS_WIN) + (size_t)l * NP * 1024, kt * 64, nt * 64, 1, nullptr, tile); continue; }
            r -= I_IN;
            if (r < I_PA) { const int kt = r / 16, nt = r % 16;
                p0_transpose(p.w_proj_a + (size_t)l * 512 * 1024, 1024, 512, (bf16_t*)(p.ws + WS_WPA) + (size_t)l * 1024 * 512, kt * 64, nt * 64, 0, nullptr, tile); continue; }
            r -= I_PA;
            if (r < I_PB) { const int kt = r / 16, nt = r % 16;
                p0_transpose(p.w_proj_b + (size_t)l * 256 * 1024, 1024, 256, (bf16_t*)(p.ws + WS_WPB) + (size_t)l * 1024 * 256, kt * 64, nt * 64, 0, nullptr, tile); continue; }
            r -= I_PB;
            if (r < I_PC) { const int kt = r / 16, nt = r % 16;
                p0_transpose(p.w_proj_c + (size_t)l * 512 * 1024, 1024, 512, (bf16_t*)(p.ws + WS_WPC) + (size_t)l * 1024 * 512, kt * 64, nt * 64, 0, p.ssm_norm_w + l * 512, tile); continue; }
            r -= I_PC;
            { const int kt = r / 16, nt = r % 16;
                p0_transpose(p.w_out + (size_t)l * 1024 * 1024, 1024, 1024, (bf16_t*)(p.ws + WS_WOUT) + (size_t)l * 1024 * 1024, kt * 64, nt * 64, 0, nullptr, tile); }
        } else if (item < I_T + I_MOD) {
            const int it = item - I_T, l = it / 96, col0 = (it % 96) * 32, cl = tid & 31, ks = tid >> 5;
            float a0 = 0.f, a1 = 0.f, a2 = 0.f, a3 = 0.f;
            const float* wp = p.w_ada + ((size_t)l * 1024 + ks * 128) * 3072 + col0 + cl;
#pragma unroll 8
            for (int k = 0; k < 128; ++k) {
                const float wv = wp[(size_t)k * 3072]; const int kk = ks * 128 + k;
                a0 += siluf(p.c[kk]) * wv; a1 += siluf(p.c[1024 + kk]) * wv; a2 += siluf(p.c[2048 + kk]) * wv; a3 += siluf(p.c[3072 + kk]) * wv;
            }
            float* red = (float*)smem;
            red[(ks * 32 + cl) * 4 + 0] = a0; red[(ks * 32 + cl) * 4 + 1] = a1; red[(ks * 32 + cl) * 4 + 2] = a2; red[(ks * 32 + cl) * 4 + 3] = a3;
            __syncthreads();
            if (tid < 128) { const int b = tid >> 5, c2 = tid & 31; float s = 0.f;
#pragma unroll
                for (int k = 0; k < 8; ++k) s += red[(k * 32 + c2) * 4 + b];
                ((float*)(p.ws + WS_MOD))[(l * 4 + b) * 3072 + col0 + c2] = s + p.b_ada[l * 3072 + col0 + c2]; }
            __syncthreads();
        } else {
            float* rc = (float*)(p.ws + WS_ROPE); float* rs = rc + 128 * 16;
            for (int e = tid; e < 2048; e += 256) {
                const int pos = e >> 4, i = e & 15;
                const float freq = powf(10000.0f, -(float)i / 16.0f);
                const float ang = (float)pos * freq;
                const double rev = (double)ang * 0.15915494309189535; const double fr = rev - rint(rev);
                const float a = (float)(fr * 6.283185307179586);
                rc[e] = cosf(a); rs[e] = sinf(a);
            }
            if (tid < 2) {
                const int l = tid; float mqa = 0.f, mka = 0.f, mqb = 0.f, mkb = 0.f, mb = 0.f;
                for (int i = 0; i < 64; ++i) { mqa = fmaxf(mqa, fabsf(p.q_norm_a[l * 64 + i])); mka = fmaxf(mka, fabsf(p.k_norm_a[l * 64 + i]));
                    mqb = fmaxf(mqb, fabsf(p.q_norm_b[l * 64 + i])); mkb = fmaxf(mkb, fabsf(p.k_norm_b[l * 64 + i])); }
                for (int i = 0; i < 32 * 12; ++i) mb = fmaxf(mb, p.rel_bias[i]);
                float* bd = (float*)(p.ws + WS_BND);
                bd[l] = 8.f * mqa * mka * LOG2E; bd[2 + l] = (8.f * mqb * mkb + mb) * LOG2E;
            }
        }
    }
}

__device__ void norm_phase(const Params& p, int l, int hb, const float* xsrc) {
    int tx_ = threadIdx.x; asm volatile("" : "+v"(tx_));
    const int lane = tx_ & 63, gw = blockIdx.x * 8 + (tx_ >> 6), nw = gridDim.x * 8;
    bf16_t* H = (bf16_t*)(p.ws + WS_H);
    const float* nwp = p.norm_w + l * 1024;
    for (int row = gw; row < TP; row += nw) {
        const size_t rg = (size_t)hb * TP + row; const int b = (int)(rg / SEQ);
        const f32x4* xr = (const f32x4*)(xsrc + rg * 1024);
        const float* md = (const float*)(p.ws + WS_MOD) + (size_t)(l * 4 + b) * 3072;
        f32x4 v[4]; float ss = 0.f;
#pragma unroll
        for (int j = 0; j < 4; ++j) { v[j] = xr[lane + 64 * j]; ss += v[j].x * v[j].x + v[j].y * v[j].y + v[j].z * v[j].z + v[j].w * v[j].w; }
        ss = wave_sum(ss); const float rstd = rsqrtf(ss * (1.f / 1024.f) + EPS);
#pragma unroll
        for (int j = 0; j < 4; ++j) {
            const int col = 4 * (lane + 64 * j);
            const f32x4 w4 = *(const f32x4*)(nwp + col), sh = *(const f32x4*)(md + col), sc = *(const f32x4*)(md + 1024 + col);
            const f32x4 o = v[j] * rstd * w4 * (1.f + sc) + sh;
            u32x2 pk; pk.x = pk2(o.x, o.y); pk.y = pk2(o.z, o.w);
            *(u32x2*)(H + (size_t)row * 1024 + col) = pk;
        }
    }
}

constexpr int G_STAGE = 65536, G_AB = 32768;
__device__ __forceinline__ void gemm_core(const bf16_t* __restrict__ A, int lda, const bf16_t* __restrict__ Bt, int ldb, int K, f32x4 (&acc)[8][4], unsigned char* smem, int tid) {
    asm volatile("" : "+v"(tid));
    const int lane = tid & 63, w = __builtin_amdgcn_readfirstlane(tid >> 6), wm = w >> 2, wn = w & 3, idx = lane & 15, kq = lane >> 4;
    unsigned offA[4], offB[4];
#pragma unroll
    for (int j = 0; j < 4; ++j) { const int row = (j * 8 + w) * 8 + (lane >> 3), c = (lane & 7) ^ ((row >> 1) & 7);
        offA[j] = (unsigned)(row * lda + c * 8) * 2u; offB[j] = (unsigned)(row * ldb + c * 8) * 2u; }
#pragma unroll
    for (int mi = 0; mi < 8; ++mi)
#pragma unroll
        for (int ni = 0; ni < 4; ++ni) acc[mi][ni] = (f32x4){0.f, 0.f, 0.f, 0.f};
    LDSAS unsigned char* lds = (LDSAS unsigned char*)smem;
#define G_ISSUE(kt, st) do { _Pragma("unroll") for (int j = 0; j < 4; ++j) { \
        __builtin_amdgcn_global_load_lds((const unsigned*)((const char*)A + offA[j] + (kt) * 128), (LDSAS unsigned*)(lds + (st) * G_STAGE + (j * 8 + w) * 1024), 16, 0, 0); \
        __builtin_amdgcn_global_load_lds((const unsigned*)((const char*)Bt + offB[j] + (kt) * 128), (LDSAS unsigned*)(lds + (st) * G_STAGE + G_AB + (j * 8 + w) * 1024), 16, 0, 0); } } while (0)
    const int nk = K >> 6;
    G_ISSUE(0, 0);
    asm volatile("s_waitcnt vmcnt(0)" ::: "memory");
    __syncthreads();
    const int swz = (idx >> 1) & 7;
    const int aoff = (wm * 128 + idx) * 128, boff = G_AB + (wn * 64 + idx) * 128;
    for (int kt = 0; kt < nk; ++kt) {
        const int st = kt & 1;
        if (kt + 1 < nk) G_ISSUE(kt + 1, st ^ 1);
        const unsigned char* sb = smem + st * G_STAGE;
#pragma unroll
        for (int ks = 0; ks < 2; ++ks) {
            bf16x8 bfr[4];
            const int co = ((ks * 4 + kq) ^ swz) * 16;
#pragma unroll
            for (int ni = 0; ni < 4; ++ni) bfr[ni] = *(const bf16x8*)(sb + boff + ni * 2048 + co);
#pragma unroll
            for (int mh = 0; mh < 2; ++mh) {
                bf16x8 af[4];
#pragma unroll
                for (int mi = 0; mi < 4; ++mi) af[mi] = *(const bf16x8*)(sb + aoff + (mh * 4 + mi) * 2048 + co);
#pragma unroll
                for (int mi = 0; mi < 4; ++mi)
#pragma unroll
                    for (int ni = 0; ni < 4; ++ni) acc[mh * 4 + mi][ni] = __builtin_amdgcn_mfma_f32_16x16x32_bf16(bfr[ni], af[mi], acc[mh * 4 + mi][ni], 0, 0, 0);
            }
        }
        asm volatile("s_waitcnt vmcnt(0)" ::: "memory");
        __syncthreads();
    }
#undef G_ISSUE
}

__device__ __forceinline__ void st4bf(bf16_t* dst, f32x4 v) { u32x2 pk; pk.x = pk2(v.x, v.y); pk.y = pk2(v.z, v.w); *(u32x2*)dst = pk; }

__device__ void gemm1_phase(const Params& p, int l, int hb, unsigned char* smem) {
    const bf16_t* H = (const bf16_t*)(p.ws + WS_H);
    const bf16_t* Wt = (const bf16_t*)(p.ws + WS_WIN) + (size_t)l * NP * 1024;
    const float* ropec = (const float*)(p.ws + WS_ROPE); const float* ropes = ropec + 2048;
    constexpr int NT = 34, NTILES = 64 * NT, GRP = 8 * NT;
    for (int t = blockIdx.x; t < NTILES; t += gridDim.x) {
        const int grp = t / GRP, r = t % GRP, jx = NT * (r & 7) + (r >> 3), mt = grp * 8 + (jx & 7), nt = jx >> 3;
        const int m0 = mt * 256, n0 = nt * 256;
        f32x4 acc[8][4];
        int tid = threadIdx.x;
        gemm_core(H + (size_t)m0 * 1024, 1024, Wt + (size_t)n0 * 1024, 1024, 1024, acc, smem, tid);
        asm volatile("" : "+v"(tid));
        const int lane = tid & 63, w = tid >> 6, wm = w >> 2, wn = w & 3, idx = lane & 15, kq = lane >> 4;
        const int cw = n0 + wn * 64;
        const int lc = 4 * kq;
        if (cw < 768 && (cw < 640)) {
            const bool isq = cw < 512;
            const float* nwp = (isq ? p.q_norm_a : p.k_norm_a) + l * 64;
            bf16_t* dst = isq ? (bf16_t*)(p.ws + WS_QA) : (bf16_t*)(p.ws + WS_KA);
            const int pitch = isq ? 512 : 128, c0 = isq ? cw : cw - 512;
            const float qs = isq ? 0.125f * LOG2E : 1.f;
#pragma unroll
            for (int mi = 0; mi < 8; ++mi) {
                const int row = m0 + wm * 128 + mi * 16 + idx;
                float ss = 0.f;
#pragma unroll
                for (int ni = 0; ni < 4; ++ni) { const f32x4 v = acc[mi][ni]; ss += v.x * v.x + v.y * v.y + v.z * v.z + v.w * v.w; }
                ss += __shfl_xor(ss, 16); ss += __shfl_xor(ss, 32);
                const float rstd = rsqrtf(ss * (1.f / 64.f) + EPS);
                f32x4 y[4];
#pragma unroll
                for (int ni = 0; ni < 4; ++ni) y[ni] = acc[mi][ni] * rstd * *(const f32x4*)(nwp + ni * 16 + lc);
                const int tt = row & (SEQ - 1), prow = tt >> 6, pcol = tt & 63;
#pragma unroll
                for (int hf = 0; hf < 2; ++hf) {
                    const int pos = hf ? pcol : prow;
                    const f32x4 cs = *(const f32x4*)(ropec + pos * 16 + lc), sn = *(const f32x4*)(ropes + pos * 16 + lc);
                    const f32x4 a = y[2 * hf], b = y[2 * hf + 1];
                    y[2 * hf] = a * cs - b * sn; y[2 * hf + 1] = b * cs + a * sn;
                }
#pragma unroll
                for (int ni = 0; ni < 4; ++ni) st4bf(dst + (size_t)row * pitch + c0 + ni * 16 + lc, y[ni] * qs);
            }
        } else if (cw >= 1280 && cw < 2816) {
            const bool isq = cw < 2048;
            const float* nwp = (isq ? p.q_norm_b : p.k_norm_b) + l * 64;
            const int gc = isq ? cw - 1280 : cw - 2048, g = gc >> 8, c0 = gc & 255;
            const int sh = 2 * g;
            bf16_t* dst = (bf16_t*)(p.ws + (isq ? WS_QB : WS_KB));
            const float qs = isq ? 0.125f * LOG2E : 1.f;
#pragma unroll
            for (int mi = 0; mi < 8; ++mi) {
                const int row = m0 + wm * 128 + mi * 16 + idx;
                float ss = 0.f;
#pragma unroll
                for (int ni = 0; ni < 4; ++ni) { const f32x4 v = acc[mi][ni]; ss += v.x * v.x + v.y * v.y + v.z * v.z + v.w * v.w; }
                ss += __shfl_xor(ss, 16); ss += __shfl_xor(ss, 32);
                const float rstd = rsqrtf(ss * (1.f / 64.f) + EPS) * qs;
                const int bl = row >> 13, tt = row & (SEQ - 1);
                const int pp = (tt & ((1 << sh) - 1)) * (SEQ >> sh) + (tt >> sh);
                bf16_t* drow = dst + ((size_t)(bl * 3 + g) * SEQ + pp) * 256 + c0 + lc;
#pragma unroll
                for (int ni = 0; ni < 4; ++ni) st4bf(drow + ni * 16, acc[mi][ni] * rstd * *(const f32x4*)(nwp + ni * 16 + lc));
            }
        } else if (cw >= 2816 && cw < 3584) {
            const int gc = cw - 2816, g = gc >> 8, c0 = gc & 255, sh = 2 * g;
            bf16_t* dst = (bf16_t*)(p.ws + WS_VB);
#pragma unroll
            for (int mi = 0; mi < 8; ++mi) {
                const int row = m0 + wm * 128 + mi * 16 + idx;
                const int bl = row >> 13, tt = row & (SEQ - 1);
                const int pp = (tt & ((1 << sh) - 1)) * (SEQ >> sh) + (tt >> sh);
                bf16_t* drow = dst + ((size_t)(bl * 3 + g) * SEQ + pp) * 256 + c0 + lc;
#pragma unroll
                for (int ni = 0; ni < 4; ++ni) st4bf(drow + ni * 16, acc[mi][ni]);
            }
        } else if (cw >= 8448) {
            if (cw == 8448) {
                float* dst = (float*)(p.ws + WS_DT);
                const f32x4 bias = *(const f32x4*)(p.dt_bias + l * 16 + lc);
#pragma unroll
                for (int mi = 0; mi < 8; ++mi) {
                    const int row = m0 + wm * 128 + mi * 16 + idx;
                    f32x4 v = acc[mi][0] + bias, o;
                    o.x = v.x > 20.f ? v.x : log1pf(__expf(v.x)); o.y = v.y > 20.f ? v.y : log1pf(__expf(v.y));
                    o.z = v.z > 20.f ? v.z : log1pf(__expf(v.z)); o.w = v.w > 20.f ? v.w : log1pf(__expf(v.w));
                    *(f32x4*)(dst + (size_t)row * 16 + lc) = o;
                }
            }
        } else {
            bf16_t* dst; int pitch, c0, mode;
            if (cw < 768) { dst = (bf16_t*)(p.ws + WS_VA); pitch = 128; c0 = cw - 640; mode = 0; }
            else if (cw < 1280) { dst = (bf16_t*)(p.ws + WS_GA); pitch = 512; c0 = cw - 768; mode = 1; }
            else if (cw < 3840) { dst = (bf16_t*)(p.ws + WS_GB); pitch = 256; c0 = cw - 3584; mode = 1; }
            else if (cw < 4864) { dst = (bf16_t*)(p.ws + WS_XBC); pitch = 1024; c0 = cw - 3840; mode = 0; }
            else if (cw < 5376) { dst = (bf16_t*)(p.ws + WS_ZS); pitch = 512; c0 = cw - 4864; mode = 1; }
            else { dst = (bf16_t*)(p.ws + WS_MG); pitch = 3072; c0 = cw - 5376; mode = 2; }
            const float* bg = p.b_gate + l * 3072 + c0 + lc;
#pragma unroll
            for (int mi = 0; mi < 8; ++mi) {
                const int row = m0 + wm * 128 + mi * 16 + idx;
#pragma unroll
                for (int ni = 0; ni < 4; ++ni) {
                    f32x4 v = acc[mi][ni];
                    if (mode == 1) { v.x = siluf(v.x); v.y = siluf(v.y); v.z = siluf(v.z); v.w = siluf(v.w); }
                    else if (mode == 2) { const f32x4 bb = *(const f32x4*)(bg + ni * 16); v.x = sigmf(v.x + bb.x); v.y = sigmf(v.y + bb.y); v.z = sigmf(v.z + bb.z); v.w = sigmf(v.w + bb.w); }
                    st4bf(dst + (size_t)row * pitch + c0 + ni * 16 + lc, v);
                }
            }
        }
    }
}

__device__ void merge_phase(const Params& p, int l, unsigned char* smem) {
    const bf16_t* MG = (const bf16_t*)(p.ws + WS_MG);
    const float* rstd = (const float*)(p.ws + WS_RSTD);
    bf16_t* MR = (bf16_t*)(p.ws + WS_MRG);
    for (int t = blockIdx.x; t < 64 * 4; t += gridDim.x) {
        const int xq = t >> 3, mt = (xq >> 2) * 8 + (t & 7), nt = xq & 3, m0 = mt * 256, n0 = nt * 256;
#pragma unroll 1
        for (int br = 0; br < 3; ++br) {
            f32x4 acc[8][4];
            const bf16_t* A; const bf16_t* Bt; int K;
            if (br == 0) { A = (const bf16_t*)(p.ws + WS_QA); K = 512; Bt = (const bf16_t*)(p.ws + WS_WPA) + (size_t)l * 1024 * 512; }
            else if (br == 1) { A = (const bf16_t*)(p.ws + WS_YBM); K = 256; Bt = (const bf16_t*)(p.ws + WS_WPB) + (size_t)l * 1024 * 256; }
            else { A = (const bf16_t*)(p.ws + WS_YC); K = 512; Bt = (const bf16_t*)(p.ws + WS_WPC) + (size_t)l * 1024 * 512; }
            int tid = threadIdx.x;
            gemm_core(A + (size_t)m0 * K, K, Bt + (size_t)n0 * K, K, K, acc, smem, tid);
            asm volatile("" : "+v"(tid));
            const int lane = tid & 63, w = tid >> 6, wm = w >> 2, wn = w & 3, idx = lane & 15, kq = lane >> 4;
#pragma unroll
            for (int mi = 0; mi < 8; ++mi) {
                const int row = m0 + wm * 128 + mi * 16 + idx;
                const float rs = (br == 2) ? rstd[row] : 1.f;
#pragma unroll
                for (int ni = 0; ni < 4; ++ni) {
                    const int col = n0 + wn * 64 + ni * 16 + 4 * kq;
                    const u32x2 g = *(const u32x2*)(MG + (size_t)row * 3072 + br * 1024 + col);
                    f32x4 gv; gv.x = bflo(g.x); gv.y = bfhi(g.x); gv.z = bflo(g.y); gv.w = bfhi(g.y);
                    f32x4 v = gv * rs * acc[mi][ni];
                    bf16_t* mp = MR + (size_t)row * 1024 + col;
                    if (br > 0) { const u32x2 o = *(const u32x2*)mp; v.x += bflo(o.x); v.y += bfhi(o.x); v.z += bflo(o.y); v.w += bfhi(o.y); }
                    st4bf(mp, v);
                }
            }
        }
    }
}

__device__ void out_phase(const Params& p, int l, int hb, const float* xsrc, unsigned char* smem) {
    const bf16_t* MR = (const bf16_t*)(p.ws + WS_MRG);
    const bf16_t* Wt = (const bf16_t*)(p.ws + WS_WOUT) + (size_t)l * 1024 * 1024;
    for (int t = blockIdx.x; t < 64 * 4; t += gridDim.x) {
        const int xq = t >> 3, mt = (xq >> 2) * 8 + (t & 7), nt = xq & 3, m0 = mt * 256, n0 = nt * 256;
        f32x4 acc[8][4];
        int tid = threadIdx.x;
        gemm_core(MR + (size_t)m0 * 1024, 1024, Wt + (size_t)n0 * 1024, 1024, 1024, acc, smem, tid);
        asm volatile("" : "+v"(tid));
        const int lane = tid & 63, w = tid >> 6, wm = w >> 2, wn = w & 3, idx = lane & 15, kq = lane >> 4;
#pragma unroll
        for (int mi = 0; mi < 8; ++mi) {
            const int row = m0 + wm * 128 + mi * 16 + idx; const size_t rg = (size_t)hb * TP + row; const int b = (int)(rg / SEQ);
            const float* gate = (const float*)(p.ws + WS_MOD) + (size_t)(l * 4 + b) * 3072 + 2048;
#pragma unroll
            for (int ni = 0; ni < 4; ++ni) {
                const int col = n0 + wn * 64 + ni * 16 + 4 * kq;
                const f32x4 xv = *(const f32x4*)(xsrc + rg * 1024 + col), gv = *(const f32x4*)(gate + col);
                *(f32x4*)(p.out + rg * 1024 + col) = xv + gv * acc[mi][ni];
            }
        }
    }
}

constexpr int AT_KS = 0, AT_VS = 9216, AT_LQ = 9216 + 8192, AT_LUT = AT_LQ + 512;

#define AT_STAGE_STORE() do { _Pragma("unroll") for (int i = 0; i < 2; ++i) { const int c = tid + 256 * i, row = c >> 3, ch = c & 7; \
        *(u32x4*)(Ks + row * 72 + ch * 8) = rk[i]; *(u32x4*)(Vs + (ch >> 2) * 4096 + row * 64 + (ch & 3) * 16) = rv[i]; } } while (0)

__device__ __forceinline__ void at_qk(f32x16& p0, f32x16& p1, const bf16_t* Ks, const bf16x8* qr, int r32, int hi) {
#pragma unroll
    for (int ds = 0; ds < 4; ++ds) {
        const bf16x8 k0 = *(const bf16x8*)(Ks + r32 * 72 + ds * 16 + hi * 8);
        const bf16x8 k1 = *(const bf16x8*)(Ks + (r32 + 32) * 72 + ds * 16 + hi * 8);
        p0 = __builtin_amdgcn_mfma_f32_32x32x16_bf16(k0, qr[ds], p0, 0, 0, 0);
        p1 = __builtin_amdgcn_mfma_f32_32x32x16_bf16(k1, qr[ds], p1, 0, 0, 0);
    }
}
__device__ __forceinline__ void at_pv(f32x16& o0, f32x16& o1, const f32x16& p0, const f32x16& p1, const unsigned char* Vs, int lane) {
    const int hi = lane >> 5;
    const unsigned char* vb = Vs + ((lane >> 4) & 1) * 32 + (lane & 3) * 8 + (4 * hi + ((lane & 15) >> 2)) * 64;
#pragma unroll
    for (int s = 0; s < 4; ++s) {
        u32x4 pw;
        if (s < 2) { pw.x = pk2(p0[8 * s + 0], p0[8 * s + 1]); pw.y = pk2(p0[8 * s + 2], p0[8 * s + 3]); pw.z = pk2(p0[8 * s + 4], p0[8 * s + 5]); pw.w = pk2(p0[8 * s + 6], p0[8 * s + 7]); }
        else { const int q = s - 2; pw.x = pk2(p1[8 * q + 0], p1[8 * q + 1]); pw.y = pk2(p1[8 * q + 2], p1[8 * q + 3]); pw.z = pk2(p1[8 * q + 4], p1[8 * q + 5]); pw.w = pk2(p1[8 * q + 6], p1[8 * q + 7]); }
        const bf16x8 pa = __builtin_bit_cast(bf16x8, pw);
        const bf16x8 v0 = cat8(tr16(vb + s * 1024), tr16(vb + s * 1024 + 512));
        const bf16x8 v1 = cat8(tr16(vb + 4096 + s * 1024), tr16(vb + 4096 + s * 1024 + 512));
        o0 = __builtin_amdgcn_mfma_f32_32x32x16_bf16(pa, v0, o0, 0, 0, 0);
        o1 = __builtin_amdgcn_mfma_f32_32x32x16_bf16(pa, v1, o1, 0, 0, 0);
    }
}

constexpr int ATA_STAGE = 17408, ATA_LQ = 2 * ATA_STAGE;
__device__ void attn_a_item(const Params& p, int item, int l, unsigned char* smem) {
    int tid_ = VTID; asm volatile("" : "+v"(tid_));
    const int tid = tid_, lane = tid & 63, w = tid >> 6, r32 = lane & 31, hi = lane >> 5;
    const int b = item >> 9, r = item & 511, kvh = r >> 8, qblk = (r >> 2) & 63, hq = kvh * 4 + (r & 3);
    float* lq = (float*)(smem + ATA_LQ) + w * 32;
    bf16_t* QA = (bf16_t*)(p.ws + WS_QA);
    const bf16_t* GA = (const bf16_t*)(p.ws + WS_GA);
    const size_t tokq = (size_t)b * SEQ + qblk * 128 + w * 32;
    bf16x8 qr[4];
#pragma unroll
    for (int ds = 0; ds < 4; ++ds) qr[ds] = *(const bf16x8*)(QA + (tokq + r32) * 512 + hq * 64 + ds * 16 + hi * 8);
    const bf16_t* Kb = (const bf16_t*)(p.ws + WS_KA) + (size_t)b * SEQ * 128 + kvh * 64;
    const bf16_t* Vb = (const bf16_t*)(p.ws + WS_VA) + (size_t)b * SEQ * 128 + kvh * 64;
    const float nshift = -((const float*)(p.ws + WS_BND))[l];
    f32x16 o0, o1;
#pragma unroll
    for (int i = 0; i < 16; ++i) { o0[i] = 0.f; o1[i] = 0.f; }
    float lacc = 0.f;
    constexpr int NT = SEQ / 64;
    const int row0 = tid >> 3, ch0 = tid & 7;
    const size_t goff0 = (size_t)row0 * 128 + ch0 * 8, goff1 = goff0 + (size_t)32 * 128;
    const int ko0 = row0 * 144 + ch0 * 16, ko1 = ko0 + 32 * 144;
    const int vo0 = 9216 + (ch0 >> 2) * 4096 + row0 * 64 + (ch0 & 3) * 16, vo1 = vo0 + 32 * 64;
    u32x4 rkA[2], rvA[2], rkB[2], rvB[2];
#define ATA_LOAD(RK, RV, t) do { const size_t tb = (size_t)(t) * 64 * 128; RK[0] = *(const u32x4*)(Kb + tb + goff0); RK[1] = *(const u32x4*)(Kb + tb + goff1); \
        RV[0] = *(const u32x4*)(Vb + tb + goff0); RV[1] = *(const u32x4*)(Vb + tb + goff1); } while (0)
#define ATA_STORE(RK, RV, st) do { unsigned char* sb_ = smem + (st) * ATA_STAGE; *(u32x4*)(sb_ + ko0) = RK[0]; *(u32x4*)(sb_ + ko1) = RK[1]; \
        *(u32x4*)(sb_ + vo0) = RV[0]; *(u32x4*)(sb_ + vo1) = RV[1]; } while (0)
#define ATA_COMPUTE(st) do { const unsigned char* sb_ = smem + (st) * ATA_STAGE; f32x16 p0, p1; \
        _Pragma("unroll") for (int i = 0; i < 16; ++i) { p0[i] = nshift; p1[i] = nshift; } \
        at_qk(p0, p1, (const bf16_t*)sb_, qr, r32, hi); \
        _Pragma("unroll") for (int i = 0; i < 16; ++i) { p0[i] = __builtin_amdgcn_exp2f(p0[i]); p1[i] = __builtin_amdgcn_exp2f(p1[i]); lacc += p0[i] + p1[i]; } \
        at_pv(o0, o1, p0, p1, sb_ + 9216, lane); } while (0)
    __syncthreads();
    ATA_LOAD(rkA, rvA, 0); ATA_LOAD(rkB, rvB, 1);
    ATA_STORE(rkA, rvA, 0);
    ATA_LOAD(rkA, rvA, 2);
    __syncthreads();
    for (int kt = 0; kt < NT; kt += 2) {
        ATA_COMPUTE(0);
        ATA_STORE(rkB, rvB, 1);
        if (kt + 3 < NT) ATA_LOAD(rkB, rvB, kt + 3);
        __syncthreads();
        ATA_COMPUTE(1);
        if (kt + 2 < NT) { ATA_STORE(rkA, rvA, 0); if (kt + 4 < NT) ATA_LOAD(rkA, rvA, kt + 4); }
        __syncthreads();
    }
#undef ATA_LOAD
#undef ATA_STORE
#undef ATA_COMPUTE
    lacc += __shfl_xor(lacc, 32);
    if (hi == 0) lq[r32] = lacc;
    asm volatile("s_waitcnt lgkmcnt(0)" ::: "memory");
#pragma unroll
    for (int rr = 0; rr < 16; ++rr) {
        const int q = crow(rr, hi); const float inv = 1.f / lq[q];
        const size_t off = (tokq + q) * 512 + hq * 64 + r32;
        const float g0 = bf2f(GA[off]), g1 = bf2f(GA[off + 32]);
        QA[off] = (bf16_t)(pk2(o0[rr] * inv * g0, 0.f) & 0xffffu);
        QA[off + 32] = (bf16_t)(pk2(o1[rr] * inv * g1, 0.f) & 0xffffu);
    }
}

__device__ void attn_b_item(const Params& p, int item, int l, unsigned char* smem) {
    int tid_ = VTID; asm volatile("" : "+v"(tid_));
    const int tid = tid_, lane = tid & 63, w = tid >> 6, r32 = lane & 31, hi = lane >> 5;
    const int blk = item & 63, j = (item >> 6) & 3, bg = item >> 8, g = bg % 3, b = bg / 3;
    const int sh = 2 * g, dil = 1 << sh, Mlen = SEQ >> sh;
    bf16_t* Ks = (bf16_t*)(smem + AT_KS); unsigned char* Vs = smem + AT_VS; float* lq = (float*)(smem + AT_LQ) + w * 32; float* lut = (float*)(smem + AT_LUT);
    bf16_t* QB = (bf16_t*)(p.ws + WS_QB) + (size_t)bg * SEQ * 256 + j * 64;
    const bf16_t* KB = (const bf16_t*)(p.ws + WS_KB) + (size_t)bg * SEQ * 256 + j * 64;
    const bf16_t* VB = (const bf16_t*)(p.ws + WS_VB) + (size_t)bg * SEQ * 256 + j * 64;
    float* LSE = (float*)(p.ws + WS_LSE) + (size_t)bg * SEQ * 4 + j;
    const int p0r = blk * 128, seq_lo = (p0r / Mlen) * Mlen, seq_hi = seq_lo + Mlen;
    __syncthreads();
    if (tid < 129) {
        const int rel = tid - 64, n = (rel < 0 ? -rel : rel) * dil;
        int bk;
        if (n < 8) bk = n; else { bk = 8 + (n >= 15) + (n >= 27) + (n >= 50) + (n >= 91) + (n >= 166) + (n >= 305) + (n >= 559); }
        if (rel > 0) bk += 16;
        lut[tid] = p.rel_bias[bk * 12 + g * 4 + j] * LOG2E;
    }
    const int qpos = p0r + w * 32 + r32;
    bf16x8 qr[4];
#pragma unroll
    for (int ds = 0; ds < 4; ++ds) qr[ds] = *(const bf16x8*)(QB + (size_t)qpos * 256 + ds * 16 + hi * 8);
    const float nshift = -((const float*)(p.ws + WS_BND))[2 + l];
    f32x16 o0, o1;
#pragma unroll
    for (int i = 0; i < 16; ++i) { o0[i] = 0.f; o1[i] = 0.f; }
    float lacc = 0.f;
    u32x4 rk[2], rv[2];
    for (int kt = 0; kt < 4; ++kt) {
        const int kbase = p0r - 64 + 64 * kt;
#pragma unroll
        for (int i = 0; i < 2; ++i) { const int c = tid + 256 * i, row = c >> 3, ch = c & 7;
            int pr = kbase + row; pr = pr < 0 ? 0 : (pr > SEQ - 1 ? SEQ - 1 : pr);
            rk[i] = *(const u32x4*)(KB + (size_t)pr * 256 + ch * 8); rv[i] = *(const u32x4*)(VB + (size_t)pr * 256 + ch * 8); }
        __syncthreads();
        AT_STAGE_STORE();
        __syncthreads();
        f32x16 p0, p1;
#pragma unroll
        for (int i = 0; i < 16; ++i) { p0[i] = nshift; p1[i] = nshift; }
        at_qk(p0, p1, Ks, qr, r32, hi);
#pragma unroll
        for (int i = 0; i < 16; ++i) {
            const int kv0 = kbase + crow(i, hi), kv1 = kv0 + 32;
            const int rel0 = kv0 - qpos, rel1 = kv1 - qpos;
            const bool ok0 = rel0 >= -64 && rel0 <= 64 && kv0 >= seq_lo && kv0 < seq_hi;
            const bool ok1 = rel1 >= -64 && rel1 <= 64 && kv1 >= seq_lo && kv1 < seq_hi;
            const float e0 = __builtin_amdgcn_exp2f(p0[i] + lut[ok0 ? rel0 + 64 : 64]);
            const float e1 = __builtin_amdgcn_exp2f(p1[i] + lut[ok1 ? rel1 + 64 : 64]);
            p0[i] = ok0 ? e0 : 0.f; p1[i] = ok1 ? e1 : 0.f; lacc += p0[i] + p1[i];
        }
        at_pv(o0, o1, p0, p1, Vs, lane);
    }
    lacc += __shfl_xor(lacc, 32);
    if (hi == 0) { lq[r32] = lacc; LSE[(size_t)qpos * 4] = (-nshift + log2f(lacc)) * LN2; }
    asm volatile("s_waitcnt lgkmcnt(0)" ::: "memory");
#pragma unroll
    for (int rr = 0; rr < 16; ++rr) {
        const int q = crow(rr, hi); const float inv = 1.f / lq[q];
        const size_t off = (size_t)(p0r + w * 32 + q) * 256 + r32;
        QB[off] = (bf16_t)(pk2(o0[rr] * inv, 0.f) & 0xffffu);
        QB[off + 32] = (bf16_t)(pk2(o1[rr] * inv, 0.f) & 0xffffu);
    }
}

constexpr int SS_BS = 0, SS_CS = 8704, SS_XS = 17408, SS_XWS = 22016, SS_GS = 26624, SS_SB = 29184, SS_CW = 46592, SS_SC = 54272, SS_DTA = 55296, SS_END = 57344;

template <int PASS>
__device__ void ssd_item(const Params& p, int item, int l, unsigned char* smem) {
    int tid_ = VTID; asm volatile("" : "+v"(tid_));
    const int tid = tid_, lane = tid & 63, w = tid >> 6, idx = lane & 15, kq = lane >> 4;
    const int seg = item & 15, h = (item >> 4) & 7, dir = (item >> 7) & 1, b = item >> 8, grp = h >> 2;
    bf16_t* Bs = (bf16_t*)(smem + SS_BS); bf16_t* Cs = (bf16_t*)(smem + SS_CS); bf16_t* Xs = (bf16_t*)(smem + SS_XS); bf16_t* Xws = (bf16_t*)(smem + SS_XWS);
    bf16_t* Gs = (bf16_t*)(smem + SS_GS); bf16_t* Sb = (bf16_t*)(smem + SS_SB); float* cwl = (float*)(smem + SS_CW); float* sc = (float*)(smem + SS_SC);
    float* s_dt = sc, *s_c = sc + 32, *s_rs = sc + 64, *s_wl = sc + 96, *s_tot = sc + 128;
    const bf16_t* XBC = (const bf16_t*)(p.ws + WS_XBC);
    const float* DT = (const float*)(p.ws + WS_DT);
    float* ST = (float*)(p.ws + WS_ST); float* SEGT = (float*)(p.ws + WS_SEGT);
    bf16_t* Y = (bf16_t*)(p.ws + (dir ? WS_YS : WS_YF));
    const float Aneg = -__expf(p.a_log[l * 16 + dir * 8 + h]);
    const float Dh = p.d_skip[l * 8 + h];
    __syncthreads();
    for (int e = tid; e < 6 * 320; e += 256) {
        const int tap = e / 320, lc = e % 320;
        const int ch = lc < 64 ? h * 64 + lc : (lc < 192 ? 512 + grp * 128 + (lc - 64) : 768 + grp * 128 + (lc - 192));
        cwl[e] = tap < 5 ? p.conv_w[(size_t)l * 5 * 1024 + tap * 1024 + ch] : p.conv_b[l * 1024 + ch];
    }
    f32x4 S[8];
#pragma unroll
    for (int nt = 0; nt < 8; ++nt) S[nt] = (f32x4){0.f, 0.f, 0.f, 0.f};
    const int ibase = item & ~15;
    if (PASS == 3) {
        if (dir == 0) {
            for (int e = 0; e < seg; ++e) { const float dc = __expf(SEGT[ibase + e]); const f32x4* src = (const f32x4*)(ST + (size_t)(ibase + e) * 8192);
#pragma unroll
                for (int nt = 0; nt < 8; ++nt) S[nt] = S[nt] * dc + src[(w * 8 + nt) * 64 + lane]; }
        } else {
            for (int e = NSEG - 1; e > seg; --e) { const float dc = __expf(SEGT[ibase + e]); const f32x4* src = (const f32x4*)(ST + (size_t)(ibase + e) * 8192);
#pragma unroll
                for (int nt = 0; nt < 8; ++nt) S[nt] = S[nt] * dc + src[(w * 8 + nt) * 64 + lane]; }
        }
#pragma unroll
        for (int nt = 0; nt < 8; ++nt) st4bf(Sb + (16 * w + idx) * 136 + 16 * nt + 4 * kq, S[nt]);
    }
    float* s_dta = (float*)(smem + SS_DTA);
    for (int e = tid; e < SEGLEN; e += 256) s_dta[e] = DT[((size_t)b * SEQ + seg * SEGLEN + e) * 16 + dir * 8 + h];
    float segtot = 0.f;
    const int ci0 = tid % 40, tg0 = tid / 40, ci1 = (tid + 64) % 40, tg1 = (tid + 64) / 40;
    const int sc0 = ci0 < 8 ? h * 64 + ci0 * 8 : (ci0 < 24 ? 512 + grp * 128 + (ci0 * 8 - 64) : 768 + grp * 128 + (ci0 * 8 - 192));
    const int sc1 = ci1 < 8 ? h * 64 + ci1 * 8 : (ci1 < 24 ? 512 + grp * 128 + (ci1 * 8 - 64) : 768 + grp * 128 + (ci1 * 8 - 192));
    const bool has1 = tid >= 192;
#define SS_CONV(RAW, CI, TG) do { const int lc_ = (CI) * 8; float ac_[4][8]; \
        { const f32x4 a_ = *(const f32x4*)(cwl + 5 * 320 + lc_), b_ = *(const f32x4*)(cwl + 5 * 320 + lc_ + 4); \
          _Pragma("unroll") for (int l_ = 0; l_ < 4; ++l_) { ac_[l_][0] = a_.x; ac_[l_][1] = a_.y; ac_[l_][2] = a_.z; ac_[l_][3] = a_.w; ac_[l_][4] = b_.x; ac_[l_][5] = b_.y; ac_[l_][6] = b_.z; ac_[l_][7] = b_.w; } } \
        _Pragma("unroll") for (int k_ = 0; k_ < 5; ++k_) { const f32x4 wa_ = *(const f32x4*)(cwl + k_ * 320 + lc_), wb_ = *(const f32x4*)(cwl + k_ * 320 + lc_ + 4); \
            _Pragma("unroll") for (int l_ = 0; l_ < 4; ++l_) { const u32x4 v_ = RAW[l_ + k_]; \
                ac_[l_][0] += bflo(v_.x) * wa_.x; ac_[l_][1] += bfhi(v_.x) * wa_.y; ac_[l_][2] += bflo(v_.y) * wa_.z; ac_[l_][3] += bfhi(v_.y) * wa_.w; \
                ac_[l_][4] += bflo(v_.z) * wb_.x; ac_[l_][5] += bfhi(v_.z) * wb_.y; ac_[l_][6] += bflo(v_.w) * wb_.z; ac_[l_][7] += bfhi(v_.w) * wb_.w; } \
            asm volatile("" ::: "memory"); } \
        _Pragma("unroll") for (int l_ = 0; l_ < 4; ++l_) { const int lrow_ = 4 * (TG) + l_; float* a_ = ac_[l_]; \
            _Pragma("unroll") for (int e_ = 0; e_ < 8; ++e_) a_[e_] = siluf(a_[e_]); \
            u32x4 o_; o_.x = pk2(a_[0], a_[1]); o_.y = pk2(a_[2], a_[3]); o_.z = pk2(a_[4], a_[5]); o_.w = pk2(a_[6], a_[7]); \
            if ((CI) < 8) { *(u32x4*)(Xs + lrow_ * 72 + lc_) = o_; const float wl_ = s_wl[lrow_]; \
                u32x4 o2_; o2_.x = pk2(a_[0] * wl_, a_[1] * wl_); o2_.y = pk2(a_[2] * wl_, a_[3] * wl_); o2_.z = pk2(a_[4] * wl_, a_[5] * wl_); o2_.w = pk2(a_[6] * wl_, a_[7] * wl_); \
                *(u32x4*)(Xws + lrow_ * 72 + lc_) = o2_; } \
            else if ((CI) < 24) *(u32x4*)(Bs + lrow_ * 136 + (lc_ - 64)) = o_; \
            else *(u32x4*)(Cs + lrow_ * 136 + (lc_ - 192)) = o_; } } while (0)
    const size_t tokb = (size_t)b * SEQ;
    const unsigned char* xb_ = (const unsigned char*)(XBC + tokb * 1024);
    u32x4 raw0[8];
#define SS_LOAD0(T0) do { const unsigned o0_ = (unsigned)((((T0) + 4 * tg0 - 2) * 1024 + sc0) * 2); \
        _Pragma("unroll") for (int r_ = 0; r_ < 8; ++r_) { const int tt0 = (T0) + 4 * tg0 - 2 + r_; raw0[r_] = (u32x4){0u, 0u, 0u, 0u}; \
            if (tt0 >= 0 && tt0 < SEQ) raw0[r_] = *(const u32x4*)(xb_ + (o0_ + (unsigned)(r_ * 2048))); } } while (0)
    for (int si = 0; si < NSUB; ++si) {
        const int scn = dir ? (NSUB - 1 - si) : si;
        const int t0 = seg * SEGLEN + scn * TSUB;
        __syncthreads();
        SS_LOAD0(t0);
        if (w == 0) {
            float dtv = 0.f, av = 0.f;
            if (lane < 32) { dtv = s_dta[scn * TSUB + lane]; av = dtv * Aneg; }
            float pre = av;
#pragma unroll
            for (int o = 1; o < 32; o <<= 1) { const float t = __shfl_up(pre, o); if (lane >= o) pre += t; }
            const float tot = __shfl(pre, 31);
            const float cc = dir ? (tot - pre + av) : pre;
            if (lane < 32) { s_dt[lane] = dtv; s_c[lane] = cc; s_rs[lane] = __expf(cc); s_wl[lane] = dtv * __expf(tot - cc); }
            if (lane == 0) s_tot[0] = tot;
        }
        __syncthreads();
        segtot += s_tot[0];
        SS_CONV(raw0, ci0, tg0);
        if (has1) {
            const unsigned o1_ = (unsigned)(((t0 + 4 * tg1 - 2) * 1024 + sc1) * 2);
#pragma unroll
            for (int r_ = 0; r_ < 8; ++r_) {
                const int tt1 = t0 + 4 * tg1 - 2 + r_;
                raw0[r_] = (u32x4){0u, 0u, 0u, 0u};
                if (tt1 >= 0 && tt1 < SEQ) raw0[r_] = *(const u32x4*)(xb_ + (o1_ + (unsigned)(r_ * 2048)));
            }
            SS_CONV(raw0, ci1, tg1);
        }
        __syncthreads();
        if (PASS == 3) {
            const int it = w >> 1, jt = w & 1;
            f32x4 cb = (f32x4){0.f, 0.f, 0.f, 0.f};
#pragma unroll
            for (int ks = 0; ks < 4; ++ks) {
                const bf16x8 fb = *(const bf16x8*)(Bs + (16 * jt + idx) * 136 + ks * 32 + kq * 8);
                const bf16x8 fc = *(const bf16x8*)(Cs + (16 * it + idx) * 136 + ks * 32 + kq * 8);
                cb = __builtin_amdgcn_mfma_f32_16x16x32_bf16(fb, fc, cb, 0, 0, 0);
            }
            {
                const int ii = 16 * it + idx; const float ci_ = s_c[ii];
                f32x4 gv;
#pragma unroll
                for (int rg = 0; rg < 4; ++rg) {
                    const int jj = 16 * jt + 4 * kq + rg;
                    const bool ok = dir ? (jj >= ii) : (jj <= ii);
                    const float e = __expf(ci_ - s_c[jj]) * s_dt[jj];
                    gv[rg] = ok ? cb[rg] * e : 0.f;
                }
                st4bf(Gs + ii * 40 + 16 * jt + 4 * kq, gv);
            }
            __syncthreads();
            const unsigned char* xtr = (const unsigned char*)Xs + (8 * kq + (idx >> 2)) * 144 + (16 * w + 4 * (idx & 3)) * 2;
            const bf16x8 xf = cat8(tr16(xtr), tr16(xtr + 4 * 144));
#pragma unroll 1
            for (int it2 = 0; it2 < 2; ++it2) {
                const int ii = 16 * it2 + idx;
                const bf16x8 gf = *(const bf16x8*)(Gs + ii * 40 + 8 * kq);
                f32x4 yd = (f32x4){0.f, 0.f, 0.f, 0.f}, yo = (f32x4){0.f, 0.f, 0.f, 0.f};
                yd = __builtin_amdgcn_mfma_f32_16x16x32_bf16(xf, gf, yd, 0, 0, 0);
#pragma unroll
                for (int ks = 0; ks < 4; ++ks) {
                    const bf16x8 sf = *(const bf16x8*)(Sb + (16 * w + idx) * 136 + ks * 32 + kq * 8);
                    const bf16x8 cf = *(const bf16x8*)(Cs + ii * 136 + ks * 32 + kq * 8);
                    yo = __builtin_amdgcn_mfma_f32_16x16x32_bf16(sf, cf, yo, 0, 0, 0);
                }
                f32x4 y = yd + yo * s_rs[ii];
                if (dir == 0) { const u32x2 xv = *(const u32x2*)(Xs + ii * 72 + 16 * w + 4 * kq);
                    y.x += Dh * bflo(xv.x); y.y += Dh * bfhi(xv.x); y.z += Dh * bflo(xv.y); y.w += Dh * bfhi(xv.y); }
                st4bf(Y + (tokb + t0 + ii) * 512 + h * 64 + 16 * w + 4 * kq, y);
            }
        }
        {
            const float dc = __expf(s_tot[0]);
            const unsigned char* xw = (const unsigned char*)Xws + (8 * kq + (idx >> 2)) * 144 + (16 * w + 4 * (idx & 3)) * 2;
            const bf16x8 xwf = cat8(tr16(xw), tr16(xw + 4 * 144));
#pragma unroll
            for (int nt = 0; nt < 8; ++nt) {
                const unsigned char* bt = (const unsigned char*)Bs + (8 * kq + (idx >> 2)) * 272 + (16 * nt + 4 * (idx & 3)) * 2;
                const bf16x8 bf = cat8(tr16(bt), tr16(bt + 4 * 272));
                S[nt] = __builtin_amdgcn_mfma_f32_16x16x32_bf16(bf, xwf, S[nt] * dc, 0, 0, 0);
            }
            if (PASS == 3) {
#pragma unroll
                for (int nt = 0; nt < 8; ++nt) st4bf(Sb + (16 * w + idx) * 136 + 16 * nt + 4 * kq, S[nt]);
            }
        }
    }
    if (PASS == 1) {
        f32x4* dst = (f32x4*)(ST + (size_t)item * 8192);
#pragma unroll
        for (int nt = 0; nt < 8; ++nt) dst[(w * 8 + nt) * 64 + lane] = S[nt];
        if (tid == 0) SEGT[item] = segtot;
    }
}

__device__ void post2_phase(const Params& p) {
    int tx_ = threadIdx.x; asm volatile("" : "+v"(tx_));
    const int lane = tx_ & 63, gw = blockIdx.x * 8 + (tx_ >> 6), nw = gridDim.x * 8;
    const bf16_t* OB = (const bf16_t*)(p.ws + WS_QB); const float* LSE = (const float*)(p.ws + WS_LSE);
    const bf16_t* GB = (const bf16_t*)(p.ws + WS_GB);
    bf16_t* YBM = (bf16_t*)(p.ws + WS_YBM);
    const bf16_t* YF = (const bf16_t*)(p.ws + WS_YF); const bf16_t* YS = (const bf16_t*)(p.ws + WS_YS); const bf16_t* ZS = (const bf16_t*)(p.ws + WS_ZS);
    bf16_t* YC = (bf16_t*)(p.ws + WS_YC); float* RS = (float*)(p.ws + WS_RSTD);
    for (int row = gw; row < TP; row += nw) {
        const int bl = row >> 13, tt = row & (SEQ - 1), j = lane >> 4;
        float ls[3]; size_t ro[3];
#pragma unroll
        for (int g = 0; g < 3; ++g) { const int sh = 2 * g; const int pp = (tt & ((1 << sh) - 1)) * (SEQ >> sh) + (tt >> sh);
            ro[g] = (size_t)(bl * 3 + g) * SEQ + pp; ls[g] = LSE[ro[g] * 4 + j]; }
        const float mx = fmaxf(ls[0], fmaxf(ls[1], ls[2]));
        float wg[3]; float ws = 0.f;
#pragma unroll
        for (int g = 0; g < 3; ++g) { wg[g] = __expf(ls[g] - mx); ws += wg[g]; }
        const float inv = 1.f / ws;
        f32x4 acc = (f32x4){0.f, 0.f, 0.f, 0.f};
#pragma unroll
        for (int g = 0; g < 3; ++g) { const u32x2 v = *(const u32x2*)(OB + ro[g] * 256 + 4 * lane); const float wv = wg[g] * inv;
            acc.x += wv * bflo(v.x); acc.y += wv * bfhi(v.x); acc.z += wv * bflo(v.y); acc.w += wv * bfhi(v.y); }
        { const u32x2 gt = *(const u32x2*)(GB + (size_t)row * 256 + 4 * lane);
          acc.x *= bflo(gt.x); acc.y *= bfhi(gt.x); acc.z *= bflo(gt.y); acc.w *= bfhi(gt.y); }
        st4bf(YBM + (size_t)row * 256 + 4 * lane, acc);
        const u32x4 a = *(const u32x4*)(YF + (size_t)row * 512 + 8 * lane), bq = *(const u32x4*)(YS + (size_t)row * 512 + 8 * lane), z = *(const u32x4*)(ZS + (size_t)row * 512 + 8 * lane);
        float y[8];
        y[0] = (bflo(a.x) + bflo(bq.x)) * bflo(z.x); y[1] = (bfhi(a.x) + bfhi(bq.x)) * bfhi(z.x);
        y[2] = (bflo(a.y) + bflo(bq.y)) * bflo(z.y); y[3] = (bfhi(a.y) + bfhi(bq.y)) * bfhi(z.y);
        y[4] = (bflo(a.z) + bflo(bq.z)) * bflo(z.z); y[5] = (bfhi(a.z) + bfhi(bq.z)) * bfhi(z.z);
        y[6] = (bflo(a.w) + bflo(bq.w)) * bflo(z.w); y[7] = (bfhi(a.w) + bfhi(bq.w)) * bfhi(z.w);
        float ss = 0.f;
#pragma unroll
        for (int e = 0; e < 8; ++e) ss += y[e] * y[e];
        ss = wave_sum(ss);
        u32x4 o; o.x = pk2(y[0], y[1]); o.y = pk2(y[2], y[3]); o.z = pk2(y[4], y[5]); o.w = pk2(y[6], y[7]);
        *(u32x4*)(YC + (size_t)row * 512 + 8 * lane) = o;
        if (lane == 0) RS[row] = rsqrtf(ss * (1.f / 512.f) + EPS);
    }
}


#define XB_TMO      128
#define XB_XCNT(j)  (256  + 64 * (j))
#define XB_XSUB(j)  (1280 + 64 * (j))
#define XB_XGEN(j)  (2304 + 64 * (j))
#define XB_TOP      3328
#define XB_TOPGEN   3392
#define XCD_BAR_WORDS 3456
#define XB_SPIN_CAP (1u << 20)
__device__ __forceinline__ unsigned xb_ld(unsigned* p)              { return __hip_atomic_load(p, __ATOMIC_RELAXED, __HIP_MEMORY_SCOPE_AGENT); }
__device__ __forceinline__ unsigned xb_add(unsigned* p, unsigned v) { return __hip_atomic_fetch_add(p, v, __ATOMIC_RELAXED, __HIP_MEMORY_SCOPE_AGENT); }
__device__ __forceinline__ unsigned xb_xcc_id() { return (unsigned)__builtin_amdgcn_s_getreg((3 << 11) | 20) & 0xFu; }
#define XB_SPIN(cond, bar) do { unsigned _sp = 0; while (cond) { __builtin_amdgcn_s_sleep(1); \
    if ((++_sp & 255u) == 0u) { if (xb_ld(&(bar)[XB_TMO])) break; if (_sp > XB_SPIN_CAP) { atomicAdd(&(bar)[XB_TMO], 1u); break; } } } } while (0)
struct XcdBarrier { unsigned* bar; unsigned x; volatile LDSAS unsigned* st; };
__device__ __forceinline__ XcdBarrier xcd_barrier_post(unsigned* bar, volatile LDSAS unsigned* st) {
    XcdBarrier b; b.bar = bar; b.x = xb_xcc_id(); b.st = st;
    if (threadIdx.x == 0) (void)xb_add(&bar[XB_XCNT(b.x)], 1u);
    return b;
}
__device__ __forceinline__ void xcd_barrier_complete(unsigned* bar, unsigned x, unsigned& nloc, unsigned& nx) {
    const unsigned G = gridDim.x * gridDim.y * gridDim.z;
    unsigned sum, cnt, mine, sp = 0u;
    for (;;) {
        sum = 0u; cnt = 0u; mine = 0u;
#pragma unroll
        for (unsigned j = 0; j < 16; ++j) { const unsigned c = xb_ld(&bar[XB_XCNT(j)]); sum += c; cnt += (c > 0u) ? 1u : 0u; mine = (j == x) ? c : mine; }
        if (sum == G) break;
        __builtin_amdgcn_s_sleep(1);
        if ((++sp & 255u) == 0u) { if (xb_ld(&bar[XB_TMO])) break; if (sp > XB_SPIN_CAP) { atomicAdd(&bar[XB_TMO], 1u); break; } }
    }
    nloc = mine > 0u ? mine : 1u; nx = cnt > 0u ? cnt : 1u;
}
__device__ __forceinline__ void xcd_barrier(const XcdBarrier& b) {
    asm volatile("s_waitcnt vmcnt(0)" ::: "memory");
    __syncthreads();
    if (threadIdx.x == 0) {
        unsigned* bar = b.bar;
        __builtin_amdgcn_s_waitcnt(0);
        unsigned nloc = b.st[0], nx = b.st[1];
        if (nloc == 0u) { xcd_barrier_complete(bar, b.x, nloc, nx); b.st[0] = nloc; b.st[1] = nx; }
        const unsigned old = xb_add(&bar[XB_XSUB(b.x)], 1u);
        const unsigned gen = old / nloc;
        if (old + 1u == (gen + 1u) * nloc) {
            __builtin_amdgcn_fence(__ATOMIC_RELEASE, "agent");
            asm volatile("s_waitcnt vmcnt(0)" ::: "memory");
            const unsigned og = xb_add(&bar[XB_TOP], 1u);
            const unsigned tg = og / nx;
            if (og + 1u == (tg + 1u) * nx) xb_add(&bar[XB_TOPGEN], 1u);
            else XB_SPIN(xb_ld(&bar[XB_TOPGEN]) == tg, bar);
            __builtin_amdgcn_fence(__ATOMIC_ACQUIRE, "agent");
            xb_add(&bar[XB_XGEN(b.x)], 1u);
            asm volatile("s_waitcnt vmcnt(0)" ::: "memory");
        } else {
            XB_SPIN(xb_ld(&bar[XB_XGEN(b.x)]) == gen, bar);
            __builtin_amdgcn_fence(__ATOMIC_ACQUIRE, "agent");
            asm volatile("s_waitcnt vmcnt(0)" ::: "memory");
        }
    }
    __syncthreads();
}

__device__ __forceinline__ unsigned char* lds_half(unsigned char* smem) { int h_ = threadIdx.x >> 8; asm volatile("" : "+v"(h_)); return smem + h_ * HALF_LDS; }
__global__ void __launch_bounds__(512, 2) hybrid_fwd(Params p) {
    cg::grid_group grid = cg::this_grid();
    extern __shared__ __attribute__((aligned(16))) unsigned char smem[];
    volatile LDSAS unsigned* bst = (volatile LDSAS unsigned*)(smem + LDS_TOTAL - 16);
    if (threadIdx.x < 4) bst[threadIdx.x] = 0u;
    __syncthreads();
    const XcdBarrier xbar = xcd_barrier_post((unsigned*)(p.ws + WS_BAR), bst);
    { const Params q = launder(p); phase0(q, lds_half(smem)); }
    grid.sync();
#pragma unroll 1
    for (int l = 0; l < DEPTH; ++l) {
#pragma unroll 1
        for (int hb = 0; hb < 2; ++hb) {
            { const Params q = launder(p); norm_phase(q, l, hb, (l == 0) ? q.x : q.out); }
            xcd_barrier(xbar);
            { const Params q = launder(p); gemm1_phase(q, l, hb, smem); }
            xcd_barrier(xbar);
            { const Params q = launder(p); unsigned char* smh = lds_half(smem);
#pragma unroll 1
              for (int it = VBLK; it < 512 + 1536; it += VGRID) { if (it < 512) ssd_item<1>(q, it, l, smh); else attn_b_item(q, it - 512, l, smh); } }
            xcd_barrier(xbar);
            { const Params q = launder(p); unsigned char* smh = lds_half(smem);
#pragma unroll 1
              for (int it = VBLK; it < 1024 + 512; it += VGRID) { if (it < 1024) attn_a_item(q, it, l, smh); else ssd_item<3>(q, it - 1024, l, smh); } }
            xcd_barrier(xbar);
            { const Params q = launder(p); post2_phase(q); }
            xcd_barrier(xbar);
            { const Params q = launder(p); merge_phase(q, l, smem); }
            xcd_barrier(xbar);
            { const Params q = launder(p); out_phase(q, l, hb, (l == 0) ? q.x : q.out, smem); }
            xcd_barrier(xbar);
        }
    }
}

extern "C" void kernel_launch(void* const* d_in, const int* in_sizes, int n_in, void* d_out, int out_size, void* d_ws, size_t ws_size, hipStream_t stream) {
    static int grid_blocks = 0;
    if (!grid_blocks) {
        int dev = 0, cus = 0, per_cu = 0;
        hipGetDevice(&dev);
        hipDeviceGetAttribute(&cus, hipDeviceAttributeMultiprocessorCount, dev);
        hipFuncSetAttribute((const void*)hybrid_fwd, hipFuncAttributeMaxDynamicSharedMemorySize, LDS_TOTAL);
        hipOccupancyMaxActiveBlocksPerMultiprocessor(&per_cu, hybrid_fwd, 512, LDS_TOTAL);
        if (per_cu > 1) per_cu = 1;
        if (per_cu < 1) per_cu = 1;
        grid_blocks = cus * per_cu;
    }
    Params p{};
    const float** pp = (const float**)&p;
    for (int i = 0; i < 22; ++i) pp[i] = (const float*)d_in[i];
    p.out = (float*)d_out; p.ws = (unsigned char*)d_ws;
    hipMemsetAsync((unsigned char*)d_ws + WS_BAR, 0, XCD_BAR_WORDS * 4, stream);
    void* args[] = {&p};
    hipError_t e = hipLaunchCooperativeKernel((void*)hybrid_fwd, dim3(grid_blocks), dim3(512), args, LDS_TOTAL, stream);
    if (e != hipSuccess) fprintf(stderr, "cooperative launch failed: %s (grid %d)\n", hipGetErrorString(e), grid_blocks);
}
```

```cpp
#include <hip/hip_runtime.h>
#include <hip/hip_cooperative_groups.h>
#include <cstdint>
#include <cstdio>
namespace cg = cooperative_groups;

typedef unsigned short bf16_t;
typedef short bf16x8 __attribute__((ext_vector_type(8)));
typedef short v4i16 __attribute__((ext_vector_type(4)));
typedef float f32x2 __attribute__((ext_vector_type(2)));
typedef float f32x4 __attribute__((ext_vector_type(4)));
typedef float f32x16 __attribute__((ext_vector_type(16)));
typedef unsigned u32x2 __attribute__((ext_vector_type(2)));
typedef unsigned u32x4 __attribute__((ext_vector_type(4)));
typedef __bf16 bf16x2_t __attribute__((ext_vector_type(2)));
#define LDSAS __attribute__((address_space(3)))
#define VTID ((int)(threadIdx.x & 255u))
__device__ __forceinline__ int vblk_() { int h_ = threadIdx.x >> 8; asm volatile("" : "+v"(h_)); return __builtin_amdgcn_readfirstlane(2 * (int)blockIdx.x + h_); }
#define VBLK vblk_()
#define VGRID ((int)(2u * gridDim.x))
constexpr int HALF_LDS = 73728, LDS_TOTAL = 147456;

constexpr int SEQ = 8192, DM = 1024, NBATCH = 4, NBH = 2, TP = NBH * SEQ, DEPTH = 2;
constexpr int NP = 8704;
constexpr float EPS = 1e-6f;
constexpr float LOG2E = 1.4426950408889634f, LN2 = 0.6931471805599453f;
constexpr int NSEG = 16, SEGLEN = 512, TSUB = 32, NSUB = SEGLEN / TSUB;

constexpr size_t MiB = 1u << 20;
constexpr size_t WS_WIN = 0;
constexpr size_t WS_WPA = 34 * MiB;
constexpr size_t WS_WPB = 36 * MiB;
constexpr size_t WS_WPC = 37 * MiB;
constexpr size_t WS_WOUT = 39 * MiB;
constexpr size_t WS_MOD = 43 * MiB;
constexpr size_t WS_ROPE = 43 * MiB + 128 * 1024;
constexpr size_t WS_BND = 43 * MiB + 160 * 1024;
constexpr size_t WS_RSTD = 43 * MiB + 256 * 1024;
constexpr size_t WS_SEGT = 43 * MiB + 512 * 1024;
constexpr size_t WS_LSE = 44 * MiB;
constexpr size_t WS_DT = 45 * MiB;
constexpr size_t WS_BAR = 46 * MiB;
constexpr size_t WS_H = 48 * MiB;
constexpr size_t WS_QA = 80 * MiB;
constexpr size_t WS_KA = 96 * MiB;
constexpr size_t WS_VA = 100 * MiB;
constexpr size_t WS_GA = 104 * MiB;
constexpr size_t WS_QB = 120 * MiB;
constexpr size_t WS_KB = 144 * MiB;
constexpr size_t WS_VB = 168 * MiB;
constexpr size_t WS_GB = 192 * MiB;
constexpr size_t WS_XBC = 200 * MiB;
constexpr size_t WS_ZS = 232 * MiB;
constexpr size_t WS_MG = 248 * MiB;
constexpr size_t WS_YF = 344 * MiB;
constexpr size_t WS_YS = 360 * MiB;
constexpr size_t WS_YBM = 376 * MiB;
constexpr size_t WS_YC = 384 * MiB;
constexpr size_t WS_MRG = 400 * MiB;
constexpr size_t WS_ST = 432 * MiB;

struct Params {
    const float *x, *c, *norm_w, *w_ada, *b_ada, *w_in, *b_gate, *q_norm_a, *k_norm_a, *q_norm_b, *k_norm_b, *rel_bias,
        *conv_w, *conv_b, *a_log, *dt_bias, *d_skip, *ssm_norm_w, *w_proj_a, *w_proj_b, *w_proj_c, *w_out;
    float* out;
    unsigned char* ws;
};


#define AS1 __attribute__((address_space(1)))
#define GLOBF(f) do { AS1 const float* g_ = (AS1 const float*)p.f; asm volatile("" : "+s"(g_)); q.f = (const float*)g_; } while (0)
__device__ __forceinline__ Params launder(const Params& p) {
    Params q;
    GLOBF(x); GLOBF(c); GLOBF(norm_w); GLOBF(w_ada); GLOBF(b_ada); GLOBF(w_in); GLOBF(b_gate); GLOBF(q_norm_a); GLOBF(k_norm_a); GLOBF(q_norm_b); GLOBF(k_norm_b); GLOBF(rel_bias);
    GLOBF(conv_w); GLOBF(conv_b); GLOBF(a_log); GLOBF(dt_bias); GLOBF(d_skip); GLOBF(ssm_norm_w); GLOBF(w_proj_a); GLOBF(w_proj_b); GLOBF(w_proj_c); GLOBF(w_out);
    { AS1 float* g_ = (AS1 float*)p.out; asm volatile("" : "+s"(g_)); q.out = (float*)g_; }
    { AS1 unsigned char* g_ = (AS1 unsigned char*)p.ws; asm volatile("" : "+s"(g_)); q.ws = (unsigned char*)g_; }
    return q;
}
__device__ __forceinline__ unsigned pk2(float lo, float hi) { f32x2 v = {lo, hi}; bf16x2_t b = __builtin_convertvector(v, bf16x2_t); return __builtin_bit_cast(unsigned, b); }
__device__ __forceinline__ float bf2f(unsigned short b) { return __uint_as_float(((unsigned)b) << 16); }
__device__ __forceinline__ float bflo(unsigned u) { return __uint_as_float(u << 16); }
__device__ __forceinline__ float bfhi(unsigned u) { return __uint_as_float(u & 0xffff0000u); }
__device__ __forceinline__ float siluf(float v) { return v * __builtin_amdgcn_rcpf(1.f + __builtin_amdgcn_exp2f(-1.4426950408889634f * v)); }
__device__ __forceinline__ float sigmf(float v) { return __builtin_amdgcn_rcpf(1.f + __builtin_amdgcn_exp2f(-1.4426950408889634f * v)); }
__device__ __forceinline__ float wave_sum(float v) {
#pragma unroll
    for (int o = 1; o < 64; o <<= 1) v += __shfl_xor(v, o);
    return v;
}
__device__ __forceinline__ v4i16 tr16(const unsigned char* p) { return __builtin_amdgcn_ds_read_tr16_b64_v4i16((LDSAS v4i16*)p); }
__device__ __forceinline__ bf16x8 cat8(v4i16 a, v4i16 b) { return (bf16x8){a[0], a[1], a[2], a[3], b[0], b[1], b[2], b[3]}; }
__device__ __forceinline__ int crow(int r, int hi) { return (r & 3) + 8 * (r >> 2) + 4 * hi; }

__device__ __forceinline__ void p0_transpose(const float* __restrict__ W, int ldw, int K, bf16_t* __restrict__ Wt, int k0, int n0, int mode,
                                             const float* __restrict__ rowscale, float* tile) {
    const int tid = VTID, tx = tid & 63, ty = tid >> 6;
    const int np = n0 + tx; int n = np; bool valid = true;
    if (mode == 1) {
        if (np < 4352) n = np; else if (np < 4864) n = np + 512; else if (np < 5376) n = np - 512;
        else if (np < 8448) n = np + 16; else if (np < 8464) n = np - 3072; else { valid = false; n = 0; }
    }
#pragma unroll 4
    for (int i = 0; i < 16; ++i) {
        const int k = ty + 4 * i; float v = valid ? W[(size_t)(k0 + k) * ldw + n] : 0.f;
        if (rowscale) v *= rowscale[k0 + k];
        tile[k * 65 + tx] = v;
    }
    __syncthreads();
    const int r = tid >> 2, kc = (tid & 3) * 16;
    u32x4 o0, o1;
    o0.x = pk2(tile[(kc + 0) * 65 + r], tile[(kc + 1) * 65 + r]); o0.y = pk2(tile[(kc + 2) * 65 + r], tile[(kc + 3) * 65 + r]);
    o0.z = pk2(tile[(kc + 4) * 65 + r], tile[(kc + 5) * 65 + r]); o0.w = pk2(tile[(kc + 6) * 65 + r], tile[(kc + 7) * 65 + r]);
    o1.x = pk2(tile[(kc + 8) * 65 + r], tile[(kc + 9) * 65 + r]); o1.y = pk2(tile[(kc + 10) * 65 + r], tile[(kc + 11) * 65 + r]);
    o1.z = pk2(tile[(kc + 12) * 65 + r], tile[(kc + 13) * 65 + r]); o1.w = pk2(tile[(kc + 14) * 65 + r], tile[(kc + 15) * 65 + r]);
    bf16_t* dst = Wt + (size_t)(n0 + r) * K + k0 + kc;
    *(u32x4*)dst = o0; *(u32x4*)(dst + 8) = o1;
    __syncthreads();
}

__device__ void phase0(const Params& p, unsigned char* smem) {
    const int tid = VTID;
    float* tile = (float*)smem;
    constexpr int I_IN = 16 * 136, I_PA = 8 * 16, I_PB = 4 * 16, I_PC = 8 * 16, I_OUT = 16 * 16, I_L = I_IN + I_PA + I_PB + I_PC + I_OUT;
    constexpr int I_T = 2 * I_L, I_MOD = 192, I_ALL = I_T + I_MOD + 1;
    for (int item = VBLK; item < I_ALL; item += VGRID) {
        if (item < I_T) {
            const int l = item / I_L; int r = item % I_L;
            if (r < I_IN) { const int kt = r / 136, nt = r % 136;
                p0_transpose(p.w_in + (size_t)l * 1024 * 8464, 8464, 1024, (bf16_t*)(p.ws + WS_WIN) + (size_t)l * NP * 1024, kt * 64, nt * 64, 1, nullptr, tile); continue; }
            r -= I_IN;
            if (r < I_PA) { const int kt = r / 16, nt = r % 16;
                p0_transpose(p.w_proj_a + (size_t)l * 512 * 1024, 1024, 512, (bf16_t*)(p.ws + WS_WPA) + (size_t)l * 1024 * 512, kt * 64, nt * 64, 0, nullptr, tile); continue; }
            r -= I_PA;
            if (r < I_PB) { const int kt = r / 16, nt = r % 16;
                p0_transpose(p.w_proj_b + (size_t)l * 256 * 1024, 1024, 256, (bf16_t*)(p.ws + WS_WPB) + (size_t)l * 1024 * 256, kt * 64, nt * 64, 0, nullptr, tile); continue; }
            r -= I_PB;
            if (r < I_PC) { const int kt = r / 16, nt = r % 16;
                p0_transpose(p.w_proj_c + (size_t)l * 512 * 1024, 1024, 512, (bf16_t*)(p.ws + WS_WPC) + (size_t)l * 1024 * 512, kt * 64, nt * 64, 0, p.ssm_norm_w + l * 512, tile); continue; }
            r -= I_PC;
            { const int kt = r / 16, nt = r % 16;
                p0_transpose(p.w_out + (size_t)l * 1024 * 1024, 1024, 1024, (bf16_t*)(p.ws + WS_WOUT) + (size_t)l * 1024 * 1024, kt * 64, nt * 64, 0, nullptr, tile); }
        } else if (item < I_T + I_MOD) {
            const int it = item - I_T, l = it / 96, col0 = (it % 96) * 32, cl = tid & 31, ks = tid >> 5;
            float a0 = 0.f, a1 = 0.f, a2 = 0.f, a3 = 0.f;
            const float* wp = p.w_ada + ((size_t)l * 1024 + ks * 128) * 3072 + col0 + cl;
#pragma unroll 8
            for (int k = 0; k < 128; ++k) {
                const float wv = wp[(size_t)k * 3072]; const int kk = ks * 128 + k;
                a0 += siluf(p.c[kk]) * wv; a1 += siluf(p.c[1024 + kk]) * wv; a2 += siluf(p.c[2048 + kk]) * wv; a3 += siluf(p.c[3072 + kk]) * wv;
            }
            float* red = (float*)smem;
            red[(ks * 32 + cl) * 4 + 0] = a0; red[(ks * 32 + cl) * 4 + 1] = a1; red[(ks * 32 + cl) * 4 + 2] = a2; red[(ks * 32 + cl) * 4 + 3] = a3;
            __syncthreads();
            if (tid < 128) { const int b = tid >> 5, c2 = tid & 31; float s = 0.f;
#pragma unroll
                for (int k = 0; k < 8; ++k) s += red[(k * 32 + c2) * 4 + b];
                ((float*)(p.ws + WS_MOD))[(l * 4 + b) * 3072 + col0 + c2] = s + p.b_ada[l * 3072 + col0 + c2]; }
            __syncthreads();
        } else {
            float* rc = (float*)(p.ws + WS_ROPE); float* rs = rc + 128 * 16;
            for (int e = tid; e < 2048; e += 256) {
                const int pos = e >> 4, i = e & 15;
                const float freq = powf(10000.0f, -(float)i / 16.0f);
                const float ang = (float)pos * freq;
                const double rev = (double)ang * 0.15915494309189535; const double fr = rev - rint(rev);
                const float a = (float)(fr * 6.283185307179586);
                rc[e] = cosf(a); rs[e] = sinf(a);
            }
            if (tid < 2) {
                const int l = tid; float mqa = 0.f, mka = 0.f, mqb = 0.f, mkb = 0.f, mb = 0.f;
                for (int i = 0; i < 64; ++i) { mqa = fmaxf(mqa, fabsf(p.q_norm_a[l * 64 + i])); mka = fmaxf(mka, fabsf(p.k_norm_a[l * 64 + i]));
                    mqb = fmaxf(mqb, fabsf(p.q_norm_b[l * 64 + i])); mkb = fmaxf(mkb, fabsf(p.k_norm_b[l * 64 + i])); }
                for (int i = 0; i < 32 * 12; ++i) mb = fmaxf(mb, p.rel_bias[i]);
                float* bd = (float*)(p.ws + WS_BND);
                bd[l] = 8.f * mqa * mka * LOG2E; bd[2 + l] = (8.f * mqb * mkb + mb) * LOG2E;
            }
        }
    }
}

__device__ void norm_phase(const Params& p, int l, int hb, const float* xsrc) {
    int tx_ = threadIdx.x; asm volatile("" : "+v"(tx_));
    const int lane = tx_ & 63, gw = blockIdx.x * 8 + (tx_ >> 6), nw = gridDim.x * 8;
    bf16_t* H = (bf16_t*)(p.ws + WS_H);
    const float* nwp = p.norm_w + l * 1024;
    for (int row = gw; row < TP; row += nw) {
        const size_t rg = (size_t)hb * TP + row; const int b = (int)(rg / SEQ);
        const f32x4* xr = (const f32x4*)(xsrc + rg * 1024);
        const float* md = (const float*)(p.ws + WS_MOD) + (size_t)(l * 4 + b) * 3072;
        f32x4 v[4]; float ss = 0.f;
#pragma unroll
        for (int j = 0; j < 4; ++j) { v[j] = xr[lane + 64 * j]; ss += v[j].x * v[j].x + v[j].y * v[j].y + v[j].z * v[j].z + v[j].w * v[j].w; }
        ss = wave_sum(ss); const float rstd = rsqrtf(ss * (1.f / 1024.f) + EPS);
#pragma unroll
        for (int j = 0; j < 4; ++j) {
            const int col = 4 * (lane + 64 * j);
            const f32x4 w4 = *(const f32x4*)(nwp + col), sh = *(const f32x4*)(md + col), sc = *(const f32x4*)(md + 1024 + col);
            const f32x4 o = v[j] * rstd * w4 * (1.f + sc) + sh;
            u32x2 pk; pk.x = pk2(o.x, o.y); pk.y = pk2(o.z, o.w);
            *(u32x2*)(H + (size_t)row * 1024 + col) = pk;
        }
    }
}

constexpr int G_STAGE = 65536, G_AB = 32768;
__device__ __forceinline__ void gemm_core(const bf16_t* __restrict__ A, int lda, const bf16_t* __restrict__ Bt, int ldb, int K, f32x4 (&acc)[8][4], unsigned char* smem, int tid) {
    asm volatile("" : "+v"(tid));
    const int lane = tid & 63, w = __builtin_amdgcn_readfirstlane(tid >> 6), wm = w >> 2, wn = w & 3, idx = lane & 15, kq = lane >> 4;
    unsigned offA[4], offB[4];
#pragma unroll
    for (int j = 0; j < 4; ++j) { const int row = (j * 8 + w) * 8 + (lane >> 3), c = (lane & 7) ^ ((row >> 1) & 7);
        offA[j] = (unsigned)(row * lda + c * 8) * 2u; offB[j] = (unsigned)(row * ldb + c * 8) * 2u; }
#pragma unroll
    for (int mi = 0; mi < 8; ++mi)
#pragma unroll
        for (int ni = 0; ni < 4; ++ni) acc[mi][ni] = (f32x4){0.f, 0.f, 0.f, 0.f};
    LDSAS unsigned char* lds = (LDSAS unsigned char*)smem;
#define G_ISSUE1(kt, st, j) do { \
        __builtin_amdgcn_global_load_lds((const unsigned*)((const char*)A + offA[j] + (kt) * 128), (LDSAS unsigned*)(lds + (st) * G_STAGE + ((j) * 8 + w) * 1024), 16, 0, 0); \
        __builtin_amdgcn_global_load_lds((const unsigned*)((const char*)Bt + offB[j] + (kt) * 128), (LDSAS unsigned*)(lds + (st) * G_STAGE + G_AB + ((j) * 8 + w) * 1024), 16, 0, 0); } while (0)
#define G_ISSUE(kt, st) do { G_ISSUE1(kt, st, 0); G_ISSUE1(kt, st, 1); G_ISSUE1(kt, st, 2); G_ISSUE1(kt, st, 3); } while (0)
    const int nk = K >> 6;
    G_ISSUE(0, 0);
    asm volatile("s_waitcnt vmcnt(0)" ::: "memory");
    __syncthreads();
    const int swz = (idx >> 1) & 7;
    const int aoff = (wm * 128 + idx) * 128, boff = G_AB + (wn * 64 + idx) * 128;
    for (int kt = 0; kt < nk; ++kt) {
        const int st = kt & 1;
        const bool more = kt + 1 < nk;
        const unsigned char* sb = smem + st * G_STAGE;
#pragma unroll
        for (int ks = 0; ks < 2; ++ks) {
            bf16x8 bfr[4], af[8];
            const int co = ((ks * 4 + kq) ^ swz) * 16;
#pragma unroll
            for (int ni = 0; ni < 4; ++ni) bfr[ni] = *(const bf16x8*)(sb + boff + ni * 2048 + co);
#pragma unroll
            for (int mi = 0; mi < 8; ++mi) af[mi] = *(const bf16x8*)(sb + aoff + mi * 2048 + co);
            if (more) { G_ISSUE1(kt + 1, st ^ 1, ks * 2); G_ISSUE1(kt + 1, st ^ 1, ks * 2 + 1); }
            __builtin_amdgcn_sched_barrier(0);
            __builtin_amdgcn_s_setprio(1);
#pragma unroll
            for (int mi = 0; mi < 8; ++mi)
#pragma unroll
                for (int ni = 0; ni < 4; ++ni) acc[mi][ni] = __builtin_amdgcn_mfma_f32_16x16x32_bf16(bfr[ni], af[mi], acc[mi][ni], 0, 0, 0);
            __builtin_amdgcn_s_setprio(0);
            __builtin_amdgcn_sched_barrier(0);
        }
        asm volatile("s_waitcnt vmcnt(0)" ::: "memory");
        __syncthreads();
    }
#undef G_ISSUE1
#undef G_ISSUE
}

__device__ __forceinline__ void st4bf(bf16_t* dst, f32x4 v) { u32x2 pk; pk.x = pk2(v.x, v.y); pk.y = pk2(v.z, v.w); *(u32x2*)dst = pk; }

__device__ void gemm1_phase(const Params& p, int l, int hb, unsigned char* smem) {
    const bf16_t* H = (const bf16_t*)(p.ws + WS_H);
    const bf16_t* Wt = (const bf16_t*)(p.ws + WS_WIN) + (size_t)l * NP * 1024;
    const float* ropec = (const float*)(p.ws + WS_ROPE); const float* ropes = ropec + 2048;
    constexpr int NT = 34, NTILES = 64 * NT, GRP = 8 * NT;
    for (int t = blockIdx.x; t < NTILES; t += gridDim.x) {
        const int grp = t / GRP, r = t % GRP, jx = NT * (r & 7) + (r >> 3), mt = grp * 8 + (jx & 7), nt = jx >> 3;
        const int m0 = mt * 256, n0 = nt * 256;
        f32x4 acc[8][4];
        int tid = threadIdx.x;
        gemm_core(H + (size_t)m0 * 1024, 1024, Wt + (size_t)n0 * 1024, 1024, 1024, acc, smem, tid);
        asm volatile("" : "+v"(tid));
        const int lane = tid & 63, w = tid >> 6, wm = w >> 2, wn = w & 3, idx = lane & 15, kq = lane >> 4;
        const int cw = n0 + wn * 64;
        const int lc = 4 * kq;
        if (cw < 768 && (cw < 640)) {
            const bool isq = cw < 512;
            const float* nwp = (isq ? p.q_norm_a : p.k_norm_a) + l * 64;
            bf16_t* dst = isq ? (bf16_t*)(p.ws + WS_QA) : (bf16_t*)(p.ws + WS_KA);
            const int pitch = isq ? 512 : 128, c0 = isq ? cw : cw - 512;
            const float qs = isq ? 0.125f * LOG2E : 1.f;
#pragma unroll
            for (int mi = 0; mi < 8; ++mi) {
                const int row = m0 + wm * 128 + mi * 16 + idx;
                float ss = 0.f;
#pragma unroll
                for (int ni = 0; ni < 4; ++ni) { const f32x4 v = acc[mi][ni]; ss += v.x * v.x + v.y * v.y + v.z * v.z + v.w * v.w; }
                ss += __shfl_xor(ss, 16); ss += __shfl_xor(ss, 32);
                const float rstd = rsqrtf(ss * (1.f / 64.f) + EPS);
                f32x4 y[4];
#pragma unroll
                for (int ni = 0; ni < 4; ++ni) y[ni] = acc[mi][ni] * rstd * *(const f32x4*)(nwp + ni * 16 + lc);
                const int tt = row & (SEQ - 1), prow = tt >> 6, pcol = tt & 63;
#pragma unroll
                for (int hf = 0; hf < 2; ++hf) {
                    const int pos = hf ? pcol : prow;
                    const f32x4 cs = *(const f32x4*)(ropec + pos * 16 + lc), sn = *(const f32x4*)(ropes + pos * 16 + lc);
                    const f32x4 a = y[2 * hf], b = y[2 * hf + 1];
                    y[2 * hf] = a * cs - b * sn; y[2 * hf + 1] = b * cs + a * sn;
                }
#pragma unroll
                for (int ni = 0; ni < 4; ++ni) st4bf(dst + (size_t)row * pitch + c0 + ni * 16 + lc, y[ni] * qs);
            }
        } else if (cw >= 1280 && cw < 2816) {
            const bool isq = cw < 2048;
            const float* nwp = (isq ? p.q_norm_b : p.k_norm_b) + l * 64;
            const int gc = isq ? cw - 1280 : cw - 2048, g = gc >> 8, c0 = gc & 255;
            const int sh = 2 * g;
            bf16_t* dst = (bf16_t*)(p.ws + (isq ? WS_QB : WS_KB));
            const float qs = isq ? 0.125f * LOG2E : 1.f;
#pragma unroll
            for (int mi = 0; mi < 8; ++mi) {
                const int row = m0 + wm * 128 + mi * 16 + idx;
                float ss = 0.f;
#pragma unroll
                for (int ni = 0; ni < 4; ++ni) { const f32x4 v = acc[mi][ni]; ss += v.x * v.x + v.y * v.y + v.z * v.z + v.w * v.w; }
                ss += __shfl_xor(ss, 16); ss += __shfl_xor(ss, 32);
                const float rstd = rsqrtf(ss * (1.f / 64.f) + EPS) * qs;
                const int bl = row >> 13, tt = row & (SEQ - 1);
                const int pp = (tt & ((1 << sh) - 1)) * (SEQ >> sh) + (tt >> sh);
                bf16_t* drow = dst + ((size_t)(bl * 3 + g) * SEQ + pp) * 256 + c0 + lc;
#pragma unroll
                for (int ni = 0; ni < 4; ++ni) st4bf(drow + ni * 16, acc[mi][ni] * rstd * *(const f32x4*)(nwp + ni * 16 + lc));
            }
        } else if (cw >= 2816 && cw < 3584) {
            const int gc = cw - 2816, g = gc >> 8, c0 = gc & 255, sh = 2 * g;
            bf16_t* dst = (bf16_t*)(p.ws + WS_VB);
#pragma unroll
            for (int mi = 0; mi < 8; ++mi) {
                const int row = m0 + wm * 128 + mi * 16 + idx;
                const int bl = row >> 13, tt = row & (SEQ - 1);
                const int pp = (tt & ((1 << sh) - 1)) * (SEQ >> sh) + (tt >> sh);
                bf16_t* drow = dst + ((size_t)(bl * 3 + g) * SEQ + pp) * 256 + c0 + lc;
#pragma unroll
                for (int ni = 0; ni < 4; ++ni) st4bf(drow + ni * 16, acc[mi][ni]);
            }
        } else if (cw >= 8448) {
            if (cw == 8448) {
                float* dst = (float*)(p.ws + WS_DT);
                const f32x4 bias = *(const f32x4*)(p.dt_bias + l * 16 + lc);
#pragma unroll
                for (int mi = 0; mi < 8; ++mi) {
                    const int row = m0 + wm * 128 + mi * 16 + idx;
                    f32x4 v = acc[mi][0] + bias, o;
                    o.x = v.x > 20.f ? v.x : log1pf(__expf(v.x)); o.y = v.y > 20.f ? v.y : log1pf(__expf(v.y));
                    o.z = v.z > 20.f ? v.z : log1pf(__expf(v.z)); o.w = v.w > 20.f ? v.w : log1pf(__expf(v.w));
                    *(f32x4*)(dst + (size_t)row * 16 + lc) = o;
                }
            }
        } else {
            bf16_t* dst; int pitch, c0, mode;
            if (cw < 768) { dst = (bf16_t*)(p.ws + WS_VA); pitch = 128; c0 = cw - 640; mode = 0; }
            else if (cw < 1280) { dst = (bf16_t*)(p.ws + WS_GA); pitch = 512; c0 = cw - 768; mode = 1; }
            else if (cw < 3840) { dst = (bf16_t*)(p.ws + WS_GB); pitch = 256; c0 = cw - 3584; mode = 1; }
            else if (cw < 4864) { dst = (bf16_t*)(p.ws + WS_XBC); pitch = 1024; c0 = cw - 3840; mode = 0; }
            else if (cw < 5376) { dst = (bf16_t*)(p.ws + WS_ZS); pitch = 512; c0 = cw - 4864; mode = 1; }
            else { dst = (bf16_t*)(p.ws + WS_MG); pitch = 3072; c0 = cw - 5376; mode = 2; }
            const float* bg = p.b_gate + l * 3072 + c0 + lc;
#pragma unroll
            for (int mi = 0; mi < 8; ++mi) {
                const int row = m0 + wm * 128 + mi * 16 + idx;
#pragma unroll
                for (int ni = 0; ni < 4; ++ni) {
                    f32x4 v = acc[mi][ni];
                    if (mode == 1) { v.x = siluf(v.x); v.y = siluf(v.y); v.z = siluf(v.z); v.w = siluf(v.w); }
                    else if (mode == 2) { const f32x4 bb = *(const f32x4*)(bg + ni * 16); v.x = sigmf(v.x + bb.x); v.y = sigmf(v.y + bb.y); v.z = sigmf(v.z + bb.z); v.w = sigmf(v.w + bb.w); }
                    st4bf(dst + (size_t)row * pitch + c0 + ni * 16 + lc, v);
                }
            }
        }
    }
}

__device__ void merge_phase(const Params& p, int l, unsigned char* smem) {
    const bf16_t* MG = (const bf16_t*)(p.ws + WS_MG);
    const float* rstd = (const float*)(p.ws + WS_RSTD);
    bf16_t* MR = (bf16_t*)(p.ws + WS_MRG);
    for (int t = blockIdx.x; t < 64 * 4; t += gridDim.x) {
        const int xq = t >> 3, mt = (xq >> 2) * 8 + (t & 7), nt = xq & 3, m0 = mt * 256, n0 = nt * 256;
#pragma unroll 1
        for (int br = 0; br < 3; ++br) {
            f32x4 acc[8][4];
            const bf16_t* A; const bf16_t* Bt; int K;
            if (br == 0) { A = (const bf16_t*)(p.ws + WS_QA); K = 512; Bt = (const bf16_t*)(p.ws + WS_WPA) + (size_t)l * 1024 * 512; }
            else if (br == 1) { A = (const bf16_t*)(p.ws + WS_YBM); K = 256; Bt = (const bf16_t*)(p.ws + WS_WPB) + (size_t)l * 1024 * 256; }
            else { A = (const bf16_t*)(p.ws + WS_YC); K = 512; Bt = (const bf16_t*)(p.ws + WS_WPC) + (size_t)l * 1024 * 512; }
            int tid = threadIdx.x;
            gemm_core(A + (size_t)m0 * K, K, Bt + (size_t)n0 * K, K, K, acc, smem, tid);
            asm volatile("" : "+v"(tid));
            const int lane = tid & 63, w = tid >> 6, wm = w >> 2, wn = w & 3, idx = lane & 15, kq = lane >> 4;
#pragma unroll
            for (int mi = 0; mi < 8; ++mi) {
                const int row = m0 + wm * 128 + mi * 16 + idx;
                const float rs = (br == 2) ? rstd[row] : 1.f;
#pragma unroll
                for (int ni = 0; ni < 4; ++ni) {
                    const int col = n0 + wn * 64 + ni * 16 + 4 * kq;
                    const u32x2 g = *(const u32x2*)(MG + (size_t)row * 3072 + br * 1024 + col);
                    f32x4 gv; gv.x = bflo(g.x); gv.y = bfhi(g.x); gv.z = bflo(g.y); gv.w = bfhi(g.y);
                    f32x4 v = gv * rs * acc[mi][ni];
                    bf16_t* mp = MR + (size_t)row * 1024 + col;
                    if (br > 0) { const u32x2 o = *(const u32x2*)mp; v.x += bflo(o.x); v.y += bfhi(o.x); v.z += bflo(o.y); v.w += bfhi(o.y); }
                    st4bf(mp, v);
                }
            }
        }
    }
}

__device__ void out_phase(const Params& p, int l, int hb, const float* xsrc, unsigned char* smem) {
    const bf16_t* MR = (const bf16_t*)(p.ws + WS_MRG);
    const bf16_t* Wt = (const bf16_t*)(p.ws + WS_WOUT) + (size_t)l * 1024 * 1024;
    for (int t = blockIdx.x; t < 64 * 4; t += gridDim.x) {
        const int xq = t >> 3, mt = (xq >> 2) * 8 + (t & 7), nt = xq & 3, m0 = mt * 256, n0 = nt * 256;
        f32x4 acc[8][4];
        int tid = threadIdx.x;
        gemm_core(MR + (size_t)m0 * 1024, 1024, Wt + (size_t)n0 * 1024, 1024, 1024, acc, smem, tid);
        asm volatile("" : "+v"(tid));
        const int lane = tid & 63, w = tid >> 6, wm = w >> 2, wn = w & 3, idx = lane & 15, kq = lane >> 4;
#pragma unroll
        for (int mi = 0; mi < 8; ++mi) {
            const int row = m0 + wm * 128 + mi * 16 + idx; const size_t rg = (size_t)hb * TP + row; const int b = (int)(rg / SEQ);
            const float* gate = (const float*)(p.ws + WS_MOD) + (size_t)(l * 4 + b) * 3072 + 2048;
#pragma unroll
            for (int ni = 0; ni < 4; ++ni) {
                const int col = n0 + wn * 64 + ni * 16 + 4 * kq;
                const f32x4 xv = *(const f32x4*)(xsrc + rg * 1024 + col), gv = *(const f32x4*)(gate + col);
                *(f32x4*)(p.out + rg * 1024 + col) = xv + gv * acc[mi][ni];
            }
        }
    }
}

constexpr int AT_KS = 0, AT_VS = 9216, AT_LQ = 9216 + 8192, AT_LUT = AT_LQ + 512;

#define AT_STAGE_STORE() do { _Pragma("unroll") for (int i = 0; i < 2; ++i) { const int c = tid + 256 * i, row = c >> 3, ch = c & 7; \
        *(u32x4*)(Ks + row * 72 + ch * 8) = rk[i]; *(u32x4*)(Vs + (ch >> 2) * 4096 + row * 64 + (ch & 3) * 16) = rv[i]; } } while (0)

__device__ __forceinline__ void at_qk(f32x16& p0, f32x16& p1, const bf16_t* Ks, const bf16x8* qr, int r32, int hi) {
#pragma unroll
    for (int ds = 0; ds < 4; ++ds) {
        const bf16x8 k0 = *(const bf16x8*)(Ks + r32 * 72 + ds * 16 + hi * 8);
        const bf16x8 k1 = *(const bf16x8*)(Ks + (r32 + 32) * 72 + ds * 16 + hi * 8);
        p0 = __builtin_amdgcn_mfma_f32_32x32x16_bf16(k0, qr[ds], p0, 0, 0, 0);
        p1 = __builtin_amdgcn_mfma_f32_32x32x16_bf16(k1, qr[ds], p1, 0, 0, 0);
    }
}
__device__ __forceinline__ void at_pv(f32x16& o0, f32x16& o1, const f32x16& p0, const f32x16& p1, const unsigned char* Vs, int lane) {
    const int hi = lane >> 5;
    const unsigned char* vb = Vs + ((lane >> 4) & 1) * 32 + (lane & 3) * 8 + (4 * hi + ((lane & 15) >> 2)) * 64;
#pragma unroll
    for (int s = 0; s < 4; ++s) {
        u32x4 pw;
        if (s < 2) { pw.x = pk2(p0[8 * s + 0], p0[8 * s + 1]); pw.y = pk2(p0[8 * s + 2], p0[8 * s + 3]); pw.z = pk2(p0[8 * s + 4], p0[8 * s + 5]); pw.w = pk2(p0[8 * s + 6], p0[8 * s + 7]); }
        else { const int q = s - 2; pw.x = pk2(p1[8 * q + 0], p1[8 * q + 1]); pw.y = pk2(p1[8 * q + 2], p1[8 * q + 3]); pw.z = pk2(p1[8 * q + 4], p1[8 * q + 5]); pw.w = pk2(p1[8 * q + 6], p1[8 * q + 7]); }
        const bf16x8 pa = __builtin_bit_cast(bf16x8, pw);
        const bf16x8 v0 = cat8(tr16(vb + s * 1024), tr16(vb + s * 1024 + 512));
        const bf16x8 v1 = cat8(tr16(vb + 4096 + s * 1024), tr16(vb + 4096 + s * 1024 + 512));
        o0 = __builtin_amdgcn_mfma_f32_32x32x16_bf16(pa, v0, o0, 0, 0, 0);
        o1 = __builtin_amdgcn_mfma_f32_32x32x16_bf16(pa, v1, o1, 0, 0, 0);
    }
}

constexpr int ATA_STAGE = 17408, ATA_LQ = 2 * ATA_STAGE;
__device__ void attn_a_item(const Params& p, int item, int l, unsigned char* smem) {
    int tid_ = VTID; asm volatile("" : "+v"(tid_));
    const int tid = tid_, lane = tid & 63, w = tid >> 6, r32 = lane & 31, hi = lane >> 5;
    const int b = item >> 9, r = item & 511, kvh = r >> 8, qblk = (r >> 2) & 63, hq = kvh * 4 + (r & 3);
    float* lq = (float*)(smem + ATA_LQ) + w * 32;
    bf16_t* QA = (bf16_t*)(p.ws + WS_QA);
    const bf16_t* GA = (const bf16_t*)(p.ws + WS_GA);
    const size_t tokq = (size_t)b * SEQ + qblk * 128 + w * 32;
    bf16x8 qr[4];
#pragma unroll
    for (int ds = 0; ds < 4; ++ds) qr[ds] = *(const bf16x8*)(QA + (tokq + r32) * 512 + hq * 64 + ds * 16 + hi * 8);
    const bf16_t* Kb = (const bf16_t*)(p.ws + WS_KA) + (size_t)b * SEQ * 128 + kvh * 64;
    const bf16_t* Vb = (const bf16_t*)(p.ws + WS_VA) + (size_t)b * SEQ * 128 + kvh * 64;
    const float nshift = -((const float*)(p.ws + WS_BND))[l];
    f32x16 o0, o1;
#pragma unroll
    for (int i = 0; i < 16; ++i) { o0[i] = 0.f; o1[i] = 0.f; }
    float lacc = 0.f;
    constexpr int NT = SEQ / 64;
    const int row0 = tid >> 3, ch0 = tid & 7;
    const size_t goff0 = (size_t)row0 * 128 + ch0 * 8, goff1 = goff0 + (size_t)32 * 128;
    const int ko0 = row0 * 144 + ch0 * 16, ko1 = ko0 + 32 * 144;
    const int vo0 = 9216 + (ch0 >> 2) * 4096 + row0 * 64 + (ch0 & 3) * 16, vo1 = vo0 + 32 * 64;
    u32x4 rkA[2], rvA[2], rkB[2], rvB[2];
#define ATA_LOAD(RK, RV, t) do { const size_t tb = (size_t)(t) * 64 * 128; RK[0] = *(const u32x4*)(Kb + tb + goff0); RK[1] = *(const u32x4*)(Kb + tb + goff1); \
        RV[0] = *(const u32x4*)(Vb + tb + goff0); RV[1] = *(const u32x4*)(Vb + tb + goff1); } while (0)
#define ATA_STORE(RK, RV, st) do { unsigned char* sb_ = smem + (st) * ATA_STAGE; *(u32x4*)(sb_ + ko0) = RK[0]; *(u32x4*)(sb_ + ko1) = RK[1]; \
        *(u32x4*)(sb_ + vo0) = RV[0]; *(u32x4*)(sb_ + vo1) = RV[1]; } while (0)
#define ATA_COMPUTE(st) do { const unsigned char* sb_ = smem + (st) * ATA_STAGE; f32x16 p0, p1; \
        _Pragma("unroll") for (int i = 0; i < 16; ++i) { p0[i] = nshift; p1[i] = nshift; } \
        at_qk(p0, p1, (const bf16_t*)sb_, qr, r32, hi); \
        _Pragma("unroll") for (int i = 0; i < 16; ++i) { p0[i] = __builtin_amdgcn_exp2f(p0[i]); p1[i] = __builtin_amdgcn_exp2f(p1[i]); lacc += p0[i] + p1[i]; } \
        at_pv(o0, o1, p0, p1, sb_ + 9216, lane); } while (0)
    __syncthreads();
    ATA_LOAD(rkA, rvA, 0); ATA_LOAD(rkB, rvB, 1);
    ATA_STORE(rkA, rvA, 0);
    ATA_LOAD(rkA, rvA, 2);
    __syncthreads();
    for (int kt = 0; kt < NT; kt += 2) {
        ATA_COMPUTE(0);
        ATA_STORE(rkB, rvB, 1);
        if (kt + 3 < NT) ATA_LOAD(rkB, rvB, kt + 3);
        __syncthreads();
        ATA_COMPUTE(1);
        if (kt + 2 < NT) { ATA_STORE(rkA, rvA, 0); if (kt + 4 < NT) ATA_LOAD(rkA, rvA, kt + 4); }
        __syncthreads();
    }
#undef ATA_LOAD
#undef ATA_STORE
#undef ATA_COMPUTE
    lacc += __shfl_xor(lacc, 32);
    if (hi == 0) lq[r32] = lacc;
    asm volatile("s_waitcnt lgkmcnt(0)" ::: "memory");
#pragma unroll
    for (int rr = 0; rr < 16; ++rr) {
        const int q = crow(rr, hi); const float inv = 1.f / lq[q];
        const size_t off = (tokq + q) * 512 + hq * 64 + r32;
        const float g0 = bf2f(GA[off]), g1 = bf2f(GA[off + 32]);
        QA[off] = (bf16_t)(pk2(o0[rr] * inv * g0, 0.f) & 0xffffu);
        QA[off + 32] = (bf16_t)(pk2(o1[rr] * inv * g1, 0.f) & 0xffffu);
    }
}

__device__ void attn_b_item(const Params& p, int item, int l, unsigned char* smem) {
    int tid_ = VTID; asm volatile("" : "+v"(tid_));
    const int tid = tid_, lane = tid & 63, w = tid >> 6, r32 = lane & 31, hi = lane >> 5;
    const int blk = item & 63, j = (item >> 6) & 3, bg = item >> 8, g = bg % 3, b = bg / 3;
    const int sh = 2 * g, dil = 1 << sh, Mlen = SEQ >> sh;
    bf16_t* Ks = (bf16_t*)(smem + AT_KS); unsigned char* Vs = smem + AT_VS; float* lq = (float*)(smem + AT_LQ) + w * 32; float* lut = (float*)(smem + AT_LUT);
    bf16_t* QB = (bf16_t*)(p.ws + WS_QB) + (size_t)bg * SEQ * 256 + j * 64;
    const bf16_t* KB = (const bf16_t*)(p.ws + WS_KB) + (size_t)bg * SEQ * 256 + j * 64;
    const bf16_t* VB = (const bf16_t*)(p.ws + WS_VB) + (size_t)bg * SEQ * 256 + j * 64;
    float* LSE = (float*)(p.ws + WS_LSE) + (size_t)bg * SEQ * 4 + j;
    const int p0r = blk * 128, seq_lo = (p0r / Mlen) * Mlen, seq_hi = seq_lo + Mlen;
    __syncthreads();
    if (tid < 129) {
        const int rel = tid - 64, n = (rel < 0 ? -rel : rel) * dil;
        int bk;
        if (n < 8) bk = n; else { bk = 8 + (n >= 15) + (n >= 27) + (n >= 50) + (n >= 91) + (n >= 166) + (n >= 305) + (n >= 559); }
        if (rel > 0) bk += 16;
        lut[tid] = p.rel_bias[bk * 12 + g * 4 + j] * LOG2E;
    }
    const int qpos = p0r + w * 32 + r32;
    bf16x8 qr[4];
#pragma unroll
    for (int ds = 0; ds < 4; ++ds) qr[ds] = *(const bf16x8*)(QB + (size_t)qpos * 256 + ds * 16 + hi * 8);
    const float nshift = -((const float*)(p.ws + WS_BND))[2 + l];
    f32x16 o0, o1;
#pragma unroll
    for (int i = 0; i < 16; ++i) { o0[i] = 0.f; o1[i] = 0.f; }
    float lacc = 0.f;
    u32x4 rk[2], rv[2];
    for (int kt = 0; kt < 4; ++kt) {
        const int kbase = p0r - 64 + 64 * kt;
#pragma unroll
        for (int i = 0; i < 2; ++i) { const int c = tid + 256 * i, row = c >> 3, ch = c & 7;
            int pr = kbase + row; pr = pr < 0 ? 0 : (pr > SEQ - 1 ? SEQ - 1 : pr);
            rk[i] = *(const u32x4*)(KB + (size_t)pr * 256 + ch * 8); rv[i] = *(const u32x4*)(VB + (size_t)pr * 256 + ch * 8); }
        __syncthreads();
        AT_STAGE_STORE();
        __syncthreads();
        f32x16 p0, p1;
#pragma unroll
        for (int i = 0; i < 16; ++i) { p0[i] = nshift; p1[i] = nshift; }
        at_qk(p0, p1, Ks, qr, r32, hi);
#pragma unroll
        for (int i = 0; i < 16; ++i) {
            const int kv0 = kbase + crow(i, hi), kv1 = kv0 + 32;
            const int rel0 = kv0 - qpos, rel1 = kv1 - qpos;
            const bool ok0 = rel0 >= -64 && rel0 <= 64 && kv0 >= seq_lo && kv0 < seq_hi;
            const bool ok1 = rel1 >= -64 && rel1 <= 64 && kv1 >= seq_lo && kv1 < seq_hi;
            const float e0 = __builtin_amdgcn_exp2f(p0[i] + lut[ok0 ? rel0 + 64 : 64]);
            const float e1 = __builtin_amdgcn_exp2f(p1[i] + lut[ok1 ? rel1 + 64 : 64]);
            p0[i] = ok0 ? e0 : 0.f; p1[i] = ok1 ? e1 : 0.f; lacc += p0[i] + p1[i];
        }
        at_pv(o0, o1, p0, p1, Vs, lane);
    }
    lacc += __shfl_xor(lacc, 32);
    if (hi == 0) { lq[r32] = lacc; LSE[(size_t)qpos * 4] = (-nshift + log2f(lacc)) * LN2; }
    asm volatile("s_waitcnt lgkmcnt(0)" ::: "memory");
#pragma unroll
    for (int rr = 0; rr < 16; ++rr) {
        const int q = crow(rr, hi); const float inv = 1.f / lq[q];
        const size_t off = (size_t)(p0r + w * 32 + q) * 256 + r32;
        QB[off] = (bf16_t)(pk2(o0[rr] * inv, 0.f) & 0xffffu);
        QB[off + 32] = (bf16_t)(pk2(o1[rr] * inv, 0.f) & 0xffffu);
    }
}

constexpr int SS_BS = 0, SS_CS = 8704, SS_XS = 17408, SS_XWS = 22016, SS_GS = 26624, SS_SB = 29184, SS_CW = 46592, SS_SC = 54272, SS_DTA = 55296, SS_END = 57344;

template <int PASS>
__device__ void ssd_item(const Params& p, int item, int l, unsigned char* smem) {
    int tid_ = VTID; asm volatile("" : "+v"(tid_));
    const int tid = tid_, lane = tid & 63, w = tid >> 6, idx = lane & 15, kq = lane >> 4;
    const int seg = item & 15, h = (item >> 4) & 7, dir = (item >> 7) & 1, b = item >> 8, grp = h >> 2;
    bf16_t* Bs = (bf16_t*)(smem + SS_BS); bf16_t* Cs = (bf16_t*)(smem + SS_CS); bf16_t* Xs = (bf16_t*)(smem + SS_XS); bf16_t* Xws = (bf16_t*)(smem + SS_XWS);
    bf16_t* Gs = (bf16_t*)(smem + SS_GS); bf16_t* Sb = (bf16_t*)(smem + SS_SB); float* cwl = (float*)(smem + SS_CW); float* sc = (float*)(smem + SS_SC);
    float* s_dt = sc, *s_c = sc + 32, *s_rs = sc + 64, *s_wl = sc + 96, *s_tot = sc + 128;
    const bf16_t* XBC = (const bf16_t*)(p.ws + WS_XBC);
    const float* DT = (const float*)(p.ws + WS_DT);
    float* ST = (float*)(p.ws + WS_ST); float* SEGT = (float*)(p.ws + WS_SEGT);
    bf16_t* Y = (bf16_t*)(p.ws + (dir ? WS_YS : WS_YF));
    const float Aneg = -__expf(p.a_log[l * 16 + dir * 8 + h]);
    const float Dh = p.d_skip[l * 8 + h];
    __syncthreads();
    for (int e = tid; e < 6 * 320; e += 256) {
        const int tap = e / 320, lc = e % 320;
        const int ch = lc < 64 ? h * 64 + lc : (lc < 192 ? 512 + grp * 128 + (lc - 64) : 768 + grp * 128 + (lc - 192));
        cwl[e] = tap < 5 ? p.conv_w[(size_t)l * 5 * 1024 + tap * 1024 + ch] : p.conv_b[l * 1024 + ch];
    }
    f32x4 S[8];
#pragma unroll
    for (int nt = 0; nt < 8; ++nt) S[nt] = (f32x4){0.f, 0.f, 0.f, 0.f};
    const int ibase = item & ~15;
    if (PASS == 3) {
        if (dir == 0) {
            for (int e = 0; e < seg; ++e) { const float dc = __expf(SEGT[ibase + e]); const f32x4* src = (const f32x4*)(ST + (size_t)(ibase + e) * 8192);
#pragma unroll
                for (int nt = 0; nt < 8; ++nt) S[nt] = S[nt] * dc + src[(w * 8 + nt) * 64 + lane]; }
        } else {
            for (int e = NSEG - 1; e > seg; --e) { const float dc = __expf(SEGT[ibase + e]); const f32x4* src = (const f32x4*)(ST + (size_t)(ibase + e) * 8192);
#pragma unroll
                for (int nt = 0; nt < 8; ++nt) S[nt] = S[nt] * dc + src[(w * 8 + nt) * 64 + lane]; }
        }
#pragma unroll
        for (int nt = 0; nt < 8; ++nt) st4bf(Sb + (16 * w + idx) * 136 + 16 * nt + 4 * kq, S[nt]);
    }
    float* s_dta = (float*)(smem + SS_DTA);
    for (int e = tid; e < SEGLEN; e += 256) s_dta[e] = DT[((size_t)b * SEQ + seg * SEGLEN + e) * 16 + dir * 8 + h];
    float segtot = 0.f;
    const int ci0 = tid % 40, tg0 = tid / 40, ci1 = (tid + 64) % 40, tg1 = (tid + 64) / 40;
    const int sc0 = ci0 < 8 ? h * 64 + ci0 * 8 : (ci0 < 24 ? 512 + grp * 128 + (ci0 * 8 - 64) : 768 + grp * 128 + (ci0 * 8 - 192));
    const int sc1 = ci1 < 8 ? h * 64 + ci1 * 8 : (ci1 < 24 ? 512 + grp * 128 + (ci1 * 8 - 64) : 768 + grp * 128 + (ci1 * 8 - 192));
    const bool has1 = tid >= 192;
#define SS_CONV(RAW, CI, TG) do { const int lc_ = (CI) * 8; float ac_[4][8]; \
        { const f32x4 a_ = *(const f32x4*)(cwl + 5 * 320 + lc_), b_ = *(const f32x4*)(cwl + 5 * 320 + lc_ + 4); \
          _Pragma("unroll") for (int l_ = 0; l_ < 4; ++l_) { ac_[l_][0] = a_.x; ac_[l_][1] = a_.y; ac_[l_][2] = a_.z; ac_[l_][3] = a_.w; ac_[l_][4] = b_.x; ac_[l_][5] = b_.y; ac_[l_][6] = b_.z; ac_[l_][7] = b_.w; } } \
        _Pragma("unroll") for (int k_ = 0; k_ < 5; ++k_) { const f32x4 wa_ = *(const f32x4*)(cwl + k_ * 320 + lc_), wb_ = *(const f32x4*)(cwl + k_ * 320 + lc_ + 4); \
            _Pragma("unroll") for (int l_ = 0; l_ < 4; ++l_) { const u32x4 v_ = RAW[l_ + k_]; \
                ac_[l_][0] += bflo(v_.x) * wa_.x; ac_[l_][1] += bfhi(v_.x) * wa_.y; ac_[l_][2] += bflo(v_.y) * wa_.z; ac_[l_][3] += bfhi(v_.y) * wa_.w; \
                ac_[l_][4] += bflo(v_.z) * wb_.x; ac_[l_][5] += bfhi(v_.z) * wb_.y; ac_[l_][6] += bflo(v_.w) * wb_.z; ac_[l_][7] += bfhi(v_.w) * wb_.w; } \
            asm volatile("" ::: "memory"); } \
        _Pragma("unroll") for (int l_ = 0; l_ < 4; ++l_) { const int lrow_ = 4 * (TG) + l_; float* a_ = ac_[l_]; \
            _Pragma("unroll") for (int e_ = 0; e_ < 8; ++e_) a_[e_] = siluf(a_[e_]); \
            u32x4 o_; o_.x = pk2(a_[0], a_[1]); o_.y = pk2(a_[2], a_[3]); o_.z = pk2(a_[4], a_[5]); o_.w = pk2(a_[6], a_[7]); \
            if ((CI) < 8) { *(u32x4*)(Xs + lrow_ * 72 + lc_) = o_; const float wl_ = s_wl[lrow_]; \
                u32x4 o2_; o2_.x = pk2(a_[0] * wl_, a_[1] * wl_); o2_.y = pk2(a_[2] * wl_, a_[3] * wl_); o2_.z = pk2(a_[4] * wl_, a_[5] * wl_); o2_.w = pk2(a_[6] * wl_, a_[7] * wl_); \
                *(u32x4*)(Xws + lrow_ * 72 + lc_) = o2_; } \
            else if ((CI) < 24) *(u32x4*)(Bs + lrow_ * 136 + (lc_ - 64)) = o_; \
            else *(u32x4*)(Cs + lrow_ * 136 + (lc_ - 192)) = o_; } } while (0)
    const size_t tokb = (size_t)b * SEQ;
    const unsigned char* xb_ = (const unsigned char*)(XBC + tokb * 1024);
    u32x4 raw0[8];
#define SS_LOAD0(T0) do { const unsigned o0_ = (unsigned)((((T0) + 4 * tg0 - 2) * 1024 + sc0) * 2); \
        _Pragma("unroll") for (int r_ = 0; r_ < 8; ++r_) { const int tt0 = (T0) + 4 * tg0 - 2 + r_; raw0[r_] = (u32x4){0u, 0u, 0u, 0u}; \
            if (tt0 >= 0 && tt0 < SEQ) raw0[r_] = *(const u32x4*)(xb_ + (o0_ + (unsigned)(r_ * 2048))); } } while (0)
    for (int si = 0; si < NSUB; ++si) {
        const int scn = dir ? (NSUB - 1 - si) : si;
        const int t0 = seg * SEGLEN + scn * TSUB;
        __syncthreads();
        SS_LOAD0(t0);
        if (w == 0) {
            float dtv = 0.f, av = 0.f;
            if (lane < 32) { dtv = s_dta[scn * TSUB + lane]; av = dtv * Aneg; }
            float pre = av;
#pragma unroll
            for (int o = 1; o < 32; o <<= 1) { const float t = __shfl_up(pre, o); if (lane >= o) pre += t; }
            const float tot = __shfl(pre, 31);
            const float cc = dir ? (tot - pre + av) : pre;
            if (lane < 32) { s_dt[lane] = dtv; s_c[lane] = cc; s_rs[lane] = __expf(cc); s_wl[lane] = dtv * __expf(tot - cc); }
            if (lane == 0) s_tot[0] = tot;
        }
        __syncthreads();
        segtot += s_tot[0];
        SS_CONV(raw0, ci0, tg0);
        if (has1) {
            const unsigned o1_ = (unsigned)(((t0 + 4 * tg1 - 2) * 1024 + sc1) * 2);
#pragma unroll
            for (int r_ = 0; r_ < 8; ++r_) {
                const int tt1 = t0 + 4 * tg1 - 2 + r_;
                raw0[r_] = (u32x4){0u, 0u, 0u, 0u};
                if (tt1 >= 0 && tt1 < SEQ) raw0[r_] = *(const u32x4*)(xb_ + (o1_ + (unsigned)(r_ * 2048)));
            }
            SS_CONV(raw0, ci1, tg1);
        }
        __syncthreads();
        if (PASS == 3) {
            const int it = w >> 1, jt = w & 1;
            f32x4 cb = (f32x4){0.f, 0.f, 0.f, 0.f};
#pragma unroll
            for (int ks = 0; ks < 4; ++ks) {
                const bf16x8 fb = *(const bf16x8*)(Bs + (16 * jt + idx) * 136 + ks * 32 + kq * 8);
                const bf16x8 fc = *(const bf16x8*)(Cs + (16 * it + idx) * 136 + ks * 32 + kq * 8);
                cb = __builtin_amdgcn_mfma_f32_16x16x32_bf16(fb, fc, cb, 0, 0, 0);
            }
            {
                const int ii = 16 * it + idx; const float ci_ = s_c[ii];
                f32x4 gv;
#pragma unroll
                for (int rg = 0; rg < 4; ++rg) {
                    const int jj = 16 * jt + 4 * kq + rg;
                    const bool ok = dir ? (jj >= ii) : (jj <= ii);
                    const float e = __expf(ci_ - s_c[jj]) * s_dt[jj];
                    gv[rg] = ok ? cb[rg] * e : 0.f;
                }
                st4bf(Gs + ii * 40 + 16 * jt + 4 * kq, gv);
            }
            __syncthreads();
            const unsigned char* xtr = (const unsigned char*)Xs + (8 * kq + (idx >> 2)) * 144 + (16 * w + 4 * (idx & 3)) * 2;
            const bf16x8 xf = cat8(tr16(xtr), tr16(xtr + 4 * 144));
#pragma unroll 1
            for (int it2 = 0; it2 < 2; ++it2) {
                const int ii = 16 * it2 + idx;
                const bf16x8 gf = *(const bf16x8*)(Gs + ii * 40 + 8 * kq);
                f32x4 yd = (f32x4){0.f, 0.f, 0.f, 0.f}, yo = (f32x4){0.f, 0.f, 0.f, 0.f};
                yd = __builtin_amdgcn_mfma_f32_16x16x32_bf16(xf, gf, yd, 0, 0, 0);
#pragma unroll
                for (int ks = 0; ks < 4; ++ks) {
                    const bf16x8 sf = *(const bf16x8*)(Sb + (16 * w + idx) * 136 + ks * 32 + kq * 8);
                    const bf16x8 cf = *(const bf16x8*)(Cs + ii * 136 + ks * 32 + kq * 8);
                    yo = __builtin_amdgcn_mfma_f32_16x16x32_bf16(sf, cf, yo, 0, 0, 0);
                }
                f32x4 y = yd + yo * s_rs[ii];
                if (dir == 0) { const u32x2 xv = *(const u32x2*)(Xs + ii * 72 + 16 * w + 4 * kq);
                    y.x += Dh * bflo(xv.x); y.y += Dh * bfhi(xv.x); y.z += Dh * bflo(xv.y); y.w += Dh * bfhi(xv.y); }
                st4bf(Y + (tokb + t0 + ii) * 512 + h * 64 + 16 * w + 4 * kq, y);
            }
        }
        {
            const float dc = __expf(s_tot[0]);
            const unsigned char* xw = (const unsigned char*)Xws + (8 * kq + (idx >> 2)) * 144 + (16 * w + 4 * (idx & 3)) * 2;
            const bf16x8 xwf = cat8(tr16(xw), tr16(xw + 4 * 144));
#pragma unroll
            for (int nt = 0; nt < 8; ++nt) {
                const unsigned char* bt = (const unsigned char*)Bs + (8 * kq + (idx >> 2)) * 272 + (16 * nt + 4 * (idx & 3)) * 2;
                const bf16x8 bf = cat8(tr16(bt), tr16(bt + 4 * 272));
                S[nt] = __builtin_amdgcn_mfma_f32_16x16x32_bf16(bf, xwf, S[nt] * dc, 0, 0, 0);
            }
            if (PASS == 3) {
#pragma unroll
                for (int nt = 0; nt < 8; ++nt) st4bf(Sb + (16 * w + idx) * 136 + 16 * nt + 4 * kq, S[nt]);
            }
        }
    }
    if (PASS == 1) {
        f32x4* dst = (f32x4*)(ST + (size_t)item * 8192);
#pragma unroll
        for (int nt = 0; nt < 8; ++nt) dst[(w * 8 + nt) * 64 + lane] = S[nt];
        if (tid == 0) SEGT[item] = segtot;
    }
}

__device__ void post2_phase(const Params& p) {
    int tx_ = threadIdx.x; asm volatile("" : "+v"(tx_));
    const int lane = tx_ & 63, gw = blockIdx.x * 8 + (tx_ >> 6), nw = gridDim.x * 8;
    const bf16_t* OB = (const bf16_t*)(p.ws + WS_QB); const float* LSE = (const float*)(p.ws + WS_LSE);
    const bf16_t* GB = (const bf16_t*)(p.ws + WS_GB);
    bf16_t* YBM = (bf16_t*)(p.ws + WS_YBM);
    const bf16_t* YF = (const bf16_t*)(p.ws + WS_YF); const bf16_t* YS = (const bf16_t*)(p.ws + WS_YS); const bf16_t* ZS = (const bf16_t*)(p.ws + WS_ZS);
    bf16_t* YC = (bf16_t*)(p.ws + WS_YC); float* RS = (float*)(p.ws + WS_RSTD);
    for (int row = gw; row < TP; row += nw) {
        const int bl = row >> 13, tt = row & (SEQ - 1), j = lane >> 4;
        float ls[3]; size_t ro[3];
#pragma unroll
        for (int g = 0; g < 3; ++g) { const int sh = 2 * g; const int pp = (tt & ((1 << sh) - 1)) * (SEQ >> sh) + (tt >> sh);
            ro[g] = (size_t)(bl * 3 + g) * SEQ + pp; ls[g] = LSE[ro[g] * 4 + j]; }
        const float mx = fmaxf(ls[0], fmaxf(ls[1], ls[2]));
        float wg[3]; float ws = 0.f;
#pragma unroll
        for (int g = 0; g < 3; ++g) { wg[g] = __expf(ls[g] - mx); ws += wg[g]; }
        const float inv = 1.f / ws;
        f32x4 acc = (f32x4){0.f, 0.f, 0.f, 0.f};
#pragma unroll
        for (int g = 0; g < 3; ++g) { const u32x2 v = *(const u32x2*)(OB + ro[g] * 256 + 4 * lane); const float wv = wg[g] * inv;
            acc.x += wv * bflo(v.x); acc.y += wv * bfhi(v.x); acc.z += wv * bflo(v.y); acc.w += wv * bfhi(v.y); }
        { const u32x2 gt = *(const u32x2*)(GB + (size_t)row * 256 + 4 * lane);
          acc.x *= bflo(gt.x); acc.y *= bfhi(gt.x); acc.z *= bflo(gt.y); acc.w *= bfhi(gt.y); }
        st4bf(YBM + (size_t)row * 256 + 4 * lane, acc);
        const u32x4 a = *(const u32x4*)(YF + (size_t)row * 512 + 8 * lane), bq = *(const u32x4*)(YS + (size_t)row * 512 + 8 * lane), z = *(const u32x4*)(ZS + (size_t)row * 512 + 8 * lane);
        float y[8];
        y[0] = (bflo(a.x) + bflo(bq.x)) * bflo(z.x); y[1] = (bfhi(a.x) + bfhi(bq.x)) * bfhi(z.x);
        y[2] = (bflo(a.y) + bflo(bq.y)) * bflo(z.y); y[3] = (bfhi(a.y) + bfhi(bq.y)) * bfhi(z.y);
        y[4] = (bflo(a.z) + bflo(bq.z)) * bflo(z.z); y[5] = (bfhi(a.z) + bfhi(bq.z)) * bfhi(z.z);
        y[6] = (bflo(a.w) + bflo(bq.w)) * bflo(z.w); y[7] = (bfhi(a.w) + bfhi(bq.w)) * bfhi(z.w);
        float ss = 0.f;
#pragma unroll
        for (int e = 0; e < 8; ++e) ss += y[e] * y[e];
        ss = wave_sum(ss);
        u32x4 o; o.x = pk2(y[0], y[1]); o.y = pk2(y[2], y[3]); o.z = pk2(y[4], y[5]); o.w = pk2(y[6], y[7]);
        *(u32x4*)(YC + (size_t)row * 512 + 8 * lane) = o;
        if (lane == 0) RS[row] = rsqrtf(ss * (1.f / 512.f) + EPS);
    }
}


#define XB_TMO      128
#define XB_XCNT(j)  (256  + 64 * (j))
#define XB_XSUB(j)  (1280 + 64 * (j))
#define XB_XGEN(j)  (2304 + 64 * (j))
#define XB_TOP      3328
#define XB_TOPGEN   3392
#define XCD_BAR_WORDS 3456
#define XB_SPIN_CAP (1u << 20)
__device__ __forceinline__ unsigned xb_ld(unsigned* p)              { return __hip_atomic_load(p, __ATOMIC_RELAXED, __HIP_MEMORY_SCOPE_AGENT); }
__device__ __forceinline__ unsigned xb_add(unsigned* p, unsigned v) { return __hip_atomic_fetch_add(p, v, __ATOMIC_RELAXED, __HIP_MEMORY_SCOPE_AGENT); }
__device__ __forceinline__ unsigned xb_xcc_id() { return (unsigned)__builtin_amdgcn_s_getreg((3 << 11) | 20) & 0xFu; }
#define XB_SPIN(cond, bar) do { unsigned _sp = 0; while (cond) { __builtin_amdgcn_s_sleep(1); \
    if ((++_sp & 255u) == 0u) { if (xb_ld(&(bar)[XB_TMO])) break; if (_sp > XB_SPIN_CAP) { atomicAdd(&(bar)[XB_TMO], 1u); break; } } } } while (0)
struct XcdBarrier { unsigned* bar; unsigned x; volatile LDSAS unsigned* st; };
__device__ __forceinline__ XcdBarrier xcd_barrier_post(unsigned* bar, volatile LDSAS unsigned* st) {
    XcdBarrier b; b.bar = bar; b.x = xb_xcc_id(); b.st = st;
    if (threadIdx.x == 0) (void)xb_add(&bar[XB_XCNT(b.x)], 1u);
    return b;
}
__device__ __forceinline__ void xcd_barrier_complete(unsigned* bar, unsigned x, unsigned& nloc, unsigned& nx) {
    const unsigned G = gridDim.x * gridDim.y * gridDim.z;
    unsigned sum, cnt, mine, sp = 0u;
    for (;;) {
        sum = 0u; cnt = 0u; mine = 0u;
#pragma unroll
        for (unsigned j = 0; j < 16; ++j) { const unsigned c = xb_ld(&bar[XB_XCNT(j)]); sum += c; cnt += (c > 0u) ? 1u : 0u; mine = (j == x) ? c : mine; }
        if (sum == G) break;
        __builtin_amdgcn_s_sleep(1);
        if ((++sp & 255u) == 0u) { if (xb_ld(&bar[XB_TMO])) break; if (sp > XB_SPIN_CAP) { atomicAdd(&bar[XB_TMO], 1u); break; } }
    }
    nloc = mine > 0u ? mine : 1u; nx = cnt > 0u ? cnt : 1u;
}
__device__ __forceinline__ void xcd_barrier(const XcdBarrier& b) {
    asm volatile("s_waitcnt vmcnt(0)" ::: "memory");
    __syncthreads();
    if (threadIdx.x == 0) {
        unsigned* bar = b.bar;
        __builtin_amdgcn_s_waitcnt(0);
        unsigned nloc = b.st[0], nx = b.st[1];
        if (nloc == 0u) { xcd_barrier_complete(bar, b.x, nloc, nx); b.st[0] = nloc; b.st[1] = nx; }
        const unsigned old = xb_add(&bar[XB_XSUB(b.x)], 1u);
        const unsigned gen = old / nloc;
        if (old + 1u == (gen + 1u) * nloc) {
            __builtin_amdgcn_fence(__ATOMIC_RELEASE, "agent");
            asm volatile("s_waitcnt vmcnt(0)" ::: "memory");
            const unsigned og = xb_add(&bar[XB_TOP], 1u);
            const unsigned tg = og / nx;
            if (og + 1u == (tg + 1u) * nx) xb_add(&bar[XB_TOPGEN], 1u);
            else XB_SPIN(xb_ld(&bar[XB_TOPGEN]) == tg, bar);
            __builtin_amdgcn_fence(__ATOMIC_ACQUIRE, "agent");
            xb_add(&bar[XB_XGEN(b.x)], 1u);
            asm volatile("s_waitcnt vmcnt(0)" ::: "memory");
        } else {
            XB_SPIN(xb_ld(&bar[XB_XGEN(b.x)]) == gen, bar);
            __builtin_amdgcn_fence(__ATOMIC_ACQUIRE, "agent");
            asm volatile("s_waitcnt vmcnt(0)" ::: "memory");
        }
    }
    __syncthreads();
}

__device__ __forceinline__ unsigned char* lds_half(unsigned char* smem) { int h_ = threadIdx.x >> 8; asm volatile("" : "+v"(h_)); return smem + h_ * HALF_LDS; }
__global__ void __launch_bounds__(512, 2) hybrid_fwd(Params p) {
    cg::grid_group grid = cg::this_grid();
    extern __shared__ __attribute__((aligned(16))) unsigned char smem[];
    volatile LDSAS unsigned* bst = (volatile LDSAS unsigned*)(smem + LDS_TOTAL - 16);
    if (threadIdx.x < 4) bst[threadIdx.x] = 0u;
    __syncthreads();
    const XcdBarrier xbar = xcd_barrier_post((unsigned*)(p.ws + WS_BAR), bst);
    { const Params q = launder(p); phase0(q, lds_half(smem)); }
    grid.sync();
#pragma unroll 1
    for (int l = 0; l < DEPTH; ++l) {
#pragma unroll 1
        for (int hb = 0; hb < 2; ++hb) {
            { const Params q = launder(p); norm_phase(q, l, hb, (l == 0) ? q.x : q.out); }
            xcd_barrier(xbar);
            { const Params q = launder(p); gemm1_phase(q, l, hb, smem); }
            xcd_barrier(xbar);
            { const Params q = launder(p); unsigned char* smh = lds_half(smem);
#pragma unroll 1
              for (int it = VBLK; it < 512 + 1536; it += VGRID) { if (it < 512) ssd_item<1>(q, it, l, smh); else attn_b_item(q, it - 512, l, smh); } }
            xcd_barrier(xbar);
            { const Params q = launder(p); unsigned char* smh = lds_half(smem);
#pragma unroll 1
              for (int it = VBLK; it < 1024 + 512; it += VGRID) { if (it < 1024) attn_a_item(q, it, l, smh); else ssd_item<3>(q, it - 1024, l, smh); } }
            xcd_barrier(xbar);
            { const Params q = launder(p); post2_phase(q); }
            xcd_barrier(xbar);
            { const Params q = launder(p); merge_phase(q, l, smem); }
            xcd_barrier(xbar);
            { const Params q = launder(p); out_phase(q, l, hb, (l == 0) ? q.x : q.out, smem); }
            xcd_barrier(xbar);
        }
    }
}

extern "C" void kernel_launch(void* const* d_in, const int* in_sizes, int n_in, void* d_out, int out_size, void* d_ws, size_t ws_size, hipStream_t stream) {
    static int grid_blocks = 0;
    if (!grid_blocks) {
        int dev = 0, cus = 0, per_cu = 0;
        hipGetDevice(&dev);
        hipDeviceGetAttribute(&cus, hipDeviceAttributeMultiprocessorCount, dev);
        hipFuncSetAttribute((const void*)hybrid_fwd, hipFuncAttributeMaxDynamicSharedMemorySize, LDS_TOTAL);
        hipOccupancyMaxActiveBlocksPerMultiprocessor(&per_cu, hybrid_fwd, 512, LDS_TOTAL);
        if (per_cu > 1) per_cu = 1;
        if (per_cu < 1) per_cu = 1;
        grid_blocks = cus * per_cu;
    }
    Params p{};
    const float** pp = (const float**)&p;
    for (int i = 0; i < 22; ++i) pp[i] = (const float*)d_in[i];
    p.out = (float*)d_out; p.ws = (unsigned char*)d_ws;
    hipMemsetAsync((unsigned char*)d_ws + WS_BAR, 0, XCD_BAR_WORDS * 4, stream);
    void* args[] = {&p};
    hipError_t e = hipLaunchCooperativeKernel((void*)hybrid_fwd, dim3(grid_blocks), dim3(512), args, LDS_TOTAL, stream);
    if (e != hipSuccess) fprintf(stderr, "cooperative launch failed: %s (grid %d)\n", hipGetErrorString(e), grid_blocks);
}
```

```cpp
#include <hip/hip_runtime.h>
#include <hip/hip_cooperative_groups.h>
#include <cstdint>
#include <cstdio>
namespace cg = cooperative_groups;

typedef unsigned short bf16_t;
typedef short bf16x8 __attribute__((ext_vector_type(8)));
typedef short v4i16 __attribute__((ext_vector_type(4)));
typedef float f32x2 __attribute__((ext_vector_type(2)));
typedef float f32x4 __attribute__((ext_vector_type(4)));
typedef float f32x16 __attribute__((ext_vector_type(16)));
typedef unsigned u32x2 __attribute__((ext_vector_type(2)));
typedef unsigned u32x4 __attribute__((ext_vector_type(4)));
typedef __bf16 bf16x2_t __attribute__((ext_vector_type(2)));
#define LDSAS __attribute__((address_space(3)))
#define VTID ((int)(threadIdx.x & 255u))
__device__ __forceinline__ int vblk_() { int h_ = threadIdx.x >> 8; asm volatile("" : "+v"(h_)); return __builtin_amdgcn_readfirstlane(2 * (int)blockIdx.x + h_); }
#define VBLK vblk_()
#define VGRID ((int)(2u * gridDim.x))
constexpr int HALF_LDS = 73728, LDS_TOTAL = 147456;

constexpr int SEQ = 8192, DM = 1024, NBATCH = 4, NBH = 2, TP = NBH * SEQ, DEPTH = 2;
constexpr int NP = 8704;
constexpr float EPS = 1e-6f;
constexpr float LOG2E = 1.4426950408889634f, LN2 = 0.6931471805599453f;
constexpr int NSEG = 16, SEGLEN = 512, TSUB = 32, NSUB = SEGLEN / TSUB;

constexpr size_t MiB = 1u << 20;
constexpr size_t WS_WIN = 0;
constexpr size_t WS_WPA = 34 * MiB;
constexpr size_t WS_WPB = 36 * MiB;
constexpr size_t WS_WPC = 37 * MiB;
constexpr size_t WS_WOUT = 39 * MiB;
constexpr size_t WS_MOD = 43 * MiB;
constexpr size_t WS_ROPE = 43 * MiB + 128 * 1024;
constexpr size_t WS_BND = 43 * MiB + 160 * 1024;
constexpr size_t WS_RSTD = 43 * MiB + 256 * 1024;
constexpr size_t WS_SEGT = 43 * MiB + 512 * 1024;
constexpr size_t WS_LSE = 44 * MiB;
constexpr size_t WS_DT = 45 * MiB;
constexpr size_t WS_BAR = 46 * MiB;
constexpr size_t WS_H = 48 * MiB;
constexpr size_t WS_QA = 80 * MiB;
constexpr size_t WS_KA = 96 * MiB;
constexpr size_t WS_VA = 100 * MiB;
constexpr size_t WS_GA = 104 * MiB;
constexpr size_t WS_QB = 120 * MiB;
constexpr size_t WS_KB = 144 * MiB;
constexpr size_t WS_VB = 168 * MiB;
constexpr size_t WS_GB = 192 * MiB;
constexpr size_t WS_XBC = 200 * MiB;
constexpr size_t WS_ZS = 232 * MiB;
constexpr size_t WS_MG = 248 * MiB;
constexpr size_t WS_YF = 344 * MiB;
constexpr size_t WS_YS = 360 * MiB;
constexpr size_t WS_YBM = 376 * MiB;
constexpr size_t WS_YC = 384 * MiB;
constexpr size_t WS_MRG = 400 * MiB;
constexpr size_t WS_ST = 432 * MiB;

struct Params {
    const float *x, *c, *norm_w, *w_ada, *b_ada, *w_in, *b_gate, *q_norm_a, *k_norm_a, *q_norm_b, *k_norm_b, *rel_bias,
        *conv_w, *conv_b, *a_log, *dt_bias, *d_skip, *ssm_norm_w, *w_proj_a, *w_proj_b, *w_proj_c, *w_out;
    float* out;
    unsigned char* ws;
};


#define AS1 __attribute__((address_space(1)))
#define GLOBF(f) do { AS1 const float* g_ = (AS1 const float*)p.f; asm volatile("" : "+s"(g_)); q.f = (const float*)g_; } while (0)
__device__ __forceinline__ Params launder(const Params& p) {
    Params q;
    GLOBF(x); GLOBF(c); GLOBF(norm_w); GLOBF(w_ada); GLOBF(b_ada); GLOBF(w_in); GLOBF(b_gate); GLOBF(q_norm_a); GLOBF(k_norm_a); GLOBF(q_norm_b); GLOBF(k_norm_b); GLOBF(rel_bias);
    GLOBF(conv_w); GLOBF(conv_b); GLOBF(a_log); GLOBF(dt_bias); GLOBF(d_skip); GLOBF(ssm_norm_w); GLOBF(w_proj_a); GLOBF(w_proj_b); GLOBF(w_proj_c); GLOBF(w_out);
    { AS1 float* g_ = (AS1 float*)p.out; asm volatile("" : "+s"(g_)); q.out = (float*)g_; }
    { AS1 unsigned char* g_ = (AS1 unsigned char*)p.ws; asm volatile("" : "+s"(g_)); q.ws = (unsigned char*)g_; }
    return q;
}
__device__ __forceinline__ unsigned pk2(float lo, float hi) { f32x2 v = {lo, hi}; bf16x2_t b = __builtin_convertvector(v, bf16x2_t); return __builtin_bit_cast(unsigned, b); }
__device__ __forceinline__ float bf2f(unsigned short b) { return __uint_as_float(((unsigned)b) << 16); }
__device__ __forceinline__ float bflo(unsigned u) { return __uint_as_float(u << 16); }
__device__ __forceinline__ float bfhi(unsigned u) { return __uint_as_float(u & 0xffff0000u); }
__device__ __forceinline__ float siluf(float v) { return v * __builtin_amdgcn_rcpf(1.f + __builtin_amdgcn_exp2f(-1.4426950408889634f * v)); }
__device__ __forceinline__ float sigmf(float v) { return __builtin_amdgcn_rcpf(1.f + __builtin_amdgcn_exp2f(-1.4426950408889634f * v)); }
__device__ __forceinline__ float wave_sum(float v) {
#pragma unroll
    for (int o = 1; o < 64; o <<= 1) v += __shfl_xor(v, o);
    return v;
}
__device__ __forceinline__ v4i16 tr16(const unsigned char* p) { return __builtin_amdgcn_ds_read_tr16_b64_v4i16((LDSAS v4i16*)p); }
__device__ __forceinline__ bf16x8 cat8(v4i16 a, v4i16 b) { return (bf16x8){a[0], a[1], a[2], a[3], b[0], b[1], b[2], b[3]}; }
__device__ __forceinline__ int crow(int r, int hi) { return (r & 3) + 8 * (r >> 2) + 4 * hi; }

__device__ __forceinline__ void p0_transpose(const float* __restrict__ W, int ldw, int K, bf16_t* __restrict__ Wt, int k0, int n0, int mode,
                                             const float* __restrict__ rowscale, float* tile) {
    const int tid = VTID, tx = tid & 63, ty = tid >> 6;
    const int np = n0 + tx; int n = np; bool valid = true;
    if (mode == 1) {
        if (np < 4352) n = np; else if (np < 4864) n = np + 512; else if (np < 5376) n = np - 512;
        else if (np < 8448) n = np + 16; else if (np < 8464) n = np - 3072; else { valid = false; n = 0; }
    }
#pragma unroll 4
    for (int i = 0; i < 16; ++i) {
        const int k = ty + 4 * i; float v = valid ? W[(size_t)(k0 + k) * ldw + n] : 0.f;
        if (rowscale) v *= rowscale[k0 + k];
        tile[k * 65 + tx] = v;
    }
    __syncthreads();
    const int r = tid >> 2, kc = (tid & 3) * 16;
    u32x4 o0, o1;
    o0.x = pk2(tile[(kc + 0) * 65 + r], tile[(kc + 1) * 65 + r]); o0.y = pk2(tile[(kc + 2) * 65 + r], tile[(kc + 3) * 65 + r]);
    o0.z = pk2(tile[(kc + 4) * 65 + r], tile[(kc + 5) * 65 + r]); o0.w = pk2(tile[(kc + 6) * 65 + r], tile[(kc + 7) * 65 + r]);
    o1.x = pk2(tile[(kc + 8) * 65 + r], tile[(kc + 9) * 65 + r]); o1.y = pk2(tile[(kc + 10) * 65 + r], tile[(kc + 11) * 65 + r]);
    o1.z = pk2(tile[(kc + 12) * 65 + r], tile[(kc + 13) * 65 + r]); o1.w = pk2(tile[(kc + 14) * 65 + r], tile[(kc + 15) * 65 + r]);
    bf16_t* dst = Wt + (size_t)(n0 + r) * K + k0 + kc;
    *(u32x4*)dst = o0; *(u32x4*)(dst + 8) = o1;
    __syncthreads();
}

__device__ void phase0(const Params& p, unsigned char* smem) {
    const int tid = VTID;
    float* tile = (float*)smem;
    constexpr int I_IN = 16 * 136, I_PA = 8 * 16, I_PB = 4 * 16, I_PC = 8 * 16, I_OUT = 16 * 16, I_L = I_IN + I_PA + I_PB + I_PC + I_OUT;
    constexpr int I_T = 2 * I_L, I_MOD = 192, I_ALL = I_T + I_MOD + 1;
    for (int item = VBLK; item < I_ALL; item += VGRID) {
        if (item < I_T) {
            const int l = item / I_L; int r = item % I_L;
            if (r < I_IN) { const int kt = r / 136, nt = r % 136;
                p0_transpose(p.w_in + (size_t)l * 1024 * 8464, 8464, 1024, (bf16_t*)(p.ws + WS_WIN) + (size_t)l * NP * 1024, kt * 64, nt * 64, 1, nullptr, tile); continue; }
            r -= I_IN;
            if (r < I_PA) { const int kt = r / 16, nt = r % 16;
                p0_transpose(p.w_proj_a + (size_t)l * 512 * 1024, 1024, 512, (bf16_t*)(p.ws + WS_WPA) + (size_t)l * 1024 * 512, kt * 64, nt * 64, 0, nullptr, tile); continue; }
            r -= I_PA;
            if (r < I_PB) { const int kt = r / 16, nt = r % 16;
                p0_transpose(p.w_proj_b + (size_t)l * 256 * 1024, 1024, 256, (bf16_t*)(p.ws + WS_WPB) + (size_t)l * 1024 * 256, kt * 64, nt * 64, 0, nullptr, tile); continue; }
            r -= I_PB;
            if (r < I_PC) { const int kt = r / 16, nt = r % 16;
                p0_transpose(p.w_proj_c + (size_t)l * 512 * 1024, 1024, 512, (bf16_t*)(p.ws + WS_WPC) + (size_t)l * 1024 * 512, kt * 64, nt * 64, 0, p.ssm_norm_w + l * 512, tile); continue; }
            r -= I_PC;
            { const int kt = r / 16, nt = r % 16;
                p0_transpose(p.w_out + (size_t)l * 1024 * 1024, 1024, 1024, (bf16_t*)(p.ws + WS_WOUT) + (size_t)l * 1024 * 1024, kt * 64, nt * 64, 0, nullptr, tile); }
        } else if (item < I_T + I_MOD) {
            const int it = item - I_T, l = it / 96, col0 = (it % 96) * 32, cl = tid & 31, ks = tid >> 5;
            float a0 = 0.f, a1 = 0.f, a2 = 0.f, a3 = 0.f;
            const float* wp = p.w_ada + ((size_t)l * 1024 + ks * 128) * 3072 + col0 + cl;
#pragma unroll 8
            for (int k = 0; k < 128; ++k) {
                const float wv = wp[(size_t)k * 3072]; const int kk = ks * 128 + k;
                a0 += siluf(p.c[kk]) * wv; a1 += siluf(p.c[1024 + kk]) * wv; a2 += siluf(p.c[2048 + kk]) * wv; a3 += siluf(p.c[3072 + kk]) * wv;
            }
            float* red = (float*)smem;
            red[(ks * 32 + cl) * 4 + 0] = a0; red[(ks * 32 + cl) * 4 + 1] = a1; red[(ks * 32 + cl) * 4 + 2] = a2; red[(ks * 32 + cl) * 4 + 3] = a3;
            __syncthreads();
            if (tid < 128) { const int b = tid >> 5, c2 = tid & 31; float s = 0.f;
#pragma unroll
                for (int k = 0; k < 8; ++k) s += red[(k * 32 + c2) * 4 + b];
                ((float*)(p.ws + WS_MOD))[(l * 4 + b) * 3072 + col0 + c2] = s + p.b_ada[l * 3072 + col0 + c2]; }
            __syncthreads();
        } else {
            float* rc = (float*)(p.ws + WS_ROPE); float* rs = rc + 128 * 16;
            for (int e = tid; e < 2048; e += 256) {
                const int pos = e >> 4, i = e & 15;
                const float freq = powf(10000.0f, -(float)i / 16.0f);
                const float ang = (float)pos * freq;
                const double rev = (double)ang * 0.15915494309189535; const double fr = rev - rint(rev);
                const float a = (float)(fr * 6.283185307179586);
                rc[e] = cosf(a); rs[e] = sinf(a);
            }
            if (tid < 2) {
                const int l = tid; float mqa = 0.f, mka = 0.f, mqb = 0.f, mkb = 0.f, mb = 0.f;
                for (int i = 0; i < 64; ++i) { mqa = fmaxf(mqa, fabsf(p.q_norm_a[l * 64 + i])); mka = fmaxf(mka, fabsf(p.k_norm_a[l * 64 + i]));
                    mqb = fmaxf(mqb, fabsf(p.q_norm_b[l * 64 + i])); mkb = fmaxf(mkb, fabsf(p.k_norm_b[l * 64 + i])); }
                for (int i = 0; i < 32 * 12; ++i) mb = fmaxf(mb, p.rel_bias[i]);
                float* bd = (float*)(p.ws + WS_BND);
                bd[l] = 8.f * mqa * mka * LOG2E; bd[2 + l] = (8.f * mqb * mkb + mb) * LOG2E;
            }
        }
    }
}

__device__ void norm_phase(const Params& p, int l, int hb, const float* xsrc) {
    int tx_ = threadIdx.x; asm volatile("" : "+v"(tx_));
    const int lane = tx_ & 63, gw = blockIdx.x * 8 + (tx_ >> 6), nw = gridDim.x * 8;
    bf16_t* H = (bf16_t*)(p.ws + WS_H);
    const float* nwp = p.norm_w + l * 1024;
    for (int row = gw; row < TP; row += nw) {
        const size_t rg = (size_t)hb * TP + row; const int b = (int)(rg / SEQ);
        const f32x4* xr = (const f32x4*)(xsrc + rg * 1024);
        const float* md = (const float*)(p.ws + WS_MOD) + (size_t)(l * 4 + b) * 3072;
        f32x4 v[4]; float ss = 0.f;
#pragma unroll
        for (int j = 0; j < 4; ++j) { v[j] = xr[lane + 64 * j]; ss += v[j].x * v[j].x + v[j].y * v[j].y + v[j].z * v[j].z + v[j].w * v[j].w; }
        ss = wave_sum(ss); const float rstd = rsqrtf(ss * (1.f / 1024.f) + EPS);
#pragma unroll
        for (int j = 0; j < 4; ++j) {
            const int col = 4 * (lane + 64 * j);
            const f32x4 w4 = *(const f32x4*)(nwp + col), sh = *(const f32x4*)(md + col), sc = *(const f32x4*)(md + 1024 + col);
            const f32x4 o = v[j] * rstd * w4 * (1.f + sc) + sh;
            u32x2 pk; pk.x = pk2(o.x, o.y); pk.y = pk2(o.z, o.w);
            *(u32x2*)(H + (size_t)row * 1024 + col) = pk;
        }
    }
}

constexpr int G_STAGE = 65536, G_AB = 32768;
__device__ __forceinline__ void gemm_core(const bf16_t* __restrict__ A, int lda, const bf16_t* __restrict__ Bt, int ldb, int K, f32x4 (&acc)[8][4], unsigned char* smem, int tid) {
    asm volatile("" : "+v"(tid));
    const int lane = tid & 63, w = __builtin_amdgcn_readfirstlane(tid >> 6), wm = w >> 2, wn = w & 3, idx = lane & 15, kq = lane >> 4;
    unsigned offA[4], offB[4];
#pragma unroll
    for (int j = 0; j < 4; ++j) { const int row = (j * 8 + w) * 8 + (lane >> 3), c = (lane & 7) ^ ((row >> 1) & 7);
        offA[j] = (unsigned)(row * lda + c * 8) * 2u; offB[j] = (unsigned)(row * ldb + c * 8) * 2u; }
#pragma unroll
    for (int mi = 0; mi < 8; ++mi)
#pragma unroll
        for (int ni = 0; ni < 4; ++ni) acc[mi][ni] = (f32x4){0.f, 0.f, 0.f, 0.f};
    LDSAS unsigned char* lds = (LDSAS unsigned char*)smem;
#define G_ISSUE1(kt, st, j) do { \
        __builtin_amdgcn_global_load_lds((const unsigned*)((const char*)A + offA[j] + (kt) * 128), (LDSAS unsigned*)(lds + (st) * G_STAGE + ((j) * 8 + w) * 1024), 16, 0, 0); \
        __builtin_amdgcn_global_load_lds((const unsigned*)((const char*)Bt + offB[j] + (kt) * 128), (LDSAS unsigned*)(lds + (st) * G_STAGE + G_AB + ((j) * 8 + w) * 1024), 16, 0, 0); } while (0)
#define G_ISSUE(kt, st) do { G_ISSUE1(kt, st, 0); G_ISSUE1(kt, st, 1); G_ISSUE1(kt, st, 2); G_ISSUE1(kt, st, 3); } while (0)
    const int nk = K >> 6;
    G_ISSUE(0, 0);
    asm volatile("s_waitcnt vmcnt(0)" ::: "memory");
    __syncthreads();
    const int swz = (idx >> 1) & 7;
    const int aoff = (wm * 128 + idx) * 128, boff = G_AB + (wn * 64 + idx) * 128;
    for (int kt = 0; kt < nk; ++kt) {
        const int st = kt & 1;
        const bool more = kt + 1 < nk;
        const unsigned char* sb = smem + st * G_STAGE;
#pragma unroll
        for (int ks = 0; ks < 2; ++ks) {
            bf16x8 bfr[4], af[8];
            const int co = ((ks * 4 + kq) ^ swz) * 16;
#pragma unroll
            for (int ni = 0; ni < 4; ++ni) bfr[ni] = *(const bf16x8*)(sb + boff + ni * 2048 + co);
#pragma unroll
            for (int mi = 0; mi < 8; ++mi) af[mi] = *(const bf16x8*)(sb + aoff + mi * 2048 + co);
            if (more) { G_ISSUE1(kt + 1, st ^ 1, ks * 2); G_ISSUE1(kt + 1, st ^ 1, ks * 2 + 1); }
            __builtin_amdgcn_sched_barrier(0);
            __builtin_amdgcn_s_setprio(1);
#pragma unroll
            for (int mi = 0; mi < 8; ++mi)
#pragma unroll
                for (int ni = 0; ni < 4; ++ni) acc[mi][ni] = __builtin_amdgcn_mfma_f32_16x16x32_bf16(bfr[ni], af[mi], acc[mi][ni], 0, 0, 0);
            __builtin_amdgcn_s_setprio(0);
            __builtin_amdgcn_sched_barrier(0);
        }
        asm volatile("s_waitcnt vmcnt(0)" ::: "memory");
        __syncthreads();
    }
#undef G_ISSUE1
#undef G_ISSUE
}

__device__ __forceinline__ void st4bf(bf16_t* dst, f32x4 v) { u32x2 pk; pk.x = pk2(v.x, v.y); pk.y = pk2(v.z, v.w); *(u32x2*)dst = pk; }

__device__ void gemm1_phase(const Params& p, int l, int hb, unsigned char* smem) {
    const bf16_t* H = (const bf16_t*)(p.ws + WS_H);
    const bf16_t* Wt = (const bf16_t*)(p.ws + WS_WIN) + (size_t)l * NP * 1024;
    const float* ropec = (const float*)(p.ws + WS_ROPE); const float* ropes = ropec + 2048;
    constexpr int NT = 34, NTILES = 64 * NT, GRP = 8 * NT;
    for (int t = blockIdx.x; t < NTILES; t += gridDim.x) {
        const int grp = t / GRP, r = t % GRP, jx = NT * (r & 7) + (r >> 3), mt = grp * 8 + (jx & 7), nt = jx >> 3;
        const int m0 = mt * 256, n0 = nt * 256;
        f32x4 acc[8][4];
        int tid = threadIdx.x;
        gemm_core(H + (size_t)m0 * 1024, 1024, Wt + (size_t)n0 * 1024, 1024, 1024, acc, smem, tid);
        asm volatile("" : "+v"(tid));
        const int lane = tid & 63, w = tid >> 6, wm = w >> 2, wn = w & 3, idx = lane & 15, kq = lane >> 4;
        const int cw = n0 + wn * 64;
        const int lc = 4 * kq;
        if (cw < 768 && (cw < 640)) {
            const bool isq = cw < 512;
            const float* nwp = (isq ? p.q_norm_a : p.k_norm_a) + l * 64;
            bf16_t* dst = isq ? (bf16_t*)(p.ws + WS_QA) : (bf16_t*)(p.ws + WS_KA);
            const int pitch = isq ? 512 : 128, c0 = isq ? cw : cw - 512;
            const float qs = isq ? 0.125f * LOG2E : 1.f;
#pragma unroll
            for (int mi = 0; mi < 8; ++mi) {
                const int row = m0 + wm * 128 + mi * 16 + idx;
                float ss = 0.f;
#pragma unroll
                for (int ni = 0; ni < 4; ++ni) { const f32x4 v = acc[mi][ni]; ss += v.x * v.x + v.y * v.y + v.z * v.z + v.w * v.w; }
                ss += __shfl_xor(ss, 16); ss += __shfl_xor(ss, 32);
                const float rstd = rsqrtf(ss * (1.f / 64.f) + EPS);
                f32x4 y[4];
#pragma unroll
                for (int ni = 0; ni < 4; ++ni) y[ni] = acc[mi][ni] * rstd * *(const f32x4*)(nwp + ni * 16 + lc);
                const int tt = row & (SEQ - 1), prow = tt >> 6, pcol = tt & 63;
#pragma unroll
                for (int hf = 0; hf < 2; ++hf) {
                    const int pos = hf ? pcol : prow;
                    const f32x4 cs = *(const f32x4*)(ropec + pos * 16 + lc), sn = *(const f32x4*)(ropes + pos * 16 + lc);
                    const f32x4 a = y[2 * hf], b = y[2 * hf + 1];
                    y[2 * hf] = a * cs - b * sn; y[2 * hf + 1] = b * cs + a * sn;
                }
#pragma unroll
                for (int ni = 0; ni < 4; ++ni) st4bf(dst + (size_t)row * pitch + c0 + ni * 16 + lc, y[ni] * qs);
            }
        } else if (cw >= 1280 && cw < 2816) {
            const bool isq = cw < 2048;
            const float* nwp = (isq ? p.q_norm_b : p.k_norm_b) + l * 64;
            const int gc = isq ? cw - 1280 : cw - 2048, g = gc >> 8, c0 = gc & 255;
            const int sh = 2 * g;
            bf16_t* dst = (bf16_t*)(p.ws + (isq ? WS_QB : WS_KB));
            const float qs = isq ? 0.125f * LOG2E : 1.f;
#pragma unroll
            for (int mi = 0; mi < 8; ++mi) {
                const int row = m0 + wm * 128 + mi * 16 + idx;
                float ss = 0.f;
#pragma unroll
                for (int ni = 0; ni < 4; ++ni) { const f32x4 v = acc[mi][ni]; ss += v.x * v.x + v.y * v.y + v.z * v.z + v.w * v.w; }
                ss += __shfl_xor(ss, 16); ss += __shfl_xor(ss, 32);
                const float rstd = rsqrtf(ss * (1.f / 64.f) + EPS) * qs;
                const int bl = row >> 13, tt = row & (SEQ - 1);
                const int pp = (tt & ((1 << sh) - 1)) * (SEQ >> sh) + (tt >> sh);
                bf16_t* drow = dst + ((size_t)(bl * 3 + g) * SEQ + pp) * 256 + c0 + lc;
#pragma unroll
                for (int ni = 0; ni < 4; ++ni) st4bf(drow + ni * 16, acc[mi][ni] * rstd * *(const f32x4*)(nwp + ni * 16 + lc));
            }
        } else if (cw >= 2816 && cw < 3584) {
            const int gc = cw - 2816, g = gc >> 8, c0 = gc & 255, sh = 2 * g;
            bf16_t* dst = (bf16_t*)(p.ws + WS_VB);
#pragma unroll
            for (int mi = 0; mi < 8; ++mi) {
                const int row = m0 + wm * 128 + mi * 16 + idx;
                const int bl = row >> 13, tt = row & (SEQ - 1);
                const int pp = (tt & ((1 << sh) - 1)) * (SEQ >> sh) + (tt >> sh);
                bf16_t* drow = dst + ((size_t)(bl * 3 + g) * SEQ + pp) * 256 + c0 + lc;
#pragma unroll
                for (int ni = 0; ni < 4; ++ni) st4bf(drow + ni * 16, acc[mi][ni]);
            }
        } else if (cw >= 8448) {
            if (cw == 8448) {
                float* dst = (float*)(p.ws + WS_DT);
                const f32x4 bias = *(const f32x4*)(p.dt_bias + l * 16 + lc);
#pragma unroll
                for (int mi = 0; mi < 8; ++mi) {
                    const int row = m0 + wm * 128 + mi * 16 + idx;
                    f32x4 v = acc[mi][0] + bias, o;
                    o.x = v.x > 20.f ? v.x : log1pf(__expf(v.x)); o.y = v.y > 20.f ? v.y : log1pf(__expf(v.y));
                    o.z = v.z > 20.f ? v.z : log1pf(__expf(v.z)); o.w = v.w > 20.f ? v.w : log1pf(__expf(v.w));
                    *(f32x4*)(dst + (size_t)row * 16 + lc) = o;
                }
            }
        } else {
            bf16_t* dst; int pitch, c0, mode;
            if (cw < 768) { dst = (bf16_t*)(p.ws + WS_VA); pitch = 128; c0 = cw - 640; mode = 0; }
            else if (cw < 1280) { dst = (bf16_t*)(p.ws + WS_GA); pitch = 512; c0 = cw - 768; mode = 1; }
            else if (cw < 3840) { dst = (bf16_t*)(p.ws + WS_GB); pitch = 256; c0 = cw - 3584; mode = 1; }
            else if (cw < 4864) { dst = (bf16_t*)(p.ws + WS_XBC); pitch = 1024; c0 = cw - 3840; mode = 0; }
            else if (cw < 5376) { dst = (bf16_t*)(p.ws + WS_ZS); pitch = 512; c0 = cw - 4864; mode = 1; }
            else { dst = (bf16_t*)(p.ws + WS_MG); pitch = 3072; c0 = cw - 5376; mode = 2; }
            const float* bg = p.b_gate + l * 3072 + c0 + lc;
#pragma unroll
            for (int mi = 0; mi < 8; ++mi) {
                const int row = m0 + wm * 128 + mi * 16 + idx;
#pragma unroll
                for (int ni = 0; ni < 4; ++ni) {
                    f32x4 v = acc[mi][ni];
                    if (mode == 1) { v.x = siluf(v.x); v.y = siluf(v.y); v.z = siluf(v.z); v.w = siluf(v.w); }
                    else if (mode == 2) { const f32x4 bb = *(const f32x4*)(bg + ni * 16); v.x = sigmf(v.x + bb.x); v.y = sigmf(v.y + bb.y); v.z = sigmf(v.z + bb.z); v.w = sigmf(v.w + bb.w); }
                    st4bf(dst + (size_t)row * pitch + c0 + ni * 16 + lc, v);
                }
            }
        }
    }
}

__device__ void merge_phase(const Params& p, int l, unsigned char* smem) {
    const bf16_t* MG = (const bf16_t*)(p.ws + WS_MG);
    const float* rstd = (const float*)(p.ws + WS_RSTD);
    bf16_t* MR = (bf16_t*)(p.ws + WS_MRG);
    for (int t = blockIdx.x; t < 64 * 4; t += gridDim.x) {
        const int xq = t >> 3, mt = (xq >> 2) * 8 + (t & 7), nt = xq & 3, m0 = mt * 256, n0 = nt * 256;
#pragma unroll 1
        for (int br = 0; br < 3; ++br) {
            f32x4 acc[8][4];
            const bf16_t* A; const bf16_t* Bt; int K;
            if (br == 0) { A = (const bf16_t*)(p.ws + WS_QA); K = 512; Bt = (const bf16_t*)(p.ws + WS_WPA) + (size_t)l * 1024 * 512; }
            else if (br == 1) { A = (const bf16_t*)(p.ws + WS_YBM); K = 256; Bt = (const bf16_t*)(p.ws + WS_WPB) + (size_t)l * 1024 * 256; }
            else { A = (const bf16_t*)(p.ws + WS_YC); K = 512; Bt = (const bf16_t*)(p.ws + WS_WPC) + (size_t)l * 1024 * 512; }
            int tid = threadIdx.x;
            gemm_core(A + (size_t)m0 * K, K, Bt + (size_t)n0 * K, K, K, acc, smem, tid);
            asm volatile("" : "+v"(tid));
            const int lane = tid & 63, w = tid >> 6, wm = w >> 2, wn = w & 3, idx = lane & 15, kq = lane >> 4;
#pragma unroll
            for (int mi = 0; mi < 8; ++mi) {
                const int row = m0 + wm * 128 + mi * 16 + idx;
                const float rs = (br == 2) ? rstd[row] : 1.f;
#pragma unroll
                for (int ni = 0; ni < 4; ++ni) {
                    const int col = n0 + wn * 64 + ni * 16 + 4 * kq;
                    const u32x2 g = *(const u32x2*)(MG + (size_t)row * 3072 + br * 1024 + col);
                    f32x4 gv; gv.x = bflo(g.x); gv.y = bfhi(g.x); gv.z = bflo(g.y); gv.w = bfhi(g.y);
                    f32x4 v = gv * rs * acc[mi][ni];
                    bf16_t* mp = MR + (size_t)row * 1024 + col;
                    if (br > 0) { const u32x2 o = *(const u32x2*)mp; v.x += bflo(o.x); v.y += bfhi(o.x); v.z += bflo(o.y); v.w += bfhi(o.y); }
                    st4bf(mp, v);
                }
            }
        }
    }
}

__device__ void out_phase(const Params& p, int l, int hb, const float* xsrc, unsigned char* smem) {
    const bf16_t* MR = (const bf16_t*)(p.ws + WS_MRG);
    const bf16_t* Wt = (const bf16_t*)(p.ws + WS_WOUT) + (size_t)l * 1024 * 1024;
    for (int t = blockIdx.x; t < 64 * 4; t += gridDim.x) {
        const int xq = t >> 3, mt = (xq >> 2) * 8 + (t & 7), nt = xq & 3, m0 = mt * 256, n0 = nt * 256;
        f32x4 acc[8][4];
        int tid = threadIdx.x;
        gemm_core(MR + (size_t)m0 * 1024, 1024, Wt + (size_t)n0 * 1024, 1024, 1024, acc, smem, tid);
        asm volatile("" : "+v"(tid));
        const int lane = tid & 63, w = tid >> 6, wm = w >> 2, wn = w & 3, idx = lane & 15, kq = lane >> 4;
#pragma unroll
        for (int mi = 0; mi < 8; ++mi) {
            const int row = m0 + wm * 128 + mi * 16 + idx; const size_t rg = (size_t)hb * TP + row; const int b = (int)(rg / SEQ);
            const float* gate = (const float*)(p.ws + WS_MOD) + (size_t)(l * 4 + b) * 3072 + 2048;
#pragma unroll
            for (int ni = 0; ni < 4; ++ni) {
                const int col = n0 + wn * 64 + ni * 16 + 4 * kq;
                const f32x4 xv = *(const f32x4*)(xsrc + rg * 1024 + col), gv = *(const f32x4*)(gate + col);
                *(f32x4*)(p.out + rg * 1024 + col) = xv + gv * acc[mi][ni];
            }
        }
    }
}

constexpr int AT_KS = 0, AT_VS = 9216, AT_LQ = 9216 + 8192, AT_LUT = AT_LQ + 512;

#define AT_STAGE_STORE() do { _Pragma("unroll") for (int i = 0; i < 2; ++i) { const int c = tid + 256 * i, row = c >> 3, ch = c & 7; \
        *(u32x4*)(Ks + row * 72 + ch * 8) = rk[i]; *(u32x4*)(Vs + (ch >> 2) * 4096 + row * 64 + (ch & 3) * 16) = rv[i]; } } while (0)

__device__ __forceinline__ void at_qk(f32x16& p0, f32x16& p1, const bf16_t* Ks, const bf16x8* qr, int r32, int hi) {
    bf16x8 kf[8];
#pragma unroll
    for (int ds = 0; ds < 4; ++ds) {
        kf[2 * ds] = *(const bf16x8*)(Ks + r32 * 72 + ds * 16 + hi * 8);
        kf[2 * ds + 1] = *(const bf16x8*)(Ks + (r32 + 32) * 72 + ds * 16 + hi * 8);
    }
    __builtin_amdgcn_sched_barrier(0);
    __builtin_amdgcn_s_setprio(1);
#pragma unroll
    for (int ds = 0; ds < 4; ++ds) {
        p0 = __builtin_amdgcn_mfma_f32_32x32x16_bf16(kf[2 * ds], qr[ds], p0, 0, 0, 0);
        p1 = __builtin_amdgcn_mfma_f32_32x32x16_bf16(kf[2 * ds + 1], qr[ds], p1, 0, 0, 0);
    }
    __builtin_amdgcn_s_setprio(0);
    __builtin_amdgcn_sched_barrier(0);
}
__device__ __forceinline__ void at_pv(f32x16& o0, f32x16& o1, const f32x16& p0, const f32x16& p1, const unsigned char* Vs, int lane) {
    const int hi = lane >> 5;
    const unsigned char* vb = Vs + ((lane >> 4) & 1) * 32 + (lane & 3) * 8 + (4 * hi + ((lane & 15) >> 2)) * 64;
    bf16x8 v0[4], v1[4], pa[4];
#pragma unroll
    for (int s = 0; s < 4; ++s) {
        v0[s] = cat8(tr16(vb + s * 1024), tr16(vb + s * 1024 + 512));
        v1[s] = cat8(tr16(vb + 4096 + s * 1024), tr16(vb + 4096 + s * 1024 + 512));
    }
#pragma unroll
    for (int s = 0; s < 4; ++s) {
        u32x4 pw;
        if (s < 2) { pw.x = pk2(p0[8 * s + 0], p0[8 * s + 1]); pw.y = pk2(p0[8 * s + 2], p0[8 * s + 3]); pw.z = pk2(p0[8 * s + 4], p0[8 * s + 5]); pw.w = pk2(p0[8 * s + 6], p0[8 * s + 7]); }
        else { const int q = s - 2; pw.x = pk2(p1[8 * q + 0], p1[8 * q + 1]); pw.y = pk2(p1[8 * q + 2], p1[8 * q + 3]); pw.z = pk2(p1[8 * q + 4], p1[8 * q + 5]); pw.w = pk2(p1[8 * q + 6], p1[8 * q + 7]); }
        pa[s] = __builtin_bit_cast(bf16x8, pw);
    }
    __builtin_amdgcn_sched_barrier(0);
    __builtin_amdgcn_s_setprio(1);
#pragma unroll
    for (int s = 0; s < 4; ++s) {
        o0 = __builtin_amdgcn_mfma_f32_32x32x16_bf16(pa[s], v0[s], o0, 0, 0, 0);
        o1 = __builtin_amdgcn_mfma_f32_32x32x16_bf16(pa[s], v1[s], o1, 0, 0, 0);
    }
    __builtin_amdgcn_s_setprio(0);
    __builtin_amdgcn_sched_barrier(0);
}

constexpr int ATA_STAGE = 17408, ATA_LQ = 2 * ATA_STAGE;
__device__ void attn_a_item(const Params& p, int item, int l, unsigned char* smem) {
    int tid_ = VTID; asm volatile("" : "+v"(tid_));
    const int tid = tid_, lane = tid & 63, w = tid >> 6, r32 = lane & 31, hi = lane >> 5;
    const int b = item >> 9, r = item & 511, kvh = r >> 8, qblk = (r >> 2) & 63, hq = kvh * 4 + (r & 3);
    float* lq = (float*)(smem + ATA_LQ) + w * 32;
    bf16_t* QA = (bf16_t*)(p.ws + WS_QA);
    const bf16_t* GA = (const bf16_t*)(p.ws + WS_GA);
    const size_t tokq = (size_t)b * SEQ + qblk * 128 + w * 32;
    bf16x8 qr[4];
#pragma unroll
    for (int ds = 0; ds < 4; ++ds) qr[ds] = *(const bf16x8*)(QA + (tokq + r32) * 512 + hq * 64 + ds * 16 + hi * 8);
    const bf16_t* Kb = (const bf16_t*)(p.ws + WS_KA) + (size_t)b * SEQ * 128 + kvh * 64;
    const bf16_t* Vb = (const bf16_t*)(p.ws + WS_VA) + (size_t)b * SEQ * 128 + kvh * 64;
    const float nshift = -((const float*)(p.ws + WS_BND))[l];
    f32x16 o0, o1;
#pragma unroll
    for (int i = 0; i < 16; ++i) { o0[i] = 0.f; o1[i] = 0.f; }
    float lacc = 0.f;
    constexpr int NT = SEQ / 64;
    const int row0 = tid >> 3, ch0 = tid & 7;
    const size_t goff0 = (size_t)row0 * 128 + ch0 * 8, goff1 = goff0 + (size_t)32 * 128;
    const int ko0 = row0 * 144 + ch0 * 16, ko1 = ko0 + 32 * 144;
    const int vo0 = 9216 + (ch0 >> 2) * 4096 + row0 * 64 + (ch0 & 3) * 16, vo1 = vo0 + 32 * 64;
    u32x4 rkA[2], rvA[2], rkB[2], rvB[2];
#define ATA_LOAD(RK, RV, t) do { const size_t tb = (size_t)(t) * 64 * 128; RK[0] = *(const u32x4*)(Kb + tb + goff0); RK[1] = *(const u32x4*)(Kb + tb + goff1); \
        RV[0] = *(const u32x4*)(Vb + tb + goff0); RV[1] = *(const u32x4*)(Vb + tb + goff1); } while (0)
#define ATA_STORE(RK, RV, st) do { unsigned char* sb_ = smem + (st) * ATA_STAGE; *(u32x4*)(sb_ + ko0) = RK[0]; *(u32x4*)(sb_ + ko1) = RK[1]; \
        *(u32x4*)(sb_ + vo0) = RV[0]; *(u32x4*)(sb_ + vo1) = RV[1]; } while (0)
#define ATA_COMPUTE(st) do { const unsigned char* sb_ = smem + (st) * ATA_STAGE; f32x16 p0, p1; \
        _Pragma("unroll") for (int i = 0; i < 16; ++i) { p0[i] = nshift; p1[i] = nshift; } \
        at_qk(p0, p1, (const bf16_t*)sb_, qr, r32, hi); \
        _Pragma("unroll") for (int i = 0; i < 16; ++i) { p0[i] = __builtin_amdgcn_exp2f(p0[i]); p1[i] = __builtin_amdgcn_exp2f(p1[i]); lacc += p0[i] + p1[i]; } \
        at_pv(o0, o1, p0, p1, sb_ + 9216, lane); } while (0)
    __syncthreads();
    ATA_LOAD(rkA, rvA, 0); ATA_LOAD(rkB, rvB, 1);
    ATA_STORE(rkA, rvA, 0);
    ATA_LOAD(rkA, rvA, 2);
    __syncthreads();
    for (int kt = 0; kt < NT; kt += 2) {
        ATA_COMPUTE(0);
        ATA_STORE(rkB, rvB, 1);
        if (kt + 3 < NT) ATA_LOAD(rkB, rvB, kt + 3);
        __syncthreads();
        ATA_COMPUTE(1);
        if (kt + 2 < NT) { ATA_STORE(rkA, rvA, 0); if (kt + 4 < NT) ATA_LOAD(rkA, rvA, kt + 4); }
        __syncthreads();
    }
#undef ATA_LOAD
#undef ATA_STORE
#undef ATA_COMPUTE
    lacc += __shfl_xor(lacc, 32);
    if (hi == 0) lq[r32] = lacc;
    asm volatile("s_waitcnt lgkmcnt(0)" ::: "memory");
#pragma unroll
    for (int rr = 0; rr < 16; ++rr) {
        const int q = crow(rr, hi); const float inv = 1.f / lq[q];
        const size_t off = (tokq + q) * 512 + hq * 64 + r32;
        const float g0 = bf2f(GA[off]), g1 = bf2f(GA[off + 32]);
        QA[off] = (bf16_t)(pk2(o0[rr] * inv * g0, 0.f) & 0xffffu);
        QA[off + 32] = (bf16_t)(pk2(o1[rr] * inv * g1, 0.f) & 0xffffu);
    }
}

__device__ void attn_b_item(const Params& p, int item, int l, unsigned char* smem) {
    int tid_ = VTID; asm volatile("" : "+v"(tid_));
    const int tid = tid_, lane = tid & 63, w = tid >> 6, r32 = lane & 31, hi = lane >> 5;
    const int blk = item & 63, j = (item >> 6) & 3, bg = item >> 8, g = bg % 3, b = bg / 3;
    const int sh = 2 * g, dil = 1 << sh, Mlen = SEQ >> sh;
    bf16_t* Ks = (bf16_t*)(smem + AT_KS); unsigned char* Vs = smem + AT_VS; float* lq = (float*)(smem + AT_LQ) + w * 32; float* lut = (float*)(smem + AT_LUT);
    bf16_t* QB = (bf16_t*)(p.ws + WS_QB) + (size_t)bg * SEQ * 256 + j * 64;
    const bf16_t* KB = (const bf16_t*)(p.ws + WS_KB) + (size_t)bg * SEQ * 256 + j * 64;
    const bf16_t* VB = (const bf16_t*)(p.ws + WS_VB) + (size_t)bg * SEQ * 256 + j * 64;
    float* LSE = (float*)(p.ws + WS_LSE) + (size_t)bg * SEQ * 4 + j;
    const int p0r = blk * 128, seq_lo = (p0r / Mlen) * Mlen, seq_hi = seq_lo + Mlen;
    __syncthreads();
    if (tid < 129) {
        const int rel = tid - 64, n = (rel < 0 ? -rel : rel) * dil;
        int bk;
        if (n < 8) bk = n; else { bk = 8 + (n >= 15) + (n >= 27) + (n >= 50) + (n >= 91) + (n >= 166) + (n >= 305) + (n >= 559); }
        if (rel > 0) bk += 16;
        lut[tid] = p.rel_bias[bk * 12 + g * 4 + j] * LOG2E;
    }
    const int qpos = p0r + w * 32 + r32;
    bf16x8 qr[4];
#pragma unroll
    for (int ds = 0; ds < 4; ++ds) qr[ds] = *(const bf16x8*)(QB + (size_t)qpos * 256 + ds * 16 + hi * 8);
    const float nshift = -((const float*)(p.ws + WS_BND))[2 + l];
    f32x16 o0, o1;
#pragma unroll
    for (int i = 0; i < 16; ++i) { o0[i] = 0.f; o1[i] = 0.f; }
    float lacc = 0.f;
    u32x4 rk[2], rv[2];
    for (int kt = 0; kt < 4; ++kt) {
        const int kbase = p0r - 64 + 64 * kt;
#pragma unroll
        for (int i = 0; i < 2; ++i) { const int c = tid + 256 * i, row = c >> 3, ch = c & 7;
            int pr = kbase + row; pr = pr < 0 ? 0 : (pr > SEQ - 1 ? SEQ - 1 : pr);
            rk[i] = *(const u32x4*)(KB + (size_t)pr * 256 + ch * 8); rv[i] = *(const u32x4*)(VB + (size_t)pr * 256 + ch * 8); }
        __syncthreads();
        AT_STAGE_STORE();
        __syncthreads();
        f32x16 p0, p1;
#pragma unroll
        for (int i = 0; i < 16; ++i) { p0[i] = nshift; p1[i] = nshift; }
        at_qk(p0, p1, Ks, qr, r32, hi);
#pragma unroll
        for (int i = 0; i < 16; ++i) {
            const int kv0 = kbase + crow(i, hi), kv1 = kv0 + 32;
            const int rel0 = kv0 - qpos, rel1 = kv1 - qpos;
            const bool ok0 = rel0 >= -64 && rel0 <= 64 && kv0 >= seq_lo && kv0 < seq_hi;
            const bool ok1 = rel1 >= -64 && rel1 <= 64 && kv1 >= seq_lo && kv1 < seq_hi;
            const float e0 = __builtin_amdgcn_exp2f(p0[i] + lut[ok0 ? rel0 + 64 : 64]);
            const float e1 = __builtin_amdgcn_exp2f(p1[i] + lut[ok1 ? rel1 + 64 : 64]);
            p0[i] = ok0 ? e0 : 0.f; p1[i] = ok1 ? e1 : 0.f; lacc += p0[i] + p1[i];
        }
        at_pv(o0, o1, p0, p1, Vs, lane);
    }
    lacc += __shfl_xor(lacc, 32);
    if (hi == 0) { lq[r32] = lacc; LSE[(size_t)qpos * 4] = (-nshift + log2f(lacc)) * LN2; }
    asm volatile("s_waitcnt lgkmcnt(0)" ::: "memory");
#pragma unroll
    for (int rr = 0; rr < 16; ++rr) {
        const int q = crow(rr, hi); const float inv = 1.f / lq[q];
        const size_t off = (size_t)(p0r + w * 32 + q) * 256 + r32;
        QB[off] = (bf16_t)(pk2(o0[rr] * inv, 0.f) & 0xffffu);
        QB[off + 32] = (bf16_t)(pk2(o1[rr] * inv, 0.f) & 0xffffu);
    }
}

constexpr int SS_BS = 0, SS_CS = 8704, SS_XS = 17408, SS_XWS = 22016, SS_GS = 26624, SS_SB = 29184, SS_CW = 46592, SS_SC = 54272, SS_DTA = 55296, SS_END = 57344;

template <int PASS>
__device__ void ssd_item(const Params& p, int item, int l, unsigned char* smem) {
    int tid_ = VTID; asm volatile("" : "+v"(tid_));
    const int tid = tid_, lane = tid & 63, w = tid >> 6, idx = lane & 15, kq = lane >> 4;
    const int seg = item & 15, h = (item >> 4) & 7, dir = (item >> 7) & 1, b = item >> 8, grp = h >> 2;
    bf16_t* Bs = (bf16_t*)(smem + SS_BS); bf16_t* Cs = (bf16_t*)(smem + SS_CS); bf16_t* Xs = (bf16_t*)(smem + SS_XS); bf16_t* Xws = (bf16_t*)(smem + SS_XWS);
    bf16_t* Gs = (bf16_t*)(smem + SS_GS); bf16_t* Sb = (bf16_t*)(smem + SS_SB); float* cwl = (float*)(smem + SS_CW); float* sc = (float*)(smem + SS_SC);
    float* s_dt = sc, *s_c = sc + 32, *s_rs = sc + 64, *s_wl = sc + 96, *s_tot = sc + 128;
    const bf16_t* XBC = (const bf16_t*)(p.ws + WS_XBC);
    const float* DT = (const float*)(p.ws + WS_DT);
    float* ST = (float*)(p.ws + WS_ST); float* SEGT = (float*)(p.ws + WS_SEGT);
    bf16_t* Y = (bf16_t*)(p.ws + (dir ? WS_YS : WS_YF));
    const float Aneg = -__expf(p.a_log[l * 16 + dir * 8 + h]);
    const float Dh = p.d_skip[l * 8 + h];
    __syncthreads();
    for (int e = tid; e < 6 * 320; e += 256) {
        const int tap = e / 320, lc = e % 320;
        const int ch = lc < 64 ? h * 64 + lc : (lc < 192 ? 512 + grp * 128 + (lc - 64) : 768 + grp * 128 + (lc - 192));
        cwl[e] = tap < 5 ? p.conv_w[(size_t)l * 5 * 1024 + tap * 1024 + ch] : p.conv_b[l * 1024 + ch];
    }
    f32x4 S[8];
#pragma unroll
    for (int nt = 0; nt < 8; ++nt) S[nt] = (f32x4){0.f, 0.f, 0.f, 0.f};
    const int ibase = item & ~15;
    if (PASS == 3) {
        if (dir == 0) {
            for (int e = 0; e < seg; ++e) { const float dc = __expf(SEGT[ibase + e]); const f32x4* src = (const f32x4*)(ST + (size_t)(ibase + e) * 8192);
#pragma unroll
                for (int nt = 0; nt < 8; ++nt) S[nt] = S[nt] * dc + src[(w * 8 + nt) * 64 + lane]; }
        } else {
            for (int e = NSEG - 1; e > seg; --e) { const float dc = __expf(SEGT[ibase + e]); const f32x4* src = (const f32x4*)(ST + (size_t)(ibase + e) * 8192);
#pragma unroll
                for (int nt = 0; nt < 8; ++nt) S[nt] = S[nt] * dc + src[(w * 8 + nt) * 64 + lane]; }
        }
#pragma unroll
        for (int nt = 0; nt < 8; ++nt) st4bf(Sb + (16 * w + idx) * 136 + 16 * nt + 4 * kq, S[nt]);
    }
    float* s_dta = (float*)(smem + SS_DTA);
    for (int e = tid; e < SEGLEN; e += 256) s_dta[e] = DT[((size_t)b * SEQ + seg * SEGLEN + e) * 16 + dir * 8 + h];
    float segtot = 0.f;
    const int ci0 = tid % 40, tg0 = tid / 40, ci1 = (tid + 64) % 40, tg1 = (tid + 64) / 40;
    const int sc0 = ci0 < 8 ? h * 64 + ci0 * 8 : (ci0 < 24 ? 512 + grp * 128 + (ci0 * 8 - 64) : 768 + grp * 128 + (ci0 * 8 - 192));
    const int sc1 = ci1 < 8 ? h * 64 + ci1 * 8 : (ci1 < 24 ? 512 + grp * 128 + (ci1 * 8 - 64) : 768 + grp * 128 + (ci1 * 8 - 192));
    const bool has1 = tid >= 192;
#define SS_CONV(RAW, CI, TG) do { const int lc_ = (CI) * 8; float ac_[4][8]; \
        { const f32x4 a_ = *(const f32x4*)(cwl + 5 * 320 + lc_), b_ = *(const f32x4*)(cwl + 5 * 320 + lc_ + 4); \
          _Pragma("unroll") for (int l_ = 0; l_ < 4; ++l_) { ac_[l_][0] = a_.x; ac_[l_][1] = a_.y; ac_[l_][2] = a_.z; ac_[l_][3] = a_.w; ac_[l_][4] = b_.x; ac_[l_][5] = b_.y; ac_[l_][6] = b_.z; ac_[l_][7] = b_.w; } } \
        _Pragma("unroll") for (int k_ = 0; k_ < 5; ++k_) { const f32x4 wa_ = *(const f32x4*)(cwl + k_ * 320 + lc_), wb_ = *(const f32x4*)(cwl + k_ * 320 + lc_ + 4); \
            _Pragma("unroll") for (int l_ = 0; l_ < 4; ++l_) { const u32x4 v_ = RAW[l_ + k_]; \
                ac_[l_][0] += bflo(v_.x) * wa_.x; ac_[l_][1] += bfhi(v_.x) * wa_.y; ac_[l_][2] += bflo(v_.y) * wa_.z; ac_[l_][3] += bfhi(v_.y) * wa_.w; \
                ac_[l_][4] += bflo(v_.z) * wb_.x; ac_[l_][5] += bfhi(v_.z) * wb_.y; ac_[l_][6] += bflo(v_.w) * wb_.z; ac_[l_][7] += bfhi(v_.w) * wb_.w; } \
            asm volatile("" ::: "memory"); } \
        _Pragma("unroll") for (int l_ = 0; l_ < 4; ++l_) { const int lrow_ = 4 * (TG) + l_; float* a_ = ac_[l_]; \
            _Pragma("unroll") for (int e_ = 0; e_ < 8; ++e_) a_[e_] = siluf(a_[e_]); \
            u32x4 o_; o_.x = pk2(a_[0], a_[1]); o_.y = pk2(a_[2], a_[3]); o_.z = pk2(a_[4], a_[5]); o_.w = pk2(a_[6], a_[7]); \
            if ((CI) < 8) { *(u32x4*)(Xs + lrow_ * 72 + lc_) = o_; const float wl_ = s_wl[lrow_]; \
                u32x4 o2_; o2_.x = pk2(a_[0] * wl_, a_[1] * wl_); o2_.y = pk2(a_[2] * wl_, a_[3] * wl_); o2_.z = pk2(a_[4] * wl_, a_[5] * wl_); o2_.w = pk2(a_[6] * wl_, a_[7] * wl_); \
                *(u32x4*)(Xws + lrow_ * 72 + lc_) = o2_; } \
            else if ((CI) < 24) *(u32x4*)(Bs + lrow_ * 136 + (lc_ - 64)) = o_; \
            else *(u32x4*)(Cs + lrow_ * 136 + (lc_ - 192)) = o_; } } while (0)
    const size_t tokb = (size_t)b * SEQ;
    const unsigned char* xb_ = (const unsigned char*)(XBC + tokb * 1024);
    u32x4 raw0[8];
#define SS_LOAD0(T0) do { const unsigned o0_ = (unsigned)((((T0) + 4 * tg0 - 2) * 1024 + sc0) * 2); \
        _Pragma("unroll") for (int r_ = 0; r_ < 8; ++r_) { const int tt0 = (T0) + 4 * tg0 - 2 + r_; raw0[r_] = (u32x4){0u, 0u, 0u, 0u}; \
            if (tt0 >= 0 && tt0 < SEQ) raw0[r_] = *(const u32x4*)(xb_ + (o0_ + (unsigned)(r_ * 2048))); } } while (0)
    for (int si = 0; si < NSUB; ++si) {
        const int scn = dir ? (NSUB - 1 - si) : si;
        const int t0 = seg * SEGLEN + scn * TSUB;
        __syncthreads();
        SS_LOAD0(t0);
        if (w == 0) {
            float dtv = 0.f, av = 0.f;
            if (lane < 32) { dtv = s_dta[scn * TSUB + lane]; av = dtv * Aneg; }
            float pre = av;
#pragma unroll
            for (int o = 1; o < 32; o <<= 1) { const float t = __shfl_up(pre, o); if (lane >= o) pre += t; }
            const float tot = __shfl(pre, 31);
            const float cc = dir ? (tot - pre + av) : pre;
            if (lane < 32) { s_dt[lane] = dtv; s_c[lane] = cc; s_rs[lane] = __expf(cc); s_wl[lane] = dtv * __expf(tot - cc); }
            if (lane == 0) s_tot[0] = tot;
        }
        __syncthreads();
        segtot += s_tot[0];
        SS_CONV(raw0, ci0, tg0);
        if (has1) {
            const unsigned o1_ = (unsigned)(((t0 + 4 * tg1 - 2) * 1024 + sc1) * 2);
#pragma unroll
            for (int r_ = 0; r_ < 8; ++r_) {
                const int tt1 = t0 + 4 * tg1 - 2 + r_;
                raw0[r_] = (u32x4){0u, 0u, 0u, 0u};
                if (tt1 >= 0 && tt1 < SEQ) raw0[r_] = *(const u32x4*)(xb_ + (o1_ + (unsigned)(r_ * 2048)));
            }
            SS_CONV(raw0, ci1, tg1);
        }
        __syncthreads();
        if (PASS == 3) {
            const int it = w >> 1, jt = w & 1;
            f32x4 cb = (f32x4){0.f, 0.f, 0.f, 0.f};
#pragma unroll
            for (int ks = 0; ks < 4; ++ks) {
                const bf16x8 fb = *(const bf16x8*)(Bs + (16 * jt + idx) * 136 + ks * 32 + kq * 8);
                const bf16x8 fc = *(const bf16x8*)(Cs + (16 * it + idx) * 136 + ks * 32 + kq * 8);
                cb = __builtin_amdgcn_mfma_f32_16x16x32_bf16(fb, fc, cb, 0, 0, 0);
            }
            {
                const int ii = 16 * it + idx; const float ci_ = s_c[ii];
                f32x4 gv;
#pragma unroll
                for (int rg = 0; rg < 4; ++rg) {
                    const int jj = 16 * jt + 4 * kq + rg;
                    const bool ok = dir ? (jj >= ii) : (jj <= ii);
                    const float e = __expf(ci_ - s_c[jj]) * s_dt[jj];
                    gv[rg] = ok ? cb[rg] * e : 0.f;
                }
                st4bf(Gs + ii * 40 + 16 * jt + 4 * kq, gv);
            }
            __syncthreads();
            const unsigned char* xtr = (const unsigned char*)Xs + (8 * kq + (idx >> 2)) * 144 + (16 * w + 4 * (idx & 3)) * 2;
            const bf16x8 xf = cat8(tr16(xtr), tr16(xtr + 4 * 144));
#pragma unroll 1
            for (int it2 = 0; it2 < 2; ++it2) {
                const int ii = 16 * it2 + idx;
                const bf16x8 gf = *(const bf16x8*)(Gs + ii * 40 + 8 * kq);
                f32x4 yd = (f32x4){0.f, 0.f, 0.f, 0.f}, yo = (f32x4){0.f, 0.f, 0.f, 0.f};
                yd = __builtin_amdgcn_mfma_f32_16x16x32_bf16(xf, gf, yd, 0, 0, 0);
#pragma unroll
                for (int ks = 0; ks < 4; ++ks) {
                    const bf16x8 sf = *(const bf16x8*)(Sb + (16 * w + idx) * 136 + ks * 32 + kq * 8);
                    const bf16x8 cf = *(const bf16x8*)(Cs + ii * 136 + ks * 32 + kq * 8);
                    yo = __builtin_amdgcn_mfma_f32_16x16x32_bf16(sf, cf, yo, 0, 0, 0);
                }
                f32x4 y = yd + yo * s_rs[ii];
                if (dir == 0) { const u32x2 xv = *(const u32x2*)(Xs + ii * 72 + 16 * w + 4 * kq);
                    y.x += Dh * bflo(xv.x); y.y += Dh * bfhi(xv.x); y.z += Dh * bflo(xv.y); y.w += Dh * bfhi(xv.y); }
                st4bf(Y + (tokb + t0 + ii) * 512 + h * 64 + 16 * w + 4 * kq, y);
            }
        }
        {
            const float dc = __expf(s_tot[0]);
            const unsigned char* xw = (const unsigned char*)Xws + (8 * kq + (idx >> 2)) * 144 + (16 * w + 4 * (idx & 3)) * 2;
            const bf16x8 xwf = cat8(tr16(xw), tr16(xw + 4 * 144));
            bf16x8 bfv[8];
#pragma unroll
            for (int nt = 0; nt < 8; ++nt) {
                const unsigned char* bt = (const unsigned char*)Bs + (8 * kq + (idx >> 2)) * 272 + (16 * nt + 4 * (idx & 3)) * 2;
                bfv[nt] = cat8(tr16(bt), tr16(bt + 4 * 272));
            }
            __builtin_amdgcn_sched_barrier(0);
#pragma unroll
            for (int nt = 0; nt < 8; ++nt) S[nt] = __builtin_amdgcn_mfma_f32_16x16x32_bf16(bfv[nt], xwf, S[nt] * dc, 0, 0, 0);
            __builtin_amdgcn_sched_barrier(0);
            if (PASS == 3) {
#pragma unroll
                for (int nt = 0; nt < 8; ++nt) st4bf(Sb + (16 * w + idx) * 136 + 16 * nt + 4 * kq, S[nt]);
            }
        }
    }
    if (PASS == 1) {
        f32x4* dst = (f32x4*)(ST + (size_t)item * 8192);
#pragma unroll
        for (int nt = 0; nt < 8; ++nt) dst[(w * 8 + nt) * 64 + lane] = S[nt];
        if (tid == 0) SEGT[item] = segtot;
    }
}

__device__ void post2_phase(const Params& p) {
    int tx_ = threadIdx.x; asm volatile("" : "+v"(tx_));
    const int lane = tx_ & 63, gw = blockIdx.x * 8 + (tx_ >> 6), nw = gridDim.x * 8;
    const bf16_t* OB = (const bf16_t*)(p.ws + WS_QB); const float* LSE = (const float*)(p.ws + WS_LSE);
    const bf16_t* GB = (const bf16_t*)(p.ws + WS_GB);
    bf16_t* YBM = (bf16_t*)(p.ws + WS_YBM);
    const bf16_t* YF = (const bf16_t*)(p.ws + WS_YF); const bf16_t* YS = (const bf16_t*)(p.ws + WS_YS); const bf16_t* ZS = (const bf16_t*)(p.ws + WS_ZS);
    bf16_t* YC = (bf16_t*)(p.ws + WS_YC); float* RS = (float*)(p.ws + WS_RSTD);
    for (int row = gw; row < TP; row += nw) {
        const int bl = row >> 13, tt = row & (SEQ - 1), j = lane >> 4;
        float ls[3]; size_t ro[3];
#pragma unroll
        for (int g = 0; g < 3; ++g) { const int sh = 2 * g; const int pp = (tt & ((1 << sh) - 1)) * (SEQ >> sh) + (tt >> sh);
            ro[g] = (size_t)(bl * 3 + g) * SEQ + pp; ls[g] = LSE[ro[g] * 4 + j]; }
        const float mx = fmaxf(ls[0], fmaxf(ls[1], ls[2]));
        float wg[3]; float ws = 0.f;
#pragma unroll
        for (int g = 0; g < 3; ++g) { wg[g] = __expf(ls[g] - mx); ws += wg[g]; }
        const float inv = 1.f / ws;
        f32x4 acc = (f32x4){0.f, 0.f, 0.f, 0.f};
#pragma unroll
        for (int g = 0; g < 3; ++g) { const u32x2 v = *(const u32x2*)(OB + ro[g] * 256 + 4 * lane); const float wv = wg[g] * inv;
            acc.x += wv * bflo(v.x); acc.y += wv * bfhi(v.x); acc.z += wv * bflo(v.y); acc.w += wv * bfhi(v.y); }
        { const u32x2 gt = *(const u32x2*)(GB + (size_t)row * 256 + 4 * lane);
          acc.x *= bflo(gt.x); acc.y *= bfhi(gt.x); acc.z *= bflo(gt.y); acc.w *= bfhi(gt.y); }
        st4bf(YBM + (size_t)row * 256 + 4 * lane, acc);
        const u32x4 a = *(const u32x4*)(YF + (size_t)row * 512 + 8 * lane), bq = *(const u32x4*)(YS + (size_t)row * 512 + 8 * lane), z = *(const u32x4*)(ZS + (size_t)row * 512 + 8 * lane);
        float y[8];
        y[0] = (bflo(a.x) + bflo(bq.x)) * bflo(z.x); y[1] = (bfhi(a.x) + bfhi(bq.x)) * bfhi(z.x);
        y[2] = (bflo(a.y) + bflo(bq.y)) * bflo(z.y); y[3] = (bfhi(a.y) + bfhi(bq.y)) * bfhi(z.y);
        y[4] = (bflo(a.z) + bflo(bq.z)) * bflo(z.z); y[5] = (bfhi(a.z) + bfhi(bq.z)) * bfhi(z.z);
        y[6] = (bflo(a.w) + bflo(bq.w)) * bflo(z.w); y[7] = (bfhi(a.w) + bfhi(bq.w)) * bfhi(z.w);
        float ss = 0.f;
#pragma unroll
        for (int e = 0; e < 8; ++e) ss += y[e] * y[e];
        ss = wave_sum(ss);
        u32x4 o; o.x = pk2(y[0], y[1]); o.y = pk2(y[2], y[3]); o.z = pk2(y[4], y[5]); o.w = pk2(y[6], y[7]);
        *(u32x4*)(YC + (size_t)row * 512 + 8 * lane) = o;
        if (lane == 0) RS[row] = rsqrtf(ss * (1.f / 512.f) + EPS);
    }
}


#define XB_TMO      128
#define XB_XCNT(j)  (256  + 64 * (j))
#define XB_XSUB(j)  (1280 + 64 * (j))
#define XB_XGEN(j)  (2304 + 64 * (j))
#define XB_TOP      3328
#define XB_TOPGEN   3392
#define XCD_BAR_WORDS 3456
#define XB_SPIN_CAP (1u << 20)
__device__ __forceinline__ unsigned xb_ld(unsigned* p)              { return __hip_atomic_load(p, __ATOMIC_RELAXED, __HIP_MEMORY_SCOPE_AGENT); }
__device__ __forceinline__ unsigned xb_add(unsigned* p, unsigned v) { return __hip_atomic_fetch_add(p, v, __ATOMIC_RELAXED, __HIP_MEMORY_SCOPE_AGENT); }
__device__ __forceinline__ unsigned xb_xcc_id() { return (unsigned)__builtin_amdgcn_s_getreg((3 << 11) | 20) & 0xFu; }
#define XB_SPIN(cond, bar) do { unsigned _sp = 0; while (cond) { __builtin_amdgcn_s_sleep(1); \
    if ((++_sp & 255u) == 0u) { if (xb_ld(&(bar)[XB_TMO])) break; if (_sp > XB_SPIN_CAP) { atomicAdd(&(bar)[XB_TMO], 1u); break; } } } } while (0)
struct XcdBarrier { unsigned* bar; unsigned x; volatile LDSAS unsigned* st; };
__device__ __forceinline__ XcdBarrier xcd_barrier_post(unsigned* bar, volatile LDSAS unsigned* st) {
    XcdBarrier b; b.bar = bar; b.x = xb_xcc_id(); b.st = st;
    if (threadIdx.x == 0) (void)xb_add(&bar[XB_XCNT(b.x)], 1u);
    return b;
}
__device__ __forceinline__ void xcd_barrier_complete(unsigned* bar, unsigned x, unsigned& nloc, unsigned& nx) {
    const unsigned G = gridDim.x * gridDim.y * gridDim.z;
    unsigned sum, cnt, mine, sp = 0u;
    for (;;) {
        sum = 0u; cnt = 0u; mine = 0u;
#pragma unroll
        for (unsigned j = 0; j < 16; ++j) { const unsigned c = xb_ld(&bar[XB_XCNT(j)]); sum += c; cnt += (c > 0u) ? 1u : 0u; mine = (j == x) ? c : mine; }
        if (sum == G) break;
        __builtin_amdgcn_s_sleep(1);
        if ((++sp & 255u) == 0u) { if (xb_ld(&bar[XB_TMO])) break; if (sp > XB_SPIN_CAP) { atomicAdd(&bar[XB_TMO], 1u); break; } }
    }
    nloc = mine > 0u ? mine : 1u; nx = cnt > 0u ? cnt : 1u;
}
__device__ __forceinline__ void xcd_barrier(const XcdBarrier& b) {
    asm volatile("s_waitcnt vmcnt(0)" ::: "memory");
    __syncthreads();
    if (threadIdx.x == 0) {
        unsigned* bar = b.bar;
        __builtin_amdgcn_s_waitcnt(0);
        unsigned nloc = b.st[0], nx = b.st[1];
        if (nloc == 0u) { xcd_barrier_complete(bar, b.x, nloc, nx); b.st[0] = nloc; b.st[1] = nx; }
        const unsigned old = xb_add(&bar[XB_XSUB(b.x)], 1u);
        const unsigned gen = old / nloc;
        if (old + 1u == (gen + 1u) * nloc) {
            __builtin_amdgcn_fence(__ATOMIC_RELEASE, "agent");
            asm volatile("s_waitcnt vmcnt(0)" ::: "memory");
            const unsigned og = xb_add(&bar[XB_TOP], 1u);
            const unsigned tg = og / nx;
            if (og + 1u == (tg + 1u) * nx) xb_add(&bar[XB_TOPGEN], 1u);
            else XB_SPIN(xb_ld(&bar[XB_TOPGEN]) == tg, bar);
            __builtin_amdgcn_fence(__ATOMIC_ACQUIRE, "agent");
            xb_add(&bar[XB_XGEN(b.x)], 1u);
            asm volatile("s_waitcnt vmcnt(0)" ::: "memory");
        } else {
            XB_SPIN(xb_ld(&bar[XB_XGEN(b.x)]) == gen, bar);
            __builtin_amdgcn_fence(__ATOMIC_ACQUIRE, "agent");
            asm volatile("s_waitcnt vmcnt(0)" ::: "memory");
        }
    }
    __syncthreads();
}

__device__ __forceinline__ unsigned char* lds_half(unsigned char* smem) { int h_ = threadIdx.x >> 8; asm volatile("" : "+v"(h_)); return smem + h_ * HALF_LDS; }
__global__ void __launch_bounds__(512, 2) hybrid_fwd(Params p) {
    cg::grid_group grid = cg::this_grid();
    extern __shared__ __attribute__((aligned(16))) unsigned char smem[];
    volatile LDSAS unsigned* bst = (volatile LDSAS unsigned*)(smem + LDS_TOTAL - 16);
    if (threadIdx.x < 4) bst[threadIdx.x] = 0u;
    __syncthreads();
    const XcdBarrier xbar = xcd_barrier_post((unsigned*)(p.ws + WS_BAR), bst);
    { const Params q = launder(p); phase0(q, lds_half(smem)); }
    grid.sync();
#pragma unroll 1
    for (int l = 0; l < DEPTH; ++l) {
#pragma unroll 1
        for (int hb = 0; hb < 2; ++hb) {
            { const Params q = launder(p); norm_phase(q, l, hb, (l == 0) ? q.x : q.out); }
            xcd_barrier(xbar);
            { const Params q = launder(p); gemm1_phase(q, l, hb, smem); }
            xcd_barrier(xbar);
            { const Params q = launder(p); unsigned char* smh = lds_half(smem);
#pragma unroll 1
              for (int it = VBLK; it < 512 + 1536; it += VGRID) { if (it < 512) ssd_item<1>(q, it, l, smh); else attn_b_item(q, it - 512, l, smh); } }
            xcd_barrier(xbar);
            { const Params q = launder(p); unsigned char* smh = lds_half(smem);
#pragma unroll 1
              for (int it = VBLK; it < 1024 + 512; it += VGRID) { if (it < 1024) attn_a_item(q, it, l, smh); else ssd_item<3>(q, it - 1024, l, smh); } }
            xcd_barrier(xbar);
            { const Params q = launder(p); post2_phase(q); }
            xcd_barrier(xbar);
            { const Params q = launder(p); merge_phase(q, l, smem); }
            xcd_barrier(xbar);
            { const Params q = launder(p); out_phase(q, l, hb, (l == 0) ? q.x : q.out, smem); }
        }
    }
}

extern "C" void kernel_launch(void* const* d_in, const int* in_sizes, int n_in, void* d_out, int out_size, void* d_ws, size_t ws_size, hipStream_t stream) {
    static int grid_blocks = 0;
    if (!grid_blocks) {
        int dev = 0, cus = 0, per_cu = 0;
        hipGetDevice(&dev);
        hipDeviceGetAttribute(&cus, hipDeviceAttributeMultiprocessorCount, dev);
        hipFuncSetAttribute((const void*)hybrid_fwd, hipFuncAttributeMaxDynamicSharedMemorySize, LDS_TOTAL);
        hipOccupancyMaxActiveBlocksPerMultiprocessor(&per_cu, hybrid_fwd, 512, LDS_TOTAL);
        if (per_cu > 1) per_cu = 1;
        if (per_cu < 1) per_cu = 1;
        grid_blocks = cus * per_cu;
    }
    Params p{};
    const float** pp = (const float**)&p;
    for (int i = 0; i < 22; ++i) pp[i] = (const float*)d_in[i];
    p.out = (float*)d_out; p.ws = (unsigned char*)d_ws;
    hipMemsetAsync((unsigned char*)d_ws + WS_BAR, 0, XCD_BAR_WORDS * 4, stream);
    void* args[] = {&p};
    hipError_t e = hipLaunchCooperativeKernel((void*)hybrid_fwd, dim3(grid_blocks), dim3(512), args, LDS_TOTAL, stream);
    if (e != hipSuccess) fprintf(stderr, "cooperative launch failed: %s (grid %d)\n", hipGetErrorString(e), grid_blocks);
}
```

```cpp
#include <hip/hip_runtime.h>
#include <hip/hip_cooperative_groups.h>
#include <cstdint>
#include <cstdio>
namespace cg = cooperative_groups;

typedef unsigned short bf16_t;
typedef short bf16x8 __attribute__((ext_vector_type(8)));
typedef short v4i16 __attribute__((ext_vector_type(4)));
typedef float f32x2 __attribute__((ext_vector_type(2)));
typedef float f32x4 __attribute__((ext_vector_type(4)));
typedef float f32x16 __attribute__((ext_vector_type(16)));
typedef unsigned u32x2 __attribute__((ext_vector_type(2)));
typedef unsigned u32x4 __attribute__((ext_vector_type(4)));
typedef __bf16 bf16x2_t __attribute__((ext_vector_type(2)));
#define LDSAS __attribute__((address_space(3)))
#define VTID ((int)(threadIdx.x & 255u))
__device__ __forceinline__ int vblk_() { int h_ = threadIdx.x >> 8; asm volatile("" : "+v"(h_)); return __builtin_amdgcn_readfirstlane(2 * (int)blockIdx.x + h_); }
#define VBLK vblk_()
#define VGRID ((int)(2u * gridDim.x))
constexpr int HALF_LDS = 73728, LDS_TOTAL = 147456;

constexpr int SEQ = 8192, DM = 1024, NBATCH = 4, NBH = 2, TP = NBH * SEQ, DEPTH = 2;
constexpr int NP = 8704;
constexpr float EPS = 1e-6f;
constexpr float LOG2E = 1.4426950408889634f, LN2 = 0.6931471805599453f;
constexpr int NSEG = 16, SEGLEN = 512, TSUB = 32, NSUB = SEGLEN / TSUB;

constexpr size_t MiB = 1u << 20;
constexpr size_t WS_WIN = 0;
constexpr size_t WS_WPA = 34 * MiB;
constexpr size_t WS_WPB = 36 * MiB;
constexpr size_t WS_WPC = 37 * MiB;
constexpr size_t WS_WOUT = 39 * MiB;
constexpr size_t WS_MOD = 43 * MiB;
constexpr size_t WS_ROPE = 43 * MiB + 128 * 1024;
constexpr size_t WS_BND = 43 * MiB + 160 * 1024;
constexpr size_t WS_RSTD = 43 * MiB + 256 * 1024;
constexpr size_t WS_SEGT = 43 * MiB + 512 * 1024;
constexpr size_t WS_LSE = 44 * MiB;
constexpr size_t WS_DT = 45 * MiB;
constexpr size_t WS_BAR = 46 * MiB;
constexpr size_t WS_H = 48 * MiB;
constexpr size_t WS_QA = 80 * MiB;
constexpr size_t WS_KA = 96 * MiB;
constexpr size_t WS_VA = 100 * MiB;
constexpr size_t WS_GA = 104 * MiB;
constexpr size_t WS_QB = 120 * MiB;
constexpr size_t WS_KB = 144 * MiB;
constexpr size_t WS_VB = 168 * MiB;
constexpr size_t WS_GB = 192 * MiB;
constexpr size_t WS_XBC = 200 * MiB;
constexpr size_t WS_ZS = 232 * MiB;
constexpr size_t WS_MG = 248 * MiB;
constexpr size_t WS_YF = 344 * MiB;
constexpr size_t WS_YS = 360 * MiB;
constexpr size_t WS_YBM = 376 * MiB;
constexpr size_t WS_YC = 384 * MiB;
constexpr size_t WS_MRG = 400 * MiB;
constexpr size_t WS_ST = 432 * MiB;
constexpr size_t WS_XBCC = 448 * MiB;

struct Params {
    const float *x, *c, *norm_w, *w_ada, *b_ada, *w_in, *b_gate, *q_norm_a, *k_norm_a, *q_norm_b, *k_norm_b, *rel_bias,
        *conv_w, *conv_b, *a_log, *dt_bias, *d_skip, *ssm_norm_w, *w_proj_a, *w_proj_b, *w_proj_c, *w_out;
    float* out;
    unsigned char* ws;
};


#define AS1 __attribute__((address_space(1)))
#define GLOBF(f) do { AS1 const float* g_ = (AS1 const float*)p.f; asm volatile("" : "+s"(g_)); q.f = (const float*)g_; } while (0)
__device__ __forceinline__ Params launder(const Params& p) {
    Params q;
    GLOBF(x); GLOBF(c); GLOBF(norm_w); GLOBF(w_ada); GLOBF(b_ada); GLOBF(w_in); GLOBF(b_gate); GLOBF(q_norm_a); GLOBF(k_norm_a); GLOBF(q_norm_b); GLOBF(k_norm_b); GLOBF(rel_bias);
    GLOBF(conv_w); GLOBF(conv_b); GLOBF(a_log); GLOBF(dt_bias); GLOBF(d_skip); GLOBF(ssm_norm_w); GLOBF(w_proj_a); GLOBF(w_proj_b); GLOBF(w_proj_c); GLOBF(w_out);
    { AS1 float* g_ = (AS1 float*)p.out; asm volatile("" : "+s"(g_)); q.out = (float*)g_; }
    { AS1 unsigned char* g_ = (AS1 unsigned char*)p.ws; asm volatile("" : "+s"(g_)); q.ws = (unsigned char*)g_; }
    return q;
}
__device__ __forceinline__ unsigned pk2(float lo, float hi) { f32x2 v = {lo, hi}; bf16x2_t b = __builtin_convertvector(v, bf16x2_t); return __builtin_bit_cast(unsigned, b); }
__device__ __forceinline__ float bf2f(unsigned short b) { return __uint_as_float(((unsigned)b) << 16); }
__device__ __forceinline__ float bflo(unsigned u) { return __uint_as_float(u << 16); }
__device__ __forceinline__ float bfhi(unsigned u) { return __uint_as_float(u & 0xffff0000u); }
__device__ __forceinline__ float siluf(float v) { return v * __builtin_amdgcn_rcpf(1.f + __builtin_amdgcn_exp2f(-1.4426950408889634f * v)); }
__device__ __forceinline__ float sigmf(float v) { return __builtin_amdgcn_rcpf(1.f + __builtin_amdgcn_exp2f(-1.4426950408889634f * v)); }
__device__ __forceinline__ float wave_sum(float v) {
#pragma unroll
    for (int o = 1; o < 64; o <<= 1) v += __shfl_xor(v, o);
    return v;
}
__device__ __forceinline__ v4i16 tr16(const unsigned char* p) { return __builtin_amdgcn_ds_read_tr16_b64_v4i16((LDSAS v4i16*)p); }
__device__ __forceinline__ bf16x8 cat8(v4i16 a, v4i16 b) { return (bf16x8){a[0], a[1], a[2], a[3], b[0], b[1], b[2], b[3]}; }
__device__ __forceinline__ int crow(int r, int hi) { return (r & 3) + 8 * (r >> 2) + 4 * hi; }

__device__ __forceinline__ void p0_transpose(const float* __restrict__ W, int ldw, int K, bf16_t* __restrict__ Wt, int k0, int n0, int mode,
                                             const float* __restrict__ rowscale, float* tile) {
    const int tid = VTID, tx = tid & 63, ty = tid >> 6;
    const int np = n0 + tx; int n = np; bool valid = true;
    if (mode == 1) {
        if (np < 4352) n = np; else if (np < 4864) n = np + 512; else if (np < 5376) n = np - 512;
        else if (np < 8448) n = np + 16; else if (np < 8464) n = np - 3072; else { valid = false; n = 0; }
    }
#pragma unroll 4
    for (int i = 0; i < 16; ++i) {
        const int k = ty + 4 * i; float v = valid ? W[(size_t)(k0 + k) * ldw + n] : 0.f;
        if (rowscale) v *= rowscale[k0 + k];
        tile[k * 65 + tx] = v;
    }
    __syncthreads();
    const int r = tid >> 2, kc = (tid & 3) * 16;
    u32x4 o0, o1;
    o0.x = pk2(tile[(kc + 0) * 65 + r], tile[(kc + 1) * 65 + r]); o0.y = pk2(tile[(kc + 2) * 65 + r], tile[(kc + 3) * 65 + r]);
    o0.z = pk2(tile[(kc + 4) * 65 + r], tile[(kc + 5) * 65 + r]); o0.w = pk2(tile[(kc + 6) * 65 + r], tile[(kc + 7) * 65 + r]);
    o1.x = pk2(tile[(kc + 8) * 65 + r], tile[(kc + 9) * 65 + r]); o1.y = pk2(tile[(kc + 10) * 65 + r], tile[(kc + 11) * 65 + r]);
    o1.z = pk2(tile[(kc + 12) * 65 + r], tile[(kc + 13) * 65 + r]); o1.w = pk2(tile[(kc + 14) * 65 + r], tile[(kc + 15) * 65 + r]);
    bf16_t* dst = Wt + (size_t)(n0 + r) * K + k0 + kc;
    *(u32x4*)dst = o0; *(u32x4*)(dst + 8) = o1;
    __syncthreads();
}

__device__ void phase0(const Params& p, unsigned char* smem) {
    const int tid = VTID;
    float* tile = (float*)smem;
    constexpr int I_IN = 16 * 136, I_PA = 8 * 16, I_PB = 4 * 16, I_PC = 8 * 16, I_OUT = 16 * 16, I_L = I_IN + I_PA + I_PB + I_PC + I_OUT;
    constexpr int I_T = 2 * I_L, I_MOD = 192, I_ALL = I_T + I_MOD + 1;
    for (int item = VBLK; item < I_ALL; item += VGRID) {
        if (item < I_T) {
            const int l = item / I_L; int r = item % I_L;
            if (r < I_IN) { const int kt = r / 136, nt = r % 136;
                p0_transpose(p.w_in + (size_t)l * 1024 * 8464, 8464, 1024, (bf16_t*)(p.ws + WS_WIN) + (size_t)l * NP * 1024, kt * 64, nt * 64, 1, nullptr, tile); continue; }
            r -= I_IN;
            if (r < I_PA) { const int kt = r / 16, nt = r % 16;
                p0_transpose(p.w_proj_a + (size_t)l * 512 * 1024, 1024, 512, (bf16_t*)(p.ws + WS_WPA) + (size_t)l * 1024 * 512, kt * 64, nt * 64, 0, nullptr, tile); continue; }
            r -= I_PA;
            if (r < I_PB) { const int kt = r / 16, nt = r % 16;
                p0_transpose(p.w_proj_b + (size_t)l * 256 * 1024, 1024, 256, (bf16_t*)(p.ws + WS_WPB) + (size_t)l * 1024 * 256, kt * 64, nt * 64, 0, nullptr, tile); continue; }
            r -= I_PB;
            if (r < I_PC) { const int kt = r / 16, nt = r % 16;
                p0_transpose(p.w_proj_c + (size_t)l * 512 * 1024, 1024, 512, (bf16_t*)(p.ws + WS_WPC) + (size_t)l * 1024 * 512, kt * 64, nt * 64, 0, p.ssm_norm_w + l * 512, tile); continue; }
            r -= I_PC;
            { const int kt = r / 16, nt = r % 16;
                p0_transpose(p.w_out + (size_t)l * 1024 * 1024, 1024, 1024, (bf16_t*)(p.ws + WS_WOUT) + (size_t)l * 1024 * 1024, kt * 64, nt * 64, 0, nullptr, tile); }
        } else if (item < I_T + I_MOD) {
            const int it = item - I_T, l = it / 96, col0 = (it % 96) * 32, cl = tid & 31, ks = tid >> 5;
            float a0 = 0.f, a1 = 0.f, a2 = 0.f, a3 = 0.f;
            const float* wp = p.w_ada + ((size_t)l * 1024 + ks * 128) * 3072 + col0 + cl;
#pragma unroll 8
            for (int k = 0; k < 128; ++k) {
                const float wv = wp[(size_t)k * 3072]; const int kk = ks * 128 + k;
                a0 += siluf(p.c[kk]) * wv; a1 += siluf(p.c[1024 + kk]) * wv; a2 += siluf(p.c[2048 + kk]) * wv; a3 += siluf(p.c[3072 + kk]) * wv;
            }
            float* red = (float*)smem;
            red[(ks * 32 + cl) * 4 + 0] = a0; red[(ks * 32 + cl) * 4 + 1] = a1; red[(ks * 32 + cl) * 4 + 2] = a2; red[(ks * 32 + cl) * 4 + 3] = a3;
            __syncthreads();
            if (tid < 128) { const int b = tid >> 5, c2 = tid & 31; float s = 0.f;
#pragma unroll
                for (int k = 0; k < 8; ++k) s += red[(k * 32 + c2) * 4 + b];
                ((float*)(p.ws + WS_MOD))[(l * 4 + b) * 3072 + col0 + c2] = s + p.b_ada[l * 3072 + col0 + c2]; }
            __syncthreads();
        } else {
            float* rc = (float*)(p.ws + WS_ROPE); float* rs = rc + 128 * 16;
            for (int e = tid; e < 2048; e += 256) {
                const int pos = e >> 4, i = e & 15;
                const float freq = powf(10000.0f, -(float)i / 16.0f);
                const float ang = (float)pos * freq;
                const double rev = (double)ang * 0.15915494309189535; const double fr = rev - rint(rev);
                const float a = (float)(fr * 6.283185307179586);
                rc[e] = cosf(a); rs[e] = sinf(a);
            }
            if (tid < 2) {
                const int l = tid; float mqa = 0.f, mka = 0.f, mqb = 0.f, mkb = 0.f, mb = 0.f;
                for (int i = 0; i < 64; ++i) { mqa = fmaxf(mqa, fabsf(p.q_norm_a[l * 64 + i])); mka = fmaxf(mka, fabsf(p.k_norm_a[l * 64 + i]));
                    mqb = fmaxf(mqb, fabsf(p.q_norm_b[l * 64 + i])); mkb = fmaxf(mkb, fabsf(p.k_norm_b[l * 64 + i])); }
                for (int i = 0; i < 32 * 12; ++i) mb = fmaxf(mb, p.rel_bias[i]);
                float* bd = (float*)(p.ws + WS_BND);
                bd[l] = 8.f * mqa * mka * LOG2E; bd[2 + l] = (8.f * mqb * mkb + mb) * LOG2E;
            }
        }
    }
}

__device__ void norm_phase(const Params& p, int l, int hb, const float* xsrc) {
    int tx_ = threadIdx.x; asm volatile("" : "+v"(tx_));
    const int lane = tx_ & 63, gw = blockIdx.x * 8 + (tx_ >> 6), nw = gridDim.x * 8;
    bf16_t* H = (bf16_t*)(p.ws + WS_H);
    const float* nwp = p.norm_w + l * 1024;
    for (int row = gw; row < TP; row += nw) {
        const size_t rg = (size_t)hb * TP + row; const int b = (int)(rg / SEQ);
        const f32x4* xr = (const f32x4*)(xsrc + rg * 1024);
        const float* md = (const float*)(p.ws + WS_MOD) + (size_t)(l * 4 + b) * 3072;
        f32x4 v[4]; float ss = 0.f;
#pragma unroll
        for (int j = 0; j < 4; ++j) { v[j] = xr[lane + 64 * j]; ss += v[j].x * v[j].x + v[j].y * v[j].y + v[j].z * v[j].z + v[j].w * v[j].w; }
        ss = wave_sum(ss); const float rstd = rsqrtf(ss * (1.f / 1024.f) + EPS);
#pragma unroll
        for (int j = 0; j < 4; ++j) {
            const int col = 4 * (lane + 64 * j);
            const f32x4 w4 = *(const f32x4*)(nwp + col), sh = *(const f32x4*)(md + col), sc = *(const f32x4*)(md + 1024 + col);
            const f32x4 o = v[j] * rstd * w4 * (1.f + sc) + sh;
            u32x2 pk; pk.x = pk2(o.x, o.y); pk.y = pk2(o.z, o.w);
            *(u32x2*)(H + (size_t)row * 1024 + col) = pk;
        }
    }
}

constexpr int G_STAGE = 65536, G_AB = 32768;
__device__ __forceinline__ void gemm_core(const bf16_t* __restrict__ A, int lda, const bf16_t* __restrict__ Bt, int ldb, int K, f32x4 (&acc)[8][4], unsigned char* smem, int tid) {
    asm volatile("" : "+v"(tid));
    const int lane = tid & 63, w = __builtin_amdgcn_readfirstlane(tid >> 6), wm = w >> 2, wn = w & 3, idx = lane & 15, kq = lane >> 4;
    unsigned offA[4], offB[4];
#pragma unroll
    for (int j = 0; j < 4; ++j) { const int row = (j * 8 + w) * 8 + (lane >> 3), c = (lane & 7) ^ ((row >> 1) & 7);
        offA[j] = (unsigned)(row * lda + c * 8) * 2u; offB[j] = (unsigned)(row * ldb + c * 8) * 2u; }
#pragma unroll
    for (int mi = 0; mi < 8; ++mi)
#pragma unroll
        for (int ni = 0; ni < 4; ++ni) acc[mi][ni] = (f32x4){0.f, 0.f, 0.f, 0.f};
    LDSAS unsigned char* lds = (LDSAS unsigned char*)smem;
#define G_ISSUE1(kt, st, j) do { \
        __builtin_amdgcn_global_load_lds((const unsigned*)((const char*)A + offA[j] + (kt) * 128), (LDSAS unsigned*)(lds + (st) * G_STAGE + ((j) * 8 + w) * 1024), 16, 0, 0); \
        __builtin_amdgcn_global_load_lds((const unsigned*)((const char*)Bt + offB[j] + (kt) * 128), (LDSAS unsigned*)(lds + (st) * G_STAGE + G_AB + ((j) * 8 + w) * 1024), 16, 0, 0); } while (0)
#define G_ISSUE(kt, st) do { G_ISSUE1(kt, st, 0); G_ISSUE1(kt, st, 1); G_ISSUE1(kt, st, 2); G_ISSUE1(kt, st, 3); } while (0)
    const int nk = K >> 6;
    G_ISSUE(0, 0);
    asm volatile("s_waitcnt vmcnt(0)" ::: "memory");
    __syncthreads();
    const int swz = (idx >> 1) & 7;
    const int aoff = (wm * 128 + idx) * 128, boff = G_AB + (wn * 64 + idx) * 128;
    for (int kt = 0; kt < nk; ++kt) {
        const int st = kt & 1;
        const bool more = kt + 1 < nk;
        const unsigned char* sb = smem + st * G_STAGE;
#pragma unroll
        for (int ks = 0; ks < 2; ++ks) {
            bf16x8 bfr[4], af[8];
            const int co = ((ks * 4 + kq) ^ swz) * 16;
#pragma unroll
            for (int ni = 0; ni < 4; ++ni) bfr[ni] = *(const bf16x8*)(sb + boff + ni * 2048 + co);
#pragma unroll
            for (int mi = 0; mi < 8; ++mi) af[mi] = *(const bf16x8*)(sb + aoff + mi * 2048 + co);
            if (more) { G_ISSUE1(kt + 1, st ^ 1, ks * 2); G_ISSUE1(kt + 1, st ^ 1, ks * 2 + 1); }
            __builtin_amdgcn_sched_barrier(0);
            __builtin_amdgcn_s_setprio(1);
#pragma unroll
            for (int mi = 0; mi < 8; ++mi)
#pragma unroll
                for (int ni = 0; ni < 4; ++ni) acc[mi][ni] = __builtin_amdgcn_mfma_f32_16x16x32_bf16(bfr[ni], af[mi], acc[mi][ni], 0, 0, 0);
            __builtin_amdgcn_s_setprio(0);
            __builtin_amdgcn_sched_barrier(0);
        }
        asm volatile("s_waitcnt vmcnt(0)" ::: "memory");
        __syncthreads();
    }
#undef G_ISSUE1
#undef G_ISSUE
}

__device__ __forceinline__ void st4bf(bf16_t* dst, f32x4 v) { u32x2 pk; pk.x = pk2(v.x, v.y); pk.y = pk2(v.z, v.w); *(u32x2*)dst = pk; }

__device__ void gemm1_phase(const Params& p, int l, int hb, unsigned char* smem) {
    const bf16_t* H = (const bf16_t*)(p.ws + WS_H);
    const bf16_t* Wt = (const bf16_t*)(p.ws + WS_WIN) + (size_t)l * NP * 1024;
    const float* ropec = (const float*)(p.ws + WS_ROPE); const float* ropes = ropec + 2048;
    constexpr int NT = 34, NTILES = 64 * NT, GRP = 8 * NT;
    for (int t = blockIdx.x; t < NTILES; t += gridDim.x) {
        const int grp = t / GRP, r = t % GRP, jx = NT * (r & 7) + (r >> 3), mt = grp * 8 + (jx & 7), nt = jx >> 3;
        const int m0 = mt * 256, n0 = nt * 256;
        f32x4 acc[8][4];
        int tid = threadIdx.x;
        gemm_core(H + (size_t)m0 * 1024, 1024, Wt + (size_t)n0 * 1024, 1024, 1024, acc, smem, tid);
        asm volatile("" : "+v"(tid));
        const int lane = tid & 63, w = tid >> 6, wm = w >> 2, wn = w & 3, idx = lane & 15, kq = lane >> 4;
        const int cw = n0 + wn * 64;
        const int lc = 4 * kq;
        if (cw < 768 && (cw < 640)) {
            const bool isq = cw < 512;
            const float* nwp = (isq ? p.q_norm_a : p.k_norm_a) + l * 64;
            bf16_t* dst = isq ? (bf16_t*)(p.ws + WS_QA) : (bf16_t*)(p.ws + WS_KA);
            const int pitch = isq ? 512 : 128, c0 = isq ? cw : cw - 512;
            const float qs = isq ? 0.125f * LOG2E : 1.f;
#pragma unroll
            for (int mi = 0; mi < 8; ++mi) {
                const int row = m0 + wm * 128 + mi * 16 + idx;
                float ss = 0.f;
#pragma unroll
                for (int ni = 0; ni < 4; ++ni) { const f32x4 v = acc[mi][ni]; ss += v.x * v.x + v.y * v.y + v.z * v.z + v.w * v.w; }
                ss += __shfl_xor(ss, 16); ss += __shfl_xor(ss, 32);
                const float rstd = rsqrtf(ss * (1.f / 64.f) + EPS);
                f32x4 y[4];
#pragma unroll
                for (int ni = 0; ni < 4; ++ni) y[ni] = acc[mi][ni] * rstd * *(const f32x4*)(nwp + ni * 16 + lc);
                const int tt = row & (SEQ - 1), prow = tt >> 6, pcol = tt & 63;
#pragma unroll
                for (int hf = 0; hf < 2; ++hf) {
                    const int pos = hf ? pcol : prow;
                    const f32x4 cs = *(const f32x4*)(ropec + pos * 16 + lc), sn = *(const f32x4*)(ropes + pos * 16 + lc);
                    const f32x4 a = y[2 * hf], b = y[2 * hf + 1];
                    y[2 * hf] = a * cs - b * sn; y[2 * hf + 1] = b * cs + a * sn;
                }
#pragma unroll
                for (int ni = 0; ni < 4; ++ni) st4bf(dst + (size_t)row * pitch + c0 + ni * 16 + lc, y[ni] * qs);
            }
        } else if (cw >= 1280 && cw < 2816) {
            const bool isq = cw < 2048;
            const float* nwp = (isq ? p.q_norm_b : p.k_norm_b) + l * 64;
            const int gc = isq ? cw - 1280 : cw - 2048, g = gc >> 8, c0 = gc & 255;
            const int sh = 2 * g;
            bf16_t* dst = (bf16_t*)(p.ws + (isq ? WS_QB : WS_KB));
            const float qs = isq ? 0.125f * LOG2E : 1.f;
#pragma unroll
            for (int mi = 0; mi < 8; ++mi) {
                const int row = m0 + wm * 128 + mi * 16 + idx;
                float ss = 0.f;
#pragma unroll
                for (int ni = 0; ni < 4; ++ni) { const f32x4 v = acc[mi][ni]; ss += v.x * v.x + v.y * v.y + v.z * v.z + v.w * v.w; }
                ss += __shfl_xor(ss, 16); ss += __shfl_xor(ss, 32);
                const float rstd = rsqrtf(ss * (1.f / 64.f) + EPS) * qs;
                const int bl = row >> 13, tt = row & (SEQ - 1);
                const int pp = (tt & ((1 << sh) - 1)) * (SEQ >> sh) + (tt >> sh);
                bf16_t* drow = dst + ((size_t)(bl * 3 + g) * SEQ + pp) * 256 + c0 + lc;
#pragma unroll
                for (int ni = 0; ni < 4; ++ni) st4bf(drow + ni * 16, acc[mi][ni] * rstd * *(const f32x4*)(nwp + ni * 16 + lc));
            }
        } else if (cw >= 2816 && cw < 3584) {
            const int gc = cw - 2816, g = gc >> 8, c0 = gc & 255, sh = 2 * g;
            bf16_t* dst = (bf16_t*)(p.ws + WS_VB);
#pragma unroll
            for (int mi = 0; mi < 8; ++mi) {
                const int row = m0 + wm * 128 + mi * 16 + idx;
                const int bl = row >> 13, tt = row & (SEQ - 1);
                const int pp = (tt & ((1 << sh) - 1)) * (SEQ >> sh) + (tt >> sh);
                bf16_t* drow = dst + ((size_t)(bl * 3 + g) * SEQ + pp) * 256 + c0 + lc;
#pragma unroll
                for (int ni = 0; ni < 4; ++ni) st4bf(drow + ni * 16, acc[mi][ni]);
            }
        } else if (cw >= 8448) {
            if (cw == 8448) {
                float* dst = (float*)(p.ws + WS_DT);
                const f32x4 bias = *(const f32x4*)(p.dt_bias + l * 16 + lc);
#pragma unroll
                for (int mi = 0; mi < 8; ++mi) {
                    const int row = m0 + wm * 128 + mi * 16 + idx;
                    f32x4 v = acc[mi][0] + bias, o;
                    o.x = v.x > 20.f ? v.x : log1pf(__expf(v.x)); o.y = v.y > 20.f ? v.y : log1pf(__expf(v.y));
                    o.z = v.z > 20.f ? v.z : log1pf(__expf(v.z)); o.w = v.w > 20.f ? v.w : log1pf(__expf(v.w));
                    *(f32x4*)(dst + (size_t)row * 16 + lc) = o;
                }
            }
        } else {
            bf16_t* dst; int pitch, c0, mode;
            if (cw < 768) { dst = (bf16_t*)(p.ws + WS_VA); pitch = 128; c0 = cw - 640; mode = 0; }
            else if (cw < 1280) { dst = (bf16_t*)(p.ws + WS_GA); pitch = 512; c0 = cw - 768; mode = 1; }
            else if (cw < 3840) { dst = (bf16_t*)(p.ws + WS_GB); pitch = 256; c0 = cw - 3584; mode = 1; }
            else if (cw < 4864) { dst = (bf16_t*)(p.ws + WS_XBC); pitch = 1024; c0 = cw - 3840; mode = 0; }
            else if (cw < 5376) { dst = (bf16_t*)(p.ws + WS_ZS); pitch = 512; c0 = cw - 4864; mode = 1; }
            else { dst = (bf16_t*)(p.ws + WS_MG); pitch = 3072; c0 = cw - 5376; mode = 2; }
            const float* bg = p.b_gate + l * 3072 + c0 + lc;
#pragma unroll
            for (int mi = 0; mi < 8; ++mi) {
                const int row = m0 + wm * 128 + mi * 16 + idx;
#pragma unroll
                for (int ni = 0; ni < 4; ++ni) {
                    f32x4 v = acc[mi][ni];
                    if (mode == 1) { v.x = siluf(v.x); v.y = siluf(v.y); v.z = siluf(v.z); v.w = siluf(v.w); }
                    else if (mode == 2) { const f32x4 bb = *(const f32x4*)(bg + ni * 16); v.x = sigmf(v.x + bb.x); v.y = sigmf(v.y + bb.y); v.z = sigmf(v.z + bb.z); v.w = sigmf(v.w + bb.w); }
                    st4bf(dst + (size_t)row * pitch + c0 + ni * 16 + lc, v);
                }
            }
        }
    }
}

__device__ void merge_phase(const Params& p, int l, unsigned char* smem) {
    const bf16_t* MG = (const bf16_t*)(p.ws + WS_MG);
    const float* rstd = (const float*)(p.ws + WS_RSTD);
    bf16_t* MR = (bf16_t*)(p.ws + WS_MRG);
    for (int t = blockIdx.x; t < 64 * 4; t += gridDim.x) {
        const int xq = t >> 3, mt = (xq >> 2) * 8 + (t & 7), nt = xq & 3, m0 = mt * 256, n0 = nt * 256;
#pragma unroll 1
        for (int br = 0; br < 3; ++br) {
            f32x4 acc[8][4];
            const bf16_t* A; const bf16_t* Bt; int K;
            if (br == 0) { A = (const bf16_t*)(p.ws + WS_QA); K = 512; Bt = (const bf16_t*)(p.ws + WS_WPA) + (size_t)l * 1024 * 512; }
            else if (br == 1) { A = (const bf16_t*)(p.ws + WS_YBM); K = 256; Bt = (const bf16_t*)(p.ws + WS_WPB) + (size_t)l * 1024 * 256; }
            else { A = (const bf16_t*)(p.ws + WS_YC); K = 512; Bt = (const bf16_t*)(p.ws + WS_WPC) + (size_t)l * 1024 * 512; }
            int tid = threadIdx.x;
            gemm_core(A + (size_t)m0 * K, K, Bt + (size_t)n0 * K, K, K, acc, smem, tid);
            asm volatile("" : "+v"(tid));
            const int lane = tid & 63, w = tid >> 6, wm = w >> 2, wn = w & 3, idx = lane & 15, kq = lane >> 4;
#pragma unroll
            for (int mi = 0; mi < 8; ++mi) {
                const int row = m0 + wm * 128 + mi * 16 + idx;
                const float rs = (br == 2) ? rstd[row] : 1.f;
#pragma unroll
                for (int ni = 0; ni < 4; ++ni) {
                    const int col = n0 + wn * 64 + ni * 16 + 4 * kq;
                    const u32x2 g = *(const u32x2*)(MG + (size_t)row * 3072 + br * 1024 + col);
                    f32x4 gv; gv.x = bflo(g.x); gv.y = bfhi(g.x); gv.z = bflo(g.y); gv.w = bfhi(g.y);
                    f32x4 v = gv * rs * acc[mi][ni];
                    bf16_t* mp = MR + (size_t)row * 1024 + col;
                    if (br > 0) { const u32x2 o = *(const u32x2*)mp; v.x += bflo(o.x); v.y += bfhi(o.x); v.z += bflo(o.y); v.w += bfhi(o.y); }
                    st4bf(mp, v);
                }
            }
        }
    }
}

__device__ void out_phase(const Params& p, int l, int hb, const float* xsrc, unsigned char* smem) {
    const bf16_t* MR = (const bf16_t*)(p.ws + WS_MRG);
    const bf16_t* Wt = (const bf16_t*)(p.ws + WS_WOUT) + (size_t)l * 1024 * 1024;
    for (int t = blockIdx.x; t < 64 * 4; t += gridDim.x) {
        const int xq = t >> 3, mt = (xq >> 2) * 8 + (t & 7), nt = xq & 3, m0 = mt * 256, n0 = nt * 256;
        f32x4 acc[8][4];
        int tid = threadIdx.x;
        gemm_core(MR + (size_t)m0 * 1024, 1024, Wt + (size_t)n0 * 1024, 1024, 1024, acc, smem, tid);
        asm volatile("" : "+v"(tid));
        const int lane = tid & 63, w = tid >> 6, wm = w >> 2, wn = w & 3, idx = lane & 15, kq = lane >> 4;
#pragma unroll
        for (int mi = 0; mi < 8; ++mi) {
            const int row = m0 + wm * 128 + mi * 16 + idx; const size_t rg = (size_t)hb * TP + row; const int b = (int)(rg / SEQ);
            const float* gate = (const float*)(p.ws + WS_MOD) + (size_t)(l * 4 + b) * 3072 + 2048;
#pragma unroll
            for (int ni = 0; ni < 4; ++ni) {
                const int col = n0 + wn * 64 + ni * 16 + 4 * kq;
                const f32x4 xv = *(const f32x4*)(xsrc + rg * 1024 + col), gv = *(const f32x4*)(gate + col);
                *(f32x4*)(p.out + rg * 1024 + col) = xv + gv * acc[mi][ni];
            }
        }
    }
}

constexpr int AT_KS = 0, AT_VS = 9216, AT_LQ = 9216 + 8192, AT_LUT = AT_LQ + 512;

#define AT_STAGE_STORE() do { _Pragma("unroll") for (int i = 0; i < 2; ++i) { const int c = tid + 256 * i, row = c >> 3, ch = c & 7; \
        *(u32x4*)(Ks + row * 72 + ch * 8) = rk[i]; *(u32x4*)(Vs + (ch >> 2) * 4096 + row * 64 + (ch & 3) * 16) = rv[i]; } } while (0)

__device__ __forceinline__ void at_qk(f32x16& p0, f32x16& p1, const bf16_t* Ks, const bf16x8* qr, int r32, int hi) {
    bf16x8 kf[8];
#pragma unroll
    for (int ds = 0; ds < 4; ++ds) {
        kf[2 * ds] = *(const bf16x8*)(Ks + r32 * 72 + ds * 16 + hi * 8);
        kf[2 * ds + 1] = *(const bf16x8*)(Ks + (r32 + 32) * 72 + ds * 16 + hi * 8);
    }
    __builtin_amdgcn_sched_barrier(0);
    __builtin_amdgcn_s_setprio(1);
#pragma unroll
    for (int ds = 0; ds < 4; ++ds) {
        p0 = __builtin_amdgcn_mfma_f32_32x32x16_bf16(kf[2 * ds], qr[ds], p0, 0, 0, 0);
        p1 = __builtin_amdgcn_mfma_f32_32x32x16_bf16(kf[2 * ds + 1], qr[ds], p1, 0, 0, 0);
    }
    __builtin_amdgcn_s_setprio(0);
    __builtin_amdgcn_sched_barrier(0);
}
__device__ __forceinline__ void at_pv(f32x16& o0, f32x16& o1, const f32x16& p0, const f32x16& p1, const unsigned char* Vs, int lane) {
    const int hi = lane >> 5;
    const unsigned char* vb = Vs + ((lane >> 4) & 1) * 32 + (lane & 3) * 8 + (4 * hi + ((lane & 15) >> 2)) * 64;
    bf16x8 v0[4], v1[4], pa[4];
#pragma unroll
    for (int s = 0; s < 4; ++s) {
        v0[s] = cat8(tr16(vb + s * 1024), tr16(vb + s * 1024 + 512));
        v1[s] = cat8(tr16(vb + 4096 + s * 1024), tr16(vb + 4096 + s * 1024 + 512));
    }
#pragma unroll
    for (int s = 0; s < 4; ++s) {
        u32x4 pw;
        if (s < 2) { pw.x = pk2(p0[8 * s + 0], p0[8 * s + 1]); pw.y = pk2(p0[8 * s + 2], p0[8 * s + 3]); pw.z = pk2(p0[8 * s + 4], p0[8 * s + 5]); pw.w = pk2(p0[8 * s + 6], p0[8 * s + 7]); }
        else { const int q = s - 2; pw.x = pk2(p1[8 * q + 0], p1[8 * q + 1]); pw.y = pk2(p1[8 * q + 2], p1[8 * q + 3]); pw.z = pk2(p1[8 * q + 4], p1[8 * q + 5]); pw.w = pk2(p1[8 * q + 6], p1[8 * q + 7]); }
        pa[s] = __builtin_bit_cast(bf16x8, pw);
    }
    __builtin_amdgcn_sched_barrier(0);
    __builtin_amdgcn_s_setprio(1);
#pragma unroll
    for (int s = 0; s < 4; ++s) {
        o0 = __builtin_amdgcn_mfma_f32_32x32x16_bf16(pa[s], v0[s], o0, 0, 0, 0);
        o1 = __builtin_amdgcn_mfma_f32_32x32x16_bf16(pa[s], v1[s], o1, 0, 0, 0);
    }
    __builtin_amdgcn_s_setprio(0);
    __builtin_amdgcn_sched_barrier(0);
}

constexpr int ATA_STAGE = 17408, ATA_LQ = 2 * ATA_STAGE;
__device__ void attn_a_item(const Params& p, int item, int l, unsigned char* smem) {
    int tid_ = VTID; asm volatile("" : "+v"(tid_));
    const int tid = tid_, lane = tid & 63, w = tid >> 6, r32 = lane & 31, hi = lane >> 5;
    const int b = item >> 9, r = item & 511, kvh = r >> 8, qblk = (r >> 2) & 63, hq = kvh * 4 + (r & 3);
    float* lq = (float*)(smem + ATA_LQ) + w * 32;
    bf16_t* QA = (bf16_t*)(p.ws + WS_QA);
    const bf16_t* GA = (const bf16_t*)(p.ws + WS_GA);
    const size_t tokq = (size_t)b * SEQ + qblk * 128 + w * 32;
    bf16x8 qr[4];
#pragma unroll
    for (int ds = 0; ds < 4; ++ds) qr[ds] = *(const bf16x8*)(QA + (tokq + r32) * 512 + hq * 64 + ds * 16 + hi * 8);
    const bf16_t* Kb = (const bf16_t*)(p.ws + WS_KA) + (size_t)b * SEQ * 128 + kvh * 64;
    const bf16_t* Vb = (const bf16_t*)(p.ws + WS_VA) + (size_t)b * SEQ * 128 + kvh * 64;
    const float nshift = -((const float*)(p.ws + WS_BND))[l];
    f32x16 o0, o1;
#pragma unroll
    for (int i = 0; i < 16; ++i) { o0[i] = 0.f; o1[i] = 0.f; }
    float lacc = 0.f;
    constexpr int NT = SEQ / 64;
    const int row0 = tid >> 3, ch0 = tid & 7;
    const size_t goff0 = (size_t)row0 * 128 + ch0 * 8, goff1 = goff0 + (size_t)32 * 128;
    const int ko0 = row0 * 144 + ch0 * 16, ko1 = ko0 + 32 * 144;
    const int vo0 = 9216 + (ch0 >> 2) * 4096 + row0 * 64 + (ch0 & 3) * 16, vo1 = vo0 + 32 * 64;
    u32x4 rkA[2], rvA[2], rkB[2], rvB[2];
#define ATA_LOAD(RK, RV, t) do { const size_t tb = (size_t)(t) * 64 * 128; RK[0] = *(const u32x4*)(Kb + tb + goff0); RK[1] = *(const u32x4*)(Kb + tb + goff1); \
        RV[0] = *(const u32x4*)(Vb + tb + goff0); RV[1] = *(const u32x4*)(Vb + tb + goff1); } while (0)
#define ATA_STORE(RK, RV, st) do { unsigned char* sb_ = smem + (st) * ATA_STAGE; *(u32x4*)(sb_ + ko0) = RK[0]; *(u32x4*)(sb_ + ko1) = RK[1]; \
        *(u32x4*)(sb_ + vo0) = RV[0]; *(u32x4*)(sb_ + vo1) = RV[1]; } while (0)
#define ATA_COMPUTE(st) do { const unsigned char* sb_ = smem + (st) * ATA_STAGE; f32x16 p0, p1; \
        _Pragma("unroll") for (int i = 0; i < 16; ++i) { p0[i] = nshift; p1[i] = nshift; } \
        at_qk(p0, p1, (const bf16_t*)sb_, qr, r32, hi); \
        _Pragma("unroll") for (int i = 0; i < 16; ++i) { p0[i] = __builtin_amdgcn_exp2f(p0[i]); p1[i] = __builtin_amdgcn_exp2f(p1[i]); lacc += p0[i] + p1[i]; } \
        at_pv(o0, o1, p0, p1, sb_ + 9216, lane); } while (0)
    __syncthreads();
    ATA_LOAD(rkA, rvA, 0); ATA_LOAD(rkB, rvB, 1);
    ATA_STORE(rkA, rvA, 0);
    ATA_LOAD(rkA, rvA, 2);
    __syncthreads();
    for (int kt = 0; kt < NT; kt += 2) {
        ATA_COMPUTE(0);
        ATA_STORE(rkB, rvB, 1);
        if (kt + 3 < NT) ATA_LOAD(rkB, rvB, kt + 3);
        __syncthreads();
        ATA_COMPUTE(1);
        if (kt + 2 < NT) { ATA_STORE(rkA, rvA, 0); if (kt + 4 < NT) ATA_LOAD(rkA, rvA, kt + 4); }
        __syncthreads();
    }
#undef ATA_LOAD
#undef ATA_STORE
#undef ATA_COMPUTE
    lacc += __shfl_xor(lacc, 32);
    if (hi == 0) lq[r32] = lacc;
    asm volatile("s_waitcnt lgkmcnt(0)" ::: "memory");
#pragma unroll
    for (int rr = 0; rr < 16; ++rr) {
        const int q = crow(rr, hi); const float inv = 1.f / lq[q];
        const size_t off = (tokq + q) * 512 + hq * 64 + r32;
        const float g0 = bf2f(GA[off]), g1 = bf2f(GA[off + 32]);
        QA[off] = (bf16_t)(pk2(o0[rr] * inv * g0, 0.f) & 0xffffu);
        QA[off + 32] = (bf16_t)(pk2(o1[rr] * inv * g1, 0.f) & 0xffffu);
    }
}

__device__ void attn_b_item(const Params& p, int item, int l, unsigned char* smem) {
    int tid_ = VTID; asm volatile("" : "+v"(tid_));
    const int tid = tid_, lane = tid & 63, w = tid >> 6, r32 = lane & 31, hi = lane >> 5;
    const int blk = item & 63, j = (item >> 6) & 3, bg = item >> 8, g = bg % 3, b = bg / 3;
    const int sh = 2 * g, dil = 1 << sh, Mlen = SEQ >> sh;
    bf16_t* Ks = (bf16_t*)(smem + AT_KS); unsigned char* Vs = smem + AT_VS; float* lq = (float*)(smem + AT_LQ) + w * 32; float* lut = (float*)(smem + AT_LUT);
    bf16_t* QB = (bf16_t*)(p.ws + WS_QB) + (size_t)bg * SEQ * 256 + j * 64;
    const bf16_t* KB = (const bf16_t*)(p.ws + WS_KB) + (size_t)bg * SEQ * 256 + j * 64;
    const bf16_t* VB = (const bf16_t*)(p.ws + WS_VB) + (size_t)bg * SEQ * 256 + j * 64;
    float* LSE = (float*)(p.ws + WS_LSE) + (size_t)bg * SEQ * 4 + j;
    const int p0r = blk * 128, seq_lo = (p0r / Mlen) * Mlen, seq_hi = seq_lo + Mlen;
    __syncthreads();
    if (tid < 129) {
        const int rel = tid - 64, n = (rel < 0 ? -rel : rel) * dil;
        int bk;
        if (n < 8) bk = n; else { bk = 8 + (n >= 15) + (n >= 27) + (n >= 50) + (n >= 91) + (n >= 166) + (n >= 305) + (n >= 559); }
        if (rel > 0) bk += 16;
        lut[tid] = p.rel_bias[bk * 12 + g * 4 + j] * LOG2E;
    }
    const int qpos = p0r + w * 32 + r32;
    bf16x8 qr[4];
#pragma unroll
    for (int ds = 0; ds < 4; ++ds) qr[ds] = *(const bf16x8*)(QB + (size_t)qpos * 256 + ds * 16 + hi * 8);
    const float nshift = -((const float*)(p.ws + WS_BND))[2 + l];
    f32x16 o0, o1;
#pragma unroll
    for (int i = 0; i < 16; ++i) { o0[i] = 0.f; o1[i] = 0.f; }
    float lacc = 0.f;
    u32x4 rk[2], rv[2];
    for (int kt = 0; kt < 4; ++kt) {
        const int kbase = p0r - 64 + 64 * kt;
#pragma unroll
        for (int i = 0; i < 2; ++i) { const int c = tid + 256 * i, row = c >> 3, ch = c & 7;
            int pr = kbase + row; pr = pr < 0 ? 0 : (pr > SEQ - 1 ? SEQ - 1 : pr);
            rk[i] = *(const u32x4*)(KB + (size_t)pr * 256 + ch * 8); rv[i] = *(const u32x4*)(VB + (size_t)pr * 256 + ch * 8); }
        __syncthreads();
        AT_STAGE_STORE();
        __syncthreads();
        f32x16 p0, p1;
#pragma unroll
        for (int i = 0; i < 16; ++i) { p0[i] = nshift; p1[i] = nshift; }
        at_qk(p0, p1, Ks, qr, r32, hi);
#pragma unroll
        for (int i = 0; i < 16; ++i) {
            const int kv0 = kbase + crow(i, hi), kv1 = kv0 + 32;
            const int rel0 = kv0 - qpos, rel1 = kv1 - qpos;
            const bool ok0 = rel0 >= -64 && rel0 <= 64 && kv0 >= seq_lo && kv0 < seq_hi;
            const bool ok1 = rel1 >= -64 && rel1 <= 64 && kv1 >= seq_lo && kv1 < seq_hi;
            const float e0 = __builtin_amdgcn_exp2f(p0[i] + lut[ok0 ? rel0 + 64 : 64]);
            const float e1 = __builtin_amdgcn_exp2f(p1[i] + lut[ok1 ? rel1 + 64 : 64]);
            p0[i] = ok0 ? e0 : 0.f; p1[i] = ok1 ? e1 : 0.f; lacc += p0[i] + p1[i];
        }
        at_pv(o0, o1, p0, p1, Vs, lane);
    }
    lacc += __shfl_xor(lacc, 32);
    if (hi == 0) { lq[r32] = lacc; LSE[(size_t)qpos * 4] = (-nshift + log2f(lacc)) * LN2; }
    asm volatile("s_waitcnt lgkmcnt(0)" ::: "memory");
#pragma unroll
    for (int rr = 0; rr < 16; ++rr) {
        const int q = crow(rr, hi); const float inv = 1.f / lq[q];
        const size_t off = (size_t)(p0r + w * 32 + q) * 256 + r32;
        QB[off] = (bf16_t)(pk2(o0[rr] * inv, 0.f) & 0xffffu);
        QB[off + 32] = (bf16_t)(pk2(o1[rr] * inv, 0.f) & 0xffffu);
    }
}

__device__ void conv_phase(const Params& p, int l) {
    int tx_ = threadIdx.x; asm volatile("" : "+v"(tx_));
    const bf16_t* XBC = (const bf16_t*)(p.ws + WS_XBC);
    bf16_t* XC = (bf16_t*)(p.ws + WS_XBCC);
    const float* cw = p.conv_w + (size_t)l * 5 * 1024; const float* cb = p.conv_b + l * 1024;
    const int nthr = gridDim.x * 512;
    for (int u = blockIdx.x * 512 + tx_; u < (TP / 4) * 128; u += nthr) {
        const int ch = (u & 127) * 8, tg = u >> 7, tok0 = tg * 4, tt0 = tok0 & (SEQ - 1);
        u32x4 raw[8];
#pragma unroll
        for (int r = 0; r < 8; ++r) { const int tt = tt0 - 2 + r; raw[r] = (u32x4){0u, 0u, 0u, 0u};
            if (tt >= 0 && tt < SEQ) raw[r] = *(const u32x4*)(XBC + (size_t)(tok0 - 2 + r) * 1024 + ch); }
        float ac[4][8];
        { const f32x4 a = *(const f32x4*)(cb + ch), b2 = *(const f32x4*)(cb + ch + 4);
#pragma unroll
          for (int t = 0; t < 4; ++t) { ac[t][0] = a.x; ac[t][1] = a.y; ac[t][2] = a.z; ac[t][3] = a.w; ac[t][4] = b2.x; ac[t][5] = b2.y; ac[t][6] = b2.z; ac[t][7] = b2.w; } }
#pragma unroll
        for (int k = 0; k < 5; ++k) { const f32x4 wa = *(const f32x4*)(cw + k * 1024 + ch), wb = *(const f32x4*)(cw + k * 1024 + ch + 4);
#pragma unroll
            for (int t = 0; t < 4; ++t) { const u32x4 v = raw[t + k];
                ac[t][0] += bflo(v.x) * wa.x; ac[t][1] += bfhi(v.x) * wa.y; ac[t][2] += bflo(v.y) * wa.z; ac[t][3] += bfhi(v.y) * wa.w;
                ac[t][4] += bflo(v.z) * wb.x; ac[t][5] += bfhi(v.z) * wb.y; ac[t][6] += bflo(v.w) * wb.z; ac[t][7] += bfhi(v.w) * wb.w; } }
#pragma unroll
        for (int t = 0; t < 4; ++t) { u32x4 o;
            o.x = pk2(siluf(ac[t][0]), siluf(ac[t][1])); o.y = pk2(siluf(ac[t][2]), siluf(ac[t][3])); o.z = pk2(siluf(ac[t][4]), siluf(ac[t][5])); o.w = pk2(siluf(ac[t][6]), siluf(ac[t][7]));
            *(u32x4*)(XC + (size_t)(tok0 + t) * 1024 + ch) = o; }
    }
}

constexpr int SS_BS = 0, SS_CS = 8704, SS_XS = 17408, SS_XWS = 22016, SS_GS = 26624, SS_SB = 29184, SS_CW = 46592, SS_SC = 54272, SS_DTA = 55296, SS_END = 57344;

template <int PASS>
__device__ void ssd_item(const Params& p, int item, int l, unsigned char* smem) {
    int tid_ = VTID; asm volatile("" : "+v"(tid_));
    const int tid = tid_, lane = tid & 63, w = tid >> 6, idx = lane & 15, kq = lane >> 4;
    const int seg = item & 15, h = (item >> 4) & 7, dir = (item >> 7) & 1, b = item >> 8, grp = h >> 2;
    bf16_t* Bs = (bf16_t*)(smem + SS_BS); bf16_t* Cs = (bf16_t*)(smem + SS_CS); bf16_t* Xs = (bf16_t*)(smem + SS_XS); bf16_t* Xws = (bf16_t*)(smem + SS_XWS);
    bf16_t* Gs = (bf16_t*)(smem + SS_GS); bf16_t* Sb = (bf16_t*)(smem + SS_SB); float* cwl = (float*)(smem + SS_CW); float* sc = (float*)(smem + SS_SC);
    float* s_dt = sc, *s_c = sc + 32, *s_rs = sc + 64, *s_wl = sc + 96, *s_tot = sc + 128;
    const bf16_t* XBC = (const bf16_t*)(p.ws + WS_XBC);
    const float* DT = (const float*)(p.ws + WS_DT);
    float* ST = (float*)(p.ws + WS_ST); float* SEGT = (float*)(p.ws + WS_SEGT);
    bf16_t* Y = (bf16_t*)(p.ws + (dir ? WS_YS : WS_YF));
    const float Aneg = -__expf(p.a_log[l * 16 + dir * 8 + h]);
    const float Dh = p.d_skip[l * 8 + h];
    __syncthreads();
    f32x4 S[8];
#pragma unroll
    for (int nt = 0; nt < 8; ++nt) S[nt] = (f32x4){0.f, 0.f, 0.f, 0.f};
    const int ibase = item & ~15;
    if (PASS == 3) {
        if (dir == 0) {
            for (int e = 0; e < seg; ++e) { const float dc = __expf(SEGT[ibase + e]); const f32x4* src = (const f32x4*)(ST + (size_t)(ibase + e) * 8192);
#pragma unroll
                for (int nt = 0; nt < 8; ++nt) S[nt] = S[nt] * dc + src[(w * 8 + nt) * 64 + lane]; }
        } else {
            for (int e = NSEG - 1; e > seg; --e) { const float dc = __expf(SEGT[ibase + e]); const f32x4* src = (const f32x4*)(ST + (size_t)(ibase + e) * 8192);
#pragma unroll
                for (int nt = 0; nt < 8; ++nt) S[nt] = S[nt] * dc + src[(w * 8 + nt) * 64 + lane]; }
        }
#pragma unroll
        for (int nt = 0; nt < 8; ++nt) st4bf(Sb + (16 * w + idx) * 136 + 16 * nt + 4 * kq, S[nt]);
    }
    float* s_dta = (float*)(smem + SS_DTA);
    for (int e = tid; e < SEGLEN; e += 256) s_dta[e] = DT[((size_t)b * SEQ + seg * SEGLEN + e) * 16 + dir * 8 + h];
    float segtot = 0.f;
    const size_t tokb = (size_t)b * SEQ;
    const unsigned char* xb_ = (const unsigned char*)((const bf16_t*)(p.ws + WS_XBCC) + tokb * 1024);
    unsigned soff[5];
#pragma unroll
    for (int i = 0; i < 5; ++i) { const int u = tid + 256 * i, lrow = u / 40, ci = u % 40;
        const int scol = ci < 8 ? h * 64 + ci * 8 : (ci < 24 ? 512 + grp * 128 + (ci * 8 - 64) : 768 + grp * 128 + (ci * 8 - 192));
        soff[i] = (unsigned)((lrow * 1024 + scol) * 2); }
    for (int si = 0; si < NSUB; ++si) {
        const int scn = dir ? (NSUB - 1 - si) : si;
        const int t0 = seg * SEGLEN + scn * TSUB;
        __syncthreads();
        u32x4 raw[5];
#pragma unroll
        for (int i = 0; i < 5; ++i) raw[i] = *(const u32x4*)(xb_ + ((unsigned)(t0 * 2048) + soff[i]));
        if (w == 0) {
            float dtv = 0.f, av = 0.f;
            if (lane < 32) { dtv = s_dta[scn * TSUB + lane]; av = dtv * Aneg; }
            float pre = av;
#pragma unroll
            for (int o = 1; o < 32; o <<= 1) { const float t = __shfl_up(pre, o); if (lane >= o) pre += t; }
            const float tot = __shfl(pre, 31);
            const float cc = dir ? (tot - pre + av) : pre;
            if (lane < 32) { s_dt[lane] = dtv; s_c[lane] = cc; s_rs[lane] = __expf(cc); s_wl[lane] = dtv * __expf(tot - cc); }
            if (lane == 0) s_tot[0] = tot;
        }
        __syncthreads();
        segtot += s_tot[0];
#pragma unroll
        for (int i = 0; i < 5; ++i) { const int u = tid + 256 * i, lrow = u / 40, ci = u % 40, lc = ci * 8; const u32x4 o = raw[i];
            if (ci < 8) { *(u32x4*)(Xs + lrow * 72 + lc) = o; const float wl = s_wl[lrow];
                u32x4 o2; o2.x = pk2(bflo(o.x) * wl, bfhi(o.x) * wl); o2.y = pk2(bflo(o.y) * wl, bfhi(o.y) * wl); o2.z = pk2(bflo(o.z) * wl, bfhi(o.z) * wl); o2.w = pk2(bflo(o.w) * wl, bfhi(o.w) * wl);
                *(u32x4*)(Xws + lrow * 72 + lc) = o2; }
            else if (ci < 24) *(u32x4*)(Bs + lrow * 136 + (lc - 64)) = o;
            else *(u32x4*)(Cs + lrow * 136 + (lc - 192)) = o; }
        __syncthreads();
        if (PASS == 3) {
            const int it = w >> 1, jt = w & 1;
            f32x4 cb = (f32x4){0.f, 0.f, 0.f, 0.f};
            {
                bf16x8 fb[4], fc[4];
#pragma unroll
                for (int ks = 0; ks < 4; ++ks) { fb[ks] = *(const bf16x8*)(Bs + (16 * jt + idx) * 136 + ks * 32 + kq * 8); fc[ks] = *(const bf16x8*)(Cs + (16 * it + idx) * 136 + ks * 32 + kq * 8); }
                __builtin_amdgcn_sched_barrier(0);
#pragma unroll
                for (int ks = 0; ks < 4; ++ks) cb = __builtin_amdgcn_mfma_f32_16x16x32_bf16(fb[ks], fc[ks], cb, 0, 0, 0);
                __builtin_amdgcn_sched_barrier(0);
            }
            {
                const int ii = 16 * it + idx; const float ci_ = s_c[ii];
                f32x4 gv;
#pragma unroll
                for (int rg = 0; rg < 4; ++rg) {
                    const int jj = 16 * jt + 4 * kq + rg;
                    const bool ok = dir ? (jj >= ii) : (jj <= ii);
                    const float e = __expf(ci_ - s_c[jj]) * s_dt[jj];
                    gv[rg] = ok ? cb[rg] * e : 0.f;
                }
                st4bf(Gs + ii * 40 + 16 * jt + 4 * kq, gv);
            }
            __syncthreads();
            const unsigned char* xtr = (const unsigned char*)Xs + (8 * kq + (idx >> 2)) * 144 + (16 * w + 4 * (idx & 3)) * 2;
            const bf16x8 xf = cat8(tr16(xtr), tr16(xtr + 4 * 144));
#pragma unroll 1
            for (int it2 = 0; it2 < 2; ++it2) {
                const int ii = 16 * it2 + idx;
                const bf16x8 gf = *(const bf16x8*)(Gs + ii * 40 + 8 * kq);
                f32x4 yd = (f32x4){0.f, 0.f, 0.f, 0.f}, yo = (f32x4){0.f, 0.f, 0.f, 0.f};
                bf16x8 sf[4], cf[4];
#pragma unroll
                for (int ks = 0; ks < 4; ++ks) { sf[ks] = *(const bf16x8*)(Sb + (16 * w + idx) * 136 + ks * 32 + kq * 8); cf[ks] = *(const bf16x8*)(Cs + ii * 136 + ks * 32 + kq * 8); }
                __builtin_amdgcn_sched_barrier(0);
                yd = __builtin_amdgcn_mfma_f32_16x16x32_bf16(xf, gf, yd, 0, 0, 0);
#pragma unroll
                for (int ks = 0; ks < 4; ++ks) yo = __builtin_amdgcn_mfma_f32_16x16x32_bf16(sf[ks], cf[ks], yo, 0, 0, 0);
                __builtin_amdgcn_sched_barrier(0);
                f32x4 y = yd + yo * s_rs[ii];
                if (dir == 0) { const u32x2 xv = *(const u32x2*)(Xs + ii * 72 + 16 * w + 4 * kq);
                    y.x += Dh * bflo(xv.x); y.y += Dh * bfhi(xv.x); y.z += Dh * bflo(xv.y); y.w += Dh * bfhi(xv.y); }
                st4bf(Y + (tokb + t0 + ii) * 512 + h * 64 + 16 * w + 4 * kq, y);
            }
        }
        {
            const float dc = __expf(s_tot[0]);
            const unsigned char* xw = (const unsigned char*)Xws + (8 * kq + (idx >> 2)) * 144 + (16 * w + 4 * (idx & 3)) * 2;
            const bf16x8 xwf = cat8(tr16(xw), tr16(xw + 4 * 144));
            bf16x8 bfv[8];
#pragma unroll
            for (int nt = 0; nt < 8; ++nt) {
                const unsigned char* bt = (const unsigned char*)Bs + (8 * kq + (idx >> 2)) * 272 + (16 * nt + 4 * (idx & 3)) * 2;
                bfv[nt] = cat8(tr16(bt), tr16(bt + 4 * 272));
            }
            __builtin_amdgcn_sched_barrier(0);
#pragma unroll
            for (int nt = 0; nt < 8; ++nt) S[nt] = __builtin_amdgcn_mfma_f32_16x16x32_bf16(bfv[nt], xwf, S[nt] * dc, 0, 0, 0);
            __builtin_amdgcn_sched_barrier(0);
            if (PASS == 3) {
#pragma unroll
                for (int nt = 0; nt < 8; ++nt) st4bf(Sb + (16 * w + idx) * 136 + 16 * nt + 4 * kq, S[nt]);
            }
        }
    }
    if (PASS == 1) {
        f32x4* dst = (f32x4*)(ST + (size_t)item * 8192);
#pragma unroll
        for (int nt = 0; nt < 8; ++nt) dst[(w * 8 + nt) * 64 + lane] = S[nt];
        if (tid == 0) SEGT[item] = segtot;
    }
}

__device__ void post2_phase(const Params& p) {
    int tx_ = threadIdx.x; asm volatile("" : "+v"(tx_));
    const int lane = tx_ & 63, gw = blockIdx.x * 8 + (tx_ >> 6), nw = gridDim.x * 8;
    const bf16_t* OB = (const bf16_t*)(p.ws + WS_QB); const float* LSE = (const float*)(p.ws + WS_LSE);
    const bf16_t* GB = (const bf16_t*)(p.ws + WS_GB);
    bf16_t* YBM = (bf16_t*)(p.ws + WS_YBM);
    const bf16_t* YF = (const bf16_t*)(p.ws + WS_YF); const bf16_t* YS = (const bf16_t*)(p.ws + WS_YS); const bf16_t* ZS = (const bf16_t*)(p.ws + WS_ZS);
    bf16_t* YC = (bf16_t*)(p.ws + WS_YC); float* RS = (float*)(p.ws + WS_RSTD);
    for (int row = gw; row < TP; row += nw) {
        const int bl = row >> 13, tt = row & (SEQ - 1), j = lane >> 4;
        float ls[3]; size_t ro[3];
#pragma unroll
        for (int g = 0; g < 3; ++g) { const int sh = 2 * g; const int pp = (tt & ((1 << sh) - 1)) * (SEQ >> sh) + (tt >> sh);
            ro[g] = (size_t)(bl * 3 + g) * SEQ + pp; ls[g] = LSE[ro[g] * 4 + j]; }
        const float mx = fmaxf(ls[0], fmaxf(ls[1], ls[2]));
        float wg[3]; float ws = 0.f;
#pragma unroll
        for (int g = 0; g < 3; ++g) { wg[g] = __expf(ls[g] - mx); ws += wg[g]; }
        const float inv = 1.f / ws;
        f32x4 acc = (f32x4){0.f, 0.f, 0.f, 0.f};
#pragma unroll
        for (int g = 0; g < 3; ++g) { const u32x2 v = *(const u32x2*)(OB + ro[g] * 256 + 4 * lane); const float wv = wg[g] * inv;
            acc.x += wv * bflo(v.x); acc.y += wv * bfhi(v.x); acc.z += wv * bflo(v.y); acc.w += wv * bfhi(v.y); }
        { const u32x2 gt = *(const u32x2*)(GB + (size_t)row * 256 + 4 * lane);
          acc.x *= bflo(gt.x); acc.y *= bfhi(gt.x); acc.z *= bflo(gt.y); acc.w *= bfhi(gt.y); }
        st4bf(YBM + (size_t)row * 256 + 4 * lane, acc);
        const u32x4 a = *(const u32x4*)(YF + (size_t)row * 512 + 8 * lane), bq = *(const u32x4*)(YS + (size_t)row * 512 + 8 * lane), z = *(const u32x4*)(ZS + (size_t)row * 512 + 8 * lane);
        float y[8];
        y[0] = (bflo(a.x) + bflo(bq.x)) * bflo(z.x); y[1] = (bfhi(a.x) + bfhi(bq.x)) * bfhi(z.x);
        y[2] = (bflo(a.y) + bflo(bq.y)) * bflo(z.y); y[3] = (bfhi(a.y) + bfhi(bq.y)) * bfhi(z.y);
        y[4] = (bflo(a.z) + bflo(bq.z)) * bflo(z.z); y[5] = (bfhi(a.z) + bfhi(bq.z)) * bfhi(z.z);
        y[6] = (bflo(a.w) + bflo(bq.w)) * bflo(z.w); y[7] = (bfhi(a.w) + bfhi(bq.w)) * bfhi(z.w);
        float ss = 0.f;
#pragma unroll
        for (int e = 0; e < 8; ++e) ss += y[e] * y[e];
        ss = wave_sum(ss);
        u32x4 o; o.x = pk2(y[0], y[1]); o.y = pk2(y[2], y[3]); o.z = pk2(y[4], y[5]); o.w = pk2(y[6], y[7]);
        *(u32x4*)(YC + (size_t)row * 512 + 8 * lane) = o;
        if (lane == 0) RS[row] = rsqrtf(ss * (1.f / 512.f) + EPS);
    }
}


#define XB_TMO      128
#define XB_XCNT(j)  (256  + 64 * (j))
#define XB_XSUB(j)  (1280 + 64 * (j))
#define XB_XGEN(j)  (2304 + 64 * (j))
#define XB_TOP      3328
#define XB_TOPGEN   3392
#define XCD_BAR_WORDS 3456
#define XB_SPIN_CAP (1u << 20)
__device__ __forceinline__ unsigned xb_ld(unsigned* p)              { return __hip_atomic_load(p, __ATOMIC_RELAXED, __HIP_MEMORY_SCOPE_AGENT); }
__device__ __forceinline__ unsigned xb_add(unsigned* p, unsigned v) { return __hip_atomic_fetch_add(p, v, __ATOMIC_RELAXED, __HIP_MEMORY_SCOPE_AGENT); }
__device__ __forceinline__ unsigned xb_xcc_id() { return (unsigned)__builtin_amdgcn_s_getreg((3 << 11) | 20) & 0xFu; }
#define XB_SPIN(cond, bar) do { unsigned _sp = 0; while (cond) { __builtin_amdgcn_s_sleep(1); \
    if ((++_sp & 255u) == 0u) { if (xb_ld(&(bar)[XB_TMO])) break; if (_sp > XB_SPIN_CAP) { atomicAdd(&(bar)[XB_TMO], 1u); break; } } } } while (0)
struct XcdBarrier { unsigned* bar; unsigned x; volatile LDSAS unsigned* st; };
__device__ __forceinline__ XcdBarrier xcd_barrier_post(unsigned* bar, volatile LDSAS unsigned* st) {
    XcdBarrier b; b.bar = bar; b.x = xb_xcc_id(); b.st = st;
    if (threadIdx.x == 0) (void)xb_add(&bar[XB_XCNT(b.x)], 1u);
    return b;
}
__device__ __forceinline__ void xcd_barrier_complete(unsigned* bar, unsigned x, unsigned& nloc, unsigned& nx) {
    const unsigned G = gridDim.x * gridDim.y * gridDim.z;
    unsigned sum, cnt, mine, sp = 0u;
    for (;;) {
        sum = 0u; cnt = 0u; mine = 0u;
#pragma unroll
        for (unsigned j = 0; j < 16; ++j) { const unsigned c = xb_ld(&bar[XB_XCNT(j)]); sum += c; cnt += (c > 0u) ? 1u : 0u; mine = (j == x) ? c : mine; }
        if (sum == G) break;
        __builtin_amdgcn_s_sleep(1);
        if ((++sp & 255u) == 0u) { if (xb_ld(&bar[XB_TMO])) break; if (sp > XB_SPIN_CAP) { atomicAdd(&bar[XB_TMO], 1u); break; } }
    }
    nloc = mine > 0u ? mine : 1u; nx = cnt > 0u ? cnt : 1u;
}
__device__ __forceinline__ void xcd_barrier(const XcdBarrier& b) {
    asm volatile("s_waitcnt vmcnt(0)" ::: "memory");
    __syncthreads();
    if (threadIdx.x == 0) {
        unsigned* bar = b.bar;
        __builtin_amdgcn_s_waitcnt(0);
        unsigned nloc = b.st[0], nx = b.st[1];
        if (nloc == 0u) { xcd_barrier_complete(bar, b.x, nloc, nx); b.st[0] = nloc; b.st[1] = nx; }
        const unsigned old = xb_add(&bar[XB_XSUB(b.x)], 1u);
        const unsigned gen = old / nloc;
        if (old + 1u == (gen + 1u) * nloc) {
            __builtin_amdgcn_fence(__ATOMIC_RELEASE, "agent");
            asm volatile("s_waitcnt vmcnt(0)" ::: "memory");
            const unsigned og = xb_add(&bar[XB_TOP], 1u);
            const unsigned tg = og / nx;
            if (og + 1u == (tg + 1u) * nx) xb_add(&bar[XB_TOPGEN], 1u);
            else XB_SPIN(xb_ld(&bar[XB_TOPGEN]) == tg, bar);
            __builtin_amdgcn_fence(__ATOMIC_ACQUIRE, "agent");
            xb_add(&bar[XB_XGEN(b.x)], 1u);
            asm volatile("s_waitcnt vmcnt(0)" ::: "memory");
        } else {
            XB_SPIN(xb_ld(&bar[XB_XGEN(b.x)]) == gen, bar);
            __builtin_amdgcn_fence(__ATOMIC_ACQUIRE, "agent");
            asm volatile("s_waitcnt vmcnt(0)" ::: "memory");
        }
    }
    __syncthreads();
}

__device__ __forceinline__ unsigned char* lds_half(unsigned char* smem) { int h_ = threadIdx.x >> 8; asm volatile("" : "+v"(h_)); return smem + h_ * HALF_LDS; }
__global__ void __launch_bounds__(512, 2) hybrid_fwd(Params p) {
    cg::grid_group grid = cg::this_grid();
    extern __shared__ __attribute__((aligned(16))) unsigned char smem[];
    volatile LDSAS unsigned* bst = (volatile LDSAS unsigned*)(smem + LDS_TOTAL - 16);
    if (threadIdx.x < 4) bst[threadIdx.x] = 0u;
    __syncthreads();
    const XcdBarrier xbar = xcd_barrier_post((unsigned*)(p.ws + WS_BAR), bst);
    { const Params q = launder(p); phase0(q, lds_half(smem)); }
    grid.sync();
#pragma unroll 1
    for (int l = 0; l < DEPTH; ++l) {
#pragma unroll 1
        for (int hb = 0; hb < 2; ++hb) {
            { const Params q = launder(p); norm_phase(q, l, hb, (l == 0) ? q.x : q.out); }
            xcd_barrier(xbar);
            { const Params q = launder(p); gemm1_phase(q, l, hb, smem); }
            xcd_barrier(xbar);
            { const Params q = launder(p); conv_phase(q, l); }
            xcd_barrier(xbar);
            { const Params q = launder(p); unsigned char* smh = lds_half(smem);
#pragma unroll 1
              for (int it = VBLK; it < 512 + 1536; it += VGRID) { if (it < 512) ssd_item<1>(q, it, l, smh); else attn_b_item(q, it - 512, l, smh); } }
            xcd_barrier(xbar);
            { const Params q = launder(p); unsigned char* smh = lds_half(smem);
#pragma unroll 1
              for (int it = VBLK; it < 1024 + 512; it += VGRID) { if (it < 1024) attn_a_item(q, it, l, smh); else ssd_item<3>(q, it - 1024, l, smh); } }
            xcd_barrier(xbar);
            { const Params q = launder(p); post2_phase(q); }
            xcd_barrier(xbar);
            { const Params q = launder(p); merge_phase(q, l, smem); }
            xcd_barrier(xbar);
            { const Params q = launder(p); out_phase(q, l, hb, (l == 0) ? q.x : q.out, smem); }
        }
    }
}

extern "C" void kernel_launch(void* const* d_in, const int* in_sizes, int n_in, void* d_out, int out_size, void* d_ws, size_t ws_size, hipStream_t stream) {
    static int grid_blocks = 0;
    if (!grid_blocks) {
        int dev = 0, cus = 0, per_cu = 0;
        hipGetDevice(&dev);
        hipDeviceGetAttribute(&cus, hipDeviceAttributeMultiprocessorCount, dev);
        hipFuncSetAttribute((const void*)hybrid_fwd, hipFuncAttributeMaxDynamicSharedMemorySize, LDS_TOTAL);
        hipOccupancyMaxActiveBlocksPerMultiprocessor(&per_cu, hybrid_fwd, 512, LDS_TOTAL);
        if (per_cu > 1) per_cu = 1;
        if (per_cu < 1) per_cu = 1;
        grid_blocks = cus * per_cu;
    }
    Params p{};
    const float** pp = (const float**)&p;
    for (int i = 0; i < 22; ++i) pp[i] = (const float*)d_in[i];
    p.out = (float*)d_out; p.ws = (unsigned char*)d_ws;
    hipMemsetAsync((unsigned char*)d_ws + WS_BAR, 0, XCD_BAR_WORDS * 4, stream);
    void* args[] = {&p};
    hipError_t e = hipLaunchCooperativeKernel((void*)hybrid_fwd, dim3(grid_blocks), dim3(512), args, LDS_TOTAL, stream);
    if (e != hipSuccess) fprintf(stderr, "cooperative launch failed: %s (grid %d)\n", hipGetErrorString(e), grid_blocks);
}
```

```cpp
#include <hip/hip_runtime.h>
#include <hip/hip_cooperative_groups.h>
#include <cstdint>
#include <cstdio>
namespace cg = cooperative_groups;

typedef unsigned short bf16_t;
typedef short bf16x8 __attribute__((ext_vector_type(8)));
typedef short v4i16 __attribute__((ext_vector_type(4)));
typedef float f32x2 __attribute__((ext_vector_type(2)));
typedef float f32x4 __attribute__((ext_vector_type(4)));
typedef float f32x16 __attribute__((ext_vector_type(16)));
typedef unsigned u32x2 __attribute__((ext_vector_type(2)));
typedef unsigned u32x4 __attribute__((ext_vector_type(4)));
typedef __bf16 bf16x2_t __attribute__((ext_vector_type(2)));
#define LDSAS __attribute__((address_space(3)))
#define VTID ((int)(threadIdx.x & 255u))
__device__ __forceinline__ int vblk_() { int h_ = threadIdx.x >> 8; asm volatile("" : "+v"(h_)); return __builtin_amdgcn_readfirstlane(2 * (int)blockIdx.x + h_); }
#define VBLK vblk_()
#define VGRID ((int)(2u * gridDim.x))
constexpr int HALF_LDS = 73728, LDS_TOTAL = 147456;

constexpr int SEQ = 8192, DM = 1024, NBATCH = 4, NBH = 2, TP = NBH * SEQ, DEPTH = 2;
constexpr int NP = 8704;
constexpr float EPS = 1e-6f;
constexpr float LOG2E = 1.4426950408889634f, LN2 = 0.6931471805599453f;
constexpr int NSEG = 16, SEGLEN = 512, TSUB = 32, NSUB = SEGLEN / TSUB;

constexpr size_t MiB = 1u << 20;
constexpr size_t WS_WIN = 0;
constexpr size_t WS_WPA = 34 * MiB;
constexpr size_t WS_WPB = 36 * MiB;
constexpr size_t WS_WPC = 37 * MiB;
constexpr size_t WS_WOUT = 39 * MiB;
constexpr size_t WS_MOD = 43 * MiB;
constexpr size_t WS_ROPE = 43 * MiB + 128 * 1024;
constexpr size_t WS_BND = 43 * MiB + 160 * 1024;
constexpr size_t WS_RSTD = 43 * MiB + 256 * 1024;
constexpr size_t WS_SEGT = 43 * MiB + 512 * 1024;
constexpr size_t WS_LSE = 44 * MiB;
constexpr size_t WS_DT = 45 * MiB;
constexpr size_t WS_BAR = 46 * MiB;
constexpr size_t WS_H = 48 * MiB;
constexpr size_t WS_QA = 80 * MiB;
constexpr size_t WS_KA = 96 * MiB;
constexpr size_t WS_VA = 100 * MiB;
constexpr size_t WS_GA = 104 * MiB;
constexpr size_t WS_QB = 120 * MiB;
constexpr size_t WS_KB = 144 * MiB;
constexpr size_t WS_VB = 168 * MiB;
constexpr size_t WS_GB = 192 * MiB;
constexpr size_t WS_XBC = 200 * MiB;
constexpr size_t WS_ZS = 232 * MiB;
constexpr size_t WS_MG = 248 * MiB;
constexpr size_t WS_YF = 344 * MiB;
constexpr size_t WS_YS = 360 * MiB;
constexpr size_t WS_YBM = 376 * MiB;
constexpr size_t WS_YC = 384 * MiB;
constexpr size_t WS_MRG = 400 * MiB;
constexpr size_t WS_ST = 432 * MiB;
constexpr size_t WS_XBCC = 448 * MiB;

struct Params {
    const float *x, *c, *norm_w, *w_ada, *b_ada, *w_in, *b_gate, *q_norm_a, *k_norm_a, *q_norm_b, *k_norm_b, *rel_bias,
        *conv_w, *conv_b, *a_log, *dt_bias, *d_skip, *ssm_norm_w, *w_proj_a, *w_proj_b, *w_proj_c, *w_out;
    float* out;
    unsigned char* ws;
};


#define AS1 __attribute__((address_space(1)))
#define GLOBF(f) do { AS1 const float* g_ = (AS1 const float*)p.f; asm volatile("" : "+s"(g_)); q.f = (const float*)g_; } while (0)
__device__ __forceinline__ Params launder(const Params& p) {
    Params q;
    GLOBF(x); GLOBF(c); GLOBF(norm_w); GLOBF(w_ada); GLOBF(b_ada); GLOBF(w_in); GLOBF(b_gate); GLOBF(q_norm_a); GLOBF(k_norm_a); GLOBF(q_norm_b); GLOBF(k_norm_b); GLOBF(rel_bias);
    GLOBF(conv_w); GLOBF(conv_b); GLOBF(a_log); GLOBF(dt_bias); GLOBF(d_skip); GLOBF(ssm_norm_w); GLOBF(w_proj_a); GLOBF(w_proj_b); GLOBF(w_proj_c); GLOBF(w_out);
    { AS1 float* g_ = (AS1 float*)p.out; asm volatile("" : "+s"(g_)); q.out = (float*)g_; }
    { AS1 unsigned char* g_ = (AS1 unsigned char*)p.ws; asm volatile("" : "+s"(g_)); q.ws = (unsigned char*)g_; }
    return q;
}
__device__ __forceinline__ unsigned pk2(float lo, float hi) { f32x2 v = {lo, hi}; bf16x2_t b = __builtin_convertvector(v, bf16x2_t); return __builtin_bit_cast(unsigned, b); }
__device__ __forceinline__ float bf2f(unsigned short b) { return __uint_as_float(((unsigned)b) << 16); }
__device__ __forceinline__ float bflo(unsigned u) { return __uint_as_float(u << 16); }
__device__ __forceinline__ float bfhi(unsigned u) { return __uint_as_float(u & 0xffff0000u); }
__device__ __forceinline__ float siluf(float v) { return v * __builtin_amdgcn_rcpf(1.f + __builtin_amdgcn_exp2f(-1.4426950408889634f * v)); }
__device__ __forceinline__ float sigmf(float v) { return __builtin_amdgcn_rcpf(1.f + __builtin_amdgcn_exp2f(-1.4426950408889634f * v)); }
__device__ __forceinline__ float wave_sum(float v) {
#pragma unroll
    for (int o = 1; o < 64; o <<= 1) v += __shfl_xor(v, o);
    return v;
}
__device__ __forceinline__ v4i16 tr16(const unsigned char* p) { return __builtin_amdgcn_ds_read_tr16_b64_v4i16((LDSAS v4i16*)p); }
__device__ __forceinline__ bf16x8 cat8(v4i16 a, v4i16 b) { return (bf16x8){a[0], a[1], a[2], a[3], b[0], b[1], b[2], b[3]}; }
__device__ __forceinline__ int crow(int r, int hi) { return (r & 3) + 8 * (r >> 2) + 4 * hi; }

__device__ __forceinline__ void p0_transpose(const float* __restrict__ W, int ldw, int K, bf16_t* __restrict__ Wt, int k0, int n0, int mode,
                                             const float* __restrict__ rowscale, float* tile) {
    const int tid = VTID, tx = tid & 63, ty = tid >> 6;
    const int np = n0 + tx; int n = np; bool valid = true;
    if (mode == 1) {
        if (np < 4352) n = np; else if (np < 4864) n = np + 512; else if (np < 5376) n = np - 512;
        else if (np < 8448) n = np + 16; else if (np < 8464) n = np - 3072; else { valid = false; n = 0; }
    }
#pragma unroll 4
    for (int i = 0; i < 16; ++i) {
        const int k = ty + 4 * i; float v = valid ? W[(size_t)(k0 + k) * ldw + n] : 0.f;
        if (rowscale) v *= rowscale[k0 + k];
        tile[k * 65 + tx] = v;
    }
    __syncthreads();
    const int r = tid >> 2, kc = (tid & 3) * 16;
    u32x4 o0, o1;
    o0.x = pk2(tile[(kc + 0) * 65 + r], tile[(kc + 1) * 65 + r]); o0.y = pk2(tile[(kc + 2) * 65 + r], tile[(kc + 3) * 65 + r]);
    o0.z = pk2(tile[(kc + 4) * 65 + r], tile[(kc + 5) * 65 + r]); o0.w = pk2(tile[(kc + 6) * 65 + r], tile[(kc + 7) * 65 + r]);
    o1.x = pk2(tile[(kc + 8) * 65 + r], tile[(kc + 9) * 65 + r]); o1.y = pk2(tile[(kc + 10) * 65 + r], tile[(kc + 11) * 65 + r]);
    o1.z = pk2(tile[(kc + 12) * 65 + r], tile[(kc + 13) * 65 + r]); o1.w = pk2(tile[(kc + 14) * 65 + r], tile[(kc + 15) * 65 + r]);
    bf16_t* dst = Wt + (size_t)(n0 + r) * K + k0 + kc;
    *(u32x4*)dst = o0; *(u32x4*)(dst + 8) = o1;
    __syncthreads();
}

__device__ void phase0(const Params& p, unsigned char* smem) {
    const int tid = VTID;
    float* tile = (float*)smem;
    constexpr int I_IN = 16 * 136, I_PA = 8 * 16, I_PB = 4 * 16, I_PC = 8 * 16, I_OUT = 16 * 16, I_L = I_IN + I_PA + I_PB + I_PC + I_OUT;
    constexpr int I_T = 2 * I_L, I_MOD = 192, I_ALL = I_T + I_MOD + 1;
    for (int item = VBLK; item < I_ALL; item += VGRID) {
        if (item < I_T) {
            const int l = item / I_L; int r = item % I_L;
            if (r < I_IN) { const int kt = r / 136, nt = r % 136;
                p0_transpose(p.w_in + (size_t)l * 1024 * 8464, 8464, 1024, (bf16_t*)(p.ws + WS_WIN) + (size_t)l * NP * 1024, kt * 64, nt * 64, 1, nullptr, tile); continue; }
            r -= I_IN;
            if (r < I_PA) { const int kt = r / 16, nt = r % 16;
                p0_transpose(p.w_proj_a + (size_t)l * 512 * 1024, 1024, 512, (bf16_t*)(p.ws + WS_WPA) + (size_t)l * 1024 * 512, kt * 64, nt * 64, 0, nullptr, tile); continue; }
            r -= I_PA;
            if (r < I_PB) { const int kt = r / 16, nt = r % 16;
                p0_transpose(p.w_proj_b + (size_t)l * 256 * 1024, 1024, 256, (bf16_t*)(p.ws + WS_WPB) + (size_t)l * 1024 * 256, kt * 64, nt * 64, 0, nullptr, tile); continue; }
            r -= I_PB;
            if (r < I_PC) { const int kt = r / 16, nt = r % 16;
                p0_transpose(p.w_proj_c + (size_t)l * 512 * 1024, 1024, 512, (bf16_t*)(p.ws + WS_WPC) + (size_t)l * 1024 * 512, kt * 64, nt * 64, 0, p.ssm_norm_w + l * 512, tile); continue; }
            r -= I_PC;
            { const int kt = r / 16, nt = r % 16;
                p0_transpose(p.w_out + (size_t)l * 1024 * 1024, 1024, 1024, (bf16_t*)(p.ws + WS_WOUT) + (size_t)l * 1024 * 1024, kt * 64, nt * 64, 0, nullptr, tile); }
        } else if (item < I_T + I_MOD) {
            const int it = item - I_T, l = it / 96, col0 = (it % 96) * 32, cl = tid & 31, ks = tid >> 5;
            float a0 = 0.f, a1 = 0.f, a2 = 0.f, a3 = 0.f;
            const float* wp = p.w_ada + ((size_t)l * 1024 + ks * 128) * 3072 + col0 + cl;
#pragma unroll 8
            for (int k = 0; k < 128; ++k) {
                const float wv = wp[(size_t)k * 3072]; const int kk = ks * 128 + k;
                a0 += siluf(p.c[kk]) * wv; a1 += siluf(p.c[1024 + kk]) * wv; a2 += siluf(p.c[2048 + kk]) * wv; a3 += siluf(p.c[3072 + kk]) * wv;
            }
            float* red = (float*)smem;
            red[(ks * 32 + cl) * 4 + 0] = a0; red[(ks * 32 + cl) * 4 + 1] = a1; red[(ks * 32 + cl) * 4 + 2] = a2; red[(ks * 32 + cl) * 4 + 3] = a3;
            __syncthreads();
            if (tid < 128) { const int b = tid >> 5, c2 = tid & 31; float s = 0.f;
#pragma unroll
                for (int k = 0; k < 8; ++k) s += red[(k * 32 + c2) * 4 + b];
                ((float*)(p.ws + WS_MOD))[(l * 4 + b) * 3072 + col0 + c2] = s + p.b_ada[l * 3072 + col0 + c2]; }
            __syncthreads();
        } else {
            float* rc = (float*)(p.ws + WS_ROPE); float* rs = rc + 128 * 16;
            for (int e = tid; e < 2048; e += 256) {
                const int pos = e >> 4, i = e & 15;
                const float freq = powf(10000.0f, -(float)i / 16.0f);
                const float ang = (float)pos * freq;
                const double rev = (double)ang * 0.15915494309189535; const double fr = rev - rint(rev);
                const float a = (float)(fr * 6.283185307179586);
                rc[e] = cosf(a); rs[e] = sinf(a);
            }
            if (tid < 2) {
                const int l = tid; float mqa = 0.f, mka = 0.f, mqb = 0.f, mkb = 0.f, mb = 0.f;
                for (int i = 0; i < 64; ++i) { mqa = fmaxf(mqa, fabsf(p.q_norm_a[l * 64 + i])); mka = fmaxf(mka, fabsf(p.k_norm_a[l * 64 + i]));
                    mqb = fmaxf(mqb, fabsf(p.q_norm_b[l * 64 + i])); mkb = fmaxf(mkb, fabsf(p.k_norm_b[l * 64 + i])); }
                for (int i = 0; i < 32 * 12; ++i) mb = fmaxf(mb, p.rel_bias[i]);
                float* bd = (float*)(p.ws + WS_BND);
                bd[l] = 8.f * mqa * mka * LOG2E; bd[2 + l] = (8.f * mqb * mkb + mb) * LOG2E;
            }
        }
    }
}

__device__ void norm_phase(const Params& p, int l, int hb, const float* xsrc) {
    int tx_ = threadIdx.x; asm volatile("" : "+v"(tx_));
    const int lane = tx_ & 63, gw = blockIdx.x * 8 + (tx_ >> 6), nw = gridDim.x * 8;
    bf16_t* H = (bf16_t*)(p.ws + WS_H);
    const float* nwp = p.norm_w + l * 1024;
    for (int row = gw; row < TP; row += nw) {
        const size_t rg = (size_t)hb * TP + row; const int b = (int)(rg / SEQ);
        const f32x4* xr = (const f32x4*)(xsrc + rg * 1024);
        const float* md = (const float*)(p.ws + WS_MOD) + (size_t)(l * 4 + b) * 3072;
        f32x4 v[4]; float ss = 0.f;
#pragma unroll
        for (int j = 0; j < 4; ++j) { v[j] = xr[lane + 64 * j]; ss += v[j].x * v[j].x + v[j].y * v[j].y + v[j].z * v[j].z + v[j].w * v[j].w; }
        ss = wave_sum(ss); const float rstd = rsqrtf(ss * (1.f / 1024.f) + EPS);
#pragma unroll
        for (int j = 0; j < 4; ++j) {
            const int col = 4 * (lane + 64 * j);
            const f32x4 w4 = *(const f32x4*)(nwp + col), sh = *(const f32x4*)(md + col), sc = *(const f32x4*)(md + 1024 + col);
            const f32x4 o = v[j] * rstd * w4 * (1.f + sc) + sh;
            u32x2 pk; pk.x = pk2(o.x, o.y); pk.y = pk2(o.z, o.w);
            *(u32x2*)(H + (size_t)row * 1024 + col) = pk;
        }
    }
}

constexpr int G_STAGE = 65536, G_AB = 32768;
__device__ __forceinline__ void gemm_core(const bf16_t* __restrict__ A, int lda, const bf16_t* __restrict__ Bt, int ldb, int K, f32x4 (&acc)[8][4], unsigned char* smem, int tid) {
    asm volatile("" : "+v"(tid));
    const int lane = tid & 63, w = __builtin_amdgcn_readfirstlane(tid >> 6), wm = w >> 2, wn = w & 3, idx = lane & 15, kq = lane >> 4;
    unsigned offA[4], offB[4];
#pragma unroll
    for (int j = 0; j < 4; ++j) { const int row = (j * 8 + w) * 8 + (lane >> 3), c = (lane & 7) ^ ((row >> 1) & 7);
        offA[j] = (unsigned)(row * lda + c * 8) * 2u; offB[j] = (unsigned)(row * ldb + c * 8) * 2u; }
#pragma unroll
    for (int mi = 0; mi < 8; ++mi)
#pragma unroll
        for (int ni = 0; ni < 4; ++ni) acc[mi][ni] = (f32x4){0.f, 0.f, 0.f, 0.f};
    LDSAS unsigned char* lds = (LDSAS unsigned char*)smem;
#define G_ISSUE1(kt, st, j) do { \
        __builtin_amdgcn_global_load_lds((const unsigned*)((const char*)A + offA[j] + (kt) * 128), (LDSAS unsigned*)(lds + (st) * G_STAGE + ((j) * 8 + w) * 1024), 16, 0, 0); \
        __builtin_amdgcn_global_load_lds((const unsigned*)((const char*)Bt + offB[j] + (kt) * 128), (LDSAS unsigned*)(lds + (st) * G_STAGE + G_AB + ((j) * 8 + w) * 1024), 16, 0, 0); } while (0)
#define G_ISSUE(kt, st) do { G_ISSUE1(kt, st, 0); G_ISSUE1(kt, st, 1); G_ISSUE1(kt, st, 2); G_ISSUE1(kt, st, 3); } while (0)
    const int nk = K >> 6;
    G_ISSUE(0, 0);
    asm volatile("s_waitcnt vmcnt(0)" ::: "memory");
    __syncthreads();
    const int swz = (idx >> 1) & 7;
    const int aoff = (wm * 128 + idx) * 128, boff = G_AB + (wn * 64 + idx) * 128;
    for (int kt = 0; kt < nk; ++kt) {
        const int st = kt & 1;
        const bool more = kt + 1 < nk;
        const unsigned char* sb = smem + st * G_STAGE;
#pragma unroll
        for (int ks = 0; ks < 2; ++ks) {
            bf16x8 bfr[4], af[8];
            const int co = ((ks * 4 + kq) ^ swz) * 16;
#pragma unroll
            for (int ni = 0; ni < 4; ++ni) bfr[ni] = *(const bf16x8*)(sb + boff + ni * 2048 + co);
#pragma unroll
            for (int mi = 0; mi < 8; ++mi) af[mi] = *(const bf16x8*)(sb + aoff + mi * 2048 + co);
            if (more) { G_ISSUE1(kt + 1, st ^ 1, ks * 2); G_ISSUE1(kt + 1, st ^ 1, ks * 2 + 1); }
            __builtin_amdgcn_sched_barrier(0);
            __builtin_amdgcn_s_setprio(1);
#pragma unroll
            for (int mi = 0; mi < 8; ++mi)
#pragma unroll
                for (int ni = 0; ni < 4; ++ni) acc[mi][ni] = __builtin_amdgcn_mfma_f32_16x16x32_bf16(bfr[ni], af[mi], acc[mi][ni], 0, 0, 0);
            __builtin_amdgcn_s_setprio(0);
            __builtin_amdgcn_sched_barrier(0);
        }
        asm volatile("s_waitcnt vmcnt(0)" ::: "memory");
        __syncthreads();
    }
#undef G_ISSUE1
#undef G_ISSUE
}

__device__ __forceinline__ void st4bf(bf16_t* dst, f32x4 v) { u32x2 pk; pk.x = pk2(v.x, v.y); pk.y = pk2(v.z, v.w); *(u32x2*)dst = pk; }

__device__ void gemm1_phase(const Params& p, int l, int hb, unsigned char* smem) {
    const bf16_t* H = (const bf16_t*)(p.ws + WS_H);
    const bf16_t* Wt = (const bf16_t*)(p.ws + WS_WIN) + (size_t)l * NP * 1024;
    const float* ropec = (const float*)(p.ws + WS_ROPE); const float* ropes = ropec + 2048;
    constexpr int NT = 34, NTILES = 64 * NT, GRP = 8 * NT;
    for (int t = blockIdx.x; t < NTILES; t += gridDim.x) {
        const int grp = t / GRP, r = t % GRP, jx = NT * (r & 7) + (r >> 3), mt = grp * 8 + (jx & 7), nt = jx >> 3;
        const int m0 = mt * 256, n0 = nt * 256;
        f32x4 acc[8][4];
        int tid = threadIdx.x;
        gemm_core(H + (size_t)m0 * 1024, 1024, Wt + (size_t)n0 * 1024, 1024, 1024, acc, smem, tid);
        asm volatile("" : "+v"(tid));
        const int lane = tid & 63, w = tid >> 6, wm = w >> 2, wn = w & 3, idx = lane & 15, kq = lane >> 4;
        const int cw = n0 + wn * 64;
        const int lc = 4 * kq;
        if (cw < 768 && (cw < 640)) {
            const bool isq = cw < 512;
            const float* nwp = (isq ? p.q_norm_a : p.k_norm_a) + l * 64;
            bf16_t* dst = isq ? (bf16_t*)(p.ws + WS_QA) : (bf16_t*)(p.ws + WS_KA);
            const int pitch = isq ? 512 : 128, c0 = isq ? cw : cw - 512;
            const float qs = isq ? 0.125f * LOG2E : 1.f;
#pragma unroll
            for (int mi = 0; mi < 8; ++mi) {
                const int row = m0 + wm * 128 + mi * 16 + idx;
                float ss = 0.f;
#pragma unroll
                for (int ni = 0; ni < 4; ++ni) { const f32x4 v = acc[mi][ni]; ss += v.x * v.x + v.y * v.y + v.z * v.z + v.w * v.w; }
                ss += __shfl_xor(ss, 16); ss += __shfl_xor(ss, 32);
                const float rstd = rsqrtf(ss * (1.f / 64.f) + EPS);
                f32x4 y[4];
#pragma unroll
                for (int ni = 0; ni < 4; ++ni) y[ni] = acc[mi][ni] * rstd * *(const f32x4*)(nwp + ni * 16 + lc);
                const int tt = row & (SEQ - 1), prow = tt >> 6, pcol = tt & 63;
#pragma unroll
                for (int hf = 0; hf < 2; ++hf) {
                    const int pos = hf ? pcol : prow;
                    const f32x4 cs = *(const f32x4*)(ropec + pos * 16 + lc), sn = *(const f32x4*)(ropes + pos * 16 + lc);
                    const f32x4 a = y[2 * hf], b = y[2 * hf + 1];
                    y[2 * hf] = a * cs - b * sn; y[2 * hf + 1] = b * cs + a * sn;
                }
#pragma unroll
                for (int ni = 0; ni < 4; ++ni) st4bf(dst + (size_t)row * pitch + c0 + ni * 16 + lc, y[ni] * qs);
            }
        } else if (cw >= 1280 && cw < 2816) {
            const bool isq = cw < 2048;
            const float* nwp = (isq ? p.q_norm_b : p.k_norm_b) + l * 64;
            const int gc = isq ? cw - 1280 : cw - 2048, g = gc >> 8, c0 = gc & 255;
            const int sh = 2 * g;
            bf16_t* dst = (bf16_t*)(p.ws + (isq ? WS_QB : WS_KB));
            const float qs = isq ? 0.125f * LOG2E : 1.f;
#pragma unroll
            for (int mi = 0; mi < 8; ++mi) {
                const int row = m0 + wm * 128 + mi * 16 + idx;
                float ss = 0.f;
#pragma unroll
                for (int ni = 0; ni < 4; ++ni) { const f32x4 v = acc[mi][ni]; ss += v.x * v.x + v.y * v.y + v.z * v.z + v.w * v.w; }
                ss += __shfl_xor(ss, 16); ss += __shfl_xor(ss, 32);
                const float rstd = rsqrtf(ss * (1.f / 64.f) + EPS) * qs;
                const int bl = row >> 13, tt = row & (SEQ - 1);
                const int pp = (tt & ((1 << sh) - 1)) * (SEQ >> sh) + (tt >> sh);
                bf16_t* drow = dst + ((size_t)(bl * 3 + g) * SEQ + pp) * 256 + c0 + lc;
#pragma unroll
                for (int ni = 0; ni < 4; ++ni) st4bf(drow + ni * 16, acc[mi][ni] * rstd * *(const f32x4*)(nwp + ni * 16 + lc));
            }
        } else if (cw >= 2816 && cw < 3584) {
            const int gc = cw - 2816, g = gc >> 8, c0 = gc & 255, sh = 2 * g;
            bf16_t* dst = (bf16_t*)(p.ws + WS_VB);
#pragma unroll
            for (int mi = 0; mi < 8; ++mi) {
                const int row = m0 + wm * 128 + mi * 16 + idx;
                const int bl = row >> 13, tt = row & (SEQ - 1);
                const int pp = (tt & ((1 << sh) - 1)) * (SEQ >> sh) + (tt >> sh);
                bf16_t* drow = dst + ((size_t)(bl * 3 + g) * SEQ + pp) * 256 + c0 + lc;
#pragma unroll
                for (int ni = 0; ni < 4; ++ni) st4bf(drow + ni * 16, acc[mi][ni]);
            }
        } else if (cw >= 8448) {
            if (cw == 8448) {
                float* dst = (float*)(p.ws + WS_DT);
                const f32x4 bias = *(const f32x4*)(p.dt_bias + l * 16 + lc);
#pragma unroll
                for (int mi = 0; mi < 8; ++mi) {
                    const int row = m0 + wm * 128 + mi * 16 + idx;
                    f32x4 v = acc[mi][0] + bias, o;
                    o.x = v.x > 20.f ? v.x : log1pf(__expf(v.x)); o.y = v.y > 20.f ? v.y : log1pf(__expf(v.y));
                    o.z = v.z > 20.f ? v.z : log1pf(__expf(v.z)); o.w = v.w > 20.f ? v.w : log1pf(__expf(v.w));
                    *(f32x4*)(dst + (size_t)row * 16 + lc) = o;
                }
            }
        } else {
            bf16_t* dst; int pitch, c0, mode;
            if (cw < 768) { dst = (bf16_t*)(p.ws + WS_VA); pitch = 128; c0 = cw - 640; mode = 0; }
            else if (cw < 1280) { dst = (bf16_t*)(p.ws + WS_GA); pitch = 512; c0 = cw - 768; mode = 1; }
            else if (cw < 3840) { dst = (bf16_t*)(p.ws + WS_GB); pitch = 256; c0 = cw - 3584; mode = 1; }
            else if (cw < 4864) { dst = (bf16_t*)(p.ws + WS_XBC); pitch = 1024; c0 = cw - 3840; mode = 0; }
            else if (cw < 5376) { dst = (bf16_t*)(p.ws + WS_ZS); pitch = 512; c0 = cw - 4864; mode = 1; }
            else { dst = (bf16_t*)(p.ws + WS_MG); pitch = 3072; c0 = cw - 5376; mode = 2; }
            const float* bg = p.b_gate + l * 3072 + c0 + lc;
#pragma unroll
            for (int mi = 0; mi < 8; ++mi) {
                const int row = m0 + wm * 128 + mi * 16 + idx;
#pragma unroll
                for (int ni = 0; ni < 4; ++ni) {
                    f32x4 v = acc[mi][ni];
                    if (mode == 1) { v.x = siluf(v.x); v.y = siluf(v.y); v.z = siluf(v.z); v.w = siluf(v.w); }
                    else if (mode == 2) { const f32x4 bb = *(const f32x4*)(bg + ni * 16); v.x = sigmf(v.x + bb.x); v.y = sigmf(v.y + bb.y); v.z = sigmf(v.z + bb.z); v.w = sigmf(v.w + bb.w); }
                    st4bf(dst + (size_t)row * pitch + c0 + ni * 16 + lc, v);
                }
            }
        }
    }
}

__device__ void merge_phase(const Params& p, int l, unsigned char* smem) {
    const bf16_t* MG = (const bf16_t*)(p.ws + WS_MG);
    const float* rstd = (const float*)(p.ws + WS_RSTD);
    bf16_t* MR = (bf16_t*)(p.ws + WS_MRG);
    for (int t = blockIdx.x; t < 64 * 4; t += gridDim.x) {
        const int xq = t >> 3, mt = (xq >> 2) * 8 + (t & 7), nt = xq & 3, m0 = mt * 256, n0 = nt * 256;
#pragma unroll 1
        for (int br = 0; br < 3; ++br) {
            f32x4 acc[8][4];
            const bf16_t* A; const bf16_t* Bt; int K;
            if (br == 0) { A = (const bf16_t*)(p.ws + WS_QA); K = 512; Bt = (const bf16_t*)(p.ws + WS_WPA) + (size_t)l * 1024 * 512; }
            else if (br == 1) { A = (const bf16_t*)(p.ws + WS_YBM); K = 256; Bt = (const bf16_t*)(p.ws + WS_WPB) + (size_t)l * 1024 * 256; }
            else { A = (const bf16_t*)(p.ws + WS_YC); K = 512; Bt = (const bf16_t*)(p.ws + WS_WPC) + (size_t)l * 1024 * 512; }
            int tid = threadIdx.x;
            gemm_core(A + (size_t)m0 * K, K, Bt + (size_t)n0 * K, K, K, acc, smem, tid);
            asm volatile("" : "+v"(tid));
            const int lane = tid & 63, w = tid >> 6, wm = w >> 2, wn = w & 3, idx = lane & 15, kq = lane >> 4;
#pragma unroll
            for (int mi = 0; mi < 8; ++mi) {
                const int row = m0 + wm * 128 + mi * 16 + idx;
                const float rs = (br == 2) ? rstd[row] : 1.f;
#pragma unroll
                for (int ni = 0; ni < 4; ++ni) {
                    const int col = n0 + wn * 64 + ni * 16 + 4 * kq;
                    const u32x2 g = *(const u32x2*)(MG + (size_t)row * 3072 + br * 1024 + col);
                    f32x4 gv; gv.x = bflo(g.x); gv.y = bfhi(g.x); gv.z = bflo(g.y); gv.w = bfhi(g.y);
                    f32x4 v = gv * rs * acc[mi][ni];
                    bf16_t* mp = MR + (size_t)row * 1024 + col;
                    if (br > 0) { const u32x2 o = *(const u32x2*)mp; v.x += bflo(o.x); v.y += bfhi(o.x); v.z += bflo(o.y); v.w += bfhi(o.y); }
                    st4bf(mp, v);
                }
            }
        }
    }
}

__device__ void out_phase(const Params& p, int l, int hb, const float* xsrc, unsigned char* smem) {
    const bf16_t* MR = (const bf16_t*)(p.ws + WS_MRG);
    const bf16_t* Wt = (const bf16_t*)(p.ws + WS_WOUT) + (size_t)l * 1024 * 1024;
    for (int t = blockIdx.x; t < 64 * 4; t += gridDim.x) {
        const int xq = t >> 3, mt = (xq >> 2) * 8 + (t & 7), nt = xq & 3, m0 = mt * 256, n0 = nt * 256;
        f32x4 acc[8][4];
        int tid = threadIdx.x;
        gemm_core(MR + (size_t)m0 * 1024, 1024, Wt + (size_t)n0 * 1024, 1024, 1024, acc, smem, tid);
        asm volatile("" : "+v"(tid));
        const int lane = tid & 63, w = tid >> 6, wm = w >> 2, wn = w & 3, idx = lane & 15, kq = lane >> 4;
#pragma unroll
        for (int mi = 0; mi < 8; ++mi) {
            const int row = m0 + wm * 128 + mi * 16 + idx; const size_t rg = (size_t)hb * TP + row; const int b = (int)(rg / SEQ);
            const float* gate = (const float*)(p.ws + WS_MOD) + (size_t)(l * 4 + b) * 3072 + 2048;
#pragma unroll
            for (int ni = 0; ni < 4; ++ni) {
                const int col = n0 + wn * 64 + ni * 16 + 4 * kq;
                const f32x4 xv = *(const f32x4*)(xsrc + rg * 1024 + col), gv = *(const f32x4*)(gate + col);
                *(f32x4*)(p.out + rg * 1024 + col) = xv + gv * acc[mi][ni];
            }
        }
    }
}

constexpr int AT_KS = 0, AT_VS = 9216, AT_LQ = 9216 + 8192, AT_LUT = AT_LQ + 512;

#define AT_STAGE_STORE() do { _Pragma("unroll") for (int i = 0; i < 2; ++i) { const int c = tid + 256 * i, row = c >> 3, ch = c & 7; \
        *(u32x4*)(Ks + row * 72 + ch * 8) = rk[i]; *(u32x4*)(Vs + (ch >> 2) * 4096 + row * 64 + (ch & 3) * 16) = rv[i]; } } while (0)

__device__ __forceinline__ void at_qk(f32x16& p0, f32x16& p1, const bf16_t* Ks, const bf16x8* qr, int r32, int hi) {
    bf16x8 kf[8];
#pragma unroll
    for (int ds = 0; ds < 4; ++ds) {
        kf[2 * ds] = *(const bf16x8*)(Ks + r32 * 72 + ds * 16 + hi * 8);
        kf[2 * ds + 1] = *(const bf16x8*)(Ks + (r32 + 32) * 72 + ds * 16 + hi * 8);
    }
    __builtin_amdgcn_sched_barrier(0);
    __builtin_amdgcn_s_setprio(1);
#pragma unroll
    for (int ds = 0; ds < 4; ++ds) {
        p0 = __builtin_amdgcn_mfma_f32_32x32x16_bf16(kf[2 * ds], qr[ds], p0, 0, 0, 0);
        p1 = __builtin_amdgcn_mfma_f32_32x32x16_bf16(kf[2 * ds + 1], qr[ds], p1, 0, 0, 0);
    }
    __builtin_amdgcn_s_setprio(0);
    __builtin_amdgcn_sched_barrier(0);
}
__device__ __forceinline__ void at_pv(f32x16& o0, f32x16& o1, const f32x16& p0, const f32x16& p1, const unsigned char* Vs, int lane) {
    const int hi = lane >> 5;
    const unsigned char* vb = Vs + ((lane >> 4) & 1) * 32 + (lane & 3) * 8 + (4 * hi + ((lane & 15) >> 2)) * 64;
    bf16x8 v0[4], v1[4], pa[4];
#pragma unroll
    for (int s = 0; s < 4; ++s) {
        v0[s] = cat8(tr16(vb + s * 1024), tr16(vb + s * 1024 + 512));
        v1[s] = cat8(tr16(vb + 4096 + s * 1024), tr16(vb + 4096 + s * 1024 + 512));
    }
#pragma unroll
    for (int s = 0; s < 4; ++s) {
        u32x4 pw;
        if (s < 2) { pw.x = pk2(p0[8 * s + 0], p0[8 * s + 1]); pw.y = pk2(p0[8 * s + 2], p0[8 * s + 3]); pw.z = pk2(p0[8 * s + 4], p0[8 * s + 5]); pw.w = pk2(p0[8 * s + 6], p0[8 * s + 7]); }
        else { const int q = s - 2; pw.x = pk2(p1[8 * q + 0], p1[8 * q + 1]); pw.y = pk2(p1[8 * q + 2], p1[8 * q + 3]); pw.z = pk2(p1[8 * q + 4], p1[8 * q + 5]); pw.w = pk2(p1[8 * q + 6], p1[8 * q + 7]); }
        pa[s] = __builtin_bit_cast(bf16x8, pw);
    }
    __builtin_amdgcn_sched_barrier(0);
    __builtin_amdgcn_s_setprio(1);
#pragma unroll
    for (int s = 0; s < 4; ++s) {
        o0 = __builtin_amdgcn_mfma_f32_32x32x16_bf16(pa[s], v0[s], o0, 0, 0, 0);
        o1 = __builtin_amdgcn_mfma_f32_32x32x16_bf16(pa[s], v1[s], o1, 0, 0, 0);
    }
    __builtin_amdgcn_s_setprio(0);
    __builtin_amdgcn_sched_barrier(0);
}

__device__ __forceinline__ void at_ldv(bf16x8 (&v0)[4], bf16x8 (&v1)[4], const unsigned char* Vs, int lane) {
    const int hi = lane >> 5;
    const unsigned char* vb = Vs + ((lane >> 4) & 1) * 32 + (lane & 3) * 8 + (4 * hi + ((lane & 15) >> 2)) * 64;
#pragma unroll
    for (int s = 0; s < 4; ++s) {
        v0[s] = cat8(tr16(vb + s * 1024), tr16(vb + s * 1024 + 512));
        v1[s] = cat8(tr16(vb + 4096 + s * 1024), tr16(vb + 4096 + s * 1024 + 512));
    }
}
__device__ __forceinline__ void at_pv2(f32x16& o0, f32x16& o1, const f32x16& p0, const f32x16& p1, const bf16x8 (&v0)[4], const bf16x8 (&v1)[4]) {
    bf16x8 pa[4];
#pragma unroll
    for (int s = 0; s < 4; ++s) {
        u32x4 pw;
        if (s < 2) { pw.x = pk2(p0[8 * s + 0], p0[8 * s + 1]); pw.y = pk2(p0[8 * s + 2], p0[8 * s + 3]); pw.z = pk2(p0[8 * s + 4], p0[8 * s + 5]); pw.w = pk2(p0[8 * s + 6], p0[8 * s + 7]); }
        else { const int q = s - 2; pw.x = pk2(p1[8 * q + 0], p1[8 * q + 1]); pw.y = pk2(p1[8 * q + 2], p1[8 * q + 3]); pw.z = pk2(p1[8 * q + 4], p1[8 * q + 5]); pw.w = pk2(p1[8 * q + 6], p1[8 * q + 7]); }
        pa[s] = __builtin_bit_cast(bf16x8, pw);
    }
    __builtin_amdgcn_sched_barrier(0);
    __builtin_amdgcn_s_setprio(1);
#pragma unroll
    for (int s = 0; s < 4; ++s) {
        o0 = __builtin_amdgcn_mfma_f32_32x32x16_bf16(pa[s], v0[s], o0, 0, 0, 0);
        o1 = __builtin_amdgcn_mfma_f32_32x32x16_bf16(pa[s], v1[s], o1, 0, 0, 0);
    }
    __builtin_amdgcn_s_setprio(0);
    __builtin_amdgcn_sched_barrier(0);
}

constexpr int ATA_STAGE = 17408, ATA_LQ = 2 * ATA_STAGE;
__device__ void attn_a_item(const Params& p, int item, int l, unsigned char* smem) {
    int tid_ = VTID; asm volatile("" : "+v"(tid_));
    const int tid = tid_, lane = tid & 63, w = tid >> 6, r32 = lane & 31, hi = lane >> 5;
    const int b = item >> 9, r = item & 511, kvh = r >> 8, qblk = (r >> 2) & 63, hq = kvh * 4 + (r & 3);
    float* lq = (float*)(smem + ATA_LQ) + w * 32;
    bf16_t* QA = (bf16_t*)(p.ws + WS_QA);
    const bf16_t* GA = (const bf16_t*)(p.ws + WS_GA);
    const size_t tokq = (size_t)b * SEQ + qblk * 128 + w * 32;
    bf16x8 qr[4];
#pragma unroll
    for (int ds = 0; ds < 4; ++ds) qr[ds] = *(const bf16x8*)(QA + (tokq + r32) * 512 + hq * 64 + ds * 16 + hi * 8);
    const bf16_t* Kb = (const bf16_t*)(p.ws + WS_KA) + (size_t)b * SEQ * 128 + kvh * 64;
    const bf16_t* Vb = (const bf16_t*)(p.ws + WS_VA) + (size_t)b * SEQ * 128 + kvh * 64;
    const float nshift = -((const float*)(p.ws + WS_BND))[l];
    f32x16 o0, o1;
#pragma unroll
    for (int i = 0; i < 16; ++i) { o0[i] = 0.f; o1[i] = 0.f; }
    f32x4 la4 = (f32x4){0.f, 0.f, 0.f, 0.f};
    constexpr int NT = SEQ / 64;
    const int row0 = tid >> 3, ch0 = tid & 7;
    const size_t goff0 = (size_t)row0 * 128 + ch0 * 8, goff1 = goff0 + (size_t)32 * 128;
    const int ko0 = row0 * 144 + ch0 * 16, ko1 = ko0 + 32 * 144;
    const int vo0 = 9216 + (ch0 >> 2) * 4096 + row0 * 64 + (ch0 & 3) * 16, vo1 = vo0 + 32 * 64;
    u32x4 rkA[2], rvA[2], rkB[2], rvB[2];
#define ATA_LOAD(RK, RV, t) do { const size_t tb = (size_t)(t) * 64 * 128; RK[0] = *(const u32x4*)(Kb + tb + goff0); RK[1] = *(const u32x4*)(Kb + tb + goff1); \
        RV[0] = *(const u32x4*)(Vb + tb + goff0); RV[1] = *(const u32x4*)(Vb + tb + goff1); } while (0)
#define ATA_STORE(RK, RV, st) do { unsigned char* sb_ = smem + (st) * ATA_STAGE; *(u32x4*)(sb_ + ko0) = RK[0]; *(u32x4*)(sb_ + ko1) = RK[1]; \
        *(u32x4*)(sb_ + vo0) = RV[0]; *(u32x4*)(sb_ + vo1) = RV[1]; } while (0)
#define ATA_COMPUTE(st) do { const unsigned char* sb_ = smem + (st) * ATA_STAGE; f32x16 p0, p1; bf16x8 vf0[4], vf1[4]; \
        _Pragma("unroll") for (int i = 0; i < 16; ++i) { p0[i] = nshift; p1[i] = nshift; } \
        at_qk(p0, p1, (const bf16_t*)sb_, qr, r32, hi); \
        at_ldv(vf0, vf1, sb_ + 9216, lane); __builtin_amdgcn_sched_barrier(0); \
        _Pragma("unroll") for (int i = 0; i < 16; ++i) { p0[i] = __builtin_amdgcn_exp2f(p0[i]); p1[i] = __builtin_amdgcn_exp2f(p1[i]); } \
        _Pragma("unroll") for (int i = 0; i < 4; ++i) { la4 += (f32x4){p0[4 * i], p0[4 * i + 1], p0[4 * i + 2], p0[4 * i + 3]}; la4 += (f32x4){p1[4 * i], p1[4 * i + 1], p1[4 * i + 2], p1[4 * i + 3]}; } \
        at_pv2(o0, o1, p0, p1, vf0, vf1); } while (0)
    __syncthreads();
    ATA_LOAD(rkA, rvA, 0); ATA_LOAD(rkB, rvB, 1);
    ATA_STORE(rkA, rvA, 0);
    ATA_LOAD(rkA, rvA, 2);
    __syncthreads();
    for (int kt = 0; kt < NT; kt += 2) {
        ATA_COMPUTE(0);
        ATA_STORE(rkB, rvB, 1);
        if (kt + 3 < NT) ATA_LOAD(rkB, rvB, kt + 3);
        __syncthreads();
        ATA_COMPUTE(1);
        if (kt + 2 < NT) { ATA_STORE(rkA, rvA, 0); if (kt + 4 < NT) ATA_LOAD(rkA, rvA, kt + 4); }
        __syncthreads();
    }
#undef ATA_LOAD
#undef ATA_STORE
#undef ATA_COMPUTE
    float lacc = (la4.x + la4.y) + (la4.z + la4.w);
    lacc += __shfl_xor(lacc, 32);
    if (hi == 0) lq[r32] = lacc;
    asm volatile("s_waitcnt lgkmcnt(0)" ::: "memory");
#pragma unroll
    for (int rr = 0; rr < 16; ++rr) {
        const int q = crow(rr, hi); const float inv = 1.f / lq[q];
        const size_t off = (tokq + q) * 512 + hq * 64 + r32;
        const float g0 = bf2f(GA[off]), g1 = bf2f(GA[off + 32]);
        QA[off] = (bf16_t)(pk2(o0[rr] * inv * g0, 0.f) & 0xffffu);
        QA[off + 32] = (bf16_t)(pk2(o1[rr] * inv * g1, 0.f) & 0xffffu);
    }
}

__device__ void attn_b_item(const Params& p, int item, int l, unsigned char* smem) {
    int tid_ = VTID; asm volatile("" : "+v"(tid_));
    const int tid = tid_, lane = tid & 63, w = tid >> 6, r32 = lane & 31, hi = lane >> 5;
    const int blk = item & 63, j = (item >> 6) & 3, bg = item >> 8, g = bg % 3, b = bg / 3;
    const int sh = 2 * g, dil = 1 << sh, Mlen = SEQ >> sh;
    bf16_t* Ks = (bf16_t*)(smem + AT_KS); unsigned char* Vs = smem + AT_VS; float* lq = (float*)(smem + AT_LQ) + w * 32; float* lut = (float*)(smem + AT_LUT);
    bf16_t* QB = (bf16_t*)(p.ws + WS_QB) + (size_t)bg * SEQ * 256 + j * 64;
    const bf16_t* KB = (const bf16_t*)(p.ws + WS_KB) + (size_t)bg * SEQ * 256 + j * 64;
    const bf16_t* VB = (const bf16_t*)(p.ws + WS_VB) + (size_t)bg * SEQ * 256 + j * 64;
    float* LSE = (float*)(p.ws + WS_LSE) + (size_t)bg * SEQ * 4 + j;
    const int p0r = blk * 128, seq_lo = (p0r / Mlen) * Mlen, seq_hi = seq_lo + Mlen;
    __syncthreads();
    if (tid < 129) {
        const int rel = tid - 64, n = (rel < 0 ? -rel : rel) * dil;
        int bk;
        if (n < 8) bk = n; else { bk = 8 + (n >= 15) + (n >= 27) + (n >= 50) + (n >= 91) + (n >= 166) + (n >= 305) + (n >= 559); }
        if (rel > 0) bk += 16;
        lut[tid] = p.rel_bias[bk * 12 + g * 4 + j] * LOG2E;
    }
    const int qpos = p0r + w * 32 + r32;
    bf16x8 qr[4];
#pragma unroll
    for (int ds = 0; ds < 4; ++ds) qr[ds] = *(const bf16x8*)(QB + (size_t)qpos * 256 + ds * 16 + hi * 8);
    const float nshift = -((const float*)(p.ws + WS_BND))[2 + l];
    f32x16 o0, o1;
#pragma unroll
    for (int i = 0; i < 16; ++i) { o0[i] = 0.f; o1[i] = 0.f; }
    f32x4 la4 = (f32x4){0.f, 0.f, 0.f, 0.f};
    u32x4 rk[2], rv[2];
    for (int kt = 0; kt < 4; ++kt) {
        const int kbase = p0r - 64 + 64 * kt;
#pragma unroll
        for (int i = 0; i < 2; ++i) { const int c = tid + 256 * i, row = c >> 3, ch = c & 7;
            int pr = kbase + row; pr = pr < 0 ? 0 : (pr > SEQ - 1 ? SEQ - 1 : pr);
            rk[i] = *(const u32x4*)(KB + (size_t)pr * 256 + ch * 8); rv[i] = *(const u32x4*)(VB + (size_t)pr * 256 + ch * 8); }
        __syncthreads();
        AT_STAGE_STORE();
        __syncthreads();
        f32x16 p0, p1;
#pragma unroll
        for (int i = 0; i < 16; ++i) { p0[i] = nshift; p1[i] = nshift; }
        at_qk(p0, p1, Ks, qr, r32, hi);
#pragma unroll
        for (int i = 0; i < 16; ++i) {
            const int kv0 = kbase + crow(i, hi), kv1 = kv0 + 32;
            const int rel0 = kv0 - qpos, rel1 = kv1 - qpos;
            const bool ok0 = rel0 >= -64 && rel0 <= 64 && kv0 >= seq_lo && kv0 < seq_hi;
            const bool ok1 = rel1 >= -64 && rel1 <= 64 && kv1 >= seq_lo && kv1 < seq_hi;
            const float e0 = __builtin_amdgcn_exp2f(p0[i] + lut[ok0 ? rel0 + 64 : 64]);
            const float e1 = __builtin_amdgcn_exp2f(p1[i] + lut[ok1 ? rel1 + 64 : 64]);
            p0[i] = ok0 ? e0 : 0.f; p1[i] = ok1 ? e1 : 0.f;
        }
#pragma unroll
        for (int i = 0; i < 4; ++i) { la4 += (f32x4){p0[4 * i], p0[4 * i + 1], p0[4 * i + 2], p0[4 * i + 3]}; la4 += (f32x4){p1[4 * i], p1[4 * i + 1], p1[4 * i + 2], p1[4 * i + 3]}; }
        at_pv(o0, o1, p0, p1, Vs, lane);
    }
    float lacc = (la4.x + la4.y) + (la4.z + la4.w);
    lacc += __shfl_xor(lacc, 32);
    if (hi == 0) { lq[r32] = lacc; LSE[(size_t)qpos * 4] = (-nshift + log2f(lacc)) * LN2; }
    asm volatile("s_waitcnt lgkmcnt(0)" ::: "memory");
#pragma unroll
    for (int rr = 0; rr < 16; ++rr) {
        const int q = crow(rr, hi); const float inv = 1.f / lq[q];
        const size_t off = (size_t)(p0r + w * 32 + q) * 256 + r32;
        QB[off] = (bf16_t)(pk2(o0[rr] * inv, 0.f) & 0xffffu);
        QB[off + 32] = (bf16_t)(pk2(o1[rr] * inv, 0.f) & 0xffffu);
    }
}

__device__ void conv_phase(const Params& p, int l) {
    int tx_ = threadIdx.x; asm volatile("" : "+v"(tx_));
    const bf16_t* XBC = (const bf16_t*)(p.ws + WS_XBC);
    bf16_t* XC = (bf16_t*)(p.ws + WS_XBCC);
    const float* cw = p.conv_w + (size_t)l * 5 * 1024; const float* cb = p.conv_b + l * 1024;
    const int nthr = gridDim.x * 512;
    for (int u = blockIdx.x * 512 + tx_; u < (TP / 4) * 128; u += nthr) {
        const int ch = (u & 127) * 8, tg = u >> 7, tok0 = tg * 4, tt0 = tok0 & (SEQ - 1);
        u32x4 raw[8];
#pragma unroll
        for (int r = 0; r < 8; ++r) { const int tt = tt0 - 2 + r; raw[r] = (u32x4){0u, 0u, 0u, 0u};
            if (tt >= 0 && tt < SEQ) raw[r] = *(const u32x4*)(XBC + (size_t)(tok0 - 2 + r) * 1024 + ch); }
        float ac[4][8];
        { const f32x4 a = *(const f32x4*)(cb + ch), b2 = *(const f32x4*)(cb + ch + 4);
#pragma unroll
          for (int t = 0; t < 4; ++t) { ac[t][0] = a.x; ac[t][1] = a.y; ac[t][2] = a.z; ac[t][3] = a.w; ac[t][4] = b2.x; ac[t][5] = b2.y; ac[t][6] = b2.z; ac[t][7] = b2.w; } }
#pragma unroll
        for (int k = 0; k < 5; ++k) { const f32x4 wa = *(const f32x4*)(cw + k * 1024 + ch), wb = *(const f32x4*)(cw + k * 1024 + ch + 4);
#pragma unroll
            for (int t = 0; t < 4; ++t) { const u32x4 v = raw[t + k];
                ac[t][0] += bflo(v.x) * wa.x; ac[t][1] += bfhi(v.x) * wa.y; ac[t][2] += bflo(v.y) * wa.z; ac[t][3] += bfhi(v.y) * wa.w;
                ac[t][4] += bflo(v.z) * wb.x; ac[t][5] += bfhi(v.z) * wb.y; ac[t][6] += bflo(v.w) * wb.z; ac[t][7] += bfhi(v.w) * wb.w; } }
#pragma unroll
        for (int t = 0; t < 4; ++t) { u32x4 o;
            o.x = pk2(siluf(ac[t][0]), siluf(ac[t][1])); o.y = pk2(siluf(ac[t][2]), siluf(ac[t][3])); o.z = pk2(siluf(ac[t][4]), siluf(ac[t][5])); o.w = pk2(siluf(ac[t][6]), siluf(ac[t][7]));
            *(u32x4*)(XC + (size_t)(tok0 + t) * 1024 + ch) = o; }
    }
}

constexpr int SS_BS = 0, SS_CS = 8704, SS_XS = 17408, SS_XWS = 22016, SS_GS = 26624, SS_SB = 29184, SS_CW = 46592, SS_SC = 54272, SS_DTA = 55296, SS_END = 57344;

template <int PASS>
__device__ void ssd_item(const Params& p, int item, int l, unsigned char* smem) {
    int tid_ = VTID; asm volatile("" : "+v"(tid_));
    const int tid = tid_, lane = tid & 63, w = tid >> 6, idx = lane & 15, kq = lane >> 4;
    const int seg = item & 15, h = (item >> 4) & 7, dir = (item >> 7) & 1, b = item >> 8, grp = h >> 2;
    bf16_t* Bs = (bf16_t*)(smem + SS_BS); bf16_t* Cs = (bf16_t*)(smem + SS_CS); bf16_t* Xs = (bf16_t*)(smem + SS_XS); bf16_t* Xws = (bf16_t*)(smem + SS_XWS);
    bf16_t* Gs = (bf16_t*)(smem + SS_GS); bf16_t* Sb = (bf16_t*)(smem + SS_SB); float* cwl = (float*)(smem + SS_CW); float* sc = (float*)(smem + SS_SC);
    float* s_dt = sc, *s_c = sc + 32, *s_rs = sc + 64, *s_wl = sc + 96, *s_tot = sc + 128;
    const bf16_t* XBC = (const bf16_t*)(p.ws + WS_XBC);
    const float* DT = (const float*)(p.ws + WS_DT);
    float* ST = (float*)(p.ws + WS_ST); float* SEGT = (float*)(p.ws + WS_SEGT);
    bf16_t* Y = (bf16_t*)(p.ws + (dir ? WS_YS : WS_YF));
    const float Aneg = -__expf(p.a_log[l * 16 + dir * 8 + h]);
    const float Dh = p.d_skip[l * 8 + h];
    __syncthreads();
    f32x4 S[8];
#pragma unroll
    for (int nt = 0; nt < 8; ++nt) S[nt] = (f32x4){0.f, 0.f, 0.f, 0.f};
    const int ibase = item & ~15;
    if (PASS == 3) {
        if (dir == 0) {
            for (int e = 0; e < seg; ++e) { const float dc = __expf(SEGT[ibase + e]); const f32x4* src = (const f32x4*)(ST + (size_t)(ibase + e) * 8192);
#pragma unroll
                for (int nt = 0; nt < 8; ++nt) S[nt] = S[nt] * dc + src[(w * 8 + nt) * 64 + lane]; }
        } else {
            for (int e = NSEG - 1; e > seg; --e) { const float dc = __expf(SEGT[ibase + e]); const f32x4* src = (const f32x4*)(ST + (size_t)(ibase + e) * 8192);
#pragma unroll
                for (int nt = 0; nt < 8; ++nt) S[nt] = S[nt] * dc + src[(w * 8 + nt) * 64 + lane]; }
        }
#pragma unroll
        for (int nt = 0; nt < 8; ++nt) st4bf(Sb + (16 * w + idx) * 136 + 16 * nt + 4 * kq, S[nt]);
    }
    float* s_dta = (float*)(smem + SS_DTA);
    for (int e = tid; e < SEGLEN; e += 256) s_dta[e] = DT[((size_t)b * SEQ + seg * SEGLEN + e) * 16 + dir * 8 + h];
    float segtot = 0.f;
    const size_t tokb = (size_t)b * SEQ;
    const unsigned char* xb_ = (const unsigned char*)((const bf16_t*)(p.ws + WS_XBCC) + tokb * 1024);
    unsigned soff[5];
#pragma unroll
    for (int i = 0; i < 5; ++i) { const int u = tid + 256 * i, lrow = u / 40, ci = u % 40;
        const int scol = ci < 8 ? h * 64 + ci * 8 : (ci < 24 ? 512 + grp * 128 + (ci * 8 - 64) : 768 + grp * 128 + (ci * 8 - 192));
        soff[i] = (unsigned)((lrow * 1024 + scol) * 2); }
    for (int si = 0; si < NSUB; ++si) {
        const int scn = dir ? (NSUB - 1 - si) : si;
        const int t0 = seg * SEGLEN + scn * TSUB;
        __syncthreads();
        u32x4 raw[5];
#pragma unroll
        for (int i = 0; i < 5; ++i) raw[i] = *(const u32x4*)(xb_ + ((unsigned)(t0 * 2048) + soff[i]));
        if (w == 0) {
            float dtv = 0.f, av = 0.f;
            if (lane < 32) { dtv = s_dta[scn * TSUB + lane]; av = dtv * Aneg; }
            float pre = av;
#pragma unroll
            for (int o = 1; o < 32; o <<= 1) { const float t = __shfl_up(pre, o); if (lane >= o) pre += t; }
            const float tot = __shfl(pre, 31);
            const float cc = dir ? (tot - pre + av) : pre;
            if (lane < 32) { s_dt[lane] = dtv; s_c[lane] = cc; s_rs[lane] = __expf(cc); s_wl[lane] = dtv * __expf(tot - cc); }
            if (lane == 0) s_tot[0] = tot;
        }
        __syncthreads();
        segtot += s_tot[0];
#pragma unroll
        for (int i = 0; i < 5; ++i) { const int u = tid + 256 * i, lrow = u / 40, ci = u % 40, lc = ci * 8; const u32x4 o = raw[i];
            if (ci < 8) { *(u32x4*)(Xs + lrow * 72 + lc) = o; const float wl = s_wl[lrow];
                u32x4 o2; o2.x = pk2(bflo(o.x) * wl, bfhi(o.x) * wl); o2.y = pk2(bflo(o.y) * wl, bfhi(o.y) * wl); o2.z = pk2(bflo(o.z) * wl, bfhi(o.z) * wl); o2.w = pk2(bflo(o.w) * wl, bfhi(o.w) * wl);
                *(u32x4*)(Xws + lrow * 72 + lc) = o2; }
            else if (ci < 24) *(u32x4*)(Bs + lrow * 136 + (lc - 64)) = o;
            else *(u32x4*)(Cs + lrow * 136 + (lc - 192)) = o; }
        __syncthreads();
        if (PASS == 3) {
            const int it = w >> 1, jt = w & 1;
            f32x4 cb = (f32x4){0.f, 0.f, 0.f, 0.f};
            {
                bf16x8 fb[4], fc[4];
#pragma unroll
                for (int ks = 0; ks < 4; ++ks) { fb[ks] = *(const bf16x8*)(Bs + (16 * jt + idx) * 136 + ks * 32 + kq * 8); fc[ks] = *(const bf16x8*)(Cs + (16 * it + idx) * 136 + ks * 32 + kq * 8); }
                __builtin_amdgcn_sched_barrier(0);
#pragma unroll
                for (int ks = 0; ks < 4; ++ks) cb = __builtin_amdgcn_mfma_f32_16x16x32_bf16(fb[ks], fc[ks], cb, 0, 0, 0);
                __builtin_amdgcn_sched_barrier(0);
            }
            {
                const int ii = 16 * it + idx; const float ci_ = s_c[ii];
                f32x4 gv;
#pragma unroll
                for (int rg = 0; rg < 4; ++rg) {
                    const int jj = 16 * jt + 4 * kq + rg;
                    const bool ok = dir ? (jj >= ii) : (jj <= ii);
                    const float e = __expf(ci_ - s_c[jj]) * s_dt[jj];
                    gv[rg] = ok ? cb[rg] * e : 0.f;
                }
                st4bf(Gs + ii * 40 + 16 * jt + 4 * kq, gv);
            }
            __syncthreads();
            const unsigned char* xtr = (const unsigned char*)Xs + (8 * kq + (idx >> 2)) * 144 + (16 * w + 4 * (idx & 3)) * 2;
            const bf16x8 xf = cat8(tr16(xtr), tr16(xtr + 4 * 144));
#pragma unroll 1
            for (int it2 = 0; it2 < 2; ++it2) {
                const int ii = 16 * it2 + idx;
                const bf16x8 gf = *(const bf16x8*)(Gs + ii * 40 + 8 * kq);
                f32x4 yd = (f32x4){0.f, 0.f, 0.f, 0.f}, yo = (f32x4){0.f, 0.f, 0.f, 0.f};
                bf16x8 sf[4], cf[4];
#pragma unroll
                for (int ks = 0; ks < 4; ++ks) { sf[ks] = *(const bf16x8*)(Sb + (16 * w + idx) * 136 + ks * 32 + kq * 8); cf[ks] = *(const bf16x8*)(Cs + ii * 136 + ks * 32 + kq * 8); }
                __builtin_amdgcn_sched_barrier(0);
                yd = __builtin_amdgcn_mfma_f32_16x16x32_bf16(xf, gf, yd, 0, 0, 0);
#pragma unroll
                for (int ks = 0; ks < 4; ++ks) yo = __builtin_amdgcn_mfma_f32_16x16x32_bf16(sf[ks], cf[ks], yo, 0, 0, 0);
                __builtin_amdgcn_sched_barrier(0);
                f32x4 y = yd + yo * s_rs[ii];
                if (dir == 0) { const u32x2 xv = *(const u32x2*)(Xs + ii * 72 + 16 * w + 4 * kq);
                    y.x += Dh * bflo(xv.x); y.y += Dh * bfhi(xv.x); y.z += Dh * bflo(xv.y); y.w += Dh * bfhi(xv.y); }
                st4bf(Y + (tokb + t0 + ii) * 512 + h * 64 + 16 * w + 4 * kq, y);
            }
        }
        {
            const float dc = __expf(s_tot[0]);
            const unsigned char* xw = (const unsigned char*)Xws + (8 * kq + (idx >> 2)) * 144 + (16 * w + 4 * (idx & 3)) * 2;
            const bf16x8 xwf = cat8(tr16(xw), tr16(xw + 4 * 144));
            bf16x8 bfv[8];
#pragma unroll
            for (int nt = 0; nt < 8; ++nt) {
                const unsigned char* bt = (const unsigned char*)Bs + (8 * kq + (idx >> 2)) * 272 + (16 * nt + 4 * (idx & 3)) * 2;
                bfv[nt] = cat8(tr16(bt), tr16(bt + 4 * 272));
            }
            __builtin_amdgcn_sched_barrier(0);
#pragma unroll
            for (int nt = 0; nt < 8; ++nt) S[nt] = __builtin_amdgcn_mfma_f32_16x16x32_bf16(bfv[nt], xwf, S[nt] * dc, 0, 0, 0);
            __builtin_amdgcn_sched_barrier(0);
            if (PASS == 3) {
#pragma unroll
                for (int nt = 0; nt < 8; ++nt) st4bf(Sb + (16 * w + idx) * 136 + 16 * nt + 4 * kq, S[nt]);
            }
        }
    }
    if (PASS == 1) {
        f32x4* dst = (f32x4*)(ST + (size_t)item * 8192);
#pragma unroll
        for (int nt = 0; nt < 8; ++nt) dst[(w * 8 + nt) * 64 + lane] = S[nt];
        if (tid == 0) SEGT[item] = segtot;
    }
}

__device__ void post2_phase(const Params& p) {
    int tx_ = threadIdx.x; asm volatile("" : "+v"(tx_));
    const int lane = tx_ & 63, gw = blockIdx.x * 8 + (tx_ >> 6), nw = gridDim.x * 8;
    const bf16_t* OB = (const bf16_t*)(p.ws + WS_QB); const float* LSE = (const float*)(p.ws + WS_LSE);
    const bf16_t* GB = (const bf16_t*)(p.ws + WS_GB);
    bf16_t* YBM = (bf16_t*)(p.ws + WS_YBM);
    const bf16_t* YF = (const bf16_t*)(p.ws + WS_YF); const bf16_t* YS = (const bf16_t*)(p.ws + WS_YS); const bf16_t* ZS = (const bf16_t*)(p.ws + WS_ZS);
    bf16_t* YC = (bf16_t*)(p.ws + WS_YC); float* RS = (float*)(p.ws + WS_RSTD);
    for (int row = gw; row < TP; row += nw) {
        const int bl = row >> 13, tt = row & (SEQ - 1), j = lane >> 4;
        float ls[3]; size_t ro[3];
#pragma unroll
        for (int g = 0; g < 3; ++g) { const int sh = 2 * g; const int pp = (tt & ((1 << sh) - 1)) * (SEQ >> sh) + (tt >> sh);
            ro[g] = (size_t)(bl * 3 + g) * SEQ + pp; ls[g] = LSE[ro[g] * 4 + j]; }
        const float mx = fmaxf(ls[0], fmaxf(ls[1], ls[2]));
        float wg[3]; float ws = 0.f;
#pragma unroll
        for (int g = 0; g < 3; ++g) { wg[g] = __expf(ls[g] - mx); ws += wg[g]; }
        const float inv = 1.f / ws;
        f32x4 acc = (f32x4){0.f, 0.f, 0.f, 0.f};
#pragma unroll
        for (int g = 0; g < 3; ++g) { const u32x2 v = *(const u32x2*)(OB + ro[g] * 256 + 4 * lane); const float wv = wg[g] * inv;
            acc.x += wv * bflo(v.x); acc.y += wv * bfhi(v.x); acc.z += wv * bflo(v.y); acc.w += wv * bfhi(v.y); }
        { const u32x2 gt = *(const u32x2*)(GB + (size_t)row * 256 + 4 * lane);
          acc.x *= bflo(gt.x); acc.y *= bfhi(gt.x); acc.z *= bflo(gt.y); acc.w *= bfhi(gt.y); }
        st4bf(YBM + (size_t)row * 256 + 4 * lane, acc);
        const u32x4 a = *(const u32x4*)(YF + (size_t)row * 512 + 8 * lane), bq = *(const u32x4*)(YS + (size_t)row * 512 + 8 * lane), z = *(const u32x4*)(ZS + (size_t)row * 512 + 8 * lane);
        float y[8];
        y[0] = (bflo(a.x) + bflo(bq.x)) * bflo(z.x); y[1] = (bfhi(a.x) + bfhi(bq.x)) * bfhi(z.x);
        y[2] = (bflo(a.y) + bflo(bq.y)) * bflo(z.y); y[3] = (bfhi(a.y) + bfhi(bq.y)) * bfhi(z.y);
        y[4] = (bflo(a.z) + bflo(bq.z)) * bflo(z.z); y[5] = (bfhi(a.z) + bfhi(bq.z)) * bfhi(z.z);
        y[6] = (bflo(a.w) + bflo(bq.w)) * bflo(z.w); y[7] = (bfhi(a.w) + bfhi(bq.w)) * bfhi(z.w);
        float ss = 0.f;
#pragma unroll
        for (int e = 0; e < 8; ++e) ss += y[e] * y[e];
        ss = wave_sum(ss);
        u32x4 o; o.x = pk2(y[0], y[1]); o.y = pk2(y[2], y[3]); o.z = pk2(y[4], y[5]); o.w = pk2(y[6], y[7]);
        *(u32x4*)(YC + (size_t)row * 512 + 8 * lane) = o;
        if (lane == 0) RS[row] = rsqrtf(ss * (1.f / 512.f) + EPS);
    }
}


#define XB_TMO      128
#define XB_XCNT(j)  (256  + 64 * (j))
#define XB_XSUB(j)  (1280 + 64 * (j))
#define XB_XGEN(j)  (2304 + 64 * (j))
#define XB_TOP      3328
#define XB_TOPGEN   3392
#define XCD_BAR_WORDS 3456
#define XB_SPIN_CAP (1u << 20)
__device__ __forceinline__ unsigned xb_ld(unsigned* p)              { return __hip_atomic_load(p, __ATOMIC_RELAXED, __HIP_MEMORY_SCOPE_AGENT); }
__device__ __forceinline__ unsigned xb_add(unsigned* p, unsigned v) { return __hip_atomic_fetch_add(p, v, __ATOMIC_RELAXED, __HIP_MEMORY_SCOPE_AGENT); }
__device__ __forceinline__ unsigned xb_xcc_id() { return (unsigned)__builtin_amdgcn_s_getreg((3 << 11) | 20) & 0xFu; }
#define XB_SPIN(cond, bar) do { unsigned _sp = 0; while (cond) { __builtin_amdgcn_s_sleep(1); \
    if ((++_sp & 255u) == 0u) { if (xb_ld(&(bar)[XB_TMO])) break; if (_sp > XB_SPIN_CAP) { atomicAdd(&(bar)[XB_TMO], 1u); break; } } } } while (0)
struct XcdBarrier { unsigned* bar; unsigned x; volatile LDSAS unsigned* st; };
__device__ __forceinline__ XcdBarrier xcd_barrier_post(unsigned* bar, volatile LDSAS unsigned* st) {
    XcdBarrier b; b.bar = bar; b.x = xb_xcc_id(); b.st = st;
    if (threadIdx.x == 0) (void)xb_add(&bar[XB_XCNT(b.x)], 1u);
    return b;
}
__device__ __forceinline__ void xcd_barrier_complete(unsigned* bar, unsigned x, unsigned& nloc, unsigned& nx) {
    const unsigned G = gridDim.x * gridDim.y * gridDim.z;
    unsigned sum, cnt, mine, sp = 0u;
    for (;;) {
        sum = 0u; cnt = 0u; mine = 0u;
#pragma unroll
        for (unsigned j = 0; j < 16; ++j) { const unsigned c = xb_ld(&bar[XB_XCNT(j)]); sum += c; cnt += (c > 0u) ? 1u : 0u; mine = (j == x) ? c : mine; }
        if (sum == G) break;
        __builtin_amdgcn_s_sleep(1);
        if ((++sp & 255u) == 0u) { if (xb_ld(&bar[XB_TMO])) break; if (sp > XB_SPIN_CAP) { atomicAdd(&bar[XB_TMO], 1u); break; } }
    }
    nloc = mine > 0u ? mine : 1u; nx = cnt > 0u ? cnt : 1u;
}
__device__ __forceinline__ void xcd_barrier(const XcdBarrier& b) {
    asm volatile("s_waitcnt vmcnt(0)" ::: "memory");
    __syncthreads();
    if (threadIdx.x == 0) {
        unsigned* bar = b.bar;
        __builtin_amdgcn_s_waitcnt(0);
        unsigned nloc = b.st[0], nx = b.st[1];
        if (nloc == 0u) { xcd_barrier_complete(bar, b.x, nloc, nx); b.st[0] = nloc; b.st[1] = nx; }
        const unsigned old = xb_add(&bar[XB_XSUB(b.x)], 1u);
        const unsigned gen = old / nloc;
        if (old + 1u == (gen + 1u) * nloc) {
            __builtin_amdgcn_fence(__ATOMIC_RELEASE, "agent");
            asm volatile("s_waitcnt vmcnt(0)" ::: "memory");
            const unsigned og = xb_add(&bar[XB_TOP], 1u);
            const unsigned tg = og / nx;
            if (og + 1u == (tg + 1u) * nx) xb_add(&bar[XB_TOPGEN], 1u);
            else XB_SPIN(xb_ld(&bar[XB_TOPGEN]) == tg, bar);
            __builtin_amdgcn_fence(__ATOMIC_ACQUIRE, "agent");
            xb_add(&bar[XB_XGEN(b.x)], 1u);
            asm volatile("s_waitcnt vmcnt(0)" ::: "memory");
        } else {
            XB_SPIN(xb_ld(&bar[XB_XGEN(b.x)]) == gen, bar);
            __builtin_amdgcn_fence(__ATOMIC_ACQUIRE, "agent");
            asm volatile("s_waitcnt vmcnt(0)" ::: "memory");
        }
    }
    __syncthreads();
}

__device__ __forceinline__ unsigned char* lds_half(unsigned char* smem) { int h_ = threadIdx.x >> 8; asm volatile("" : "+v"(h_)); return smem + h_ * HALF_LDS; }
__global__ void __launch_bounds__(512, 2) hybrid_fwd(Params p) {
    cg::grid_group grid = cg::this_grid();
    extern __shared__ __attribute__((aligned(16))) unsigned char smem[];
    volatile LDSAS unsigned* bst = (volatile LDSAS unsigned*)(smem + LDS_TOTAL - 16);
    if (threadIdx.x < 4) bst[threadIdx.x] = 0u;
    __syncthreads();
    const XcdBarrier xbar = xcd_barrier_post((unsigned*)(p.ws + WS_BAR), bst);
    { const Params q = launder(p); phase0(q, lds_half(smem)); }
    grid.sync();
#pragma unroll 1
    for (int l = 0; l < DEPTH; ++l) {
#pragma unroll 1
        for (int hb = 0; hb < 2; ++hb) {
            { const Params q = launder(p); norm_phase(q, l, hb, (l == 0) ? q.x : q.out); }
            xcd_barrier(xbar);
            { const Params q = launder(p); gemm1_phase(q, l, hb, smem); }
            xcd_barrier(xbar);
            { const Params q = launder(p); conv_phase(q, l); }
            xcd_barrier(xbar);
            { const Params q = launder(p); unsigned char* smh = lds_half(smem);
#pragma unroll 1
              for (int it = VBLK; it < 512 + 1536; it += VGRID) { if (it < 512) ssd_item<1>(q, it, l, smh); else attn_b_item(q, it - 512, l, smh); } }
            xcd_barrier(xbar);
            { const Params q = launder(p); unsigned char* smh = lds_half(smem);
#pragma unroll 1
              for (int it = VBLK; it < 1024 + 512; it += VGRID) { if (it < 1024) attn_a_item(q, it, l, smh); else ssd_item<3>(q, it - 1024, l, smh); } }
            xcd_barrier(xbar);
            { const Params q = launder(p); post2_phase(q); }
            xcd_barrier(xbar);
            { const Params q = launder(p); merge_phase(q, l, smem); }
            xcd_barrier(xbar);
            { const Params q = launder(p); out_phase(q, l, hb, (l == 0) ? q.x : q.out, smem); }
        }
    }
}

extern "C" void kernel_launch(void* const* d_in, const int* in_sizes, int n_in, void* d_out, int out_size, void* d_ws, size_t ws_size, hipStream_t stream) {
    static int grid_blocks = 0;
    if (!grid_blocks) {
        int dev = 0, cus = 0, per_cu = 0;
        hipGetDevice(&dev);
        hipDeviceGetAttribute(&cus, hipDeviceAttributeMultiprocessorCount, dev);
        hipFuncSetAttribute((const void*)hybrid_fwd, hipFuncAttributeMaxDynamicSharedMemorySize, LDS_TOTAL);
        hipOccupancyMaxActiveBlocksPerMultiprocessor(&per_cu, hybrid_fwd, 512, LDS_TOTAL);
        if (per_cu > 1) per_cu = 1;
        if (per_cu < 1) per_cu = 1;
        grid_blocks = cus * per_cu;
    }
    Params p{};
    const float** pp = (const float**)&p;
    for (int i = 0; i < 22; ++i) pp[i] = (const float*)d_in[i];
    p.out = (float*)d_out; p.ws = (unsigned char*)d_ws;
    hipMemsetAsync((unsigned char*)d_ws + WS_BAR, 0, XCD_BAR_WORDS * 4, stream);
    void* args[] = {&p};
    hipError_t e = hipLaunchCooperativeKernel((void*)hybrid_fwd, dim3(grid_blocks), dim3(512), args, LDS_TOTAL, stream);
    if (e != hipSuccess) fprintf(stderr, "cooperative launch failed: %s (grid %d)\n", hipGetErrorString(e), grid_blocks);
}
```

```cpp
#include <hip/hip_runtime.h>
#include <hip/hip_cooperative_groups.h>
#include <cstdint>
#include <cstdio>
namespace cg = cooperative_groups;

typedef unsigned short bf16_t;
typedef short bf16x8 __attribute__((ext_vector_type(8)));
typedef short v4i16 __attribute__((ext_vector_type(4)));
typedef float f32x2 __attribute__((ext_vector_type(2)));
typedef float f32x4 __attribute__((ext_vector_type(4)));
typedef float f32x16 __attribute__((ext_vector_type(16)));
typedef unsigned u32x2 __attribute__((ext_vector_type(2)));
typedef unsigned u32x4 __attribute__((ext_vector_type(4)));
typedef __bf16 bf16x2_t __attribute__((ext_vector_type(2)));
#define LDSAS __attribute__((address_space(3)))
#define VTID ((int)(threadIdx.x & 255u))
__device__ __forceinline__ int vblk_() { int h_ = threadIdx.x >> 8; asm volatile("" : "+v"(h_)); return __builtin_amdgcn_readfirstlane(2 * (int)blockIdx.x + h_); }
#define VBLK vblk_()
#define VGRID ((int)(2u * gridDim.x))
constexpr int HALF_LDS = 73728, LDS_TOTAL = 147456;

constexpr int SEQ = 8192, DM = 1024, NBATCH = 4, NBH = 2, TP = NBH * SEQ, DEPTH = 2;
constexpr int NP = 8704;
constexpr float EPS = 1e-6f;
constexpr float LOG2E = 1.4426950408889634f, LN2 = 0.6931471805599453f;
constexpr int NSEG = 16, SEGLEN = 512, TSUB = 32, NSUB = SEGLEN / TSUB;

constexpr size_t MiB = 1u << 20;
constexpr size_t WS_WIN = 0;
constexpr size_t WS_WPA = 34 * MiB;
constexpr size_t WS_WPB = 36 * MiB;
constexpr size_t WS_WPC = 37 * MiB;
constexpr size_t WS_WOUT = 39 * MiB;
constexpr size_t WS_MOD = 43 * MiB;
constexpr size_t WS_ROPE = 43 * MiB + 128 * 1024;
constexpr size_t WS_BND = 43 * MiB + 160 * 1024;
constexpr size_t WS_RSTD = 43 * MiB + 256 * 1024;
constexpr size_t WS_SEGT = 43 * MiB + 512 * 1024;
constexpr size_t WS_LSE = 44 * MiB;
constexpr size_t WS_DT = 45 * MiB;
constexpr size_t WS_BAR = 46 * MiB;
constexpr size_t WS_H = 48 * MiB;
constexpr size_t WS_QA = 80 * MiB;
constexpr size_t WS_KA = 96 * MiB;
constexpr size_t WS_VA = 100 * MiB;
constexpr size_t WS_GA = 104 * MiB;
constexpr size_t WS_QB = 120 * MiB;
constexpr size_t WS_KB = 144 * MiB;
constexpr size_t WS_VB = 168 * MiB;
constexpr size_t WS_GB = 192 * MiB;
constexpr size_t WS_XBC = 200 * MiB;
constexpr size_t WS_ZS = 232 * MiB;
constexpr size_t WS_MG = 248 * MiB;
constexpr size_t WS_YF = 344 * MiB;
constexpr size_t WS_YS = 360 * MiB;
constexpr size_t WS_YBM = 376 * MiB;
constexpr size_t WS_YC = 384 * MiB;
constexpr size_t WS_MRG = 400 * MiB;
constexpr size_t WS_ST = 432 * MiB;
constexpr size_t WS_XBCC = 448 * MiB;

struct Params {
    const float *x, *c, *norm_w, *w_ada, *b_ada, *w_in, *b_gate, *q_norm_a, *k_norm_a, *q_norm_b, *k_norm_b, *rel_bias,
        *conv_w, *conv_b, *a_log, *dt_bias, *d_skip, *ssm_norm_w, *w_proj_a, *w_proj_b, *w_proj_c, *w_out;
    float* out;
    unsigned char* ws;
};


#define AS1 __attribute__((address_space(1)))
#define GLOBF(f) do { AS1 const float* g_ = (AS1 const float*)p.f; asm volatile("" : "+s"(g_)); q.f = (const float*)g_; } while (0)
__device__ __forceinline__ Params launder(const Params& p) {
    Params q;
    GLOBF(x); GLOBF(c); GLOBF(norm_w); GLOBF(w_ada); GLOBF(b_ada); GLOBF(w_in); GLOBF(b_gate); GLOBF(q_norm_a); GLOBF(k_norm_a); GLOBF(q_norm_b); GLOBF(k_norm_b); GLOBF(rel_bias);
    GLOBF(conv_w); GLOBF(conv_b); GLOBF(a_log); GLOBF(dt_bias); GLOBF(d_skip); GLOBF(ssm_norm_w); GLOBF(w_proj_a); GLOBF(w_proj_b); GLOBF(w_proj_c); GLOBF(w_out);
    { AS1 float* g_ = (AS1 float*)p.out; asm volatile("" : "+s"(g_)); q.out = (float*)g_; }
    { AS1 unsigned char* g_ = (AS1 unsigned char*)p.ws; asm volatile("" : "+s"(g_)); q.ws = (unsigned char*)g_; }
    return q;
}
__device__ __forceinline__ unsigned pk2(float lo, float hi) { f32x2 v = {lo, hi}; bf16x2_t b = __builtin_convertvector(v, bf16x2_t); return __builtin_bit_cast(unsigned, b); }
__device__ __forceinline__ float bf2f(unsigned short b) { return __uint_as_float(((unsigned)b) << 16); }
__device__ __forceinline__ float bflo(unsigned u) { return __uint_as_float(u << 16); }
__device__ __forceinline__ float bfhi(unsigned u) { return __uint_as_float(u & 0xffff0000u); }
__device__ __forceinline__ float siluf(float v) { return v * __builtin_amdgcn_rcpf(1.f + __builtin_amdgcn_exp2f(-1.4426950408889634f * v)); }
__device__ __forceinline__ float sigmf(float v) { return __builtin_amdgcn_rcpf(1.f + __builtin_amdgcn_exp2f(-1.4426950408889634f * v)); }
__device__ __forceinline__ float wave_sum(float v) {
#pragma unroll
    for (int o = 1; o < 64; o <<= 1) v += __shfl_xor(v, o);
    return v;
}
__device__ __forceinline__ v4i16 tr16(const unsigned char* p) { return __builtin_amdgcn_ds_read_tr16_b64_v4i16((LDSAS v4i16*)p); }
__device__ __forceinline__ bf16x8 cat8(v4i16 a, v4i16 b) { return (bf16x8){a[0], a[1], a[2], a[3], b[0], b[1], b[2], b[3]}; }
__device__ __forceinline__ int crow(int r, int hi) { return (r & 3) + 8 * (r >> 2) + 4 * hi; }

struct P0It { const float* W; bf16_t* Wt; const float* rs; int ldw, K, k0, n0, mode; };
__device__ __forceinline__ void p0_load(const P0It& t, float (&vv)[16]) {
    const int tid = VTID, tx = tid & 63, ty = tid >> 6;
    const int np = t.n0 + tx; int n = np; bool valid = true;
    if (t.mode == 1) {
        if (np < 4352) n = np; else if (np < 4864) n = np + 512; else if (np < 5376) n = np - 512;
        else if (np < 8448) n = np + 16; else if (np < 8464) n = np - 3072; else { valid = false; n = 0; }
    }
#pragma unroll
    for (int i = 0; i < 16; ++i) { const int k = ty + 4 * i; vv[i] = valid ? t.W[(size_t)(t.k0 + k) * t.ldw + n] : 0.f; }
}
__device__ __forceinline__ void p0_finish(const P0It& t, const float (&vv)[16], float* tile) {
    const int tid = VTID, tx = tid & 63, ty = tid >> 6;
#pragma unroll
    for (int i = 0; i < 16; ++i) { const int k = ty + 4 * i; float v = vv[i]; if (t.rs) v *= t.rs[t.k0 + k]; tile[k * 65 + tx] = v; }
    __syncthreads();
    const int r = tid >> 2, kc = (tid & 3) * 16;
    u32x4 o0, o1;
    o0.x = pk2(tile[(kc + 0) * 65 + r], tile[(kc + 1) * 65 + r]); o0.y = pk2(tile[(kc + 2) * 65 + r], tile[(kc + 3) * 65 + r]);
    o0.z = pk2(tile[(kc + 4) * 65 + r], tile[(kc + 5) * 65 + r]); o0.w = pk2(tile[(kc + 6) * 65 + r], tile[(kc + 7) * 65 + r]);
    o1.x = pk2(tile[(kc + 8) * 65 + r], tile[(kc + 9) * 65 + r]); o1.y = pk2(tile[(kc + 10) * 65 + r], tile[(kc + 11) * 65 + r]);
    o1.z = pk2(tile[(kc + 12) * 65 + r], tile[(kc + 13) * 65 + r]); o1.w = pk2(tile[(kc + 14) * 65 + r], tile[(kc + 15) * 65 + r]);
    bf16_t* dst = t.Wt + (size_t)(t.n0 + r) * t.K + t.k0 + kc;
    *(u32x4*)dst = o0; *(u32x4*)(dst + 8) = o1;
    __syncthreads();
}
constexpr int P0_IN = 16 * 136, P0_PA = 8 * 16, P0_PB = 4 * 16, P0_PC = 8 * 16, P0_OUT = 16 * 16, P0_L = P0_IN + P0_PA + P0_PB + P0_PC + P0_OUT;
__device__ __forceinline__ P0It p0_params(const Params& p, int item) {
    P0It t; const int l = item / P0_L; int r = item % P0_L; t.rs = nullptr; t.mode = 0;
    if (r < P0_IN) { t.W = p.w_in + (size_t)l * 1024 * 8464; t.ldw = 8464; t.K = 1024; t.Wt = (bf16_t*)(p.ws + WS_WIN) + (size_t)l * NP * 1024; t.k0 = (r / 136) * 64; t.n0 = (r % 136) * 64; t.mode = 1; return t; }
    r -= P0_IN;
    if (r < P0_PA) { t.W = p.w_proj_a + (size_t)l * 512 * 1024; t.ldw = 1024; t.K = 512; t.Wt = (bf16_t*)(p.ws + WS_WPA) + (size_t)l * 1024 * 512; t.k0 = (r / 16) * 64; t.n0 = (r % 16) * 64; return t; }
    r -= P0_PA;
    if (r < P0_PB) { t.W = p.w_proj_b + (size_t)l * 256 * 1024; t.ldw = 1024; t.K = 256; t.Wt = (bf16_t*)(p.ws + WS_WPB) + (size_t)l * 1024 * 256; t.k0 = (r / 16) * 64; t.n0 = (r % 16) * 64; return t; }
    r -= P0_PB;
    if (r < P0_PC) { t.W = p.w_proj_c + (size_t)l * 512 * 1024; t.ldw = 1024; t.K = 512; t.Wt = (bf16_t*)(p.ws + WS_WPC) + (size_t)l * 1024 * 512; t.k0 = (r / 16) * 64; t.n0 = (r % 16) * 64; t.rs = p.ssm_norm_w + l * 512; return t; }
    r -= P0_PC;
    t.W = p.w_out + (size_t)l * 1024 * 1024; t.ldw = 1024; t.K = 1024; t.Wt = (bf16_t*)(p.ws + WS_WOUT) + (size_t)l * 1024 * 1024; t.k0 = (r / 16) * 64; t.n0 = (r % 16) * 64; return t;
}

__device__ void phase0(const Params& p, unsigned char* smem) {
    const int tid = VTID;
    float* tile = (float*)smem;
    constexpr int I_T = 2 * P0_L, I_MOD = 192, I_ALL = I_T + I_MOD + 1;
    {
        int item = VBLK;
        if (item < I_T) {
            P0It cur = p0_params(p, item); float va[16], vb[16]; p0_load(cur, va);
            for (;;) {
                const int nx = item + VGRID; const bool more = nx < I_T; P0It nxt = cur;
                if (more) { nxt = p0_params(p, nx); p0_load(nxt, vb); }
                p0_finish(cur, va, tile);
                if (!more) break;
                item = nx; cur = nxt;
#pragma unroll
                for (int i = 0; i < 16; ++i) va[i] = vb[i];
            }
        }
    }
    for (int item = VBLK; item < I_ALL; item += VGRID) {
        if (item < I_T) {
            continue;
        } else if (item < I_T + I_MOD) {
            const int it = item - I_T, l = it / 96, col0 = (it % 96) * 32, cl = tid & 31, ks = tid >> 5;
            float a0 = 0.f, a1 = 0.f, a2 = 0.f, a3 = 0.f;
            const float* wp = p.w_ada + ((size_t)l * 1024 + ks * 128) * 3072 + col0 + cl;
#pragma unroll 8
            for (int k = 0; k < 128; ++k) {
                const float wv = wp[(size_t)k * 3072]; const int kk = ks * 128 + k;
                a0 += siluf(p.c[kk]) * wv; a1 += siluf(p.c[1024 + kk]) * wv; a2 += siluf(p.c[2048 + kk]) * wv; a3 += siluf(p.c[3072 + kk]) * wv;
            }
            float* red = (float*)smem;
            red[(ks * 32 + cl) * 4 + 0] = a0; red[(ks * 32 + cl) * 4 + 1] = a1; red[(ks * 32 + cl) * 4 + 2] = a2; red[(ks * 32 + cl) * 4 + 3] = a3;
            __syncthreads();
            if (tid < 128) { const int b = tid >> 5, c2 = tid & 31; float s = 0.f;
#pragma unroll
                for (int k = 0; k < 8; ++k) s += red[(k * 32 + c2) * 4 + b];
                ((float*)(p.ws + WS_MOD))[(l * 4 + b) * 3072 + col0 + c2] = s + p.b_ada[l * 3072 + col0 + c2]; }
            __syncthreads();
        } else {
            float* rc = (float*)(p.ws + WS_ROPE); float* rs = rc + 128 * 16;
            for (int e = tid; e < 2048; e += 256) {
                const int pos = e >> 4, i = e & 15;
                const float freq = powf(10000.0f, -(float)i / 16.0f);
                const float ang = (float)pos * freq;
                const double rev = (double)ang * 0.15915494309189535; const double fr = rev - rint(rev);
                const float a = (float)(fr * 6.283185307179586);
                rc[e] = cosf(a); rs[e] = sinf(a);
            }
            if (tid < 2) {
                const int l = tid; float mqa = 0.f, mka = 0.f, mqb = 0.f, mkb = 0.f, mb = 0.f;
                for (int i = 0; i < 64; ++i) { mqa = fmaxf(mqa, fabsf(p.q_norm_a[l * 64 + i])); mka = fmaxf(mka, fabsf(p.k_norm_a[l * 64 + i]));
                    mqb = fmaxf(mqb, fabsf(p.q_norm_b[l * 64 + i])); mkb = fmaxf(mkb, fabsf(p.k_norm_b[l * 64 + i])); }
                for (int i = 0; i < 32 * 12; ++i) mb = fmaxf(mb, p.rel_bias[i]);
                float* bd = (float*)(p.ws + WS_BND);
                bd[l] = 8.f * mqa * mka * LOG2E; bd[2 + l] = (8.f * mqb * mkb + mb) * LOG2E;
            }
        }
    }
}

__device__ void norm_phase(const Params& p, int l, int hb, const float* xsrc) {
    int tx_ = threadIdx.x; asm volatile("" : "+v"(tx_));
    const int lane = tx_ & 63, gw = blockIdx.x * 8 + (tx_ >> 6), nw = gridDim.x * 8;
    bf16_t* H = (bf16_t*)(p.ws + WS_H);
    const float* nwp = p.norm_w + l * 1024;
    for (int row = gw; row < TP; row += nw) {
        const size_t rg = (size_t)hb * TP + row; const int b = (int)(rg / SEQ);
        const f32x4* xr = (const f32x4*)(xsrc + rg * 1024);
        const float* md = (const float*)(p.ws + WS_MOD) + (size_t)(l * 4 + b) * 3072;
        f32x4 v[4]; float ss = 0.f;
#pragma unroll
        for (int j = 0; j < 4; ++j) { v[j] = xr[lane + 64 * j]; ss += v[j].x * v[j].x + v[j].y * v[j].y + v[j].z * v[j].z + v[j].w * v[j].w; }
        ss = wave_sum(ss); const float rstd = rsqrtf(ss * (1.f / 1024.f) + EPS);
#pragma unroll
        for (int j = 0; j < 4; ++j) {
            const int col = 4 * (lane + 64 * j);
            const f32x4 w4 = *(const f32x4*)(nwp + col), sh = *(const f32x4*)(md + col), sc = *(const f32x4*)(md + 1024 + col);
            const f32x4 o = v[j] * rstd * w4 * (1.f + sc) + sh;
            u32x2 pk; pk.x = pk2(o.x, o.y); pk.y = pk2(o.z, o.w);
            *(u32x2*)(H + (size_t)row * 1024 + col) = pk;
        }
    }
}

constexpr int G_STAGE = 65536, G_AB = 32768;
__device__ __forceinline__ void gemm_core(const bf16_t* __restrict__ A, int lda, const bf16_t* __restrict__ Bt, int ldb, int K, f32x4 (&acc)[8][4], unsigned char* smem, int tid) {
    asm volatile("" : "+v"(tid));
    const int lane = tid & 63, w = __builtin_amdgcn_readfirstlane(tid >> 6), wm = w >> 2, wn = w & 3, idx = lane & 15, kq = lane >> 4;
    unsigned offA[4], offB[4];
#pragma unroll
    for (int j = 0; j < 4; ++j) { const int row = (j * 8 + w) * 8 + (lane >> 3), c = (lane & 7) ^ ((row >> 1) & 7);
        offA[j] = (unsigned)(row * lda + c * 8) * 2u; offB[j] = (unsigned)(row * ldb + c * 8) * 2u; }
#pragma unroll
    for (int mi = 0; mi < 8; ++mi)
#pragma unroll
        for (int ni = 0; ni < 4; ++ni) acc[mi][ni] = (f32x4){0.f, 0.f, 0.f, 0.f};
    LDSAS unsigned char* lds = (LDSAS unsigned char*)smem;
#define G_ISSUE1(kt, st, j) do { \
        __builtin_amdgcn_global_load_lds((const unsigned*)((const char*)A + offA[j] + (kt) * 128), (LDSAS unsigned*)(lds + (st) * G_STAGE + ((j) * 8 + w) * 1024), 16, 0, 0); \
        __builtin_amdgcn_global_load_lds((const unsigned*)((const char*)Bt + offB[j] + (kt) * 128), (LDSAS unsigned*)(lds + (st) * G_STAGE + G_AB + ((j) * 8 + w) * 1024), 16, 0, 0); } while (0)
#define G_ISSUE(kt, st) do { G_ISSUE1(kt, st, 0); G_ISSUE1(kt, st, 1); G_ISSUE1(kt, st, 2); G_ISSUE1(kt, st, 3); } while (0)
    const int nk = K >> 6;
    G_ISSUE(0, 0);
    asm volatile("s_waitcnt vmcnt(0)" ::: "memory");
    __syncthreads();
    const int swz = (idx >> 1) & 7;
    const int aoff = (wm * 128 + idx) * 128, boff = G_AB + (wn * 64 + idx) * 128;
    for (int kt = 0; kt < nk; ++kt) {
        const int st = kt & 1;
        const bool more = kt + 1 < nk;
        const unsigned char* sb = smem + st * G_STAGE;
#pragma unroll
        for (int ks = 0; ks < 2; ++ks) {
            bf16x8 bfr[4], af[8];
            const int co = ((ks * 4 + kq) ^ swz) * 16;
#pragma unroll
            for (int ni = 0; ni < 4; ++ni) bfr[ni] = *(const bf16x8*)(sb + boff + ni * 2048 + co);
#pragma unroll
            for (int mi = 0; mi < 8; ++mi) af[mi] = *(const bf16x8*)(sb + aoff + mi * 2048 + co);
            if (more) { G_ISSUE1(kt + 1, st ^ 1, ks * 2); G_ISSUE1(kt + 1, st ^ 1, ks * 2 + 1); }
            __builtin_amdgcn_sched_barrier(0);
            __builtin_amdgcn_s_setprio(1);
#pragma unroll
            for (int mi = 0; mi < 8; ++mi)
#pragma unroll
                for (int ni = 0; ni < 4; ++ni) acc[mi][ni] = __builtin_amdgcn_mfma_f32_16x16x32_bf16(bfr[ni], af[mi], acc[mi][ni], 0, 0, 0);
            __builtin_amdgcn_s_setprio(0);
            __builtin_amdgcn_sched_barrier(0);
        }
        asm volatile("s_waitcnt vmcnt(0)" ::: "memory");
        __syncthreads();
    }
#undef G_ISSUE1
#undef G_ISSUE
}

__device__ __forceinline__ void st4bf(bf16_t* dst, f32x4 v) { u32x2 pk; pk.x = pk2(v.x, v.y); pk.y = pk2(v.z, v.w); *(u32x2*)dst = pk; }

__device__ void gemm1_phase(const Params& p, int l, int hb, unsigned char* smem) {
    const bf16_t* H = (const bf16_t*)(p.ws + WS_H);
    const bf16_t* Wt = (const bf16_t*)(p.ws + WS_WIN) + (size_t)l * NP * 1024;
    const float* ropec = (const float*)(p.ws + WS_ROPE); const float* ropes = ropec + 2048;
    constexpr int NT = 34, NTILES = 64 * NT, GRP = 8 * NT;
    for (int t = blockIdx.x; t < NTILES; t += gridDim.x) {
        const int grp = t / GRP, r = t % GRP, jx = NT * (r & 7) + (r >> 3), mt = grp * 8 + (jx & 7), nt = jx >> 3;
        const int m0 = mt * 256, n0 = nt * 256;
        f32x4 acc[8][4];
        int tid = threadIdx.x;
        gemm_core(H + (size_t)m0 * 1024, 1024, Wt + (size_t)n0 * 1024, 1024, 1024, acc, smem, tid);
        asm volatile("" : "+v"(tid));
        const int lane = tid & 63, w = tid >> 6, wm = w >> 2, wn = w & 3, idx = lane & 15, kq = lane >> 4;
        const int cw = n0 + wn * 64;
        const int lc = 4 * kq;
        if (cw < 768 && (cw < 640)) {
            const bool isq = cw < 512;
            const float* nwp = (isq ? p.q_norm_a : p.k_norm_a) + l * 64;
            bf16_t* dst = isq ? (bf16_t*)(p.ws + WS_QA) : (bf16_t*)(p.ws + WS_KA);
            const int pitch = isq ? 512 : 128, c0 = isq ? cw : cw - 512;
            const float qs = isq ? 0.125f * LOG2E : 1.f;
#pragma unroll
            for (int mi = 0; mi < 8; ++mi) {
                const int row = m0 + wm * 128 + mi * 16 + idx;
                float ss = 0.f;
#pragma unroll
                for (int ni = 0; ni < 4; ++ni) { const f32x4 v = acc[mi][ni]; ss += v.x * v.x + v.y * v.y + v.z * v.z + v.w * v.w; }
                ss += __shfl_xor(ss, 16); ss += __shfl_xor(ss, 32);
                const float rstd = rsqrtf(ss * (1.f / 64.f) + EPS);
                f32x4 y[4];
#pragma unroll
                for (int ni = 0; ni < 4; ++ni) y[ni] = acc[mi][ni] * rstd * *(const f32x4*)(nwp + ni * 16 + lc);
                const int tt = row & (SEQ - 1), prow = tt >> 6, pcol = tt & 63;
#pragma unroll
                for (int hf = 0; hf < 2; ++hf) {
                    const int pos = hf ? pcol : prow;
                    const f32x4 cs = *(const f32x4*)(ropec + pos * 16 + lc), sn = *(const f32x4*)(ropes + pos * 16 + lc);
                    const f32x4 a = y[2 * hf], b = y[2 * hf + 1];
                    y[2 * hf] = a * cs - b * sn; y[2 * hf + 1] = b * cs + a * sn;
                }
#pragma unroll
                for (int ni = 0; ni < 4; ++ni) st4bf(dst + (size_t)row * pitch + c0 + ni * 16 + lc, y[ni] * qs);
            }
        } else if (cw >= 1280 && cw < 2816) {
            const bool isq = cw < 2048;
            const float* nwp = (isq ? p.q_norm_b : p.k_norm_b) + l * 64;
            const int gc = isq ? cw - 1280 : cw - 2048, g = gc >> 8, c0 = gc & 255;
            const int sh = 2 * g;
            bf16_t* dst = (bf16_t*)(p.ws + (isq ? WS_QB : WS_KB));
            const float qs = isq ? 0.125f * LOG2E : 1.f;
#pragma unroll
            for (int mi = 0; mi < 8; ++mi) {
                const int row = m0 + wm * 128 + mi * 16 + idx;
                float ss = 0.f;
#pragma unroll
                for (int ni = 0; ni < 4; ++ni) { const f32x4 v = acc[mi][ni]; ss += v.x * v.x + v.y * v.y + v.z * v.z + v.w * v.w; }
                ss += __shfl_xor(ss, 16); ss += __shfl_xor(ss, 32);
                const float rstd = rsqrtf(ss * (1.f / 64.f) + EPS) * qs;
                const int bl = row >> 13, tt = row & (SEQ - 1);
                const int pp = (tt & ((1 << sh) - 1)) * (SEQ >> sh) + (tt >> sh);
                bf16_t* drow = dst + ((size_t)(bl * 3 + g) * SEQ + pp) * 256 + c0 + lc;
#pragma unroll
                for (int ni = 0; ni < 4; ++ni) st4bf(drow + ni * 16, acc[mi][ni] * rstd * *(const f32x4*)(nwp + ni * 16 + lc));
            }
        } else if (cw >= 2816 && cw < 3584) {
            const int gc = cw - 2816, g = gc >> 8, c0 = gc & 255, sh = 2 * g;
            bf16_t* dst = (bf16_t*)(p.ws + WS_VB);
#pragma unroll
            for (int mi = 0; mi < 8; ++mi) {
                const int row = m0 + wm * 128 + mi * 16 + idx;
                const int bl = row >> 13, tt = row & (SEQ - 1);
                const int pp = (tt & ((1 << sh) - 1)) * (SEQ >> sh) + (tt >> sh);
                bf16_t* drow = dst + ((size_t)(bl * 3 + g) * SEQ + pp) * 256 + c0 + lc;
#pragma unroll
                for (int ni = 0; ni < 4; ++ni) st4bf(drow + ni * 16, acc[mi][ni]);
            }
        } else if (cw >= 8448) {
            if (cw == 8448) {
                float* dst = (float*)(p.ws + WS_DT);
                const f32x4 bias = *(const f32x4*)(p.dt_bias + l * 16 + lc);
#pragma unroll
                for (int mi = 0; mi < 8; ++mi) {
                    const int row = m0 + wm * 128 + mi * 16 + idx;
                    f32x4 v = acc[mi][0] + bias, o;
                    o.x = v.x > 20.f ? v.x : log1pf(__expf(v.x)); o.y = v.y > 20.f ? v.y : log1pf(__expf(v.y));
                    o.z = v.z > 20.f ? v.z : log1pf(__expf(v.z)); o.w = v.w > 20.f ? v.w : log1pf(__expf(v.w));
                    *(f32x4*)(dst + (size_t)row * 16 + lc) = o;
                }
            }
        } else {
            bf16_t* dst; int pitch, c0, mode;
            if (cw < 768) { dst = (bf16_t*)(p.ws + WS_VA); pitch = 128; c0 = cw - 640; mode = 0; }
            else if (cw < 1280) { dst = (bf16_t*)(p.ws + WS_GA); pitch = 512; c0 = cw - 768; mode = 1; }
            else if (cw < 3840) { dst = (bf16_t*)(p.ws + WS_GB); pitch = 256; c0 = cw - 3584; mode = 1; }
            else if (cw < 4864) { dst = (bf16_t*)(p.ws + WS_XBC); pitch = 1024; c0 = cw - 3840; mode = 0; }
            else if (cw < 5376) { dst = (bf16_t*)(p.ws + WS_ZS); pitch = 512; c0 = cw - 4864; mode = 1; }
            else { dst = (bf16_t*)(p.ws + WS_MG); pitch = 3072; c0 = cw - 5376; mode = 2; }
            const float* bg = p.b_gate + l * 3072 + c0 + lc;
#pragma unroll
            for (int mi = 0; mi < 8; ++mi) {
                const int row = m0 + wm * 128 + mi * 16 + idx;
#pragma unroll
                for (int ni = 0; ni < 4; ++ni) {
                    f32x4 v = acc[mi][ni];
                    if (mode == 1) { v.x = siluf(v.x); v.y = siluf(v.y); v.z = siluf(v.z); v.w = siluf(v.w); }
                    else if (mode == 2) { const f32x4 bb = *(const f32x4*)(bg + ni * 16); v.x = sigmf(v.x + bb.x); v.y = sigmf(v.y + bb.y); v.z = sigmf(v.z + bb.z); v.w = sigmf(v.w + bb.w); }
                    st4bf(dst + (size_t)row * pitch + c0 + ni * 16 + lc, v);
                }
            }
        }
    }
}

__device__ void merge_phase(const Params& p, int l, unsigned char* smem) {
    const bf16_t* MG = (const bf16_t*)(p.ws + WS_MG);
    const float* rstd = (const float*)(p.ws + WS_RSTD);
    bf16_t* MR = (bf16_t*)(p.ws + WS_MRG);
    for (int t = blockIdx.x; t < 64 * 4; t += gridDim.x) {
        const int xq = t >> 3, mt = (xq >> 2) * 8 + (t & 7), nt = xq & 3, m0 = mt * 256, n0 = nt * 256;
#pragma unroll 1
        for (int br = 0; br < 3; ++br) {
            f32x4 acc[8][4];
            const bf16_t* A; const bf16_t* Bt; int K;
            if (br == 0) { A = (const bf16_t*)(p.ws + WS_QA); K = 512; Bt = (const bf16_t*)(p.ws + WS_WPA) + (size_t)l * 1024 * 512; }
            else if (br == 1) { A = (const bf16_t*)(p.ws + WS_YBM); K = 256; Bt = (const bf16_t*)(p.ws + WS_WPB) + (size_t)l * 1024 * 256; }
            else { A = (const bf16_t*)(p.ws + WS_YC); K = 512; Bt = (const bf16_t*)(p.ws + WS_WPC) + (size_t)l * 1024 * 512; }
            int tid = threadIdx.x;
            gemm_core(A + (size_t)m0 * K, K, Bt + (size_t)n0 * K, K, K, acc, smem, tid);
            asm volatile("" : "+v"(tid));
            const int lane = tid & 63, w = tid >> 6, wm = w >> 2, wn = w & 3, idx = lane & 15, kq = lane >> 4;
#pragma unroll
            for (int mi = 0; mi < 8; ++mi) {
                const int row = m0 + wm * 128 + mi * 16 + idx;
                const float rs = (br == 2) ? rstd[row] : 1.f;
#pragma unroll
                for (int ni = 0; ni < 4; ++ni) {
                    const int col = n0 + wn * 64 + ni * 16 + 4 * kq;
                    const u32x2 g = *(const u32x2*)(MG + (size_t)row * 3072 + br * 1024 + col);
                    f32x4 gv; gv.x = bflo(g.x); gv.y = bfhi(g.x); gv.z = bflo(g.y); gv.w = bfhi(g.y);
                    f32x4 v = gv * rs * acc[mi][ni];
                    bf16_t* mp = MR + (size_t)row * 1024 + col;
                    if (br > 0) { const u32x2 o = *(const u32x2*)mp; v.x += bflo(o.x); v.y += bfhi(o.x); v.z += bflo(o.y); v.w += bfhi(o.y); }
                    st4bf(mp, v);
                }
            }
        }
    }
}

__device__ void out_phase(const Params& p, int l, int hb, const float* xsrc, unsigned char* smem) {
    const bf16_t* MR = (const bf16_t*)(p.ws + WS_MRG);
    const bf16_t* Wt = (const bf16_t*)(p.ws + WS_WOUT) + (size_t)l * 1024 * 1024;
    for (int t = blockIdx.x; t < 64 * 4; t += gridDim.x) {
        const int xq = t >> 3, mt = (xq >> 2) * 8 + (t & 7), nt = xq & 3, m0 = mt * 256, n0 = nt * 256;
        f32x4 acc[8][4];
        int tid = threadIdx.x;
        gemm_core(MR + (size_t)m0 * 1024, 1024, Wt + (size_t)n0 * 1024, 1024, 1024, acc, smem, tid);
        asm volatile("" : "+v"(tid));
        const int lane = tid & 63, w = tid >> 6, wm = w >> 2, wn = w & 3, idx = lane & 15, kq = lane >> 4;
#pragma unroll
        for (int mi = 0; mi < 8; ++mi) {
            const int row = m0 + wm * 128 + mi * 16 + idx; const size_t rg = (size_t)hb * TP + row; const int b = (int)(rg / SEQ);
            const float* gate = (const float*)(p.ws + WS_MOD) + (size_t)(l * 4 + b) * 3072 + 2048;
#pragma unroll
            for (int ni = 0; ni < 4; ++ni) {
                const int col = n0 + wn * 64 + ni * 16 + 4 * kq;
                const f32x4 xv = *(const f32x4*)(xsrc + rg * 1024 + col), gv = *(const f32x4*)(gate + col);
                *(f32x4*)(p.out + rg * 1024 + col) = xv + gv * acc[mi][ni];
            }
        }
    }
}

constexpr int AT_KS = 0, AT_VS = 9216, AT_LQ = 9216 + 8192, AT_LUT = AT_LQ + 512;

#define AT_STAGE_STORE() do { _Pragma("unroll") for (int i = 0; i < 2; ++i) { const int c = tid + 256 * i, row = c >> 3, ch = c & 7; \
        *(u32x4*)(Ks + row * 72 + ch * 8) = rk[i]; *(u32x4*)(Vs + (ch >> 2) * 4096 + row * 64 + (ch & 3) * 16) = rv[i]; } } while (0)

__device__ __forceinline__ void at_qk(f32x16& p0, f32x16& p1, const bf16_t* Ks, const bf16x8* qr, int r32, int hi) {
    bf16x8 kf[8];
#pragma unroll
    for (int ds = 0; ds < 4; ++ds) {
        kf[2 * ds] = *(const bf16x8*)(Ks + r32 * 72 + ds * 16 + hi * 8);
        kf[2 * ds + 1] = *(const bf16x8*)(Ks + (r32 + 32) * 72 + ds * 16 + hi * 8);
    }
    __builtin_amdgcn_sched_barrier(0);
    __builtin_amdgcn_s_setprio(1);
#pragma unroll
    for (int ds = 0; ds < 4; ++ds) {
        p0 = __builtin_amdgcn_mfma_f32_32x32x16_bf16(kf[2 * ds], qr[ds], p0, 0, 0, 0);
        p1 = __builtin_amdgcn_mfma_f32_32x32x16_bf16(kf[2 * ds + 1], qr[ds], p1, 0, 0, 0);
    }
    __builtin_amdgcn_s_setprio(0);
    __builtin_amdgcn_sched_barrier(0);
}
__device__ __forceinline__ void at_pv(f32x16& o0, f32x16& o1, const f32x16& p0, const f32x16& p1, const unsigned char* Vs, int lane) {
    const int hi = lane >> 5;
    const unsigned char* vb = Vs + ((lane >> 4) & 1) * 32 + (lane & 3) * 8 + (4 * hi + ((lane & 15) >> 2)) * 64;
    bf16x8 v0[4], v1[4], pa[4];
#pragma unroll
    for (int s = 0; s < 4; ++s) {
        v0[s] = cat8(tr16(vb + s * 1024), tr16(vb + s * 1024 + 512));
        v1[s] = cat8(tr16(vb + 4096 + s * 1024), tr16(vb + 4096 + s * 1024 + 512));
    }
#pragma unroll
    for (int s = 0; s < 4; ++s) {
        u32x4 pw;
        if (s < 2) { pw.x = pk2(p0[8 * s + 0], p0[8 * s + 1]); pw.y = pk2(p0[8 * s + 2], p0[8 * s + 3]); pw.z = pk2(p0[8 * s + 4], p0[8 * s + 5]); pw.w = pk2(p0[8 * s + 6], p0[8 * s + 7]); }
        else { const int q = s - 2; pw.x = pk2(p1[8 * q + 0], p1[8 * q + 1]); pw.y = pk2(p1[8 * q + 2], p1[8 * q + 3]); pw.z = pk2(p1[8 * q + 4], p1[8 * q + 5]); pw.w = pk2(p1[8 * q + 6], p1[8 * q + 7]); }
        pa[s] = __builtin_bit_cast(bf16x8, pw);
    }
    __builtin_amdgcn_sched_barrier(0);
    __builtin_amdgcn_s_setprio(1);
#pragma unroll
    for (int s = 0; s < 4; ++s) {
        o0 = __builtin_amdgcn_mfma_f32_32x32x16_bf16(pa[s], v0[s], o0, 0, 0, 0);
        o1 = __builtin_amdgcn_mfma_f32_32x32x16_bf16(pa[s], v1[s], o1, 0, 0, 0);
    }
    __builtin_amdgcn_s_setprio(0);
    __builtin_amdgcn_sched_barrier(0);
}

__device__ __forceinline__ void at_ldv(bf16x8 (&v0)[4], bf16x8 (&v1)[4], const unsigned char* Vs, int lane) {
    const int hi = lane >> 5;
    const unsigned char* vb = Vs + ((lane >> 4) & 1) * 32 + (lane & 3) * 8 + (4 * hi + ((lane & 15) >> 2)) * 64;
#pragma unroll
    for (int s = 0; s < 4; ++s) {
        v0[s] = cat8(tr16(vb + s * 1024), tr16(vb + s * 1024 + 512));
        v1[s] = cat8(tr16(vb + 4096 + s * 1024), tr16(vb + 4096 + s * 1024 + 512));
    }
}
__device__ __forceinline__ void at_pv2(f32x16& o0, f32x16& o1, const f32x16& p0, const f32x16& p1, const bf16x8 (&v0)[4], const bf16x8 (&v1)[4]) {
    bf16x8 pa[4];
#pragma unroll
    for (int s = 0; s < 4; ++s) {
        u32x4 pw;
        if (s < 2) { pw.x = pk2(p0[8 * s + 0], p0[8 * s + 1]); pw.y = pk2(p0[8 * s + 2], p0[8 * s + 3]); pw.z = pk2(p0[8 * s + 4], p0[8 * s + 5]); pw.w = pk2(p0[8 * s + 6], p0[8 * s + 7]); }
        else { const int q = s - 2; pw.x = pk2(p1[8 * q + 0], p1[8 * q + 1]); pw.y = pk2(p1[8 * q + 2], p1[8 * q + 3]); pw.z = pk2(p1[8 * q + 4], p1[8 * q + 5]); pw.w = pk2(p1[8 * q + 6], p1[8 * q + 7]); }
        pa[s] = __builtin_bit_cast(bf16x8, pw);
    }
    __builtin_amdgcn_sched_barrier(0);
    __builtin_amdgcn_s_setprio(1);
#pragma unroll
    for (int s = 0; s < 4; ++s) {
        o0 = __builtin_amdgcn_mfma_f32_32x32x16_bf16(pa[s], v0[s], o0, 0, 0, 0);
        o1 = __builtin_amdgcn_mfma_f32_32x32x16_bf16(pa[s], v1[s], o1, 0, 0, 0);
    }
    __builtin_amdgcn_s_setprio(0);
    __builtin_amdgcn_sched_barrier(0);
}

constexpr int ATA_STAGE = 17408, ATA_LQ = 2 * ATA_STAGE;
__device__ void attn_a_item(const Params& p, int item, int l, unsigned char* smem) {
    int tid_ = VTID; asm volatile("" : "+v"(tid_));
    const int tid = tid_, lane = tid & 63, w = tid >> 6, r32 = lane & 31, hi = lane >> 5;
    const int b = item >> 9, r = item & 511, kvh = r >> 8, qblk = (r >> 2) & 63, hq = kvh * 4 + (r & 3);
    float* lq = (float*)(smem + ATA_LQ) + w * 32;
    bf16_t* QA = (bf16_t*)(p.ws + WS_QA);
    const bf16_t* GA = (const bf16_t*)(p.ws + WS_GA);
    const size_t tokq = (size_t)b * SEQ + qblk * 128 + w * 32;
    bf16x8 qr[4];
#pragma unroll
    for (int ds = 0; ds < 4; ++ds) qr[ds] = *(const bf16x8*)(QA + (tokq + r32) * 512 + hq * 64 + ds * 16 + hi * 8);
    const bf16_t* Kb = (const bf16_t*)(p.ws + WS_KA) + (size_t)b * SEQ * 128 + kvh * 64;
    const bf16_t* Vb = (const bf16_t*)(p.ws + WS_VA) + (size_t)b * SEQ * 128 + kvh * 64;
    const float nshift = -((const float*)(p.ws + WS_BND))[l];
    f32x16 o0, o1;
#pragma unroll
    for (int i = 0; i < 16; ++i) { o0[i] = 0.f; o1[i] = 0.f; }
    f32x4 la4 = (f32x4){0.f, 0.f, 0.f, 0.f};
    constexpr int NT = SEQ / 64;
    const int row0 = tid >> 3, ch0 = tid & 7;
    const size_t goff0 = (size_t)row0 * 128 + ch0 * 8, goff1 = goff0 + (size_t)32 * 128;
    const int ko0 = row0 * 144 + ch0 * 16, ko1 = ko0 + 32 * 144;
    const int vo0 = 9216 + (ch0 >> 2) * 4096 + row0 * 64 + (ch0 & 3) * 16, vo1 = vo0 + 32 * 64;
    u32x4 rkA[2], rvA[2], rkB[2], rvB[2];
#define ATA_LOAD(RK, RV, t) do { const size_t tb = (size_t)(t) * 64 * 128; RK[0] = *(const u32x4*)(Kb + tb + goff0); RK[1] = *(const u32x4*)(Kb + tb + goff1); \
        RV[0] = *(const u32x4*)(Vb + tb + goff0); RV[1] = *(const u32x4*)(Vb + tb + goff1); } while (0)
#define ATA_STORE(RK, RV, st) do { unsigned char* sb_ = smem + (st) * ATA_STAGE; *(u32x4*)(sb_ + ko0) = RK[0]; *(u32x4*)(sb_ + ko1) = RK[1]; \
        *(u32x4*)(sb_ + vo0) = RV[0]; *(u32x4*)(sb_ + vo1) = RV[1]; } while (0)
#define ATA_COMPUTE(st) do { const unsigned char* sb_ = smem + (st) * ATA_STAGE; f32x16 p0, p1; bf16x8 vf0[4], vf1[4]; \
        _Pragma("unroll") for (int i = 0; i < 16; ++i) { p0[i] = nshift; p1[i] = nshift; } \
        at_qk(p0, p1, (const bf16_t*)sb_, qr, r32, hi); \
        at_ldv(vf0, vf1, sb_ + 9216, lane); __builtin_amdgcn_sched_barrier(0); \
        _Pragma("unroll") for (int i = 0; i < 16; ++i) { p0[i] = __builtin_amdgcn_exp2f(p0[i]); p1[i] = __builtin_amdgcn_exp2f(p1[i]); } \
        _Pragma("unroll") for (int i = 0; i < 4; ++i) { la4 += (f32x4){p0[4 * i], p0[4 * i + 1], p0[4 * i + 2], p0[4 * i + 3]}; la4 += (f32x4){p1[4 * i], p1[4 * i + 1], p1[4 * i + 2], p1[4 * i + 3]}; } \
        at_pv2(o0, o1, p0, p1, vf0, vf1); } while (0)
    __syncthreads();
    ATA_LOAD(rkA, rvA, 0); ATA_LOAD(rkB, rvB, 1);
    ATA_STORE(rkA, rvA, 0);
    ATA_LOAD(rkA, rvA, 2);
    __syncthreads();
    for (int kt = 0; kt < NT; kt += 2) {
        ATA_COMPUTE(0);
        ATA_STORE(rkB, rvB, 1);
        if (kt + 3 < NT) ATA_LOAD(rkB, rvB, kt + 3);
        __syncthreads();
        ATA_COMPUTE(1);
        if (kt + 2 < NT) { ATA_STORE(rkA, rvA, 0); if (kt + 4 < NT) ATA_LOAD(rkA, rvA, kt + 4); }
        __syncthreads();
    }
#undef ATA_LOAD
#undef ATA_STORE
#undef ATA_COMPUTE
    float lacc = (la4.x + la4.y) + (la4.z + la4.w);
    lacc += __shfl_xor(lacc, 32);
    if (hi == 0) lq[r32] = lacc;
    asm volatile("s_waitcnt lgkmcnt(0)" ::: "memory");
#pragma unroll
    for (int rr = 0; rr < 16; ++rr) {
        const int q = crow(rr, hi); const float inv = 1.f / lq[q];
        const size_t off = (tokq + q) * 512 + hq * 64 + r32;
        const float g0 = bf2f(GA[off]), g1 = bf2f(GA[off + 32]);
        QA[off] = (bf16_t)(pk2(o0[rr] * inv * g0, 0.f) & 0xffffu);
        QA[off + 32] = (bf16_t)(pk2(o1[rr] * inv * g1, 0.f) & 0xffffu);
    }
}

__device__ void attn_b_item(const Params& p, int item, int l, unsigned char* smem) {
    int tid_ = VTID; asm volatile("" : "+v"(tid_));
    const int tid = tid_, lane = tid & 63, w = tid >> 6, r32 = lane & 31, hi = lane >> 5;
    const int blk = item & 63, j = (item >> 6) & 3, bg = item >> 8, g = bg % 3, b = bg / 3;
    const int sh = 2 * g, dil = 1 << sh, Mlen = SEQ >> sh;
    bf16_t* Ks = (bf16_t*)(smem + AT_KS); unsigned char* Vs = smem + AT_VS; float* lq = (float*)(smem + AT_LQ) + w * 32; float* lut = (float*)(smem + AT_LUT);
    bf16_t* QB = (bf16_t*)(p.ws + WS_QB) + (size_t)bg * SEQ * 256 + j * 64;
    const bf16_t* KB = (const bf16_t*)(p.ws + WS_KB) + (size_t)bg * SEQ * 256 + j * 64;
    const bf16_t* VB = (const bf16_t*)(p.ws + WS_VB) + (size_t)bg * SEQ * 256 + j * 64;
    float* LSE = (float*)(p.ws + WS_LSE) + (size_t)bg * SEQ * 4 + j;
    const int p0r = blk * 128, seq_lo = (p0r / Mlen) * Mlen, seq_hi = seq_lo + Mlen;
    __syncthreads();
    if (tid < 129) {
        const int rel = tid - 64, n = (rel < 0 ? -rel : rel) * dil;
        int bk;
        if (n < 8) bk = n; else { bk = 8 + (n >= 15) + (n >= 27) + (n >= 50) + (n >= 91) + (n >= 166) + (n >= 305) + (n >= 559); }
        if (rel > 0) bk += 16;
        lut[tid] = p.rel_bias[bk * 12 + g * 4 + j] * LOG2E;
    }
    const int qpos = p0r + w * 32 + r32;
    bf16x8 qr[4];
#pragma unroll
    for (int ds = 0; ds < 4; ++ds) qr[ds] = *(const bf16x8*)(QB + (size_t)qpos * 256 + ds * 16 + hi * 8);
    const float nshift = -((const float*)(p.ws + WS_BND))[2 + l];
    f32x16 o0, o1;
#pragma unroll
    for (int i = 0; i < 16; ++i) { o0[i] = 0.f; o1[i] = 0.f; }
    f32x4 la4 = (f32x4){0.f, 0.f, 0.f, 0.f};
    u32x4 rk[2], rv[2];
    for (int kt = 0; kt < 4; ++kt) {
        const int kbase = p0r - 64 + 64 * kt;
#pragma unroll
        for (int i = 0; i < 2; ++i) { const int c = tid + 256 * i, row = c >> 3, ch = c & 7;
            int pr = kbase + row; pr = pr < 0 ? 0 : (pr > SEQ - 1 ? SEQ - 1 : pr);
            rk[i] = *(const u32x4*)(KB + (size_t)pr * 256 + ch * 8); rv[i] = *(const u32x4*)(VB + (size_t)pr * 256 + ch * 8); }
        __syncthreads();
        AT_STAGE_STORE();
        __syncthreads();
        f32x16 p0, p1;
#pragma unroll
        for (int i = 0; i < 16; ++i) { p0[i] = nshift; p1[i] = nshift; }
        at_qk(p0, p1, Ks, qr, r32, hi);
#pragma unroll
        for (int i = 0; i < 16; ++i) {
            const int kv0 = kbase + crow(i, hi), kv1 = kv0 + 32;
            const int rel0 = kv0 - qpos, rel1 = kv1 - qpos;
            const bool ok0 = rel0 >= -64 && rel0 <= 64 && kv0 >= seq_lo && kv0 < seq_hi;
            const bool ok1 = rel1 >= -64 && rel1 <= 64 && kv1 >= seq_lo && kv1 < seq_hi;
            const float e0 = __builtin_amdgcn_exp2f(p0[i] + lut[ok0 ? rel0 + 64 : 64]);
            const float e1 = __builtin_amdgcn_exp2f(p1[i] + lut[ok1 ? rel1 + 64 : 64]);
            p0[i] = ok0 ? e0 : 0.f; p1[i] = ok1 ? e1 : 0.f;
        }
#pragma unroll
        for (int i = 0; i < 4; ++i) { la4 += (f32x4){p0[4 * i], p0[4 * i + 1], p0[4 * i + 2], p0[4 * i + 3]}; la4 += (f32x4){p1[4 * i], p1[4 * i + 1], p1[4 * i + 2], p1[4 * i + 3]}; }
        at_pv(o0, o1, p0, p1, Vs, lane);
    }
    float lacc = (la4.x + la4.y) + (la4.z + la4.w);
    lacc += __shfl_xor(lacc, 32);
    if (hi == 0) { lq[r32] = lacc; LSE[(size_t)qpos * 4] = (-nshift + log2f(lacc)) * LN2; }
    asm volatile("s_waitcnt lgkmcnt(0)" ::: "memory");
#pragma unroll
    for (int rr = 0; rr < 16; ++rr) {
        const int q = crow(rr, hi); const float inv = 1.f / lq[q];
        const size_t off = (size_t)(p0r + w * 32 + q) * 256 + r32;
        QB[off] = (bf16_t)(pk2(o0[rr] * inv, 0.f) & 0xffffu);
        QB[off + 32] = (bf16_t)(pk2(o1[rr] * inv, 0.f) & 0xffffu);
    }
}

__device__ void conv_phase(const Params& p, int l) {
    int tx_ = threadIdx.x; asm volatile("" : "+v"(tx_));
    const bf16_t* XBC = (const bf16_t*)(p.ws + WS_XBC);
    bf16_t* XC = (bf16_t*)(p.ws + WS_XBCC);
    const float* cw = p.conv_w + (size_t)l * 5 * 1024; const float* cb = p.conv_b + l * 1024;
    const int nthr = gridDim.x * 512;
    for (int u = blockIdx.x * 512 + tx_; u < (TP / 4) * 128; u += nthr) {
        const int ch = (u & 127) * 8, tg = u >> 7, tok0 = tg * 4, tt0 = tok0 & (SEQ - 1);
        u32x4 raw[8];
#pragma unroll
        for (int r = 0; r < 8; ++r) { const int tt = tt0 - 2 + r; raw[r] = (u32x4){0u, 0u, 0u, 0u};
            if (tt >= 0 && tt < SEQ) raw[r] = *(const u32x4*)(XBC + (size_t)(tok0 - 2 + r) * 1024 + ch); }
        float ac[4][8];
        { const f32x4 a = *(const f32x4*)(cb + ch), b2 = *(const f32x4*)(cb + ch + 4);
#pragma unroll
          for (int t = 0; t < 4; ++t) { ac[t][0] = a.x; ac[t][1] = a.y; ac[t][2] = a.z; ac[t][3] = a.w; ac[t][4] = b2.x; ac[t][5] = b2.y; ac[t][6] = b2.z; ac[t][7] = b2.w; } }
#pragma unroll
        for (int k = 0; k < 5; ++k) { const f32x4 wa = *(const f32x4*)(cw + k * 1024 + ch), wb = *(const f32x4*)(cw + k * 1024 + ch + 4);
#pragma unroll
            for (int t = 0; t < 4; ++t) { const u32x4 v = raw[t + k];
                ac[t][0] += bflo(v.x) * wa.x; ac[t][1] += bfhi(v.x) * wa.y; ac[t][2] += bflo(v.y) * wa.z; ac[t][3] += bfhi(v.y) * wa.w;
                ac[t][4] += bflo(v.z) * wb.x; ac[t][5] += bfhi(v.z) * wb.y; ac[t][6] += bflo(v.w) * wb.z; ac[t][7] += bfhi(v.w) * wb.w; } }
#pragma unroll
        for (int t = 0; t < 4; ++t) { u32x4 o;
            o.x = pk2(siluf(ac[t][0]), siluf(ac[t][1])); o.y = pk2(siluf(ac[t][2]), siluf(ac[t][3])); o.z = pk2(siluf(ac[t][4]), siluf(ac[t][5])); o.w = pk2(siluf(ac[t][6]), siluf(ac[t][7]));
            *(u32x4*)(XC + (size_t)(tok0 + t) * 1024 + ch) = o; }
    }
}

constexpr int SS_BS = 0, SS_CS = 8704, SS_XS = 17408, SS_XWS = 22016, SS_GS = 26624, SS_SB = 29184, SS_CW = 46592, SS_SC = 54272, SS_DTA = 55296, SS_END = 57344;

template <int PASS>
__device__ void ssd_item(const Params& p, int item, int l, unsigned char* smem) {
    int tid_ = VTID; asm volatile("" : "+v"(tid_));
    const int tid = tid_, lane = tid & 63, w = tid >> 6, idx = lane & 15, kq = lane >> 4;
    const int seg = item & 15, h = (item >> 4) & 7, dir = (item >> 7) & 1, b = item >> 8, grp = h >> 2;
    bf16_t* Bs = (bf16_t*)(smem + SS_BS); bf16_t* Cs = (bf16_t*)(smem + SS_CS); bf16_t* Xs = (bf16_t*)(smem + SS_XS); bf16_t* Xws = (bf16_t*)(smem + SS_XWS);
    bf16_t* Gs = (bf16_t*)(smem + SS_GS); bf16_t* Sb = (bf16_t*)(smem + SS_SB); float* cwl = (float*)(smem + SS_CW); float* sc = (float*)(smem + SS_SC);
    float* s_dt = sc, *s_c = sc + 32, *s_rs = sc + 64, *s_wl = sc + 96, *s_tot = sc + 128;
    const bf16_t* XBC = (const bf16_t*)(p.ws + WS_XBC);
    const float* DT = (const float*)(p.ws + WS_DT);
    float* ST = (float*)(p.ws + WS_ST); float* SEGT = (float*)(p.ws + WS_SEGT);
    bf16_t* Y = (bf16_t*)(p.ws + (dir ? WS_YS : WS_YF));
    const float Aneg = -__expf(p.a_log[l * 16 + dir * 8 + h]);
    const float Dh = p.d_skip[l * 8 + h];
    __syncthreads();
    f32x4 S[8];
#pragma unroll
    for (int nt = 0; nt < 8; ++nt) S[nt] = (f32x4){0.f, 0.f, 0.f, 0.f};
    const int ibase = item & ~15;
    if (PASS == 3) {
        if (dir == 0) {
            for (int e = 0; e < seg; ++e) { const float dc = __expf(SEGT[ibase + e]); const f32x4* src = (const f32x4*)(ST + (size_t)(ibase + e) * 8192);
#pragma unroll
                for (int nt = 0; nt < 8; ++nt) S[nt] = S[nt] * dc + src[(w * 8 + nt) * 64 + lane]; }
        } else {
            for (int e = NSEG - 1; e > seg; --e) { const float dc = __expf(SEGT[ibase + e]); const f32x4* src = (const f32x4*)(ST + (size_t)(ibase + e) * 8192);
#pragma unroll
                for (int nt = 0; nt < 8; ++nt) S[nt] = S[nt] * dc + src[(w * 8 + nt) * 64 + lane]; }
        }
#pragma unroll
        for (int nt = 0; nt < 8; ++nt) st4bf(Sb + (16 * w + idx) * 136 + 16 * nt + 4 * kq, S[nt]);
    }
    float* s_dta = (float*)(smem + SS_DTA);
    for (int e = tid; e < SEGLEN; e += 256) s_dta[e] = DT[((size_t)b * SEQ + seg * SEGLEN + e) * 16 + dir * 8 + h];
    float segtot = 0.f;
    const size_t tokb = (size_t)b * SEQ;
    const unsigned char* xb_ = (const unsigned char*)((const bf16_t*)(p.ws + WS_XBCC) + tokb * 1024);
    unsigned soff[5];
#pragma unroll
    for (int i = 0; i < 5; ++i) { const int u = tid + 256 * i, lrow = u / 40, ci = u % 40;
        const int scol = ci < 8 ? h * 64 + ci * 8 : (ci < 24 ? 512 + grp * 128 + (ci * 8 - 64) : 768 + grp * 128 + (ci * 8 - 192));
        soff[i] = (unsigned)((lrow * 1024 + scol) * 2); }
    for (int si = 0; si < NSUB; ++si) {
        const int scn = dir ? (NSUB - 1 - si) : si;
        const int t0 = seg * SEGLEN + scn * TSUB;
        __syncthreads();
        u32x4 raw[5];
#pragma unroll
        for (int i = 0; i < 5; ++i) raw[i] = *(const u32x4*)(xb_ + ((unsigned)(t0 * 2048) + soff[i]));
        if (w == 0) {
            float dtv = 0.f, av = 0.f;
            if (lane < 32) { dtv = s_dta[scn * TSUB + lane]; av = dtv * Aneg; }
            float pre = av;
#pragma unroll
            for (int o = 1; o < 32; o <<= 1) { const float t = __shfl_up(pre, o); if (lane >= o) pre += t; }
            const float tot = __shfl(pre, 31);
            const float cc = dir ? (tot - pre + av) : pre;
            if (lane < 32) { s_dt[lane] = dtv; s_c[lane] = cc; s_rs[lane] = __expf(cc); s_wl[lane] = dtv * __expf(tot - cc); }
            if (lane == 0) s_tot[0] = tot;
        }
        __syncthreads();
        segtot += s_tot[0];
#pragma unroll
        for (int i = 0; i < 5; ++i) { const int u = tid + 256 * i, lrow = u / 40, ci = u % 40, lc = ci * 8; const u32x4 o = raw[i];
            if (ci < 8) { *(u32x4*)(Xs + lrow * 72 + lc) = o; const float wl = s_wl[lrow];
                u32x4 o2; o2.x = pk2(bflo(o.x) * wl, bfhi(o.x) * wl); o2.y = pk2(bflo(o.y) * wl, bfhi(o.y) * wl); o2.z = pk2(bflo(o.z) * wl, bfhi(o.z) * wl); o2.w = pk2(bflo(o.w) * wl, bfhi(o.w) * wl);
                *(u32x4*)(Xws + lrow * 72 + lc) = o2; }
            else if (ci < 24) *(u32x4*)(Bs + lrow * 136 + (lc - 64)) = o;
            else *(u32x4*)(Cs + lrow * 136 + (lc - 192)) = o; }
        __syncthreads();
        if (PASS == 3) {
            const int it = w >> 1, jt = w & 1;
            f32x4 cb = (f32x4){0.f, 0.f, 0.f, 0.f};
            {
                bf16x8 fb[4], fc[4];
#pragma unroll
                for (int ks = 0; ks < 4; ++ks) { fb[ks] = *(const bf16x8*)(Bs + (16 * jt + idx) * 136 + ks * 32 + kq * 8); fc[ks] = *(const bf16x8*)(Cs + (16 * it + idx) * 136 + ks * 32 + kq * 8); }
                __builtin_amdgcn_sched_barrier(0);
#pragma unroll
                for (int ks = 0; ks < 4; ++ks) cb = __builtin_amdgcn_mfma_f32_16x16x32_bf16(fb[ks], fc[ks], cb, 0, 0, 0);
                __builtin_amdgcn_sched_barrier(0);
            }
            {
                const int ii = 16 * it + idx; const float ci_ = s_c[ii];
                f32x4 gv;
#pragma unroll
                for (int rg = 0; rg < 4; ++rg) {
                    const int jj = 16 * jt + 4 * kq + rg;
                    const bool ok = dir ? (jj >= ii) : (jj <= ii);
                    const float e = __expf(ci_ - s_c[jj]) * s_dt[jj];
                    gv[rg] = ok ? cb[rg] * e : 0.f;
                }
                st4bf(Gs + ii * 40 + 16 * jt + 4 * kq, gv);
            }
            __syncthreads();
            const unsigned char* xtr = (const unsigned char*)Xs + (8 * kq + (idx >> 2)) * 144 + (16 * w + 4 * (idx & 3)) * 2;
            const bf16x8 xf = cat8(tr16(xtr), tr16(xtr + 4 * 144));
#pragma unroll 1
            for (int it2 = 0; it2 < 2; ++it2) {
                const int ii = 16 * it2 + idx;
                const bf16x8 gf = *(const bf16x8*)(Gs + ii * 40 + 8 * kq);
                f32x4 yd = (f32x4){0.f, 0.f, 0.f, 0.f}, yo = (f32x4){0.f, 0.f, 0.f, 0.f};
                bf16x8 sf[4], cf[4];
#pragma unroll
                for (int ks = 0; ks < 4; ++ks) { sf[ks] = *(const bf16x8*)(Sb + (16 * w + idx) * 136 + ks * 32 + kq * 8); cf[ks] = *(const bf16x8*)(Cs + ii * 136 + ks * 32 + kq * 8); }
                __builtin_amdgcn_sched_barrier(0);
                yd = __builtin_amdgcn_mfma_f32_16x16x32_bf16(xf, gf, yd, 0, 0, 0);
#pragma unroll
                for (int ks = 0; ks < 4; ++ks) yo = __builtin_amdgcn_mfma_f32_16x16x32_bf16(sf[ks], cf[ks], yo, 0, 0, 0);
                __builtin_amdgcn_sched_barrier(0);
                f32x4 y = yd + yo * s_rs[ii];
                if (dir == 0) { const u32x2 xv = *(const u32x2*)(Xs + ii * 72 + 16 * w + 4 * kq);
                    y.x += Dh * bflo(xv.x); y.y += Dh * bfhi(xv.x); y.z += Dh * bflo(xv.y); y.w += Dh * bfhi(xv.y); }
                st4bf(Y + (tokb + t0 + ii) * 512 + h * 64 + 16 * w + 4 * kq, y);
            }
        }
        {
            const float dc = __expf(s_tot[0]);
            const unsigned char* xw = (const unsigned char*)Xws + (8 * kq + (idx >> 2)) * 144 + (16 * w + 4 * (idx & 3)) * 2;
            const bf16x8 xwf = cat8(tr16(xw), tr16(xw + 4 * 144));
            bf16x8 bfv[8];
#pragma unroll
            for (int nt = 0; nt < 8; ++nt) {
                const unsigned char* bt = (const unsigned char*)Bs + (8 * kq + (idx >> 2)) * 272 + (16 * nt + 4 * (idx & 3)) * 2;
                bfv[nt] = cat8(tr16(bt), tr16(bt + 4 * 272));
            }
            __builtin_amdgcn_sched_barrier(0);
#pragma unroll
            for (int nt = 0; nt < 8; ++nt) S[nt] = __builtin_amdgcn_mfma_f32_16x16x32_bf16(bfv[nt], xwf, S[nt] * dc, 0, 0, 0);
            __builtin_amdgcn_sched_barrier(0);
            if (PASS == 3) {
#pragma unroll
                for (int nt = 0; nt < 8; ++nt) st4bf(Sb + (16 * w + idx) * 136 + 16 * nt + 4 * kq, S[nt]);
            }
        }
    }
    if (PASS == 1) {
        f32x4* dst = (f32x4*)(ST + (size_t)item * 8192);
#pragma unroll
        for (int nt = 0; nt < 8; ++nt) dst[(w * 8 + nt) * 64 + lane] = S[nt];
        if (tid == 0) SEGT[item] = segtot;
    }
}

__device__ void post2_phase(const Params& p) {
    int tx_ = threadIdx.x; asm volatile("" : "+v"(tx_));
    const int lane = tx_ & 63, gw = blockIdx.x * 8 + (tx_ >> 6), nw = gridDim.x * 8;
    const bf16_t* OB = (const bf16_t*)(p.ws + WS_QB); const float* LSE = (const float*)(p.ws + WS_LSE);
    const bf16_t* GB = (const bf16_t*)(p.ws + WS_GB);
    bf16_t* YBM = (bf16_t*)(p.ws + WS_YBM);
    const bf16_t* YF = (const bf16_t*)(p.ws + WS_YF); const bf16_t* YS = (const bf16_t*)(p.ws + WS_YS); const bf16_t* ZS = (const bf16_t*)(p.ws + WS_ZS);
    bf16_t* YC = (bf16_t*)(p.ws + WS_YC); float* RS = (float*)(p.ws + WS_RSTD);
    for (int row = gw; row < TP; row += nw) {
        const int bl = row >> 13, tt = row & (SEQ - 1), j = lane >> 4;
        float ls[3]; size_t ro[3];
#pragma unroll
        for (int g = 0; g < 3; ++g) { const int sh = 2 * g; const int pp = (tt & ((1 << sh) - 1)) * (SEQ >> sh) + (tt >> sh);
            ro[g] = (size_t)(bl * 3 + g) * SEQ + pp; ls[g] = LSE[ro[g] * 4 + j]; }
        const float mx = fmaxf(ls[0], fmaxf(ls[1], ls[2]));
        float wg[3]; float ws = 0.f;
#pragma unroll
        for (int g = 0; g < 3; ++g) { wg[g] = __expf(ls[g] - mx); ws += wg[g]; }
        const float inv = 1.f / ws;
        f32x4 acc = (f32x4){0.f, 0.f, 0.f, 0.f};
#pragma unroll
        for (int g = 0; g < 3; ++g) { const u32x2 v = *(const u32x2*)(OB + ro[g] * 256 + 4 * lane); const float wv = wg[g] * inv;
            acc.x += wv * bflo(v.x); acc.y += wv * bfhi(v.x); acc.z += wv * bflo(v.y); acc.w += wv * bfhi(v.y); }
        { const u32x2 gt = *(const u32x2*)(GB + (size_t)row * 256 + 4 * lane);
          acc.x *= bflo(gt.x); acc.y *= bfhi(gt.x); acc.z *= bflo(gt.y); acc.w *= bfhi(gt.y); }
        st4bf(YBM + (size_t)row * 256 + 4 * lane, acc);
        const u32x4 a = *(const u32x4*)(YF + (size_t)row * 512 + 8 * lane), bq = *(const u32x4*)(YS + (size_t)row * 512 + 8 * lane), z = *(const u32x4*)(ZS + (size_t)row * 512 + 8 * lane);
        float y[8];
        y[0] = (bflo(a.x) + bflo(bq.x)) * bflo(z.x); y[1] = (bfhi(a.x) + bfhi(bq.x)) * bfhi(z.x);
        y[2] = (bflo(a.y) + bflo(bq.y)) * bflo(z.y); y[3] = (bfhi(a.y) + bfhi(bq.y)) * bfhi(z.y);
        y[4] = (bflo(a.z) + bflo(bq.z)) * bflo(z.z); y[5] = (bfhi(a.z) + bfhi(bq.z)) * bfhi(z.z);
        y[6] = (bflo(a.w) + bflo(bq.w)) * bflo(z.w); y[7] = (bfhi(a.w) + bfhi(bq.w)) * bfhi(z.w);
        float ss = 0.f;
#pragma unroll
        for (int e = 0; e < 8; ++e) ss += y[e] * y[e];
        ss = wave_sum(ss);
        u32x4 o; o.x = pk2(y[0], y[1]); o.y = pk2(y[2], y[3]); o.z = pk2(y[4], y[5]); o.w = pk2(y[6], y[7]);
        *(u32x4*)(YC + (size_t)row * 512 + 8 * lane) = o;
        if (lane == 0) RS[row] = rsqrtf(ss * (1.f / 512.f) + EPS);
    }
}


#define XB_TMO      128
#define XB_XCNT(j)  (256  + 64 * (j))
#define XB_XSUB(j)  (1280 + 64 * (j))
#define XB_XGEN(j)  (2304 + 64 * (j))
#define XB_TOP      3328
#define XB_TOPGEN   3392
#define XCD_BAR_WORDS 3456
#define XB_SPIN_CAP (1u << 20)
__device__ __forceinline__ unsigned xb_ld(unsigned* p)              { return __hip_atomic_load(p, __ATOMIC_RELAXED, __HIP_MEMORY_SCOPE_AGENT); }
__device__ __forceinline__ unsigned xb_add(unsigned* p, unsigned v) { return __hip_atomic_fetch_add(p, v, __ATOMIC_RELAXED, __HIP_MEMORY_SCOPE_AGENT); }
__device__ __forceinline__ unsigned xb_xcc_id() { return (unsigned)__builtin_amdgcn_s_getreg((3 << 11) | 20) & 0xFu; }
#define XB_SPIN(cond, bar) do { unsigned _sp = 0; while (cond) { __builtin_amdgcn_s_sleep(1); \
    if ((++_sp & 255u) == 0u) { if (xb_ld(&(bar)[XB_TMO])) break; if (_sp > XB_SPIN_CAP) { atomicAdd(&(bar)[XB_TMO], 1u); break; } } } } while (0)
struct XcdBarrier { unsigned* bar; unsigned x; volatile LDSAS unsigned* st; };
__device__ __forceinline__ XcdBarrier xcd_barrier_post(unsigned* bar, volatile LDSAS unsigned* st) {
    XcdBarrier b; b.bar = bar; b.x = xb_xcc_id(); b.st = st;
    if (threadIdx.x == 0) (void)xb_add(&bar[XB_XCNT(b.x)], 1u);
    return b;
}
__device__ __forceinline__ void xcd_barrier_complete(unsigned* bar, unsigned x, unsigned& nloc, unsigned& nx) {
    const unsigned G = gridDim.x * gridDim.y * gridDim.z;
    unsigned sum, cnt, mine, sp = 0u;
    for (;;) {
        sum = 0u; cnt = 0u; mine = 0u;
#pragma unroll
        for (unsigned j = 0; j < 16; ++j) { const unsigned c = xb_ld(&bar[XB_XCNT(j)]); sum += c; cnt += (c > 0u) ? 1u : 0u; mine = (j == x) ? c : mine; }
        if (sum == G) break;
        __builtin_amdgcn_s_sleep(1);
        if ((++sp & 255u) == 0u) { if (xb_ld(&bar[XB_TMO])) break; if (sp > XB_SPIN_CAP) { atomicAdd(&bar[XB_TMO], 1u); break; } }
    }
    nloc = mine > 0u ? mine : 1u; nx = cnt > 0u ? cnt : 1u;
}
__device__ __forceinline__ void xcd_barrier(const XcdBarrier& b) {
    asm volatile("s_waitcnt vmcnt(0)" ::: "memory");
    __syncthreads();
    if (threadIdx.x == 0) {
        unsigned* bar = b.bar;
        __builtin_amdgcn_s_waitcnt(0);
        unsigned nloc = b.st[0], nx = b.st[1];
        if (nloc == 0u) { xcd_barrier_complete(bar, b.x, nloc, nx); b.st[0] = nloc; b.st[1] = nx; }
        const unsigned old = xb_add(&bar[XB_XSUB(b.x)], 1u);
        const unsigned gen = old / nloc;
        if (old + 1u == (gen + 1u) * nloc) {
            __builtin_amdgcn_fence(__ATOMIC_RELEASE, "agent");
            asm volatile("s_waitcnt vmcnt(0)" ::: "memory");
            const unsigned og = xb_add(&bar[XB_TOP], 1u);
            const unsigned tg = og / nx;
            if (og + 1u == (tg + 1u) * nx) xb_add(&bar[XB_TOPGEN], 1u);
            else XB_SPIN(xb_ld(&bar[XB_TOPGEN]) == tg, bar);
            __builtin_amdgcn_fence(__ATOMIC_ACQUIRE, "agent");
            xb_add(&bar[XB_XGEN(b.x)], 1u);
            asm volatile("s_waitcnt vmcnt(0)" ::: "memory");
        } else {
            XB_SPIN(xb_ld(&bar[XB_XGEN(b.x)]) == gen, bar);
            __builtin_amdgcn_fence(__ATOMIC_ACQUIRE, "agent");
            asm volatile("s_waitcnt vmcnt(0)" ::: "memory");
        }
    }
    __syncthreads();
}

__device__ __forceinline__ unsigned char* lds_half(unsigned char* smem) { int h_ = threadIdx.x >> 8; asm volatile("" : "+v"(h_)); return smem + h_ * HALF_LDS; }
__global__ void __launch_bounds__(512, 2) hybrid_fwd(Params p) {
    cg::grid_group grid = cg::this_grid();
    extern __shared__ __attribute__((aligned(16))) unsigned char smem[];
    volatile LDSAS unsigned* bst = (volatile LDSAS unsigned*)(smem + LDS_TOTAL - 16);
    if (threadIdx.x < 4) bst[threadIdx.x] = 0u;
    __syncthreads();
    const XcdBarrier xbar = xcd_barrier_post((unsigned*)(p.ws + WS_BAR), bst);
    { const Params q = launder(p); phase0(q, lds_half(smem)); }
    grid.sync();
#pragma unroll 1
    for (int l = 0; l < DEPTH; ++l) {
#pragma unroll 1
        for (int hb = 0; hb < 2; ++hb) {
            { const Params q = launder(p); norm_phase(q, l, hb, (l == 0) ? q.x : q.out); }
            xcd_barrier(xbar);
            { const Params q = launder(p); gemm1_phase(q, l, hb, smem); }
            xcd_barrier(xbar);
            { const Params q = launder(p); conv_phase(q, l); }
            xcd_barrier(xbar);
            { const Params q = launder(p); unsigned char* smh = lds_half(smem);
#pragma unroll 1
              for (int it = VBLK; it < 512 + 1536; it += VGRID) { if (it < 512) ssd_item<1>(q, it, l, smh); else attn_b_item(q, it - 512, l, smh); } }
            xcd_barrier(xbar);
            { const Params q = launder(p); unsigned char* smh = lds_half(smem);
#pragma unroll 1
              for (int it = VBLK; it < 1024 + 512; it += VGRID) { if (it < 1024) attn_a_item(q, it, l, smh); else ssd_item<3>(q, it - 1024, l, smh); } }
            xcd_barrier(xbar);
            { const Params q = launder(p); post2_phase(q); }
            xcd_barrier(xbar);
            { const Params q = launder(p); merge_phase(q, l, smem); }
            xcd_barrier(xbar);
            { const Params q = launder(p); out_phase(q, l, hb, (l == 0) ? q.x : q.out, smem); }
        }
    }
}

extern "C" void kernel_launch(void* const* d_in, const int* in_sizes, int n_in, void* d_out, int out_size, void* d_ws, size_t ws_size, hipStream_t stream) {
    static int grid_blocks = 0;
    if (!grid_blocks) {
        int dev = 0, cus = 0, per_cu = 0;
        hipGetDevice(&dev);
        hipDeviceGetAttribute(&cus, hipDeviceAttributeMultiprocessorCount, dev);
        hipFuncSetAttribute((const void*)hybrid_fwd, hipFuncAttributeMaxDynamicSharedMemorySize, LDS_TOTAL);
        hipOccupancyMaxActiveBlocksPerMultiprocessor(&per_cu, hybrid_fwd, 512, LDS_TOTAL);
        if (per_cu > 1) per_cu = 1;
        if (per_cu < 1) per_cu = 1;
        grid_blocks = cus * per_cu;
    }
    Params p{};
    const float** pp = (const float**)&p;
    for (int i = 0; i < 22; ++i) pp[i] = (const float*)d_in[i];
    p.out = (float*)d_out; p.ws = (unsigned char*)d_ws;
    hipMemsetAsync((unsigned char*)d_ws + WS_BAR, 0, XCD_BAR_WORDS * 4, stream);
    void* args[] = {&p};
    hipError_t e = hipLaunchCooperativeKernel((void*)hybrid_fwd, dim3(grid_blocks), dim3(512), args, LDS_TOTAL, stream);
    if (e != hipSuccess) fprintf(stderr, "cooperative launch failed: %s (grid %d)\n", hipGetErrorString(e), grid_blocks);
}
```

```cpp
#include <hip/hip_runtime.h>
#include <hip/hip_cooperative_groups.h>
#include <cstdint>
#include <cstdio>
namespace cg = cooperative_groups;

typedef unsigned short bf16_t;
typedef short bf16x8 __attribute__((ext_vector_type(8)));
typedef short v4i16 __attribute__((ext_vector_type(4)));
typedef float f32x2 __attribute__((ext_vector_type(2)));
typedef float f32x4 __attribute__((ext_vector_type(4)));
typedef float f32x16 __attribute__((ext_vector_type(16)));
typedef unsigned u32x2 __attribute__((ext_vector_type(2)));
typedef unsigned u32x4 __attribute__((ext_vector_type(4)));
typedef __bf16 bf16x2_t __attribute__((ext_vector_type(2)));
#define LDSAS __attribute__((address_space(3)))
#define VTID ((int)(threadIdx.x & 255u))
__device__ __forceinline__ int vblk_() { int h_ = threadIdx.x >> 8; asm volatile("" : "+v"(h_)); return __builtin_amdgcn_readfirstlane(2 * (int)blockIdx.x + h_); }
#define VBLK vblk_()
#define VGRID ((int)(2u * gridDim.x))
constexpr int HALF_LDS = 73728, LDS_TOTAL = 147456;

constexpr int SEQ = 8192, DM = 1024, NBATCH = 4, NBH = 2, TP = NBH * SEQ, DEPTH = 2;
constexpr int NP = 8704;
constexpr float EPS = 1e-6f;
constexpr float LOG2E = 1.4426950408889634f, LN2 = 0.6931471805599453f;
constexpr int NSEG = 16, SEGLEN = 512, TSUB = 32, NSUB = SEGLEN / TSUB;

constexpr size_t MiB = 1u << 20;
constexpr size_t WS_WIN = 0;
constexpr size_t WS_WPA = 34 * MiB;
constexpr size_t WS_WPB = 36 * MiB;
constexpr size_t WS_WPC = 37 * MiB;
constexpr size_t WS_WOUT = 39 * MiB;
constexpr size_t WS_MOD = 43 * MiB;
constexpr size_t WS_ROPE = 43 * MiB + 128 * 1024;
constexpr size_t WS_BND = 43 * MiB + 160 * 1024;
constexpr size_t WS_RSTD = 43 * MiB + 256 * 1024;
constexpr size_t WS_SEGT = 43 * MiB + 512 * 1024;
constexpr size_t WS_LSE = 44 * MiB;
constexpr size_t WS_DT = 45 * MiB;
constexpr size_t WS_BAR = 46 * MiB;
constexpr size_t WS_H = 48 * MiB;
constexpr size_t WS_QA = 80 * MiB;
constexpr size_t WS_KA = 96 * MiB;
constexpr size_t WS_VA = 100 * MiB;
constexpr size_t WS_GA = 104 * MiB;
constexpr size_t WS_QB = 120 * MiB;
constexpr size_t WS_KB = 144 * MiB;
constexpr size_t WS_VB = 168 * MiB;
constexpr size_t WS_GB = 192 * MiB;
constexpr size_t WS_XBC = 200 * MiB;
constexpr size_t WS_ZS = 232 * MiB;
constexpr size_t WS_MG = 248 * MiB;
constexpr size_t WS_YF = 344 * MiB;
constexpr size_t WS_YS = 360 * MiB;
constexpr size_t WS_YBM = 376 * MiB;
constexpr size_t WS_YC = 384 * MiB;
constexpr size_t WS_MRG = 400 * MiB;
constexpr size_t WS_ST = 432 * MiB;
constexpr size_t WS_XBCC = 448 * MiB;

struct Params {
    const float *x, *c, *norm_w, *w_ada, *b_ada, *w_in, *b_gate, *q_norm_a, *k_norm_a, *q_norm_b, *k_norm_b, *rel_bias,
        *conv_w, *conv_b, *a_log, *dt_bias, *d_skip, *ssm_norm_w, *w_proj_a, *w_proj_b, *w_proj_c, *w_out;
    float* out;
    unsigned char* ws;
};


#define AS1 __attribute__((address_space(1)))
#define GLOBF(f) do { AS1 const float* g_ = (AS1 const float*)p.f; asm volatile("" : "+s"(g_)); q.f = (const float*)g_; } while (0)
__device__ __forceinline__ Params launder(const Params& p) {
    Params q;
    GLOBF(x); GLOBF(c); GLOBF(norm_w); GLOBF(w_ada); GLOBF(b_ada); GLOBF(w_in); GLOBF(b_gate); GLOBF(q_norm_a); GLOBF(k_norm_a); GLOBF(q_norm_b); GLOBF(k_norm_b); GLOBF(rel_bias);
    GLOBF(conv_w); GLOBF(conv_b); GLOBF(a_log); GLOBF(dt_bias); GLOBF(d_skip); GLOBF(ssm_norm_w); GLOBF(w_proj_a); GLOBF(w_proj_b); GLOBF(w_proj_c); GLOBF(w_out);
    { AS1 float* g_ = (AS1 float*)p.out; asm volatile("" : "+s"(g_)); q.out = (float*)g_; }
    { AS1 unsigned char* g_ = (AS1 unsigned char*)p.ws; asm volatile("" : "+s"(g_)); q.ws = (unsigned char*)g_; }
    return q;
}
__device__ __forceinline__ unsigned pk2(float lo, float hi) { f32x2 v = {lo, hi}; bf16x2_t b = __builtin_convertvector(v, bf16x2_t); return __builtin_bit_cast(unsigned, b); }
__device__ __forceinline__ float bf2f(unsigned short b) { return __uint_as_float(((unsigned)b) << 16); }
__device__ __forceinline__ float bflo(unsigned u) { return __uint_as_float(u << 16); }
__device__ __forceinline__ float bfhi(unsigned u) { return __uint_as_float(u & 0xffff0000u); }
__device__ __forceinline__ float siluf(float v) { return v * __builtin_amdgcn_rcpf(1.f + __builtin_amdgcn_exp2f(-1.4426950408889634f * v)); }
__device__ __forceinline__ float sigmf(float v) { return __builtin_amdgcn_rcpf(1.f + __builtin_amdgcn_exp2f(-1.4426950408889634f * v)); }
__device__ __forceinline__ float wave_sum(float v) {
#pragma unroll
    for (int o = 1; o < 64; o <<= 1) v += __shfl_xor(v, o);
    return v;
}
__device__ __forceinline__ v4i16 tr16(const unsigned char* p) { return __builtin_amdgcn_ds_read_tr16_b64_v4i16((LDSAS v4i16*)p); }
__device__ __forceinline__ bf16x8 cat8(v4i16 a, v4i16 b) { return (bf16x8){a[0], a[1], a[2], a[3], b[0], b[1], b[2], b[3]}; }
__device__ __forceinline__ int crow(int r, int hi) { return (r & 3) + 8 * (r >> 2) + 4 * hi; }

struct P0It { const float* W; bf16_t* Wt; const float* rs; int ldw, K, k0, n0, mode; };
__device__ __forceinline__ void p0_load(const P0It& t, float (&vv)[16]) {
    const int tid = VTID, tx = tid & 63, ty = tid >> 6;
    const int np = t.n0 + tx; int n = np; bool valid = true;
    if (t.mode == 1) {
        if (np < 4352) n = np; else if (np < 4864) n = np + 512; else if (np < 5376) n = np - 512;
        else if (np < 8448) n = np + 16; else if (np < 8464) n = np - 3072; else { valid = false; n = 0; }
    }
#pragma unroll
    for (int i = 0; i < 16; ++i) { const int k = ty + 4 * i; vv[i] = valid ? t.W[(size_t)(t.k0 + k) * t.ldw + n] : 0.f; }
}
__device__ __forceinline__ void p0_finish(const P0It& t, const float (&vv)[16], float* tile) {
    const int tid = VTID, tx = tid & 63, ty = tid >> 6;
#pragma unroll
    for (int i = 0; i < 16; ++i) { const int k = ty + 4 * i; float v = vv[i]; if (t.rs) v *= t.rs[t.k0 + k]; tile[k * 65 + tx] = v; }
    __syncthreads();
    const int r = tid >> 2, kc = (tid & 3) * 16;
    u32x4 o0, o1;
    o0.x = pk2(tile[(kc + 0) * 65 + r], tile[(kc + 1) * 65 + r]); o0.y = pk2(tile[(kc + 2) * 65 + r], tile[(kc + 3) * 65 + r]);
    o0.z = pk2(tile[(kc + 4) * 65 + r], tile[(kc + 5) * 65 + r]); o0.w = pk2(tile[(kc + 6) * 65 + r], tile[(kc + 7) * 65 + r]);
    o1.x = pk2(tile[(kc + 8) * 65 + r], tile[(kc + 9) * 65 + r]); o1.y = pk2(tile[(kc + 10) * 65 + r], tile[(kc + 11) * 65 + r]);
    o1.z = pk2(tile[(kc + 12) * 65 + r], tile[(kc + 13) * 65 + r]); o1.w = pk2(tile[(kc + 14) * 65 + r], tile[(kc + 15) * 65 + r]);
    bf16_t* dst = t.Wt + (size_t)(t.n0 + r) * t.K + t.k0 + kc;
    *(u32x4*)dst = o0; *(u32x4*)(dst + 8) = o1;
    __syncthreads();
}
constexpr int P0_IN = 16 * 136, P0_PA = 8 * 16, P0_PB = 4 * 16, P0_PC = 8 * 16, P0_OUT = 16 * 16, P0_L = P0_IN + P0_PA + P0_PB + P0_PC + P0_OUT;
__device__ __forceinline__ P0It p0_params(const Params& p, int item) {
    P0It t; const int l = item / P0_L; int r = item % P0_L; t.rs = nullptr; t.mode = 0;
    if (r < P0_IN) { t.W = p.w_in + (size_t)l * 1024 * 8464; t.ldw = 8464; t.K = 1024; t.Wt = (bf16_t*)(p.ws + WS_WIN) + (size_t)l * NP * 1024; t.k0 = (r / 136) * 64; t.n0 = (r % 136) * 64; t.mode = 1; return t; }
    r -= P0_IN;
    if (r < P0_PA) { t.W = p.w_proj_a + (size_t)l * 512 * 1024; t.ldw = 1024; t.K = 512; t.Wt = (bf16_t*)(p.ws + WS_WPA) + (size_t)l * 1024 * 512; t.k0 = (r / 16) * 64; t.n0 = (r % 16) * 64; return t; }
    r -= P0_PA;
    if (r < P0_PB) { t.W = p.w_proj_b + (size_t)l * 256 * 1024; t.ldw = 1024; t.K = 256; t.Wt = (bf16_t*)(p.ws + WS_WPB) + (size_t)l * 1024 * 256; t.k0 = (r / 16) * 64; t.n0 = (r % 16) * 64; return t; }
    r -= P0_PB;
    if (r < P0_PC) { t.W = p.w_proj_c + (size_t)l * 512 * 1024; t.ldw = 1024; t.K = 512; t.Wt = (bf16_t*)(p.ws + WS_WPC) + (size_t)l * 1024 * 512; t.k0 = (r / 16) * 64; t.n0 = (r % 16) * 64; t.rs = p.ssm_norm_w + l * 512; return t; }
    r -= P0_PC;
    t.W = p.w_out + (size_t)l * 1024 * 1024; t.ldw = 1024; t.K = 1024; t.Wt = (bf16_t*)(p.ws + WS_WOUT) + (size_t)l * 1024 * 1024; t.k0 = (r / 16) * 64; t.n0 = (r % 16) * 64; return t;
}

__device__ void phase0(const Params& p, unsigned char* smem) {
    const int tid = VTID;
    float* tile = (float*)smem;
    constexpr int I_T = 2 * P0_L, I_MOD = 192, I_ALL = I_T + I_MOD + 1;
    {
        int item = VBLK;
        if (item < I_T) {
            P0It cur = p0_params(p, item); float va[16], vb[16]; p0_load(cur, va);
            for (;;) {
                const int nx = item + VGRID; const bool more = nx < I_T; P0It nxt = cur;
                if (more) { nxt = p0_params(p, nx); p0_load(nxt, vb); }
                p0_finish(cur, va, tile);
                if (!more) break;
                item = nx; cur = nxt;
#pragma unroll
                for (int i = 0; i < 16; ++i) va[i] = vb[i];
            }
        }
    }
    for (int item = VBLK; item < I_ALL; item += VGRID) {
        if (item < I_T) {
            continue;
        } else if (item < I_T + I_MOD) {
            const int it = item - I_T, l = it / 96, col0 = (it % 96) * 32, cl = tid & 31, ks = tid >> 5;
            float a0 = 0.f, a1 = 0.f, a2 = 0.f, a3 = 0.f;
            const float* wp = p.w_ada + ((size_t)l * 1024 + ks * 128) * 3072 + col0 + cl;
#pragma unroll 8
            for (int k = 0; k < 128; ++k) {
                const float wv = wp[(size_t)k * 3072]; const int kk = ks * 128 + k;
                a0 += siluf(p.c[kk]) * wv; a1 += siluf(p.c[1024 + kk]) * wv; a2 += siluf(p.c[2048 + kk]) * wv; a3 += siluf(p.c[3072 + kk]) * wv;
            }
            float* red = (float*)smem;
            red[(ks * 32 + cl) * 4 + 0] = a0; red[(ks * 32 + cl) * 4 + 1] = a1; red[(ks * 32 + cl) * 4 + 2] = a2; red[(ks * 32 + cl) * 4 + 3] = a3;
            __syncthreads();
            if (tid < 128) { const int b = tid >> 5, c2 = tid & 31; float s = 0.f;
#pragma unroll
                for (int k = 0; k < 8; ++k) s += red[(k * 32 + c2) * 4 + b];
                ((float*)(p.ws + WS_MOD))[(l * 4 + b) * 3072 + col0 + c2] = s + p.b_ada[l * 3072 + col0 + c2]; }
            __syncthreads();
        } else {
            float* rc = (float*)(p.ws + WS_ROPE); float* rs = rc + 128 * 16;
            for (int e = tid; e < 2048; e += 256) {
                const int pos = e >> 4, i = e & 15;
                const float freq = powf(10000.0f, -(float)i / 16.0f);
                const float ang = (float)pos * freq;
                const double rev = (double)ang * 0.15915494309189535; const double fr = rev - rint(rev);
                const float a = (float)(fr * 6.283185307179586);
                rc[e] = cosf(a); rs[e] = sinf(a);
            }
            if (tid < 2) {
                const int l = tid; float mqa = 0.f, mka = 0.f, mqb = 0.f, mkb = 0.f, mb = 0.f;
                for (int i = 0; i < 64; ++i) { mqa = fmaxf(mqa, fabsf(p.q_norm_a[l * 64 + i])); mka = fmaxf(mka, fabsf(p.k_norm_a[l * 64 + i]));
                    mqb = fmaxf(mqb, fabsf(p.q_norm_b[l * 64 + i])); mkb = fmaxf(mkb, fabsf(p.k_norm_b[l * 64 + i])); }
                for (int i = 0; i < 32 * 12; ++i) mb = fmaxf(mb, p.rel_bias[i]);
                float* bd = (float*)(p.ws + WS_BND);
                bd[l] = 8.f * mqa * mka * LOG2E; bd[2 + l] = (8.f * mqb * mkb + mb) * LOG2E;
            }
        }
    }
}

__device__ void norm_phase(const Params& p, int l, int hb, const float* xsrc) {
    int tx_ = threadIdx.x; asm volatile("" : "+v"(tx_));
    const int lane = tx_ & 63, gw = blockIdx.x * 8 + (tx_ >> 6), nw = gridDim.x * 8;
    bf16_t* H = (bf16_t*)(p.ws + WS_H);
    const float* nwp = p.norm_w + l * 1024;
    for (int row = gw; row < TP; row += nw) {
        const size_t rg = (size_t)hb * TP + row; const int b = (int)(rg / SEQ);
        const f32x4* xr = (const f32x4*)(xsrc + rg * 1024);
        const float* md = (const float*)(p.ws + WS_MOD) + (size_t)(l * 4 + b) * 3072;
        f32x4 v[4]; float ss = 0.f;
#pragma unroll
        for (int j = 0; j < 4; ++j) { v[j] = xr[lane + 64 * j]; ss += v[j].x * v[j].x + v[j].y * v[j].y + v[j].z * v[j].z + v[j].w * v[j].w; }
        ss = wave_sum(ss); const float rstd = rsqrtf(ss * (1.f / 1024.f) + EPS);
#pragma unroll
        for (int j = 0; j < 4; ++j) {
            const int col = 4 * (lane + 64 * j);
            const f32x4 w4 = *(const f32x4*)(nwp + col), sh = *(const f32x4*)(md + col), sc = *(const f32x4*)(md + 1024 + col);
            const f32x4 o = v[j] * rstd * w4 * (1.f + sc) + sh;
            u32x2 pk; pk.x = pk2(o.x, o.y); pk.y = pk2(o.z, o.w);
            *(u32x2*)(H + (size_t)row * 1024 + col) = pk;
        }
    }
}

constexpr int G_STAGE = 65536, G_AB = 32768;
__device__ __forceinline__ void gemm_core(const bf16_t* __restrict__ A, int lda, const bf16_t* __restrict__ Bt, int ldb, int K, f32x4 (&acc)[8][4], unsigned char* smem, int tid) {
    asm volatile("" : "+v"(tid));
    const int lane = tid & 63, w = __builtin_amdgcn_readfirstlane(tid >> 6), wm = w >> 2, wn = w & 3, idx = lane & 15, kq = lane >> 4;
    unsigned offA[4], offB[4];
#pragma unroll
    for (int j = 0; j < 4; ++j) { const int row = (j * 8 + w) * 8 + (lane >> 3), c = (lane & 7) ^ ((row >> 1) & 7);
        offA[j] = (unsigned)(row * lda + c * 8) * 2u; offB[j] = (unsigned)(row * ldb + c * 8) * 2u; }
#pragma unroll
    for (int mi = 0; mi < 8; ++mi)
#pragma unroll
        for (int ni = 0; ni < 4; ++ni) acc[mi][ni] = (f32x4){0.f, 0.f, 0.f, 0.f};
    LDSAS unsigned char* lds = (LDSAS unsigned char*)smem;
#define G_ISSUE1(kt, st, j) do { \
        __builtin_amdgcn_global_load_lds((const unsigned*)((const char*)A + offA[j] + (kt) * 128), (LDSAS unsigned*)(lds + (st) * G_STAGE + ((j) * 8 + w) * 1024), 16, 0, 0); \
        __builtin_amdgcn_global_load_lds((const unsigned*)((const char*)Bt + offB[j] + (kt) * 128), (LDSAS unsigned*)(lds + (st) * G_STAGE + G_AB + ((j) * 8 + w) * 1024), 16, 0, 0); } while (0)
#define G_ISSUE(kt, st) do { G_ISSUE1(kt, st, 0); G_ISSUE1(kt, st, 1); G_ISSUE1(kt, st, 2); G_ISSUE1(kt, st, 3); } while (0)
    const int nk = K >> 6;
    G_ISSUE(0, 0);
    asm volatile("s_waitcnt vmcnt(0)" ::: "memory");
    __syncthreads();
    const int swz = (idx >> 1) & 7;
    const int aoff = (wm * 128 + idx) * 128, boff = G_AB + (wn * 64 + idx) * 128;
    for (int kt = 0; kt < nk; ++kt) {
        const int st = kt & 1;
        const bool more = kt + 1 < nk;
        const unsigned char* sb = smem + st * G_STAGE;
#pragma unroll
        for (int ks = 0; ks < 2; ++ks) {
            bf16x8 bfr[4], af[8];
            const int co = ((ks * 4 + kq) ^ swz) * 16;
#pragma unroll
            for (int ni = 0; ni < 4; ++ni) bfr[ni] = *(const bf16x8*)(sb + boff + ni * 2048 + co);
#pragma unroll
            for (int mi = 0; mi < 8; ++mi) af[mi] = *(const bf16x8*)(sb + aoff + mi * 2048 + co);
            if (more) { G_ISSUE1(kt + 1, st ^ 1, ks * 2); G_ISSUE1(kt + 1, st ^ 1, ks * 2 + 1); }
            __builtin_amdgcn_sched_barrier(0);
            __builtin_amdgcn_s_setprio(1);
#pragma unroll
            for (int mi = 0; mi < 8; ++mi)
#pragma unroll
                for (int ni = 0; ni < 4; ++ni) acc[mi][ni] = __builtin_amdgcn_mfma_f32_16x16x32_bf16(bfr[ni], af[mi], acc[mi][ni], 0, 0, 0);
            __builtin_amdgcn_s_setprio(0);
            __builtin_amdgcn_sched_barrier(0);
        }
        asm volatile("s_waitcnt vmcnt(0)" ::: "memory");
        __syncthreads();
    }
#undef G_ISSUE1
#undef G_ISSUE
}

__device__ __forceinline__ void st4bf(bf16_t* dst, f32x4 v) { u32x2 pk; pk.x = pk2(v.x, v.y); pk.y = pk2(v.z, v.w); *(u32x2*)dst = pk; }

__device__ void gemm1_phase(const Params& p, int l, int hb, unsigned char* smem) {
    const bf16_t* H = (const bf16_t*)(p.ws + WS_H);
    const bf16_t* Wt = (const bf16_t*)(p.ws + WS_WIN) + (size_t)l * NP * 1024;
    const float* ropec = (const float*)(p.ws + WS_ROPE); const float* ropes = ropec + 2048;
    constexpr int NT = 34, NTILES = 64 * NT, GRP = 8 * NT;
    for (int t = blockIdx.x; t < NTILES; t += gridDim.x) {
        const int grp = t / GRP, r = t % GRP, jx = NT * (r & 7) + (r >> 3), mt = grp * 8 + (jx & 7), nt = jx >> 3;
        const int m0 = mt * 256, n0 = nt * 256;
        f32x4 acc[8][4];
        int tid = threadIdx.x;
        gemm_core(H + (size_t)m0 * 1024, 1024, Wt + (size_t)n0 * 1024, 1024, 1024, acc, smem, tid);
        asm volatile("" : "+v"(tid));
        const int lane = tid & 63, w = __builtin_amdgcn_readfirstlane(tid >> 6), wm = w >> 2, wn = w & 3, idx = lane & 15, kq = lane >> 4;
        const int cw = n0 + wn * 64;
        const int lc = 4 * kq;
        unsigned char* wl = smem + w * 16384;
#define G1_STG(mi_, ni_, v_) do { const int r_ = (mi_) * 16 + idx; const f32x4 t_ = (v_); u32x2 pk_; pk_.x = pk2(t_.x, t_.y); pk_.y = pk2(t_.z, t_.w); \
        *(u32x2*)(wl + r_ * 128 + ((((ni_) * 2 + (kq >> 1)) ^ (r_ & 7)) * 16) + (kq & 1) * 8) = pk_; } while (0)
        bf16_t* dbase = nullptr; int dpitch = 0, dc0 = 0, dsh = -1, dg = 0;
        if (cw < 768 && (cw < 640)) {
            const bool isq = cw < 512;
            const float* nwp = (isq ? p.q_norm_a : p.k_norm_a) + l * 64;
            dbase = isq ? (bf16_t*)(p.ws + WS_QA) : (bf16_t*)(p.ws + WS_KA);
            dpitch = isq ? 512 : 128; dc0 = isq ? cw : cw - 512;
            const float qs = isq ? 0.125f * LOG2E : 1.f;
#pragma unroll
            for (int mi = 0; mi < 8; ++mi) {
                const int row = m0 + wm * 128 + mi * 16 + idx;
                float ss = 0.f;
#pragma unroll
                for (int ni = 0; ni < 4; ++ni) { const f32x4 v = acc[mi][ni]; ss += v.x * v.x + v.y * v.y + v.z * v.z + v.w * v.w; }
                ss += __shfl_xor(ss, 16); ss += __shfl_xor(ss, 32);
                const float rstd = rsqrtf(ss * (1.f / 64.f) + EPS);
                f32x4 y[4];
#pragma unroll
                for (int ni = 0; ni < 4; ++ni) y[ni] = acc[mi][ni] * rstd * *(const f32x4*)(nwp + ni * 16 + lc);
                const int tt = row & (SEQ - 1), prow = tt >> 6, pcol = tt & 63;
#pragma unroll
                for (int hf = 0; hf < 2; ++hf) {
                    const int pos = hf ? pcol : prow;
                    const f32x4 cs = *(const f32x4*)(ropec + pos * 16 + lc), sn = *(const f32x4*)(ropes + pos * 16 + lc);
                    const f32x4 a = y[2 * hf], b = y[2 * hf + 1];
                    y[2 * hf] = a * cs - b * sn; y[2 * hf + 1] = b * cs + a * sn;
                }
#pragma unroll
                for (int ni = 0; ni < 4; ++ni) G1_STG(mi, ni, y[ni] * qs);
            }
        } else if (cw >= 1280 && cw < 2816) {
            const bool isq = cw < 2048;
            const float* nwp = (isq ? p.q_norm_b : p.k_norm_b) + l * 64;
            const int gc = isq ? cw - 1280 : cw - 2048;
            dg = gc >> 8; dc0 = gc & 255; dsh = 2 * dg; dpitch = 256;
            dbase = (bf16_t*)(p.ws + (isq ? WS_QB : WS_KB));
            const float qs = isq ? 0.125f * LOG2E : 1.f;
#pragma unroll
            for (int mi = 0; mi < 8; ++mi) {
                float ss = 0.f;
#pragma unroll
                for (int ni = 0; ni < 4; ++ni) { const f32x4 v = acc[mi][ni]; ss += v.x * v.x + v.y * v.y + v.z * v.z + v.w * v.w; }
                ss += __shfl_xor(ss, 16); ss += __shfl_xor(ss, 32);
                const float rstd = rsqrtf(ss * (1.f / 64.f) + EPS) * qs;
#pragma unroll
                for (int ni = 0; ni < 4; ++ni) G1_STG(mi, ni, acc[mi][ni] * rstd * *(const f32x4*)(nwp + ni * 16 + lc));
            }
        } else if (cw >= 2816 && cw < 3584) {
            const int gc = cw - 2816;
            dg = gc >> 8; dc0 = gc & 255; dsh = 2 * dg; dpitch = 256; dbase = (bf16_t*)(p.ws + WS_VB);
#pragma unroll
            for (int mi = 0; mi < 8; ++mi)
#pragma unroll
                for (int ni = 0; ni < 4; ++ni) G1_STG(mi, ni, acc[mi][ni]);
        } else if (cw >= 8448) {
            if (cw == 8448) {
                float* dst = (float*)(p.ws + WS_DT);
                const f32x4 bias = *(const f32x4*)(p.dt_bias + l * 16 + lc);
#pragma unroll
                for (int mi = 0; mi < 8; ++mi) {
                    const int row = m0 + wm * 128 + mi * 16 + idx;
                    f32x4 v = acc[mi][0] + bias, o;
                    o.x = v.x > 20.f ? v.x : log1pf(__expf(v.x)); o.y = v.y > 20.f ? v.y : log1pf(__expf(v.y));
                    o.z = v.z > 20.f ? v.z : log1pf(__expf(v.z)); o.w = v.w > 20.f ? v.w : log1pf(__expf(v.w));
                    *(f32x4*)(dst + (size_t)row * 16 + lc) = o;
                }
            }
        } else {
            int mode;
            if (cw < 768) { dbase = (bf16_t*)(p.ws + WS_VA); dpitch = 128; dc0 = cw - 640; mode = 0; }
            else if (cw < 1280) { dbase = (bf16_t*)(p.ws + WS_GA); dpitch = 512; dc0 = cw - 768; mode = 1; }
            else if (cw < 3840) { dbase = (bf16_t*)(p.ws + WS_GB); dpitch = 256; dc0 = cw - 3584; mode = 1; }
            else if (cw < 4864) { dbase = (bf16_t*)(p.ws + WS_XBC); dpitch = 1024; dc0 = cw - 3840; mode = 0; }
            else if (cw < 5376) { dbase = (bf16_t*)(p.ws + WS_ZS); dpitch = 512; dc0 = cw - 4864; mode = 1; }
            else { dbase = (bf16_t*)(p.ws + WS_MG); dpitch = 3072; dc0 = cw - 5376; mode = 2; }
            const float* bg = p.b_gate + l * 3072 + dc0 + lc;
#pragma unroll
            for (int mi = 0; mi < 8; ++mi) {
#pragma unroll
                for (int ni = 0; ni < 4; ++ni) {
                    f32x4 v = acc[mi][ni];
                    if (mode == 1) { v.x = siluf(v.x); v.y = siluf(v.y); v.z = siluf(v.z); v.w = siluf(v.w); }
                    else if (mode == 2) { const f32x4 bb = *(const f32x4*)(bg + ni * 16); v.x = sigmf(v.x + bb.x); v.y = sigmf(v.y + bb.y); v.z = sigmf(v.z + bb.z); v.w = sigmf(v.w + bb.w); }
                    G1_STG(mi, ni, v);
                }
            }
        }
#undef G1_STG
        if (dbase) {
            const int ch = lane & 7;
#pragma unroll
            for (int j = 0; j < 16; ++j) {
                const int rl = 8 * j + (lane >> 3), row = m0 + wm * 128 + rl;
                const u32x4 v = *(const u32x4*)(wl + rl * 128 + ((ch ^ (rl & 7)) * 16));
                size_t drow = (size_t)row;
                if (dsh >= 0) { const int bl = row >> 13, tt = row & (SEQ - 1); drow = (size_t)(bl * 3 + dg) * SEQ + (size_t)((tt & ((1 << dsh) - 1)) * (SEQ >> dsh) + (tt >> dsh)); }
                *(u32x4*)(dbase + drow * dpitch + dc0 + ch * 8) = v;
            }
        }
        __syncthreads();
    }
}

__device__ void merge_phase(const Params& p, int l, unsigned char* smem) {
    const bf16_t* MG = (const bf16_t*)(p.ws + WS_MG);
    const float* rstd = (const float*)(p.ws + WS_RSTD);
    bf16_t* MR = (bf16_t*)(p.ws + WS_MRG);
    for (int t = blockIdx.x; t < 64 * 4; t += gridDim.x) {
        const int xq = t >> 3, mt = (xq >> 2) * 8 + (t & 7), nt = xq & 3, m0 = mt * 256, n0 = nt * 256;
#pragma unroll 1
        for (int br = 0; br < 3; ++br) {
            f32x4 acc[8][4];
            const bf16_t* A; const bf16_t* Bt; int K;
            if (br == 0) { A = (const bf16_t*)(p.ws + WS_QA); K = 512; Bt = (const bf16_t*)(p.ws + WS_WPA) + (size_t)l * 1024 * 512; }
            else if (br == 1) { A = (const bf16_t*)(p.ws + WS_YBM); K = 256; Bt = (const bf16_t*)(p.ws + WS_WPB) + (size_t)l * 1024 * 256; }
            else { A = (const bf16_t*)(p.ws + WS_YC); K = 512; Bt = (const bf16_t*)(p.ws + WS_WPC) + (size_t)l * 1024 * 512; }
            int tid = threadIdx.x;
            gemm_core(A + (size_t)m0 * K, K, Bt + (size_t)n0 * K, K, K, acc, smem, tid);
            asm volatile("" : "+v"(tid));
            const int lane = tid & 63, w = tid >> 6, wm = w >> 2, wn = w & 3, idx = lane & 15, kq = lane >> 4;
#pragma unroll
            for (int mi = 0; mi < 8; ++mi) {
                const int row = m0 + wm * 128 + mi * 16 + idx;
                const float rs = (br == 2) ? rstd[row] : 1.f;
#pragma unroll
                for (int ni = 0; ni < 4; ++ni) {
                    const int col = n0 + wn * 64 + ni * 16 + 4 * kq;
                    const u32x2 g = *(const u32x2*)(MG + (size_t)row * 3072 + br * 1024 + col);
                    f32x4 gv; gv.x = bflo(g.x); gv.y = bfhi(g.x); gv.z = bflo(g.y); gv.w = bfhi(g.y);
                    f32x4 v = gv * rs * acc[mi][ni];
                    bf16_t* mp = MR + (size_t)row * 1024 + col;
                    if (br > 0) { const u32x2 o = *(const u32x2*)mp; v.x += bflo(o.x); v.y += bfhi(o.x); v.z += bflo(o.y); v.w += bfhi(o.y); }
                    st4bf(mp, v);
                }
            }
        }
    }
}

__device__ void out_phase(const Params& p, int l, int hb, const float* xsrc, unsigned char* smem) {
    const bf16_t* MR = (const bf16_t*)(p.ws + WS_MRG);
    const bf16_t* Wt = (const bf16_t*)(p.ws + WS_WOUT) + (size_t)l * 1024 * 1024;
    for (int t = blockIdx.x; t < 64 * 4; t += gridDim.x) {
        const int xq = t >> 3, mt = (xq >> 2) * 8 + (t & 7), nt = xq & 3, m0 = mt * 256, n0 = nt * 256;
        f32x4 acc[8][4];
        int tid = threadIdx.x;
        gemm_core(MR + (size_t)m0 * 1024, 1024, Wt + (size_t)n0 * 1024, 1024, 1024, acc, smem, tid);
        asm volatile("" : "+v"(tid));
        const int lane = tid & 63, w = tid >> 6, wm = w >> 2, wn = w & 3, idx = lane & 15, kq = lane >> 4;
#pragma unroll
        for (int mi = 0; mi < 8; ++mi) {
            const int row = m0 + wm * 128 + mi * 16 + idx; const size_t rg = (size_t)hb * TP + row; const int b = (int)(rg / SEQ);
            const float* gate = (const float*)(p.ws + WS_MOD) + (size_t)(l * 4 + b) * 3072 + 2048;
#pragma unroll
            for (int ni = 0; ni < 4; ++ni) {
                const int col = n0 + wn * 64 + ni * 16 + 4 * kq;
                const f32x4 xv = *(const f32x4*)(xsrc + rg * 1024 + col), gv = *(const f32x4*)(gate + col);
                *(f32x4*)(p.out + rg * 1024 + col) = xv + gv * acc[mi][ni];
            }
        }
    }
}

constexpr int AT_KS = 0, AT_VS = 9216, AT_LQ = 9216 + 8192, AT_LUT = AT_LQ + 512;

#define AT_STAGE_STORE() do { _Pragma("unroll") for (int i = 0; i < 2; ++i) { const int c = tid + 256 * i, row = c >> 3, ch = c & 7; \
        *(u32x4*)(Ks + row * 72 + ch * 8) = rk[i]; *(u32x4*)(Vs + (ch >> 2) * 4096 + row * 64 + (ch & 3) * 16) = rv[i]; } } while (0)

__device__ __forceinline__ void at_qk(f32x16& p0, f32x16& p1, const bf16_t* Ks, const bf16x8* qr, int r32, int hi) {
    bf16x8 kf[8];
#pragma unroll
    for (int ds = 0; ds < 4; ++ds) {
        kf[2 * ds] = *(const bf16x8*)(Ks + r32 * 72 + ds * 16 + hi * 8);
        kf[2 * ds + 1] = *(const bf16x8*)(Ks + (r32 + 32) * 72 + ds * 16 + hi * 8);
    }
    __builtin_amdgcn_sched_barrier(0);
    __builtin_amdgcn_s_setprio(1);
#pragma unroll
    for (int ds = 0; ds < 4; ++ds) {
        p0 = __builtin_amdgcn_mfma_f32_32x32x16_bf16(kf[2 * ds], qr[ds], p0, 0, 0, 0);
        p1 = __builtin_amdgcn_mfma_f32_32x32x16_bf16(kf[2 * ds + 1], qr[ds], p1, 0, 0, 0);
    }
    __builtin_amdgcn_s_setprio(0);
    __builtin_amdgcn_sched_barrier(0);
}
__device__ __forceinline__ void at_pv(f32x16& o0, f32x16& o1, const f32x16& p0, const f32x16& p1, const unsigned char* Vs, int lane) {
    const int hi = lane >> 5;
    const unsigned char* vb = Vs + ((lane >> 4) & 1) * 32 + (lane & 3) * 8 + (4 * hi + ((lane & 15) >> 2)) * 64;
    bf16x8 v0[4], v1[4], pa[4];
#pragma unroll
    for (int s = 0; s < 4; ++s) {
        v0[s] = cat8(tr16(vb + s * 1024), tr16(vb + s * 1024 + 512));
        v1[s] = cat8(tr16(vb + 4096 + s * 1024), tr16(vb + 4096 + s * 1024 + 512));
    }
#pragma unroll
    for (int s = 0; s < 4; ++s) {
        u32x4 pw;
        if (s < 2) { pw.x = pk2(p0[8 * s + 0], p0[8 * s + 1]); pw.y = pk2(p0[8 * s + 2], p0[8 * s + 3]); pw.z = pk2(p0[8 * s + 4], p0[8 * s + 5]); pw.w = pk2(p0[8 * s + 6], p0[8 * s + 7]); }
        else { const int q = s - 2; pw.x = pk2(p1[8 * q + 0], p1[8 * q + 1]); pw.y = pk2(p1[8 * q + 2], p1[8 * q + 3]); pw.z = pk2(p1[8 * q + 4], p1[8 * q + 5]); pw.w = pk2(p1[8 * q + 6], p1[8 * q + 7]); }
        pa[s] = __builtin_bit_cast(bf16x8, pw);
    }
    __builtin_amdgcn_sched_barrier(0);
    __builtin_amdgcn_s_setprio(1);
#pragma unroll
    for (int s = 0; s < 4; ++s) {
        o0 = __builtin_amdgcn_mfma_f32_32x32x16_bf16(pa[s], v0[s], o0, 0, 0, 0);
        o1 = __builtin_amdgcn_mfma_f32_32x32x16_bf16(pa[s], v1[s], o1, 0, 0, 0);
    }
    __builtin_amdgcn_s_setprio(0);
    __builtin_amdgcn_sched_barrier(0);
}

__device__ __forceinline__ void at_ldv(bf16x8 (&v0)[4], bf16x8 (&v1)[4], const unsigned char* Vs, int lane) {
    const int hi = lane >> 5;
    const unsigned char* vb = Vs + ((lane >> 4) & 1) * 32 + (lane & 3) * 8 + (4 * hi + ((lane & 15) >> 2)) * 64;
#pragma unroll
    for (int s = 0; s < 4; ++s) {
        v0[s] = cat8(tr16(vb + s * 1024), tr16(vb + s * 1024 + 512));
        v1[s] = cat8(tr16(vb + 4096 + s * 1024), tr16(vb + 4096 + s * 1024 + 512));
    }
}
__device__ __forceinline__ void at_pv2(f32x16& o0, f32x16& o1, const f32x16& p0, const f32x16& p1, const bf16x8 (&v0)[4], const bf16x8 (&v1)[4]) {
    bf16x8 pa[4];
#pragma unroll
    for (int s = 0; s < 4; ++s) {
        u32x4 pw;
        if (s < 2) { pw.x = pk2(p0[8 * s + 0], p0[8 * s + 1]); pw.y = pk2(p0[8 * s + 2], p0[8 * s + 3]); pw.z = pk2(p0[8 * s + 4], p0[8 * s + 5]); pw.w = pk2(p0[8 * s + 6], p0[8 * s + 7]); }
        else { const int q = s - 2; pw.x = pk2(p1[8 * q + 0], p1[8 * q + 1]); pw.y = pk2(p1[8 * q + 2], p1[8 * q + 3]); pw.z = pk2(p1[8 * q + 4], p1[8 * q + 5]); pw.w = pk2(p1[8 * q + 6], p1[8 * q + 7]); }
        pa[s] = __builtin_bit_cast(bf16x8, pw);
    }
    __builtin_amdgcn_sched_barrier(0);
    __builtin_amdgcn_s_setprio(1);
#pragma unroll
    for (int s = 0; s < 4; ++s) {
        o0 = __builtin_amdgcn_mfma_f32_32x32x16_bf16(pa[s], v0[s], o0, 0, 0, 0);
        o1 = __builtin_amdgcn_mfma_f32_32x32x16_bf16(pa[s], v1[s], o1, 0, 0, 0);
    }
    __builtin_amdgcn_s_setprio(0);
    __builtin_amdgcn_sched_barrier(0);
}

constexpr int ATA_STAGE = 17408, ATA_LQ = 2 * ATA_STAGE;
__device__ void attn_a_item(const Params& p, int item, int l, unsigned char* smem) {
    int tid_ = VTID; asm volatile("" : "+v"(tid_));
    const int tid = tid_, lane = tid & 63, w = tid >> 6, r32 = lane & 31, hi = lane >> 5;
    const int b = item >> 9, r = item & 511, kvh = r >> 8, qblk = (r >> 2) & 63, hq = kvh * 4 + (r & 3);
    float* lq = (float*)(smem + ATA_LQ) + w * 32;
    bf16_t* QA = (bf16_t*)(p.ws + WS_QA);
    const bf16_t* GA = (const bf16_t*)(p.ws + WS_GA);
    const size_t tokq = (size_t)b * SEQ + qblk * 128 + w * 32;
    bf16x8 qr[4];
#pragma unroll
    for (int ds = 0; ds < 4; ++ds) qr[ds] = *(const bf16x8*)(QA + (tokq + r32) * 512 + hq * 64 + ds * 16 + hi * 8);
    const bf16_t* Kb = (const bf16_t*)(p.ws + WS_KA) + (size_t)b * SEQ * 128 + kvh * 64;
    const bf16_t* Vb = (const bf16_t*)(p.ws + WS_VA) + (size_t)b * SEQ * 128 + kvh * 64;
    const float nshift = -((const float*)(p.ws + WS_BND))[l];
    f32x16 o0, o1;
#pragma unroll
    for (int i = 0; i < 16; ++i) { o0[i] = 0.f; o1[i] = 0.f; }
    f32x4 la4 = (f32x4){0.f, 0.f, 0.f, 0.f};
    constexpr int NT = SEQ / 64;
    const int row0 = tid >> 3, ch0 = tid & 7;
    const size_t goff0 = (size_t)row0 * 128 + ch0 * 8, goff1 = goff0 + (size_t)32 * 128;
    const int ko0 = row0 * 144 + ch0 * 16, ko1 = ko0 + 32 * 144;
    const int vo0 = 9216 + (ch0 >> 2) * 4096 + row0 * 64 + (ch0 & 3) * 16, vo1 = vo0 + 32 * 64;
    u32x4 rkA[2], rvA[2], rkB[2], rvB[2];
#define ATA_LOAD(RK, RV, t) do { const size_t tb = (size_t)(t) * 64 * 128; RK[0] = *(const u32x4*)(Kb + tb + goff0); RK[1] = *(const u32x4*)(Kb + tb + goff1); \
        RV[0] = *(const u32x4*)(Vb + tb + goff0); RV[1] = *(const u32x4*)(Vb + tb + goff1); } while (0)
#define ATA_STORE(RK, RV, st) do { unsigned char* sb_ = smem + (st) * ATA_STAGE; *(u32x4*)(sb_ + ko0) = RK[0]; *(u32x4*)(sb_ + ko1) = RK[1]; \
        *(u32x4*)(sb_ + vo0) = RV[0]; *(u32x4*)(sb_ + vo1) = RV[1]; } while (0)
#define ATA_COMPUTE(st) do { const unsigned char* sb_ = smem + (st) * ATA_STAGE; f32x16 p0, p1; bf16x8 vf0[4], vf1[4]; \
        _Pragma("unroll") for (int i = 0; i < 16; ++i) { p0[i] = nshift; p1[i] = nshift; } \
        at_qk(p0, p1, (const bf16_t*)sb_, qr, r32, hi); \
        at_ldv(vf0, vf1, sb_ + 9216, lane); __builtin_amdgcn_sched_barrier(0); \
        _Pragma("unroll") for (int i = 0; i < 16; ++i) { p0[i] = __builtin_amdgcn_exp2f(p0[i]); p1[i] = __builtin_amdgcn_exp2f(p1[i]); } \
        _Pragma("unroll") for (int i = 0; i < 4; ++i) { la4 += (f32x4){p0[4 * i], p0[4 * i + 1], p0[4 * i + 2], p0[4 * i + 3]}; la4 += (f32x4){p1[4 * i], p1[4 * i + 1], p1[4 * i + 2], p1[4 * i + 3]}; } \
        at_pv2(o0, o1, p0, p1, vf0, vf1); } while (0)
    __syncthreads();
    ATA_LOAD(rkA, rvA, 0); ATA_LOAD(rkB, rvB, 1);
    ATA_STORE(rkA, rvA, 0);
    ATA_LOAD(rkA, rvA, 2);
    __syncthreads();
    for (int kt = 0; kt < NT; kt += 2) {
        ATA_COMPUTE(0);
        ATA_STORE(rkB, rvB, 1);
        if (kt + 3 < NT) ATA_LOAD(rkB, rvB, kt + 3);
        __syncthreads();
        ATA_COMPUTE(1);
        if (kt + 2 < NT) { ATA_STORE(rkA, rvA, 0); if (kt + 4 < NT) ATA_LOAD(rkA, rvA, kt + 4); }
        __syncthreads();
    }
#undef ATA_LOAD
#undef ATA_STORE
#undef ATA_COMPUTE
    float lacc = (la4.x + la4.y) + (la4.z + la4.w);
    lacc += __shfl_xor(lacc, 32);
    if (hi == 0) lq[r32] = lacc;
    asm volatile("s_waitcnt lgkmcnt(0)" ::: "memory");
#pragma unroll
    for (int rr = 0; rr < 16; ++rr) {
        const int q = crow(rr, hi); const float inv = 1.f / lq[q];
        const size_t off = (tokq + q) * 512 + hq * 64 + r32;
        const float g0 = bf2f(GA[off]), g1 = bf2f(GA[off + 32]);
        QA[off] = (bf16_t)(pk2(o0[rr] * inv * g0, 0.f) & 0xffffu);
        QA[off + 32] = (bf16_t)(pk2(o1[rr] * inv * g1, 0.f) & 0xffffu);
    }
}

__device__ void attn_b_item(const Params& p, int item, int l, unsigned char* smem) {
    int tid_ = VTID; asm volatile("" : "+v"(tid_));
    const int tid = tid_, lane = tid & 63, w = tid >> 6, r32 = lane & 31, hi = lane >> 5;
    const int blk = item & 63, j = (item >> 6) & 3, bg = item >> 8, g = bg % 3, b = bg / 3;
    const int sh = 2 * g, dil = 1 << sh, Mlen = SEQ >> sh;
    bf16_t* Ks = (bf16_t*)(smem + AT_KS); unsigned char* Vs = smem + AT_VS; float* lq = (float*)(smem + AT_LQ) + w * 32; float* lut = (float*)(smem + AT_LUT);
    bf16_t* QB = (bf16_t*)(p.ws + WS_QB) + (size_t)bg * SEQ * 256 + j * 64;
    const bf16_t* KB = (const bf16_t*)(p.ws + WS_KB) + (size_t)bg * SEQ * 256 + j * 64;
    const bf16_t* VB = (const bf16_t*)(p.ws + WS_VB) + (size_t)bg * SEQ * 256 + j * 64;
    float* LSE = (float*)(p.ws + WS_LSE) + (size_t)bg * SEQ * 4 + j;
    const int p0r = blk * 128, seq_lo = (p0r / Mlen) * Mlen, seq_hi = seq_lo + Mlen;
    __syncthreads();
    if (tid < 129) {
        const int rel = tid - 64, n = (rel < 0 ? -rel : rel) * dil;
        int bk;
        if (n < 8) bk = n; else { bk = 8 + (n >= 15) + (n >= 27) + (n >= 50) + (n >= 91) + (n >= 166) + (n >= 305) + (n >= 559); }
        if (rel > 0) bk += 16;
        lut[tid] = p.rel_bias[bk * 12 + g * 4 + j] * LOG2E;
    }
    const int qpos = p0r + w * 32 + r32;
    bf16x8 qr[4];
#pragma unroll
    for (int ds = 0; ds < 4; ++ds) qr[ds] = *(const bf16x8*)(QB + (size_t)qpos * 256 + ds * 16 + hi * 8);
    const float nshift = -((const float*)(p.ws + WS_BND))[2 + l];
    f32x16 o0, o1;
#pragma unroll
    for (int i = 0; i < 16; ++i) { o0[i] = 0.f; o1[i] = 0.f; }
    f32x4 la4 = (f32x4){0.f, 0.f, 0.f, 0.f};
    u32x4 rk[2], rv[2];
    for (int kt = 0; kt < 4; ++kt) {
        const int kbase = p0r - 64 + 64 * kt;
#pragma unroll
        for (int i = 0; i < 2; ++i) { const int c = tid + 256 * i, row = c >> 3, ch = c & 7;
            int pr = kbase + row; pr = pr < 0 ? 0 : (pr > SEQ - 1 ? SEQ - 1 : pr);
            rk[i] = *(const u32x4*)(KB + (size_t)pr * 256 + ch * 8); rv[i] = *(const u32x4*)(VB + (size_t)pr * 256 + ch * 8); }
        __syncthreads();
        AT_STAGE_STORE();
        __syncthreads();
        f32x16 p0, p1;
#pragma unroll
        for (int i = 0; i < 16; ++i) { p0[i] = nshift; p1[i] = nshift; }
        at_qk(p0, p1, Ks, qr, r32, hi);
#pragma unroll
        for (int i = 0; i < 16; ++i) {
            const int kv0 = kbase + crow(i, hi), kv1 = kv0 + 32;
            const int rel0 = kv0 - qpos, rel1 = kv1 - qpos;
            const bool ok0 = rel0 >= -64 && rel0 <= 64 && kv0 >= seq_lo && kv0 < seq_hi;
            const bool ok1 = rel1 >= -64 && rel1 <= 64 && kv1 >= seq_lo && kv1 < seq_hi;
            const float e0 = __builtin_amdgcn_exp2f(p0[i] + lut[ok0 ? rel0 + 64 : 64]);
            const float e1 = __builtin_amdgcn_exp2f(p1[i] + lut[ok1 ? rel1 + 64 : 64]);
            p0[i] = ok0 ? e0 : 0.f; p1[i] = ok1 ? e1 : 0.f;
        }
#pragma unroll
        for (int i = 0; i < 4; ++i) { la4 += (f32x4){p0[4 * i], p0[4 * i + 1], p0[4 * i + 2], p0[4 * i + 3]}; la4 += (f32x4){p1[4 * i], p1[4 * i + 1], p1[4 * i + 2], p1[4 * i + 3]}; }
        at_pv(o0, o1, p0, p1, Vs, lane);
    }
    float lacc = (la4.x + la4.y) + (la4.z + la4.w);
    lacc += __shfl_xor(lacc, 32);
    if (hi == 0) { lq[r32] = lacc; LSE[(size_t)qpos * 4] = (-nshift + log2f(lacc)) * LN2; }
    asm volatile("s_waitcnt lgkmcnt(0)" ::: "memory");
#pragma unroll
    for (int rr = 0; rr < 16; ++rr) {
        const int q = crow(rr, hi); const float inv = 1.f / lq[q];
        const size_t off = (size_t)(p0r + w * 32 + q) * 256 + r32;
        QB[off] = (bf16_t)(pk2(o0[rr] * inv, 0.f) & 0xffffu);
        QB[off + 32] = (bf16_t)(pk2(o1[rr] * inv, 0.f) & 0xffffu);
    }
}

__device__ void conv_phase(const Params& p, int l) {
    int tx_ = threadIdx.x; asm volatile("" : "+v"(tx_));
    const bf16_t* XBC = (const bf16_t*)(p.ws + WS_XBC);
    bf16_t* XC = (bf16_t*)(p.ws + WS_XBCC);
    const float* cw = p.conv_w + (size_t)l * 5 * 1024; const float* cb = p.conv_b + l * 1024;
    const int nthr = gridDim.x * 512;
    for (int u = blockIdx.x * 512 + tx_; u < (TP / 4) * 128; u += nthr) {
        const int ch = (u & 127) * 8, tg = u >> 7, tok0 = tg * 4, tt0 = tok0 & (SEQ - 1);
        u32x4 raw[8];
#pragma unroll
        for (int r = 0; r < 8; ++r) { const int tt = tt0 - 2 + r; raw[r] = (u32x4){0u, 0u, 0u, 0u};
            if (tt >= 0 && tt < SEQ) raw[r] = *(const u32x4*)(XBC + (size_t)(tok0 - 2 + r) * 1024 + ch); }
        float ac[4][8];
        { const f32x4 a = *(const f32x4*)(cb + ch), b2 = *(const f32x4*)(cb + ch + 4);
#pragma unroll
          for (int t = 0; t < 4; ++t) { ac[t][0] = a.x; ac[t][1] = a.y; ac[t][2] = a.z; ac[t][3] = a.w; ac[t][4] = b2.x; ac[t][5] = b2.y; ac[t][6] = b2.z; ac[t][7] = b2.w; } }
#pragma unroll
        for (int k = 0; k < 5; ++k) { const f32x4 wa = *(const f32x4*)(cw + k * 1024 + ch), wb = *(const f32x4*)(cw + k * 1024 + ch + 4);
#pragma unroll
            for (int t = 0; t < 4; ++t) { const u32x4 v = raw[t + k];
                ac[t][0] += bflo(v.x) * wa.x; ac[t][1] += bfhi(v.x) * wa.y; ac[t][2] += bflo(v.y) * wa.z; ac[t][3] += bfhi(v.y) * wa.w;
                ac[t][4] += bflo(v.z) * wb.x; ac[t][5] += bfhi(v.z) * wb.y; ac[t][6] += bflo(v.w) * wb.z; ac[t][7] += bfhi(v.w) * wb.w; } }
#pragma unroll
        for (int t = 0; t < 4; ++t) { u32x4 o;
            o.x = pk2(siluf(ac[t][0]), siluf(ac[t][1])); o.y = pk2(siluf(ac[t][2]), siluf(ac[t][3])); o.z = pk2(siluf(ac[t][4]), siluf(ac[t][5])); o.w = pk2(siluf(ac[t][6]), siluf(ac[t][7]));
            *(u32x4*)(XC + (size_t)(tok0 + t) * 1024 + ch) = o; }
    }
}

constexpr int SS_BS = 0, SS_CS = 8704, SS_XS = 17408, SS_XWS = 22016, SS_GS = 26624, SS_SB = 29184, SS_CW = 46592, SS_SC = 54272, SS_DTA = 55296, SS_END = 57344;

template <int PASS>
__device__ void ssd_item(const Params& p, int item, int l, unsigned char* smem) {
    int tid_ = VTID; asm volatile("" : "+v"(tid_));
    const int tid = tid_, lane = tid & 63, w = tid >> 6, idx = lane & 15, kq = lane >> 4;
    const int seg = item & 15, h = (item >> 4) & 7, dir = (item >> 7) & 1, b = item >> 8, grp = h >> 2;
    bf16_t* Bs = (bf16_t*)(smem + SS_BS); bf16_t* Cs = (bf16_t*)(smem + SS_CS); bf16_t* Xs = (bf16_t*)(smem + SS_XS); bf16_t* Xws = (bf16_t*)(smem + SS_XWS);
    bf16_t* Gs = (bf16_t*)(smem + SS_GS); bf16_t* Sb = (bf16_t*)(smem + SS_SB); float* cwl = (float*)(smem + SS_CW); float* sc = (float*)(smem + SS_SC);
    float* s_dt = sc, *s_c = sc + 32, *s_rs = sc + 64, *s_wl = sc + 96, *s_tot = sc + 128;
    const bf16_t* XBC = (const bf16_t*)(p.ws + WS_XBC);
    const float* DT = (const float*)(p.ws + WS_DT);
    float* ST = (float*)(p.ws + WS_ST); float* SEGT = (float*)(p.ws + WS_SEGT);
    bf16_t* Y = (bf16_t*)(p.ws + (dir ? WS_YS : WS_YF));
    const float Aneg = -__expf(p.a_log[l * 16 + dir * 8 + h]);
    const float Dh = p.d_skip[l * 8 + h];
    __syncthreads();
    f32x4 S[8];
#pragma unroll
    for (int nt = 0; nt < 8; ++nt) S[nt] = (f32x4){0.f, 0.f, 0.f, 0.f};
    const int ibase = item & ~15;
    if (PASS == 3) {
        if (dir == 0) {
            for (int e = 0; e < seg; ++e) { const float dc = __expf(SEGT[ibase + e]); const f32x4* src = (const f32x4*)(ST + (size_t)(ibase + e) * 8192);
#pragma unroll
                for (int nt = 0; nt < 8; ++nt) S[nt] = S[nt] * dc + src[(w * 8 + nt) * 64 + lane]; }
        } else {
            for (int e = NSEG - 1; e > seg; --e) { const float dc = __expf(SEGT[ibase + e]); const f32x4* src = (const f32x4*)(ST + (size_t)(ibase + e) * 8192);
#pragma unroll
                for (int nt = 0; nt < 8; ++nt) S[nt] = S[nt] * dc + src[(w * 8 + nt) * 64 + lane]; }
        }
#pragma unroll
        for (int nt = 0; nt < 8; ++nt) st4bf(Sb + (16 * w + idx) * 136 + 16 * nt + 4 * kq, S[nt]);
    }
    float* s_dta = (float*)(smem + SS_DTA);
    for (int e = tid; e < SEGLEN; e += 256) s_dta[e] = DT[((size_t)b * SEQ + seg * SEGLEN + e) * 16 + dir * 8 + h];
    float segtot = 0.f;
    const size_t tokb = (size_t)b * SEQ;
    const unsigned char* xb_ = (const unsigned char*)((const bf16_t*)(p.ws + WS_XBCC) + tokb * 1024);
    unsigned soff[5];
#pragma unroll
    for (int i = 0; i < 5; ++i) { const int u = tid + 256 * i, lrow = u / 40, ci = u % 40;
        const int scol = ci < 8 ? h * 64 + ci * 8 : (ci < 24 ? 512 + grp * 128 + (ci * 8 - 64) : 768 + grp * 128 + (ci * 8 - 192));
        soff[i] = (unsigned)((lrow * 1024 + scol) * 2); }
    for (int si = 0; si < NSUB; ++si) {
        const int scn = dir ? (NSUB - 1 - si) : si;
        const int t0 = seg * SEGLEN + scn * TSUB;
        __syncthreads();
        u32x4 raw[5];
#pragma unroll
        for (int i = 0; i < 5; ++i) raw[i] = *(const u32x4*)(xb_ + ((unsigned)(t0 * 2048) + soff[i]));
        if (w == 0) {
            float dtv = 0.f, av = 0.f;
            if (lane < 32) { dtv = s_dta[scn * TSUB + lane]; av = dtv * Aneg; }
            float pre = av;
#pragma unroll
            for (int o = 1; o < 32; o <<= 1) { const float t = __shfl_up(pre, o); if (lane >= o) pre += t; }
            const float tot = __shfl(pre, 31);
            const float cc = dir ? (tot - pre + av) : pre;
            if (lane < 32) { s_dt[lane] = dtv; s_c[lane] = cc; s_rs[lane] = __expf(cc); s_wl[lane] = dtv * __expf(tot - cc); }
            if (lane == 0) s_tot[0] = tot;
        }
        __syncthreads();
        segtot += s_tot[0];
#pragma unroll
        for (int i = 0; i < 5; ++i) { const int u = tid + 256 * i, lrow = u / 40, ci = u % 40, lc = ci * 8; const u32x4 o = raw[i];
            if (ci < 8) { *(u32x4*)(Xs + lrow * 72 + lc) = o; const float wl = s_wl[lrow];
                u32x4 o2; o2.x = pk2(bflo(o.x) * wl, bfhi(o.x) * wl); o2.y = pk2(bflo(o.y) * wl, bfhi(o.y) * wl); o2.z = pk2(bflo(o.z) * wl, bfhi(o.z) * wl); o2.w = pk2(bflo(o.w) * wl, bfhi(o.w) * wl);
                *(u32x4*)(Xws + lrow * 72 + lc) = o2; }
            else if (ci < 24) *(u32x4*)(Bs + lrow * 136 + (lc - 64)) = o;
            else *(u32x4*)(Cs + lrow * 136 + (lc - 192)) = o; }
        __syncthreads();
        if (PASS == 3) {
            const int it = w >> 1, jt = w & 1;
            f32x4 cb = (f32x4){0.f, 0.f, 0.f, 0.f};
            {
                bf16x8 fb[4], fc[4];
#pragma unroll
                for (int ks = 0; ks < 4; ++ks) { fb[ks] = *(const bf16x8*)(Bs + (16 * jt + idx) * 136 + ks * 32 + kq * 8); fc[ks] = *(const bf16x8*)(Cs + (16 * it + idx) * 136 + ks * 32 + kq * 8); }
                __builtin_amdgcn_sched_barrier(0);
#pragma unroll
                for (int ks = 0; ks < 4; ++ks) cb = __builtin_amdgcn_mfma_f32_16x16x32_bf16(fb[ks], fc[ks], cb, 0, 0, 0);
                __builtin_amdgcn_sched_barrier(0);
            }
            {
                const int ii = 16 * it + idx; const float ci_ = s_c[ii];
                f32x4 gv;
#pragma unroll
                for (int rg = 0; rg < 4; ++rg) {
                    const int jj = 16 * jt + 4 * kq + rg;
                    const bool ok = dir ? (jj >= ii) : (jj <= ii);
                    const float e = __expf(ci_ - s_c[jj]) * s_dt[jj];
                    gv[rg] = ok ? cb[rg] * e : 0.f;
                }
                st4bf(Gs + ii * 40 + 16 * jt + 4 * kq, gv);
            }
            __syncthreads();
            const unsigned char* xtr = (const unsigned char*)Xs + (8 * kq + (idx >> 2)) * 144 + (16 * w + 4 * (idx & 3)) * 2;
            const bf16x8 xf = cat8(tr16(xtr), tr16(xtr + 4 * 144));
#pragma unroll 1
            for (int it2 = 0; it2 < 2; ++it2) {
                const int ii = 16 * it2 + idx;
                const bf16x8 gf = *(const bf16x8*)(Gs + ii * 40 + 8 * kq);
                f32x4 yd = (f32x4){0.f, 0.f, 0.f, 0.f}, yo = (f32x4){0.f, 0.f, 0.f, 0.f};
                bf16x8 sf[4], cf[4];
#pragma unroll
                for (int ks = 0; ks < 4; ++ks) { sf[ks] = *(const bf16x8*)(Sb + (16 * w + idx) * 136 + ks * 32 + kq * 8); cf[ks] = *(const bf16x8*)(Cs + ii * 136 + ks * 32 + kq * 8); }
                __builtin_amdgcn_sched_barrier(0);
                yd = __builtin_amdgcn_mfma_f32_16x16x32_bf16(xf, gf, yd, 0, 0, 0);
#pragma unroll
                for (int ks = 0; ks < 4; ++ks) yo = __builtin_amdgcn_mfma_f32_16x16x32_bf16(sf[ks], cf[ks], yo, 0, 0, 0);
                __builtin_amdgcn_sched_barrier(0);
                f32x4 y = yd + yo * s_rs[ii];
                if (dir == 0) { const u32x2 xv = *(const u32x2*)(Xs + ii * 72 + 16 * w + 4 * kq);
                    y.x += Dh * bflo(xv.x); y.y += Dh * bfhi(xv.x); y.z += Dh * bflo(xv.y); y.w += Dh * bfhi(xv.y); }
                st4bf(Y + (tokb + t0 + ii) * 512 + h * 64 + 16 * w + 4 * kq, y);
            }
        }
        {
            const float dc = __expf(s_tot[0]);
            const unsigned char* xw = (const unsigned char*)Xws + (8 * kq + (idx >> 2)) * 144 + (16 * w + 4 * (idx & 3)) * 2;
            const bf16x8 xwf = cat8(tr16(xw), tr16(xw + 4 * 144));
            bf16x8 bfv[8];
#pragma unroll
            for (int nt = 0; nt < 8; ++nt) {
                const unsigned char* bt = (const unsigned char*)Bs + (8 * kq + (idx >> 2)) * 272 + (16 * nt + 4 * (idx & 3)) * 2;
                bfv[nt] = cat8(tr16(bt), tr16(bt + 4 * 272));
            }
            __builtin_amdgcn_sched_barrier(0);
#pragma unroll
            for (int nt = 0; nt < 8; ++nt) S[nt] = __builtin_amdgcn_mfma_f32_16x16x32_bf16(bfv[nt], xwf, S[nt] * dc, 0, 0, 0);
            __builtin_amdgcn_sched_barrier(0);
            if (PASS == 3) {
#pragma unroll
                for (int nt = 0; nt < 8; ++nt) st4bf(Sb + (16 * w + idx) * 136 + 16 * nt + 4 * kq, S[nt]);
            }
        }
    }
    if (PASS == 1) {
        f32x4* dst = (f32x4*)(ST + (size_t)item * 8192);
#pragma unroll
        for (int nt = 0; nt < 8; ++nt) dst[(w * 8 + nt) * 64 + lane] = S[nt];
        if (tid == 0) SEGT[item] = segtot;
    }
}

__device__ void post2_phase(const Params& p) {
    int tx_ = threadIdx.x; asm volatile("" : "+v"(tx_));
    const int lane = tx_ & 63, gw = blockIdx.x * 8 + (tx_ >> 6), nw = gridDim.x * 8;
    const bf16_t* OB = (const bf16_t*)(p.ws + WS_QB); const float* LSE = (const float*)(p.ws + WS_LSE);
    const bf16_t* GB = (const bf16_t*)(p.ws + WS_GB);
    bf16_t* YBM = (bf16_t*)(p.ws + WS_YBM);
    const bf16_t* YF = (const bf16_t*)(p.ws + WS_YF); const bf16_t* YS = (const bf16_t*)(p.ws + WS_YS); const bf16_t* ZS = (const bf16_t*)(p.ws + WS_ZS);
    bf16_t* YC = (bf16_t*)(p.ws + WS_YC); float* RS = (float*)(p.ws + WS_RSTD);
    for (int row = gw; row < TP; row += nw) {
        const int bl = row >> 13, tt = row & (SEQ - 1), j = lane >> 4;
        float ls[3]; size_t ro[3];
#pragma unroll
        for (int g = 0; g < 3; ++g) { const int sh = 2 * g; const int pp = (tt & ((1 << sh) - 1)) * (SEQ >> sh) + (tt >> sh);
            ro[g] = (size_t)(bl * 3 + g) * SEQ + pp; ls[g] = LSE[ro[g] * 4 + j]; }
        const float mx = fmaxf(ls[0], fmaxf(ls[1], ls[2]));
        float wg[3]; float ws = 0.f;
#pragma unroll
        for (int g = 0; g < 3; ++g) { wg[g] = __expf(ls[g] - mx); ws += wg[g]; }
        const float inv = 1.f / ws;
        f32x4 acc = (f32x4){0.f, 0.f, 0.f, 0.f};
#pragma unroll
        for (int g = 0; g < 3; ++g) { const u32x2 v = *(const u32x2*)(OB + ro[g] * 256 + 4 * lane); const float wv = wg[g] * inv;
            acc.x += wv * bflo(v.x); acc.y += wv * bfhi(v.x); acc.z += wv * bflo(v.y); acc.w += wv * bfhi(v.y); }
        { const u32x2 gt = *(const u32x2*)(GB + (size_t)row * 256 + 4 * lane);
          acc.x *= bflo(gt.x); acc.y *= bfhi(gt.x); acc.z *= bflo(gt.y); acc.w *= bfhi(gt.y); }
        st4bf(YBM + (size_t)row * 256 + 4 * lane, acc);
        const u32x4 a = *(const u32x4*)(YF + (size_t)row * 512 + 8 * lane), bq = *(const u32x4*)(YS + (size_t)row * 512 + 8 * lane), z = *(const u32x4*)(ZS + (size_t)row * 512 + 8 * lane);
        float y[8];
        y[0] = (bflo(a.x) + bflo(bq.x)) * bflo(z.x); y[1] = (bfhi(a.x) + bfhi(bq.x)) * bfhi(z.x);
        y[2] = (bflo(a.y) + bflo(bq.y)) * bflo(z.y); y[3] = (bfhi(a.y) + bfhi(bq.y)) * bfhi(z.y);
        y[4] = (bflo(a.z) + bflo(bq.z)) * bflo(z.z); y[5] = (bfhi(a.z) + bfhi(bq.z)) * bfhi(z.z);
        y[6] = (bflo(a.w) + bflo(bq.w)) * bflo(z.w); y[7] = (bfhi(a.w) + bfhi(bq.w)) * bfhi(z.w);
        float ss = 0.f;
#pragma unroll
        for (int e = 0; e < 8; ++e) ss += y[e] * y[e];
        ss = wave_sum(ss);
        u32x4 o; o.x = pk2(y[0], y[1]); o.y = pk2(y[2], y[3]); o.z = pk2(y[4], y[5]); o.w = pk2(y[6], y[7]);
        *(u32x4*)(YC + (size_t)row * 512 + 8 * lane) = o;
        if (lane == 0) RS[row] = rsqrtf(ss * (1.f / 512.f) + EPS);
    }
}


#define XB_TMO      128
#define XB_XCNT(j)  (256  + 64 * (j))
#define XB_XSUB(j)  (1280 + 64 * (j))
#define XB_XGEN(j)  (2304 + 64 * (j))
#define XB_TOP      3328
#define XB_TOPGEN   3392
#define XCD_BAR_WORDS 3456
#define XB_SPIN_CAP (1u << 20)
__device__ __forceinline__ unsigned xb_ld(unsigned* p)              { return __hip_atomic_load(p, __ATOMIC_RELAXED, __HIP_MEMORY_SCOPE_AGENT); }
__device__ __forceinline__ unsigned xb_add(unsigned* p, unsigned v) { return __hip_atomic_fetch_add(p, v, __ATOMIC_RELAXED, __HIP_MEMORY_SCOPE_AGENT); }
__device__ __forceinline__ unsigned xb_xcc_id() { return (unsigned)__builtin_amdgcn_s_getreg((3 << 11) | 20) & 0xFu; }
#define XB_SPIN(cond, bar) do { unsigned _sp = 0; while (cond) { __builtin_amdgcn_s_sleep(1); \
    if ((++_sp & 255u) == 0u) { if (xb_ld(&(bar)[XB_TMO])) break; if (_sp > XB_SPIN_CAP) { atomicAdd(&(bar)[XB_TMO], 1u); break; } } } } while (0)
struct XcdBarrier { unsigned* bar; unsigned x; volatile LDSAS unsigned* st; };
__device__ __forceinline__ XcdBarrier xcd_barrier_post(unsigned* bar, volatile LDSAS unsigned* st) {
    XcdBarrier b; b.bar = bar; b.x = xb_xcc_id(); b.st = st;
    if (threadIdx.x == 0) (void)xb_add(&bar[XB_XCNT(b.x)], 1u);
    return b;
}
__device__ __forceinline__ void xcd_barrier_complete(unsigned* bar, unsigned x, unsigned& nloc, unsigned& nx) {
    const unsigned G = gridDim.x * gridDim.y * gridDim.z;
    unsigned sum, cnt, mine, sp = 0u;
    for (;;) {
        sum = 0u; cnt = 0u; mine = 0u;
#pragma unroll
        for (unsigned j = 0; j < 16; ++j) { const unsigned c = xb_ld(&bar[XB_XCNT(j)]); sum += c; cnt += (c > 0u) ? 1u : 0u; mine = (j == x) ? c : mine; }
        if (sum == G) break;
        __builtin_amdgcn_s_sleep(1);
        if ((++sp & 255u) == 0u) { if (xb_ld(&bar[XB_TMO])) break; if (sp > XB_SPIN_CAP) { atomicAdd(&bar[XB_TMO], 1u); break; } }
    }
    nloc = mine > 0u ? mine : 1u; nx = cnt > 0u ? cnt : 1u;
}
__device__ __forceinline__ void xcd_barrier(const XcdBarrier& b) {
    asm volatile("s_waitcnt vmcnt(0)" ::: "memory");
    __syncthreads();
    if (threadIdx.x == 0) {
        unsigned* bar = b.bar;
        __builtin_amdgcn_s_waitcnt(0);
        unsigned nloc = b.st[0], nx = b.st[1];
        if (nloc == 0u) { xcd_barrier_complete(bar, b.x, nloc, nx); b.st[0] = nloc; b.st[1] = nx; }
        const unsigned old = xb_add(&bar[XB_XSUB(b.x)], 1u);
        const unsigned gen = old / nloc;
        if (old + 1u == (gen + 1u) * nloc) {
            __builtin_amdgcn_fence(__ATOMIC_RELEASE, "agent");
            asm volatile("s_waitcnt vmcnt(0)" ::: "memory");
            const unsigned og = xb_add(&bar[XB_TOP], 1u);
            const unsigned tg = og / nx;
            if (og + 1u == (tg + 1u) * nx) xb_add(&bar[XB_TOPGEN], 1u);
            else XB_SPIN(xb_ld(&bar[XB_TOPGEN]) == tg, bar);
            __builtin_amdgcn_fence(__ATOMIC_ACQUIRE, "agent");
            xb_add(&bar[XB_XGEN(b.x)], 1u);
            asm volatile("s_waitcnt vmcnt(0)" ::: "memory");
        } else {
            XB_SPIN(xb_ld(&bar[XB_XGEN(b.x)]) == gen, bar);
            __builtin_amdgcn_fence(__ATOMIC_ACQUIRE, "agent");
            asm volatile("s_waitcnt vmcnt(0)" ::: "memory");
        }
    }
    __syncthreads();
}

__device__ __forceinline__ unsigned char* lds_half(unsigned char* smem) { int h_ = threadIdx.x >> 8; asm volatile("" : "+v"(h_)); return smem + h_ * HALF_LDS; }
__global__ void __launch_bounds__(512, 2) hybrid_fwd(Params p) {
    cg::grid_group grid = cg::this_grid();
    extern __shared__ __attribute__((aligned(16))) unsigned char smem[];
    volatile LDSAS unsigned* bst = (volatile LDSAS unsigned*)(smem + LDS_TOTAL - 16);
    if (threadIdx.x < 4) bst[threadIdx.x] = 0u;
    __syncthreads();
    const XcdBarrier xbar = xcd_barrier_post((unsigned*)(p.ws + WS_BAR), bst);
    { const Params q = launder(p); phase0(q, lds_half(smem)); }
    grid.sync();
#pragma unroll 1
    for (int l = 0; l < DEPTH; ++l) {
#pragma unroll 1
        for (int hb = 0; hb < 2; ++hb) {
            { const Params q = launder(p); norm_phase(q, l, hb, (l == 0) ? q.x : q.out); }
            xcd_barrier(xbar);
            { const Params q = launder(p); gemm1_phase(q, l, hb, smem); }
            xcd_barrier(xbar);
            { const Params q = launder(p); conv_phase(q, l); }
            xcd_barrier(xbar);
            { const Params q = launder(p); unsigned char* smh = lds_half(smem);
#pragma unroll 1
              for (int it = VBLK; it < 512 + 1536; it += VGRID) { if (it < 512) ssd_item<1>(q, it, l, smh); else attn_b_item(q, it - 512, l, smh); } }
            xcd_barrier(xbar);
            { const Params q = launder(p); unsigned char* smh = lds_half(smem);
#pragma unroll 1
              for (int it = VBLK; it < 1024 + 512; it += VGRID) { if (it < 1024) attn_a_item(q, it, l, smh); else ssd_item<3>(q, it - 1024, l, smh); } }
            xcd_barrier(xbar);
            { const Params q = launder(p); post2_phase(q); }
            xcd_barrier(xbar);
            { const Params q = launder(p); merge_phase(q, l, smem); }
            xcd_barrier(xbar);
            { const Params q = launder(p); out_phase(q, l, hb, (l == 0) ? q.x : q.out, smem); }
        }
    }
}

extern "C" void kernel_launch(void* const* d_in, const int* in_sizes, int n_in, void* d_out, int out_size, void* d_ws, size_t ws_size, hipStream_t stream) {
    static int grid_blocks = 0;
    if (!grid_blocks) {
        int dev = 0, cus = 0, per_cu = 0;
        hipGetDevice(&dev);
        hipDeviceGetAttribute(&cus, hipDeviceAttributeMultiprocessorCount, dev);
        hipFuncSetAttribute((const void*)hybrid_fwd, hipFuncAttributeMaxDynamicSharedMemorySize, LDS_TOTAL);
        hipOccupancyMaxActiveBlocksPerMultiprocessor(&per_cu, hybrid_fwd, 512, LDS_TOTAL);
        if (per_cu > 1) per_cu = 1;
        if (per_cu < 1) per_cu = 1;
        grid_blocks = cus * per_cu;
    }
    Params p{};
    const float** pp = (const float**)&p;
    for (int i = 0; i < 22; ++i) pp[i] = (const float*)d_in[i];
    p.out = (float*)d_out; p.ws = (unsigned char*)d_ws;
    hipMemsetAsync((unsigned char*)d_ws + WS_BAR, 0, XCD_BAR_WORDS * 4, stream);
    void* args[] = {&p};
    hipError_t e = hipLaunchCooperativeKernel((void*)hybrid_fwd, dim3(grid_blocks), dim3(512), args, LDS_TOTAL, stream);
    if (e != hipSuccess) fprintf(stderr, "cooperative launch failed: %s (grid %d)\n", hipGetErrorString(e), grid_blocks);
}
```

```cpp
#include <hip/hip_runtime.h>
#include <hip/hip_cooperative_groups.h>
#include <cstdint>
#include <cstdio>
namespace cg = cooperative_groups;

typedef unsigned short bf16_t;
typedef short bf16x8 __attribute__((ext_vector_type(8)));
typedef short v4i16 __attribute__((ext_vector_type(4)));
typedef float f32x2 __attribute__((ext_vector_type(2)));
typedef float f32x4 __attribute__((ext_vector_type(4)));
typedef float f32x16 __attribute__((ext_vector_type(16)));
typedef unsigned u32x2 __attribute__((ext_vector_type(2)));
typedef unsigned u32x4 __attribute__((ext_vector_type(4)));
typedef __bf16 bf16x2_t __attribute__((ext_vector_type(2)));
#define LDSAS __attribute__((address_space(3)))
#define VTID ((int)(threadIdx.x & 255u))
__device__ __forceinline__ int vblk_() { int h_ = threadIdx.x >> 8; asm volatile("" : "+v"(h_)); return __builtin_amdgcn_readfirstlane(2 * (int)blockIdx.x + h_); }
#define VBLK vblk_()
#define VGRID ((int)(2u * gridDim.x))
constexpr int HALF_LDS = 73728, LDS_TOTAL = 147456;

constexpr int SEQ = 8192, DM = 1024, NBATCH = 4, NBH = 2, TP = NBH * SEQ, DEPTH = 2;
constexpr int NP = 8704;
constexpr float EPS = 1e-6f;
constexpr float LOG2E = 1.4426950408889634f, LN2 = 0.6931471805599453f;
constexpr int NSEG = 16, SEGLEN = 512, TSUB = 32, NSUB = SEGLEN / TSUB;

constexpr size_t MiB = 1u << 20;
constexpr size_t WS_WIN = 0;
constexpr size_t WS_WPA = 34 * MiB;
constexpr size_t WS_WPB = 36 * MiB;
constexpr size_t WS_WPC = 37 * MiB;
constexpr size_t WS_WOUT = 39 * MiB;
constexpr size_t WS_MOD = 43 * MiB;
constexpr size_t WS_ROPE = 43 * MiB + 128 * 1024;
constexpr size_t WS_BND = 43 * MiB + 160 * 1024;
constexpr size_t WS_RSTD = 43 * MiB + 256 * 1024;
constexpr size_t WS_SEGT = 43 * MiB + 512 * 1024;
constexpr size_t WS_LSE = 44 * MiB;
constexpr size_t WS_DT = 45 * MiB;
constexpr size_t WS_BAR = 46 * MiB;
constexpr size_t WS_H = 48 * MiB;
constexpr size_t WS_QA = 80 * MiB;
constexpr size_t WS_KA = 96 * MiB;
constexpr size_t WS_VA = 100 * MiB;
constexpr size_t WS_GA = 104 * MiB;
constexpr size_t WS_QB = 120 * MiB;
constexpr size_t WS_KB = 144 * MiB;
constexpr size_t WS_VB = 168 * MiB;
constexpr size_t WS_GB = 192 * MiB;
constexpr size_t WS_XBC = 200 * MiB;
constexpr size_t WS_ZS = 232 * MiB;
constexpr size_t WS_MG = 248 * MiB;
constexpr size_t WS_YF = 344 * MiB;
constexpr size_t WS_YS = 360 * MiB;
constexpr size_t WS_YBM = 376 * MiB;
constexpr size_t WS_YC = 384 * MiB;
constexpr size_t WS_MRG = 400 * MiB;
constexpr size_t WS_ST = 432 * MiB;
constexpr size_t WS_XBCC = 448 * MiB;

struct Params {
    const float *x, *c, *norm_w, *w_ada, *b_ada, *w_in, *b_gate, *q_norm_a, *k_norm_a, *q_norm_b, *k_norm_b, *rel_bias,
        *conv_w, *conv_b, *a_log, *dt_bias, *d_skip, *ssm_norm_w, *w_proj_a, *w_proj_b, *w_proj_c, *w_out;
    float* out;
    unsigned char* ws;
};


#define AS1 __attribute__((address_space(1)))
#define GLOBF(f) do { AS1 const float* g_ = (AS1 const float*)p.f; asm volatile("" : "+s"(g_)); q.f = (const float*)g_; } while (0)
__device__ __forceinline__ Params launder(const Params& p) {
    Params q;
    GLOBF(x); GLOBF(c); GLOBF(norm_w); GLOBF(w_ada); GLOBF(b_ada); GLOBF(w_in); GLOBF(b_gate); GLOBF(q_norm_a); GLOBF(k_norm_a); GLOBF(q_norm_b); GLOBF(k_norm_b); GLOBF(rel_bias);
    GLOBF(conv_w); GLOBF(conv_b); GLOBF(a_log); GLOBF(dt_bias); GLOBF(d_skip); GLOBF(ssm_norm_w); GLOBF(w_proj_a); GLOBF(w_proj_b); GLOBF(w_proj_c); GLOBF(w_out);
    { AS1 float* g_ = (AS1 float*)p.out; asm volatile("" : "+s"(g_)); q.out = (float*)g_; }
    { AS1 unsigned char* g_ = (AS1 unsigned char*)p.ws; asm volatile("" : "+s"(g_)); q.ws = (unsigned char*)g_; }
    return q;
}
__device__ __forceinline__ unsigned pk2(float lo, float hi) { f32x2 v = {lo, hi}; bf16x2_t b = __builtin_convertvector(v, bf16x2_t); return __builtin_bit_cast(unsigned, b); }
__device__ __forceinline__ float bf2f(unsigned short b) { return __uint_as_float(((unsigned)b) << 16); }
__device__ __forceinline__ float bflo(unsigned u) { return __uint_as_float(u << 16); }
__device__ __forceinline__ float bfhi(unsigned u) { return __uint_as_float(u & 0xffff0000u); }
__device__ __forceinline__ float siluf(float v) { return v * __builtin_amdgcn_rcpf(1.f + __builtin_amdgcn_exp2f(-1.4426950408889634f * v)); }
__device__ __forceinline__ float sigmf(float v) { return __builtin_amdgcn_rcpf(1.f + __builtin_amdgcn_exp2f(-1.4426950408889634f * v)); }
__device__ __forceinline__ float wave_sum(float v) {
#pragma unroll
    for (int o = 1; o < 64; o <<= 1) v += __shfl_xor(v, o);
    return v;
}
__device__ __forceinline__ v4i16 tr16(const unsigned char* p) { return __builtin_amdgcn_ds_read_tr16_b64_v4i16((LDSAS v4i16*)p); }
__device__ __forceinline__ bf16x8 cat8(v4i16 a, v4i16 b) { return (bf16x8){a[0], a[1], a[2], a[3], b[0], b[1], b[2], b[3]}; }
__device__ __forceinline__ int crow(int r, int hi) { return (r & 3) + 8 * (r >> 2) + 4 * hi; }

struct P0It { const float* W; bf16_t* Wt; const float* rs; int ldw, K, k0, n0, mode; };
__device__ __forceinline__ void p0_load(const P0It& t, float (&vv)[16]) {
    const int tid = VTID, tx = tid & 63, ty = tid >> 6;
    const int np = t.n0 + tx; int n = np; bool valid = true;
    if (t.mode == 1) {
        if (np < 4352) n = np; else if (np < 4864) n = np + 512; else if (np < 5376) n = np - 512;
        else if (np < 8448) n = np + 16; else if (np < 8464) n = np - 3072; else { valid = false; n = 0; }
    }
#pragma unroll
    for (int i = 0; i < 16; ++i) { const int k = ty + 4 * i; vv[i] = valid ? t.W[(size_t)(t.k0 + k) * t.ldw + n] : 0.f; }
}
__device__ __forceinline__ void p0_finish(const P0It& t, const float (&vv)[16], float* tile) {
    const int tid = VTID, tx = tid & 63, ty = tid >> 6;
#pragma unroll
    for (int i = 0; i < 16; ++i) { const int k = ty + 4 * i; float v = vv[i]; if (t.rs) v *= t.rs[t.k0 + k]; tile[k * 65 + tx] = v; }
    __syncthreads();
    const int r = tid >> 2, kc = (tid & 3) * 16;
    u32x4 o0, o1;
    o0.x = pk2(tile[(kc + 0) * 65 + r], tile[(kc + 1) * 65 + r]); o0.y = pk2(tile[(kc + 2) * 65 + r], tile[(kc + 3) * 65 + r]);
    o0.z = pk2(tile[(kc + 4) * 65 + r], tile[(kc + 5) * 65 + r]); o0.w = pk2(tile[(kc + 6) * 65 + r], tile[(kc + 7) * 65 + r]);
    o1.x = pk2(tile[(kc + 8) * 65 + r], tile[(kc + 9) * 65 + r]); o1.y = pk2(tile[(kc + 10) * 65 + r], tile[(kc + 11) * 65 + r]);
    o1.z = pk2(tile[(kc + 12) * 65 + r], tile[(kc + 13) * 65 + r]); o1.w = pk2(tile[(kc + 14) * 65 + r], tile[(kc + 15) * 65 + r]);
    bf16_t* dst = t.Wt + (size_t)(t.n0 + r) * t.K + t.k0 + kc;
    *(u32x4*)dst = o0; *(u32x4*)(dst + 8) = o1;
    __syncthreads();
}
constexpr int P0_IN = 16 * 136, P0_PA = 8 * 16, P0_PB = 4 * 16, P0_PC = 8 * 16, P0_OUT = 16 * 16, P0_L = P0_IN + P0_PA + P0_PB + P0_PC + P0_OUT;
__device__ __forceinline__ P0It p0_params(const Params& p, int item) {
    P0It t; const int l = item / P0_L; int r = item % P0_L; t.rs = nullptr; t.mode = 0;
    if (r < P0_IN) { t.W = p.w_in + (size_t)l * 1024 * 8464; t.ldw = 8464; t.K = 1024; t.Wt = (bf16_t*)(p.ws + WS_WIN) + (size_t)l * NP * 1024; t.k0 = (r / 136) * 64; t.n0 = (r % 136) * 64; t.mode = 1; return t; }
    r -= P0_IN;
    if (r < P0_PA) { t.W = p.w_proj_a + (size_t)l * 512 * 1024; t.ldw = 1024; t.K = 512; t.Wt = (bf16_t*)(p.ws + WS_WPA) + (size_t)l * 1024 * 512; t.k0 = (r / 16) * 64; t.n0 = (r % 16) * 64; return t; }
    r -= P0_PA;
    if (r < P0_PB) { t.W = p.w_proj_b + (size_t)l * 256 * 1024; t.ldw = 1024; t.K = 256; t.Wt = (bf16_t*)(p.ws + WS_WPB) + (size_t)l * 1024 * 256; t.k0 = (r / 16) * 64; t.n0 = (r % 16) * 64; return t; }
    r -= P0_PB;
    if (r < P0_PC) { t.W = p.w_proj_c + (size_t)l * 512 * 1024; t.ldw = 1024; t.K = 512; t.Wt = (bf16_t*)(p.ws + WS_WPC) + (size_t)l * 1024 * 512; t.k0 = (r / 16) * 64; t.n0 = (r % 16) * 64; t.rs = p.ssm_norm_w + l * 512; return t; }
    r -= P0_PC;
    t.W = p.w_out + (size_t)l * 1024 * 1024; t.ldw = 1024; t.K = 1024; t.Wt = (bf16_t*)(p.ws + WS_WOUT) + (size_t)l * 1024 * 1024; t.k0 = (r / 16) * 64; t.n0 = (r % 16) * 64; return t;
}

__device__ void phase0(const Params& p, unsigned char* smem) {
    const int tid = VTID;
    float* tile = (float*)smem;
    constexpr int I_T = 2 * P0_L, I_MOD = 192, I_ALL = I_T + I_MOD + 1;
    {
        int item = VBLK;
        if (item < I_T) {
            P0It cur = p0_params(p, item); float va[16], vb[16]; p0_load(cur, va);
            for (;;) {
                const int nx = item + VGRID; const bool more = nx < I_T; P0It nxt = cur;
                if (more) { nxt = p0_params(p, nx); p0_load(nxt, vb); }
                p0_finish(cur, va, tile);
                if (!more) break;
                item = nx; cur = nxt;
#pragma unroll
                for (int i = 0; i < 16; ++i) va[i] = vb[i];
            }
        }
    }
    for (int item = VBLK; item < I_ALL; item += VGRID) {
        if (item < I_T) {
            continue;
        } else if (item < I_T + I_MOD) {
            const int it = item - I_T, l = it / 96, col0 = (it % 96) * 32, cl = tid & 31, ks = tid >> 5;
            float a0 = 0.f, a1 = 0.f, a2 = 0.f, a3 = 0.f;
            const float* wp = p.w_ada + ((size_t)l * 1024 + ks * 128) * 3072 + col0 + cl;
#pragma unroll 8
            for (int k = 0; k < 128; ++k) {
                const float wv = wp[(size_t)k * 3072]; const int kk = ks * 128 + k;
                a0 += siluf(p.c[kk]) * wv; a1 += siluf(p.c[1024 + kk]) * wv; a2 += siluf(p.c[2048 + kk]) * wv; a3 += siluf(p.c[3072 + kk]) * wv;
            }
            float* red = (float*)smem;
            red[(ks * 32 + cl) * 4 + 0] = a0; red[(ks * 32 + cl) * 4 + 1] = a1; red[(ks * 32 + cl) * 4 + 2] = a2; red[(ks * 32 + cl) * 4 + 3] = a3;
            __syncthreads();
            if (tid < 128) { const int b = tid >> 5, c2 = tid & 31; float s = 0.f;
#pragma unroll
                for (int k = 0; k < 8; ++k) s += red[(k * 32 + c2) * 4 + b];
                ((float*)(p.ws + WS_MOD))[(l * 4 + b) * 3072 + col0 + c2] = s + p.b_ada[l * 3072 + col0 + c2]; }
            __syncthreads();
        } else {
            float* rc = (float*)(p.ws + WS_ROPE); float* rs = rc + 128 * 16;
            for (int e = tid; e < 2048; e += 256) {
                const int pos = e >> 4, i = e & 15;
                const float freq = powf(10000.0f, -(float)i / 16.0f);
                const float ang = (float)pos * freq;
                const double rev = (double)ang * 0.15915494309189535; const double fr = rev - rint(rev);
                const float a = (float)(fr * 6.283185307179586);
                rc[e] = cosf(a); rs[e] = sinf(a);
            }
            if (tid < 2) {
                const int l = tid; float mqa = 0.f, mka = 0.f, mqb = 0.f, mkb = 0.f, mb = 0.f;
                for (int i = 0; i < 64; ++i) { mqa = fmaxf(mqa, fabsf(p.q_norm_a[l * 64 + i])); mka = fmaxf(mka, fabsf(p.k_norm_a[l * 64 + i]));
                    mqb = fmaxf(mqb, fabsf(p.q_norm_b[l * 64 + i])); mkb = fmaxf(mkb, fabsf(p.k_norm_b[l * 64 + i])); }
                for (int i = 0; i < 32 * 12; ++i) mb = fmaxf(mb, p.rel_bias[i]);
                float* bd = (float*)(p.ws + WS_BND);
                bd[l] = 8.f * mqa * mka * LOG2E; bd[2 + l] = (8.f * mqb * mkb + mb) * LOG2E;
            }
        }
    }
}

__device__ void norm_phase(const Params& p, int l, int hb, const float* xsrc) {
    int tx_ = threadIdx.x; asm volatile("" : "+v"(tx_));
    const int lane = tx_ & 63, gw = blockIdx.x * 8 + (tx_ >> 6), nw = gridDim.x * 8;
    bf16_t* H = (bf16_t*)(p.ws + WS_H);
    const float* nwp = p.norm_w + l * 1024;
    for (int row = gw; row < TP; row += nw) {
        const size_t rg = (size_t)hb * TP + row; const int b = (int)(rg / SEQ);
        const f32x4* xr = (const f32x4*)(xsrc + rg * 1024);
        const float* md = (const float*)(p.ws + WS_MOD) + (size_t)(l * 4 + b) * 3072;
        f32x4 v[4]; float ss = 0.f;
#pragma unroll
        for (int j = 0; j < 4; ++j) { v[j] = xr[lane + 64 * j]; ss += v[j].x * v[j].x + v[j].y * v[j].y + v[j].z * v[j].z + v[j].w * v[j].w; }
        ss = wave_sum(ss); const float rstd = rsqrtf(ss * (1.f / 1024.f) + EPS);
#pragma unroll
        for (int j = 0; j < 4; ++j) {
            const int col = 4 * (lane + 64 * j);
            const f32x4 w4 = *(const f32x4*)(nwp + col), sh = *(const f32x4*)(md + col), sc = *(const f32x4*)(md + 1024 + col);
            const f32x4 o = v[j] * rstd * w4 * (1.f + sc) + sh;
            u32x2 pk; pk.x = pk2(o.x, o.y); pk.y = pk2(o.z, o.w);
            *(u32x2*)(H + (size_t)row * 1024 + col) = pk;
        }
    }
}

constexpr int G_STAGE = 65536, G_AB = 32768;
__device__ __forceinline__ void gemm_core(const bf16_t* __restrict__ A, int lda, const bf16_t* __restrict__ Bt, int ldb, int K, f32x4 (&acc)[8][4], unsigned char* smem, int tid) {
    asm volatile("" : "+v"(tid));
    const int lane = tid & 63, w = __builtin_amdgcn_readfirstlane(tid >> 6), wm = w >> 2, wn = w & 3, idx = lane & 15, kq = lane >> 4;
    unsigned offA[4], offB[4];
#pragma unroll
    for (int j = 0; j < 4; ++j) { const int row = (j * 8 + w) * 8 + (lane >> 3), c = (lane & 7) ^ ((row >> 1) & 7);
        offA[j] = (unsigned)(row * lda + c * 8) * 2u; offB[j] = (unsigned)(row * ldb + c * 8) * 2u; }
#pragma unroll
    for (int mi = 0; mi < 8; ++mi)
#pragma unroll
        for (int ni = 0; ni < 4; ++ni) acc[mi][ni] = (f32x4){0.f, 0.f, 0.f, 0.f};
    LDSAS unsigned char* lds = (LDSAS unsigned char*)smem;
#define G_ISSUE1(kt, st, j) do { \
        __builtin_amdgcn_global_load_lds((const unsigned*)((const char*)A + offA[j] + (kt) * 128), (LDSAS unsigned*)(lds + (st) * G_STAGE + ((j) * 8 + w) * 1024), 16, 0, 0); \
        __builtin_amdgcn_global_load_lds((const unsigned*)((const char*)Bt + offB[j] + (kt) * 128), (LDSAS unsigned*)(lds + (st) * G_STAGE + G_AB + ((j) * 8 + w) * 1024), 16, 0, 0); } while (0)
#define G_ISSUE(kt, st) do { G_ISSUE1(kt, st, 0); G_ISSUE1(kt, st, 1); G_ISSUE1(kt, st, 2); G_ISSUE1(kt, st, 3); } while (0)
    const int nk = K >> 6;
    G_ISSUE(0, 0);
    asm volatile("s_waitcnt vmcnt(0)" ::: "memory");
    __syncthreads();
    const int swz = (idx >> 1) & 7;
    const int aoff = (wm * 128 + idx) * 128, boff = G_AB + (wn * 64 + idx) * 128;
    for (int kt = 0; kt < nk; ++kt) {
        const int st = kt & 1;
        const bool more = kt + 1 < nk;
        const unsigned char* sb = smem + st * G_STAGE;
#pragma unroll
        for (int ks = 0; ks < 2; ++ks) {
            bf16x8 bfr[4], af[8];
            const int co = ((ks * 4 + kq) ^ swz) * 16;
#pragma unroll
            for (int ni = 0; ni < 4; ++ni) bfr[ni] = *(const bf16x8*)(sb + boff + ni * 2048 + co);
#pragma unroll
            for (int mi = 0; mi < 8; ++mi) af[mi] = *(const bf16x8*)(sb + aoff + mi * 2048 + co);
            if (more) { G_ISSUE1(kt + 1, st ^ 1, ks * 2); G_ISSUE1(kt + 1, st ^ 1, ks * 2 + 1); }
            __builtin_amdgcn_sched_barrier(0);
            __builtin_amdgcn_s_setprio(1);
#pragma unroll
            for (int mi = 0; mi < 8; ++mi)
#pragma unroll
                for (int ni = 0; ni < 4; ++ni) acc[mi][ni] = __builtin_amdgcn_mfma_f32_16x16x32_bf16(bfr[ni], af[mi], acc[mi][ni], 0, 0, 0);
            __builtin_amdgcn_s_setprio(0);
            __builtin_amdgcn_sched_barrier(0);
        }
        asm volatile("s_waitcnt vmcnt(0)" ::: "memory");
        __syncthreads();
    }
#undef G_ISSUE1
#undef G_ISSUE
}

__device__ __forceinline__ void st4bf(bf16_t* dst, f32x4 v) { u32x2 pk; pk.x = pk2(v.x, v.y); pk.y = pk2(v.z, v.w); *(u32x2*)dst = pk; }

__device__ void gemm1_phase(const Params& p, int l, int hb, unsigned char* smem) {
    const bf16_t* H = (const bf16_t*)(p.ws + WS_H);
    const bf16_t* Wt = (const bf16_t*)(p.ws + WS_WIN) + (size_t)l * NP * 1024;
    const float* ropec = (const float*)(p.ws + WS_ROPE); const float* ropes = ropec + 2048;
    constexpr int NT = 34, NTILES = 64 * NT, GRP = 8 * NT;
    for (int t = blockIdx.x; t < NTILES; t += gridDim.x) {
        const int grp = t / GRP, r = t % GRP, jx = NT * (r & 7) + (r >> 3), mt = grp * 8 + (jx & 7), nt = jx >> 3;
        const int m0 = mt * 256, n0 = nt * 256;
        f32x4 acc[8][4];
        int tid = threadIdx.x;
        gemm_core(H + (size_t)m0 * 1024, 1024, Wt + (size_t)n0 * 1024, 1024, 1024, acc, smem, tid);
        asm volatile("" : "+v"(tid));
        const int lane = tid & 63, w = __builtin_amdgcn_readfirstlane(tid >> 6), wm = w >> 2, wn = w & 3, idx = lane & 15, kq = lane >> 4;
        const int cw = n0 + wn * 64;
        const int lc = 4 * kq;
        unsigned char* wl = smem + w * 16384;
#define G1_STG(mi_, ni_, v_) do { const int r_ = (mi_) * 16 + idx; const f32x4 t_ = (v_); u32x2 pk_; pk_.x = pk2(t_.x, t_.y); pk_.y = pk2(t_.z, t_.w); \
        *(u32x2*)(wl + r_ * 128 + ((((ni_) * 2 + (kq >> 1)) ^ (r_ & 7)) * 16) + (kq & 1) * 8) = pk_; } while (0)
        bf16_t* dbase = nullptr; int dpitch = 0, dc0 = 0, dsh = -1, dg = 0;
        if (cw < 768 && (cw < 640)) {
            const bool isq = cw < 512;
            const float* nwp = (isq ? p.q_norm_a : p.k_norm_a) + l * 64;
            dbase = isq ? (bf16_t*)(p.ws + WS_QA) : (bf16_t*)(p.ws + WS_KA);
            dpitch = isq ? 512 : 128; dc0 = isq ? cw : cw - 512;
            const float qs = isq ? 0.125f * LOG2E : 1.f;
#pragma unroll
            for (int mi = 0; mi < 8; ++mi) {
                const int row = m0 + wm * 128 + mi * 16 + idx;
                float ss = 0.f;
#pragma unroll
                for (int ni = 0; ni < 4; ++ni) { const f32x4 v = acc[mi][ni]; ss += v.x * v.x + v.y * v.y + v.z * v.z + v.w * v.w; }
                ss += __shfl_xor(ss, 16); ss += __shfl_xor(ss, 32);
                const float rstd = rsqrtf(ss * (1.f / 64.f) + EPS);
                f32x4 y[4];
#pragma unroll
                for (int ni = 0; ni < 4; ++ni) y[ni] = acc[mi][ni] * rstd * *(const f32x4*)(nwp + ni * 16 + lc);
                const int tt = row & (SEQ - 1), prow = tt >> 6, pcol = tt & 63;
#pragma unroll
                for (int hf = 0; hf < 2; ++hf) {
                    const int pos = hf ? pcol : prow;
                    const f32x4 cs = *(const f32x4*)(ropec + pos * 16 + lc), sn = *(const f32x4*)(ropes + pos * 16 + lc);
                    const f32x4 a = y[2 * hf], b = y[2 * hf + 1];
                    y[2 * hf] = a * cs - b * sn; y[2 * hf + 1] = b * cs + a * sn;
                }
#pragma unroll
                for (int ni = 0; ni < 4; ++ni) G1_STG(mi, ni, y[ni] * qs);
            }
        } else if (cw >= 1280 && cw < 2816) {
            const bool isq = cw < 2048;
            const float* nwp = (isq ? p.q_norm_b : p.k_norm_b) + l * 64;
            const int gc = isq ? cw - 1280 : cw - 2048;
            dg = gc >> 8; dc0 = gc & 255; dsh = 2 * dg; dpitch = 256;
            dbase = (bf16_t*)(p.ws + (isq ? WS_QB : WS_KB));
            const float qs = isq ? 0.125f * LOG2E : 1.f;
#pragma unroll
            for (int mi = 0; mi < 8; ++mi) {
                float ss = 0.f;
#pragma unroll
                for (int ni = 0; ni < 4; ++ni) { const f32x4 v = acc[mi][ni]; ss += v.x * v.x + v.y * v.y + v.z * v.z + v.w * v.w; }
                ss += __shfl_xor(ss, 16); ss += __shfl_xor(ss, 32);
                const float rstd = rsqrtf(ss * (1.f / 64.f) + EPS) * qs;
#pragma unroll
                for (int ni = 0; ni < 4; ++ni) G1_STG(mi, ni, acc[mi][ni] * rstd * *(const f32x4*)(nwp + ni * 16 + lc));
            }
        } else if (cw >= 2816 && cw < 3584) {
            const int gc = cw - 2816;
            dg = gc >> 8; dc0 = gc & 255; dsh = 2 * dg; dpitch = 256; dbase = (bf16_t*)(p.ws + WS_VB);
#pragma unroll
            for (int mi = 0; mi < 8; ++mi)
#pragma unroll
                for (int ni = 0; ni < 4; ++ni) G1_STG(mi, ni, acc[mi][ni]);
        } else if (cw >= 8448) {
            if (cw == 8448) {
                float* dst = (float*)(p.ws + WS_DT);
                const f32x4 bias = *(const f32x4*)(p.dt_bias + l * 16 + lc);
#pragma unroll
                for (int mi = 0; mi < 8; ++mi) {
                    const int row = m0 + wm * 128 + mi * 16 + idx;
                    f32x4 v = acc[mi][0] + bias, o;
                    o.x = v.x > 20.f ? v.x : log1pf(__expf(v.x)); o.y = v.y > 20.f ? v.y : log1pf(__expf(v.y));
                    o.z = v.z > 20.f ? v.z : log1pf(__expf(v.z)); o.w = v.w > 20.f ? v.w : log1pf(__expf(v.w));
                    *(f32x4*)(dst + (size_t)row * 16 + lc) = o;
                }
            }
        } else {
            int mode;
            if (cw < 768) { dbase = (bf16_t*)(p.ws + WS_VA); dpitch = 128; dc0 = cw - 640; mode = 0; }
            else if (cw < 1280) { dbase = (bf16_t*)(p.ws + WS_GA); dpitch = 512; dc0 = cw - 768; mode = 1; }
            else if (cw < 3840) { dbase = (bf16_t*)(p.ws + WS_GB); dpitch = 256; dc0 = cw - 3584; mode = 1; }
            else if (cw < 4864) { dbase = (bf16_t*)(p.ws + WS_XBC); dpitch = 1024; dc0 = cw - 3840; mode = 0; }
            else if (cw < 5376) { dbase = (bf16_t*)(p.ws + WS_ZS); dpitch = 512; dc0 = cw - 4864; mode = 1; }
            else { dbase = (bf16_t*)(p.ws + WS_MG); dpitch = 3072; dc0 = cw - 5376; mode = 2; }
            const float* bg = p.b_gate + l * 3072 + dc0 + lc;
#pragma unroll
            for (int mi = 0; mi < 8; ++mi) {
#pragma unroll
                for (int ni = 0; ni < 4; ++ni) {
                    f32x4 v = acc[mi][ni];
                    if (mode == 1) { v.x = siluf(v.x); v.y = siluf(v.y); v.z = siluf(v.z); v.w = siluf(v.w); }
                    else if (mode == 2) { const f32x4 bb = *(const f32x4*)(bg + ni * 16); v.x = sigmf(v.x + bb.x); v.y = sigmf(v.y + bb.y); v.z = sigmf(v.z + bb.z); v.w = sigmf(v.w + bb.w); }
                    G1_STG(mi, ni, v);
                }
            }
        }
#undef G1_STG
        if (dbase) {
            const int ch = lane & 7;
#pragma unroll
            for (int j = 0; j < 16; ++j) {
                const int rl = 8 * j + (lane >> 3), row = m0 + wm * 128 + rl;
                const u32x4 v = *(const u32x4*)(wl + rl * 128 + ((ch ^ (rl & 7)) * 16));
                size_t drow = (size_t)row;
                if (dsh >= 0) { const int bl = row >> 13, tt = row & (SEQ - 1); drow = (size_t)(bl * 3 + dg) * SEQ + (size_t)((tt & ((1 << dsh) - 1)) * (SEQ >> dsh) + (tt >> dsh)); }
                *(u32x4*)(dbase + drow * dpitch + dc0 + ch * 8) = v;
            }
        }
        __syncthreads();
    }
}

__device__ void merge_phase(const Params& p, int l, unsigned char* smem) {
    const bf16_t* MG = (const bf16_t*)(p.ws + WS_MG);
    const float* rstd = (const float*)(p.ws + WS_RSTD);
    bf16_t* MR = (bf16_t*)(p.ws + WS_MRG);
    for (int t = blockIdx.x; t < 64 * 4; t += gridDim.x) {
        const int xq = t >> 3, mt = (xq >> 2) * 8 + (t & 7), nt = xq & 3, m0 = mt * 256, n0 = nt * 256;
#pragma unroll 1
        for (int br = 0; br < 3; ++br) {
            f32x4 acc[8][4];
            const bf16_t* A; const bf16_t* Bt; int K;
            if (br == 0) { A = (const bf16_t*)(p.ws + WS_QA); K = 512; Bt = (const bf16_t*)(p.ws + WS_WPA) + (size_t)l * 1024 * 512; }
            else if (br == 1) { A = (const bf16_t*)(p.ws + WS_YBM); K = 256; Bt = (const bf16_t*)(p.ws + WS_WPB) + (size_t)l * 1024 * 256; }
            else { A = (const bf16_t*)(p.ws + WS_YC); K = 512; Bt = (const bf16_t*)(p.ws + WS_WPC) + (size_t)l * 1024 * 512; }
            int tid = threadIdx.x;
            gemm_core(A + (size_t)m0 * K, K, Bt + (size_t)n0 * K, K, K, acc, smem, tid);
            asm volatile("" : "+v"(tid));
            const int lane = tid & 63, w = tid >> 6, wm = w >> 2, wn = w & 3, idx = lane & 15, kq = lane >> 4;
#pragma unroll
            for (int mi = 0; mi < 8; ++mi) {
                const int row = m0 + wm * 128 + mi * 16 + idx;
                const float rs = (br == 2) ? rstd[row] : 1.f;
#pragma unroll
                for (int ni = 0; ni < 4; ++ni) {
                    const int col = n0 + wn * 64 + ni * 16 + 4 * kq;
                    const u32x2 g = *(const u32x2*)(MG + (size_t)row * 3072 + br * 1024 + col);
                    f32x4 gv; gv.x = bflo(g.x); gv.y = bfhi(g.x); gv.z = bflo(g.y); gv.w = bfhi(g.y);
                    f32x4 v = gv * rs * acc[mi][ni];
                    bf16_t* mp = MR + (size_t)row * 1024 + col;
                    if (br > 0) { const u32x2 o = *(const u32x2*)mp; v.x += bflo(o.x); v.y += bfhi(o.x); v.z += bflo(o.y); v.w += bfhi(o.y); }
                    st4bf(mp, v);
                }
            }
        }
    }
}

__device__ void out_phase(const Params& p, int l, int hb, const float* xsrc, unsigned char* smem) {
    const bf16_t* MR = (const bf16_t*)(p.ws + WS_MRG);
    const bf16_t* Wt = (const bf16_t*)(p.ws + WS_WOUT) + (size_t)l * 1024 * 1024;
    for (int t = blockIdx.x; t < 64 * 4; t += gridDim.x) {
        const int xq = t >> 3, mt = (xq >> 2) * 8 + (t & 7), nt = xq & 3, m0 = mt * 256, n0 = nt * 256;
        f32x4 acc[8][4];
        int tid = threadIdx.x;
        gemm_core(MR + (size_t)m0 * 1024, 1024, Wt + (size_t)n0 * 1024, 1024, 1024, acc, smem, tid);
        asm volatile("" : "+v"(tid));
        const int lane = tid & 63, w = tid >> 6, wm = w >> 2, wn = w & 3, idx = lane & 15, kq = lane >> 4;
#pragma unroll
        for (int mi = 0; mi < 8; ++mi) {
            const int row = m0 + wm * 128 + mi * 16 + idx; const size_t rg = (size_t)hb * TP + row; const int b = (int)(rg / SEQ);
            const float* gate = (const float*)(p.ws + WS_MOD) + (size_t)(l * 4 + b) * 3072 + 2048;
#pragma unroll
            for (int ni = 0; ni < 4; ++ni) {
                const int col = n0 + wn * 64 + ni * 16 + 4 * kq;
                const f32x4 xv = *(const f32x4*)(xsrc + rg * 1024 + col), gv = *(const f32x4*)(gate + col);
                *(f32x4*)(p.out + rg * 1024 + col) = xv + gv * acc[mi][ni];
            }
        }
    }
}

constexpr int AT_KS = 0, AT_VS = 9216, AT_LQ = 9216 + 8192, AT_LUT = AT_LQ + 512;

#define AT_STAGE_STORE() do { _Pragma("unroll") for (int i = 0; i < 2; ++i) { const int c = tid + 256 * i, row = c >> 3, ch = c & 7; \
        *(u32x4*)(Ks + row * 72 + ch * 8) = rk[i]; *(u32x4*)(Vs + (ch >> 2) * 4096 + row * 64 + (ch & 3) * 16) = rv[i]; } } while (0)

__device__ __forceinline__ void at_qk(f32x16& p0, f32x16& p1, const bf16_t* Ks, const bf16x8* qr, int r32, int hi) {
    bf16x8 kf[8];
#pragma unroll
    for (int ds = 0; ds < 4; ++ds) {
        kf[2 * ds] = *(const bf16x8*)(Ks + r32 * 72 + ds * 16 + hi * 8);
        kf[2 * ds + 1] = *(const bf16x8*)(Ks + (r32 + 32) * 72 + ds * 16 + hi * 8);
    }
    __builtin_amdgcn_sched_barrier(0);
    __builtin_amdgcn_s_setprio(1);
#pragma unroll
    for (int ds = 0; ds < 4; ++ds) {
        p0 = __builtin_amdgcn_mfma_f32_32x32x16_bf16(kf[2 * ds], qr[ds], p0, 0, 0, 0);
        p1 = __builtin_amdgcn_mfma_f32_32x32x16_bf16(kf[2 * ds + 1], qr[ds], p1, 0, 0, 0);
    }
    __builtin_amdgcn_s_setprio(0);
    __builtin_amdgcn_sched_barrier(0);
}
__device__ __forceinline__ void at_pv(f32x16& o0, f32x16& o1, const f32x16& p0, const f32x16& p1, const unsigned char* Vs, int lane) {
    const int hi = lane >> 5;
    const unsigned char* vb = Vs + ((lane >> 4) & 1) * 32 + (lane & 3) * 8 + (4 * hi + ((lane & 15) >> 2)) * 64;
    bf16x8 v0[4], v1[4], pa[4];
#pragma unroll
    for (int s = 0; s < 4; ++s) {
        v0[s] = cat8(tr16(vb + s * 1024), tr16(vb + s * 1024 + 512));
        v1[s] = cat8(tr16(vb + 4096 + s * 1024), tr16(vb + 4096 + s * 1024 + 512));
    }
#pragma unroll
    for (int s = 0; s < 4; ++s) {
        u32x4 pw;
        if (s < 2) { pw.x = pk2(p0[8 * s + 0], p0[8 * s + 1]); pw.y = pk2(p0[8 * s + 2], p0[8 * s + 3]); pw.z = pk2(p0[8 * s + 4], p0[8 * s + 5]); pw.w = pk2(p0[8 * s + 6], p0[8 * s + 7]); }
        else { const int q = s - 2; pw.x = pk2(p1[8 * q + 0], p1[8 * q + 1]); pw.y = pk2(p1[8 * q + 2], p1[8 * q + 3]); pw.z = pk2(p1[8 * q + 4], p1[8 * q + 5]); pw.w = pk2(p1[8 * q + 6], p1[8 * q + 7]); }
        pa[s] = __builtin_bit_cast(bf16x8, pw);
    }
    __builtin_amdgcn_sched_barrier(0);
    __builtin_amdgcn_s_setprio(1);
#pragma unroll
    for (int s = 0; s < 4; ++s) {
        o0 = __builtin_amdgcn_mfma_f32_32x32x16_bf16(pa[s], v0[s], o0, 0, 0, 0);
        o1 = __builtin_amdgcn_mfma_f32_32x32x16_bf16(pa[s], v1[s], o1, 0, 0, 0);
    }
    __builtin_amdgcn_s_setprio(0);
    __builtin_amdgcn_sched_barrier(0);
}

__device__ __forceinline__ void at_ldv(bf16x8 (&v0)[4], bf16x8 (&v1)[4], const unsigned char* Vs, int lane) {
    const int hi = lane >> 5;
    const unsigned char* vb = Vs + ((lane >> 4) & 1) * 32 + (lane & 3) * 8 + (4 * hi + ((lane & 15) >> 2)) * 64;
#pragma unroll
    for (int s = 0; s < 4; ++s) {
        v0[s] = cat8(tr16(vb + s * 1024), tr16(vb + s * 1024 + 512));
        v1[s] = cat8(tr16(vb + 4096 + s * 1024), tr16(vb + 4096 + s * 1024 + 512));
    }
}
__device__ __forceinline__ void at_pv2(f32x16& o0, f32x16& o1, const f32x16& p0, const f32x16& p1, const bf16x8 (&v0)[4], const bf16x8 (&v1)[4]) {
    bf16x8 pa[4];
#pragma unroll
    for (int s = 0; s < 4; ++s) {
        u32x4 pw;
        if (s < 2) { pw.x = pk2(p0[8 * s + 0], p0[8 * s + 1]); pw.y = pk2(p0[8 * s + 2], p0[8 * s + 3]); pw.z = pk2(p0[8 * s + 4], p0[8 * s + 5]); pw.w = pk2(p0[8 * s + 6], p0[8 * s + 7]); }
        else { const int q = s - 2; pw.x = pk2(p1[8 * q + 0], p1[8 * q + 1]); pw.y = pk2(p1[8 * q + 2], p1[8 * q + 3]); pw.z = pk2(p1[8 * q + 4], p1[8 * q + 5]); pw.w = pk2(p1[8 * q + 6], p1[8 * q + 7]); }
        pa[s] = __builtin_bit_cast(bf16x8, pw);
    }
    __builtin_amdgcn_sched_barrier(0);
    __builtin_amdgcn_s_setprio(1);
#pragma unroll
    for (int s = 0; s < 4; ++s) {
        o0 = __builtin_amdgcn_mfma_f32_32x32x16_bf16(pa[s], v0[s], o0, 0, 0, 0);
        o1 = __builtin_amdgcn_mfma_f32_32x32x16_bf16(pa[s], v1[s], o1, 0, 0, 0);
    }
    __builtin_amdgcn_s_setprio(0);
    __builtin_amdgcn_sched_barrier(0);
}

constexpr int ATA_STAGE = 17408, ATA_LQ = 2 * ATA_STAGE;
__device__ void attn_a_item(const Params& p, int item, int l, unsigned char* smem) {
    int tid_ = VTID; asm volatile("" : "+v"(tid_));
    const int tid = tid_, lane = tid & 63, w = tid >> 6, r32 = lane & 31, hi = lane >> 5;
    const int b = item >> 9, r = item & 511, kvh = r >> 8, qblk = (r >> 2) & 63, hq = kvh * 4 + (r & 3);
    float* lq = (float*)(smem + ATA_LQ) + w * 32;
    bf16_t* QA = (bf16_t*)(p.ws + WS_QA);
    const bf16_t* GA = (const bf16_t*)(p.ws + WS_GA);
    const size_t tokq = (size_t)b * SEQ + qblk * 128 + w * 32;
    bf16x8 qr[4];
#pragma unroll
    for (int ds = 0; ds < 4; ++ds) qr[ds] = *(const bf16x8*)(QA + (tokq + r32) * 512 + hq * 64 + ds * 16 + hi * 8);
    const bf16_t* Kb = (const bf16_t*)(p.ws + WS_KA) + (size_t)b * SEQ * 128 + kvh * 64;
    const bf16_t* Vb = (const bf16_t*)(p.ws + WS_VA) + (size_t)b * SEQ * 128 + kvh * 64;
    const float nshift = -((const float*)(p.ws + WS_BND))[l];
    f32x16 o0, o1;
#pragma unroll
    for (int i = 0; i < 16; ++i) { o0[i] = 0.f; o1[i] = 0.f; }
    f32x4 la4 = (f32x4){0.f, 0.f, 0.f, 0.f};
    constexpr int NT = SEQ / 64;
    const int row0 = tid >> 3, ch0 = tid & 7;
    const size_t goff0 = (size_t)row0 * 128 + ch0 * 8, goff1 = goff0 + (size_t)32 * 128;
    const int ko0 = row0 * 144 + ch0 * 16, ko1 = ko0 + 32 * 144;
    const int vo0 = 9216 + (ch0 >> 2) * 4096 + row0 * 64 + (ch0 & 3) * 16, vo1 = vo0 + 32 * 64;
    u32x4 rkA[2], rvA[2], rkB[2], rvB[2];
#define ATA_LOAD(RK, RV, t) do { const size_t tb = (size_t)(t) * 64 * 128; RK[0] = *(const u32x4*)(Kb + tb + goff0); RK[1] = *(const u32x4*)(Kb + tb + goff1); \
        RV[0] = *(const u32x4*)(Vb + tb + goff0); RV[1] = *(const u32x4*)(Vb + tb + goff1); } while (0)
#define ATA_STORE(RK, RV, st) do { unsigned char* sb_ = smem + (st) * ATA_STAGE; *(u32x4*)(sb_ + ko0) = RK[0]; *(u32x4*)(sb_ + ko1) = RK[1]; \
        *(u32x4*)(sb_ + vo0) = RV[0]; *(u32x4*)(sb_ + vo1) = RV[1]; } while (0)
#define ATA_COMPUTE(st) do { const unsigned char* sb_ = smem + (st) * ATA_STAGE; f32x16 p0, p1; bf16x8 vf0[4], vf1[4]; \
        _Pragma("unroll") for (int i = 0; i < 16; ++i) { p0[i] = nshift; p1[i] = nshift; } \
        at_qk(p0, p1, (const bf16_t*)sb_, qr, r32, hi); \
        at_ldv(vf0, vf1, sb_ + 9216, lane); __builtin_amdgcn_sched_barrier(0); \
        _Pragma("unroll") for (int i = 0; i < 16; ++i) { p0[i] = __builtin_amdgcn_exp2f(p0[i]); p1[i] = __builtin_amdgcn_exp2f(p1[i]); } \
        _Pragma("unroll") for (int i = 0; i < 4; ++i) { la4 += (f32x4){p0[4 * i], p0[4 * i + 1], p0[4 * i + 2], p0[4 * i + 3]}; la4 += (f32x4){p1[4 * i], p1[4 * i + 1], p1[4 * i + 2], p1[4 * i + 3]}; } \
        at_pv2(o0, o1, p0, p1, vf0, vf1); } while (0)
    __syncthreads();
    ATA_LOAD(rkA, rvA, 0); ATA_LOAD(rkB, rvB, 1);
    ATA_STORE(rkA, rvA, 0);
    ATA_LOAD(rkA, rvA, 2);
    __syncthreads();
    for (int kt = 0; kt < NT; kt += 2) {
        ATA_COMPUTE(0);
        ATA_STORE(rkB, rvB, 1);
        if (kt + 3 < NT) ATA_LOAD(rkB, rvB, kt + 3);
        __syncthreads();
        ATA_COMPUTE(1);
        if (kt + 2 < NT) { ATA_STORE(rkA, rvA, 0); if (kt + 4 < NT) ATA_LOAD(rkA, rvA, kt + 4); }
        __syncthreads();
    }
#undef ATA_LOAD
#undef ATA_STORE
#undef ATA_COMPUTE
    float lacc = (la4.x + la4.y) + (la4.z + la4.w);
    lacc += __shfl_xor(lacc, 32);
    if (hi == 0) lq[r32] = lacc;
    asm volatile("s_waitcnt lgkmcnt(0)" ::: "memory");
#pragma unroll
    for (int rr = 0; rr < 16; ++rr) {
        const int q = crow(rr, hi); const float inv = 1.f / lq[q];
        const size_t off = (tokq + q) * 512 + hq * 64 + r32;
        const float g0 = bf2f(GA[off]), g1 = bf2f(GA[off + 32]);
        QA[off] = (bf16_t)(pk2(o0[rr] * inv * g0, 0.f) & 0xffffu);
        QA[off + 32] = (bf16_t)(pk2(o1[rr] * inv * g1, 0.f) & 0xffffu);
    }
}

__device__ void attn_b_item(const Params& p, int item, int l, unsigned char* smem) {
    int tid_ = VTID; asm volatile("" : "+v"(tid_));
    const int tid = tid_, lane = tid & 63, w = tid >> 6, r32 = lane & 31, hi = lane >> 5;
    const int blk = item & 63, j = (item >> 6) & 3, bg = item >> 8, g = bg % 3, b = bg / 3;
    const int sh = 2 * g, dil = 1 << sh, Mlen = SEQ >> sh;
    bf16_t* Ks = (bf16_t*)(smem + AT_KS); unsigned char* Vs = smem + AT_VS; float* lq = (float*)(smem + AT_LQ) + w * 32; float* lut = (float*)(smem + AT_LUT);
    bf16_t* QB = (bf16_t*)(p.ws + WS_QB) + (size_t)bg * SEQ * 256 + j * 64;
    const bf16_t* KB = (const bf16_t*)(p.ws + WS_KB) + (size_t)bg * SEQ * 256 + j * 64;
    const bf16_t* VB = (const bf16_t*)(p.ws + WS_VB) + (size_t)bg * SEQ * 256 + j * 64;
    float* LSE = (float*)(p.ws + WS_LSE) + (size_t)bg * SEQ * 4 + j;
    const int p0r = blk * 128, seq_lo = (p0r / Mlen) * Mlen, seq_hi = seq_lo + Mlen;
    __syncthreads();
    if (tid < 129) {
        const int rel = tid - 64, n = (rel < 0 ? -rel : rel) * dil;
        int bk;
        if (n < 8) bk = n; else { bk = 8 + (n >= 15) + (n >= 27) + (n >= 50) + (n >= 91) + (n >= 166) + (n >= 305) + (n >= 559); }
        if (rel > 0) bk += 16;
        lut[tid] = p.rel_bias[bk * 12 + g * 4 + j] * LOG2E;
    }
    const int qpos = p0r + w * 32 + r32;
    bf16x8 qr[4];
#pragma unroll
    for (int ds = 0; ds < 4; ++ds) qr[ds] = *(const bf16x8*)(QB + (size_t)qpos * 256 + ds * 16 + hi * 8);
    const float nshift = -((const float*)(p.ws + WS_BND))[2 + l];
    f32x16 o0, o1;
#pragma unroll
    for (int i = 0; i < 16; ++i) { o0[i] = 0.f; o1[i] = 0.f; }
    f32x4 la4 = (f32x4){0.f, 0.f, 0.f, 0.f};
    u32x4 rk[2], rv[2];
    for (int kt = 0; kt < 4; ++kt) {
        const int kbase = p0r - 64 + 64 * kt;
#pragma unroll
        for (int i = 0; i < 2; ++i) { const int c = tid + 256 * i, row = c >> 3, ch = c & 7;
            int pr = kbase + row; pr = pr < 0 ? 0 : (pr > SEQ - 1 ? SEQ - 1 : pr);
            rk[i] = *(const u32x4*)(KB + (size_t)pr * 256 + ch * 8); rv[i] = *(const u32x4*)(VB + (size_t)pr * 256 + ch * 8); }
        __syncthreads();
        AT_STAGE_STORE();
        __syncthreads();
        f32x16 p0, p1;
#pragma unroll
        for (int i = 0; i < 16; ++i) { p0[i] = nshift; p1[i] = nshift; }
        at_qk(p0, p1, Ks, qr, r32, hi);
#pragma unroll
        for (int i = 0; i < 16; ++i) {
            const int kv0 = kbase + crow(i, hi), kv1 = kv0 + 32;
            const int rel0 = kv0 - qpos, rel1 = kv1 - qpos;
            const bool ok0 = rel0 >= -64 && rel0 <= 64 && kv0 >= seq_lo && kv0 < seq_hi;
            const bool ok1 = rel1 >= -64 && rel1 <= 64 && kv1 >= seq_lo && kv1 < seq_hi;
            const float e0 = __builtin_amdgcn_exp2f(p0[i] + lut[ok0 ? rel0 + 64 : 64]);
            const float e1 = __builtin_amdgcn_exp2f(p1[i] + lut[ok1 ? rel1 + 64 : 64]);
            p0[i] = ok0 ? e0 : 0.f; p1[i] = ok1 ? e1 : 0.f;
        }
#pragma unroll
        for (int i = 0; i < 4; ++i) { la4 += (f32x4){p0[4 * i], p0[4 * i + 1], p0[4 * i + 2], p0[4 * i + 3]}; la4 += (f32x4){p1[4 * i], p1[4 * i + 1], p1[4 * i + 2], p1[4 * i + 3]}; }
        at_pv(o0, o1, p0, p1, Vs, lane);
    }
    float lacc = (la4.x + la4.y) + (la4.z + la4.w);
    lacc += __shfl_xor(lacc, 32);
    if (hi == 0) { lq[r32] = lacc; LSE[(size_t)qpos * 4] = (-nshift + log2f(lacc)) * LN2; }
    asm volatile("s_waitcnt lgkmcnt(0)" ::: "memory");
#pragma unroll
    for (int rr = 0; rr < 16; ++rr) {
        const int q = crow(rr, hi); const float inv = 1.f / lq[q];
        const size_t off = (size_t)(p0r + w * 32 + q) * 256 + r32;
        QB[off] = (bf16_t)(pk2(o0[rr] * inv, 0.f) & 0xffffu);
        QB[off + 32] = (bf16_t)(pk2(o1[rr] * inv, 0.f) & 0xffffu);
    }
}

__device__ void conv_phase(const Params& p, int l) {
    int tx_ = threadIdx.x; asm volatile("" : "+v"(tx_));
    const bf16_t* XBC = (const bf16_t*)(p.ws + WS_XBC);
    bf16_t* XC = (bf16_t*)(p.ws + WS_XBCC);
    const float* cw = p.conv_w + (size_t)l * 5 * 1024; const float* cb = p.conv_b + l * 1024;
    const int nthr = gridDim.x * 512;
    for (int u = blockIdx.x * 512 + tx_; u < (TP / 4) * 128; u += nthr) {
        const int ch = (u & 127) * 8, tg = u >> 7, tok0 = tg * 4, tt0 = tok0 & (SEQ - 1);
        u32x4 raw[8];
#pragma unroll
        for (int r = 0; r < 8; ++r) { const int tt = tt0 - 2 + r; raw[r] = (u32x4){0u, 0u, 0u, 0u};
            if (tt >= 0 && tt < SEQ) raw[r] = *(const u32x4*)(XBC + (size_t)(tok0 - 2 + r) * 1024 + ch); }
        float ac[4][8];
        { const f32x4 a = *(const f32x4*)(cb + ch), b2 = *(const f32x4*)(cb + ch + 4);
#pragma unroll
          for (int t = 0; t < 4; ++t) { ac[t][0] = a.x; ac[t][1] = a.y; ac[t][2] = a.z; ac[t][3] = a.w; ac[t][4] = b2.x; ac[t][5] = b2.y; ac[t][6] = b2.z; ac[t][7] = b2.w; } }
#pragma unroll
        for (int k = 0; k < 5; ++k) { const f32x4 wa = *(const f32x4*)(cw + k * 1024 + ch), wb = *(const f32x4*)(cw + k * 1024 + ch + 4);
#pragma unroll
            for (int t = 0; t < 4; ++t) { const u32x4 v = raw[t + k];
                ac[t][0] += bflo(v.x) * wa.x; ac[t][1] += bfhi(v.x) * wa.y; ac[t][2] += bflo(v.y) * wa.z; ac[t][3] += bfhi(v.y) * wa.w;
                ac[t][4] += bflo(v.z) * wb.x; ac[t][5] += bfhi(v.z) * wb.y; ac[t][6] += bflo(v.w) * wb.z; ac[t][7] += bfhi(v.w) * wb.w; } }
#pragma unroll
        for (int t = 0; t < 4; ++t) { u32x4 o;
            o.x = pk2(siluf(ac[t][0]), siluf(ac[t][1])); o.y = pk2(siluf(ac[t][2]), siluf(ac[t][3])); o.z = pk2(siluf(ac[t][4]), siluf(ac[t][5])); o.w = pk2(siluf(ac[t][6]), siluf(ac[t][7]));
            *(u32x4*)(XC + (size_t)(tok0 + t) * 1024 + ch) = o; }
    }
}

constexpr int SS_BS = 0, SS_CS = 8704, SS_XS = 17408, SS_XWS = 22016, SS_GS = 26624, SS_SB = 29184, SS_CW = 46592, SS_SC = 54272, SS_DTA = 55296, SS_END = 57344;

template <int PASS>
__device__ void ssd_item(const Params& p, int item, int l, unsigned char* smem) {
    int tid_ = VTID; asm volatile("" : "+v"(tid_));
    const int tid = tid_, lane = tid & 63, w = tid >> 6, idx = lane & 15, kq = lane >> 4;
    const int seg = item & 15, h = (item >> 4) & 7, dir = (item >> 7) & 1, b = item >> 8, grp = h >> 2;
    bf16_t* Bs = (bf16_t*)(smem + SS_BS); bf16_t* Cs = (bf16_t*)(smem + SS_CS); bf16_t* Xs = (bf16_t*)(smem + SS_XS); bf16_t* Xws = (bf16_t*)(smem + SS_XWS);
    bf16_t* Gs = (bf16_t*)(smem + SS_GS); bf16_t* Sb = (bf16_t*)(smem + SS_SB); float* sc = (float*)(smem + SS_SC);
    float* s_dt = sc, *s_c = sc + 32, *s_rs = sc + 64, *s_wl = sc + 96, *s_tot = sc + 128;
    const bf16_t* XBC = (const bf16_t*)(p.ws + WS_XBC);
    const float* DT = (const float*)(p.ws + WS_DT);
    float* ST = (float*)(p.ws + WS_ST); float* SEGT = (float*)(p.ws + WS_SEGT);
    bf16_t* Y = (bf16_t*)(p.ws + (dir ? WS_YS : WS_YF));
    const float Aneg = -__expf(p.a_log[l * 16 + dir * 8 + h]);
    const float Dh = p.d_skip[l * 8 + h];
    __syncthreads();
    f32x4 S[8];
#pragma unroll
    for (int nt = 0; nt < 8; ++nt) S[nt] = (f32x4){0.f, 0.f, 0.f, 0.f};
    const int ibase = item & ~15;
    if (PASS == 3) {
        if (dir == 0) {
            for (int e = 0; e < seg; ++e) { const float dc = __expf(SEGT[ibase + e]); const f32x4* src = (const f32x4*)(ST + (size_t)(ibase + e) * 8192);
#pragma unroll
                for (int nt = 0; nt < 8; ++nt) S[nt] = S[nt] * dc + src[(w * 8 + nt) * 64 + lane]; }
        } else {
            for (int e = NSEG - 1; e > seg; --e) { const float dc = __expf(SEGT[ibase + e]); const f32x4* src = (const f32x4*)(ST + (size_t)(ibase + e) * 8192);
#pragma unroll
                for (int nt = 0; nt < 8; ++nt) S[nt] = S[nt] * dc + src[(w * 8 + nt) * 64 + lane]; }
        }
#pragma unroll
        for (int nt = 0; nt < 8; ++nt) st4bf(Sb + (16 * w + idx) * 136 + 16 * nt + 4 * kq, S[nt]);
    }
    float* s_dta = (float*)(smem + SS_DTA);
    for (int e = tid; e < SEGLEN; e += 256) s_dta[e] = DT[((size_t)b * SEQ + seg * SEGLEN + e) * 16 + dir * 8 + h];
    float segtot = 0.f;
    const size_t tokb = (size_t)b * SEQ;
    const unsigned char* xb_ = (const unsigned char*)((const bf16_t*)(p.ws + WS_XBCC) + tokb * 1024);
    unsigned soff[5];
#pragma unroll
    for (int i = 0; i < 5; ++i) { const int u = tid + 256 * i, lrow = u / 40, ci = u % 40;
        const int scol = ci < 8 ? h * 64 + ci * 8 : (ci < 24 ? 512 + grp * 128 + (ci * 8 - 64) : 768 + grp * 128 + (ci * 8 - 192));
        soff[i] = (unsigned)((lrow * 1024 + scol) * 2); }
    for (int si = 0; si < NSUB; ++si) {
        const int scn = dir ? (NSUB - 1 - si) : si;
        const int t0 = seg * SEGLEN + scn * TSUB;
        __syncthreads();
        u32x4 raw[5];
#pragma unroll
        for (int i = 0; i < 5; ++i) raw[i] = *(const u32x4*)(xb_ + ((unsigned)(t0 * 2048) + soff[i]));
        if (w == 0) {
            float dtv = 0.f, av = 0.f;
            if (lane < 32) { dtv = s_dta[scn * TSUB + lane]; av = dtv * Aneg; }
            float pre = av;
#pragma unroll
            for (int o = 1; o < 32; o <<= 1) { const float t = __shfl_up(pre, o); if (lane >= o) pre += t; }
            const float tot = __shfl(pre, 31);
            const float cc = dir ? (tot - pre + av) : pre;
            if (lane < 32) { s_dt[lane] = dtv; s_c[lane] = cc; s_rs[lane] = __expf(cc); s_wl[lane] = dtv * __expf(tot - cc); }
            if (lane == 0) s_tot[0] = tot;
        }
        __syncthreads();
        segtot += s_tot[0];
#pragma unroll
        for (int i = 0; i < 5; ++i) { const int u = tid + 256 * i, lrow = u / 40, ci = u % 40, lc = ci * 8; const u32x4 o = raw[i];
            if (ci < 8) { *(u32x4*)(Xs + lrow * 72 + lc) = o; const float wl = s_wl[lrow];
                u32x4 o2; o2.x = pk2(bflo(o.x) * wl, bfhi(o.x) * wl); o2.y = pk2(bflo(o.y) * wl, bfhi(o.y) * wl); o2.z = pk2(bflo(o.z) * wl, bfhi(o.z) * wl); o2.w = pk2(bflo(o.w) * wl, bfhi(o.w) * wl);
                *(u32x4*)(Xws + lrow * 72 + lc) = o2; }
            else if (ci < 24) *(u32x4*)(Bs + lrow * 136 + (lc - 64)) = o;
            else *(u32x4*)(Cs + lrow * 136 + (lc - 192)) = o; }
        __syncthreads();
        if (PASS == 3) {
            const int it = w >> 1, jt = w & 1;
            f32x4 cb = (f32x4){0.f, 0.f, 0.f, 0.f};
            {
                bf16x8 fb[4], fc[4];
#pragma unroll
                for (int ks = 0; ks < 4; ++ks) { fb[ks] = *(const bf16x8*)(Bs + (16 * jt + idx) * 136 + ks * 32 + kq * 8); fc[ks] = *(const bf16x8*)(Cs + (16 * it + idx) * 136 + ks * 32 + kq * 8); }
                __builtin_amdgcn_sched_barrier(0);
#pragma unroll
                for (int ks = 0; ks < 4; ++ks) cb = __builtin_amdgcn_mfma_f32_16x16x32_bf16(fb[ks], fc[ks], cb, 0, 0, 0);
                __builtin_amdgcn_sched_barrier(0);
            }
            {
                const int ii = 16 * it + idx; const float ci_ = s_c[ii];
                f32x4 gv;
#pragma unroll
                for (int rg = 0; rg < 4; ++rg) {
                    const int jj = 16 * jt + 4 * kq + rg;
                    const bool ok = dir ? (jj >= ii) : (jj <= ii);
                    const float e = __expf(ci_ - s_c[jj]) * s_dt[jj];
                    gv[rg] = ok ? cb[rg] * e : 0.f;
                }
                st4bf(Gs + ii * 40 + 16 * jt + 4 * kq, gv);
            }
            __syncthreads();
            const unsigned char* xtr = (const unsigned char*)Xs + (8 * kq + (idx >> 2)) * 144 + (16 * w + 4 * (idx & 3)) * 2;
            const bf16x8 xf = cat8(tr16(xtr), tr16(xtr + 4 * 144));
#pragma unroll 1
            for (int it2 = 0; it2 < 2; ++it2) {
                const int ii = 16 * it2 + idx;
                const bf16x8 gf = *(const bf16x8*)(Gs + ii * 40 + 8 * kq);
                f32x4 yd = (f32x4){0.f, 0.f, 0.f, 0.f}, yo = (f32x4){0.f, 0.f, 0.f, 0.f};
                bf16x8 sf[4], cf[4];
#pragma unroll
                for (int ks = 0; ks < 4; ++ks) { sf[ks] = *(const bf16x8*)(Sb + (16 * w + idx) * 136 + ks * 32 + kq * 8); cf[ks] = *(const bf16x8*)(Cs + ii * 136 + ks * 32 + kq * 8); }
                __builtin_amdgcn_sched_barrier(0);
                yd = __builtin_amdgcn_mfma_f32_16x16x32_bf16(xf, gf, yd, 0, 0, 0);
#pragma unroll
                for (int ks = 0; ks < 4; ++ks) yo = __builtin_amdgcn_mfma_f32_16x16x32_bf16(sf[ks], cf[ks], yo, 0, 0, 0);
                __builtin_amdgcn_sched_barrier(0);
                f32x4 y = yd + yo * s_rs[ii];
                if (dir == 0) { const u32x2 xv = *(const u32x2*)(Xs + ii * 72 + 16 * w + 4 * kq);
                    y.x += Dh * bflo(xv.x); y.y += Dh * bfhi(xv.x); y.z += Dh * bflo(xv.y); y.w += Dh * bfhi(xv.y); }
                st4bf(Y + (tokb + t0 + ii) * 512 + h * 64 + 16 * w + 4 * kq, y);
            }
        }
        {
            const float dc = __expf(s_tot[0]);
            const unsigned char* xw = (const unsigned char*)Xws + (8 * kq + (idx >> 2)) * 144 + (16 * w + 4 * (idx & 3)) * 2;
            const bf16x8 xwf = cat8(tr16(xw), tr16(xw + 4 * 144));
            bf16x8 bfv[8];
#pragma unroll
            for (int nt = 0; nt < 8; ++nt) {
                const unsigned char* bt = (const unsigned char*)Bs + (8 * kq + (idx >> 2)) * 272 + (16 * nt + 4 * (idx & 3)) * 2;
                bfv[nt] = cat8(tr16(bt), tr16(bt + 4 * 272));
            }
            __builtin_amdgcn_sched_barrier(0);
#pragma unroll
            for (int nt = 0; nt < 8; ++nt) S[nt] = __builtin_amdgcn_mfma_f32_16x16x32_bf16(bfv[nt], xwf, S[nt] * dc, 0, 0, 0);
            __builtin_amdgcn_sched_barrier(0);
            if (PASS == 3) {
#pragma unroll
                for (int nt = 0; nt < 8; ++nt) st4bf(Sb + (16 * w + idx) * 136 + 16 * nt + 4 * kq, S[nt]);
            }
        }
    }
    if (PASS == 1) {
        f32x4* dst = (f32x4*)(ST + (size_t)item * 8192);
#pragma unroll
        for (int nt = 0; nt < 8; ++nt) dst[(w * 8 + nt) * 64 + lane] = S[nt];
        if (tid == 0) SEGT[item] = segtot;
    }
}

__device__ void post2_phase(const Params& p) {
    int tx_ = threadIdx.x; asm volatile("" : "+v"(tx_));
    const int lane = tx_ & 63, gw = blockIdx.x * 8 + (tx_ >> 6), nw = gridDim.x * 8;
    const bf16_t* OB = (const bf16_t*)(p.ws + WS_QB); const float* LSE = (const float*)(p.ws + WS_LSE);
    const bf16_t* GB = (const bf16_t*)(p.ws + WS_GB);
    bf16_t* YBM = (bf16_t*)(p.ws + WS_YBM);
    const bf16_t* YF = (const bf16_t*)(p.ws + WS_YF); const bf16_t* YS = (const bf16_t*)(p.ws + WS_YS); const bf16_t* ZS = (const bf16_t*)(p.ws + WS_ZS);
    bf16_t* YC = (bf16_t*)(p.ws + WS_YC); float* RS = (float*)(p.ws + WS_RSTD);
    for (int row = gw; row < TP; row += nw) {
        const int bl = row >> 13, tt = row & (SEQ - 1), j = lane >> 4;
        float ls[3]; size_t ro[3];
#pragma unroll
        for (int g = 0; g < 3; ++g) { const int sh = 2 * g; const int pp = (tt & ((1 << sh) - 1)) * (SEQ >> sh) + (tt >> sh);
            ro[g] = (size_t)(bl * 3 + g) * SEQ + pp; ls[g] = LSE[ro[g] * 4 + j]; }
        const float mx = fmaxf(ls[0], fmaxf(ls[1], ls[2]));
        float wg[3]; float ws = 0.f;
#pragma unroll
        for (int g = 0; g < 3; ++g) { wg[g] = __expf(ls[g] - mx); ws += wg[g]; }
        const float inv = 1.f / ws;
        f32x4 acc = (f32x4){0.f, 0.f, 0.f, 0.f};
#pragma unroll
        for (int g = 0; g < 3; ++g) { const u32x2 v = *(const u32x2*)(OB + ro[g] * 256 + 4 * lane); const float wv = wg[g] * inv;
            acc.x += wv * bflo(v.x); acc.y += wv * bfhi(v.x); acc.z += wv * bflo(v.y); acc.w += wv * bfhi(v.y); }
        { const u32x2 gt = *(const u32x2*)(GB + (size_t)row * 256 + 4 * lane);
          acc.x *= bflo(gt.x); acc.y *= bfhi(gt.x); acc.z *= bflo(gt.y); acc.w *= bfhi(gt.y); }
        st4bf(YBM + (size_t)row * 256 + 4 * lane, acc);
        const u32x4 a = *(const u32x4*)(YF + (size_t)row * 512 + 8 * lane), bq = *(const u32x4*)(YS + (size_t)row * 512 + 8 * lane), z = *(const u32x4*)(ZS + (size_t)row * 512 + 8 * lane);
        float y[8];
        y[0] = (bflo(a.x) + bflo(bq.x)) * bflo(z.x); y[1] = (bfhi(a.x) + bfhi(bq.x)) * bfhi(z.x);
        y[2] = (bflo(a.y) + bflo(bq.y)) * bflo(z.y); y[3] = (bfhi(a.y) + bfhi(bq.y)) * bfhi(z.y);
        y[4] = (bflo(a.z) + bflo(bq.z)) * bflo(z.z); y[5] = (bfhi(a.z) + bfhi(bq.z)) * bfhi(z.z);
        y[6] = (bflo(a.w) + bflo(bq.w)) * bflo(z.w); y[7] = (bfhi(a.w) + bfhi(bq.w)) * bfhi(z.w);
        float ss = 0.f;
#pragma unroll
        for (int e = 0; e < 8; ++e) ss += y[e] * y[e];
        ss = wave_sum(ss);
        u32x4 o; o.x = pk2(y[0], y[1]); o.y = pk2(y[2], y[3]); o.z = pk2(y[4], y[5]); o.w = pk2(y[6], y[7]);
        *(u32x4*)(YC + (size_t)row * 512 + 8 * lane) = o;
        if (lane == 0) RS[row] = rsqrtf(ss * (1.f / 512.f) + EPS);
    }
}


#define XB_TMO      128
#define XB_XCNT(j)  (256  + 64 * (j))
#define XB_XSUB(j)  (1280 + 64 * (j))
#define XB_XGEN(j)  (2304 + 64 * (j))
#define XB_TOP      3328
#define XB_TOPGEN   3392
#define XCD_BAR_WORDS 3456
#define XB_SPIN_CAP (1u << 20)
__device__ __forceinline__ unsigned xb_ld(unsigned* p)              { return __hip_atomic_load(p, __ATOMIC_RELAXED, __HIP_MEMORY_SCOPE_AGENT); }
__device__ __forceinline__ unsigned xb_add(unsigned* p, unsigned v) { return __hip_atomic_fetch_add(p, v, __ATOMIC_RELAXED, __HIP_MEMORY_SCOPE_AGENT); }
__device__ __forceinline__ unsigned xb_xcc_id() { return (unsigned)__builtin_amdgcn_s_getreg((3 << 11) | 20) & 0xFu; }
#define XB_SPIN(cond, bar) do { unsigned _sp = 0; while (cond) { __builtin_amdgcn_s_sleep(1); \
    if ((++_sp & 255u) == 0u) { if (xb_ld(&(bar)[XB_TMO])) break; if (_sp > XB_SPIN_CAP) { atomicAdd(&(bar)[XB_TMO], 1u); break; } } } } while (0)
struct XcdBarrier { unsigned* bar; unsigned x; volatile LDSAS unsigned* st; };
__device__ __forceinline__ XcdBarrier xcd_barrier_post(unsigned* bar, volatile LDSAS unsigned* st) {
    XcdBarrier b; b.bar = bar; b.x = xb_xcc_id(); b.st = st;
    if (threadIdx.x == 0) (void)xb_add(&bar[XB_XCNT(b.x)], 1u);
    return b;
}
__device__ __forceinline__ void xcd_barrier_complete(unsigned* bar, unsigned x, unsigned& nloc, unsigned& nx) {
    const unsigned G = gridDim.x * gridDim.y * gridDim.z;
    unsigned sum, cnt, mine, sp = 0u;
    for (;;) {
        sum = 0u; cnt = 0u; mine = 0u;
#pragma unroll
        for (unsigned j = 0; j < 16; ++j) { const unsigned c = xb_ld(&bar[XB_XCNT(j)]); sum += c; cnt += (c > 0u) ? 1u : 0u; mine = (j == x) ? c : mine; }
        if (sum == G) break;
        __builtin_amdgcn_s_sleep(1);
        if ((++sp & 255u) == 0u) { if (xb_ld(&bar[XB_TMO])) break; if (sp > XB_SPIN_CAP) { atomicAdd(&bar[XB_TMO], 1u); break; } }
    }
    nloc = mine > 0u ? mine : 1u; nx = cnt > 0u ? cnt : 1u;
}
__device__ __forceinline__ void xcd_barrier(const XcdBarrier& b) {
    asm volatile("s_waitcnt vmcnt(0)" ::: "memory");
    __syncthreads();
    if (threadIdx.x == 0) {
        unsigned* bar = b.bar;
        __builtin_amdgcn_s_waitcnt(0);
        unsigned nloc = b.st[0], nx = b.st[1];
        if (nloc == 0u) { xcd_barrier_complete(bar, b.x, nloc, nx); b.st[0] = nloc; b.st[1] = nx; }
        const unsigned old = xb_add(&bar[XB_XSUB(b.x)], 1u);
        const unsigned gen = old / nloc;
        if (old + 1u == (gen + 1u) * nloc) {
            __builtin_amdgcn_fence(__ATOMIC_RELEASE, "agent");
            asm volatile("s_waitcnt vmcnt(0)" ::: "memory");
            const unsigned og = xb_add(&bar[XB_TOP], 1u);
            const unsigned tg = og / nx;
            if (og + 1u == (tg + 1u) * nx) xb_add(&bar[XB_TOPGEN], 1u);
            else XB_SPIN(xb_ld(&bar[XB_TOPGEN]) == tg, bar);
            __builtin_amdgcn_fence(__ATOMIC_ACQUIRE, "agent");
            xb_add(&bar[XB_XGEN(b.x)], 1u);
            asm volatile("s_waitcnt vmcnt(0)" ::: "memory");
        } else {
            XB_SPIN(xb_ld(&bar[XB_XGEN(b.x)]) == gen, bar);
            __builtin_amdgcn_fence(__ATOMIC_ACQUIRE, "agent");
            asm volatile("s_waitcnt vmcnt(0)" ::: "memory");
        }
    }
    __syncthreads();
}

__device__ __forceinline__ unsigned char* lds_half(unsigned char* smem) { int h_ = threadIdx.x >> 8; asm volatile("" : "+v"(h_)); return smem + h_ * HALF_LDS; }
__global__ void __launch_bounds__(512, 2) hybrid_fwd(Params p) {
    cg::grid_group grid = cg::this_grid();
    extern __shared__ __attribute__((aligned(16))) unsigned char smem[];
    volatile LDSAS unsigned* bst = (volatile LDSAS unsigned*)(smem + LDS_TOTAL - 16);
    if (threadIdx.x < 4) bst[threadIdx.x] = 0u;
    __syncthreads();
    const XcdBarrier xbar = xcd_barrier_post((unsigned*)(p.ws + WS_BAR), bst);
    { const Params q = launder(p); phase0(q, lds_half(smem)); }
    grid.sync();
#pragma unroll 1
    for (int l = 0; l < DEPTH; ++l) {
#pragma unroll 1
        for (int hb = 0; hb < 2; ++hb) {
            { const Params q = launder(p); norm_phase(q, l, hb, (l == 0) ? q.x : q.out); }
            xcd_barrier(xbar);
            { const Params q = launder(p); gemm1_phase(q, l, hb, smem); }
            xcd_barrier(xbar);
            { const Params q = launder(p); conv_phase(q, l); }
            xcd_barrier(xbar);
            { const Params q = launder(p); unsigned char* smh = lds_half(smem);
#pragma unroll 1
              for (int it = VBLK; it < 512 + 1536; it += VGRID) { if (it < 512) ssd_item<1>(q, it, l, smh); else attn_b_item(q, it - 512, l, smh); } }
            xcd_barrier(xbar);
            { const Params q = launder(p); unsigned char* smh = lds_half(smem);
#pragma unroll 1
              for (int it = VBLK; it < 1024 + 512; it += VGRID) { if (it < 1024) attn_a_item(q, it, l, smh); else ssd_item<3>(q, it - 1024, l, smh); } }
            xcd_barrier(xbar);
            { const Params q = launder(p); post2_phase(q); }
            xcd_barrier(xbar);
            { const Params q = launder(p); merge_phase(q, l, smem); }
            xcd_barrier(xbar);
            { const Params q = launder(p); out_phase(q, l, hb, (l == 0) ? q.x : q.out, smem); }
        }
    }
}

extern "C" void kernel_launch(void* const* d_in, const int* in_sizes, int n_in, void* d_out, int out_size, void* d_ws, size_t ws_size, hipStream_t stream) {
    static int grid_blocks = 0;
    if (!grid_blocks) {
        int dev = 0, cus = 0, per_cu = 0;
        hipGetDevice(&dev);
        hipDeviceGetAttribute(&cus, hipDeviceAttributeMultiprocessorCount, dev);
        hipFuncSetAttribute((const void*)hybrid_fwd, hipFuncAttributeMaxDynamicSharedMemorySize, LDS_TOTAL);
        hipOccupancyMaxActiveBlocksPerMultiprocessor(&per_cu, hybrid_fwd, 512, LDS_TOTAL);
        if (per_cu > 1) per_cu = 1;
        if (per_cu < 1) per_cu = 1;
        grid_blocks = cus * per_cu;
    }
    Params p{};
    const float** pp = (const float**)&p;
    for (int i = 0; i < 22; ++i) pp[i] = (const float*)d_in[i];
    p.out = (float*)d_out; p.ws = (unsigned char*)d_ws;
    hipMemsetAsync((unsigned char*)d_ws + WS_BAR, 0, XCD_BAR_WORDS * 4, stream);
    void* args[] = {&p};
    hipError_t e = hipLaunchCooperativeKernel((void*)hybrid_fwd, dim3(grid_blocks), dim3(512), args, LDS_TOTAL, stream);
    if (e != hipSuccess) fprintf(stderr, "cooperative launch failed: %s (grid %d)\n", hipGetErrorString(e), grid_blocks);
}
```

```cpp
#include <hip/hip_runtime.h>
#include <hip/hip_cooperative_groups.h>
#include <cstdint>
#include <cstdio>
namespace cg = cooperative_groups;

typedef unsigned short bf16_t;
typedef short bf16x8 __attribute__((ext_vector_type(8)));
typedef short v4i16 __attribute__((ext_vector_type(4)));
typedef float f32x2 __attribute__((ext_vector_type(2)));
typedef float f32x4 __attribute__((ext_vector_type(4)));
typedef float f32x16 __attribute__((ext_vector_type(16)));
typedef unsigned u32x2 __attribute__((ext_vector_type(2)));
typedef unsigned u32x4 __attribute__((ext_vector_type(4)));
typedef __bf16 bf16x2_t __attribute__((ext_vector_type(2)));
#define LDSAS __attribute__((address_space(3)))
#define VTID ((int)(threadIdx.x & 255u))
__device__ __forceinline__ int vblk_() { int h_ = threadIdx.x >> 8; asm volatile("" : "+v"(h_)); return __builtin_amdgcn_readfirstlane(2 * (int)blockIdx.x + h_); }
#define VBLK vblk_()
#define VGRID ((int)(2u * gridDim.x))
constexpr int HALF_LDS = 73728, LDS_TOTAL = 147456;

constexpr int SEQ = 8192, DM = 1024, NBATCH = 4, NBH = 2, TP = NBH * SEQ, DEPTH = 2;
constexpr int NP = 8704;
constexpr float EPS = 1e-6f;
constexpr float LOG2E = 1.4426950408889634f, LN2 = 0.6931471805599453f;
constexpr int NSEG = 16, SEGLEN = 512, TSUB = 32, NSUB = SEGLEN / TSUB;

constexpr size_t MiB = 1u << 20;
constexpr size_t WS_WIN = 0;
constexpr size_t WS_WPA = 34 * MiB;
constexpr size_t WS_WPB = 36 * MiB;
constexpr size_t WS_WPC = 37 * MiB;
constexpr size_t WS_WOUT = 39 * MiB;
constexpr size_t WS_MOD = 43 * MiB;
constexpr size_t WS_ROPE = 43 * MiB + 128 * 1024;
constexpr size_t WS_BND = 43 * MiB + 160 * 1024;
constexpr size_t WS_RSTD = 43 * MiB + 256 * 1024;
constexpr size_t WS_SEGT = 43 * MiB + 512 * 1024;
constexpr size_t WS_LSE = 44 * MiB;
constexpr size_t WS_DT = 45 * MiB;
constexpr size_t WS_BAR = 46 * MiB;
constexpr size_t WS_H = 48 * MiB;
constexpr size_t WS_QA = 80 * MiB;
constexpr size_t WS_KA = 96 * MiB;
constexpr size_t WS_VA = 100 * MiB;
constexpr size_t WS_GA = 104 * MiB;
constexpr size_t WS_QB = 120 * MiB;
constexpr size_t WS_KB = 144 * MiB;
constexpr size_t WS_VB = 168 * MiB;
constexpr size_t WS_GB = 192 * MiB;
constexpr size_t WS_XBC = 200 * MiB;
constexpr size_t WS_ZS = 232 * MiB;
constexpr size_t WS_MG = 248 * MiB;
constexpr size_t WS_YF = 344 * MiB;
constexpr size_t WS_YS = 360 * MiB;
constexpr size_t WS_YBM = 376 * MiB;
constexpr size_t WS_YC = 384 * MiB;
constexpr size_t WS_MRG = 400 * MiB;
constexpr size_t WS_ST = 432 * MiB;
constexpr size_t WS_XBCC = 448 * MiB;

struct Params {
    const float *x, *c, *norm_w, *w_ada, *b_ada, *w_in, *b_gate, *q_norm_a, *k_norm_a, *q_norm_b, *k_norm_b, *rel_bias,
        *conv_w, *conv_b, *a_log, *dt_bias, *d_skip, *ssm_norm_w, *w_proj_a, *w_proj_b, *w_proj_c, *w_out;
    float* out;
    unsigned char* ws;
};


#define AS1 __attribute__((address_space(1)))
#define GLOBF(f) do { AS1 const float* g_ = (AS1 const float*)p.f; asm volatile("" : "+s"(g_)); q.f = (const float*)g_; } while (0)
__device__ __forceinline__ Params launder(const Params& p) {
    Params q;
    GLOBF(x); GLOBF(c); GLOBF(norm_w); GLOBF(w_ada); GLOBF(b_ada); GLOBF(w_in); GLOBF(b_gate); GLOBF(q_norm_a); GLOBF(k_norm_a); GLOBF(q_norm_b); GLOBF(k_norm_b); GLOBF(rel_bias);
    GLOBF(conv_w); GLOBF(conv_b); GLOBF(a_log); GLOBF(dt_bias); GLOBF(d_skip); GLOBF(ssm_norm_w); GLOBF(w_proj_a); GLOBF(w_proj_b); GLOBF(w_proj_c); GLOBF(w_out);
    { AS1 float* g_ = (AS1 float*)p.out; asm volatile("" : "+s"(g_)); q.out = (float*)g_; }
    { AS1 unsigned char* g_ = (AS1 unsigned char*)p.ws; asm volatile("" : "+s"(g_)); q.ws = (unsigned char*)g_; }
    return q;
}
__device__ __forceinline__ unsigned pk2(float lo, float hi) { f32x2 v = {lo, hi}; bf16x2_t b = __builtin_convertvector(v, bf16x2_t); return __builtin_bit_cast(unsigned, b); }
__device__ __forceinline__ float bf2f(unsigned short b) { return __uint_as_float(((unsigned)b) << 16); }
__device__ __forceinline__ float bflo(unsigned u) { return __uint_as_float(u << 16); }
__device__ __forceinline__ float bfhi(unsigned u) { return __uint_as_float(u & 0xffff0000u); }
__device__ __forceinline__ float siluf(float v) { return v * __builtin_amdgcn_rcpf(1.f + __builtin_amdgcn_exp2f(-1.4426950408889634f * v)); }
__device__ __forceinline__ float sigmf(float v) { return __builtin_amdgcn_rcpf(1.f + __builtin_amdgcn_exp2f(-1.4426950408889634f * v)); }
__device__ __forceinline__ float wave_sum(float v) {
#pragma unroll
    for (int o = 1; o < 64; o <<= 1) v += __shfl_xor(v, o);
    return v;
}
__device__ __forceinline__ v4i16 tr16(const unsigned char* p) { return __builtin_amdgcn_ds_read_tr16_b64_v4i16((LDSAS v4i16*)p); }
__device__ __forceinline__ bf16x8 cat8(v4i16 a, v4i16 b) { return (bf16x8){a[0], a[1], a[2], a[3], b[0], b[1], b[2], b[3]}; }
__device__ __forceinline__ int crow(int r, int hi) { return (r & 3) + 8 * (r >> 2) + 4 * hi; }

struct P0It { const float* W; bf16_t* Wt; const float* rs; int ldw, K, k0, n0, mode; };
__device__ __forceinline__ void p0_load(const P0It& t, float (&vv)[16]) {
    const int tid = VTID, tx = tid & 63, ty = tid >> 6;
    const int np = t.n0 + tx; int n = np; bool valid = true;
    if (t.mode == 1) {
        if (np < 4352) n = np; else if (np < 4864) n = np + 512; else if (np < 5376) n = np - 512;
        else if (np < 8448) n = np + 16; else if (np < 8464) n = np - 3072; else { valid = false; n = 0; }
    }
#pragma unroll
    for (int i = 0; i < 16; ++i) { const int k = ty + 4 * i; vv[i] = valid ? t.W[(size_t)(t.k0 + k) * t.ldw + n] : 0.f; }
}
__device__ __forceinline__ void p0_finish(const P0It& t, const float (&vv)[16], float* tile) {
    const int tid = VTID, tx = tid & 63, ty = tid >> 6;
#pragma unroll
    for (int i = 0; i < 16; ++i) { const int k = ty + 4 * i; float v = vv[i]; if (t.rs) v *= t.rs[t.k0 + k]; tile[k * 65 + tx] = v; }
    __syncthreads();
    const int r = tid >> 2, kc = (tid & 3) * 16;
    u32x4 o0, o1;
    o0.x = pk2(tile[(kc + 0) * 65 + r], tile[(kc + 1) * 65 + r]); o0.y = pk2(tile[(kc + 2) * 65 + r], tile[(kc + 3) * 65 + r]);
    o0.z = pk2(tile[(kc + 4) * 65 + r], tile[(kc + 5) * 65 + r]); o0.w = pk2(tile[(kc + 6) * 65 + r], tile[(kc + 7) * 65 + r]);
    o1.x = pk2(tile[(kc + 8) * 65 + r], tile[(kc + 9) * 65 + r]); o1.y = pk2(tile[(kc + 10) * 65 + r], tile[(kc + 11) * 65 + r]);
    o1.z = pk2(tile[(kc + 12) * 65 + r], tile[(kc + 13) * 65 + r]); o1.w = pk2(tile[(kc + 14) * 65 + r], tile[(kc + 15) * 65 + r]);
    bf16_t* dst = t.Wt + (size_t)(t.n0 + r) * t.K + t.k0 + kc;
    *(u32x4*)dst = o0; *(u32x4*)(dst + 8) = o1;
    __syncthreads();
}
constexpr int P0_IN = 16 * 136, P0_PA = 8 * 16, P0_PB = 4 * 16, P0_PC = 8 * 16, P0_OUT = 16 * 16, P0_L = P0_IN + P0_PA + P0_PB + P0_PC + P0_OUT;
__device__ __forceinline__ P0It p0_params(const Params& p, int item) {
    P0It t; const int l = item / P0_L; int r = item % P0_L; t.rs = nullptr; t.mode = 0;
    if (r < P0_IN) { t.W = p.w_in + (size_t)l * 1024 * 8464; t.ldw = 8464; t.K = 1024; t.Wt = (bf16_t*)(p.ws + WS_WIN) + (size_t)l * NP * 1024; t.k0 = (r / 136) * 64; t.n0 = (r % 136) * 64; t.mode = 1; return t; }
    r -= P0_IN;
    if (r < P0_PA) { t.W = p.w_proj_a + (size_t)l * 512 * 1024; t.ldw = 1024; t.K = 512; t.Wt = (bf16_t*)(p.ws + WS_WPA) + (size_t)l * 1024 * 512; t.k0 = (r / 16) * 64; t.n0 = (r % 16) * 64; return t; }
    r -= P0_PA;
    if (r < P0_PB) { t.W = p.w_proj_b + (size_t)l * 256 * 1024; t.ldw = 1024; t.K = 256; t.Wt = (bf16_t*)(p.ws + WS_WPB) + (size_t)l * 1024 * 256; t.k0 = (r / 16) * 64; t.n0 = (r % 16) * 64; return t; }
    r -= P0_PB;
    if (r < P0_PC) { t.W = p.w_proj_c + (size_t)l * 512 * 1024; t.ldw = 1024; t.K = 512; t.Wt = (bf16_t*)(p.ws + WS_WPC) + (size_t)l * 1024 * 512; t.k0 = (r / 16) * 64; t.n0 = (r % 16) * 64; t.rs = p.ssm_norm_w + l * 512; return t; }
    r -= P0_PC;
    t.W = p.w_out + (size_t)l * 1024 * 1024; t.ldw = 1024; t.K = 1024; t.Wt = (bf16_t*)(p.ws + WS_WOUT) + (size_t)l * 1024 * 1024; t.k0 = (r / 16) * 64; t.n0 = (r % 16) * 64; return t;
}

__device__ void phase0(const Params& p, unsigned char* smem) {
    const int tid = VTID;
    float* tile = (float*)smem;
    constexpr int I_T = 2 * P0_L, I_MOD = 192, I_ALL = I_T + I_MOD + 1;
    {
        int item = VBLK;
        if (item < I_T) {
            P0It cur = p0_params(p, item); float va[16], vb[16]; p0_load(cur, va);
            for (;;) {
                const int nx = item + VGRID; const bool more = nx < I_T; P0It nxt = cur;
                if (more) { nxt = p0_params(p, nx); p0_load(nxt, vb); }
                p0_finish(cur, va, tile);
                if (!more) break;
                item = nx; cur = nxt;
#pragma unroll
                for (int i = 0; i < 16; ++i) va[i] = vb[i];
            }
        }
    }
    for (int item = VBLK; item < I_ALL; item += VGRID) {
        if (item < I_T) {
            continue;
        } else if (item < I_T + I_MOD) {
            const int it = item - I_T, l = it / 96, col0 = (it % 96) * 32, cl = tid & 31, ks = tid >> 5;
            float a0 = 0.f, a1 = 0.f, a2 = 0.f, a3 = 0.f;
            const float* wp = p.w_ada + ((size_t)l * 1024 + ks * 128) * 3072 + col0 + cl;
#pragma unroll 8
            for (int k = 0; k < 128; ++k) {
                const float wv = wp[(size_t)k * 3072]; const int kk = ks * 128 + k;
                a0 += siluf(p.c[kk]) * wv; a1 += siluf(p.c[1024 + kk]) * wv; a2 += siluf(p.c[2048 + kk]) * wv; a3 += siluf(p.c[3072 + kk]) * wv;
            }
            float* red = (float*)smem;
            red[(ks * 32 + cl) * 4 + 0] = a0; red[(ks * 32 + cl) * 4 + 1] = a1; red[(ks * 32 + cl) * 4 + 2] = a2; red[(ks * 32 + cl) * 4 + 3] = a3;
            __syncthreads();
            if (tid < 128) { const int b = tid >> 5, c2 = tid & 31; float s = 0.f;
#pragma unroll
                for (int k = 0; k < 8; ++k) s += red[(k * 32 + c2) * 4 + b];
                ((float*)(p.ws + WS_MOD))[(l * 4 + b) * 3072 + col0 + c2] = s + p.b_ada[l * 3072 + col0 + c2]; }
            __syncthreads();
        } else {
            float* rc = (float*)(p.ws + WS_ROPE); float* rs = rc + 128 * 16;
            for (int e = tid; e < 2048; e += 256) {
                const int pos = e >> 4, i = e & 15;
                const float freq = powf(10000.0f, -(float)i / 16.0f);
                const float ang = (float)pos * freq;
                const double rev = (double)ang * 0.15915494309189535; const double fr = rev - rint(rev);
                const float a = (float)(fr * 6.283185307179586);
                rc[e] = cosf(a); rs[e] = sinf(a);
            }
            if (tid < 2) {
                const int l = tid; float mqa = 0.f, mka = 0.f, mqb = 0.f, mkb = 0.f, mb = 0.f;
                for (int i = 0; i < 64; ++i) { mqa = fmaxf(mqa, fabsf(p.q_norm_a[l * 64 + i])); mka = fmaxf(mka, fabsf(p.k_norm_a[l * 64 + i]));
                    mqb = fmaxf(mqb, fabsf(p.q_norm_b[l * 64 + i])); mkb = fmaxf(mkb, fabsf(p.k_norm_b[l * 64 + i])); }
                for (int i = 0; i < 32 * 12; ++i) mb = fmaxf(mb, p.rel_bias[i]);
                float* bd = (float*)(p.ws + WS_BND);
                bd[l] = 8.f * mqa * mka * LOG2E; bd[2 + l] = (8.f * mqb * mkb + mb) * LOG2E;
            }
        }
    }
}

__device__ void norm_phase(const Params& p, int l, int hb, const float* xsrc) {
    int tx_ = threadIdx.x; asm volatile("" : "+v"(tx_));
    const int lane = tx_ & 63, gw = blockIdx.x * 8 + (tx_ >> 6), nw = gridDim.x * 8;
    bf16_t* H = (bf16_t*)(p.ws + WS_H);
    const float* nwp = p.norm_w + l * 1024;
    for (int row = gw; row < TP; row += nw) {
        const size_t rg = (size_t)hb * TP + row; const int b = (int)(rg / SEQ);
        const f32x4* xr = (const f32x4*)(xsrc + rg * 1024);
        const float* md = (const float*)(p.ws + WS_MOD) + (size_t)(l * 4 + b) * 3072;
        f32x4 v[4]; float ss = 0.f;
#pragma unroll
        for (int j = 0; j < 4; ++j) { v[j] = xr[lane + 64 * j]; ss += v[j].x * v[j].x + v[j].y * v[j].y + v[j].z * v[j].z + v[j].w * v[j].w; }
        ss = wave_sum(ss); const float rstd = rsqrtf(ss * (1.f / 1024.f) + EPS);
#pragma unroll
        for (int j = 0; j < 4; ++j) {
            const int col = 4 * (lane + 64 * j);
            const f32x4 w4 = *(const f32x4*)(nwp + col), sh = *(const f32x4*)(md + col), sc = *(const f32x4*)(md + 1024 + col);
            const f32x4 o = v[j] * rstd * w4 * (1.f + sc) + sh;
            u32x2 pk; pk.x = pk2(o.x, o.y); pk.y = pk2(o.z, o.w);
            *(u32x2*)(H + (size_t)row * 1024 + col) = pk;
        }
    }
}

constexpr int G_STAGE = 65536, G_AB = 32768;
__device__ __forceinline__ void gemm_core(const bf16_t* __restrict__ A, int lda, const bf16_t* __restrict__ Bt, int ldb, int K, f32x4 (&acc)[8][4], unsigned char* smem, int tid) {
    asm volatile("" : "+v"(tid));
    const int lane = tid & 63, w = __builtin_amdgcn_readfirstlane(tid >> 6), wm = w >> 2, wn = w & 3, idx = lane & 15, kq = lane >> 4;
    unsigned offA[4], offB[4];
#pragma unroll
    for (int j = 0; j < 4; ++j) { const int row = (j * 8 + w) * 8 + (lane >> 3), c = (lane & 7) ^ ((row >> 1) & 7);
        offA[j] = (unsigned)(row * lda + c * 8) * 2u; offB[j] = (unsigned)(row * ldb + c * 8) * 2u; }
#pragma unroll
    for (int mi = 0; mi < 8; ++mi)
#pragma unroll
        for (int ni = 0; ni < 4; ++ni) acc[mi][ni] = (f32x4){0.f, 0.f, 0.f, 0.f};
    LDSAS unsigned char* lds = (LDSAS unsigned char*)smem;
#define G_ISSUE1(kt, st, j) do { \
        __builtin_amdgcn_global_load_lds((const unsigned*)((const char*)A + offA[j] + (kt) * 128), (LDSAS unsigned*)(lds + (st) * G_STAGE + ((j) * 8 + w) * 1024), 16, 0, 0); \
        __builtin_amdgcn_global_load_lds((const unsigned*)((const char*)Bt + offB[j] + (kt) * 128), (LDSAS unsigned*)(lds + (st) * G_STAGE + G_AB + ((j) * 8 + w) * 1024), 16, 0, 0); } while (0)
#define G_ISSUE(kt, st) do { G_ISSUE1(kt, st, 0); G_ISSUE1(kt, st, 1); G_ISSUE1(kt, st, 2); G_ISSUE1(kt, st, 3); } while (0)
    const int nk = K >> 6;
    G_ISSUE(0, 0);
    asm volatile("s_waitcnt vmcnt(0)" ::: "memory");
    __syncthreads();
    const int swz = (idx >> 1) & 7;
    const int aoff = (wm * 128 + idx) * 128, boff = G_AB + (wn * 64 + idx) * 128;
    for (int kt = 0; kt < nk; ++kt) {
        const int st = kt & 1;
        const bool more = kt + 1 < nk;
        const unsigned char* sb = smem + st * G_STAGE;
#pragma unroll
        for (int ks = 0; ks < 2; ++ks) {
            bf16x8 bfr[4], af[8];
            const int co = ((ks * 4 + kq) ^ swz) * 16;
#pragma unroll
            for (int ni = 0; ni < 4; ++ni) bfr[ni] = *(const bf16x8*)(sb + boff + ni * 2048 + co);
#pragma unroll
            for (int mi = 0; mi < 8; ++mi) af[mi] = *(const bf16x8*)(sb + aoff + mi * 2048 + co);
            if (more) { G_ISSUE1(kt + 1, st ^ 1, ks * 2); G_ISSUE1(kt + 1, st ^ 1, ks * 2 + 1); }
            __builtin_amdgcn_sched_barrier(0);
            __builtin_amdgcn_s_setprio(1);
#pragma unroll
            for (int mi = 0; mi < 8; ++mi)
#pragma unroll
                for (int ni = 0; ni < 4; ++ni) acc[mi][ni] = __builtin_amdgcn_mfma_f32_16x16x32_bf16(bfr[ni], af[mi], acc[mi][ni], 0, 0, 0);
            __builtin_amdgcn_s_setprio(0);
            __builtin_amdgcn_sched_barrier(0);
        }
        asm volatile("s_waitcnt vmcnt(0)" ::: "memory");
        __syncthreads();
    }
#undef G_ISSUE1
#undef G_ISSUE
}

__device__ __forceinline__ void st4bf(bf16_t* dst, f32x4 v) { u32x2 pk; pk.x = pk2(v.x, v.y); pk.y = pk2(v.z, v.w); *(u32x2*)dst = pk; }

__device__ void gemm1_phase(const Params& p, int l, int hb, unsigned char* smem) {
    const bf16_t* H = (const bf16_t*)(p.ws + WS_H);
    const bf16_t* Wt = (const bf16_t*)(p.ws + WS_WIN) + (size_t)l * NP * 1024;
    const float* ropec = (const float*)(p.ws + WS_ROPE); const float* ropes = ropec + 2048;
    constexpr int NT = 34, NTILES = 64 * NT, GRP = 8 * NT;
    for (int t = blockIdx.x; t < NTILES; t += gridDim.x) {
        const int grp = t / GRP, r = t % GRP, jx = NT * (r & 7) + (r >> 3), mt = grp * 8 + (jx & 7), nt = jx >> 3;
        const int m0 = mt * 256, n0 = nt * 256;
        f32x4 acc[8][4];
        int tid = threadIdx.x;
        gemm_core(H + (size_t)m0 * 1024, 1024, Wt + (size_t)n0 * 1024, 1024, 1024, acc, smem, tid);
        asm volatile("" : "+v"(tid));
        const int lane = tid & 63, w = __builtin_amdgcn_readfirstlane(tid >> 6), wm = w >> 2, wn = w & 3, idx = lane & 15, kq = lane >> 4;
        const int cw = n0 + wn * 64;
        const int lc = 4 * kq;
        unsigned char* wl = smem + w * 16384;
#define G1_STG(mi_, ni_, v_) do { const int r_ = (mi_) * 16 + idx; const f32x4 t_ = (v_); u32x2 pk_; pk_.x = pk2(t_.x, t_.y); pk_.y = pk2(t_.z, t_.w); \
        *(u32x2*)(wl + r_ * 128 + ((((ni_) * 2 + (kq >> 1)) ^ (r_ & 7)) * 16) + (kq & 1) * 8) = pk_; } while (0)
        bf16_t* dbase = nullptr; int dpitch = 0, dc0 = 0, dsh = -1, dg = 0;
        if (cw < 768 && (cw < 640)) {
            const bool isq = cw < 512;
            const float* nwp = (isq ? p.q_norm_a : p.k_norm_a) + l * 64;
            dbase = isq ? (bf16_t*)(p.ws + WS_QA) : (bf16_t*)(p.ws + WS_KA);
            dpitch = isq ? 512 : 128; dc0 = isq ? cw : cw - 512;
            const float qs = isq ? 0.125f * LOG2E : 1.f;
#pragma unroll
            for (int mi = 0; mi < 8; ++mi) {
                const int row = m0 + wm * 128 + mi * 16 + idx;
                float ss = 0.f;
#pragma unroll
                for (int ni = 0; ni < 4; ++ni) { const f32x4 v = acc[mi][ni]; ss += v.x * v.x + v.y * v.y + v.z * v.z + v.w * v.w; }
                ss += __shfl_xor(ss, 16); ss += __shfl_xor(ss, 32);
                const float rstd = rsqrtf(ss * (1.f / 64.f) + EPS);
                f32x4 y[4];
#pragma unroll
                for (int ni = 0; ni < 4; ++ni) y[ni] = acc[mi][ni] * rstd * *(const f32x4*)(nwp + ni * 16 + lc);
                const int tt = row & (SEQ - 1), prow = tt >> 6, pcol = tt & 63;
#pragma unroll
                for (int hf = 0; hf < 2; ++hf) {
                    const int pos = hf ? pcol : prow;
                    const f32x4 cs = *(const f32x4*)(ropec + pos * 16 + lc), sn = *(const f32x4*)(ropes + pos * 16 + lc);
                    const f32x4 a = y[2 * hf], b = y[2 * hf + 1];
                    y[2 * hf] = a * cs - b * sn; y[2 * hf + 1] = b * cs + a * sn;
                }
#pragma unroll
                for (int ni = 0; ni < 4; ++ni) G1_STG(mi, ni, y[ni] * qs);
            }
        } else if (cw >= 1280 && cw < 2816) {
            const bool isq = cw < 2048;
            const float* nwp = (isq ? p.q_norm_b : p.k_norm_b) + l * 64;
            const int gc = isq ? cw - 1280 : cw - 2048;
            dg = gc >> 8; dc0 = gc & 255; dsh = 2 * dg; dpitch = 256;
            dbase = (bf16_t*)(p.ws + (isq ? WS_QB : WS_KB));
            const float qs = isq ? 0.125f * LOG2E : 1.f;
#pragma unroll
            for (int mi = 0; mi < 8; ++mi) {
                float ss = 0.f;
#pragma unroll
                for (int ni = 0; ni < 4; ++ni) { const f32x4 v = acc[mi][ni]; ss += v.x * v.x + v.y * v.y + v.z * v.z + v.w * v.w; }
                ss += __shfl_xor(ss, 16); ss += __shfl_xor(ss, 32);
                const float rstd = rsqrtf(ss * (1.f / 64.f) + EPS) * qs;
#pragma unroll
                for (int ni = 0; ni < 4; ++ni) G1_STG(mi, ni, acc[mi][ni] * rstd * *(const f32x4*)(nwp + ni * 16 + lc));
            }
        } else if (cw >= 2816 && cw < 3584) {
            const int gc = cw - 2816;
            dg = gc >> 8; dc0 = gc & 255; dsh = 2 * dg; dpitch = 256; dbase = (bf16_t*)(p.ws + WS_VB);
#pragma unroll
            for (int mi = 0; mi < 8; ++mi)
#pragma unroll
                for (int ni = 0; ni < 4; ++ni) G1_STG(mi, ni, acc[mi][ni]);
        } else if (cw >= 8448) {
            if (cw == 8448) {
                float* dst = (float*)(p.ws + WS_DT);
                const f32x4 bias = *(const f32x4*)(p.dt_bias + l * 16 + lc);
#pragma unroll
                for (int mi = 0; mi < 8; ++mi) {
                    const int row = m0 + wm * 128 + mi * 16 + idx;
                    f32x4 v = acc[mi][0] + bias, o;
                    o.x = v.x > 20.f ? v.x : log1pf(__expf(v.x)); o.y = v.y > 20.f ? v.y : log1pf(__expf(v.y));
                    o.z = v.z > 20.f ? v.z : log1pf(__expf(v.z)); o.w = v.w > 20.f ? v.w : log1pf(__expf(v.w));
                    *(f32x4*)(dst + (size_t)row * 16 + lc) = o;
                }
            }
        } else {
            int mode;
            if (cw < 768) { dbase = (bf16_t*)(p.ws + WS_VA); dpitch = 128; dc0 = cw - 640; mode = 0; }
            else if (cw < 1280) { dbase = (bf16_t*)(p.ws + WS_GA); dpitch = 512; dc0 = cw - 768; mode = 1; }
            else if (cw < 3840) { dbase = (bf16_t*)(p.ws + WS_GB); dpitch = 256; dc0 = cw - 3584; mode = 1; }
            else if (cw < 4864) { dbase = (bf16_t*)(p.ws + WS_XBC); dpitch = 1024; dc0 = cw - 3840; mode = 0; }
            else if (cw < 5376) { dbase = (bf16_t*)(p.ws + WS_ZS); dpitch = 512; dc0 = cw - 4864; mode = 1; }
            else { dbase = (bf16_t*)(p.ws + WS_MG); dpitch = 3072; dc0 = cw - 5376; mode = 2; }
            const float* bg = p.b_gate + l * 3072 + dc0 + lc;
#pragma unroll
            for (int mi = 0; mi < 8; ++mi) {
#pragma unroll
                for (int ni = 0; ni < 4; ++ni) {
                    f32x4 v = acc[mi][ni];
                    if (mode == 1) { v.x = siluf(v.x); v.y = siluf(v.y); v.z = siluf(v.z); v.w = siluf(v.w); }
                    else if (mode == 2) { const f32x4 bb = *(const f32x4*)(bg + ni * 16); v.x = sigmf(v.x + bb.x); v.y = sigmf(v.y + bb.y); v.z = sigmf(v.z + bb.z); v.w = sigmf(v.w + bb.w); }
                    G1_STG(mi, ni, v);
                }
            }
        }
#undef G1_STG
        if (dbase) {
            const int ch = lane & 7;
#pragma unroll
            for (int j = 0; j < 16; ++j) {
                const int rl = 8 * j + (lane >> 3), row = m0 + wm * 128 + rl;
                const u32x4 v = *(const u32x4*)(wl + rl * 128 + ((ch ^ (rl & 7)) * 16));
                size_t drow = (size_t)row;
                if (dsh >= 0) { const int bl = row >> 13, tt = row & (SEQ - 1); drow = (size_t)(bl * 3 + dg) * SEQ + (size_t)((tt & ((1 << dsh) - 1)) * (SEQ >> dsh) + (tt >> dsh)); }
                *(u32x4*)(dbase + drow * dpitch + dc0 + ch * 8) = v;
            }
        }
        __syncthreads();
    }
}

__device__ void merge_phase(const Params& p, int l, unsigned char* smem) {
    const bf16_t* MG = (const bf16_t*)(p.ws + WS_MG);
    const float* rstd = (const float*)(p.ws + WS_RSTD);
    bf16_t* MR = (bf16_t*)(p.ws + WS_MRG);
    for (int t = blockIdx.x; t < 64 * 4; t += gridDim.x) {
        const int xq = t >> 3, mt = (xq >> 2) * 8 + (t & 7), nt = xq & 3, m0 = mt * 256, n0 = nt * 256;
#pragma unroll 1
        for (int br = 0; br < 3; ++br) {
            f32x4 acc[8][4];
            const bf16_t* A; const bf16_t* Bt; int K;
            if (br == 0) { A = (const bf16_t*)(p.ws + WS_QA); K = 512; Bt = (const bf16_t*)(p.ws + WS_WPA) + (size_t)l * 1024 * 512; }
            else if (br == 1) { A = (const bf16_t*)(p.ws + WS_YBM); K = 256; Bt = (const bf16_t*)(p.ws + WS_WPB) + (size_t)l * 1024 * 256; }
            else { A = (const bf16_t*)(p.ws + WS_YC); K = 512; Bt = (const bf16_t*)(p.ws + WS_WPC) + (size_t)l * 1024 * 512; }
            int tid = threadIdx.x;
            gemm_core(A + (size_t)m0 * K, K, Bt + (size_t)n0 * K, K, K, acc, smem, tid);
            asm volatile("" : "+v"(tid));
            const int lane = tid & 63, w = tid >> 6, wm = w >> 2, wn = w & 3, idx = lane & 15, kq = lane >> 4;
#pragma unroll
            for (int mi = 0; mi < 8; ++mi) {
                const int row = m0 + wm * 128 + mi * 16 + idx;
                const float rs = (br == 2) ? rstd[row] : 1.f;
#pragma unroll
                for (int ni = 0; ni < 4; ++ni) {
                    const int col = n0 + wn * 64 + ni * 16 + 4 * kq;
                    const u32x2 g = *(const u32x2*)(MG + (size_t)row * 3072 + br * 1024 + col);
                    f32x4 gv; gv.x = bflo(g.x); gv.y = bfhi(g.x); gv.z = bflo(g.y); gv.w = bfhi(g.y);
                    f32x4 v = gv * rs * acc[mi][ni];
                    bf16_t* mp = MR + (size_t)row * 1024 + col;
                    if (br > 0) { const u32x2 o = *(const u32x2*)mp; v.x += bflo(o.x); v.y += bfhi(o.x); v.z += bflo(o.y); v.w += bfhi(o.y); }
                    st4bf(mp, v);
                }
            }
        }
    }
}

__device__ void out_phase(const Params& p, int l, int hb, const float* xsrc, unsigned char* smem) {
    const bf16_t* MR = (const bf16_t*)(p.ws + WS_MRG);
    const bf16_t* Wt = (const bf16_t*)(p.ws + WS_WOUT) + (size_t)l * 1024 * 1024;
    for (int t = blockIdx.x; t < 64 * 4; t += gridDim.x) {
        const int xq = t >> 3, mt = (xq >> 2) * 8 + (t & 7), nt = xq & 3, m0 = mt * 256, n0 = nt * 256;
        f32x4 acc[8][4];
        int tid = threadIdx.x;
        gemm_core(MR + (size_t)m0 * 1024, 1024, Wt + (size_t)n0 * 1024, 1024, 1024, acc, smem, tid);
        asm volatile("" : "+v"(tid));
        const int lane = tid & 63, w = tid >> 6, wm = w >> 2, wn = w & 3, idx = lane & 15, kq = lane >> 4;
#pragma unroll
        for (int mi = 0; mi < 8; ++mi) {
            const int row = m0 + wm * 128 + mi * 16 + idx; const size_t rg = (size_t)hb * TP + row; const int b = (int)(rg / SEQ);
            const float* gate = (const float*)(p.ws + WS_MOD) + (size_t)(l * 4 + b) * 3072 + 2048;
#pragma unroll
            for (int ni = 0; ni < 4; ++ni) {
                const int col = n0 + wn * 64 + ni * 16 + 4 * kq;
                const f32x4 xv = *(const f32x4*)(xsrc + rg * 1024 + col), gv = *(const f32x4*)(gate + col);
                *(f32x4*)(p.out + rg * 1024 + col) = xv + gv * acc[mi][ni];
            }
        }
    }
}

constexpr int AT_KS = 0, AT_VS = 9216, AT_LQ = 9216 + 8192, AT_LUT = AT_LQ + 512;

#define AT_STAGE_STORE() do { _Pragma("unroll") for (int i = 0; i < 2; ++i) { const int c = tid + 256 * i, row = c >> 3, ch = c & 7; \
        *(u32x4*)(Ks + row * 72 + ch * 8) = rk[i]; *(u32x4*)(Vs + (ch >> 2) * 4096 + row * 64 + (ch & 3) * 16) = rv[i]; } } while (0)

__device__ __forceinline__ void at_qk(f32x16& p0, f32x16& p1, const bf16_t* Ks, const bf16x8* qr, int r32, int hi) {
    bf16x8 kf[8];
#pragma unroll
    for (int ds = 0; ds < 4; ++ds) {
        kf[2 * ds] = *(const bf16x8*)(Ks + r32 * 72 + ds * 16 + hi * 8);
        kf[2 * ds + 1] = *(const bf16x8*)(Ks + (r32 + 32) * 72 + ds * 16 + hi * 8);
    }
    __builtin_amdgcn_sched_barrier(0);
    __builtin_amdgcn_s_setprio(1);
#pragma unroll
    for (int ds = 0; ds < 4; ++ds) {
        p0 = __builtin_amdgcn_mfma_f32_32x32x16_bf16(kf[2 * ds], qr[ds], p0, 0, 0, 0);
        p1 = __builtin_amdgcn_mfma_f32_32x32x16_bf16(kf[2 * ds + 1], qr[ds], p1, 0, 0, 0);
    }
    __builtin_amdgcn_s_setprio(0);
    __builtin_amdgcn_sched_barrier(0);
}
__device__ __forceinline__ void at_pv(f32x16& o0, f32x16& o1, const f32x16& p0, const f32x16& p1, const unsigned char* Vs, int lane) {
    const int hi = lane >> 5;
    const unsigned char* vb = Vs + ((lane >> 4) & 1) * 32 + (lane & 3) * 8 + (4 * hi + ((lane & 15) >> 2)) * 64;
    bf16x8 v0[4], v1[4], pa[4];
#pragma unroll
    for (int s = 0; s < 4; ++s) {
        v0[s] = cat8(tr16(vb + s * 1024), tr16(vb + s * 1024 + 512));
        v1[s] = cat8(tr16(vb + 4096 + s * 1024), tr16(vb + 4096 + s * 1024 + 512));
    }
#pragma unroll
    for (int s = 0; s < 4; ++s) {
        u32x4 pw;
        if (s < 2) { pw.x = pk2(p0[8 * s + 0], p0[8 * s + 1]); pw.y = pk2(p0[8 * s + 2], p0[8 * s + 3]); pw.z = pk2(p0[8 * s + 4], p0[8 * s + 5]); pw.w = pk2(p0[8 * s + 6], p0[8 * s + 7]); }
        else { const int q = s - 2; pw.x = pk2(p1[8 * q + 0], p1[8 * q + 1]); pw.y = pk2(p1[8 * q + 2], p1[8 * q + 3]); pw.z = pk2(p1[8 * q + 4], p1[8 * q + 5]); pw.w = pk2(p1[8 * q + 6], p1[8 * q + 7]); }
        pa[s] = __builtin_bit_cast(bf16x8, pw);
    }
    __builtin_amdgcn_sched_barrier(0);
    __builtin_amdgcn_s_setprio(1);
#pragma unroll
    for (int s = 0; s < 4; ++s) {
        o0 = __builtin_amdgcn_mfma_f32_32x32x16_bf16(pa[s], v0[s], o0, 0, 0, 0);
        o1 = __builtin_amdgcn_mfma_f32_32x32x16_bf16(pa[s], v1[s], o1, 0, 0, 0);
    }
    __builtin_amdgcn_s_setprio(0);
    __builtin_amdgcn_sched_barrier(0);
}

__device__ __forceinline__ void at_ldv(bf16x8 (&v0)[4], bf16x8 (&v1)[4], const unsigned char* Vs, int lane) {
    const int hi = lane >> 5;
    const unsigned char* vb = Vs + ((lane >> 4) & 1) * 32 + (lane & 3) * 8 + (4 * hi + ((lane & 15) >> 2)) * 64;
#pragma unroll
    for (int s = 0; s < 4; ++s) {
        v0[s] = cat8(tr16(vb + s * 1024), tr16(vb + s * 1024 + 512));
        v1[s] = cat8(tr16(vb + 4096 + s * 1024), tr16(vb + 4096 + s * 1024 + 512));
    }
}
__device__ __forceinline__ void at_pv2(f32x16& o0, f32x16& o1, const f32x16& p0, const f32x16& p1, const bf16x8 (&v0)[4], const bf16x8 (&v1)[4]) {
    bf16x8 pa[4];
#pragma unroll
    for (int s = 0; s < 4; ++s) {
        u32x4 pw;
        if (s < 2) { pw.x = pk2(p0[8 * s + 0], p0[8 * s + 1]); pw.y = pk2(p0[8 * s + 2], p0[8 * s + 3]); pw.z = pk2(p0[8 * s + 4], p0[8 * s + 5]); pw.w = pk2(p0[8 * s + 6], p0[8 * s + 7]); }
        else { const int q = s - 2; pw.x = pk2(p1[8 * q + 0], p1[8 * q + 1]); pw.y = pk2(p1[8 * q + 2], p1[8 * q + 3]); pw.z = pk2(p1[8 * q + 4], p1[8 * q + 5]); pw.w = pk2(p1[8 * q + 6], p1[8 * q + 7]); }
        pa[s] = __builtin_bit_cast(bf16x8, pw);
    }
    __builtin_amdgcn_sched_barrier(0);
    __builtin_amdgcn_s_setprio(1);
#pragma unroll
    for (int s = 0; s < 4; ++s) {
        o0 = __builtin_amdgcn_mfma_f32_32x32x16_bf16(pa[s], v0[s], o0, 0, 0, 0);
        o1 = __builtin_amdgcn_mfma_f32_32x32x16_bf16(pa[s], v1[s], o1, 0, 0, 0);
    }
    __builtin_amdgcn_s_setprio(0);
    __builtin_amdgcn_sched_barrier(0);
}

constexpr int ATA_STAGE = 17408, ATA_LQ = 2 * ATA_STAGE;
__device__ void attn_a_item(const Params& p, int item, int l, unsigned char* smem) {
    int tid_ = VTID; asm volatile("" : "+v"(tid_));
    const int tid = tid_, lane = tid & 63, w = tid >> 6, r32 = lane & 31, hi = lane >> 5;
    const int b = item >> 9, r = item & 511, kvh = r >> 8, qblk = (r >> 2) & 63, hq = kvh * 4 + (r & 3);
    float* lq = (float*)(smem + ATA_LQ) + w * 32;
    bf16_t* QA = (bf16_t*)(p.ws + WS_QA);
    const bf16_t* GA = (const bf16_t*)(p.ws + WS_GA);
    const size_t tokq = (size_t)b * SEQ + qblk * 128 + w * 32;
    bf16x8 qr[4];
#pragma unroll
    for (int ds = 0; ds < 4; ++ds) qr[ds] = *(const bf16x8*)(QA + (tokq + r32) * 512 + hq * 64 + ds * 16 + hi * 8);
    const bf16_t* Kb = (const bf16_t*)(p.ws + WS_KA) + (size_t)b * SEQ * 128 + kvh * 64;
    const bf16_t* Vb = (const bf16_t*)(p.ws + WS_VA) + (size_t)b * SEQ * 128 + kvh * 64;
    const float nshift = -((const float*)(p.ws + WS_BND))[l];
    f32x16 o0, o1;
#pragma unroll
    for (int i = 0; i < 16; ++i) { o0[i] = 0.f; o1[i] = 0.f; }
    f32x4 la4 = (f32x4){0.f, 0.f, 0.f, 0.f};
    constexpr int NT = SEQ / 64;
    const int row0 = tid >> 3, ch0 = tid & 7;
    const size_t goff0 = (size_t)row0 * 128 + ch0 * 8, goff1 = goff0 + (size_t)32 * 128;
    const int ko0 = row0 * 144 + ch0 * 16, ko1 = ko0 + 32 * 144;
    const int vo0 = 9216 + (ch0 >> 2) * 4096 + row0 * 64 + (ch0 & 3) * 16, vo1 = vo0 + 32 * 64;
    u32x4 rkA[2], rvA[2], rkB[2], rvB[2];
#define ATA_LOAD(RK, RV, t) do { const size_t tb = (size_t)(t) * 64 * 128; RK[0] = *(const u32x4*)(Kb + tb + goff0); RK[1] = *(const u32x4*)(Kb + tb + goff1); \
        RV[0] = *(const u32x4*)(Vb + tb + goff0); RV[1] = *(const u32x4*)(Vb + tb + goff1); } while (0)
#define ATA_STORE(RK, RV, st) do { unsigned char* sb_ = smem + (st) * ATA_STAGE; *(u32x4*)(sb_ + ko0) = RK[0]; *(u32x4*)(sb_ + ko1) = RK[1]; \
        *(u32x4*)(sb_ + vo0) = RV[0]; *(u32x4*)(sb_ + vo1) = RV[1]; } while (0)
#define ATA_COMPUTE(st) do { const unsigned char* sb_ = smem + (st) * ATA_STAGE; f32x16 p0, p1; bf16x8 vf0[4], vf1[4]; \
        _Pragma("unroll") for (int i = 0; i < 16; ++i) { p0[i] = nshift; p1[i] = nshift; } \
        at_qk(p0, p1, (const bf16_t*)sb_, qr, r32, hi); \
        at_ldv(vf0, vf1, sb_ + 9216, lane); __builtin_amdgcn_sched_barrier(0); \
        _Pragma("unroll") for (int i = 0; i < 16; ++i) { p0[i] = __builtin_amdgcn_exp2f(p0[i]); p1[i] = __builtin_amdgcn_exp2f(p1[i]); } \
        _Pragma("unroll") for (int i = 0; i < 4; ++i) { la4 += (f32x4){p0[4 * i], p0[4 * i + 1], p0[4 * i + 2], p0[4 * i + 3]}; la4 += (f32x4){p1[4 * i], p1[4 * i + 1], p1[4 * i + 2], p1[4 * i + 3]}; } \
        at_pv2(o0, o1, p0, p1, vf0, vf1); } while (0)
    __syncthreads();
    ATA_LOAD(rkA, rvA, 0); ATA_LOAD(rkB, rvB, 1);
    ATA_STORE(rkA, rvA, 0);
    ATA_LOAD(rkA, rvA, 2);
    __syncthreads();
    for (int kt = 0; kt < NT; kt += 2) {
        ATA_COMPUTE(0);
        ATA_STORE(rkB, rvB, 1);
        if (kt + 3 < NT) ATA_LOAD(rkB, rvB, kt + 3);
        __syncthreads();
        ATA_COMPUTE(1);
        if (kt + 2 < NT) { ATA_STORE(rkA, rvA, 0); if (kt + 4 < NT) ATA_LOAD(rkA, rvA, kt + 4); }
        __syncthreads();
    }
#undef ATA_LOAD
#undef ATA_STORE
#undef ATA_COMPUTE
    float lacc = (la4.x + la4.y) + (la4.z + la4.w);
    lacc += __shfl_xor(lacc, 32);
    if (hi == 0) lq[r32] = lacc;
    asm volatile("s_waitcnt lgkmcnt(0)" ::: "memory");
#pragma unroll
    for (int rr = 0; rr < 16; ++rr) {
        const int q = crow(rr, hi); const float inv = 1.f / lq[q];
        const size_t off = (tokq + q) * 512 + hq * 64 + r32;
        const float g0 = bf2f(GA[off]), g1 = bf2f(GA[off + 32]);
        QA[off] = (bf16_t)(pk2(o0[rr] * inv * g0, 0.f) & 0xffffu);
        QA[off + 32] = (bf16_t)(pk2(o1[rr] * inv * g1, 0.f) & 0xffffu);
    }
}

__device__ void attn_b_item(const Params& p, int item, int l, unsigned char* smem) {
    int tid_ = VTID; asm volatile("" : "+v"(tid_));
    const int tid = tid_, lane = tid & 63, w = tid >> 6, r32 = lane & 31, hi = lane >> 5;
    const int blk = item & 63, j = (item >> 6) & 3, bg = item >> 8, g = bg % 3, b = bg / 3;
    const int sh = 2 * g, dil = 1 << sh, Mlen = SEQ >> sh;
    bf16_t* Ks = (bf16_t*)(smem + AT_KS); unsigned char* Vs = smem + AT_VS; float* lq = (float*)(smem + AT_LQ) + w * 32; float* lut = (float*)(smem + AT_LUT);
    bf16_t* QB = (bf16_t*)(p.ws + WS_QB) + (size_t)bg * SEQ * 256 + j * 64;
    const bf16_t* KB = (const bf16_t*)(p.ws + WS_KB) + (size_t)bg * SEQ * 256 + j * 64;
    const bf16_t* VB = (const bf16_t*)(p.ws + WS_VB) + (size_t)bg * SEQ * 256 + j * 64;
    float* LSE = (float*)(p.ws + WS_LSE) + (size_t)bg * SEQ * 4 + j;
    const int p0r = blk * 128, seq_lo = (p0r / Mlen) * Mlen, seq_hi = seq_lo + Mlen;
    __syncthreads();
    if (tid < 129) {
        const int rel = tid - 64, n = (rel < 0 ? -rel : rel) * dil;
        int bk;
        if (n < 8) bk = n; else { bk = 8 + (n >= 15) + (n >= 27) + (n >= 50) + (n >= 91) + (n >= 166) + (n >= 305) + (n >= 559); }
        if (rel > 0) bk += 16;
        lut[tid] = p.rel_bias[bk * 12 + g * 4 + j] * LOG2E;
    }
    const int qpos = p0r + w * 32 + r32;
    bf16x8 qr[4];
#pragma unroll
    for (int ds = 0; ds < 4; ++ds) qr[ds] = *(const bf16x8*)(QB + (size_t)qpos * 256 + ds * 16 + hi * 8);
    const float nshift = -((const float*)(p.ws + WS_BND))[2 + l];
    f32x16 o0, o1;
#pragma unroll
    for (int i = 0; i < 16; ++i) { o0[i] = 0.f; o1[i] = 0.f; }
    f32x4 la4 = (f32x4){0.f, 0.f, 0.f, 0.f};
    u32x4 rk[2], rv[2];
    for (int kt = 0; kt < 4; ++kt) {
        const int kbase = p0r - 64 + 64 * kt;
#pragma unroll
        for (int i = 0; i < 2; ++i) { const int c = tid + 256 * i, row = c >> 3, ch = c & 7;
            int pr = kbase + row; pr = pr < 0 ? 0 : (pr > SEQ - 1 ? SEQ - 1 : pr);
            rk[i] = *(const u32x4*)(KB + (size_t)pr * 256 + ch * 8); rv[i] = *(const u32x4*)(VB + (size_t)pr * 256 + ch * 8); }
        __syncthreads();
        AT_STAGE_STORE();
        __syncthreads();
        f32x16 p0, p1;
#pragma unroll
        for (int i = 0; i < 16; ++i) { p0[i] = nshift; p1[i] = nshift; }
        at_qk(p0, p1, Ks, qr, r32, hi);
#pragma unroll
        for (int i = 0; i < 16; ++i) {
            const int kv0 = kbase + crow(i, hi), kv1 = kv0 + 32;
            const int rel0 = kv0 - qpos, rel1 = kv1 - qpos;
            const bool ok0 = rel0 >= -64 && rel0 <= 64 && kv0 >= seq_lo && kv0 < seq_hi;
            const bool ok1 = rel1 >= -64 && rel1 <= 64 && kv1 >= seq_lo && kv1 < seq_hi;
            const float e0 = __builtin_amdgcn_exp2f(p0[i] + lut[ok0 ? rel0 + 64 : 64]);
            const float e1 = __builtin_amdgcn_exp2f(p1[i] + lut[ok1 ? rel1 + 64 : 64]);
            p0[i] = ok0 ? e0 : 0.f; p1[i] = ok1 ? e1 : 0.f;
        }
#pragma unroll
        for (int i = 0; i < 4; ++i) { la4 += (f32x4){p0[4 * i], p0[4 * i + 1], p0[4 * i + 2], p0[4 * i + 3]}; la4 += (f32x4){p1[4 * i], p1[4 * i + 1], p1[4 * i + 2], p1[4 * i + 3]}; }
        at_pv(o0, o1, p0, p1, Vs, lane);
    }
    float lacc = (la4.x + la4.y) + (la4.z + la4.w);
    lacc += __shfl_xor(lacc, 32);
    if (hi == 0) { lq[r32] = lacc; LSE[(size_t)qpos * 4] = (-nshift + log2f(lacc)) * LN2; }
    asm volatile("s_waitcnt lgkmcnt(0)" ::: "memory");
#pragma unroll
    for (int rr = 0; rr < 16; ++rr) {
        const int q = crow(rr, hi); const float inv = 1.f / lq[q];
        const size_t off = (size_t)(p0r + w * 32 + q) * 256 + r32;
        QB[off] = (bf16_t)(pk2(o0[rr] * inv, 0.f) & 0xffffu);
        QB[off + 32] = (bf16_t)(pk2(o1[rr] * inv, 0.f) & 0xffffu);
    }
}

__device__ void conv_phase(const Params& p, int l) {
    int tx_ = threadIdx.x; asm volatile("" : "+v"(tx_));
    const bf16_t* XBC = (const bf16_t*)(p.ws + WS_XBC);
    bf16_t* XC = (bf16_t*)(p.ws + WS_XBCC);
    const float* cw = p.conv_w + (size_t)l * 5 * 1024; const float* cb = p.conv_b + l * 1024;
    const int nthr = gridDim.x * 512;
    for (int u = blockIdx.x * 512 + tx_; u < (TP / 4) * 128; u += nthr) {
        const int ch = (u & 127) * 8, tg = u >> 7, tok0 = tg * 4, tt0 = tok0 & (SEQ - 1);
        u32x4 raw[8];
#pragma unroll
        for (int r = 0; r < 8; ++r) { const int tt = tt0 - 2 + r; raw[r] = (u32x4){0u, 0u, 0u, 0u};
            if (tt >= 0 && tt < SEQ) raw[r] = *(const u32x4*)(XBC + (size_t)(tok0 - 2 + r) * 1024 + ch); }
        float ac[4][8];
        { const f32x4 a = *(const f32x4*)(cb + ch), b2 = *(const f32x4*)(cb + ch + 4);
#pragma unroll
          for (int t = 0; t < 4; ++t) { ac[t][0] = a.x; ac[t][1] = a.y; ac[t][2] = a.z; ac[t][3] = a.w; ac[t][4] = b2.x; ac[t][5] = b2.y; ac[t][6] = b2.z; ac[t][7] = b2.w; } }
#pragma unroll
        for (int k = 0; k < 5; ++k) { const f32x4 wa = *(const f32x4*)(cw + k * 1024 + ch), wb = *(const f32x4*)(cw + k * 1024 + ch + 4);
#pragma unroll
            for (int t = 0; t < 4; ++t) { const u32x4 v = raw[t + k];
                ac[t][0] += bflo(v.x) * wa.x; ac[t][1] += bfhi(v.x) * wa.y; ac[t][2] += bflo(v.y) * wa.z; ac[t][3] += bfhi(v.y) * wa.w;
                ac[t][4] += bflo(v.z) * wb.x; ac[t][5] += bfhi(v.z) * wb.y; ac[t][6] += bflo(v.w) * wb.z; ac[t][7] += bfhi(v.w) * wb.w; } }
#pragma unroll
        for (int t = 0; t < 4; ++t) { u32x4 o;
            o.x = pk2(siluf(ac[t][0]), siluf(ac[t][1])); o.y = pk2(siluf(ac[t][2]), siluf(ac[t][3])); o.z = pk2(siluf(ac[t][4]), siluf(ac[t][5])); o.w = pk2(siluf(ac[t][6]), siluf(ac[t][7]));
            *(u32x4*)(XC + (size_t)(tok0 + t) * 1024 + ch) = o; }
    }
}

constexpr int SS_BS = 0, SS_CS = 8704, SS_XS = 17408, SS_XWS = 22016, SS_GS = 26624, SS_SB = 29184, SS_CW = 46592, SS_SC = 54272, SS_DTA = 55296, SS_END = 57344;

template <int PASS>
__device__ void ssd_item(const Params& p, int item, int l, unsigned char* smem) {
    int tid_ = VTID; asm volatile("" : "+v"(tid_));
    const int tid = tid_, lane = tid & 63, w = tid >> 6, idx = lane & 15, kq = lane >> 4;
    const int seg = item & 15, h = (item >> 4) & 7, dir = (item >> 7) & 1, b = item >> 8, grp = h >> 2;
    bf16_t* Bs = (bf16_t*)(smem + SS_BS); bf16_t* Cs = (bf16_t*)(smem + SS_CS); bf16_t* Xs = (bf16_t*)(smem + SS_XS); bf16_t* Xws = (bf16_t*)(smem + SS_XWS);
    bf16_t* Gs = (bf16_t*)(smem + SS_GS); bf16_t* Sb = (bf16_t*)(smem + SS_SB); float* sc = (float*)(smem + SS_SC);
    float* s_cA = (float*)(smem + SS_CW), *s_rsA = s_cA + SEGLEN, *s_wlA = s_rsA + SEGLEN, *s_totA = sc;
    const bf16_t* XBC = (const bf16_t*)(p.ws + WS_XBC);
    const float* DT = (const float*)(p.ws + WS_DT);
    float* ST = (float*)(p.ws + WS_ST); float* SEGT = (float*)(p.ws + WS_SEGT);
    bf16_t* Y = (bf16_t*)(p.ws + (dir ? WS_YS : WS_YF));
    const float Aneg = -__expf(p.a_log[l * 16 + dir * 8 + h]);
    const float Dh = p.d_skip[l * 8 + h];
    __syncthreads();
    f32x4 S[8];
#pragma unroll
    for (int nt = 0; nt < 8; ++nt) S[nt] = (f32x4){0.f, 0.f, 0.f, 0.f};
    const int ibase = item & ~15;
    if (PASS == 3) {
        if (dir == 0) {
            for (int e = 0; e < seg; ++e) { const float dc = __expf(SEGT[ibase + e]); const f32x4* src = (const f32x4*)(ST + (size_t)(ibase + e) * 8192);
#pragma unroll
                for (int nt = 0; nt < 8; ++nt) S[nt] = S[nt] * dc + src[(w * 8 + nt) * 64 + lane]; }
        } else {
            for (int e = NSEG - 1; e > seg; --e) { const float dc = __expf(SEGT[ibase + e]); const f32x4* src = (const f32x4*)(ST + (size_t)(ibase + e) * 8192);
#pragma unroll
                for (int nt = 0; nt < 8; ++nt) S[nt] = S[nt] * dc + src[(w * 8 + nt) * 64 + lane]; }
        }
#pragma unroll
        for (int nt = 0; nt < 8; ++nt) st4bf(Sb + (16 * w + idx) * 136 + 16 * nt + 4 * kq, S[nt]);
    }
    float* s_dta = (float*)(smem + SS_DTA);
#pragma unroll
    for (int i = 0; i < SEGLEN / 256; ++i) {
        const int e = tid + 256 * i, l32 = lane & 31;
        const float dtv = DT[((size_t)b * SEQ + seg * SEGLEN + e) * 16 + dir * 8 + h], av = dtv * Aneg;
        float pre = av;
#pragma unroll
        for (int o = 1; o < 32; o <<= 1) { const float t = __shfl_up(pre, o, 32); if (l32 >= o) pre += t; }
        const float tot = __shfl(pre, 31, 32);
        const float cc = dir ? (tot - pre + av) : pre;
        s_dta[e] = dtv; s_cA[e] = cc; s_rsA[e] = __expf(cc); s_wlA[e] = dtv * __expf(tot - cc);
        if (l32 == 0) s_totA[e >> 5] = tot;
    }
    float segtot = 0.f;
    const size_t tokb = (size_t)b * SEQ;
    const unsigned char* xb_ = (const unsigned char*)((const bf16_t*)(p.ws + WS_XBCC) + tokb * 1024);
    unsigned soff[5];
#pragma unroll
    for (int i = 0; i < 5; ++i) { const int u = tid + 256 * i, lrow = u / 40, ci = u % 40;
        const int scol = ci < 8 ? h * 64 + ci * 8 : (ci < 24 ? 512 + grp * 128 + (ci * 8 - 64) : 768 + grp * 128 + (ci * 8 - 192));
        soff[i] = (unsigned)((lrow * 1024 + scol) * 2); }
    for (int si = 0; si < NSUB; ++si) {
        const int scn = dir ? (NSUB - 1 - si) : si;
        const int t0 = seg * SEGLEN + scn * TSUB;
        __syncthreads();
        u32x4 raw[5];
#pragma unroll
        for (int i = 0; i < 5; ++i) raw[i] = *(const u32x4*)(xb_ + ((unsigned)(t0 * 2048) + soff[i]));
        const float* s_dt = s_dta + scn * TSUB; const float* s_c = s_cA + scn * TSUB; const float* s_rs = s_rsA + scn * TSUB; const float* s_wl = s_wlA + scn * TSUB;
        const float stot = s_totA[scn];
        segtot += stot;
#pragma unroll
        for (int i = 0; i < 5; ++i) { const int u = tid + 256 * i, lrow = u / 40, ci = u % 40, lc = ci * 8; const u32x4 o = raw[i];
            if (ci < 8) { *(u32x4*)(Xs + lrow * 72 + lc) = o; const float wl = s_wl[lrow];
                u32x4 o2; o2.x = pk2(bflo(o.x) * wl, bfhi(o.x) * wl); o2.y = pk2(bflo(o.y) * wl, bfhi(o.y) * wl); o2.z = pk2(bflo(o.z) * wl, bfhi(o.z) * wl); o2.w = pk2(bflo(o.w) * wl, bfhi(o.w) * wl);
                *(u32x4*)(Xws + lrow * 72 + lc) = o2; }
            else if (ci < 24) *(u32x4*)(Bs + lrow * 136 + (lc - 64)) = o;
            else *(u32x4*)(Cs + lrow * 136 + (lc - 192)) = o; }
        __syncthreads();
        if (PASS == 3) {
            const int it = w >> 1, jt = w & 1;
            f32x4 cb = (f32x4){0.f, 0.f, 0.f, 0.f};
            {
                bf16x8 fb[4], fc[4];
#pragma unroll
                for (int ks = 0; ks < 4; ++ks) { fb[ks] = *(const bf16x8*)(Bs + (16 * jt + idx) * 136 + ks * 32 + kq * 8); fc[ks] = *(const bf16x8*)(Cs + (16 * it + idx) * 136 + ks * 32 + kq * 8); }
                __builtin_amdgcn_sched_barrier(0);
#pragma unroll
                for (int ks = 0; ks < 4; ++ks) cb = __builtin_amdgcn_mfma_f32_16x16x32_bf16(fb[ks], fc[ks], cb, 0, 0, 0);
                __builtin_amdgcn_sched_barrier(0);
            }
            {
                const int ii = 16 * it + idx; const float ci_ = s_c[ii];
                f32x4 gv;
#pragma unroll
                for (int rg = 0; rg < 4; ++rg) {
                    const int jj = 16 * jt + 4 * kq + rg;
                    const bool ok = dir ? (jj >= ii) : (jj <= ii);
                    const float e = __expf(ci_ - s_c[jj]) * s_dt[jj];
                    gv[rg] = ok ? cb[rg] * e : 0.f;
                }
                st4bf(Gs + ii * 40 + 16 * jt + 4 * kq, gv);
            }
            __syncthreads();
            const unsigned char* xtr = (const unsigned char*)Xs + (8 * kq + (idx >> 2)) * 144 + (16 * w + 4 * (idx & 3)) * 2;
            const bf16x8 xf = cat8(tr16(xtr), tr16(xtr + 4 * 144));
#pragma unroll 1
            for (int it2 = 0; it2 < 2; ++it2) {
                const int ii = 16 * it2 + idx;
                const bf16x8 gf = *(const bf16x8*)(Gs + ii * 40 + 8 * kq);
                f32x4 yd = (f32x4){0.f, 0.f, 0.f, 0.f}, yo = (f32x4){0.f, 0.f, 0.f, 0.f};
                bf16x8 sf[4], cf[4];
#pragma unroll
                for (int ks = 0; ks < 4; ++ks) { sf[ks] = *(const bf16x8*)(Sb + (16 * w + idx) * 136 + ks * 32 + kq * 8); cf[ks] = *(const bf16x8*)(Cs + ii * 136 + ks * 32 + kq * 8); }
                __builtin_amdgcn_sched_barrier(0);
                yd = __builtin_amdgcn_mfma_f32_16x16x32_bf16(xf, gf, yd, 0, 0, 0);
#pragma unroll
                for (int ks = 0; ks < 4; ++ks) yo = __builtin_amdgcn_mfma_f32_16x16x32_bf16(sf[ks], cf[ks], yo, 0, 0, 0);
                __builtin_amdgcn_sched_barrier(0);
                f32x4 y = yd + yo * s_rs[ii];
                if (dir == 0) { const u32x2 xv = *(const u32x2*)(Xs + ii * 72 + 16 * w + 4 * kq);
                    y.x += Dh * bflo(xv.x); y.y += Dh * bfhi(xv.x); y.z += Dh * bflo(xv.y); y.w += Dh * bfhi(xv.y); }
                st4bf(Y + (tokb + t0 + ii) * 512 + h * 64 + 16 * w + 4 * kq, y);
            }
        }
        {
            const float dc = __expf(stot);
            const unsigned char* xw = (const unsigned char*)Xws + (8 * kq + (idx >> 2)) * 144 + (16 * w + 4 * (idx & 3)) * 2;
            const bf16x8 xwf = cat8(tr16(xw), tr16(xw + 4 * 144));
            bf16x8 bfv[8];
#pragma unroll
            for (int nt = 0; nt < 8; ++nt) {
                const unsigned char* bt = (const unsigned char*)Bs + (8 * kq + (idx >> 2)) * 272 + (16 * nt + 4 * (idx & 3)) * 2;
                bfv[nt] = cat8(tr16(bt), tr16(bt + 4 * 272));
            }
            __builtin_amdgcn_sched_barrier(0);
#pragma unroll
            for (int nt = 0; nt < 8; ++nt) S[nt] = __builtin_amdgcn_mfma_f32_16x16x32_bf16(bfv[nt], xwf, S[nt] * dc, 0, 0, 0);
            __builtin_amdgcn_sched_barrier(0);
            if (PASS == 3) {
#pragma unroll
                for (int nt = 0; nt < 8; ++nt) st4bf(Sb + (16 * w + idx) * 136 + 16 * nt + 4 * kq, S[nt]);
            }
        }
    }
    if (PASS == 1) {
        f32x4* dst = (f32x4*)(ST + (size_t)item * 8192);
#pragma unroll
        for (int nt = 0; nt < 8; ++nt) dst[(w * 8 + nt) * 64 + lane] = S[nt];
        if (tid == 0) SEGT[item] = segtot;
    }
}

__device__ void post2_phase(const Params& p) {
    int tx_ = threadIdx.x; asm volatile("" : "+v"(tx_));
    const int lane = tx_ & 63, gw = blockIdx.x * 8 + (tx_ >> 6), nw = gridDim.x * 8;
    const bf16_t* OB = (const bf16_t*)(p.ws + WS_QB); const float* LSE = (const float*)(p.ws + WS_LSE);
    const bf16_t* GB = (const bf16_t*)(p.ws + WS_GB);
    bf16_t* YBM = (bf16_t*)(p.ws + WS_YBM);
    const bf16_t* YF = (const bf16_t*)(p.ws + WS_YF); const bf16_t* YS = (const bf16_t*)(p.ws + WS_YS); const bf16_t* ZS = (const bf16_t*)(p.ws + WS_ZS);
    bf16_t* YC = (bf16_t*)(p.ws + WS_YC); float* RS = (float*)(p.ws + WS_RSTD);
    for (int row = gw; row < TP; row += nw) {
        const int bl = row >> 13, tt = row & (SEQ - 1), j = lane >> 4;
        float ls[3]; size_t ro[3];
#pragma unroll
        for (int g = 0; g < 3; ++g) { const int sh = 2 * g; const int pp = (tt & ((1 << sh) - 1)) * (SEQ >> sh) + (tt >> sh);
            ro[g] = (size_t)(bl * 3 + g) * SEQ + pp; ls[g] = LSE[ro[g] * 4 + j]; }
        const float mx = fmaxf(ls[0], fmaxf(ls[1], ls[2]));
        float wg[3]; float ws = 0.f;
#pragma unroll
        for (int g = 0; g < 3; ++g) { wg[g] = __expf(ls[g] - mx); ws += wg[g]; }
        const float inv = 1.f / ws;
        f32x4 acc = (f32x4){0.f, 0.f, 0.f, 0.f};
#pragma unroll
        for (int g = 0; g < 3; ++g) { const u32x2 v = *(const u32x2*)(OB + ro[g] * 256 + 4 * lane); const float wv = wg[g] * inv;
            acc.x += wv * bflo(v.x); acc.y += wv * bfhi(v.x); acc.z += wv * bflo(v.y); acc.w += wv * bfhi(v.y); }
        { const u32x2 gt = *(const u32x2*)(GB + (size_t)row * 256 + 4 * lane);
          acc.x *= bflo(gt.x); acc.y *= bfhi(gt.x); acc.z *= bflo(gt.y); acc.w *= bfhi(gt.y); }
        st4bf(YBM + (size_t)row * 256 + 4 * lane, acc);
        const u32x4 a = *(const u32x4*)(YF + (size_t)row * 512 + 8 * lane), bq = *(const u32x4*)(YS + (size_t)row * 512 + 8 * lane), z = *(const u32x4*)(ZS + (size_t)row * 512 + 8 * lane);
        float y[8];
        y[0] = (bflo(a.x) + bflo(bq.x)) * bflo(z.x); y[1] = (bfhi(a.x) + bfhi(bq.x)) * bfhi(z.x);
        y[2] = (bflo(a.y) + bflo(bq.y)) * bflo(z.y); y[3] = (bfhi(a.y) + bfhi(bq.y)) * bfhi(z.y);
        y[4] = (bflo(a.z) + bflo(bq.z)) * bflo(z.z); y[5] = (bfhi(a.z) + bfhi(bq.z)) * bfhi(z.z);
        y[6] = (bflo(a.w) + bflo(bq.w)) * bflo(z.w); y[7] = (bfhi(a.w) + bfhi(bq.w)) * bfhi(z.w);
        float ss = 0.f;
#pragma unroll
        for (int e = 0; e < 8; ++e) ss += y[e] * y[e];
        ss = wave_sum(ss);
        u32x4 o; o.x = pk2(y[0], y[1]); o.y = pk2(y[2], y[3]); o.z = pk2(y[4], y[5]); o.w = pk2(y[6], y[7]);
        *(u32x4*)(YC + (size_t)row * 512 + 8 * lane) = o;
        if (lane == 0) RS[row] = rsqrtf(ss * (1.f / 512.f) + EPS);
    }
}


#define XB_TMO      128
#define XB_XCNT(j)  (256  + 64 * (j))
#define XB_XSUB(j)  (1280 + 64 * (j))
#define XB_XGEN(j)  (2304 + 64 * (j))
#define XB_TOP      3328
#define XB_TOPGEN   3392
#define XCD_BAR_WORDS 3456
#define XB_SPIN_CAP (1u << 20)
__device__ __forceinline__ unsigned xb_ld(unsigned* p)              { return __hip_atomic_load(p, __ATOMIC_RELAXED, __HIP_MEMORY_SCOPE_AGENT); }
__device__ __forceinline__ unsigned xb_add(unsigned* p, unsigned v) { return __hip_atomic_fetch_add(p, v, __ATOMIC_RELAXED, __HIP_MEMORY_SCOPE_AGENT); }
__device__ __forceinline__ unsigned xb_xcc_id() { return (unsigned)__builtin_amdgcn_s_getreg((3 << 11) | 20) & 0xFu; }
#define XB_SPIN(cond, bar) do { unsigned _sp = 0; while (cond) { __builtin_amdgcn_s_sleep(1); \
    if ((++_sp & 255u) == 0u) { if (xb_ld(&(bar)[XB_TMO])) break; if (_sp > XB_SPIN_CAP) { atomicAdd(&(bar)[XB_TMO], 1u); break; } } } } while (0)
struct XcdBarrier { unsigned* bar; unsigned x; volatile LDSAS unsigned* st; };
__device__ __forceinline__ XcdBarrier xcd_barrier_post(unsigned* bar, volatile LDSAS unsigned* st) {
    XcdBarrier b; b.bar = bar; b.x = xb_xcc_id(); b.st = st;
    if (threadIdx.x == 0) (void)xb_add(&bar[XB_XCNT(b.x)], 1u);
    return b;
}
__device__ __forceinline__ void xcd_barrier_complete(unsigned* bar, unsigned x, unsigned& nloc, unsigned& nx) {
    const unsigned G = gridDim.x * gridDim.y * gridDim.z;
    unsigned sum, cnt, mine, sp = 0u;
    for (;;) {
        sum = 0u; cnt = 0u; mine = 0u;
#pragma unroll
        for (unsigned j = 0; j < 16; ++j) { const unsigned c = xb_ld(&bar[XB_XCNT(j)]); sum += c; cnt += (c > 0u) ? 1u : 0u; mine = (j == x) ? c : mine; }
        if (sum == G) break;
        __builtin_amdgcn_s_sleep(1);
        if ((++sp & 255u) == 0u) { if (xb_ld(&bar[XB_TMO])) break; if (sp > XB_SPIN_CAP) { atomicAdd(&bar[XB_TMO], 1u); break; } }
    }
    nloc = mine > 0u ? mine : 1u; nx = cnt > 0u ? cnt : 1u;
}
__device__ __forceinline__ void xcd_barrier(const XcdBarrier& b) {
    asm volatile("s_waitcnt vmcnt(0)" ::: "memory");
    __syncthreads();
    if (threadIdx.x == 0) {
        unsigned* bar = b.bar;
        __builtin_amdgcn_s_waitcnt(0);
        unsigned nloc = b.st[0], nx = b.st[1];
        if (nloc == 0u) { xcd_barrier_complete(bar, b.x, nloc, nx); b.st[0] = nloc; b.st[1] = nx; }
        const unsigned old = xb_add(&bar[XB_XSUB(b.x)], 1u);
        const unsigned gen = old / nloc;
        if (old + 1u == (gen + 1u) * nloc) {
            __builtin_amdgcn_fence(__ATOMIC_RELEASE, "agent");
            asm volatile("s_waitcnt vmcnt(0)" ::: "memory");
            const unsigned og = xb_add(&bar[XB_TOP], 1u);
            const unsigned tg = og / nx;
            if (og + 1u == (tg + 1u) * nx) xb_add(&bar[XB_TOPGEN], 1u);
            else XB_SPIN(xb_ld(&bar[XB_TOPGEN]) == tg, bar);
            __builtin_amdgcn_fence(__ATOMIC_ACQUIRE, "agent");
            xb_add(&bar[XB_XGEN(b.x)], 1u);
            asm volatile("s_waitcnt vmcnt(0)" ::: "memory");
        } else {
            XB_SPIN(xb_ld(&bar[XB_XGEN(b.x)]) == gen, bar);
            __builtin_amdgcn_fence(__ATOMIC_ACQUIRE, "agent");
            asm volatile("s_waitcnt vmcnt(0)" ::: "memory");
        }
    }
    __syncthreads();
}

__device__ __forceinline__ unsigned char* lds_half(unsigned char* smem) { int h_ = threadIdx.x >> 8; asm volatile("" : "+v"(h_)); return smem + h_ * HALF_LDS; }
__global__ void __launch_bounds__(512, 2) hybrid_fwd(Params p) {
    cg::grid_group grid = cg::this_grid();
    extern __shared__ __attribute__((aligned(16))) unsigned char smem[];
    volatile LDSAS unsigned* bst = (volatile LDSAS unsigned*)(smem + LDS_TOTAL - 16);
    if (threadIdx.x < 4) bst[threadIdx.x] = 0u;
    __syncthreads();
    const XcdBarrier xbar = xcd_barrier_post((unsigned*)(p.ws + WS_BAR), bst);
    { const Params q = launder(p); phase0(q, lds_half(smem)); }
    grid.sync();
#pragma unroll 1
    for (int l = 0; l < DEPTH; ++l) {
#pragma unroll 1
        for (int hb = 0; hb < 2; ++hb) {
            { const Params q = launder(p); norm_phase(q, l, hb, (l == 0) ? q.x : q.out); }
            xcd_barrier(xbar);
            { const Params q = launder(p); gemm1_phase(q, l, hb, smem); }
            xcd_barrier(xbar);
            { const Params q = launder(p); conv_phase(q, l); }
            xcd_barrier(xbar);
            { const Params q = launder(p); unsigned char* smh = lds_half(smem);
#pragma unroll 1
              for (int it = VBLK; it < 512 + 1536; it += VGRID) { if (it < 512) ssd_item<1>(q, it, l, smh); else attn_b_item(q, it - 512, l, smh); } }
            xcd_barrier(xbar);
            { const Params q = launder(p); unsigned char* smh = lds_half(smem);
#pragma unroll 1
              for (int it = VBLK; it < 1024 + 512; it += VGRID) { if (it < 1024) attn_a_item(q, it, l, smh); else ssd_item<3>(q, it - 1024, l, smh); } }
            xcd_barrier(xbar);
            { const Params q = launder(p); post2_phase(q); }
            xcd_barrier(xbar);
            { const Params q = launder(p); merge_phase(q, l, smem); }
            xcd_barrier(xbar);
            { const Params q = launder(p); out_phase(q, l, hb, (l == 0) ? q.x : q.out, smem); }
        }
    }
}

extern "C" void kernel_launch(void* const* d_in, const int* in_sizes, int n_in, void* d_out, int out_size, void* d_ws, size_t ws_size, hipStream_t stream) {
    static int grid_blocks = 0;
    if (!grid_blocks) {
        int dev = 0, cus = 0, per_cu = 0;
        hipGetDevice(&dev);
        hipDeviceGetAttribute(&cus, hipDeviceAttributeMultiprocessorCount, dev);
        hipFuncSetAttribute((const void*)hybrid_fwd, hipFuncAttributeMaxDynamicSharedMemorySize, LDS_TOTAL);
        hipOccupancyMaxActiveBlocksPerMultiprocessor(&per_cu, hybrid_fwd, 512, LDS_TOTAL);
        if (per_cu > 1) per_cu = 1;
        if (per_cu < 1) per_cu = 1;
        grid_blocks = cus * per_cu;
    }
    Params p{};
    const float** pp = (const float**)&p;
    for (int i = 0; i < 22; ++i) pp[i] = (const float*)d_in[i];
    p.out = (float*)d_out; p.ws = (unsigned char*)d_ws;
    hipMemsetAsync((unsigned char*)d_ws + WS_BAR, 0, XCD_BAR_WORDS * 4, stream);
    void* args[] = {&p};
    hipError_t e = hipLaunchCooperativeKernel((void*)hybrid_fwd, dim3(grid_blocks), dim3(512), args, LDS_TOTAL, stream);
    if (e != hipSuccess) fprintf(stderr, "cooperative launch failed: %s (grid %d)\n", hipGetErrorString(e), grid_blocks);
}
```

```cpp
#include <hip/hip_runtime.h>
#include <hip/hip_cooperative_groups.h>
#include <cstdint>
#include <cstdio>
namespace cg = cooperative_groups;

typedef unsigned short bf16_t;
typedef short bf16x8 __attribute__((ext_vector_type(8)));
typedef short v4i16 __attribute__((ext_vector_type(4)));
typedef float f32x2 __attribute__((ext_vector_type(2)));
typedef float f32x4 __attribute__((ext_vector_type(4)));
typedef float f32x16 __attribute__((ext_vector_type(16)));
typedef unsigned u32x2 __attribute__((ext_vector_type(2)));
typedef unsigned u32x4 __attribute__((ext_vector_type(4)));
typedef __bf16 bf16x2_t __attribute__((ext_vector_type(2)));
#define LDSAS __attribute__((address_space(3)))
#define VTID ((int)(threadIdx.x & 255u))
__device__ __forceinline__ int vblk_() { int h_ = threadIdx.x >> 8; asm volatile("" : "+v"(h_)); return __builtin_amdgcn_readfirstlane(2 * (int)blockIdx.x + h_); }
#define VBLK vblk_()
#define VGRID ((int)(2u * gridDim.x))
constexpr int HALF_LDS = 73728, LDS_TOTAL = 147456;

constexpr int SEQ = 8192, DM = 1024, NBATCH = 4, NBH = 2, TP = NBH * SEQ, DEPTH = 2;
constexpr int NP = 8704;
constexpr float EPS = 1e-6f;
constexpr float LOG2E = 1.4426950408889634f, LN2 = 0.6931471805599453f;
constexpr int NSEG = 16, SEGLEN = 512, TSUB = 32, NSUB = SEGLEN / TSUB;

constexpr size_t MiB = 1u << 20;
constexpr size_t WS_WIN = 0;
constexpr size_t WS_WPA = 34 * MiB;
constexpr size_t WS_WPB = 36 * MiB;
constexpr size_t WS_WPC = 37 * MiB;
constexpr size_t WS_WOUT = 39 * MiB;
constexpr size_t WS_MOD = 43 * MiB;
constexpr size_t WS_ROPE = 43 * MiB + 128 * 1024;
constexpr size_t WS_BND = 43 * MiB + 160 * 1024;
constexpr size_t WS_RSTD = 43 * MiB + 256 * 1024;
constexpr size_t WS_SEGT = 43 * MiB + 512 * 1024;
constexpr size_t WS_LSE = 44 * MiB;
constexpr size_t WS_DT = 45 * MiB;
constexpr size_t WS_BAR = 46 * MiB;
constexpr size_t WS_H = 48 * MiB;
constexpr size_t WS_QA = 80 * MiB;
constexpr size_t WS_KA = 96 * MiB;
constexpr size_t WS_VA = 100 * MiB;
constexpr size_t WS_GA = 104 * MiB;
constexpr size_t WS_QB = 120 * MiB;
constexpr size_t WS_KB = 144 * MiB;
constexpr size_t WS_VB = 168 * MiB;
constexpr size_t WS_GB = 192 * MiB;
constexpr size_t WS_XBC = 200 * MiB;
constexpr size_t WS_ZS = 232 * MiB;
constexpr size_t WS_MG = 248 * MiB;
constexpr size_t WS_YF = 344 * MiB;
constexpr size_t WS_YS = 360 * MiB;
constexpr size_t WS_YBM = 376 * MiB;
constexpr size_t WS_YC = 384 * MiB;
constexpr size_t WS_MRG = 400 * MiB;
constexpr size_t WS_ST = 432 * MiB;
constexpr size_t WS_XBCC = 448 * MiB;

struct Params {
    const float *x, *c, *norm_w, *w_ada, *b_ada, *w_in, *b_gate, *q_norm_a, *k_norm_a, *q_norm_b, *k_norm_b, *rel_bias,
        *conv_w, *conv_b, *a_log, *dt_bias, *d_skip, *ssm_norm_w, *w_proj_a, *w_proj_b, *w_proj_c, *w_out;
    float* out;
    unsigned char* ws;
};


#define AS1 __attribute__((address_space(1)))
#define GLOBF(f) do { AS1 const float* g_ = (AS1 const float*)p.f; asm volatile("" : "+s"(g_)); q.f = (const float*)g_; } while (0)
__device__ __forceinline__ Params launder(const Params& p) {
    Params q;
    GLOBF(x); GLOBF(c); GLOBF(norm_w); GLOBF(w_ada); GLOBF(b_ada); GLOBF(w_in); GLOBF(b_gate); GLOBF(q_norm_a); GLOBF(k_norm_a); GLOBF(q_norm_b); GLOBF(k_norm_b); GLOBF(rel_bias);
    GLOBF(conv_w); GLOBF(conv_b); GLOBF(a_log); GLOBF(dt_bias); GLOBF(d_skip); GLOBF(ssm_norm_w); GLOBF(w_proj_a); GLOBF(w_proj_b); GLOBF(w_proj_c); GLOBF(w_out);
    { AS1 float* g_ = (AS1 float*)p.out; asm volatile("" : "+s"(g_)); q.out = (float*)g_; }
    { AS1 unsigned char* g_ = (AS1 unsigned char*)p.ws; asm volatile("" : "+s"(g_)); q.ws = (unsigned char*)g_; }
    return q;
}
__device__ __forceinline__ unsigned pk2(float lo, float hi) { f32x2 v = {lo, hi}; bf16x2_t b = __builtin_convertvector(v, bf16x2_t); return __builtin_bit_cast(unsigned, b); }
__device__ __forceinline__ float bf2f(unsigned short b) { return __uint_as_float(((unsigned)b) << 16); }
__device__ __forceinline__ float bflo(unsigned u) { return __uint_as_float(u << 16); }
__device__ __forceinline__ float bfhi(unsigned u) { return __uint_as_float(u & 0xffff0000u); }
__device__ __forceinline__ float siluf(float v) { return v * __builtin_amdgcn_rcpf(1.f + __builtin_amdgcn_exp2f(-1.4426950408889634f * v)); }
__device__ __forceinline__ float sigmf(float v) { return __builtin_amdgcn_rcpf(1.f + __builtin_amdgcn_exp2f(-1.4426950408889634f * v)); }
__device__ __forceinline__ float wave_sum(float v) {
#pragma unroll
    for (int o = 1; o < 64; o <<= 1) v += __shfl_xor(v, o);
    return v;
}
__device__ __forceinline__ v4i16 tr16(const unsigned char* p) { return __builtin_amdgcn_ds_read_tr16_b64_v4i16((LDSAS v4i16*)p); }
__device__ __forceinline__ bf16x8 cat8(v4i16 a, v4i16 b) { return (bf16x8){a[0], a[1], a[2], a[3], b[0], b[1], b[2], b[3]}; }
__device__ __forceinline__ int crow(int r, int hi) { return (r & 3) + 8 * (r >> 2) + 4 * hi; }

struct P0It { const float* W; bf16_t* Wt; const float* rs; int ldw, K, k0, n0, mode; };
__device__ __forceinline__ void p0_load(const P0It& t, float (&vv)[16]) {
    const int tid = VTID, tx = tid & 63, ty = tid >> 6;
    const int np = t.n0 + tx; int n = np; bool valid = true;
    if (t.mode == 1) {
        if (np < 4352) n = np; else if (np < 4864) n = np + 512; else if (np < 5376) n = np - 512;
        else if (np < 8448) n = np + 16; else if (np < 8464) n = np - 3072; else { valid = false; n = 0; }
    }
#pragma unroll
    for (int i = 0; i < 16; ++i) { const int k = ty + 4 * i; vv[i] = valid ? t.W[(size_t)(t.k0 + k) * t.ldw + n] : 0.f; }
}
__device__ __forceinline__ void p0_finish(const P0It& t, const float (&vv)[16], float* tile) {
    const int tid = VTID, tx = tid & 63, ty = tid >> 6;
#pragma unroll
    for (int i = 0; i < 16; ++i) { const int k = ty + 4 * i; float v = vv[i]; if (t.rs) v *= t.rs[t.k0 + k]; tile[k * 65 + tx] = v; }
    __syncthreads();
    const int r = tid >> 2, kc = (tid & 3) * 16;
    u32x4 o0, o1;
    o0.x = pk2(tile[(kc + 0) * 65 + r], tile[(kc + 1) * 65 + r]); o0.y = pk2(tile[(kc + 2) * 65 + r], tile[(kc + 3) * 65 + r]);
    o0.z = pk2(tile[(kc + 4) * 65 + r], tile[(kc + 5) * 65 + r]); o0.w = pk2(tile[(kc + 6) * 65 + r], tile[(kc + 7) * 65 + r]);
    o1.x = pk2(tile[(kc + 8) * 65 + r], tile[(kc + 9) * 65 + r]); o1.y = pk2(tile[(kc + 10) * 65 + r], tile[(kc + 11) * 65 + r]);
    o1.z = pk2(tile[(kc + 12) * 65 + r], tile[(kc + 13) * 65 + r]); o1.w = pk2(tile[(kc + 14) * 65 + r], tile[(kc + 15) * 65 + r]);
    bf16_t* dst = t.Wt + (size_t)(t.n0 + r) * t.K + t.k0 + kc;
    *(u32x4*)dst = o0; *(u32x4*)(dst + 8) = o1;
    __syncthreads();
}
constexpr int P0_IN = 16 * 136, P0_PA = 8 * 16, P0_PB = 4 * 16, P0_PC = 8 * 16, P0_OUT = 16 * 16, P0_L = P0_IN + P0_PA + P0_PB + P0_PC + P0_OUT;
__device__ __forceinline__ P0It p0_params(const Params& p, int item) {
    P0It t; const int l = item / P0_L; int r = item % P0_L; t.rs = nullptr; t.mode = 0;
    if (r < P0_IN) { t.W = p.w_in + (size_t)l * 1024 * 8464; t.ldw = 8464; t.K = 1024; t.Wt = (bf16_t*)(p.ws + WS_WIN) + (size_t)l * NP * 1024; t.k0 = (r / 136) * 64; t.n0 = (r % 136) * 64; t.mode = 1; return t; }
    r -= P0_IN;
    if (r < P0_PA) { t.W = p.w_proj_a + (size_t)l * 512 * 1024; t.ldw = 1024; t.K = 512; t.Wt = (bf16_t*)(p.ws + WS_WPA) + (size_t)l * 1024 * 512; t.k0 = (r / 16) * 64; t.n0 = (r % 16) * 64; return t; }
    r -= P0_PA;
    if (r < P0_PB) { t.W = p.w_proj_b + (size_t)l * 256 * 1024; t.ldw = 1024; t.K = 256; t.Wt = (bf16_t*)(p.ws + WS_WPB) + (size_t)l * 1024 * 256; t.k0 = (r / 16) * 64; t.n0 = (r % 16) * 64; return t; }
    r -= P0_PB;
    if (r < P0_PC) { t.W = p.w_proj_c + (size_t)l * 512 * 1024; t.ldw = 1024; t.K = 512; t.Wt = (bf16_t*)(p.ws + WS_WPC) + (size_t)l * 1024 * 512; t.k0 = (r / 16) * 64; t.n0 = (r % 16) * 64; t.rs = p.ssm_norm_w + l * 512; return t; }
    r -= P0_PC;
    t.W = p.w_out + (size_t)l * 1024 * 1024; t.ldw = 1024; t.K = 1024; t.Wt = (bf16_t*)(p.ws + WS_WOUT) + (size_t)l * 1024 * 1024; t.k0 = (r / 16) * 64; t.n0 = (r % 16) * 64; return t;
}

__device__ void phase0(const Params& p, unsigned char* smem) {
    const int tid = VTID;
    float* tile = (float*)smem;
    constexpr int I_T = 2 * P0_L, I_MOD = 192, I_ALL = I_T + I_MOD + 1;
    {
        int item = VBLK;
        if (item < I_T) {
            P0It cur = p0_params(p, item); float va[16], vb[16]; p0_load(cur, va);
            for (;;) {
                const int nx = item + VGRID; const bool more = nx < I_T; P0It nxt = cur;
                if (more) { nxt = p0_params(p, nx); p0_load(nxt, vb); }
                p0_finish(cur, va, tile);
                if (!more) break;
                item = nx; cur = nxt;
#pragma unroll
                for (int i = 0; i < 16; ++i) va[i] = vb[i];
            }
        }
    }
    for (int item = VBLK; item < I_ALL; item += VGRID) {
        if (item < I_T) {
            continue;
        } else if (item < I_T + I_MOD) {
            const int it = item - I_T, l = it / 96, col0 = (it % 96) * 32, cl = tid & 31, ks = tid >> 5;
            float a0 = 0.f, a1 = 0.f, a2 = 0.f, a3 = 0.f;
            const float* wp = p.w_ada + ((size_t)l * 1024 + ks * 128) * 3072 + col0 + cl;
#pragma unroll 8
            for (int k = 0; k < 128; ++k) {
                const float wv = wp[(size_t)k * 3072]; const int kk = ks * 128 + k;
                a0 += siluf(p.c[kk]) * wv; a1 += siluf(p.c[1024 + kk]) * wv; a2 += siluf(p.c[2048 + kk]) * wv; a3 += siluf(p.c[3072 + kk]) * wv;
            }
            float* red = (float*)smem;
            red[(ks * 32 + cl) * 4 + 0] = a0; red[(ks * 32 + cl) * 4 + 1] = a1; red[(ks * 32 + cl) * 4 + 2] = a2; red[(ks * 32 + cl) * 4 + 3] = a3;
            __syncthreads();
            if (tid < 128) { const int b = tid >> 5, c2 = tid & 31; float s = 0.f;
#pragma unroll
                for (int k = 0; k < 8; ++k) s += red[(k * 32 + c2) * 4 + b];
                ((float*)(p.ws + WS_MOD))[(l * 4 + b) * 3072 + col0 + c2] = s + p.b_ada[l * 3072 + col0 + c2]; }
            __syncthreads();
        } else {
            float* rc = (float*)(p.ws + WS_ROPE); float* rs = rc + 128 * 16;
            for (int e = tid; e < 2048; e += 256) {
                const int pos = e >> 4, i = e & 15;
                const float freq = powf(10000.0f, -(float)i / 16.0f);
                const float ang = (float)pos * freq;
                const double rev = (double)ang * 0.15915494309189535; const double fr = rev - rint(rev);
                const float a = (float)(fr * 6.283185307179586);
                rc[e] = cosf(a); rs[e] = sinf(a);
            }
            if (tid < 2) {
                const int l = tid; float mqa = 0.f, mka = 0.f, mqb = 0.f, mkb = 0.f, mb = 0.f;
                for (int i = 0; i < 64; ++i) { mqa = fmaxf(mqa, fabsf(p.q_norm_a[l * 64 + i])); mka = fmaxf(mka, fabsf(p.k_norm_a[l * 64 + i]));
                    mqb = fmaxf(mqb, fabsf(p.q_norm_b[l * 64 + i])); mkb = fmaxf(mkb, fabsf(p.k_norm_b[l * 64 + i])); }
                for (int i = 0; i < 32 * 12; ++i) mb = fmaxf(mb, p.rel_bias[i]);
                float* bd = (float*)(p.ws + WS_BND);
                bd[l] = 8.f * mqa * mka * LOG2E; bd[2 + l] = (8.f * mqb * mkb + mb) * LOG2E;
            }
        }
    }
}

__device__ void norm_phase(const Params& p, int l, int hb, const float* xsrc) {
    int tx_ = threadIdx.x; asm volatile("" : "+v"(tx_));
    const int lane = tx_ & 63, gw = blockIdx.x * 8 + (tx_ >> 6), nw = gridDim.x * 8;
    bf16_t* H = (bf16_t*)(p.ws + WS_H);
    const float* nwp = p.norm_w + l * 1024;
    for (int row0 = gw; row0 < TP; row0 += 4 * nw) {
        f32x4 v[4][4];
#pragma unroll
        for (int q = 0; q < 4; ++q) { const int row = row0 + q * nw;
            if (row < TP) { const f32x4* xr = (const f32x4*)(xsrc + ((size_t)hb * TP + row) * 1024);
#pragma unroll
                for (int j = 0; j < 4; ++j) v[q][j] = xr[lane + 64 * j]; } }
#pragma unroll
        for (int q = 0; q < 4; ++q) { const int row = row0 + q * nw;
            if (row < TP) {
                const size_t rg = (size_t)hb * TP + row; const int b = (int)(rg / SEQ);
                const float* md = (const float*)(p.ws + WS_MOD) + (size_t)(l * 4 + b) * 3072;
                float ss = 0.f;
#pragma unroll
                for (int j = 0; j < 4; ++j) ss += v[q][j].x * v[q][j].x + v[q][j].y * v[q][j].y + v[q][j].z * v[q][j].z + v[q][j].w * v[q][j].w;
                ss = wave_sum(ss); const float rstd = rsqrtf(ss * (1.f / 1024.f) + EPS);
#pragma unroll
                for (int j = 0; j < 4; ++j) {
                    const int col = 4 * (lane + 64 * j);
                    const f32x4 w4 = *(const f32x4*)(nwp + col), sh = *(const f32x4*)(md + col), sc = *(const f32x4*)(md + 1024 + col);
                    const f32x4 o = v[q][j] * rstd * w4 * (1.f + sc) + sh;
                    u32x2 pk; pk.x = pk2(o.x, o.y); pk.y = pk2(o.z, o.w);
                    *(u32x2*)(H + (size_t)row * 1024 + col) = pk;
                }
            } }
    }
}

constexpr int G_STAGE = 65536, G_AB = 32768;
__device__ __forceinline__ void gemm_core(const bf16_t* __restrict__ A, int lda, const bf16_t* __restrict__ Bt, int ldb, int K, f32x4 (&acc)[8][4], unsigned char* smem, int tid) {
    asm volatile("" : "+v"(tid));
    const int lane = tid & 63, w = __builtin_amdgcn_readfirstlane(tid >> 6), wm = w >> 2, wn = w & 3, idx = lane & 15, kq = lane >> 4;
    unsigned offA[4], offB[4];
#pragma unroll
    for (int j = 0; j < 4; ++j) { const int row = (j * 8 + w) * 8 + (lane >> 3), c = (lane & 7) ^ ((row >> 1) & 7);
        offA[j] = (unsigned)(row * lda + c * 8) * 2u; offB[j] = (unsigned)(row * ldb + c * 8) * 2u; }
#pragma unroll
    for (int mi = 0; mi < 8; ++mi)
#pragma unroll
        for (int ni = 0; ni < 4; ++ni) acc[mi][ni] = (f32x4){0.f, 0.f, 0.f, 0.f};
    LDSAS unsigned char* lds = (LDSAS unsigned char*)smem;
#define G_ISSUE1(kt, st, j) do { \
        __builtin_amdgcn_global_load_lds((const unsigned*)((const char*)A + offA[j] + (kt) * 128), (LDSAS unsigned*)(lds + (st) * G_STAGE + ((j) * 8 + w) * 1024), 16, 0, 0); \
        __builtin_amdgcn_global_load_lds((const unsigned*)((const char*)Bt + offB[j] + (kt) * 128), (LDSAS unsigned*)(lds + (st) * G_STAGE + G_AB + ((j) * 8 + w) * 1024), 16, 0, 0); } while (0)
#define G_ISSUE(kt, st) do { G_ISSUE1(kt, st, 0); G_ISSUE1(kt, st, 1); G_ISSUE1(kt, st, 2); G_ISSUE1(kt, st, 3); } while (0)
    const int nk = K >> 6;
    G_ISSUE(0, 0);
    asm volatile("s_waitcnt vmcnt(0)" ::: "memory");
    __syncthreads();
    const int swz = (idx >> 1) & 7;
    const int aoff = (wm * 128 + idx) * 128, boff = G_AB + (wn * 64 + idx) * 128;
    for (int kt = 0; kt < nk; ++kt) {
        const int st = kt & 1;
        const bool more = kt + 1 < nk;
        const unsigned char* sb = smem + st * G_STAGE;
#pragma unroll
        for (int ks = 0; ks < 2; ++ks) {
            bf16x8 bfr[4], af[8];
            const int co = ((ks * 4 + kq) ^ swz) * 16;
#pragma unroll
            for (int ni = 0; ni < 4; ++ni) bfr[ni] = *(const bf16x8*)(sb + boff + ni * 2048 + co);
#pragma unroll
            for (int mi = 0; mi < 8; ++mi) af[mi] = *(const bf16x8*)(sb + aoff + mi * 2048 + co);
            if (more) { G_ISSUE1(kt + 1, st ^ 1, ks * 2); G_ISSUE1(kt + 1, st ^ 1, ks * 2 + 1); }
            __builtin_amdgcn_sched_barrier(0);
            __builtin_amdgcn_s_setprio(1);
#pragma unroll
            for (int mi = 0; mi < 8; ++mi)
#pragma unroll
                for (int ni = 0; ni < 4; ++ni) acc[mi][ni] = __builtin_amdgcn_mfma_f32_16x16x32_bf16(bfr[ni], af[mi], acc[mi][ni], 0, 0, 0);
            __builtin_amdgcn_s_setprio(0);
            __builtin_amdgcn_sched_barrier(0);
        }
        asm volatile("s_waitcnt vmcnt(0)" ::: "memory");
        __syncthreads();
    }
#undef G_ISSUE1
#undef G_ISSUE
}

__device__ __forceinline__ void st4bf(bf16_t* dst, f32x4 v) { u32x2 pk; pk.x = pk2(v.x, v.y); pk.y = pk2(v.z, v.w); *(u32x2*)dst = pk; }

__device__ void gemm1_phase(const Params& p, int l, int hb, unsigned char* smem) {
    const bf16_t* H = (const bf16_t*)(p.ws + WS_H);
    const bf16_t* Wt = (const bf16_t*)(p.ws + WS_WIN) + (size_t)l * NP * 1024;
    const float* ropec = (const float*)(p.ws + WS_ROPE); const float* ropes = ropec + 2048;
    constexpr int NT = 34, NTILES = 64 * NT, GRP = 8 * NT;
    for (int t = blockIdx.x; t < NTILES; t += gridDim.x) {
        const int grp = t / GRP, r = t % GRP, jx = NT * (r & 7) + (r >> 3), mt = grp * 8 + (jx & 7), nt = jx >> 3;
        const int m0 = mt * 256, n0 = nt * 256;
        f32x4 acc[8][4];
        int tid = threadIdx.x;
        gemm_core(H + (size_t)m0 * 1024, 1024, Wt + (size_t)n0 * 1024, 1024, 1024, acc, smem, tid);
        asm volatile("" : "+v"(tid));
        const int lane = tid & 63, w = __builtin_amdgcn_readfirstlane(tid >> 6), wm = w >> 2, wn = w & 3, idx = lane & 15, kq = lane >> 4;
        const int cw = n0 + wn * 64;
        const int lc = 4 * kq;
        unsigned char* wl = smem + w * 16384;
#define G1_STG(mi_, ni_, v_) do { const int r_ = (mi_) * 16 + idx; const f32x4 t_ = (v_); u32x2 pk_; pk_.x = pk2(t_.x, t_.y); pk_.y = pk2(t_.z, t_.w); \
        *(u32x2*)(wl + r_ * 128 + ((((ni_) * 2 + (kq >> 1)) ^ (r_ & 7)) * 16) + (kq & 1) * 8) = pk_; } while (0)
        bf16_t* dbase = nullptr; int dpitch = 0, dc0 = 0, dsh = -1, dg = 0;
        if (cw < 768 && (cw < 640)) {
            const bool isq = cw < 512;
            const float* nwp = (isq ? p.q_norm_a : p.k_norm_a) + l * 64;
            dbase = isq ? (bf16_t*)(p.ws + WS_QA) : (bf16_t*)(p.ws + WS_KA);
            dpitch = isq ? 512 : 128; dc0 = isq ? cw : cw - 512;
            const float qs = isq ? 0.125f * LOG2E : 1.f;
#pragma unroll
            for (int mi = 0; mi < 8; ++mi) {
                const int row = m0 + wm * 128 + mi * 16 + idx;
                float ss = 0.f;
#pragma unroll
                for (int ni = 0; ni < 4; ++ni) { const f32x4 v = acc[mi][ni]; ss += v.x * v.x + v.y * v.y + v.z * v.z + v.w * v.w; }
                ss += __shfl_xor(ss, 16); ss += __shfl_xor(ss, 32);
                const float rstd = rsqrtf(ss * (1.f / 64.f) + EPS);
                f32x4 y[4];
#pragma unroll
                for (int ni = 0; ni < 4; ++ni) y[ni] = acc[mi][ni] * rstd * *(const f32x4*)(nwp + ni * 16 + lc);
                const int tt = row & (SEQ - 1), prow = tt >> 6, pcol = tt & 63;
#pragma unroll
                for (int hf = 0; hf < 2; ++hf) {
                    const int pos = hf ? pcol : prow;
                    const f32x4 cs = *(const f32x4*)(ropec + pos * 16 + lc), sn = *(const f32x4*)(ropes + pos * 16 + lc);
                    const f32x4 a = y[2 * hf], b = y[2 * hf + 1];
                    y[2 * hf] = a * cs - b * sn; y[2 * hf + 1] = b * cs + a * sn;
                }
#pragma unroll
                for (int ni = 0; ni < 4; ++ni) G1_STG(mi, ni, y[ni] * qs);
            }
        } else if (cw >= 1280 && cw < 2816) {
            const bool isq = cw < 2048;
            const float* nwp = (isq ? p.q_norm_b : p.k_norm_b) + l * 64;
            const int gc = isq ? cw - 1280 : cw - 2048;
            dg = gc >> 8; dc0 = gc & 255; dsh = 2 * dg; dpitch = 256;
            dbase = (bf16_t*)(p.ws + (isq ? WS_QB : WS_KB));
            const float qs = isq ? 0.125f * LOG2E : 1.f;
#pragma unroll
            for (int mi = 0; mi < 8; ++mi) {
                float ss = 0.f;
#pragma unroll
                for (int ni = 0; ni < 4; ++ni) { const f32x4 v = acc[mi][ni]; ss += v.x * v.x + v.y * v.y + v.z * v.z + v.w * v.w; }
                ss += __shfl_xor(ss, 16); ss += __shfl_xor(ss, 32);
                const float rstd = rsqrtf(ss * (1.f / 64.f) + EPS) * qs;
#pragma unroll
                for (int ni = 0; ni < 4; ++ni) G1_STG(mi, ni, acc[mi][ni] * rstd * *(const f32x4*)(nwp + ni * 16 + lc));
            }
        } else if (cw >= 2816 && cw < 3584) {
            const int gc = cw - 2816;
            dg = gc >> 8; dc0 = gc & 255; dsh = 2 * dg; dpitch = 256; dbase = (bf16_t*)(p.ws + WS_VB);
#pragma unroll
            for (int mi = 0; mi < 8; ++mi)
#pragma unroll
                for (int ni = 0; ni < 4; ++ni) G1_STG(mi, ni, acc[mi][ni]);
        } else if (cw >= 8448) {
            if (cw == 8448) {
                float* dst = (float*)(p.ws + WS_DT);
                const f32x4 bias = *(const f32x4*)(p.dt_bias + l * 16 + lc);
#pragma unroll
                for (int mi = 0; mi < 8; ++mi) {
                    const int row = m0 + wm * 128 + mi * 16 + idx;
                    f32x4 v = acc[mi][0] + bias, o;
                    o.x = v.x > 20.f ? v.x : log1pf(__expf(v.x)); o.y = v.y > 20.f ? v.y : log1pf(__expf(v.y));
                    o.z = v.z > 20.f ? v.z : log1pf(__expf(v.z)); o.w = v.w > 20.f ? v.w : log1pf(__expf(v.w));
                    *(f32x4*)(dst + (size_t)row * 16 + lc) = o;
                }
            }
        } else {
            int mode;
            if (cw < 768) { dbase = (bf16_t*)(p.ws + WS_VA); dpitch = 128; dc0 = cw - 640; mode = 0; }
            else if (cw < 1280) { dbase = (bf16_t*)(p.ws + WS_GA); dpitch = 512; dc0 = cw - 768; mode = 1; }
            else if (cw < 3840) { dbase = (bf16_t*)(p.ws + WS_GB); dpitch = 256; dc0 = cw - 3584; mode = 1; }
            else if (cw < 4864) { dbase = (bf16_t*)(p.ws + WS_XBC); dpitch = 1024; dc0 = cw - 3840; mode = 0; }
            else if (cw < 5376) { dbase = (bf16_t*)(p.ws + WS_ZS); dpitch = 512; dc0 = cw - 4864; mode = 1; }
            else { dbase = (bf16_t*)(p.ws + WS_MG); dpitch = 3072; dc0 = cw - 5376; mode = 2; }
            const float* bg = p.b_gate + l * 3072 + dc0 + lc;
#pragma unroll
            for (int mi = 0; mi < 8; ++mi) {
#pragma unroll
                for (int ni = 0; ni < 4; ++ni) {
                    f32x4 v = acc[mi][ni];
                    if (mode == 1) { v.x = siluf(v.x); v.y = siluf(v.y); v.z = siluf(v.z); v.w = siluf(v.w); }
                    else if (mode == 2) { const f32x4 bb = *(const f32x4*)(bg + ni * 16); v.x = sigmf(v.x + bb.x); v.y = sigmf(v.y + bb.y); v.z = sigmf(v.z + bb.z); v.w = sigmf(v.w + bb.w); }
                    G1_STG(mi, ni, v);
                }
            }
        }
#undef G1_STG
        if (dbase) {
            const int ch = lane & 7;
#pragma unroll
            for (int j = 0; j < 16; ++j) {
                const int rl = 8 * j + (lane >> 3), row = m0 + wm * 128 + rl;
                const u32x4 v = *(const u32x4*)(wl + rl * 128 + ((ch ^ (rl & 7)) * 16));
                size_t drow = (size_t)row;
                if (dsh >= 0) { const int bl = row >> 13, tt = row & (SEQ - 1); drow = (size_t)(bl * 3 + dg) * SEQ + (size_t)((tt & ((1 << dsh) - 1)) * (SEQ >> dsh) + (tt >> dsh)); }
                *(u32x4*)(dbase + drow * dpitch + dc0 + ch * 8) = v;
            }
        }
        __syncthreads();
    }
}

__device__ void merge_phase(const Params& p, int l, unsigned char* smem) {
    const bf16_t* MG = (const bf16_t*)(p.ws + WS_MG);
    const float* rstd = (const float*)(p.ws + WS_RSTD);
    bf16_t* MR = (bf16_t*)(p.ws + WS_MRG);
    for (int t = blockIdx.x; t < 64 * 4; t += gridDim.x) {
        const int xq = t >> 3, mt = (xq >> 2) * 8 + (t & 7), nt = xq & 3, m0 = mt * 256, n0 = nt * 256;
#pragma unroll 1
        for (int br = 0; br < 3; ++br) {
            f32x4 acc[8][4];
            const bf16_t* A; const bf16_t* Bt; int K;
            if (br == 0) { A = (const bf16_t*)(p.ws + WS_QA); K = 512; Bt = (const bf16_t*)(p.ws + WS_WPA) + (size_t)l * 1024 * 512; }
            else if (br == 1) { A = (const bf16_t*)(p.ws + WS_YBM); K = 256; Bt = (const bf16_t*)(p.ws + WS_WPB) + (size_t)l * 1024 * 256; }
            else { A = (const bf16_t*)(p.ws + WS_YC); K = 512; Bt = (const bf16_t*)(p.ws + WS_WPC) + (size_t)l * 1024 * 512; }
            int tid = threadIdx.x;
            gemm_core(A + (size_t)m0 * K, K, Bt + (size_t)n0 * K, K, K, acc, smem, tid);
            asm volatile("" : "+v"(tid));
            const int lane = tid & 63, w = tid >> 6, wm = w >> 2, wn = w & 3, idx = lane & 15, kq = lane >> 4;
#pragma unroll
            for (int mi = 0; mi < 8; ++mi) {
                const int row = m0 + wm * 128 + mi * 16 + idx;
                const float rs = (br == 2) ? rstd[row] : 1.f;
#pragma unroll
                for (int ni = 0; ni < 4; ++ni) {
                    const int col = n0 + wn * 64 + ni * 16 + 4 * kq;
                    const u32x2 g = *(const u32x2*)(MG + (size_t)row * 3072 + br * 1024 + col);
                    f32x4 gv; gv.x = bflo(g.x); gv.y = bfhi(g.x); gv.z = bflo(g.y); gv.w = bfhi(g.y);
                    f32x4 v = gv * rs * acc[mi][ni];
                    bf16_t* mp = MR + (size_t)row * 1024 + col;
                    if (br > 0) { const u32x2 o = *(const u32x2*)mp; v.x += bflo(o.x); v.y += bfhi(o.x); v.z += bflo(o.y); v.w += bfhi(o.y); }
                    st4bf(mp, v);
                }
            }
        }
    }
}

__device__ void out_phase(const Params& p, int l, int hb, const float* xsrc, unsigned char* smem) {
    const bf16_t* MR = (const bf16_t*)(p.ws + WS_MRG);
    const bf16_t* Wt = (const bf16_t*)(p.ws + WS_WOUT) + (size_t)l * 1024 * 1024;
    for (int t = blockIdx.x; t < 64 * 4; t += gridDim.x) {
        const int xq = t >> 3, mt = (xq >> 2) * 8 + (t & 7), nt = xq & 3, m0 = mt * 256, n0 = nt * 256;
        f32x4 acc[8][4];
        int tid = threadIdx.x;
        gemm_core(MR + (size_t)m0 * 1024, 1024, Wt + (size_t)n0 * 1024, 1024, 1024, acc, smem, tid);
        asm volatile("" : "+v"(tid));
        const int lane = tid & 63, w = tid >> 6, wm = w >> 2, wn = w & 3, idx = lane & 15, kq = lane >> 4;
#pragma unroll
        for (int mi = 0; mi < 8; ++mi) {
            const int row = m0 + wm * 128 + mi * 16 + idx; const size_t rg = (size_t)hb * TP + row; const int b = (int)(rg / SEQ);
            const float* gate = (const float*)(p.ws + WS_MOD) + (size_t)(l * 4 + b) * 3072 + 2048;
#pragma unroll
            for (int ni = 0; ni < 4; ++ni) {
                const int col = n0 + wn * 64 + ni * 16 + 4 * kq;
                const f32x4 xv = *(const f32x4*)(xsrc + rg * 1024 + col), gv = *(const f32x4*)(gate + col);
                *(f32x4*)(p.out + rg * 1024 + col) = xv + gv * acc[mi][ni];
            }
        }
    }
}

constexpr int AT_KS = 0, AT_VS = 9216, AT_LQ = 9216 + 8192, AT_LUT = AT_LQ + 512;

#define AT_STAGE_STORE() do { _Pragma("unroll") for (int i = 0; i < 2; ++i) { const int c = tid + 256 * i, row = c >> 3, ch = c & 7; \
        *(u32x4*)(Ks + row * 72 + ch * 8) = rk[i]; *(u32x4*)(Vs + (ch >> 2) * 4096 + row * 64 + (ch & 3) * 16) = rv[i]; } } while (0)

__device__ __forceinline__ void at_qk(f32x16& p0, f32x16& p1, const bf16_t* Ks, const bf16x8* qr, int r32, int hi) {
    bf16x8 kf[8];
#pragma unroll
    for (int ds = 0; ds < 4; ++ds) {
        kf[2 * ds] = *(const bf16x8*)(Ks + r32 * 72 + ds * 16 + hi * 8);
        kf[2 * ds + 1] = *(const bf16x8*)(Ks + (r32 + 32) * 72 + ds * 16 + hi * 8);
    }
    __builtin_amdgcn_sched_barrier(0);
    __builtin_amdgcn_s_setprio(1);
#pragma unroll
    for (int ds = 0; ds < 4; ++ds) {
        p0 = __builtin_amdgcn_mfma_f32_32x32x16_bf16(kf[2 * ds], qr[ds], p0, 0, 0, 0);
        p1 = __builtin_amdgcn_mfma_f32_32x32x16_bf16(kf[2 * ds + 1], qr[ds], p1, 0, 0, 0);
    }
    __builtin_amdgcn_s_setprio(0);
    __builtin_amdgcn_sched_barrier(0);
}
__device__ __forceinline__ void at_pv(f32x16& o0, f32x16& o1, const f32x16& p0, const f32x16& p1, const unsigned char* Vs, int lane) {
    const int hi = lane >> 5;
    const unsigned char* vb = Vs + ((lane >> 4) & 1) * 32 + (lane & 3) * 8 + (4 * hi + ((lane & 15) >> 2)) * 64;
    bf16x8 v0[4], v1[4], pa[4];
#pragma unroll
    for (int s = 0; s < 4; ++s) {
        v0[s] = cat8(tr16(vb + s * 1024), tr16(vb + s * 1024 + 512));
        v1[s] = cat8(tr16(vb + 4096 + s * 1024), tr16(vb + 4096 + s * 1024 + 512));
    }
#pragma unroll
    for (int s = 0; s < 4; ++s) {
        u32x4 pw;
        if (s < 2) { pw.x = pk2(p0[8 * s + 0], p0[8 * s + 1]); pw.y = pk2(p0[8 * s + 2], p0[8 * s + 3]); pw.z = pk2(p0[8 * s + 4], p0[8 * s + 5]); pw.w = pk2(p0[8 * s + 6], p0[8 * s + 7]); }
        else { const int q = s - 2; pw.x = pk2(p1[8 * q + 0], p1[8 * q + 1]); pw.y = pk2(p1[8 * q + 2], p1[8 * q + 3]); pw.z = pk2(p1[8 * q + 4], p1[8 * q + 5]); pw.w = pk2(p1[8 * q + 6], p1[8 * q + 7]); }
        pa[s] = __builtin_bit_cast(bf16x8, pw);
    }
    __builtin_amdgcn_sched_barrier(0);
    __builtin_amdgcn_s_setprio(1);
#pragma unroll
    for (int s = 0; s < 4; ++s) {
        o0 = __builtin_amdgcn_mfma_f32_32x32x16_bf16(pa[s], v0[s], o0, 0, 0, 0);
        o1 = __builtin_amdgcn_mfma_f32_32x32x16_bf16(pa[s], v1[s], o1, 0, 0, 0);
    }
    __builtin_amdgcn_s_setprio(0);
    __builtin_amdgcn_sched_barrier(0);
}

__device__ __forceinline__ void at_ldv(bf16x8 (&v0)[4], bf16x8 (&v1)[4], const unsigned char* Vs, int lane) {
    const int hi = lane >> 5;
    const unsigned char* vb = Vs + ((lane >> 4) & 1) * 32 + (lane & 3) * 8 + (4 * hi + ((lane & 15) >> 2)) * 64;
#pragma unroll
    for (int s = 0; s < 4; ++s) {
        v0[s] = cat8(tr16(vb + s * 1024), tr16(vb + s * 1024 + 512));
        v1[s] = cat8(tr16(vb + 4096 + s * 1024), tr16(vb + 4096 + s * 1024 + 512));
    }
}
__device__ __forceinline__ void at_pv2(f32x16& o0, f32x16& o1, const f32x16& p0, const f32x16& p1, const bf16x8 (&v0)[4], const bf16x8 (&v1)[4]) {
    bf16x8 pa[4];
#pragma unroll
    for (int s = 0; s < 4; ++s) {
        u32x4 pw;
        if (s < 2) { pw.x = pk2(p0[8 * s + 0], p0[8 * s + 1]); pw.y = pk2(p0[8 * s + 2], p0[8 * s + 3]); pw.z = pk2(p0[8 * s + 4], p0[8 * s + 5]); pw.w = pk2(p0[8 * s + 6], p0[8 * s + 7]); }
        else { const int q = s - 2; pw.x = pk2(p1[8 * q + 0], p1[8 * q + 1]); pw.y = pk2(p1[8 * q + 2], p1[8 * q + 3]); pw.z = pk2(p1[8 * q + 4], p1[8 * q + 5]); pw.w = pk2(p1[8 * q + 6], p1[8 * q + 7]); }
        pa[s] = __builtin_bit_cast(bf16x8, pw);
    }
    __builtin_amdgcn_sched_barrier(0);
    __builtin_amdgcn_s_setprio(1);
#pragma unroll
    for (int s = 0; s < 4; ++s) {
        o0 = __builtin_amdgcn_mfma_f32_32x32x16_bf16(pa[s], v0[s], o0, 0, 0, 0);
        o1 = __builtin_amdgcn_mfma_f32_32x32x16_bf16(pa[s], v1[s], o1, 0, 0, 0);
    }
    __builtin_amdgcn_s_setprio(0);
    __builtin_amdgcn_sched_barrier(0);
}

constexpr int ATA_STAGE = 17408, ATA_LQ = 2 * ATA_STAGE;
__device__ void attn_a_item(const Params& p, int item, int l, unsigned char* smem) {
    int tid_ = VTID; asm volatile("" : "+v"(tid_));
    const int tid = tid_, lane = tid & 63, w = tid >> 6, r32 = lane & 31, hi = lane >> 5;
    const int b = item >> 9, r = item & 511, kvh = r >> 8, qblk = (r >> 2) & 63, hq = kvh * 4 + (r & 3);
    float* lq = (float*)(smem + ATA_LQ) + w * 32;
    bf16_t* QA = (bf16_t*)(p.ws + WS_QA);
    const bf16_t* GA = (const bf16_t*)(p.ws + WS_GA);
    const size_t tokq = (size_t)b * SEQ + qblk * 128 + w * 32;
    bf16x8 qr[4];
#pragma unroll
    for (int ds = 0; ds < 4; ++ds) qr[ds] = *(const bf16x8*)(QA + (tokq + r32) * 512 + hq * 64 + ds * 16 + hi * 8);
    const bf16_t* Kb = (const bf16_t*)(p.ws + WS_KA) + (size_t)b * SEQ * 128 + kvh * 64;
    const bf16_t* Vb = (const bf16_t*)(p.ws + WS_VA) + (size_t)b * SEQ * 128 + kvh * 64;
    const float nshift = -((const float*)(p.ws + WS_BND))[l];
    f32x16 o0, o1;
#pragma unroll
    for (int i = 0; i < 16; ++i) { o0[i] = 0.f; o1[i] = 0.f; }
    f32x4 la4 = (f32x4){0.f, 0.f, 0.f, 0.f};
    constexpr int NT = SEQ / 64;
    const int row0 = tid >> 3, ch0 = tid & 7;
    const size_t goff0 = (size_t)row0 * 128 + ch0 * 8, goff1 = goff0 + (size_t)32 * 128;
    const int ko0 = row0 * 144 + ch0 * 16, ko1 = ko0 + 32 * 144;
    const int vo0 = 9216 + (ch0 >> 2) * 4096 + row0 * 64 + (ch0 & 3) * 16, vo1 = vo0 + 32 * 64;
    u32x4 rkA[2], rvA[2], rkB[2], rvB[2];
#define ATA_LOAD(RK, RV, t) do { const size_t tb = (size_t)(t) * 64 * 128; RK[0] = *(const u32x4*)(Kb + tb + goff0); RK[1] = *(const u32x4*)(Kb + tb + goff1); \
        RV[0] = *(const u32x4*)(Vb + tb + goff0); RV[1] = *(const u32x4*)(Vb + tb + goff1); } while (0)
#define ATA_STORE(RK, RV, st) do { unsigned char* sb_ = smem + (st) * ATA_STAGE; *(u32x4*)(sb_ + ko0) = RK[0]; *(u32x4*)(sb_ + ko1) = RK[1]; \
        *(u32x4*)(sb_ + vo0) = RV[0]; *(u32x4*)(sb_ + vo1) = RV[1]; } while (0)
#define ATA_COMPUTE(st) do { const unsigned char* sb_ = smem + (st) * ATA_STAGE; f32x16 p0, p1; bf16x8 vf0[4], vf1[4]; \
        _Pragma("unroll") for (int i = 0; i < 16; ++i) { p0[i] = nshift; p1[i] = nshift; } \
        at_qk(p0, p1, (const bf16_t*)sb_, qr, r32, hi); \
        at_ldv(vf0, vf1, sb_ + 9216, lane); __builtin_amdgcn_sched_barrier(0); \
        _Pragma("unroll") for (int i = 0; i < 16; ++i) { p0[i] = __builtin_amdgcn_exp2f(p0[i]); p1[i] = __builtin_amdgcn_exp2f(p1[i]); } \
        _Pragma("unroll") for (int i = 0; i < 4; ++i) { la4 += (f32x4){p0[4 * i], p0[4 * i + 1], p0[4 * i + 2], p0[4 * i + 3]}; la4 += (f32x4){p1[4 * i], p1[4 * i + 1], p1[4 * i + 2], p1[4 * i + 3]}; } \
        at_pv2(o0, o1, p0, p1, vf0, vf1); } while (0)
    __syncthreads();
    ATA_LOAD(rkA, rvA, 0); ATA_LOAD(rkB, rvB, 1);
    ATA_STORE(rkA, rvA, 0);
    ATA_LOAD(rkA, rvA, 2);
    __syncthreads();
    for (int kt = 0; kt < NT; kt += 2) {
        ATA_COMPUTE(0);
        ATA_STORE(rkB, rvB, 1);
        if (kt + 3 < NT) ATA_LOAD(rkB, rvB, kt + 3);
        __syncthreads();
        ATA_COMPUTE(1);
        if (kt + 2 < NT) { ATA_STORE(rkA, rvA, 0); if (kt + 4 < NT) ATA_LOAD(rkA, rvA, kt + 4); }
        __syncthreads();
    }
#undef ATA_LOAD
#undef ATA_STORE
#undef ATA_COMPUTE
    float lacc = (la4.x + la4.y) + (la4.z + la4.w);
    lacc += __shfl_xor(lacc, 32);
    if (hi == 0) lq[r32] = lacc;
    asm volatile("s_waitcnt lgkmcnt(0)" ::: "memory");
#pragma unroll
    for (int rr = 0; rr < 16; ++rr) {
        const int q = crow(rr, hi); const float inv = 1.f / lq[q];
        const size_t off = (tokq + q) * 512 + hq * 64 + r32;
        const float g0 = bf2f(GA[off]), g1 = bf2f(GA[off + 32]);
        QA[off] = (bf16_t)(pk2(o0[rr] * inv * g0, 0.f) & 0xffffu);
        QA[off + 32] = (bf16_t)(pk2(o1[rr] * inv * g1, 0.f) & 0xffffu);
    }
}

__device__ void attn_b_item(const Params& p, int item, int l, unsigned char* smem) {
    int tid_ = VTID; asm volatile("" : "+v"(tid_));
    const int tid = tid_, lane = tid & 63, w = tid >> 6, r32 = lane & 31, hi = lane >> 5;
    const int blk = item & 63, j = (item >> 6) & 3, bg = item >> 8, g = bg % 3, b = bg / 3;
    const int sh = 2 * g, dil = 1 << sh, Mlen = SEQ >> sh;
    bf16_t* Ks = (bf16_t*)(smem + AT_KS); unsigned char* Vs = smem + AT_VS; float* lq = (float*)(smem + AT_LQ) + w * 32; float* lut = (float*)(smem + AT_LUT);
    bf16_t* QB = (bf16_t*)(p.ws + WS_QB) + (size_t)bg * SEQ * 256 + j * 64;
    const bf16_t* KB = (const bf16_t*)(p.ws + WS_KB) + (size_t)bg * SEQ * 256 + j * 64;
    const bf16_t* VB = (const bf16_t*)(p.ws + WS_VB) + (size_t)bg * SEQ * 256 + j * 64;
    float* LSE = (float*)(p.ws + WS_LSE) + (size_t)bg * SEQ * 4 + j;
    const int p0r = blk * 128, seq_lo = (p0r / Mlen) * Mlen, seq_hi = seq_lo + Mlen;
    __syncthreads();
    if (tid < 129) {
        const int rel = tid - 64, n = (rel < 0 ? -rel : rel) * dil;
        int bk;
        if (n < 8) bk = n; else { bk = 8 + (n >= 15) + (n >= 27) + (n >= 50) + (n >= 91) + (n >= 166) + (n >= 305) + (n >= 559); }
        if (rel > 0) bk += 16;
        lut[tid] = p.rel_bias[bk * 12 + g * 4 + j] * LOG2E;
    }
    const int qpos = p0r + w * 32 + r32;
    bf16x8 qr[4];
#pragma unroll
    for (int ds = 0; ds < 4; ++ds) qr[ds] = *(const bf16x8*)(QB + (size_t)qpos * 256 + ds * 16 + hi * 8);
    const float nshift = -((const float*)(p.ws + WS_BND))[2 + l];
    f32x16 o0, o1;
#pragma unroll
    for (int i = 0; i < 16; ++i) { o0[i] = 0.f; o1[i] = 0.f; }
    f32x4 la4 = (f32x4){0.f, 0.f, 0.f, 0.f};
    u32x4 rk[2], rv[2];
    for (int kt = 0; kt < 4; ++kt) {
        const int kbase = p0r - 64 + 64 * kt;
#pragma unroll
        for (int i = 0; i < 2; ++i) { const int c = tid + 256 * i, row = c >> 3, ch = c & 7;
            int pr = kbase + row; pr = pr < 0 ? 0 : (pr > SEQ - 1 ? SEQ - 1 : pr);
            rk[i] = *(const u32x4*)(KB + (size_t)pr * 256 + ch * 8); rv[i] = *(const u32x4*)(VB + (size_t)pr * 256 + ch * 8); }
        __syncthreads();
        AT_STAGE_STORE();
        __syncthreads();
        f32x16 p0, p1;
#pragma unroll
        for (int i = 0; i < 16; ++i) { p0[i] = nshift; p1[i] = nshift; }
        at_qk(p0, p1, Ks, qr, r32, hi);
#pragma unroll
        for (int i = 0; i < 16; ++i) {
            const int kv0 = kbase + crow(i, hi), kv1 = kv0 + 32;
            const int rel0 = kv0 - qpos, rel1 = kv1 - qpos;
            const bool ok0 = rel0 >= -64 && rel0 <= 64 && kv0 >= seq_lo && kv0 < seq_hi;
            const bool ok1 = rel1 >= -64 && rel1 <= 64 && kv1 >= seq_lo && kv1 < seq_hi;
            const float e0 = __builtin_amdgcn_exp2f(p0[i] + lut[ok0 ? rel0 + 64 : 64]);
            const float e1 = __builtin_amdgcn_exp2f(p1[i] + lut[ok1 ? rel1 + 64 : 64]);
            p0[i] = ok0 ? e0 : 0.f; p1[i] = ok1 ? e1 : 0.f;
        }
#pragma unroll
        for (int i = 0; i < 4; ++i) { la4 += (f32x4){p0[4 * i], p0[4 * i + 1], p0[4 * i + 2], p0[4 * i + 3]}; la4 += (f32x4){p1[4 * i], p1[4 * i + 1], p1[4 * i + 2], p1[4 * i + 3]}; }
        at_pv(o0, o1, p0, p1, Vs, lane);
    }
    float lacc = (la4.x + la4.y) + (la4.z + la4.w);
    lacc += __shfl_xor(lacc, 32);
    if (hi == 0) { lq[r32] = lacc; LSE[(size_t)qpos * 4] = (-nshift + log2f(lacc)) * LN2; }
    asm volatile("s_waitcnt lgkmcnt(0)" ::: "memory");
#pragma unroll
    for (int rr = 0; rr < 16; ++rr) {
        const int q = crow(rr, hi); const float inv = 1.f / lq[q];
        const size_t off = (size_t)(p0r + w * 32 + q) * 256 + r32;
        QB[off] = (bf16_t)(pk2(o0[rr] * inv, 0.f) & 0xffffu);
        QB[off + 32] = (bf16_t)(pk2(o1[rr] * inv, 0.f) & 0xffffu);
    }
}

__device__ void conv_phase(const Params& p, int l) {
    int tx_ = threadIdx.x; asm volatile("" : "+v"(tx_));
    const bf16_t* XBC = (const bf16_t*)(p.ws + WS_XBC);
    bf16_t* XC = (bf16_t*)(p.ws + WS_XBCC);
    const float* cw = p.conv_w + (size_t)l * 5 * 1024; const float* cb = p.conv_b + l * 1024;
    const int nthr = gridDim.x * 512;
    for (int u = blockIdx.x * 512 + tx_; u < (TP / 4) * 128; u += nthr) {
        const int ch = (u & 127) * 8, tg = u >> 7, tok0 = tg * 4, tt0 = tok0 & (SEQ - 1);
        u32x4 raw[8];
#pragma unroll
        for (int r = 0; r < 8; ++r) { const int tt = tt0 - 2 + r; raw[r] = (u32x4){0u, 0u, 0u, 0u};
            if (tt >= 0 && tt < SEQ) raw[r] = *(const u32x4*)(XBC + (size_t)(tok0 - 2 + r) * 1024 + ch); }
        float ac[4][8];
        { const f32x4 a = *(const f32x4*)(cb + ch), b2 = *(const f32x4*)(cb + ch + 4);
#pragma unroll
          for (int t = 0; t < 4; ++t) { ac[t][0] = a.x; ac[t][1] = a.y; ac[t][2] = a.z; ac[t][3] = a.w; ac[t][4] = b2.x; ac[t][5] = b2.y; ac[t][6] = b2.z; ac[t][7] = b2.w; } }
#pragma unroll
        for (int k = 0; k < 5; ++k) { const f32x4 wa = *(const f32x4*)(cw + k * 1024 + ch), wb = *(const f32x4*)(cw + k * 1024 + ch + 4);
#pragma unroll
            for (int t = 0; t < 4; ++t) { const u32x4 v = raw[t + k];
                ac[t][0] += bflo(v.x) * wa.x; ac[t][1] += bfhi(v.x) * wa.y; ac[t][2] += bflo(v.y) * wa.z; ac[t][3] += bfhi(v.y) * wa.w;
                ac[t][4] += bflo(v.z) * wb.x; ac[t][5] += bfhi(v.z) * wb.y; ac[t][6] += bflo(v.w) * wb.z; ac[t][7] += bfhi(v.w) * wb.w; } }
#pragma unroll
        for (int t = 0; t < 4; ++t) { u32x4 o;
            o.x = pk2(siluf(ac[t][0]), siluf(ac[t][1])); o.y = pk2(siluf(ac[t][2]), siluf(ac[t][3])); o.z = pk2(siluf(ac[t][4]), siluf(ac[t][5])); o.w = pk2(siluf(ac[t][6]), siluf(ac[t][7]));
            *(u32x4*)(XC + (size_t)(tok0 + t) * 1024 + ch) = o; }
    }
}

constexpr int SS_BS = 0, SS_CS = 8704, SS_XS = 17408, SS_XWS = 22016, SS_GS = 26624, SS_SB = 29184, SS_CW = 46592, SS_SC = 54272, SS_DTA = 55296, SS_END = 57344;

template <int PASS>
__device__ void ssd_item(const Params& p, int item, int l, unsigned char* smem) {
    int tid_ = VTID; asm volatile("" : "+v"(tid_));
    const int tid = tid_, lane = tid & 63, w = tid >> 6, idx = lane & 15, kq = lane >> 4;
    const int seg = item & 15, h = (item >> 4) & 7, dir = (item >> 7) & 1, b = item >> 8, grp = h >> 2;
    bf16_t* Bs = (bf16_t*)(smem + SS_BS); bf16_t* Cs = (bf16_t*)(smem + SS_CS); bf16_t* Xs = (bf16_t*)(smem + SS_XS); bf16_t* Xws = (bf16_t*)(smem + SS_XWS);
    bf16_t* Gs = (bf16_t*)(smem + SS_GS); bf16_t* Sb = (bf16_t*)(smem + SS_SB); float* sc = (float*)(smem + SS_SC);
    float* s_cA = (float*)(smem + SS_CW), *s_rsA = s_cA + SEGLEN, *s_wlA = s_rsA + SEGLEN, *s_totA = sc;
    const bf16_t* XBC = (const bf16_t*)(p.ws + WS_XBC);
    const float* DT = (const float*)(p.ws + WS_DT);
    float* ST = (float*)(p.ws + WS_ST); float* SEGT = (float*)(p.ws + WS_SEGT);
    bf16_t* Y = (bf16_t*)(p.ws + (dir ? WS_YS : WS_YF));
    const float Aneg = -__expf(p.a_log[l * 16 + dir * 8 + h]);
    const float Dh = p.d_skip[l * 8 + h];
    __syncthreads();
    f32x4 S[8];
#pragma unroll
    for (int nt = 0; nt < 8; ++nt) S[nt] = (f32x4){0.f, 0.f, 0.f, 0.f};
    const int ibase = item & ~15;
    if (PASS == 3) {
        if (dir == 0) {
            for (int e = 0; e < seg; ++e) { const float dc = __expf(SEGT[ibase + e]); const f32x4* src = (const f32x4*)(ST + (size_t)(ibase + e) * 8192);
#pragma unroll
                for (int nt = 0; nt < 8; ++nt) S[nt] = S[nt] * dc + src[(w * 8 + nt) * 64 + lane]; }
        } else {
            for (int e = NSEG - 1; e > seg; --e) { const float dc = __expf(SEGT[ibase + e]); const f32x4* src = (const f32x4*)(ST + (size_t)(ibase + e) * 8192);
#pragma unroll
                for (int nt = 0; nt < 8; ++nt) S[nt] = S[nt] * dc + src[(w * 8 + nt) * 64 + lane]; }
        }
#pragma unroll
        for (int nt = 0; nt < 8; ++nt) st4bf(Sb + (16 * w + idx) * 136 + 16 * nt + 4 * kq, S[nt]);
    }
    float* s_dta = (float*)(smem + SS_DTA);
#pragma unroll
    for (int i = 0; i < SEGLEN / 256; ++i) {
        const int e = tid + 256 * i, l32 = lane & 31;
        const float dtv = DT[((size_t)b * SEQ + seg * SEGLEN + e) * 16 + dir * 8 + h], av = dtv * Aneg;
        float pre = av;
#pragma unroll
        for (int o = 1; o < 32; o <<= 1) { const float t = __shfl_up(pre, o, 32); if (l32 >= o) pre += t; }
        const float tot = __shfl(pre, 31, 32);
        const float cc = dir ? (tot - pre + av) : pre;
        s_dta[e] = dtv; s_cA[e] = cc; s_rsA[e] = __expf(cc); s_wlA[e] = dtv * __expf(tot - cc);
        if (l32 == 0) s_totA[e >> 5] = tot;
    }
    float segtot = 0.f;
    const size_t tokb = (size_t)b * SEQ;
    const unsigned char* xb_ = (const unsigned char*)((const bf16_t*)(p.ws + WS_XBCC) + tokb * 1024);
    unsigned soff[5];
#pragma unroll
    for (int i = 0; i < 5; ++i) { const int u = tid + 256 * i, lrow = u / 40, ci = u % 40;
        const int scol = ci < 8 ? h * 64 + ci * 8 : (ci < 24 ? 512 + grp * 128 + (ci * 8 - 64) : 768 + grp * 128 + (ci * 8 - 192));
        soff[i] = (unsigned)((lrow * 1024 + scol) * 2); }
    for (int si = 0; si < NSUB; ++si) {
        const int scn = dir ? (NSUB - 1 - si) : si;
        const int t0 = seg * SEGLEN + scn * TSUB;
        __syncthreads();
        u32x4 raw[5];
#pragma unroll
        for (int i = 0; i < 5; ++i) raw[i] = *(const u32x4*)(xb_ + ((unsigned)(t0 * 2048) + soff[i]));
        const float* s_dt = s_dta + scn * TSUB; const float* s_c = s_cA + scn * TSUB; const float* s_rs = s_rsA + scn * TSUB; const float* s_wl = s_wlA + scn * TSUB;
        const float stot = s_totA[scn];
        segtot += stot;
#pragma unroll
        for (int i = 0; i < 5; ++i) { const int u = tid + 256 * i, lrow = u / 40, ci = u % 40, lc = ci * 8; const u32x4 o = raw[i];
            if (ci < 8) { *(u32x4*)(Xs + lrow * 72 + lc) = o; const float wl = s_wl[lrow];
                u32x4 o2; o2.x = pk2(bflo(o.x) * wl, bfhi(o.x) * wl); o2.y = pk2(bflo(o.y) * wl, bfhi(o.y) * wl); o2.z = pk2(bflo(o.z) * wl, bfhi(o.z) * wl); o2.w = pk2(bflo(o.w) * wl, bfhi(o.w) * wl);
                *(u32x4*)(Xws + lrow * 72 + lc) = o2; }
            else if (ci < 24) *(u32x4*)(Bs + lrow * 136 + (lc - 64)) = o;
            else *(u32x4*)(Cs + lrow * 136 + (lc - 192)) = o; }
        __syncthreads();
        if (PASS == 3) {
            const int it = w >> 1, jt = w & 1;
            f32x4 cb = (f32x4){0.f, 0.f, 0.f, 0.f};
            {
                bf16x8 fb[4], fc[4];
#pragma unroll
                for (int ks = 0; ks < 4; ++ks) { fb[ks] = *(const bf16x8*)(Bs + (16 * jt + idx) * 136 + ks * 32 + kq * 8); fc[ks] = *(const bf16x8*)(Cs + (16 * it + idx) * 136 + ks * 32 + kq * 8); }
                __builtin_amdgcn_sched_barrier(0);
#pragma unroll
                for (int ks = 0; ks < 4; ++ks) cb = __builtin_amdgcn_mfma_f32_16x16x32_bf16(fb[ks], fc[ks], cb, 0, 0, 0);
                __builtin_amdgcn_sched_barrier(0);
            }
            {
                const int ii = 16 * it + idx; const float ci_ = s_c[ii];
                f32x4 gv;
#pragma unroll
                for (int rg = 0; rg < 4; ++rg) {
                    const int jj = 16 * jt + 4 * kq + rg;
                    const bool ok = dir ? (jj >= ii) : (jj <= ii);
                    const float e = __expf(ci_ - s_c[jj]) * s_dt[jj];
                    gv[rg] = ok ? cb[rg] * e : 0.f;
                }
                st4bf(Gs + ii * 40 + 16 * jt + 4 * kq, gv);
            }
            __syncthreads();
            const unsigned char* xtr = (const unsigned char*)Xs + (8 * kq + (idx >> 2)) * 144 + (16 * w + 4 * (idx & 3)) * 2;
            const bf16x8 xf = cat8(tr16(xtr), tr16(xtr + 4 * 144));
#pragma unroll 1
            for (int it2 = 0; it2 < 2; ++it2) {
                const int ii = 16 * it2 + idx;
                const bf16x8 gf = *(const bf16x8*)(Gs + ii * 40 + 8 * kq);
                f32x4 yd = (f32x4){0.f, 0.f, 0.f, 0.f}, yo = (f32x4){0.f, 0.f, 0.f, 0.f};
                bf16x8 sf[4], cf[4];
#pragma unroll
                for (int ks = 0; ks < 4; ++ks) { sf[ks] = *(const bf16x8*)(Sb + (16 * w + idx) * 136 + ks * 32 + kq * 8); cf[ks] = *(const bf16x8*)(Cs + ii * 136 + ks * 32 + kq * 8); }
                __builtin_amdgcn_sched_barrier(0);
                yd = __builtin_amdgcn_mfma_f32_16x16x32_bf16(xf, gf, yd, 0, 0, 0);
#pragma unroll
                for (int ks = 0; ks < 4; ++ks) yo = __builtin_amdgcn_mfma_f32_16x16x32_bf16(sf[ks], cf[ks], yo, 0, 0, 0);
                __builtin_amdgcn_sched_barrier(0);
                f32x4 y = yd + yo * s_rs[ii];
                if (dir == 0) { const u32x2 xv = *(const u32x2*)(Xs + ii * 72 + 16 * w + 4 * kq);
                    y.x += Dh * bflo(xv.x); y.y += Dh * bfhi(xv.x); y.z += Dh * bflo(xv.y); y.w += Dh * bfhi(xv.y); }
                st4bf(Y + (tokb + t0 + ii) * 512 + h * 64 + 16 * w + 4 * kq, y);
            }
        }
        {
            const float dc = __expf(stot);
            const unsigned char* xw = (const unsigned char*)Xws + (8 * kq + (idx >> 2)) * 144 + (16 * w + 4 * (idx & 3)) * 2;
            const bf16x8 xwf = cat8(tr16(xw), tr16(xw + 4 * 144));
            bf16x8 bfv[8];
#pragma unroll
            for (int nt = 0; nt < 8; ++nt) {
                const unsigned char* bt = (const unsigned char*)Bs + (8 * kq + (idx >> 2)) * 272 + (16 * nt + 4 * (idx & 3)) * 2;
                bfv[nt] = cat8(tr16(bt), tr16(bt + 4 * 272));
            }
            __builtin_amdgcn_sched_barrier(0);
#pragma unroll
            for (int nt = 0; nt < 8; ++nt) S[nt] = __builtin_amdgcn_mfma_f32_16x16x32_bf16(bfv[nt], xwf, S[nt] * dc, 0, 0, 0);
            __builtin_amdgcn_sched_barrier(0);
            if (PASS == 3) {
#pragma unroll
                for (int nt = 0; nt < 8; ++nt) st4bf(Sb + (16 * w + idx) * 136 + 16 * nt + 4 * kq, S[nt]);
            }
        }
    }
    if (PASS == 1) {
        f32x4* dst = (f32x4*)(ST + (size_t)item * 8192);
#pragma unroll
        for (int nt = 0; nt < 8; ++nt) dst[(w * 8 + nt) * 64 + lane] = S[nt];
        if (tid == 0) SEGT[item] = segtot;
    }
}

__device__ void post2_phase(const Params& p) {
    int tx_ = threadIdx.x; asm volatile("" : "+v"(tx_));
    const int lane = tx_ & 63, gw = blockIdx.x * 8 + (tx_ >> 6), nw = gridDim.x * 8;
    const bf16_t* OB = (const bf16_t*)(p.ws + WS_QB); const float* LSE = (const float*)(p.ws + WS_LSE);
    const bf16_t* GB = (const bf16_t*)(p.ws + WS_GB);
    bf16_t* YBM = (bf16_t*)(p.ws + WS_YBM);
    const bf16_t* YF = (const bf16_t*)(p.ws + WS_YF); const bf16_t* YS = (const bf16_t*)(p.ws + WS_YS); const bf16_t* ZS = (const bf16_t*)(p.ws + WS_ZS);
    bf16_t* YC = (bf16_t*)(p.ws + WS_YC); float* RS = (float*)(p.ws + WS_RSTD);
    constexpr int R = 4;
    for (int row0 = gw; row0 < TP; row0 += R * nw) {
        float ls[R][3]; u32x2 ov[R][3], gt[R]; u32x4 a[R], bq[R], z[R];
        const int j = lane >> 4;
#pragma unroll
        for (int q = 0; q < R; ++q) { const int row = row0 + q * nw; if (row < TP) {
            const int bl = row >> 13, tt = row & (SEQ - 1);
#pragma unroll
            for (int g = 0; g < 3; ++g) { const int sh = 2 * g; const int pp = (tt & ((1 << sh) - 1)) * (SEQ >> sh) + (tt >> sh);
                const size_t ro = (size_t)(bl * 3 + g) * SEQ + pp; ls[q][g] = LSE[ro * 4 + j]; ov[q][g] = *(const u32x2*)(OB + ro * 256 + 4 * lane); }
            gt[q] = *(const u32x2*)(GB + (size_t)row * 256 + 4 * lane);
            a[q] = *(const u32x4*)(YF + (size_t)row * 512 + 8 * lane); bq[q] = *(const u32x4*)(YS + (size_t)row * 512 + 8 * lane); z[q] = *(const u32x4*)(ZS + (size_t)row * 512 + 8 * lane); } }
#pragma unroll
        for (int q = 0; q < R; ++q) { const int row = row0 + q * nw; if (row < TP) {
            const float mx = fmaxf(ls[q][0], fmaxf(ls[q][1], ls[q][2]));
            float wg[3]; float ws = 0.f;
#pragma unroll
            for (int g = 0; g < 3; ++g) { wg[g] = __expf(ls[q][g] - mx); ws += wg[g]; }
            const float inv = 1.f / ws;
            f32x4 acc = (f32x4){0.f, 0.f, 0.f, 0.f};
#pragma unroll
            for (int g = 0; g < 3; ++g) { const u32x2 v = ov[q][g]; const float wv = wg[g] * inv;
                acc.x += wv * bflo(v.x); acc.y += wv * bfhi(v.x); acc.z += wv * bflo(v.y); acc.w += wv * bfhi(v.y); }
            acc.x *= bflo(gt[q].x); acc.y *= bfhi(gt[q].x); acc.z *= bflo(gt[q].y); acc.w *= bfhi(gt[q].y);
            st4bf(YBM + (size_t)row * 256 + 4 * lane, acc);
            float y[8];
            y[0] = (bflo(a[q].x) + bflo(bq[q].x)) * bflo(z[q].x); y[1] = (bfhi(a[q].x) + bfhi(bq[q].x)) * bfhi(z[q].x);
            y[2] = (bflo(a[q].y) + bflo(bq[q].y)) * bflo(z[q].y); y[3] = (bfhi(a[q].y) + bfhi(bq[q].y)) * bfhi(z[q].y);
            y[4] = (bflo(a[q].z) + bflo(bq[q].z)) * bflo(z[q].z); y[5] = (bfhi(a[q].z) + bfhi(bq[q].z)) * bfhi(z[q].z);
            y[6] = (bflo(a[q].w) + bflo(bq[q].w)) * bflo(z[q].w); y[7] = (bfhi(a[q].w) + bfhi(bq[q].w)) * bfhi(z[q].w);
            float ss = 0.f;
#pragma unroll
            for (int e = 0; e < 8; ++e) ss += y[e] * y[e];
            ss = wave_sum(ss);
            u32x4 o; o.x = pk2(y[0], y[1]); o.y = pk2(y[2], y[3]); o.z = pk2(y[4], y[5]); o.w = pk2(y[6], y[7]);
            *(u32x4*)(YC + (size_t)row * 512 + 8 * lane) = o;
            if (lane == 0) RS[row] = rsqrtf(ss * (1.f / 512.f) + EPS);
        } }
    }
}


#define XB_TMO      128
#define XB_XCNT(j)  (256  + 64 * (j))
#define XB_XSUB(j)  (1280 + 64 * (j))
#define XB_XGEN(j)  (2304 + 64 * (j))
#define XB_TOP      3328
#define XB_TOPGEN   3392
#define XCD_BAR_WORDS 3456
#define XB_SPIN_CAP (1u << 20)
__device__ __forceinline__ unsigned xb_ld(unsigned* p)              { return __hip_atomic_load(p, __ATOMIC_RELAXED, __HIP_MEMORY_SCOPE_AGENT); }
__device__ __forceinline__ unsigned xb_add(unsigned* p, unsigned v) { return __hip_atomic_fetch_add(p, v, __ATOMIC_RELAXED, __HIP_MEMORY_SCOPE_AGENT); }
__device__ __forceinline__ unsigned xb_xcc_id() { return (unsigned)__builtin_amdgcn_s_getreg((3 << 11) | 20) & 0xFu; }
#define XB_SPIN(cond, bar) do { unsigned _sp = 0; while (cond) { __builtin_amdgcn_s_sleep(1); \
    if ((++_sp & 255u) == 0u) { if (xb_ld(&(bar)[XB_TMO])) break; if (_sp > XB_SPIN_CAP) { atomicAdd(&(bar)[XB_TMO], 1u); break; } } } } while (0)
struct XcdBarrier { unsigned* bar; unsigned x; volatile LDSAS unsigned* st; };
__device__ __forceinline__ XcdBarrier xcd_barrier_post(unsigned* bar, volatile LDSAS unsigned* st) {
    XcdBarrier b; b.bar = bar; b.x = xb_xcc_id(); b.st = st;
    if (threadIdx.x == 0) (void)xb_add(&bar[XB_XCNT(b.x)], 1u);
    return b;
}
__device__ __forceinline__ void xcd_barrier_complete(unsigned* bar, unsigned x, unsigned& nloc, unsigned& nx) {
    const unsigned G = gridDim.x * gridDim.y * gridDim.z;
    unsigned sum, cnt, mine, sp = 0u;
    for (;;) {
        sum = 0u; cnt = 0u; mine = 0u;
#pragma unroll
        for (unsigned j = 0; j < 16; ++j) { const unsigned c = xb_ld(&bar[XB_XCNT(j)]); sum += c; cnt += (c > 0u) ? 1u : 0u; mine = (j == x) ? c : mine; }
        if (sum == G) break;
        __builtin_amdgcn_s_sleep(1);
        if ((++sp & 255u) == 0u) { if (xb_ld(&bar[XB_TMO])) break; if (sp > XB_SPIN_CAP) { atomicAdd(&bar[XB_TMO], 1u); break; } }
    }
    nloc = mine > 0u ? mine : 1u; nx = cnt > 0u ? cnt : 1u;
}
__device__ __forceinline__ void xcd_barrier(const XcdBarrier& b) {
    asm volatile("s_waitcnt vmcnt(0)" ::: "memory");
    __syncthreads();
    if (threadIdx.x == 0) {
        unsigned* bar = b.bar;
        __builtin_amdgcn_s_waitcnt(0);
        unsigned nloc = b.st[0], nx = b.st[1];
        if (nloc == 0u) { xcd_barrier_complete(bar, b.x, nloc, nx); b.st[0] = nloc; b.st[1] = nx; }
        const unsigned old = xb_add(&bar[XB_XSUB(b.x)], 1u);
        const unsigned gen = old / nloc;
        if (old + 1u == (gen + 1u) * nloc) {
            __builtin_amdgcn_fence(__ATOMIC_RELEASE, "agent");
            asm volatile("s_waitcnt vmcnt(0)" ::: "memory");
            const unsigned og = xb_add(&bar[XB_TOP], 1u);
            const unsigned tg = og / nx;
            if (og + 1u == (tg + 1u) * nx) xb_add(&bar[XB_TOPGEN], 1u);
            else XB_SPIN(xb_ld(&bar[XB_TOPGEN]) == tg, bar);
            __builtin_amdgcn_fence(__ATOMIC_ACQUIRE, "agent");
            xb_add(&bar[XB_XGEN(b.x)], 1u);
            asm volatile("s_waitcnt vmcnt(0)" ::: "memory");
        } else {
            XB_SPIN(xb_ld(&bar[XB_XGEN(b.x)]) == gen, bar);
            __builtin_amdgcn_fence(__ATOMIC_ACQUIRE, "agent");
            asm volatile("s_waitcnt vmcnt(0)" ::: "memory");
        }
    }
    __syncthreads();
}

__device__ __forceinline__ unsigned char* lds_half(unsigned char* smem) { int h_ = threadIdx.x >> 8; asm volatile("" : "+v"(h_)); return smem + h_ * HALF_LDS; }
__global__ void __launch_bounds__(512, 2) hybrid_fwd(Params p) {
    cg::grid_group grid = cg::this_grid();
    extern __shared__ __attribute__((aligned(16))) unsigned char smem[];
    volatile LDSAS unsigned* bst = (volatile LDSAS unsigned*)(smem + LDS_TOTAL - 16);
    if (threadIdx.x < 4) bst[threadIdx.x] = 0u;
    __syncthreads();
    const XcdBarrier xbar = xcd_barrier_post((unsigned*)(p.ws + WS_BAR), bst);
    { const Params q = launder(p); phase0(q, lds_half(smem)); }
    grid.sync();
#pragma unroll 1
    for (int l = 0; l < DEPTH; ++l) {
#pragma unroll 1
        for (int hb = 0; hb < 2; ++hb) {
            { const Params q = launder(p); norm_phase(q, l, hb, (l == 0) ? q.x : q.out); }
            xcd_barrier(xbar);
            { const Params q = launder(p); gemm1_phase(q, l, hb, smem); }
            xcd_barrier(xbar);
            { const Params q = launder(p); conv_phase(q, l); }
            xcd_barrier(xbar);
            { const Params q = launder(p); unsigned char* smh = lds_half(smem);
#pragma unroll 1
              for (int it = VBLK; it < 512 + 1536; it += VGRID) { if (it < 512) ssd_item<1>(q, it, l, smh); else attn_b_item(q, it - 512, l, smh); } }
            xcd_barrier(xbar);
            { const Params q = launder(p); unsigned char* smh = lds_half(smem);
#pragma unroll 1
              for (int it = VBLK; it < 1024 + 512; it += VGRID) { if (it < 1024) attn_a_item(q, it, l, smh); else ssd_item<3>(q, it - 1024, l, smh); } }
            xcd_barrier(xbar);
            { const Params q = launder(p); post2_phase(q); }
            xcd_barrier(xbar);
            { const Params q = launder(p); merge_phase(q, l, smem); }
            xcd_barrier(xbar);
            { const Params q = launder(p); out_phase(q, l, hb, (l == 0) ? q.x : q.out, smem); }
        }
    }
}

extern "C" void kernel_launch(void* const* d_in, const int* in_sizes, int n_in, void* d_out, int out_size, void* d_ws, size_t ws_size, hipStream_t stream) {
    static int grid_blocks = 0;
    if (!grid_blocks) {
        int dev = 0, cus = 0, per_cu = 0;
        hipGetDevice(&dev);
        hipDeviceGetAttribute(&cus, hipDeviceAttributeMultiprocessorCount, dev);
        hipFuncSetAttribute((const void*)hybrid_fwd, hipFuncAttributeMaxDynamicSharedMemorySize, LDS_TOTAL);
        hipOccupancyMaxActiveBlocksPerMultiprocessor(&per_cu, hybrid_fwd, 512, LDS_TOTAL);
        if (per_cu > 1) per_cu = 1;
        if (per_cu < 1) per_cu = 1;
        grid_blocks = cus * per_cu;
    }
    Params p{};
    const float** pp = (const float**)&p;
    for (int i = 0; i < 22; ++i) pp[i] = (const float*)d_in[i];
    p.out = (float*)d_out; p.ws = (unsigned char*)d_ws;
    hipMemsetAsync((unsigned char*)d_ws + WS_BAR, 0, XCD_BAR_WORDS * 4, stream);
    void* args[] = {&p};
    hipError_t e = hipLaunchCooperativeKernel((void*)hybrid_fwd, dim3(grid_blocks), dim3(512), args, LDS_TOTAL, stream);
    if (e != hipSuccess) fprintf(stderr, "cooperative launch failed: %s (grid %d)\n", hipGetErrorString(e), grid_blocks);
}
```

```cpp
#include <hip/hip_runtime.h>
#include <hip/hip_cooperative_groups.h>
#include <cstdint>
#include <cstdio>
namespace cg = cooperative_groups;

typedef unsigned short bf16_t;
typedef short bf16x8 __attribute__((ext_vector_type(8)));
typedef short v4i16 __attribute__((ext_vector_type(4)));
typedef float f32x2 __attribute__((ext_vector_type(2)));
typedef float f32x4 __attribute__((ext_vector_type(4)));
typedef float f32x16 __attribute__((ext_vector_type(16)));
typedef unsigned u32x2 __attribute__((ext_vector_type(2)));
typedef unsigned u32x4 __attribute__((ext_vector_type(4)));
typedef __bf16 bf16x2_t __attribute__((ext_vector_type(2)));
#define LDSAS __attribute__((address_space(3)))
#define VTID ((int)(threadIdx.x & 255u))
__device__ __forceinline__ int vblk_() { int h_ = threadIdx.x >> 8; asm volatile("" : "+v"(h_)); return __builtin_amdgcn_readfirstlane(2 * (int)blockIdx.x + h_); }
#define VBLK vblk_()
#define VGRID ((int)(2u * gridDim.x))
constexpr int HALF_LDS = 73728, LDS_TOTAL = 147456;

constexpr int SEQ = 8192, DM = 1024, NBATCH = 4, NBH = 2, TP = NBH * SEQ, DEPTH = 2;
constexpr int NP = 8704;
constexpr float EPS = 1e-6f;
constexpr float LOG2E = 1.4426950408889634f, LN2 = 0.6931471805599453f;
constexpr int NSEG = 16, SEGLEN = 512, TSUB = 32, NSUB = SEGLEN / TSUB;

constexpr size_t MiB = 1u << 20;
constexpr size_t WS_WIN = 0;
constexpr size_t WS_WPA = 34 * MiB;
constexpr size_t WS_WPB = 36 * MiB;
constexpr size_t WS_WPC = 37 * MiB;
constexpr size_t WS_WOUT = 39 * MiB;
constexpr size_t WS_MOD = 43 * MiB;
constexpr size_t WS_ROPE = 43 * MiB + 128 * 1024;
constexpr size_t WS_BND = 43 * MiB + 160 * 1024;
constexpr size_t WS_RSTD = 43 * MiB + 256 * 1024;
constexpr size_t WS_SEGT = 43 * MiB + 512 * 1024;
constexpr size_t WS_LSE = 44 * MiB;
constexpr size_t WS_DT = 45 * MiB;
constexpr size_t WS_BAR = 46 * MiB;
constexpr size_t WS_H = 48 * MiB;
constexpr size_t WS_QA = 80 * MiB;
constexpr size_t WS_KA = 96 * MiB;
constexpr size_t WS_VA = 100 * MiB;
constexpr size_t WS_GA = 104 * MiB;
constexpr size_t WS_QB = 120 * MiB;
constexpr size_t WS_KB = 144 * MiB;
constexpr size_t WS_VB = 168 * MiB;
constexpr size_t WS_GB = 192 * MiB;
constexpr size_t WS_XBC = 200 * MiB;
constexpr size_t WS_ZS = 232 * MiB;
constexpr size_t WS_MG = 248 * MiB;
constexpr size_t WS_YF = 344 * MiB;
constexpr size_t WS_YS = 360 * MiB;
constexpr size_t WS_YBM = 376 * MiB;
constexpr size_t WS_YC = 384 * MiB;
constexpr size_t WS_MRG = 400 * MiB;
constexpr size_t WS_ST = 432 * MiB;
constexpr size_t WS_XBCC = 448 * MiB;

struct Params {
    const float *x, *c, *norm_w, *w_ada, *b_ada, *w_in, *b_gate, *q_norm_a, *k_norm_a, *q_norm_b, *k_norm_b, *rel_bias,
        *conv_w, *conv_b, *a_log, *dt_bias, *d_skip, *ssm_norm_w, *w_proj_a, *w_proj_b, *w_proj_c, *w_out;
    float* out;
    unsigned char* ws;
};


#define AS1 __attribute__((address_space(1)))
#define GLOBF(f) do { AS1 const float* g_ = (AS1 const float*)p.f; asm volatile("" : "+s"(g_)); q.f = (const float*)g_; } while (0)
__device__ __forceinline__ Params launder(const Params& p) {
    Params q;
    GLOBF(x); GLOBF(c); GLOBF(norm_w); GLOBF(w_ada); GLOBF(b_ada); GLOBF(w_in); GLOBF(b_gate); GLOBF(q_norm_a); GLOBF(k_norm_a); GLOBF(q_norm_b); GLOBF(k_norm_b); GLOBF(rel_bias);
    GLOBF(conv_w); GLOBF(conv_b); GLOBF(a_log); GLOBF(dt_bias); GLOBF(d_skip); GLOBF(ssm_norm_w); GLOBF(w_proj_a); GLOBF(w_proj_b); GLOBF(w_proj_c); GLOBF(w_out);
    { AS1 float* g_ = (AS1 float*)p.out; asm volatile("" : "+s"(g_)); q.out = (float*)g_; }
    { AS1 unsigned char* g_ = (AS1 unsigned char*)p.ws; asm volatile("" : "+s"(g_)); q.ws = (unsigned char*)g_; }
    return q;
}
__device__ __forceinline__ unsigned pk2(float lo, float hi) { f32x2 v = {lo, hi}; bf16x2_t b = __builtin_convertvector(v, bf16x2_t); return __builtin_bit_cast(unsigned, b); }
__device__ __forceinline__ float bf2f(unsigned short b) { return __uint_as_float(((unsigned)b) << 16); }
__device__ __forceinline__ float bflo(unsigned u) { return __uint_as_float(u << 16); }
__device__ __forceinline__ float bfhi(unsigned u) { return __uint_as_float(u & 0xffff0000u); }
__device__ __forceinline__ float siluf(float v) { return v * __builtin_amdgcn_rcpf(1.f + __builtin_amdgcn_exp2f(-1.4426950408889634f * v)); }
__device__ __forceinline__ float sigmf(float v) { return __builtin_amdgcn_rcpf(1.f + __builtin_amdgcn_exp2f(-1.4426950408889634f * v)); }
__device__ __forceinline__ float wave_sum(float v) {
#pragma unroll
    for (int o = 1; o < 64; o <<= 1) v += __shfl_xor(v, o);
    return v;
}
__device__ __forceinline__ v4i16 tr16(const unsigned char* p) { return __builtin_amdgcn_ds_read_tr16_b64_v4i16((LDSAS v4i16*)p); }
__device__ __forceinline__ bf16x8 cat8(v4i16 a, v4i16 b) { return (bf16x8){a[0], a[1], a[2], a[3], b[0], b[1], b[2], b[3]}; }
__device__ __forceinline__ int crow(int r, int hi) { return (r & 3) + 8 * (r >> 2) + 4 * hi; }

struct P0It { const float* W; bf16_t* Wt; const float* rs; int ldw, K, k0, n0, mode; };
__device__ __forceinline__ void p0_load(const P0It& t, float (&vv)[16]) {
    const int tid = VTID, tx = tid & 63, ty = tid >> 6;
    const int np = t.n0 + tx; int n = np; bool valid = true;
    if (t.mode == 1) {
        if (np < 4352) n = np; else if (np < 4864) n = np + 512; else if (np < 5376) n = np - 512;
        else if (np < 8448) n = np + 16; else if (np < 8464) n = np - 3072; else { valid = false; n = 0; }
    }
#pragma unroll
    for (int i = 0; i < 16; ++i) { const int k = ty + 4 * i; vv[i] = valid ? t.W[(size_t)(t.k0 + k) * t.ldw + n] : 0.f; }
}
__device__ __forceinline__ void p0_finish(const P0It& t, const float (&vv)[16], float* tile) {
    const int tid = VTID, tx = tid & 63, ty = tid >> 6;
#pragma unroll
    for (int i = 0; i < 16; ++i) { const int k = ty + 4 * i; float v = vv[i]; if (t.rs) v *= t.rs[t.k0 + k]; tile[k * 65 + tx] = v; }
    __syncthreads();
    const int r = tid >> 2, kc = (tid & 3) * 16;
    u32x4 o0, o1;
    o0.x = pk2(tile[(kc + 0) * 65 + r], tile[(kc + 1) * 65 + r]); o0.y = pk2(tile[(kc + 2) * 65 + r], tile[(kc + 3) * 65 + r]);
    o0.z = pk2(tile[(kc + 4) * 65 + r], tile[(kc + 5) * 65 + r]); o0.w = pk2(tile[(kc + 6) * 65 + r], tile[(kc + 7) * 65 + r]);
    o1.x = pk2(tile[(kc + 8) * 65 + r], tile[(kc + 9) * 65 + r]); o1.y = pk2(tile[(kc + 10) * 65 + r], tile[(kc + 11) * 65 + r]);
    o1.z = pk2(tile[(kc + 12) * 65 + r], tile[(kc + 13) * 65 + r]); o1.w = pk2(tile[(kc + 14) * 65 + r], tile[(kc + 15) * 65 + r]);
    bf16_t* dst = t.Wt + (size_t)(t.n0 + r) * t.K + t.k0 + kc;
    *(u32x4*)dst = o0; *(u32x4*)(dst + 8) = o1;
    __syncthreads();
}
constexpr int P0_IN = 16 * 136, P0_PA = 8 * 16, P0_PB = 4 * 16, P0_PC = 8 * 16, P0_OUT = 16 * 16, P0_L = P0_IN + P0_PA + P0_PB + P0_PC + P0_OUT;
__device__ __forceinline__ P0It p0_params(const Params& p, int item) {
    P0It t; const int l = item / P0_L; int r = item % P0_L; t.rs = nullptr; t.mode = 0;
    if (r < P0_IN) { t.W = p.w_in + (size_t)l * 1024 * 8464; t.ldw = 8464; t.K = 1024; t.Wt = (bf16_t*)(p.ws + WS_WIN) + (size_t)l * NP * 1024; t.k0 = (r / 136) * 64; t.n0 = (r % 136) * 64; t.mode = 1; return t; }
    r -= P0_IN;
    if (r < P0_PA) { t.W = p.w_proj_a + (size_t)l * 512 * 1024; t.ldw = 1024; t.K = 512; t.Wt = (bf16_t*)(p.ws + WS_WPA) + (size_t)l * 1024 * 512; t.k0 = (r / 16) * 64; t.n0 = (r % 16) * 64; return t; }
    r -= P0_PA;
    if (r < P0_PB) { t.W = p.w_proj_b + (size_t)l * 256 * 1024; t.ldw = 1024; t.K = 256; t.Wt = (bf16_t*)(p.ws + WS_WPB) + (size_t)l * 1024 * 256; t.k0 = (r / 16) * 64; t.n0 = (r % 16) * 64; return t; }
    r -= P0_PB;
    if (r < P0_PC) { t.W = p.w_proj_c + (size_t)l * 512 * 1024; t.ldw = 1024; t.K = 512; t.Wt = (bf16_t*)(p.ws + WS_WPC) + (size_t)l * 1024 * 512; t.k0 = (r / 16) * 64; t.n0 = (r % 16) * 64; t.rs = p.ssm_norm_w + l * 512; return t; }
    r -= P0_PC;
    t.W = p.w_out + (size_t)l * 1024 * 1024; t.ldw = 1024; t.K = 1024; t.Wt = (bf16_t*)(p.ws + WS_WOUT) + (size_t)l * 1024 * 1024; t.k0 = (r / 16) * 64; t.n0 = (r % 16) * 64; return t;
}

__device__ void phase0(const Params& p, unsigned char* smem) {
    const int tid = VTID;
    float* tile = (float*)smem;
    constexpr int I_T = 2 * P0_L, I_MOD = 192, I_ALL = I_T + I_MOD + 1;
    {
        int item = VBLK;
        if (item < I_T) {
            P0It cur = p0_params(p, item); float va[16], vb[16]; p0_load(cur, va);
            for (;;) {
                const int nx = item + VGRID; const bool more = nx < I_T; P0It nxt = cur;
                if (more) { nxt = p0_params(p, nx); p0_load(nxt, vb); }
                p0_finish(cur, va, tile);
                if (!more) break;
                item = nx; cur = nxt;
#pragma unroll
                for (int i = 0; i < 16; ++i) va[i] = vb[i];
            }
        }
    }
    for (int item = VBLK; item < I_ALL; item += VGRID) {
        if (item < I_T) {
            continue;
        } else if (item < I_T + I_MOD) {
            const int it = item - I_T, l = it / 96, col0 = (it % 96) * 32, cl = tid & 31, ks = tid >> 5;
            float a0 = 0.f, a1 = 0.f, a2 = 0.f, a3 = 0.f;
            const float* wp = p.w_ada + ((size_t)l * 1024 + ks * 128) * 3072 + col0 + cl;
#pragma unroll 8
            for (int k = 0; k < 128; ++k) {
                const float wv = wp[(size_t)k * 3072]; const int kk = ks * 128 + k;
                a0 += siluf(p.c[kk]) * wv; a1 += siluf(p.c[1024 + kk]) * wv; a2 += siluf(p.c[2048 + kk]) * wv; a3 += siluf(p.c[3072 + kk]) * wv;
            }
            float* red = (float*)smem;
            red[(ks * 32 + cl) * 4 + 0] = a0; red[(ks * 32 + cl) * 4 + 1] = a1; red[(ks * 32 + cl) * 4 + 2] = a2; red[(ks * 32 + cl) * 4 + 3] = a3;
            __syncthreads();
            if (tid < 128) { const int b = tid >> 5, c2 = tid & 31; float s = 0.f;
#pragma unroll
                for (int k = 0; k < 8; ++k) s += red[(k * 32 + c2) * 4 + b];
                ((float*)(p.ws + WS_MOD))[(l * 4 + b) * 3072 + col0 + c2] = s + p.b_ada[l * 3072 + col0 + c2]; }
            __syncthreads();
        } else {
            float* rc = (float*)(p.ws + WS_ROPE); float* rs = rc + 128 * 16;
            for (int e = tid; e < 2048; e += 256) {
                const int pos = e >> 4, i = e & 15;
                const float freq = powf(10000.0f, -(float)i / 16.0f);
                const float ang = (float)pos * freq;
                const double rev = (double)ang * 0.15915494309189535; const double fr = rev - rint(rev);
                const float a = (float)(fr * 6.283185307179586);
                rc[e] = cosf(a); rs[e] = sinf(a);
            }
            if (tid < 2) {
                const int l = tid; float mqa = 0.f, mka = 0.f, mqb = 0.f, mkb = 0.f, mb = 0.f;
                for (int i = 0; i < 64; ++i) { mqa = fmaxf(mqa, fabsf(p.q_norm_a[l * 64 + i])); mka = fmaxf(mka, fabsf(p.k_norm_a[l * 64 + i]));
                    mqb = fmaxf(mqb, fabsf(p.q_norm_b[l * 64 + i])); mkb = fmaxf(mkb, fabsf(p.k_norm_b[l * 64 + i])); }
                for (int i = 0; i < 32 * 12; ++i) mb = fmaxf(mb, p.rel_bias[i]);
                float* bd = (float*)(p.ws + WS_BND);
                bd[l] = 8.f * mqa * mka * LOG2E; bd[2 + l] = (8.f * mqb * mkb + mb) * LOG2E;
            }
        }
    }
}

__device__ void norm_phase(const Params& p, int l, int hb, const float* xsrc) {
    int tx_ = threadIdx.x; asm volatile("" : "+v"(tx_));
    const int lane = tx_ & 63, gw = blockIdx.x * 8 + (tx_ >> 6), nw = gridDim.x * 8;
    bf16_t* H = (bf16_t*)(p.ws + WS_H);
    const float* nwp = p.norm_w + l * 1024;
    for (int row0 = gw; row0 < TP; row0 += 4 * nw) {
        f32x4 v[4][4];
#pragma unroll
        for (int q = 0; q < 4; ++q) { const int row = row0 + q * nw;
            if (row < TP) { const f32x4* xr = (const f32x4*)(xsrc + ((size_t)hb * TP + row) * 1024);
#pragma unroll
                for (int j = 0; j < 4; ++j) v[q][j] = xr[lane + 64 * j]; } }
#pragma unroll
        for (int q = 0; q < 4; ++q) { const int row = row0 + q * nw;
            if (row < TP) {
                const size_t rg = (size_t)hb * TP + row; const int b = (int)(rg / SEQ);
                const float* md = (const float*)(p.ws + WS_MOD) + (size_t)(l * 4 + b) * 3072;
                float ss = 0.f;
#pragma unroll
                for (int j = 0; j < 4; ++j) ss += v[q][j].x * v[q][j].x + v[q][j].y * v[q][j].y + v[q][j].z * v[q][j].z + v[q][j].w * v[q][j].w;
                ss = wave_sum(ss); const float rstd = rsqrtf(ss * (1.f / 1024.f) + EPS);
#pragma unroll
                for (int j = 0; j < 4; ++j) {
                    const int col = 4 * (lane + 64 * j);
                    const f32x4 w4 = *(const f32x4*)(nwp + col), sh = *(const f32x4*)(md + col), sc = *(const f32x4*)(md + 1024 + col);
                    const f32x4 o = v[q][j] * rstd * w4 * (1.f + sc) + sh;
                    u32x2 pk; pk.x = pk2(o.x, o.y); pk.y = pk2(o.z, o.w);
                    *(u32x2*)(H + (size_t)row * 1024 + col) = pk;
                }
            } }
    }
}

constexpr int G_STAGE = 65536, G_AB = 32768;
template <bool LOWREG = false>
__device__ __forceinline__ void gemm_core(const bf16_t* __restrict__ A, int lda, const bf16_t* __restrict__ Bt, int ldb, int K, f32x4 (&acc)[8][4], unsigned char* smem, int tid) {
    asm volatile("" : "+v"(tid));
    const int lane = tid & 63, w = __builtin_amdgcn_readfirstlane(tid >> 6), wm = w >> 2, wn = w & 3, idx = lane & 15, kq = lane >> 4;
    unsigned offA[4], offB[4];
#pragma unroll
    for (int j = 0; j < 4; ++j) { const int row = (j * 8 + w) * 8 + (lane >> 3), c = (lane & 7) ^ ((row >> 1) & 7);
        offA[j] = (unsigned)(row * lda + c * 8) * 2u; offB[j] = (unsigned)(row * ldb + c * 8) * 2u; }
#pragma unroll
    for (int mi = 0; mi < 8; ++mi)
#pragma unroll
        for (int ni = 0; ni < 4; ++ni) acc[mi][ni] = (f32x4){0.f, 0.f, 0.f, 0.f};
    LDSAS unsigned char* lds = (LDSAS unsigned char*)smem;
#define G_ISSUE1(kt, st, j) do { \
        __builtin_amdgcn_global_load_lds((const unsigned*)((const char*)A + offA[j] + (kt) * 128), (LDSAS unsigned*)(lds + (st) * G_STAGE + ((j) * 8 + w) * 1024), 16, 0, 0); \
        __builtin_amdgcn_global_load_lds((const unsigned*)((const char*)Bt + offB[j] + (kt) * 128), (LDSAS unsigned*)(lds + (st) * G_STAGE + G_AB + ((j) * 8 + w) * 1024), 16, 0, 0); } while (0)
#define G_ISSUE(kt, st) do { G_ISSUE1(kt, st, 0); G_ISSUE1(kt, st, 1); G_ISSUE1(kt, st, 2); G_ISSUE1(kt, st, 3); } while (0)
    const int nk = K >> 6;
    G_ISSUE(0, 0);
    asm volatile("s_waitcnt vmcnt(0)" ::: "memory");
    __syncthreads();
    const int swz = (idx >> 1) & 7;
    const int aoff = (wm * 128 + idx) * 128, boff = G_AB + (wn * 64 + idx) * 128;
    for (int kt = 0; kt < nk; ++kt) {
        const int st = kt & 1;
        const bool more = kt + 1 < nk;
        const unsigned char* sb = smem + st * G_STAGE;
        if constexpr (!LOWREG) {
#pragma unroll
        for (int ks = 0; ks < 2; ++ks) {
            bf16x8 bfr[4], af[8];
            const int co = ((ks * 4 + kq) ^ swz) * 16;
#pragma unroll
            for (int ni = 0; ni < 4; ++ni) bfr[ni] = *(const bf16x8*)(sb + boff + ni * 2048 + co);
#pragma unroll
            for (int mi = 0; mi < 8; ++mi) af[mi] = *(const bf16x8*)(sb + aoff + mi * 2048 + co);
            if (more) { G_ISSUE1(kt + 1, st ^ 1, ks * 2); G_ISSUE1(kt + 1, st ^ 1, ks * 2 + 1); }
            __builtin_amdgcn_sched_barrier(0);
            __builtin_amdgcn_s_setprio(1);
#pragma unroll
            for (int mi = 0; mi < 8; ++mi)
#pragma unroll
                for (int ni = 0; ni < 4; ++ni) acc[mi][ni] = __builtin_amdgcn_mfma_f32_16x16x32_bf16(bfr[ni], af[mi], acc[mi][ni], 0, 0, 0);
            __builtin_amdgcn_s_setprio(0);
            __builtin_amdgcn_sched_barrier(0);
        }
        } else {
#pragma unroll
        for (int ks = 0; ks < 2; ++ks) {
            bf16x8 bfr[4];
            const int co = ((ks * 4 + kq) ^ swz) * 16;
#pragma unroll
            for (int ni = 0; ni < 4; ++ni) bfr[ni] = *(const bf16x8*)(sb + boff + ni * 2048 + co);
#pragma unroll
            for (int mh = 0; mh < 2; ++mh) {
                bf16x8 af[4];
#pragma unroll
                for (int mi = 0; mi < 4; ++mi) af[mi] = *(const bf16x8*)(sb + aoff + (mh * 4 + mi) * 2048 + co);
                if (more) G_ISSUE1(kt + 1, st ^ 1, ks * 2 + mh);
                __builtin_amdgcn_sched_barrier(0);
                __builtin_amdgcn_s_setprio(1);
#pragma unroll
                for (int mi = 0; mi < 4; ++mi)
#pragma unroll
                    for (int ni = 0; ni < 4; ++ni) acc[mh * 4 + mi][ni] = __builtin_amdgcn_mfma_f32_16x16x32_bf16(bfr[ni], af[mi], acc[mh * 4 + mi][ni], 0, 0, 0);
                __builtin_amdgcn_s_setprio(0);
                __builtin_amdgcn_sched_barrier(0);
            }
        }
        }
        asm volatile("s_waitcnt vmcnt(0)" ::: "memory");
        __syncthreads();
    }
#undef G_ISSUE1
#undef G_ISSUE
}

__device__ __forceinline__ void st4bf(bf16_t* dst, f32x4 v) { u32x2 pk; pk.x = pk2(v.x, v.y); pk.y = pk2(v.z, v.w); *(u32x2*)dst = pk; }

__device__ void gemm1_phase(const Params& p, int l, int hb, unsigned char* smem) {
    const bf16_t* H = (const bf16_t*)(p.ws + WS_H);
    const bf16_t* Wt = (const bf16_t*)(p.ws + WS_WIN) + (size_t)l * NP * 1024;
    const float* ropec = (const float*)(p.ws + WS_ROPE); const float* ropes = ropec + 2048;
    constexpr int NT = 34, NTILES = 64 * NT, GRP = 8 * NT;
    for (int t = blockIdx.x; t < NTILES; t += gridDim.x) {
        const int grp = t / GRP, r = t % GRP, jx = NT * (r & 7) + (r >> 3), mt = grp * 8 + (jx & 7), nt = jx >> 3;
        const int m0 = mt * 256, n0 = nt * 256;
        f32x4 acc[8][4];
        int tid = threadIdx.x;
        gemm_core(H + (size_t)m0 * 1024, 1024, Wt + (size_t)n0 * 1024, 1024, 1024, acc, smem, tid);
        asm volatile("" : "+v"(tid));
        const int lane = tid & 63, w = __builtin_amdgcn_readfirstlane(tid >> 6), wm = w >> 2, wn = w & 3, idx = lane & 15, kq = lane >> 4;
        const int cw = n0 + wn * 64;
        const int lc = 4 * kq;
        unsigned char* wl = smem + w * 16384;
#define G1_STG(mi_, ni_, v_) do { const int r_ = (mi_) * 16 + idx; const f32x4 t_ = (v_); u32x2 pk_; pk_.x = pk2(t_.x, t_.y); pk_.y = pk2(t_.z, t_.w); \
        *(u32x2*)(wl + r_ * 128 + ((((ni_) * 2 + (kq >> 1)) ^ (r_ & 7)) * 16) + (kq & 1) * 8) = pk_; } while (0)
        bf16_t* dbase = nullptr; int dpitch = 0, dc0 = 0, dsh = -1, dg = 0;
        if (cw < 768 && (cw < 640)) {
            const bool isq = cw < 512;
            const float* nwp = (isq ? p.q_norm_a : p.k_norm_a) + l * 64;
            dbase = isq ? (bf16_t*)(p.ws + WS_QA) : (bf16_t*)(p.ws + WS_KA);
            dpitch = isq ? 512 : 128; dc0 = isq ? cw : cw - 512;
            const float qs = isq ? 0.125f * LOG2E : 1.f;
#pragma unroll
            for (int mi = 0; mi < 8; ++mi) {
                const int row = m0 + wm * 128 + mi * 16 + idx;
                float ss = 0.f;
#pragma unroll
                for (int ni = 0; ni < 4; ++ni) { const f32x4 v = acc[mi][ni]; ss += v.x * v.x + v.y * v.y + v.z * v.z + v.w * v.w; }
                ss += __shfl_xor(ss, 16); ss += __shfl_xor(ss, 32);
                const float rstd = rsqrtf(ss * (1.f / 64.f) + EPS);
                f32x4 y[4];
#pragma unroll
                for (int ni = 0; ni < 4; ++ni) y[ni] = acc[mi][ni] * rstd * *(const f32x4*)(nwp + ni * 16 + lc);
                const int tt = row & (SEQ - 1), prow = tt >> 6, pcol = tt & 63;
#pragma unroll
                for (int hf = 0; hf < 2; ++hf) {
                    const int pos = hf ? pcol : prow;
                    const f32x4 cs = *(const f32x4*)(ropec + pos * 16 + lc), sn = *(const f32x4*)(ropes + pos * 16 + lc);
                    const f32x4 a = y[2 * hf], b = y[2 * hf + 1];
                    y[2 * hf] = a * cs - b * sn; y[2 * hf + 1] = b * cs + a * sn;
                }
#pragma unroll
                for (int ni = 0; ni < 4; ++ni) G1_STG(mi, ni, y[ni] * qs);
            }
        } else if (cw >= 1280 && cw < 2816) {
            const bool isq = cw < 2048;
            const float* nwp = (isq ? p.q_norm_b : p.k_norm_b) + l * 64;
            const int gc = isq ? cw - 1280 : cw - 2048;
            dg = gc >> 8; dc0 = gc & 255; dsh = 2 * dg; dpitch = 256;
            dbase = (bf16_t*)(p.ws + (isq ? WS_QB : WS_KB));
            const float qs = isq ? 0.125f * LOG2E : 1.f;
#pragma unroll
            for (int mi = 0; mi < 8; ++mi) {
                float ss = 0.f;
#pragma unroll
                for (int ni = 0; ni < 4; ++ni) { const f32x4 v = acc[mi][ni]; ss += v.x * v.x + v.y * v.y + v.z * v.z + v.w * v.w; }
                ss += __shfl_xor(ss, 16); ss += __shfl_xor(ss, 32);
                const float rstd = rsqrtf(ss * (1.f / 64.f) + EPS) * qs;
#pragma unroll
                for (int ni = 0; ni < 4; ++ni) G1_STG(mi, ni, acc[mi][ni] * rstd * *(const f32x4*)(nwp + ni * 16 + lc));
            }
        } else if (cw >= 2816 && cw < 3584) {
            const int gc = cw - 2816;
            dg = gc >> 8; dc0 = gc & 255; dsh = 2 * dg; dpitch = 256; dbase = (bf16_t*)(p.ws + WS_VB);
#pragma unroll
            for (int mi = 0; mi < 8; ++mi)
#pragma unroll
                for (int ni = 0; ni < 4; ++ni) G1_STG(mi, ni, acc[mi][ni]);
        } else if (cw >= 8448) {
            if (cw == 8448) {
                float* dst = (float*)(p.ws + WS_DT);
                const f32x4 bias = *(const f32x4*)(p.dt_bias + l * 16 + lc);
#pragma unroll
                for (int mi = 0; mi < 8; ++mi) {
                    const int row = m0 + wm * 128 + mi * 16 + idx;
                    f32x4 v = acc[mi][0] + bias, o;
                    o.x = v.x > 20.f ? v.x : log1pf(__expf(v.x)); o.y = v.y > 20.f ? v.y : log1pf(__expf(v.y));
                    o.z = v.z > 20.f ? v.z : log1pf(__expf(v.z)); o.w = v.w > 20.f ? v.w : log1pf(__expf(v.w));
                    *(f32x4*)(dst + (size_t)row * 16 + lc) = o;
                }
            }
        } else {
            int mode;
            if (cw < 768) { dbase = (bf16_t*)(p.ws + WS_VA); dpitch = 128; dc0 = cw - 640; mode = 0; }
            else if (cw < 1280) { dbase = (bf16_t*)(p.ws + WS_GA); dpitch = 512; dc0 = cw - 768; mode = 1; }
            else if (cw < 3840) { dbase = (bf16_t*)(p.ws + WS_GB); dpitch = 256; dc0 = cw - 3584; mode = 1; }
            else if (cw < 4864) { dbase = (bf16_t*)(p.ws + WS_XBC); dpitch = 1024; dc0 = cw - 3840; mode = 0; }
            else if (cw < 5376) { dbase = (bf16_t*)(p.ws + WS_ZS); dpitch = 512; dc0 = cw - 4864; mode = 1; }
            else { dbase = (bf16_t*)(p.ws + WS_MG); dpitch = 3072; dc0 = cw - 5376; mode = 2; }
            const float* bg = p.b_gate + l * 3072 + dc0 + lc;
#pragma unroll
            for (int mi = 0; mi < 8; ++mi) {
#pragma unroll
                for (int ni = 0; ni < 4; ++ni) {
                    f32x4 v = acc[mi][ni];
                    if (mode == 1) { v.x = siluf(v.x); v.y = siluf(v.y); v.z = siluf(v.z); v.w = siluf(v.w); }
                    else if (mode == 2) { const f32x4 bb = *(const f32x4*)(bg + ni * 16); v.x = sigmf(v.x + bb.x); v.y = sigmf(v.y + bb.y); v.z = sigmf(v.z + bb.z); v.w = sigmf(v.w + bb.w); }
                    G1_STG(mi, ni, v);
                }
            }
        }
#undef G1_STG
        if (dbase) {
            const int ch = lane & 7;
#pragma unroll
            for (int j = 0; j < 16; ++j) {
                const int rl = 8 * j + (lane >> 3), row = m0 + wm * 128 + rl;
                const u32x4 v = *(const u32x4*)(wl + rl * 128 + ((ch ^ (rl & 7)) * 16));
                size_t drow = (size_t)row;
                if (dsh >= 0) { const int bl = row >> 13, tt = row & (SEQ - 1); drow = (size_t)(bl * 3 + dg) * SEQ + (size_t)((tt & ((1 << dsh) - 1)) * (SEQ >> dsh) + (tt >> dsh)); }
                *(u32x4*)(dbase + drow * dpitch + dc0 + ch * 8) = v;
            }
        }
        __syncthreads();
    }
}

__device__ void merge_phase(const Params& p, int l, unsigned char* smem) {
    const bf16_t* MG = (const bf16_t*)(p.ws + WS_MG);
    const float* rstd = (const float*)(p.ws + WS_RSTD);
    bf16_t* MR = (bf16_t*)(p.ws + WS_MRG);
    for (int t = blockIdx.x; t < 64 * 4; t += gridDim.x) {
        const int xq = t >> 3, mt = (xq >> 2) * 8 + (t & 7), nt = xq & 3, m0 = mt * 256, n0 = nt * 256;
        u32x2 mpk[4][4];
#pragma unroll 1
        for (int br = 0; br < 3; ++br) {
            f32x4 acc[8][4];
            const bf16_t* A; const bf16_t* Bt; int K;
            if (br == 0) { A = (const bf16_t*)(p.ws + WS_QA); K = 512; Bt = (const bf16_t*)(p.ws + WS_WPA) + (size_t)l * 1024 * 512; }
            else if (br == 1) { A = (const bf16_t*)(p.ws + WS_YBM); K = 256; Bt = (const bf16_t*)(p.ws + WS_WPB) + (size_t)l * 1024 * 256; }
            else { A = (const bf16_t*)(p.ws + WS_YC); K = 512; Bt = (const bf16_t*)(p.ws + WS_WPC) + (size_t)l * 1024 * 512; }
            int tid = threadIdx.x;
            gemm_core<true>(A + (size_t)m0 * K, K, Bt + (size_t)n0 * K, K, K, acc, smem, tid);
            asm volatile("" : "+v"(tid));
            const int lane = tid & 63, w = tid >> 6, wm = w >> 2, wn = w & 3, idx = lane & 15, kq = lane >> 4;
#pragma unroll
            for (int mi = 0; mi < 8; ++mi) {
                const int row = m0 + wm * 128 + mi * 16 + idx;
                const float rs = (br == 2) ? rstd[row] : 1.f;
#pragma unroll
                for (int ni = 0; ni < 4; ++ni) {
                    const int col = n0 + wn * 64 + ni * 16 + 4 * kq;
                    const u32x2 g = *(const u32x2*)(MG + (size_t)row * 3072 + br * 1024 + col);
                    f32x4 gv; gv.x = bflo(g.x); gv.y = bfhi(g.x); gv.z = bflo(g.y); gv.w = bfhi(g.y);
                    f32x4 v = gv * rs * acc[mi][ni];
                    bf16_t* mp = MR + (size_t)row * 1024 + col;
                    if (mi < 4) {
                        if (br > 0) { const u32x2 o = mpk[mi & 3][ni]; v.x += bflo(o.x); v.y += bfhi(o.x); v.z += bflo(o.y); v.w += bfhi(o.y); }
                        u32x2 pk; pk.x = pk2(v.x, v.y); pk.y = pk2(v.z, v.w); mpk[mi & 3][ni] = pk;
                        if (br == 2) *(u32x2*)mp = pk;
                    } else {
                        if (br > 0) { const u32x2 o = *(const u32x2*)mp; v.x += bflo(o.x); v.y += bfhi(o.x); v.z += bflo(o.y); v.w += bfhi(o.y); }
                        st4bf(mp, v);
                    }
                }
            }
        }
    }
}

__device__ void out_phase(const Params& p, int l, int hb, const float* xsrc, unsigned char* smem) {
    const bf16_t* MR = (const bf16_t*)(p.ws + WS_MRG);
    const bf16_t* Wt = (const bf16_t*)(p.ws + WS_WOUT) + (size_t)l * 1024 * 1024;
    for (int t = blockIdx.x; t < 64 * 4; t += gridDim.x) {
        const int xq = t >> 3, mt = (xq >> 2) * 8 + (t & 7), nt = xq & 3, m0 = mt * 256, n0 = nt * 256;
        f32x4 acc[8][4];
        int tid = threadIdx.x;
        gemm_core(MR + (size_t)m0 * 1024, 1024, Wt + (size_t)n0 * 1024, 1024, 1024, acc, smem, tid);
        asm volatile("" : "+v"(tid));
        const int lane = tid & 63, w = tid >> 6, wm = w >> 2, wn = w & 3, idx = lane & 15, kq = lane >> 4;
#pragma unroll
        for (int mi = 0; mi < 8; ++mi) {
            const int row = m0 + wm * 128 + mi * 16 + idx; const size_t rg = (size_t)hb * TP + row; const int b = (int)(rg / SEQ);
            const float* gate = (const float*)(p.ws + WS_MOD) + (size_t)(l * 4 + b) * 3072 + 2048;
#pragma unroll
            for (int ni = 0; ni < 4; ++ni) {
                const int col = n0 + wn * 64 + ni * 16 + 4 * kq;
                const f32x4 xv = *(const f32x4*)(xsrc + rg * 1024 + col), gv = *(const f32x4*)(gate + col);
                *(f32x4*)(p.out + rg * 1024 + col) = xv + gv * acc[mi][ni];
            }
        }
    }
}

constexpr int AT_KS = 0, AT_VS = 9216, AT_LQ = 9216 + 8192, AT_LUT = AT_LQ + 512;

#define AT_STAGE_STORE() do { _Pragma("unroll") for (int i = 0; i < 2; ++i) { const int c = tid + 256 * i, row = c >> 3, ch = c & 7; \
        *(u32x4*)(Ks + row * 72 + ch * 8) = rk[i]; *(u32x4*)(Vs + (ch >> 2) * 4096 + row * 64 + (ch & 3) * 16) = rv[i]; } } while (0)

__device__ __forceinline__ void at_qk(f32x16& p0, f32x16& p1, const bf16_t* Ks, const bf16x8* qr, int r32, int hi) {
    bf16x8 kf[8];
#pragma unroll
    for (int ds = 0; ds < 4; ++ds) {
        kf[2 * ds] = *(const bf16x8*)(Ks + r32 * 72 + ds * 16 + hi * 8);
        kf[2 * ds + 1] = *(const bf16x8*)(Ks + (r32 + 32) * 72 + ds * 16 + hi * 8);
    }
    __builtin_amdgcn_sched_barrier(0);
    __builtin_amdgcn_s_setprio(1);
#pragma unroll
    for (int ds = 0; ds < 4; ++ds) {
        p0 = __builtin_amdgcn_mfma_f32_32x32x16_bf16(kf[2 * ds], qr[ds], p0, 0, 0, 0);
        p1 = __builtin_amdgcn_mfma_f32_32x32x16_bf16(kf[2 * ds + 1], qr[ds], p1, 0, 0, 0);
    }
    __builtin_amdgcn_s_setprio(0);
    __builtin_amdgcn_sched_barrier(0);
}
__device__ __forceinline__ void at_pv(f32x16& o0, f32x16& o1, const f32x16& p0, const f32x16& p1, const unsigned char* Vs, int lane) {
    const int hi = lane >> 5;
    const unsigned char* vb = Vs + ((lane >> 4) & 1) * 32 + (lane & 3) * 8 + (4 * hi + ((lane & 15) >> 2)) * 64;
    bf16x8 v0[4], v1[4], pa[4];
#pragma unroll
    for (int s = 0; s < 4; ++s) {
        v0[s] = cat8(tr16(vb + s * 1024), tr16(vb + s * 1024 + 512));
        v1[s] = cat8(tr16(vb + 4096 + s * 1024), tr16(vb + 4096 + s * 1024 + 512));
    }
#pragma unroll
    for (int s = 0; s < 4; ++s) {
        u32x4 pw;
        if (s < 2) { pw.x = pk2(p0[8 * s + 0], p0[8 * s + 1]); pw.y = pk2(p0[8 * s + 2], p0[8 * s + 3]); pw.z = pk2(p0[8 * s + 4], p0[8 * s + 5]); pw.w = pk2(p0[8 * s + 6], p0[8 * s + 7]); }
        else { const int q = s - 2; pw.x = pk2(p1[8 * q + 0], p1[8 * q + 1]); pw.y = pk2(p1[8 * q + 2], p1[8 * q + 3]); pw.z = pk2(p1[8 * q + 4], p1[8 * q + 5]); pw.w = pk2(p1[8 * q + 6], p1[8 * q + 7]); }
        pa[s] = __builtin_bit_cast(bf16x8, pw);
    }
    __builtin_amdgcn_sched_barrier(0);
    __builtin_amdgcn_s_setprio(1);
#pragma unroll
    for (int s = 0; s < 4; ++s) {
        o0 = __builtin_amdgcn_mfma_f32_32x32x16_bf16(pa[s], v0[s], o0, 0, 0, 0);
        o1 = __builtin_amdgcn_mfma_f32_32x32x16_bf16(pa[s], v1[s], o1, 0, 0, 0);
    }
    __builtin_amdgcn_s_setprio(0);
    __builtin_amdgcn_sched_barrier(0);
}

__device__ __forceinline__ void at_ldv(bf16x8 (&v0)[4], bf16x8 (&v1)[4], const unsigned char* Vs, int lane) {
    const int hi = lane >> 5;
    const unsigned char* vb = Vs + ((lane >> 4) & 1) * 32 + (lane & 3) * 8 + (4 * hi + ((lane & 15) >> 2)) * 64;
#pragma unroll
    for (int s = 0; s < 4; ++s) {
        v0[s] = cat8(tr16(vb + s * 1024), tr16(vb + s * 1024 + 512));
        v1[s] = cat8(tr16(vb + 4096 + s * 1024), tr16(vb + 4096 + s * 1024 + 512));
    }
}
__device__ __forceinline__ void at_pv2(f32x16& o0, f32x16& o1, const f32x16& p0, const f32x16& p1, const bf16x8 (&v0)[4], const bf16x8 (&v1)[4]) {
    bf16x8 pa[4];
#pragma unroll
    for (int s = 0; s < 4; ++s) {
        u32x4 pw;
        if (s < 2) { pw.x = pk2(p0[8 * s + 0], p0[8 * s + 1]); pw.y = pk2(p0[8 * s + 2], p0[8 * s + 3]); pw.z = pk2(p0[8 * s + 4], p0[8 * s + 5]); pw.w = pk2(p0[8 * s + 6], p0[8 * s + 7]); }
        else { const int q = s - 2; pw.x = pk2(p1[8 * q + 0], p1[8 * q + 1]); pw.y = pk2(p1[8 * q + 2], p1[8 * q + 3]); pw.z = pk2(p1[8 * q + 4], p1[8 * q + 5]); pw.w = pk2(p1[8 * q + 6], p1[8 * q + 7]); }
        pa[s] = __builtin_bit_cast(bf16x8, pw);
    }
    __builtin_amdgcn_sched_barrier(0);
    __builtin_amdgcn_s_setprio(1);
#pragma unroll
    for (int s = 0; s < 4; ++s) {
        o0 = __builtin_amdgcn_mfma_f32_32x32x16_bf16(pa[s], v0[s], o0, 0, 0, 0);
        o1 = __builtin_amdgcn_mfma_f32_32x32x16_bf16(pa[s], v1[s], o1, 0, 0, 0);
    }
    __builtin_amdgcn_s_setprio(0);
    __builtin_amdgcn_sched_barrier(0);
}

constexpr int ATA_STAGE = 17408, ATA_LQ = 2 * ATA_STAGE;
__device__ void attn_a_item(const Params& p, int item, int l, unsigned char* smem) {
    int tid_ = VTID; asm volatile("" : "+v"(tid_));
    const int tid = tid_, lane = tid & 63, w = tid >> 6, r32 = lane & 31, hi = lane >> 5;
    const int b = item >> 9, r = item & 511, kvh = r >> 8, qblk = (r >> 2) & 63, hq = kvh * 4 + (r & 3);
    float* lq = (float*)(smem + ATA_LQ) + w * 32;
    bf16_t* QA = (bf16_t*)(p.ws + WS_QA);
    const bf16_t* GA = (const bf16_t*)(p.ws + WS_GA);
    const size_t tokq = (size_t)b * SEQ + qblk * 128 + w * 32;
    bf16x8 qr[4];
#pragma unroll
    for (int ds = 0; ds < 4; ++ds) qr[ds] = *(const bf16x8*)(QA + (tokq + r32) * 512 + hq * 64 + ds * 16 + hi * 8);
    const bf16_t* Kb = (const bf16_t*)(p.ws + WS_KA) + (size_t)b * SEQ * 128 + kvh * 64;
    const bf16_t* Vb = (const bf16_t*)(p.ws + WS_VA) + (size_t)b * SEQ * 128 + kvh * 64;
    const float nshift = -((const float*)(p.ws + WS_BND))[l];
    f32x16 o0, o1;
#pragma unroll
    for (int i = 0; i < 16; ++i) { o0[i] = 0.f; o1[i] = 0.f; }
    f32x4 la4 = (f32x4){0.f, 0.f, 0.f, 0.f};
    constexpr int NT = SEQ / 64;
    const int row0 = tid >> 3, ch0 = tid & 7;
    const size_t goff0 = (size_t)row0 * 128 + ch0 * 8, goff1 = goff0 + (size_t)32 * 128;
    const int ko0 = row0 * 144 + ch0 * 16, ko1 = ko0 + 32 * 144;
    const int vo0 = 9216 + (ch0 >> 2) * 4096 + row0 * 64 + (ch0 & 3) * 16, vo1 = vo0 + 32 * 64;
    u32x4 rkA[2], rvA[2], rkB[2], rvB[2];
#define ATA_LOAD(RK, RV, t) do { const size_t tb = (size_t)(t) * 64 * 128; RK[0] = *(const u32x4*)(Kb + tb + goff0); RK[1] = *(const u32x4*)(Kb + tb + goff1); \
        RV[0] = *(const u32x4*)(Vb + tb + goff0); RV[1] = *(const u32x4*)(Vb + tb + goff1); } while (0)
#define ATA_STORE(RK, RV, st) do { unsigned char* sb_ = smem + (st) * ATA_STAGE; *(u32x4*)(sb_ + ko0) = RK[0]; *(u32x4*)(sb_ + ko1) = RK[1]; \
        *(u32x4*)(sb_ + vo0) = RV[0]; *(u32x4*)(sb_ + vo1) = RV[1]; } while (0)
#define ATA_COMPUTE(st) do { const unsigned char* sb_ = smem + (st) * ATA_STAGE; f32x16 p0, p1; bf16x8 vf0[4], vf1[4]; \
        _Pragma("unroll") for (int i = 0; i < 16; ++i) { p0[i] = nshift; p1[i] = nshift; } \
        at_qk(p0, p1, (const bf16_t*)sb_, qr, r32, hi); \
        at_ldv(vf0, vf1, sb_ + 9216, lane); __builtin_amdgcn_sched_barrier(0); \
        _Pragma("unroll") for (int i = 0; i < 16; ++i) { p0[i] = __builtin_amdgcn_exp2f(p0[i]); p1[i] = __builtin_amdgcn_exp2f(p1[i]); } \
        _Pragma("unroll") for (int i = 0; i < 4; ++i) { la4 += (f32x4){p0[4 * i], p0[4 * i + 1], p0[4 * i + 2], p0[4 * i + 3]}; la4 += (f32x4){p1[4 * i], p1[4 * i + 1], p1[4 * i + 2], p1[4 * i + 3]}; } \
        at_pv2(o0, o1, p0, p1, vf0, vf1); } while (0)
    __syncthreads();
    ATA_LOAD(rkA, rvA, 0); ATA_LOAD(rkB, rvB, 1);
    ATA_STORE(rkA, rvA, 0);
    ATA_LOAD(rkA, rvA, 2);
    __syncthreads();
    for (int kt = 0; kt < NT; kt += 2) {
        ATA_COMPUTE(0);
        ATA_STORE(rkB, rvB, 1);
        if (kt + 3 < NT) ATA_LOAD(rkB, rvB, kt + 3);
        __syncthreads();
        ATA_COMPUTE(1);
        if (kt + 2 < NT) { ATA_STORE(rkA, rvA, 0); if (kt + 4 < NT) ATA_LOAD(rkA, rvA, kt + 4); }
        __syncthreads();
    }
#undef ATA_LOAD
#undef ATA_STORE
#undef ATA_COMPUTE
    float lacc = (la4.x + la4.y) + (la4.z + la4.w);
    lacc += __shfl_xor(lacc, 32);
    if (hi == 0) lq[r32] = lacc;
    asm volatile("s_waitcnt lgkmcnt(0)" ::: "memory");
#pragma unroll
    for (int rr = 0; rr < 16; ++rr) {
        const int q = crow(rr, hi); const float inv = 1.f / lq[q];
        const size_t off = (tokq + q) * 512 + hq * 64 + r32;
        const float g0 = bf2f(GA[off]), g1 = bf2f(GA[off + 32]);
        QA[off] = (bf16_t)(pk2(o0[rr] * inv * g0, 0.f) & 0xffffu);
        QA[off + 32] = (bf16_t)(pk2(o1[rr] * inv * g1, 0.f) & 0xffffu);
    }
}

__device__ void attn_b_item(const Params& p, int item, int l, unsigned char* smem) {
    int tid_ = VTID; asm volatile("" : "+v"(tid_));
    const int tid = tid_, lane = tid & 63, w = tid >> 6, r32 = lane & 31, hi = lane >> 5;
    const int blk = item & 63, j = (item >> 6) & 3, bg = item >> 8, g = bg % 3, b = bg / 3;
    const int sh = 2 * g, dil = 1 << sh, Mlen = SEQ >> sh;
    bf16_t* Ks = (bf16_t*)(smem + AT_KS); unsigned char* Vs = smem + AT_VS; float* lq = (float*)(smem + AT_LQ) + w * 32; float* lut = (float*)(smem + AT_LUT);
    bf16_t* QB = (bf16_t*)(p.ws + WS_QB) + (size_t)bg * SEQ * 256 + j * 64;
    const bf16_t* KB = (const bf16_t*)(p.ws + WS_KB) + (size_t)bg * SEQ * 256 + j * 64;
    const bf16_t* VB = (const bf16_t*)(p.ws + WS_VB) + (size_t)bg * SEQ * 256 + j * 64;
    float* LSE = (float*)(p.ws + WS_LSE) + (size_t)bg * SEQ * 4 + j;
    const int p0r = blk * 128, seq_lo = (p0r / Mlen) * Mlen, seq_hi = seq_lo + Mlen;
    __syncthreads();
    if (tid < 129) {
        const int rel = tid - 64, n = (rel < 0 ? -rel : rel) * dil;
        int bk;
        if (n < 8) bk = n; else { bk = 8 + (n >= 15) + (n >= 27) + (n >= 50) + (n >= 91) + (n >= 166) + (n >= 305) + (n >= 559); }
        if (rel > 0) bk += 16;
        lut[tid] = p.rel_bias[bk * 12 + g * 4 + j] * LOG2E;
    }
    const int qpos = p0r + w * 32 + r32;
    bf16x8 qr[4];
#pragma unroll
    for (int ds = 0; ds < 4; ++ds) qr[ds] = *(const bf16x8*)(QB + (size_t)qpos * 256 + ds * 16 + hi * 8);
    const float nshift = -((const float*)(p.ws + WS_BND))[2 + l];
    f32x16 o0, o1;
#pragma unroll
    for (int i = 0; i < 16; ++i) { o0[i] = 0.f; o1[i] = 0.f; }
    f32x4 la4 = (f32x4){0.f, 0.f, 0.f, 0.f};
    u32x4 rk[2], rv[2];
    for (int kt = 0; kt < 4; ++kt) {
        const int kbase = p0r - 64 + 64 * kt;
#pragma unroll
        for (int i = 0; i < 2; ++i) { const int c = tid + 256 * i, row = c >> 3, ch = c & 7;
            int pr = kbase + row; pr = pr < 0 ? 0 : (pr > SEQ - 1 ? SEQ - 1 : pr);
            rk[i] = *(const u32x4*)(KB + (size_t)pr * 256 + ch * 8); rv[i] = *(const u32x4*)(VB + (size_t)pr * 256 + ch * 8); }
        __syncthreads();
        AT_STAGE_STORE();
        __syncthreads();
        f32x16 p0, p1;
#pragma unroll
        for (int i = 0; i < 16; ++i) { p0[i] = nshift; p1[i] = nshift; }
        at_qk(p0, p1, Ks, qr, r32, hi);
#pragma unroll
        for (int i = 0; i < 16; ++i) {
            const int kv0 = kbase + crow(i, hi), kv1 = kv0 + 32;
            const int rel0 = kv0 - qpos, rel1 = kv1 - qpos;
            const bool ok0 = rel0 >= -64 && rel0 <= 64 && kv0 >= seq_lo && kv0 < seq_hi;
            const bool ok1 = rel1 >= -64 && rel1 <= 64 && kv1 >= seq_lo && kv1 < seq_hi;
            const float e0 = __builtin_amdgcn_exp2f(p0[i] + lut[ok0 ? rel0 + 64 : 64]);
            const float e1 = __builtin_amdgcn_exp2f(p1[i] + lut[ok1 ? rel1 + 64 : 64]);
            p0[i] = ok0 ? e0 : 0.f; p1[i] = ok1 ? e1 : 0.f;
        }
#pragma unroll
        for (int i = 0; i < 4; ++i) { la4 += (f32x4){p0[4 * i], p0[4 * i + 1], p0[4 * i + 2], p0[4 * i + 3]}; la4 += (f32x4){p1[4 * i], p1[4 * i + 1], p1[4 * i + 2], p1[4 * i + 3]}; }
        at_pv(o0, o1, p0, p1, Vs, lane);
    }
    float lacc = (la4.x + la4.y) + (la4.z + la4.w);
    lacc += __shfl_xor(lacc, 32);
    if (hi == 0) { lq[r32] = lacc; LSE[(size_t)qpos * 4] = (-nshift + log2f(lacc)) * LN2; }
    asm volatile("s_waitcnt lgkmcnt(0)" ::: "memory");
#pragma unroll
    for (int rr = 0; rr < 16; ++rr) {
        const int q = crow(rr, hi); const float inv = 1.f / lq[q];
        const size_t off = (size_t)(p0r + w * 32 + q) * 256 + r32;
        QB[off] = (bf16_t)(pk2(o0[rr] * inv, 0.f) & 0xffffu);
        QB[off + 32] = (bf16_t)(pk2(o1[rr] * inv, 0.f) & 0xffffu);
    }
}

__device__ void conv_phase(const Params& p, int l) {
    int tx_ = threadIdx.x; asm volatile("" : "+v"(tx_));
    const bf16_t* XBC = (const bf16_t*)(p.ws + WS_XBC);
    bf16_t* XC = (bf16_t*)(p.ws + WS_XBCC);
    const float* cw = p.conv_w + (size_t)l * 5 * 1024; const float* cb = p.conv_b + l * 1024;
    const int nthr = gridDim.x * 512;
    for (int u = blockIdx.x * 512 + tx_; u < (TP / 4) * 128; u += nthr) {
        const int ch = (u & 127) * 8, tg = u >> 7, tok0 = tg * 4, tt0 = tok0 & (SEQ - 1);
        u32x4 raw[8];
#pragma unroll
        for (int r = 0; r < 8; ++r) { const int tt = tt0 - 2 + r; raw[r] = (u32x4){0u, 0u, 0u, 0u};
            if (tt >= 0 && tt < SEQ) raw[r] = *(const u32x4*)(XBC + (size_t)(tok0 - 2 + r) * 1024 + ch); }
        float ac[4][8];
        { const f32x4 a = *(const f32x4*)(cb + ch), b2 = *(const f32x4*)(cb + ch + 4);
#pragma unroll
          for (int t = 0; t < 4; ++t) { ac[t][0] = a.x; ac[t][1] = a.y; ac[t][2] = a.z; ac[t][3] = a.w; ac[t][4] = b2.x; ac[t][5] = b2.y; ac[t][6] = b2.z; ac[t][7] = b2.w; } }
#pragma unroll
        for (int k = 0; k < 5; ++k) { const f32x4 wa = *(const f32x4*)(cw + k * 1024 + ch), wb = *(const f32x4*)(cw + k * 1024 + ch + 4);
#pragma unroll
            for (int t = 0; t < 4; ++t) { const u32x4 v = raw[t + k];
                ac[t][0] += bflo(v.x) * wa.x; ac[t][1] += bfhi(v.x) * wa.y; ac[t][2] += bflo(v.y) * wa.z; ac[t][3] += bfhi(v.y) * wa.w;
                ac[t][4] += bflo(v.z) * wb.x; ac[t][5] += bfhi(v.z) * wb.y; ac[t][6] += bflo(v.w) * wb.z; ac[t][7] += bfhi(v.w) * wb.w; } }
#pragma unroll
        for (int t = 0; t < 4; ++t) { u32x4 o;
            o.x = pk2(siluf(ac[t][0]), siluf(ac[t][1])); o.y = pk2(siluf(ac[t][2]), siluf(ac[t][3])); o.z = pk2(siluf(ac[t][4]), siluf(ac[t][5])); o.w = pk2(siluf(ac[t][6]), siluf(ac[t][7]));
            *(u32x4*)(XC + (size_t)(tok0 + t) * 1024 + ch) = o; }
    }
}

constexpr int SS_BS = 0, SS_CS = 8704, SS_XS = 17408, SS_XWS = 22016, SS_GS = 26624, SS_SB = 29184, SS_CW = 46592, SS_SC = 54272, SS_DTA = 55296, SS_END = 57344;

template <int PASS>
__device__ void ssd_item(const Params& p, int item, int l, unsigned char* smem) {
    int tid_ = VTID; asm volatile("" : "+v"(tid_));
    const int tid = tid_, lane = tid & 63, w = tid >> 6, idx = lane & 15, kq = lane >> 4;
    const int seg = item & 15, h = (item >> 4) & 7, dir = (item >> 7) & 1, b = item >> 8, grp = h >> 2;
    bf16_t* Bs = (bf16_t*)(smem + SS_BS); bf16_t* Cs = (bf16_t*)(smem + SS_CS); bf16_t* Xs = (bf16_t*)(smem + SS_XS); bf16_t* Xws = (bf16_t*)(smem + SS_XWS);
    bf16_t* Gs = (bf16_t*)(smem + SS_GS); bf16_t* Sb = (bf16_t*)(smem + SS_SB); float* sc = (float*)(smem + SS_SC);
    float* s_cA = (float*)(smem + SS_CW), *s_rsA = s_cA + SEGLEN, *s_wlA = s_rsA + SEGLEN, *s_totA = sc;
    const bf16_t* XBC = (const bf16_t*)(p.ws + WS_XBC);
    const float* DT = (const float*)(p.ws + WS_DT);
    float* ST = (float*)(p.ws + WS_ST); float* SEGT = (float*)(p.ws + WS_SEGT);
    bf16_t* Y = (bf16_t*)(p.ws + (dir ? WS_YS : WS_YF));
    const float Aneg = -__expf(p.a_log[l * 16 + dir * 8 + h]);
    const float Dh = p.d_skip[l * 8 + h];
    __syncthreads();
    f32x4 S[8];
#pragma unroll
    for (int nt = 0; nt < 8; ++nt) S[nt] = (f32x4){0.f, 0.f, 0.f, 0.f};
    const int ibase = item & ~15;
    if (PASS == 3) {
        if (dir == 0) {
            for (int e = 0; e < seg; ++e) { const float dc = __expf(SEGT[ibase + e]); const f32x4* src = (const f32x4*)(ST + (size_t)(ibase + e) * 8192);
#pragma unroll
                for (int nt = 0; nt < 8; ++nt) S[nt] = S[nt] * dc + src[(w * 8 + nt) * 64 + lane]; }
        } else {
            for (int e = NSEG - 1; e > seg; --e) { const float dc = __expf(SEGT[ibase + e]); const f32x4* src = (const f32x4*)(ST + (size_t)(ibase + e) * 8192);
#pragma unroll
                for (int nt = 0; nt < 8; ++nt) S[nt] = S[nt] * dc + src[(w * 8 + nt) * 64 + lane]; }
        }
#pragma unroll
        for (int nt = 0; nt < 8; ++nt) st4bf(Sb + (16 * w + idx) * 136 + 16 * nt + 4 * kq, S[nt]);
    }
    float* s_dta = (float*)(smem + SS_DTA);
#pragma unroll
    for (int i = 0; i < SEGLEN / 256; ++i) {
        const int e = tid + 256 * i, l32 = lane & 31;
        const float dtv = DT[((size_t)b * SEQ + seg * SEGLEN + e) * 16 + dir * 8 + h], av = dtv * Aneg;
        float pre = av;
#pragma unroll
        for (int o = 1; o < 32; o <<= 1) { const float t = __shfl_up(pre, o, 32); if (l32 >= o) pre += t; }
        const float tot = __shfl(pre, 31, 32);
        const float cc = dir ? (tot - pre + av) : pre;
        s_dta[e] = dtv; s_cA[e] = cc; s_rsA[e] = __expf(cc); s_wlA[e] = dtv * __expf(tot - cc);
        if (l32 == 0) s_totA[e >> 5] = tot;
    }
    float segtot = 0.f;
    const size_t tokb = (size_t)b * SEQ;
    const unsigned char* xb_ = (const unsigned char*)((const bf16_t*)(p.ws + WS_XBCC) + tokb * 1024);
    unsigned soff[5];
#pragma unroll
    for (int i = 0; i < 5; ++i) { const int u = tid + 256 * i, lrow = u / 40, ci = u % 40;
        const int scol = ci < 8 ? h * 64 + ci * 8 : (ci < 24 ? 512 + grp * 128 + (ci * 8 - 64) : 768 + grp * 128 + (ci * 8 - 192));
        soff[i] = (unsigned)((lrow * 1024 + scol) * 2); }
    for (int si = 0; si < NSUB; ++si) {
        const int scn = dir ? (NSUB - 1 - si) : si;
        const int t0 = seg * SEGLEN + scn * TSUB;
        __syncthreads();
        u32x4 raw[5];
#pragma unroll
        for (int i = 0; i < 5; ++i) raw[i] = *(const u32x4*)(xb_ + ((unsigned)(t0 * 2048) + soff[i]));
        const float* s_dt = s_dta + scn * TSUB; const float* s_c = s_cA + scn * TSUB; const float* s_rs = s_rsA + scn * TSUB; const float* s_wl = s_wlA + scn * TSUB;
        const float stot = s_totA[scn];
        segtot += stot;
#pragma unroll
        for (int i = 0; i < 5; ++i) { const int u = tid + 256 * i, lrow = u / 40, ci = u % 40, lc = ci * 8; const u32x4 o = raw[i];
            if (ci < 8) { *(u32x4*)(Xs + lrow * 72 + lc) = o; const float wl = s_wl[lrow];
                u32x4 o2; o2.x = pk2(bflo(o.x) * wl, bfhi(o.x) * wl); o2.y = pk2(bflo(o.y) * wl, bfhi(o.y) * wl); o2.z = pk2(bflo(o.z) * wl, bfhi(o.z) * wl); o2.w = pk2(bflo(o.w) * wl, bfhi(o.w) * wl);
                *(u32x4*)(Xws + lrow * 72 + lc) = o2; }
            else if (ci < 24) *(u32x4*)(Bs + lrow * 136 + (lc - 64)) = o;
            else *(u32x4*)(Cs + lrow * 136 + (lc - 192)) = o; }
        __syncthreads();
        if (PASS == 3) {
            const int it = w >> 1, jt = w & 1;
            f32x4 cb = (f32x4){0.f, 0.f, 0.f, 0.f};
            {
                bf16x8 fb[4], fc[4];
#pragma unroll
                for (int ks = 0; ks < 4; ++ks) { fb[ks] = *(const bf16x8*)(Bs + (16 * jt + idx) * 136 + ks * 32 + kq * 8); fc[ks] = *(const bf16x8*)(Cs + (16 * it + idx) * 136 + ks * 32 + kq * 8); }
                __builtin_amdgcn_sched_barrier(0);
#pragma unroll
                for (int ks = 0; ks < 4; ++ks) cb = __builtin_amdgcn_mfma_f32_16x16x32_bf16(fb[ks], fc[ks], cb, 0, 0, 0);
                __builtin_amdgcn_sched_barrier(0);
            }
            {
                const int ii = 16 * it + idx; const float ci_ = s_c[ii];
                f32x4 gv;
#pragma unroll
                for (int rg = 0; rg < 4; ++rg) {
                    const int jj = 16 * jt + 4 * kq + rg;
                    const bool ok = dir ? (jj >= ii) : (jj <= ii);
                    const float e = __expf(ci_ - s_c[jj]) * s_dt[jj];
                    gv[rg] = ok ? cb[rg] * e : 0.f;
                }
                st4bf(Gs + ii * 40 + 16 * jt + 4 * kq, gv);
            }
            __syncthreads();
            const unsigned char* xtr = (const unsigned char*)Xs + (8 * kq + (idx >> 2)) * 144 + (16 * w + 4 * (idx & 3)) * 2;
            const bf16x8 xf = cat8(tr16(xtr), tr16(xtr + 4 * 144));
#pragma unroll 1
            for (int it2 = 0; it2 < 2; ++it2) {
                const int ii = 16 * it2 + idx;
                const bf16x8 gf = *(const bf16x8*)(Gs + ii * 40 + 8 * kq);
                f32x4 yd = (f32x4){0.f, 0.f, 0.f, 0.f}, yo = (f32x4){0.f, 0.f, 0.f, 0.f};
                bf16x8 sf[4], cf[4];
#pragma unroll
                for (int ks = 0; ks < 4; ++ks) { sf[ks] = *(const bf16x8*)(Sb + (16 * w + idx) * 136 + ks * 32 + kq * 8); cf[ks] = *(const bf16x8*)(Cs + ii * 136 + ks * 32 + kq * 8); }
                __builtin_amdgcn_sched_barrier(0);
                yd = __builtin_amdgcn_mfma_f32_16x16x32_bf16(xf, gf, yd, 0, 0, 0);
#pragma unroll
                for (int ks = 0; ks < 4; ++ks) yo = __builtin_amdgcn_mfma_f32_16x16x32_bf16(sf[ks], cf[ks], yo, 0, 0, 0);
                __builtin_amdgcn_sched_barrier(0);
                f32x4 y = yd + yo * s_rs[ii];
                if (dir == 0) { const u32x2 xv = *(const u32x2*)(Xs + ii * 72 + 16 * w + 4 * kq);
                    y.x += Dh * bflo(xv.x); y.y += Dh * bfhi(xv.x); y.z += Dh * bflo(xv.y); y.w += Dh * bfhi(xv.y); }
                st4bf(Y + (tokb + t0 + ii) * 512 + h * 64 + 16 * w + 4 * kq, y);
            }
        }
        {
            const float dc = __expf(stot);
            const unsigned char* xw = (const unsigned char*)Xws + (8 * kq + (idx >> 2)) * 144 + (16 * w + 4 * (idx & 3)) * 2;
            const bf16x8 xwf = cat8(tr16(xw), tr16(xw + 4 * 144));
            bf16x8 bfv[8];
#pragma unroll
            for (int nt = 0; nt < 8; ++nt) {
                const unsigned char* bt = (const unsigned char*)Bs + (8 * kq + (idx >> 2)) * 272 + (16 * nt + 4 * (idx & 3)) * 2;
                bfv[nt] = cat8(tr16(bt), tr16(bt + 4 * 272));
            }
            __builtin_amdgcn_sched_barrier(0);
#pragma unroll
            for (int nt = 0; nt < 8; ++nt) S[nt] = __builtin_amdgcn_mfma_f32_16x16x32_bf16(bfv[nt], xwf, S[nt] * dc, 0, 0, 0);
            __builtin_amdgcn_sched_barrier(0);
            if (PASS == 3) {
#pragma unroll
                for (int nt = 0; nt < 8; ++nt) st4bf(Sb + (16 * w + idx) * 136 + 16 * nt + 4 * kq, S[nt]);
            }
        }
    }
    if (PASS == 1) {
        f32x4* dst = (f32x4*)(ST + (size_t)item * 8192);
#pragma unroll
        for (int nt = 0; nt < 8; ++nt) dst[(w * 8 + nt) * 64 + lane] = S[nt];
        if (tid == 0) SEGT[item] = segtot;
    }
}

__device__ void post2_phase(const Params& p) {
    int tx_ = threadIdx.x; asm volatile("" : "+v"(tx_));
    const int lane = tx_ & 63, gw = blockIdx.x * 8 + (tx_ >> 6), nw = gridDim.x * 8;
    const bf16_t* OB = (const bf16_t*)(p.ws + WS_QB); const float* LSE = (const float*)(p.ws + WS_LSE);
    const bf16_t* GB = (const bf16_t*)(p.ws + WS_GB);
    bf16_t* YBM = (bf16_t*)(p.ws + WS_YBM);
    const bf16_t* YF = (const bf16_t*)(p.ws + WS_YF); const bf16_t* YS = (const bf16_t*)(p.ws + WS_YS); const bf16_t* ZS = (const bf16_t*)(p.ws + WS_ZS);
    bf16_t* YC = (bf16_t*)(p.ws + WS_YC); float* RS = (float*)(p.ws + WS_RSTD);
    constexpr int R = 4;
    for (int row0 = gw; row0 < TP; row0 += R * nw) {
        float ls[R][3]; u32x2 ov[R][3], gt[R]; u32x4 a[R], bq[R], z[R];
        const int j = lane >> 4;
#pragma unroll
        for (int q = 0; q < R; ++q) { const int row = row0 + q * nw; if (row < TP) {
            const int bl = row >> 13, tt = row & (SEQ - 1);
#pragma unroll
            for (int g = 0; g < 3; ++g) { const int sh = 2 * g; const int pp = (tt & ((1 << sh) - 1)) * (SEQ >> sh) + (tt >> sh);
                const size_t ro = (size_t)(bl * 3 + g) * SEQ + pp; ls[q][g] = LSE[ro * 4 + j]; ov[q][g] = *(const u32x2*)(OB + ro * 256 + 4 * lane); }
            gt[q] = *(const u32x2*)(GB + (size_t)row * 256 + 4 * lane);
            a[q] = *(const u32x4*)(YF + (size_t)row * 512 + 8 * lane); bq[q] = *(const u32x4*)(YS + (size_t)row * 512 + 8 * lane); z[q] = *(const u32x4*)(ZS + (size_t)row * 512 + 8 * lane); } }
#pragma unroll
        for (int q = 0; q < R; ++q) { const int row = row0 + q * nw; if (row < TP) {
            const float mx = fmaxf(ls[q][0], fmaxf(ls[q][1], ls[q][2]));
            float wg[3]; float ws = 0.f;
#pragma unroll
            for (int g = 0; g < 3; ++g) { wg[g] = __expf(ls[q][g] - mx); ws += wg[g]; }
            const float inv = 1.f / ws;
            f32x4 acc = (f32x4){0.f, 0.f, 0.f, 0.f};
#pragma unroll
            for (int g = 0; g < 3; ++g) { const u32x2 v = ov[q][g]; const float wv = wg[g] * inv;
                acc.x += wv * bflo(v.x); acc.y += wv * bfhi(v.x); acc.z += wv * bflo(v.y); acc.w += wv * bfhi(v.y); }
            acc.x *= bflo(gt[q].x); acc.y *= bfhi(gt[q].x); acc.z *= bflo(gt[q].y); acc.w *= bfhi(gt[q].y);
            st4bf(YBM + (size_t)row * 256 + 4 * lane, acc);
            float y[8];
            y[0] = (bflo(a[q].x) + bflo(bq[q].x)) * bflo(z[q].x); y[1] = (bfhi(a[q].x) + bfhi(bq[q].x)) * bfhi(z[q].x);
            y[2] = (bflo(a[q].y) + bflo(bq[q].y)) * bflo(z[q].y); y[3] = (bfhi(a[q].y) + bfhi(bq[q].y)) * bfhi(z[q].y);
            y[4] = (bflo(a[q].z) + bflo(bq[q].z)) * bflo(z[q].z); y[5] = (bfhi(a[q].z) + bfhi(bq[q].z)) * bfhi(z[q].z);
            y[6] = (bflo(a[q].w) + bflo(bq[q].w)) * bflo(z[q].w); y[7] = (bfhi(a[q].w) + bfhi(bq[q].w)) * bfhi(z[q].w);
            float ss = 0.f;
#pragma unroll
            for (int e = 0; e < 8; ++e) ss += y[e] * y[e];
            ss = wave_sum(ss);
            u32x4 o; o.x = pk2(y[0], y[1]); o.y = pk2(y[2], y[3]); o.z = pk2(y[4], y[5]); o.w = pk2(y[6], y[7]);
            *(u32x4*)(YC + (size_t)row * 512 + 8 * lane) = o;
            if (lane == 0) RS[row] = rsqrtf(ss * (1.f / 512.f) + EPS);
        } }
    }
}


#define XB_TMO      128
#define XB_XCNT(j)  (256  + 64 * (j))
#define XB_XSUB(j)  (1280 + 64 * (j))
#define XB_XGEN(j)  (2304 + 64 * (j))
#define XB_TOP      3328
#define XB_TOPGEN   3392
#define XCD_BAR_WORDS 3456
#define XB_SPIN_CAP (1u << 20)
__device__ __forceinline__ unsigned xb_ld(unsigned* p)              { return __hip_atomic_load(p, __ATOMIC_RELAXED, __HIP_MEMORY_SCOPE_AGENT); }
__device__ __forceinline__ unsigned xb_add(unsigned* p, unsigned v) { return __hip_atomic_fetch_add(p, v, __ATOMIC_RELAXED, __HIP_MEMORY_SCOPE_AGENT); }
__device__ __forceinline__ unsigned xb_xcc_id() { return (unsigned)__builtin_amdgcn_s_getreg((3 << 11) | 20) & 0xFu; }
#define XB_SPIN(cond, bar) do { unsigned _sp = 0; while (cond) { __builtin_amdgcn_s_sleep(1); \
    if ((++_sp & 255u) == 0u) { if (xb_ld(&(bar)[XB_TMO])) break; if (_sp > XB_SPIN_CAP) { atomicAdd(&(bar)[XB_TMO], 1u); break; } } } } while (0)
struct XcdBarrier { unsigned* bar; unsigned x; volatile LDSAS unsigned* st; };
__device__ __forceinline__ XcdBarrier xcd_barrier_post(unsigned* bar, volatile LDSAS unsigned* st) {
    XcdBarrier b; b.bar = bar; b.x = xb_xcc_id(); b.st = st;
    if (threadIdx.x == 0) (void)xb_add(&bar[XB_XCNT(b.x)], 1u);
    return b;
}
__device__ __forceinline__ void xcd_barrier_complete(unsigned* bar, unsigned x, unsigned& nloc, unsigned& nx) {
    const unsigned G = gridDim.x * gridDim.y * gridDim.z;
    unsigned sum, cnt, mine, sp = 0u;
    for (;;) {
        sum = 0u; cnt = 0u; mine = 0u;
#pragma unroll
        for (unsigned j = 0; j < 16; ++j) { const unsigned c = xb_ld(&bar[XB_XCNT(j)]); sum += c; cnt += (c > 0u) ? 1u : 0u; mine = (j == x) ? c : mine; }
        if (sum == G) break;
        __builtin_amdgcn_s_sleep(1);
        if ((++sp & 255u) == 0u) { if (xb_ld(&bar[XB_TMO])) break; if (sp > XB_SPIN_CAP) { atomicAdd(&bar[XB_TMO], 1u); break; } }
    }
    nloc = mine > 0u ? mine : 1u; nx = cnt > 0u ? cnt : 1u;
}
__device__ __forceinline__ void xcd_barrier(const XcdBarrier& b) {
    asm volatile("s_waitcnt vmcnt(0)" ::: "memory");
    __syncthreads();
    if (threadIdx.x == 0) {
        unsigned* bar = b.bar;
        __builtin_amdgcn_s_waitcnt(0);
        unsigned nloc = b.st[0], nx = b.st[1];
        if (nloc == 0u) { xcd_barrier_complete(bar, b.x, nloc, nx); b.st[0] = nloc; b.st[1] = nx; }
        const unsigned old = xb_add(&bar[XB_XSUB(b.x)], 1u);
        const unsigned gen = old / nloc;
        if (old + 1u == (gen + 1u) * nloc) {
            __builtin_amdgcn_fence(__ATOMIC_RELEASE, "agent");
            asm volatile("s_waitcnt vmcnt(0)" ::: "memory");
            const unsigned og = xb_add(&bar[XB_TOP], 1u);
            const unsigned tg = og / nx;
            if (og + 1u == (tg + 1u) * nx) xb_add(&bar[XB_TOPGEN], 1u);
            else XB_SPIN(xb_ld(&bar[XB_TOPGEN]) == tg, bar);
            __builtin_amdgcn_fence(__ATOMIC_ACQUIRE, "agent");
            xb_add(&bar[XB_XGEN(b.x)], 1u);
            asm volatile("s_waitcnt vmcnt(0)" ::: "memory");
        } else {
            XB_SPIN(xb_ld(&bar[XB_XGEN(b.x)]) == gen, bar);
            __builtin_amdgcn_fence(__ATOMIC_ACQUIRE, "agent");
            asm volatile("s_waitcnt vmcnt(0)" ::: "memory");
        }
    }
    __syncthreads();
}

__device__ __forceinline__ unsigned char* lds_half(unsigned char* smem) { int h_ = threadIdx.x >> 8; asm volatile("" : "+v"(h_)); return smem + h_ * HALF_LDS; }
__global__ void __launch_bounds__(512, 2) hybrid_fwd(Params p) {
    cg::grid_group grid = cg::this_grid();
    extern __shared__ __attribute__((aligned(16))) unsigned char smem[];
    volatile LDSAS unsigned* bst = (volatile LDSAS unsigned*)(smem + LDS_TOTAL - 16);
    if (threadIdx.x < 4) bst[threadIdx.x] = 0u;
    __syncthreads();
    const XcdBarrier xbar = xcd_barrier_post((unsigned*)(p.ws + WS_BAR), bst);
    { const Params q = launder(p); phase0(q, lds_half(smem)); }
    grid.sync();
#pragma unroll 1
    for (int l = 0; l < DEPTH; ++l) {
#pragma unroll 1
        for (int hb = 0; hb < 2; ++hb) {
            { const Params q = launder(p); norm_phase(q, l, hb, (l == 0) ? q.x : q.out); }
            xcd_barrier(xbar);
            { const Params q = launder(p); gemm1_phase(q, l, hb, smem); }
            xcd_barrier(xbar);
            { const Params q = launder(p); conv_phase(q, l); }
            xcd_barrier(xbar);
            { const Params q = launder(p); unsigned char* smh = lds_half(smem);
#pragma unroll 1
              for (int it = VBLK; it < 512 + 1536; it += VGRID) { if (it < 512) ssd_item<1>(q, it, l, smh); else attn_b_item(q, it - 512, l, smh); } }
            xcd_barrier(xbar);
            { const Params q = launder(p); unsigned char* smh = lds_half(smem);
#pragma unroll 1
              for (int it = VBLK; it < 1024 + 512; it += VGRID) { if (it < 1024) attn_a_item(q, it, l, smh); else ssd_item<3>(q, it - 1024, l, smh); } }
            xcd_barrier(xbar);
            { const Params q = launder(p); post2_phase(q); }
            xcd_barrier(xbar);
            { const Params q = launder(p); merge_phase(q, l, smem); }
            xcd_barrier(xbar);
            { const Params q = launder(p); out_phase(q, l, hb, (l == 0) ? q.x : q.out, smem); }
        }
    }
}

extern "C" void kernel_launch(void* const* d_in, const int* in_sizes, int n_in, void* d_out, int out_size, void* d_ws, size_t ws_size, hipStream_t stream) {
    static int grid_blocks = 0;
    if (!grid_blocks) {
        int dev = 0, cus = 0, per_cu = 0;
        hipGetDevice(&dev);
        hipDeviceGetAttribute(&cus, hipDeviceAttributeMultiprocessorCount, dev);
        hipFuncSetAttribute((const void*)hybrid_fwd, hipFuncAttributeMaxDynamicSharedMemorySize, LDS_TOTAL);
        hipOccupancyMaxActiveBlocksPerMultiprocessor(&per_cu, hybrid_fwd, 512, LDS_TOTAL);
        if (per_cu > 1) per_cu = 1;
        if (per_cu < 1) per_cu = 1;
        grid_blocks = cus * per_cu;
    }
    Params p{};
    const float** pp = (const float**)&p;
    for (int i = 0; i < 22; ++i) pp[i] = (const float*)d_in[i];
    p.out = (float*)d_out; p.ws = (unsigned char*)d_ws;
    hipMemsetAsync((unsigned char*)d_ws + WS_BAR, 0, XCD_BAR_WORDS * 4, stream);
    void* args[] = {&p};
    hipError_t e = hipLaunchCooperativeKernel((void*)hybrid_fwd, dim3(grid_blocks), dim3(512), args, LDS_TOTAL, stream);
    if (e != hipSuccess) fprintf(stderr, "cooperative launch failed: %s (grid %d)\n", hipGetErrorString(e), grid_blocks);
}
```

```cpp
#include <hip/hip_runtime.h>
#include <hip/hip_cooperative_groups.h>
#include <cstdint>
#include <cstdio>
namespace cg = cooperative_groups;

typedef unsigned short bf16_t;
typedef short bf16x8 __attribute__((ext_vector_type(8)));
typedef short v4i16 __attribute__((ext_vector_type(4)));
typedef float f32x2 __attribute__((ext_vector_type(2)));
typedef float f32x4 __attribute__((ext_vector_type(4)));
typedef float f32x16 __attribute__((ext_vector_type(16)));
typedef unsigned u32x2 __attribute__((ext_vector_type(2)));
typedef unsigned u32x4 __attribute__((ext_vector_type(4)));
typedef __bf16 bf16x2_t __attribute__((ext_vector_type(2)));
#define LDSAS __attribute__((address_space(3)))
#define VTID ((int)(threadIdx.x & 255u))
__device__ __forceinline__ int vblk_() { int h_ = threadIdx.x >> 8; asm volatile("" : "+v"(h_)); return __builtin_amdgcn_readfirstlane(2 * (int)blockIdx.x + h_); }
#define VBLK vblk_()
#define VGRID ((int)(2u * gridDim.x))
constexpr int HALF_LDS = 73728, LDS_TOTAL = 147456;

constexpr int SEQ = 8192, DM = 1024, NBATCH = 4, NBH = 2, TP = NBH * SEQ, DEPTH = 2;
constexpr int NP = 8704;
constexpr float EPS = 1e-6f;
constexpr float LOG2E = 1.4426950408889634f, LN2 = 0.6931471805599453f;
constexpr int NSEG = 16, SEGLEN = 512, TSUB = 32, NSUB = SEGLEN / TSUB;

constexpr size_t MiB = 1u << 20;
constexpr size_t WS_WIN = 0;
constexpr size_t WS_WPA = 34 * MiB;
constexpr size_t WS_WPB = 36 * MiB;
constexpr size_t WS_WPC = 37 * MiB;
constexpr size_t WS_WOUT = 39 * MiB;
constexpr size_t WS_MOD = 43 * MiB;
constexpr size_t WS_ROPE = 43 * MiB + 128 * 1024;
constexpr size_t WS_BND = 43 * MiB + 160 * 1024;
constexpr size_t WS_RSTD = 43 * MiB + 256 * 1024;
constexpr size_t WS_SEGT = 43 * MiB + 512 * 1024;
constexpr size_t WS_LSE = 44 * MiB;
constexpr size_t WS_DT = 45 * MiB;
constexpr size_t WS_BAR = 46 * MiB;
constexpr size_t WS_H = 48 * MiB;
constexpr size_t WS_QA = 80 * MiB;
constexpr size_t WS_KA = 96 * MiB;
constexpr size_t WS_VA = 100 * MiB;
constexpr size_t WS_GA = 104 * MiB;
constexpr size_t WS_QB = 120 * MiB;
constexpr size_t WS_KB = 144 * MiB;
constexpr size_t WS_VB = 168 * MiB;
constexpr size_t WS_GB = 192 * MiB;
constexpr size_t WS_XBC = 200 * MiB;
constexpr size_t WS_ZS = 232 * MiB;
constexpr size_t WS_MG = 248 * MiB;
constexpr size_t WS_YF = 344 * MiB;
constexpr size_t WS_YS = 360 * MiB;
constexpr size_t WS_YBM = 376 * MiB;
constexpr size_t WS_YC = 384 * MiB;
constexpr size_t WS_MRG = 400 * MiB;
constexpr size_t WS_ST = 432 * MiB;
constexpr size_t WS_XBCC = 448 * MiB;

struct Params {
    const float *x, *c, *norm_w, *w_ada, *b_ada, *w_in, *b_gate, *q_norm_a, *k_norm_a, *q_norm_b, *k_norm_b, *rel_bias,
        *conv_w, *conv_b, *a_log, *dt_bias, *d_skip, *ssm_norm_w, *w_proj_a, *w_proj_b, *w_proj_c, *w_out;
    float* out;
    unsigned char* ws;
};


#define AS1 __attribute__((address_space(1)))
#define GLOBF(f) do { AS1 const float* g_ = (AS1 const float*)p.f; asm volatile("" : "+s"(g_)); q.f = (const float*)g_; } while (0)
__device__ __forceinline__ Params launder(const Params& p) {
    Params q;
    GLOBF(x); GLOBF(c); GLOBF(norm_w); GLOBF(w_ada); GLOBF(b_ada); GLOBF(w_in); GLOBF(b_gate); GLOBF(q_norm_a); GLOBF(k_norm_a); GLOBF(q_norm_b); GLOBF(k_norm_b); GLOBF(rel_bias);
    GLOBF(conv_w); GLOBF(conv_b); GLOBF(a_log); GLOBF(dt_bias); GLOBF(d_skip); GLOBF(ssm_norm_w); GLOBF(w_proj_a); GLOBF(w_proj_b); GLOBF(w_proj_c); GLOBF(w_out);
    { AS1 float* g_ = (AS1 float*)p.out; asm volatile("" : "+s"(g_)); q.out = (float*)g_; }
    { AS1 unsigned char* g_ = (AS1 unsigned char*)p.ws; asm volatile("" : "+s"(g_)); q.ws = (unsigned char*)g_; }
    return q;
}
__device__ __forceinline__ unsigned pk2(float lo, float hi) { f32x2 v = {lo, hi}; bf16x2_t b = __builtin_convertvector(v, bf16x2_t); return __builtin_bit_cast(unsigned, b); }
__device__ __forceinline__ float bf2f(unsigned short b) { return __uint_as_float(((unsigned)b) << 16); }
__device__ __forceinline__ float bflo(unsigned u) { return __uint_as_float(u << 16); }
__device__ __forceinline__ float bfhi(unsigned u) { return __uint_as_float(u & 0xffff0000u); }
__device__ __forceinline__ float siluf(float v) { return v * __builtin_amdgcn_rcpf(1.f + __builtin_amdgcn_exp2f(-1.4426950408889634f * v)); }
__device__ __forceinline__ float sigmf(float v) { return __builtin_amdgcn_rcpf(1.f + __builtin_amdgcn_exp2f(-1.4426950408889634f * v)); }
__device__ __forceinline__ float wave_sum(float v) {
#pragma unroll
    for (int o = 1; o < 64; o <<= 1) v += __shfl_xor(v, o);
    return v;
}
__device__ __forceinline__ v4i16 tr16(const unsigned char* p) { return __builtin_amdgcn_ds_read_tr16_b64_v4i16((LDSAS v4i16*)p); }
__device__ __forceinline__ bf16x8 cat8(v4i16 a, v4i16 b) { return (bf16x8){a[0], a[1], a[2], a[3], b[0], b[1], b[2], b[3]}; }
__device__ __forceinline__ int crow(int r, int hi) { return (r & 3) + 8 * (r >> 2) + 4 * hi; }

struct P0It { const float* W; bf16_t* Wt; const float* rs; int ldw, K, k0, n0, mode; };
__device__ __forceinline__ void p0_load(const P0It& t, float (&vv)[16]) {
    const int tid = VTID, tx = tid & 63, ty = tid >> 6;
    const int np = t.n0 + tx; int n = np; bool valid = true;
    if (t.mode == 1) {
        if (np < 4352) n = np; else if (np < 4864) n = np + 512; else if (np < 5376) n = np - 512;
        else if (np < 8448) n = np + 16; else if (np < 8464) n = np - 3072; else { valid = false; n = 0; }
    }
#pragma unroll
    for (int i = 0; i < 16; ++i) { const int k = ty + 4 * i; vv[i] = valid ? t.W[(size_t)(t.k0 + k) * t.ldw + n] : 0.f; }
}
__device__ __forceinline__ void p0_finish(const P0It& t, const float (&vv)[16], float* tile) {
    const int tid = VTID, tx = tid & 63, ty = tid >> 6;
#pragma unroll
    for (int i = 0; i < 16; ++i) { const int k = ty + 4 * i; float v = vv[i]; if (t.rs) v *= t.rs[t.k0 + k]; tile[k * 65 + tx] = v; }
    __syncthreads();
    const int r = tid >> 2, kc = (tid & 3) * 16;
    u32x4 o0, o1;
    o0.x = pk2(tile[(kc + 0) * 65 + r], tile[(kc + 1) * 65 + r]); o0.y = pk2(tile[(kc + 2) * 65 + r], tile[(kc + 3) * 65 + r]);
    o0.z = pk2(tile[(kc + 4) * 65 + r], tile[(kc + 5) * 65 + r]); o0.w = pk2(tile[(kc + 6) * 65 + r], tile[(kc + 7) * 65 + r]);
    o1.x = pk2(tile[(kc + 8) * 65 + r], tile[(kc + 9) * 65 + r]); o1.y = pk2(tile[(kc + 10) * 65 + r], tile[(kc + 11) * 65 + r]);
    o1.z = pk2(tile[(kc + 12) * 65 + r], tile[(kc + 13) * 65 + r]); o1.w = pk2(tile[(kc + 14) * 65 + r], tile[(kc + 15) * 65 + r]);
    bf16_t* dst = t.Wt + (size_t)(t.n0 + r) * t.K + t.k0 + kc;
    *(u32x4*)dst = o0; *(u32x4*)(dst + 8) = o1;
    __syncthreads();
}
constexpr int P0_IN = 16 * 136, P0_PA = 8 * 16, P0_PB = 4 * 16, P0_PC = 8 * 16, P0_OUT = 16 * 16, P0_L = P0_IN + P0_PA + P0_PB + P0_PC + P0_OUT;
__device__ __forceinline__ P0It p0_params(const Params& p, int item) {
    P0It t; const int l = item / P0_L; int r = item % P0_L; t.rs = nullptr; t.mode = 0;
    if (r < P0_IN) { t.W = p.w_in + (size_t)l * 1024 * 8464; t.ldw = 8464; t.K = 1024; t.Wt = (bf16_t*)(p.ws + WS_WIN) + (size_t)l * NP * 1024; t.k0 = (r / 136) * 64; t.n0 = (r % 136) * 64; t.mode = 1; return t; }
    r -= P0_IN;
    if (r < P0_PA) { t.W = p.w_proj_a + (size_t)l * 512 * 1024; t.ldw = 1024; t.K = 512; t.Wt = (bf16_t*)(p.ws + WS_WPA) + (size_t)l * 1024 * 512; t.k0 = (r / 16) * 64; t.n0 = (r % 16) * 64; return t; }
    r -= P0_PA;
    if (r < P0_PB) { t.W = p.w_proj_b + (size_t)l * 256 * 1024; t.ldw = 1024; t.K = 256; t.Wt = (bf16_t*)(p.ws + WS_WPB) + (size_t)l * 1024 * 256; t.k0 = (r / 16) * 64; t.n0 = (r % 16) * 64; return t; }
    r -= P0_PB;
    if (r < P0_PC) { t.W = p.w_proj_c + (size_t)l * 512 * 1024; t.ldw = 1024; t.K = 512; t.Wt = (bf16_t*)(p.ws + WS_WPC) + (size_t)l * 1024 * 512; t.k0 = (r / 16) * 64; t.n0 = (r % 16) * 64; t.rs = p.ssm_norm_w + l * 512; return t; }
    r -= P0_PC;
    t.W = p.w_out + (size_t)l * 1024 * 1024; t.ldw = 1024; t.K = 1024; t.Wt = (bf16_t*)(p.ws + WS_WOUT) + (size_t)l * 1024 * 1024; t.k0 = (r / 16) * 64; t.n0 = (r % 16) * 64; return t;
}

__device__ void phase0(const Params& p, unsigned char* smem) {
    const int tid = VTID;
    float* tile = (float*)smem;
    constexpr int I_T = 2 * P0_L, I_MOD = 192, I_ALL = I_T + I_MOD + 1;
    {
        int item = VBLK;
        if (item < I_T) {
            P0It cur = p0_params(p, item); float va[16], vb[16]; p0_load(cur, va);
            for (;;) {
                const int nx = item + VGRID; const bool more = nx < I_T; P0It nxt = cur;
                if (more) { nxt = p0_params(p, nx); p0_load(nxt, vb); }
                p0_finish(cur, va, tile);
                if (!more) break;
                item = nx; cur = nxt;
#pragma unroll
                for (int i = 0; i < 16; ++i) va[i] = vb[i];
            }
        }
    }
    for (int item = VBLK; item < I_ALL; item += VGRID) {
        if (item < I_T) {
            continue;
        } else if (item < I_T + I_MOD) {
            const int it = item - I_T, l = it / 96, col0 = (it % 96) * 32, cl = tid & 31, ks = tid >> 5;
            float a0 = 0.f, a1 = 0.f, a2 = 0.f, a3 = 0.f;
            const float* wp = p.w_ada + ((size_t)l * 1024 + ks * 128) * 3072 + col0 + cl;
#pragma unroll 8
            for (int k = 0; k < 128; ++k) {
                const float wv = wp[(size_t)k * 3072]; const int kk = ks * 128 + k;
                a0 += siluf(p.c[kk]) * wv; a1 += siluf(p.c[1024 + kk]) * wv; a2 += siluf(p.c[2048 + kk]) * wv; a3 += siluf(p.c[3072 + kk]) * wv;
            }
            float* red = (float*)smem;
            red[(ks * 32 + cl) * 4 + 0] = a0; red[(ks * 32 + cl) * 4 + 1] = a1; red[(ks * 32 + cl) * 4 + 2] = a2; red[(ks * 32 + cl) * 4 + 3] = a3;
            __syncthreads();
            if (tid < 128) { const int b = tid >> 5, c2 = tid & 31; float s = 0.f;
#pragma unroll
                for (int k = 0; k < 8; ++k) s += red[(k * 32 + c2) * 4 + b];
                ((float*)(p.ws + WS_MOD))[(l * 4 + b) * 3072 + col0 + c2] = s + p.b_ada[l * 3072 + col0 + c2]; }
            __syncthreads();
        } else {
            float* rc = (float*)(p.ws + WS_ROPE); float* rs = rc + 128 * 16;
            for (int e = tid; e < 2048; e += 256) {
                const int pos = e >> 4, i = e & 15;
                const float freq = powf(10000.0f, -(float)i / 16.0f);
                const float ang = (float)pos * freq;
                const double rev = (double)ang * 0.15915494309189535; const double fr = rev - rint(rev);
                const float a = (float)(fr * 6.283185307179586);
                rc[e] = cosf(a); rs[e] = sinf(a);
            }
            if (tid < 2) {
                const int l = tid; float mqa = 0.f, mka = 0.f, mqb = 0.f, mkb = 0.f, mb = 0.f;
                for (int i = 0; i < 64; ++i) { mqa = fmaxf(mqa, fabsf(p.q_norm_a[l * 64 + i])); mka = fmaxf(mka, fabsf(p.k_norm_a[l * 64 + i]));
                    mqb = fmaxf(mqb, fabsf(p.q_norm_b[l * 64 + i])); mkb = fmaxf(mkb, fabsf(p.k_norm_b[l * 64 + i])); }
                for (int i = 0; i < 32 * 12; ++i) mb = fmaxf(mb, p.rel_bias[i]);
                float* bd = (float*)(p.ws + WS_BND);
                bd[l] = 8.f * mqa * mka * LOG2E; bd[2 + l] = (8.f * mqb * mkb + mb) * LOG2E;
            }
        }
    }
}

__device__ void norm_phase(const Params& p, int l, int hb, const float* xsrc) {
    int tx_ = threadIdx.x; asm volatile("" : "+v"(tx_));
    const int lane = tx_ & 63, gw = blockIdx.x * 8 + (tx_ >> 6), nw = gridDim.x * 8;
    bf16_t* H = (bf16_t*)(p.ws + WS_H);
    const float* nwp = p.norm_w + l * 1024;
    for (int row0 = gw; row0 < TP; row0 += 4 * nw) {
        f32x4 v[4][4];
#pragma unroll
        for (int q = 0; q < 4; ++q) { const int row = row0 + q * nw;
            if (row < TP) { const f32x4* xr = (const f32x4*)(xsrc + ((size_t)hb * TP + row) * 1024);
#pragma unroll
                for (int j = 0; j < 4; ++j) v[q][j] = xr[lane + 64 * j]; } }
#pragma unroll
        for (int q = 0; q < 4; ++q) { const int row = row0 + q * nw;
            if (row < TP) {
                const size_t rg = (size_t)hb * TP + row; const int b = (int)(rg / SEQ);
                const float* md = (const float*)(p.ws + WS_MOD) + (size_t)(l * 4 + b) * 3072;
                float ss = 0.f;
#pragma unroll
                for (int j = 0; j < 4; ++j) ss += v[q][j].x * v[q][j].x + v[q][j].y * v[q][j].y + v[q][j].z * v[q][j].z + v[q][j].w * v[q][j].w;
                ss = wave_sum(ss); const float rstd = rsqrtf(ss * (1.f / 1024.f) + EPS);
#pragma unroll
                for (int j = 0; j < 4; ++j) {
                    const int col = 4 * (lane + 64 * j);
                    const f32x4 w4 = *(const f32x4*)(nwp + col), sh = *(const f32x4*)(md + col), sc = *(const f32x4*)(md + 1024 + col);
                    const f32x4 o = v[q][j] * rstd * w4 * (1.f + sc) + sh;
                    u32x2 pk; pk.x = pk2(o.x, o.y); pk.y = pk2(o.z, o.w);
                    *(u32x2*)(H + (size_t)row * 1024 + col) = pk;
                }
            } }
    }
}

constexpr int G_STAGE = 65536, G_AB = 32768;
template <bool LOWREG = false>
__device__ __forceinline__ void gemm_core(const bf16_t* __restrict__ A, int lda, const bf16_t* __restrict__ Bt, int ldb, int K, f32x4 (&acc)[8][4], unsigned char* smem, int tid) {
    asm volatile("" : "+v"(tid));
    const int lane = tid & 63, w = __builtin_amdgcn_readfirstlane(tid >> 6), wm = w >> 2, wn = w & 3, idx = lane & 15, kq = lane >> 4;
    unsigned offA[4], offB[4];
#pragma unroll
    for (int j = 0; j < 4; ++j) { const int row = (j * 8 + w) * 8 + (lane >> 3), c = (lane & 7) ^ ((row >> 1) & 7);
        offA[j] = (unsigned)(row * lda + c * 8) * 2u; offB[j] = (unsigned)(row * ldb + c * 8) * 2u; }
#pragma unroll
    for (int mi = 0; mi < 8; ++mi)
#pragma unroll
        for (int ni = 0; ni < 4; ++ni) acc[mi][ni] = (f32x4){0.f, 0.f, 0.f, 0.f};
    LDSAS unsigned char* lds = (LDSAS unsigned char*)smem;
#define G_ISSUE1(kt, st, j) do { \
        __builtin_amdgcn_global_load_lds((const unsigned*)((const char*)A + offA[j] + (kt) * 128), (LDSAS unsigned*)(lds + (st) * G_STAGE + ((j) * 8 + w) * 1024), 16, 0, 0); \
        __builtin_amdgcn_global_load_lds((const unsigned*)((const char*)Bt + offB[j] + (kt) * 128), (LDSAS unsigned*)(lds + (st) * G_STAGE + G_AB + ((j) * 8 + w) * 1024), 16, 0, 0); } while (0)
#define G_ISSUE(kt, st) do { G_ISSUE1(kt, st, 0); G_ISSUE1(kt, st, 1); G_ISSUE1(kt, st, 2); G_ISSUE1(kt, st, 3); } while (0)
    const int nk = K >> 6;
    G_ISSUE(0, 0);
    asm volatile("s_waitcnt vmcnt(0)" ::: "memory");
    __syncthreads();
    const int swz = (idx >> 1) & 7;
    const int aoff = (wm * 128 + idx) * 128, boff = G_AB + (wn * 64 + idx) * 128;
    for (int kt = 0; kt < nk; ++kt) {
        const int st = kt & 1;
        const bool more = kt + 1 < nk;
        const unsigned char* sb = smem + st * G_STAGE;
        if constexpr (!LOWREG) {
#pragma unroll
        for (int ks = 0; ks < 2; ++ks) {
            bf16x8 bfr[4], af[8];
            const int co = ((ks * 4 + kq) ^ swz) * 16;
#pragma unroll
            for (int ni = 0; ni < 4; ++ni) bfr[ni] = *(const bf16x8*)(sb + boff + ni * 2048 + co);
#pragma unroll
            for (int mi = 0; mi < 8; ++mi) af[mi] = *(const bf16x8*)(sb + aoff + mi * 2048 + co);
            if (more) { G_ISSUE1(kt + 1, st ^ 1, ks * 2); G_ISSUE1(kt + 1, st ^ 1, ks * 2 + 1); }
            __builtin_amdgcn_sched_barrier(0);
            __builtin_amdgcn_s_setprio(1);
#pragma unroll
            for (int mi = 0; mi < 8; ++mi)
#pragma unroll
                for (int ni = 0; ni < 4; ++ni) acc[mi][ni] = __builtin_amdgcn_mfma_f32_16x16x32_bf16(bfr[ni], af[mi], acc[mi][ni], 0, 0, 0);
            __builtin_amdgcn_s_setprio(0);
            __builtin_amdgcn_sched_barrier(0);
        }
        } else {
#pragma unroll
        for (int ks = 0; ks < 2; ++ks) {
            bf16x8 bfr[4];
            const int co = ((ks * 4 + kq) ^ swz) * 16;
#pragma unroll
            for (int ni = 0; ni < 4; ++ni) bfr[ni] = *(const bf16x8*)(sb + boff + ni * 2048 + co);
#pragma unroll
            for (int mh = 0; mh < 2; ++mh) {
                bf16x8 af[4];
#pragma unroll
                for (int mi = 0; mi < 4; ++mi) af[mi] = *(const bf16x8*)(sb + aoff + (mh * 4 + mi) * 2048 + co);
                if (more) G_ISSUE1(kt + 1, st ^ 1, ks * 2 + mh);
                __builtin_amdgcn_sched_barrier(0);
                __builtin_amdgcn_s_setprio(1);
#pragma unroll
                for (int mi = 0; mi < 4; ++mi)
#pragma unroll
                    for (int ni = 0; ni < 4; ++ni) acc[mh * 4 + mi][ni] = __builtin_amdgcn_mfma_f32_16x16x32_bf16(bfr[ni], af[mi], acc[mh * 4 + mi][ni], 0, 0, 0);
                __builtin_amdgcn_s_setprio(0);
                __builtin_amdgcn_sched_barrier(0);
            }
        }
        }
        asm volatile("s_waitcnt vmcnt(0)" ::: "memory");
        __syncthreads();
    }
#undef G_ISSUE1
#undef G_ISSUE
}

__device__ __forceinline__ void st4bf(bf16_t* dst, f32x4 v) { u32x2 pk; pk.x = pk2(v.x, v.y); pk.y = pk2(v.z, v.w); *(u32x2*)dst = pk; }

__device__ void gemm1_phase(const Params& p, int l, int hb, unsigned char* smem) {
    const bf16_t* H = (const bf16_t*)(p.ws + WS_H);
    const bf16_t* Wt = (const bf16_t*)(p.ws + WS_WIN) + (size_t)l * NP * 1024;
    const float* ropec = (const float*)(p.ws + WS_ROPE); const float* ropes = ropec + 2048;
    constexpr int NT = 34, NTILES = 64 * NT, GRP = 8 * NT;
    for (int t = blockIdx.x; t < NTILES; t += gridDim.x) {
        const int grp = t / GRP, r = t % GRP, jx = NT * (r & 7) + (r >> 3), mt = grp * 8 + (jx & 7), nt = jx >> 3;
        const int m0 = mt * 256, n0 = nt * 256;
        f32x4 acc[8][4];
        int tid = threadIdx.x;
        gemm_core(H + (size_t)m0 * 1024, 1024, Wt + (size_t)n0 * 1024, 1024, 1024, acc, smem, tid);
        asm volatile("" : "+v"(tid));
        const int lane = tid & 63, w = __builtin_amdgcn_readfirstlane(tid >> 6), wm = w >> 2, wn = w & 3, idx = lane & 15, kq = lane >> 4;
        const int cw = n0 + wn * 64;
        const int lc = 4 * kq;
        unsigned char* wl = smem + w * 16384;
#define G1_STG(mi_, ni_, v_) do { const int r_ = (mi_) * 16 + idx; const f32x4 t_ = (v_); u32x2 pk_; pk_.x = pk2(t_.x, t_.y); pk_.y = pk2(t_.z, t_.w); \
        *(u32x2*)(wl + r_ * 128 + ((((ni_) * 2 + (kq >> 1)) ^ (r_ & 7)) * 16) + (kq & 1) * 8) = pk_; } while (0)
        bf16_t* dbase = nullptr; int dpitch = 0, dc0 = 0, dsh = -1, dg = 0;
        if (cw < 768 && (cw < 640)) {
            const bool isq = cw < 512;
            const float* nwp = (isq ? p.q_norm_a : p.k_norm_a) + l * 64;
            dbase = isq ? (bf16_t*)(p.ws + WS_QA) : (bf16_t*)(p.ws + WS_KA);
            dpitch = isq ? 512 : 128; dc0 = isq ? cw : cw - 512;
            const float qs = isq ? 0.125f * LOG2E : 1.f;
#pragma unroll
            for (int mi = 0; mi < 8; ++mi) {
                const int row = m0 + wm * 128 + mi * 16 + idx;
                float ss = 0.f;
#pragma unroll
                for (int ni = 0; ni < 4; ++ni) { const f32x4 v = acc[mi][ni]; ss += v.x * v.x + v.y * v.y + v.z * v.z + v.w * v.w; }
                ss += __shfl_xor(ss, 16); ss += __shfl_xor(ss, 32);
                const float rstd = rsqrtf(ss * (1.f / 64.f) + EPS);
                f32x4 y[4];
#pragma unroll
                for (int ni = 0; ni < 4; ++ni) y[ni] = acc[mi][ni] * rstd * *(const f32x4*)(nwp + ni * 16 + lc);
                const int tt = row & (SEQ - 1), prow = tt >> 6, pcol = tt & 63;
#pragma unroll
                for (int hf = 0; hf < 2; ++hf) {
                    const int pos = hf ? pcol : prow;
                    const f32x4 cs = *(const f32x4*)(ropec + pos * 16 + lc), sn = *(const f32x4*)(ropes + pos * 16 + lc);
                    const f32x4 a = y[2 * hf], b = y[2 * hf + 1];
                    y[2 * hf] = a * cs - b * sn; y[2 * hf + 1] = b * cs + a * sn;
                }
#pragma unroll
                for (int ni = 0; ni < 4; ++ni) G1_STG(mi, ni, y[ni] * qs);
            }
        } else if (cw >= 1280 && cw < 2816) {
            const bool isq = cw < 2048;
            const float* nwp = (isq ? p.q_norm_b : p.k_norm_b) + l * 64;
            const int gc = isq ? cw - 1280 : cw - 2048;
            dg = gc >> 8; dc0 = gc & 255; dsh = 2 * dg; dpitch = 256;
            dbase = (bf16_t*)(p.ws + (isq ? WS_QB : WS_KB));
            const float qs = isq ? 0.125f * LOG2E : 1.f;
#pragma unroll
            for (int mi = 0; mi < 8; ++mi) {
                float ss = 0.f;
#pragma unroll
                for (int ni = 0; ni < 4; ++ni) { const f32x4 v = acc[mi][ni]; ss += v.x * v.x + v.y * v.y + v.z * v.z + v.w * v.w; }
                ss += __shfl_xor(ss, 16); ss += __shfl_xor(ss, 32);
                const float rstd = rsqrtf(ss * (1.f / 64.f) + EPS) * qs;
#pragma unroll
                for (int ni = 0; ni < 4; ++ni) G1_STG(mi, ni, acc[mi][ni] * rstd * *(const f32x4*)(nwp + ni * 16 + lc));
            }
        } else if (cw >= 2816 && cw < 3584) {
            const int gc = cw - 2816;
            dg = gc >> 8; dc0 = gc & 255; dsh = 2 * dg; dpitch = 256; dbase = (bf16_t*)(p.ws + WS_VB);
#pragma unroll
            for (int mi = 0; mi < 8; ++mi)
#pragma unroll
                for (int ni = 0; ni < 4; ++ni) G1_STG(mi, ni, acc[mi][ni]);
        } else if (cw >= 8448) {
            if (cw == 8448) {
                float* dst = (float*)(p.ws + WS_DT);
                const f32x4 bias = *(const f32x4*)(p.dt_bias + l * 16 + lc);
#pragma unroll
                for (int mi = 0; mi < 8; ++mi) {
                    const int row = m0 + wm * 128 + mi * 16 + idx;
                    f32x4 v = acc[mi][0] + bias, o;
                    o.x = v.x > 20.f ? v.x : log1pf(__expf(v.x)); o.y = v.y > 20.f ? v.y : log1pf(__expf(v.y));
                    o.z = v.z > 20.f ? v.z : log1pf(__expf(v.z)); o.w = v.w > 20.f ? v.w : log1pf(__expf(v.w));
                    *(f32x4*)(dst + (size_t)row * 16 + lc) = o;
                }
            }
        } else {
            int mode;
            if (cw < 768) { dbase = (bf16_t*)(p.ws + WS_VA); dpitch = 128; dc0 = cw - 640; mode = 0; }
            else if (cw < 1280) { dbase = (bf16_t*)(p.ws + WS_GA); dpitch = 512; dc0 = cw - 768; mode = 1; }
            else if (cw < 3840) { dbase = (bf16_t*)(p.ws + WS_GB); dpitch = 256; dc0 = cw - 3584; mode = 1; }
            else if (cw < 4864) { dbase = (bf16_t*)(p.ws + WS_XBC); dpitch = 1024; dc0 = cw - 3840; mode = 0; }
            else if (cw < 5376) { dbase = (bf16_t*)(p.ws + WS_ZS); dpitch = 512; dc0 = cw - 4864; mode = 1; }
            else { dbase = (bf16_t*)(p.ws + WS_MG); dpitch = 3072; dc0 = cw - 5376; mode = 2; }
            const float* bg = p.b_gate + l * 3072 + dc0 + lc;
#pragma unroll
            for (int mi = 0; mi < 8; ++mi) {
#pragma unroll
                for (int ni = 0; ni < 4; ++ni) {
                    f32x4 v = acc[mi][ni];
                    if (mode == 1) { v.x = siluf(v.x); v.y = siluf(v.y); v.z = siluf(v.z); v.w = siluf(v.w); }
                    else if (mode == 2) { const f32x4 bb = *(const f32x4*)(bg + ni * 16); v.x = sigmf(v.x + bb.x); v.y = sigmf(v.y + bb.y); v.z = sigmf(v.z + bb.z); v.w = sigmf(v.w + bb.w); }
                    G1_STG(mi, ni, v);
                }
            }
        }
#undef G1_STG
        if (dbase) {
            const int ch = lane & 7;
#pragma unroll
            for (int j = 0; j < 16; ++j) {
                const int rl = 8 * j + (lane >> 3), row = m0 + wm * 128 + rl;
                const u32x4 v = *(const u32x4*)(wl + rl * 128 + ((ch ^ (rl & 7)) * 16));
                size_t drow = (size_t)row;
                if (dsh >= 0) { const int bl = row >> 13, tt = row & (SEQ - 1); drow = (size_t)(bl * 3 + dg) * SEQ + (size_t)((tt & ((1 << dsh) - 1)) * (SEQ >> dsh) + (tt >> dsh)); }
                *(u32x4*)(dbase + drow * dpitch + dc0 + ch * 8) = v;
            }
        }
        __syncthreads();
    }
}

__device__ void merge_phase(const Params& p, int l, unsigned char* smem) {
    const bf16_t* MG = (const bf16_t*)(p.ws + WS_MG);
    const float* rstd = (const float*)(p.ws + WS_RSTD);
    bf16_t* MR = (bf16_t*)(p.ws + WS_MRG);
    for (int t = blockIdx.x; t < 64 * 4; t += gridDim.x) {
        const int xq = t >> 3, mt = (xq >> 2) * 8 + (t & 7), nt = xq & 3, m0 = mt * 256, n0 = nt * 256;
        u32x2 mpk[6][4];
#pragma unroll 1
        for (int br = 0; br < 3; ++br) {
            f32x4 acc[8][4];
            const bf16_t* A; const bf16_t* Bt; int K;
            if (br == 0) { A = (const bf16_t*)(p.ws + WS_QA); K = 512; Bt = (const bf16_t*)(p.ws + WS_WPA) + (size_t)l * 1024 * 512; }
            else if (br == 1) { A = (const bf16_t*)(p.ws + WS_YBM); K = 256; Bt = (const bf16_t*)(p.ws + WS_WPB) + (size_t)l * 1024 * 256; }
            else { A = (const bf16_t*)(p.ws + WS_YC); K = 512; Bt = (const bf16_t*)(p.ws + WS_WPC) + (size_t)l * 1024 * 512; }
            int tid = threadIdx.x;
            gemm_core<true>(A + (size_t)m0 * K, K, Bt + (size_t)n0 * K, K, K, acc, smem, tid);
            asm volatile("" : "+v"(tid));
            const int lane = tid & 63, w = tid >> 6, wm = w >> 2, wn = w & 3, idx = lane & 15, kq = lane >> 4;
#pragma unroll
            for (int mi = 0; mi < 8; ++mi) {
                const int row = m0 + wm * 128 + mi * 16 + idx;
                const float rs = (br == 2) ? rstd[row] : 1.f;
#pragma unroll
                for (int ni = 0; ni < 4; ++ni) {
                    const int col = n0 + wn * 64 + ni * 16 + 4 * kq;
                    const u32x2 g = *(const u32x2*)(MG + (size_t)row * 3072 + br * 1024 + col);
                    f32x4 gv; gv.x = bflo(g.x); gv.y = bfhi(g.x); gv.z = bflo(g.y); gv.w = bfhi(g.y);
                    f32x4 v = gv * rs * acc[mi][ni];
                    bf16_t* mp = MR + (size_t)row * 1024 + col;
                    if (mi < 6) {
                        if (br > 0) { const u32x2 o = mpk[mi < 6 ? mi : 0][ni]; v.x += bflo(o.x); v.y += bfhi(o.x); v.z += bflo(o.y); v.w += bfhi(o.y); }
                        u32x2 pk; pk.x = pk2(v.x, v.y); pk.y = pk2(v.z, v.w); mpk[mi < 6 ? mi : 0][ni] = pk;
                        if (br == 2) *(u32x2*)mp = pk;
                    } else {
                        if (br > 0) { const u32x2 o = *(const u32x2*)mp; v.x += bflo(o.x); v.y += bfhi(o.x); v.z += bflo(o.y); v.w += bfhi(o.y); }
                        st4bf(mp, v);
                    }
                }
            }
        }
    }
}

__device__ void out_phase(const Params& p, int l, int hb, const float* xsrc, unsigned char* smem) {
    const bf16_t* MR = (const bf16_t*)(p.ws + WS_MRG);
    const bf16_t* Wt = (const bf16_t*)(p.ws + WS_WOUT) + (size_t)l * 1024 * 1024;
    for (int t = blockIdx.x; t < 64 * 4; t += gridDim.x) {
        const int xq = t >> 3, mt = (xq >> 2) * 8 + (t & 7), nt = xq & 3, m0 = mt * 256, n0 = nt * 256;
        f32x4 acc[8][4];
        int tid = threadIdx.x;
        gemm_core(MR + (size_t)m0 * 1024, 1024, Wt + (size_t)n0 * 1024, 1024, 1024, acc, smem, tid);
        asm volatile("" : "+v"(tid));
        const int lane = tid & 63, w = tid >> 6, wm = w >> 2, wn = w & 3, idx = lane & 15, kq = lane >> 4;
#pragma unroll
        for (int mi = 0; mi < 8; ++mi) {
            const int row = m0 + wm * 128 + mi * 16 + idx; const size_t rg = (size_t)hb * TP + row; const int b = (int)(rg / SEQ);
            const float* gate = (const float*)(p.ws + WS_MOD) + (size_t)(l * 4 + b) * 3072 + 2048;
#pragma unroll
            for (int ni = 0; ni < 4; ++ni) {
                const int col = n0 + wn * 64 + ni * 16 + 4 * kq;
                const f32x4 xv = *(const f32x4*)(xsrc + rg * 1024 + col), gv = *(const f32x4*)(gate + col);
                *(f32x4*)(p.out + rg * 1024 + col) = xv + gv * acc[mi][ni];
            }
        }
    }
}

constexpr int AT_KS = 0, AT_VS = 9216, AT_LQ = 9216 + 8192, AT_LUT = AT_LQ + 512;

#define AT_STAGE_STORE() do { _Pragma("unroll") for (int i = 0; i < 2; ++i) { const int c = tid + 256 * i, row = c >> 3, ch = c & 7; \
        *(u32x4*)(Ks + row * 72 + ch * 8) = rk[i]; *(u32x4*)(Vs + (ch >> 2) * 4096 + row * 64 + (ch & 3) * 16) = rv[i]; } } while (0)

__device__ __forceinline__ void at_qk(f32x16& p0, f32x16& p1, const bf16_t* Ks, const bf16x8* qr, int r32, int hi) {
    bf16x8 kf[8];
#pragma unroll
    for (int ds = 0; ds < 4; ++ds) {
        kf[2 * ds] = *(const bf16x8*)(Ks + r32 * 72 + ds * 16 + hi * 8);
        kf[2 * ds + 1] = *(const bf16x8*)(Ks + (r32 + 32) * 72 + ds * 16 + hi * 8);
    }
    __builtin_amdgcn_sched_barrier(0);
    __builtin_amdgcn_s_setprio(1);
#pragma unroll
    for (int ds = 0; ds < 4; ++ds) {
        p0 = __builtin_amdgcn_mfma_f32_32x32x16_bf16(kf[2 * ds], qr[ds], p0, 0, 0, 0);
        p1 = __builtin_amdgcn_mfma_f32_32x32x16_bf16(kf[2 * ds + 1], qr[ds], p1, 0, 0, 0);
    }
    __builtin_amdgcn_s_setprio(0);
    __builtin_amdgcn_sched_barrier(0);
}
__device__ __forceinline__ void at_pv(f32x16& o0, f32x16& o1, const f32x16& p0, const f32x16& p1, const unsigned char* Vs, int lane) {
    const int hi = lane >> 5;
    const unsigned char* vb = Vs + ((lane >> 4) & 1) * 32 + (lane & 3) * 8 + (4 * hi + ((lane & 15) >> 2)) * 64;
    bf16x8 v0[4], v1[4], pa[4];
#pragma unroll
    for (int s = 0; s < 4; ++s) {
        v0[s] = cat8(tr16(vb + s * 1024), tr16(vb + s * 1024 + 512));
        v1[s] = cat8(tr16(vb + 4096 + s * 1024), tr16(vb + 4096 + s * 1024 + 512));
    }
#pragma unroll
    for (int s = 0; s < 4; ++s) {
        u32x4 pw;
        if (s < 2) { pw.x = pk2(p0[8 * s + 0], p0[8 * s + 1]); pw.y = pk2(p0[8 * s + 2], p0[8 * s + 3]); pw.z = pk2(p0[8 * s + 4], p0[8 * s + 5]); pw.w = pk2(p0[8 * s + 6], p0[8 * s + 7]); }
        else { const int q = s - 2; pw.x = pk2(p1[8 * q + 0], p1[8 * q + 1]); pw.y = pk2(p1[8 * q + 2], p1[8 * q + 3]); pw.z = pk2(p1[8 * q + 4], p1[8 * q + 5]); pw.w = pk2(p1[8 * q + 6], p1[8 * q + 7]); }
        pa[s] = __builtin_bit_cast(bf16x8, pw);
    }
    __builtin_amdgcn_sched_barrier(0);
    __builtin_amdgcn_s_setprio(1);
#pragma unroll
    for (int s = 0; s < 4; ++s) {
        o0 = __builtin_amdgcn_mfma_f32_32x32x16_bf16(pa[s], v0[s], o0, 0, 0, 0);
        o1 = __builtin_amdgcn_mfma_f32_32x32x16_bf16(pa[s], v1[s], o1, 0, 0, 0);
    }
    __builtin_amdgcn_s_setprio(0);
    __builtin_amdgcn_sched_barrier(0);
}

__device__ __forceinline__ void at_ldv(bf16x8 (&v0)[4], bf16x8 (&v1)[4], const unsigned char* Vs, int lane) {
    const int hi = lane >> 5;
    const unsigned char* vb = Vs + ((lane >> 4) & 1) * 32 + (lane & 3) * 8 + (4 * hi + ((lane & 15) >> 2)) * 64;
#pragma unroll
    for (int s = 0; s < 4; ++s) {
        v0[s] = cat8(tr16(vb + s * 1024), tr16(vb + s * 1024 + 512));
        v1[s] = cat8(tr16(vb + 4096 + s * 1024), tr16(vb + 4096 + s * 1024 + 512));
    }
}
__device__ __forceinline__ void at_pv2(f32x16& o0, f32x16& o1, const f32x16& p0, const f32x16& p1, const bf16x8 (&v0)[4], const bf16x8 (&v1)[4]) {
    bf16x8 pa[4];
#pragma unroll
    for (int s = 0; s < 4; ++s) {
        u32x4 pw;
        if (s < 2) { pw.x = pk2(p0[8 * s + 0], p0[8 * s + 1]); pw.y = pk2(p0[8 * s + 2], p0[8 * s + 3]); pw.z = pk2(p0[8 * s + 4], p0[8 * s + 5]); pw.w = pk2(p0[8 * s + 6], p0[8 * s + 7]); }
        else { const int q = s - 2; pw.x = pk2(p1[8 * q + 0], p1[8 * q + 1]); pw.y = pk2(p1[8 * q + 2], p1[8 * q + 3]); pw.z = pk2(p1[8 * q + 4], p1[8 * q + 5]); pw.w = pk2(p1[8 * q + 6], p1[8 * q + 7]); }
        pa[s] = __builtin_bit_cast(bf16x8, pw);
    }
    __builtin_amdgcn_sched_barrier(0);
    __builtin_amdgcn_s_setprio(1);
#pragma unroll
    for (int s = 0; s < 4; ++s) {
        o0 = __builtin_amdgcn_mfma_f32_32x32x16_bf16(pa[s], v0[s], o0, 0, 0, 0);
        o1 = __builtin_amdgcn_mfma_f32_32x32x16_bf16(pa[s], v1[s], o1, 0, 0, 0);
    }
    __builtin_amdgcn_s_setprio(0);
    __builtin_amdgcn_sched_barrier(0);
}

constexpr int ATA_STAGE = 17408, ATA_LQ = 2 * ATA_STAGE;
__device__ void attn_a_item(const Params& p, int item, int l, unsigned char* smem) {
    int tid_ = VTID; asm volatile("" : "+v"(tid_));
    const int tid = tid_, lane = tid & 63, w = tid >> 6, r32 = lane & 31, hi = lane >> 5;
    const int b = item >> 9, r = item & 511, kvh = r >> 8, qblk = (r >> 2) & 63, hq = kvh * 4 + (r & 3);
    float* lq = (float*)(smem + ATA_LQ) + w * 32;
    bf16_t* QA = (bf16_t*)(p.ws + WS_QA);
    const bf16_t* GA = (const bf16_t*)(p.ws + WS_GA);
    const size_t tokq = (size_t)b * SEQ + qblk * 128 + w * 32;
    bf16x8 qr[4];
#pragma unroll
    for (int ds = 0; ds < 4; ++ds) qr[ds] = *(const bf16x8*)(QA + (tokq + r32) * 512 + hq * 64 + ds * 16 + hi * 8);
    const bf16_t* Kb = (const bf16_t*)(p.ws + WS_KA) + (size_t)b * SEQ * 128 + kvh * 64;
    const bf16_t* Vb = (const bf16_t*)(p.ws + WS_VA) + (size_t)b * SEQ * 128 + kvh * 64;
    const float nshift = -((const float*)(p.ws + WS_BND))[l];
    f32x16 o0, o1;
#pragma unroll
    for (int i = 0; i < 16; ++i) { o0[i] = 0.f; o1[i] = 0.f; }
    f32x4 la4 = (f32x4){0.f, 0.f, 0.f, 0.f};
    constexpr int NT = SEQ / 64;
    const int row0 = tid >> 3, ch0 = tid & 7;
    const size_t goff0 = (size_t)row0 * 128 + ch0 * 8, goff1 = goff0 + (size_t)32 * 128;
    const int ko0 = row0 * 144 + ch0 * 16, ko1 = ko0 + 32 * 144;
    const int vo0 = 9216 + (ch0 >> 2) * 4096 + row0 * 64 + (ch0 & 3) * 16, vo1 = vo0 + 32 * 64;
    u32x4 rkA[2], rvA[2], rkB[2], rvB[2];
#define ATA_LOAD(RK, RV, t) do { const size_t tb = (size_t)(t) * 64 * 128; RK[0] = *(const u32x4*)(Kb + tb + goff0); RK[1] = *(const u32x4*)(Kb + tb + goff1); \
        RV[0] = *(const u32x4*)(Vb + tb + goff0); RV[1] = *(const u32x4*)(Vb + tb + goff1); } while (0)
#define ATA_STORE(RK, RV, st) do { unsigned char* sb_ = smem + (st) * ATA_STAGE; *(u32x4*)(sb_ + ko0) = RK[0]; *(u32x4*)(sb_ + ko1) = RK[1]; \
        *(u32x4*)(sb_ + vo0) = RV[0]; *(u32x4*)(sb_ + vo1) = RV[1]; } while (0)
#define ATA_COMPUTE(st) do { const unsigned char* sb_ = smem + (st) * ATA_STAGE; f32x16 p0, p1; bf16x8 vf0[4], vf1[4]; \
        _Pragma("unroll") for (int i = 0; i < 16; ++i) { p0[i] = nshift; p1[i] = nshift; } \
        at_qk(p0, p1, (const bf16_t*)sb_, qr, r32, hi); \
        at_ldv(vf0, vf1, sb_ + 9216, lane); __builtin_amdgcn_sched_barrier(0); \
        _Pragma("unroll") for (int i = 0; i < 16; ++i) { p0[i] = __builtin_amdgcn_exp2f(p0[i]); p1[i] = __builtin_amdgcn_exp2f(p1[i]); } \
        _Pragma("unroll") for (int i = 0; i < 4; ++i) { la4 += (f32x4){p0[4 * i], p0[4 * i + 1], p0[4 * i + 2], p0[4 * i + 3]}; la4 += (f32x4){p1[4 * i], p1[4 * i + 1], p1[4 * i + 2], p1[4 * i + 3]}; } \
        at_pv2(o0, o1, p0, p1, vf0, vf1); } while (0)
    __syncthreads();
    ATA_LOAD(rkA, rvA, 0); ATA_LOAD(rkB, rvB, 1);
    ATA_STORE(rkA, rvA, 0);
    ATA_LOAD(rkA, rvA, 2);
    __syncthreads();
    for (int kt = 0; kt < NT; kt += 2) {
        ATA_COMPUTE(0);
        ATA_STORE(rkB, rvB, 1);
        if (kt + 3 < NT) ATA_LOAD(rkB, rvB, kt + 3);
        __syncthreads();
        ATA_COMPUTE(1);
        if (kt + 2 < NT) { ATA_STORE(rkA, rvA, 0); if (kt + 4 < NT) ATA_LOAD(rkA, rvA, kt + 4); }
        __syncthreads();
    }
#undef ATA_LOAD
#undef ATA_STORE
#undef ATA_COMPUTE
    float lacc = (la4.x + la4.y) + (la4.z + la4.w);
    lacc += __shfl_xor(lacc, 32);
    if (hi == 0) lq[r32] = lacc;
    asm volatile("s_waitcnt lgkmcnt(0)" ::: "memory");
#pragma unroll
    for (int rr = 0; rr < 16; ++rr) {
        const int q = crow(rr, hi); const float inv = 1.f / lq[q];
        const size_t off = (tokq + q) * 512 + hq * 64 + r32;
        const float g0 = bf2f(GA[off]), g1 = bf2f(GA[off + 32]);
        QA[off] = (bf16_t)(pk2(o0[rr] * inv * g0, 0.f) & 0xffffu);
        QA[off + 32] = (bf16_t)(pk2(o1[rr] * inv * g1, 0.f) & 0xffffu);
    }
}

__device__ void attn_b_item(const Params& p, int item, int l, unsigned char* smem) {
    int tid_ = VTID; asm volatile("" : "+v"(tid_));
    const int tid = tid_, lane = tid & 63, w = tid >> 6, r32 = lane & 31, hi = lane >> 5;
    const int blk = item & 63, j = (item >> 6) & 3, bg = item >> 8, g = bg % 3, b = bg / 3;
    const int sh = 2 * g, dil = 1 << sh, Mlen = SEQ >> sh;
    bf16_t* Ks = (bf16_t*)(smem + AT_KS); unsigned char* Vs = smem + AT_VS; float* lq = (float*)(smem + AT_LQ) + w * 32; float* lut = (float*)(smem + AT_LUT);
    bf16_t* QB = (bf16_t*)(p.ws + WS_QB) + (size_t)bg * SEQ * 256 + j * 64;
    const bf16_t* KB = (const bf16_t*)(p.ws + WS_KB) + (size_t)bg * SEQ * 256 + j * 64;
    const bf16_t* VB = (const bf16_t*)(p.ws + WS_VB) + (size_t)bg * SEQ * 256 + j * 64;
    float* LSE = (float*)(p.ws + WS_LSE) + (size_t)bg * SEQ * 4 + j;
    const int p0r = blk * 128, seq_lo = (p0r / Mlen) * Mlen, seq_hi = seq_lo + Mlen;
    __syncthreads();
    if (tid < 129) {
        const int rel = tid - 64, n = (rel < 0 ? -rel : rel) * dil;
        int bk;
        if (n < 8) bk = n; else { bk = 8 + (n >= 15) + (n >= 27) + (n >= 50) + (n >= 91) + (n >= 166) + (n >= 305) + (n >= 559); }
        if (rel > 0) bk += 16;
        lut[tid] = p.rel_bias[bk * 12 + g * 4 + j] * LOG2E;
    }
    const int qpos = p0r + w * 32 + r32;
    bf16x8 qr[4];
#pragma unroll
    for (int ds = 0; ds < 4; ++ds) qr[ds] = *(const bf16x8*)(QB + (size_t)qpos * 256 + ds * 16 + hi * 8);
    const float nshift = -((const float*)(p.ws + WS_BND))[2 + l];
    f32x16 o0, o1;
#pragma unroll
    for (int i = 0; i < 16; ++i) { o0[i] = 0.f; o1[i] = 0.f; }
    f32x4 la4 = (f32x4){0.f, 0.f, 0.f, 0.f};
    u32x4 rk[2], rv[2];
    for (int kt = 0; kt < 4; ++kt) {
        const int kbase = p0r - 64 + 64 * kt;
#pragma unroll
        for (int i = 0; i < 2; ++i) { const int c = tid + 256 * i, row = c >> 3, ch = c & 7;
            int pr = kbase + row; pr = pr < 0 ? 0 : (pr > SEQ - 1 ? SEQ - 1 : pr);
            rk[i] = *(const u32x4*)(KB + (size_t)pr * 256 + ch * 8); rv[i] = *(const u32x4*)(VB + (size_t)pr * 256 + ch * 8); }
        __syncthreads();
        AT_STAGE_STORE();
        __syncthreads();
        f32x16 p0, p1;
#pragma unroll
        for (int i = 0; i < 16; ++i) { p0[i] = nshift; p1[i] = nshift; }
        at_qk(p0, p1, Ks, qr, r32, hi);
#pragma unroll
        for (int i = 0; i < 16; ++i) {
            const int kv0 = kbase + crow(i, hi), kv1 = kv0 + 32;
            const int rel0 = kv0 - qpos, rel1 = kv1 - qpos;
            const bool ok0 = rel0 >= -64 && rel0 <= 64 && kv0 >= seq_lo && kv0 < seq_hi;
            const bool ok1 = rel1 >= -64 && rel1 <= 64 && kv1 >= seq_lo && kv1 < seq_hi;
            const float e0 = __builtin_amdgcn_exp2f(p0[i] + lut[ok0 ? rel0 + 64 : 64]);
            const float e1 = __builtin_amdgcn_exp2f(p1[i] + lut[ok1 ? rel1 + 64 : 64]);
            p0[i] = ok0 ? e0 : 0.f; p1[i] = ok1 ? e1 : 0.f;
        }
#pragma unroll
        for (int i = 0; i < 4; ++i) { la4 += (f32x4){p0[4 * i], p0[4 * i + 1], p0[4 * i + 2], p0[4 * i + 3]}; la4 += (f32x4){p1[4 * i], p1[4 * i + 1], p1[4 * i + 2], p1[4 * i + 3]}; }
        at_pv(o0, o1, p0, p1, Vs, lane);
    }
    float lacc = (la4.x + la4.y) + (la4.z + la4.w);
    lacc += __shfl_xor(lacc, 32);
    if (hi == 0) { lq[r32] = lacc; LSE[(size_t)qpos * 4] = (-nshift + log2f(lacc)) * LN2; }
    asm volatile("s_waitcnt lgkmcnt(0)" ::: "memory");
#pragma unroll
    for (int rr = 0; rr < 16; ++rr) {
        const int q = crow(rr, hi); const float inv = 1.f / lq[q];
        const size_t off = (size_t)(p0r + w * 32 + q) * 256 + r32;
        QB[off] = (bf16_t)(pk2(o0[rr] * inv, 0.f) & 0xffffu);
        QB[off + 32] = (bf16_t)(pk2(o1[rr] * inv, 0.f) & 0xffffu);
    }
}

__device__ void conv_phase(const Params& p, int l) {
    int tx_ = threadIdx.x; asm volatile("" : "+v"(tx_));
    const bf16_t* XBC = (const bf16_t*)(p.ws + WS_XBC);
    bf16_t* XC = (bf16_t*)(p.ws + WS_XBCC);
    const float* cw = p.conv_w + (size_t)l * 5 * 1024; const float* cb = p.conv_b + l * 1024;
    const int nthr = gridDim.x * 512;
    for (int u = blockIdx.x * 512 + tx_; u < (TP / 4) * 128; u += nthr) {
        const int ch = (u & 127) * 8, tg = u >> 7, tok0 = tg * 4, tt0 = tok0 & (SEQ - 1);
        u32x4 raw[8];
#pragma unroll
        for (int r = 0; r < 8; ++r) { const int tt = tt0 - 2 + r; raw[r] = (u32x4){0u, 0u, 0u, 0u};
            if (tt >= 0 && tt < SEQ) raw[r] = *(const u32x4*)(XBC + (size_t)(tok0 - 2 + r) * 1024 + ch); }
        float ac[4][8];
        { const f32x4 a = *(const f32x4*)(cb + ch), b2 = *(const f32x4*)(cb + ch + 4);
#pragma unroll
          for (int t = 0; t < 4; ++t) { ac[t][0] = a.x; ac[t][1] = a.y; ac[t][2] = a.z; ac[t][3] = a.w; ac[t][4] = b2.x; ac[t][5] = b2.y; ac[t][6] = b2.z; ac[t][7] = b2.w; } }
#pragma unroll
        for (int k = 0; k < 5; ++k) { const f32x4 wa = *(const f32x4*)(cw + k * 1024 + ch), wb = *(const f32x4*)(cw + k * 1024 + ch + 4);
#pragma unroll
            for (int t = 0; t < 4; ++t) { const u32x4 v = raw[t + k];
                ac[t][0] += bflo(v.x) * wa.x; ac[t][1] += bfhi(v.x) * wa.y; ac[t][2] += bflo(v.y) * wa.z; ac[t][3] += bfhi(v.y) * wa.w;
                ac[t][4] += bflo(v.z) * wb.x; ac[t][5] += bfhi(v.z) * wb.y; ac[t][6] += bflo(v.w) * wb.z; ac[t][7] += bfhi(v.w) * wb.w; } }
#pragma unroll
        for (int t = 0; t < 4; ++t) { u32x4 o;
            o.x = pk2(siluf(ac[t][0]), siluf(ac[t][1])); o.y = pk2(siluf(ac[t][2]), siluf(ac[t][3])); o.z = pk2(siluf(ac[t][4]), siluf(ac[t][5])); o.w = pk2(siluf(ac[t][6]), siluf(ac[t][7]));
            *(u32x4*)(XC + (size_t)(tok0 + t) * 1024 + ch) = o; }
    }
}

constexpr int SS_BS = 0, SS_CS = 8704, SS_XS = 17408, SS_XWS = 22016, SS_GS = 26624, SS_SB = 29184, SS_CW = 46592, SS_SC = 54272, SS_DTA = 55296, SS_END = 57344;

template <int PASS>
__device__ void ssd_item(const Params& p, int item, int l, unsigned char* smem) {
    int tid_ = VTID; asm volatile("" : "+v"(tid_));
    const int tid = tid_, lane = tid & 63, w = tid >> 6, idx = lane & 15, kq = lane >> 4;
    const int seg = item & 15, h = (item >> 4) & 7, dir = (item >> 7) & 1, b = item >> 8, grp = h >> 2;
    bf16_t* Bs = (bf16_t*)(smem + SS_BS); bf16_t* Cs = (bf16_t*)(smem + SS_CS); bf16_t* Xs = (bf16_t*)(smem + SS_XS); bf16_t* Xws = (bf16_t*)(smem + SS_XWS);
    bf16_t* Gs = (bf16_t*)(smem + SS_GS); bf16_t* Sb = (bf16_t*)(smem + SS_SB); float* sc = (float*)(smem + SS_SC);
    float* s_cA = (float*)(smem + SS_CW), *s_rsA = s_cA + SEGLEN, *s_wlA = s_rsA + SEGLEN, *s_totA = sc;
    const bf16_t* XBC = (const bf16_t*)(p.ws + WS_XBC);
    const float* DT = (const float*)(p.ws + WS_DT);
    float* ST = (float*)(p.ws + WS_ST); float* SEGT = (float*)(p.ws + WS_SEGT);
    bf16_t* Y = (bf16_t*)(p.ws + (dir ? WS_YS : WS_YF));
    const float Aneg = -__expf(p.a_log[l * 16 + dir * 8 + h]);
    const float Dh = p.d_skip[l * 8 + h];
    __syncthreads();
    f32x4 S[8];
#pragma unroll
    for (int nt = 0; nt < 8; ++nt) S[nt] = (f32x4){0.f, 0.f, 0.f, 0.f};
    const int ibase = item & ~15;
    if (PASS == 3) {
        if (dir == 0) {
            for (int e = 0; e < seg; ++e) { const float dc = __expf(SEGT[ibase + e]); const f32x4* src = (const f32x4*)(ST + (size_t)(ibase + e) * 8192);
#pragma unroll
                for (int nt = 0; nt < 8; ++nt) S[nt] = S[nt] * dc + src[(w * 8 + nt) * 64 + lane]; }
        } else {
            for (int e = NSEG - 1; e > seg; --e) { const float dc = __expf(SEGT[ibase + e]); const f32x4* src = (const f32x4*)(ST + (size_t)(ibase + e) * 8192);
#pragma unroll
                for (int nt = 0; nt < 8; ++nt) S[nt] = S[nt] * dc + src[(w * 8 + nt) * 64 + lane]; }
        }
#pragma unroll
        for (int nt = 0; nt < 8; ++nt) st4bf(Sb + (16 * w + idx) * 136 + 16 * nt + 4 * kq, S[nt]);
    }
    float* s_dta = (float*)(smem + SS_DTA);
#pragma unroll
    for (int i = 0; i < SEGLEN / 256; ++i) {
        const int e = tid + 256 * i, l32 = lane & 31;
        const float dtv = DT[((size_t)b * SEQ + seg * SEGLEN + e) * 16 + dir * 8 + h], av = dtv * Aneg;
        float pre = av;
#pragma unroll
        for (int o = 1; o < 32; o <<= 1) { const float t = __shfl_up(pre, o, 32); if (l32 >= o) pre += t; }
        const float tot = __shfl(pre, 31, 32);
        const float cc = dir ? (tot - pre + av) : pre;
        s_dta[e] = dtv; s_cA[e] = cc; s_rsA[e] = __expf(cc); s_wlA[e] = dtv * __expf(tot - cc);
        if (l32 == 0) s_totA[e >> 5] = tot;
    }
    float segtot = 0.f;
    const size_t tokb = (size_t)b * SEQ;
    const unsigned char* xb_ = (const unsigned char*)((const bf16_t*)(p.ws + WS_XBCC) + tokb * 1024);
    unsigned soff[5];
#pragma unroll
    for (int i = 0; i < 5; ++i) { const int u = tid + 256 * i, lrow = u / 40, ci = u % 40;
        const int scol = ci < 8 ? h * 64 + ci * 8 : (ci < 24 ? 512 + grp * 128 + (ci * 8 - 64) : 768 + grp * 128 + (ci * 8 - 192));
        soff[i] = (unsigned)((lrow * 1024 + scol) * 2); }
    for (int si = 0; si < NSUB; ++si) {
        const int scn = dir ? (NSUB - 1 - si) : si;
        const int t0 = seg * SEGLEN + scn * TSUB;
        __syncthreads();
        u32x4 raw[5];
#pragma unroll
        for (int i = 0; i < 5; ++i) raw[i] = *(const u32x4*)(xb_ + ((unsigned)(t0 * 2048) + soff[i]));
        const float* s_dt = s_dta + scn * TSUB; const float* s_c = s_cA + scn * TSUB; const float* s_rs = s_rsA + scn * TSUB; const float* s_wl = s_wlA + scn * TSUB;
        const float stot = s_totA[scn];
        segtot += stot;
#pragma unroll
        for (int i = 0; i < 5; ++i) { const int u = tid + 256 * i, lrow = u / 40, ci = u % 40, lc = ci * 8; const u32x4 o = raw[i];
            if (ci < 8) { *(u32x4*)(Xs + lrow * 72 + lc) = o; const float wl = s_wl[lrow];
                u32x4 o2; o2.x = pk2(bflo(o.x) * wl, bfhi(o.x) * wl); o2.y = pk2(bflo(o.y) * wl, bfhi(o.y) * wl); o2.z = pk2(bflo(o.z) * wl, bfhi(o.z) * wl); o2.w = pk2(bflo(o.w) * wl, bfhi(o.w) * wl);
                *(u32x4*)(Xws + lrow * 72 + lc) = o2; }
            else if (ci < 24) *(u32x4*)(Bs + lrow * 136 + (lc - 64)) = o;
            else *(u32x4*)(Cs + lrow * 136 + (lc - 192)) = o; }
        __syncthreads();
        if (PASS == 3) {
            const int it = w >> 1, jt = w & 1;
            f32x4 cb = (f32x4){0.f, 0.f, 0.f, 0.f};
            {
                bf16x8 fb[4], fc[4];
#pragma unroll
                for (int ks = 0; ks < 4; ++ks) { fb[ks] = *(const bf16x8*)(Bs + (16 * jt + idx) * 136 + ks * 32 + kq * 8); fc[ks] = *(const bf16x8*)(Cs + (16 * it + idx) * 136 + ks * 32 + kq * 8); }
                __builtin_amdgcn_sched_barrier(0);
#pragma unroll
                for (int ks = 0; ks < 4; ++ks) cb = __builtin_amdgcn_mfma_f32_16x16x32_bf16(fb[ks], fc[ks], cb, 0, 0, 0);
                __builtin_amdgcn_sched_barrier(0);
            }
            {
                const int ii = 16 * it + idx; const float ci_ = s_c[ii];
                f32x4 gv;
#pragma unroll
                for (int rg = 0; rg < 4; ++rg) {
                    const int jj = 16 * jt + 4 * kq + rg;
                    const bool ok = dir ? (jj >= ii) : (jj <= ii);
                    const float e = __expf(ci_ - s_c[jj]) * s_dt[jj];
                    gv[rg] = ok ? cb[rg] * e : 0.f;
                }
                st4bf(Gs + ii * 40 + 16 * jt + 4 * kq, gv);
            }
            __syncthreads();
            const unsigned char* xtr = (const unsigned char*)Xs + (8 * kq + (idx >> 2)) * 144 + (16 * w + 4 * (idx & 3)) * 2;
            const bf16x8 xf = cat8(tr16(xtr), tr16(xtr + 4 * 144));
#pragma unroll 1
            for (int it2 = 0; it2 < 2; ++it2) {
                const int ii = 16 * it2 + idx;
                const bf16x8 gf = *(const bf16x8*)(Gs + ii * 40 + 8 * kq);
                f32x4 yd = (f32x4){0.f, 0.f, 0.f, 0.f}, yo = (f32x4){0.f, 0.f, 0.f, 0.f};
                bf16x8 sf[4], cf[4];
#pragma unroll
                for (int ks = 0; ks < 4; ++ks) { sf[ks] = *(const bf16x8*)(Sb + (16 * w + idx) * 136 + ks * 32 + kq * 8); cf[ks] = *(const bf16x8*)(Cs + ii * 136 + ks * 32 + kq * 8); }
                __builtin_amdgcn_sched_barrier(0);
                yd = __builtin_amdgcn_mfma_f32_16x16x32_bf16(xf, gf, yd, 0, 0, 0);
#pragma unroll
                for (int ks = 0; ks < 4; ++ks) yo = __builtin_amdgcn_mfma_f32_16x16x32_bf16(sf[ks], cf[ks], yo, 0, 0, 0);
                __builtin_amdgcn_sched_barrier(0);
                f32x4 y = yd + yo * s_rs[ii];
                if (dir == 0) { const u32x2 xv = *(const u32x2*)(Xs + ii * 72 + 16 * w + 4 * kq);
                    y.x += Dh * bflo(xv.x); y.y += Dh * bfhi(xv.x); y.z += Dh * bflo(xv.y); y.w += Dh * bfhi(xv.y); }
                st4bf(Y + (tokb + t0 + ii) * 512 + h * 64 + 16 * w + 4 * kq, y);
            }
        }
        {
            const float dc = __expf(stot);
            const unsigned char* xw = (const unsigned char*)Xws + (8 * kq + (idx >> 2)) * 144 + (16 * w + 4 * (idx & 3)) * 2;
            const bf16x8 xwf = cat8(tr16(xw), tr16(xw + 4 * 144));
            bf16x8 bfv[8];
#pragma unroll
            for (int nt = 0; nt < 8; ++nt) {
                const unsigned char* bt = (const unsigned char*)Bs + (8 * kq + (idx >> 2)) * 272 + (16 * nt + 4 * (idx & 3)) * 2;
                bfv[nt] = cat8(tr16(bt), tr16(bt + 4 * 272));
            }
            __builtin_amdgcn_sched_barrier(0);
#pragma unroll
            for (int nt = 0; nt < 8; ++nt) S[nt] = __builtin_amdgcn_mfma_f32_16x16x32_bf16(bfv[nt], xwf, S[nt] * dc, 0, 0, 0);
            __builtin_amdgcn_sched_barrier(0);
            if (PASS == 3) {
#pragma unroll
                for (int nt = 0; nt < 8; ++nt) st4bf(Sb + (16 * w + idx) * 136 + 16 * nt + 4 * kq, S[nt]);
            }
        }
    }
    if (PASS == 1) {
        f32x4* dst = (f32x4*)(ST + (size_t)item * 8192);
#pragma unroll
        for (int nt = 0; nt < 8; ++nt) dst[(w * 8 + nt) * 64 + lane] = S[nt];
        if (tid == 0) SEGT[item] = segtot;
    }
}

__device__ void post2_phase(const Params& p) {
    int tx_ = threadIdx.x; asm volatile("" : "+v"(tx_));
    const int lane = tx_ & 63, gw = blockIdx.x * 8 + (tx_ >> 6), nw = gridDim.x * 8;
    const bf16_t* OB = (const bf16_t*)(p.ws + WS_QB); const float* LSE = (const float*)(p.ws + WS_LSE);
    const bf16_t* GB = (const bf16_t*)(p.ws + WS_GB);
    bf16_t* YBM = (bf16_t*)(p.ws + WS_YBM);
    const bf16_t* YF = (const bf16_t*)(p.ws + WS_YF); const bf16_t* YS = (const bf16_t*)(p.ws + WS_YS); const bf16_t* ZS = (const bf16_t*)(p.ws + WS_ZS);
    bf16_t* YC = (bf16_t*)(p.ws + WS_YC); float* RS = (float*)(p.ws + WS_RSTD);
    constexpr int R = 4;
    for (int row0 = gw; row0 < TP; row0 += R * nw) {
        float ls[R][3]; u32x2 ov[R][3], gt[R]; u32x4 a[R], bq[R], z[R];
        const int j = lane >> 4;
#pragma unroll
        for (int q = 0; q < R; ++q) { const int row = row0 + q * nw; if (row < TP) {
            const int bl = row >> 13, tt = row & (SEQ - 1);
#pragma unroll
            for (int g = 0; g < 3; ++g) { const int sh = 2 * g; const int pp = (tt & ((1 << sh) - 1)) * (SEQ >> sh) + (tt >> sh);
                const size_t ro = (size_t)(bl * 3 + g) * SEQ + pp; ls[q][g] = LSE[ro * 4 + j]; ov[q][g] = *(const u32x2*)(OB + ro * 256 + 4 * lane); }
            gt[q] = *(const u32x2*)(GB + (size_t)row * 256 + 4 * lane);
            a[q] = *(const u32x4*)(YF + (size_t)row * 512 + 8 * lane); bq[q] = *(const u32x4*)(YS + (size_t)row * 512 + 8 * lane); z[q] = *(const u32x4*)(ZS + (size_t)row * 512 + 8 * lane); } }
#pragma unroll
        for (int q = 0; q < R; ++q) { const int row = row0 + q * nw; if (row < TP) {
            const float mx = fmaxf(ls[q][0], fmaxf(ls[q][1], ls[q][2]));
            float wg[3]; float ws = 0.f;
#pragma unroll
            for (int g = 0; g < 3; ++g) { wg[g] = __expf(ls[q][g] - mx); ws += wg[g]; }
            const float inv = 1.f / ws;
            f32x4 acc = (f32x4){0.f, 0.f, 0.f, 0.f};
#pragma unroll
            for (int g = 0; g < 3; ++g) { const u32x2 v = ov[q][g]; const float wv = wg[g] * inv;
                acc.x += wv * bflo(v.x); acc.y += wv * bfhi(v.x); acc.z += wv * bflo(v.y); acc.w += wv * bfhi(v.y); }
            acc.x *= bflo(gt[q].x); acc.y *= bfhi(gt[q].x); acc.z *= bflo(gt[q].y); acc.w *= bfhi(gt[q].y);
            st4bf(YBM + (size_t)row * 256 + 4 * lane, acc);
            float y[8];
            y[0] = (bflo(a[q].x) + bflo(bq[q].x)) * bflo(z[q].x); y[1] = (bfhi(a[q].x) + bfhi(bq[q].x)) * bfhi(z[q].x);
            y[2] = (bflo(a[q].y) + bflo(bq[q].y)) * bflo(z[q].y); y[3] = (bfhi(a[q].y) + bfhi(bq[q].y)) * bfhi(z[q].y);
            y[4] = (bflo(a[q].z) + bflo(bq[q].z)) * bflo(z[q].z); y[5] = (bfhi(a[q].z) + bfhi(bq[q].z)) * bfhi(z[q].z);
            y[6] = (bflo(a[q].w) + bflo(bq[q].w)) * bflo(z[q].w); y[7] = (bfhi(a[q].w) + bfhi(bq[q].w)) * bfhi(z[q].w);
            float ss = 0.f;
#pragma unroll
            for (int e = 0; e < 8; ++e) ss += y[e] * y[e];
            ss = wave_sum(ss);
            u32x4 o; o.x = pk2(y[0], y[1]); o.y = pk2(y[2], y[3]); o.z = pk2(y[4], y[5]); o.w = pk2(y[6], y[7]);
            *(u32x4*)(YC + (size_t)row * 512 + 8 * lane) = o;
            if (lane == 0) RS[row] = rsqrtf(ss * (1.f / 512.f) + EPS);
        } }
    }
}


#define XB_TMO      128
#define XB_XCNT(j)  (256  + 64 * (j))
#define XB_XSUB(j)  (1280 + 64 * (j))
#define XB_XGEN(j)  (2304 + 64 * (j))
#define XB_TOP      3328
#define XB_TOPGEN   3392
#define XCD_BAR_WORDS 3456
#define XB_SPIN_CAP (1u << 20)
__device__ __forceinline__ unsigned xb_ld(unsigned* p)              { return __hip_atomic_load(p, __ATOMIC_RELAXED, __HIP_MEMORY_SCOPE_AGENT); }
__device__ __forceinline__ unsigned xb_add(unsigned* p, unsigned v) { return __hip_atomic_fetch_add(p, v, __ATOMIC_RELAXED, __HIP_MEMORY_SCOPE_AGENT); }
__device__ __forceinline__ unsigned xb_xcc_id() { return (unsigned)__builtin_amdgcn_s_getreg((3 << 11) | 20) & 0xFu; }
#define XB_SPIN(cond, bar) do { unsigned _sp = 0; while (cond) { __builtin_amdgcn_s_sleep(1); \
    if ((++_sp & 255u) == 0u) { if (xb_ld(&(bar)[XB_TMO])) break; if (_sp > XB_SPIN_CAP) { atomicAdd(&(bar)[XB_TMO], 1u); break; } } } } while (0)
struct XcdBarrier { unsigned* bar; unsigned x; volatile LDSAS unsigned* st; };
__device__ __forceinline__ XcdBarrier xcd_barrier_post(unsigned* bar, volatile LDSAS unsigned* st) {
    XcdBarrier b; b.bar = bar; b.x = xb_xcc_id(); b.st = st;
    if (threadIdx.x == 0) (void)xb_add(&bar[XB_XCNT(b.x)], 1u);
    return b;
}
__device__ __forceinline__ void xcd_barrier_complete(unsigned* bar, unsigned x, unsigned& nloc, unsigned& nx) {
    const unsigned G = gridDim.x * gridDim.y * gridDim.z;
    unsigned sum, cnt, mine, sp = 0u;
    for (;;) {
        sum = 0u; cnt = 0u; mine = 0u;
#pragma unroll
        for (unsigned j = 0; j < 16; ++j) { const unsigned c = xb_ld(&bar[XB_XCNT(j)]); sum += c; cnt += (c > 0u) ? 1u : 0u; mine = (j == x) ? c : mine; }
        if (sum == G) break;
        __builtin_amdgcn_s_sleep(1);
        if ((++sp & 255u) == 0u) { if (xb_ld(&bar[XB_TMO])) break; if (sp > XB_SPIN_CAP) { atomicAdd(&bar[XB_TMO], 1u); break; } }
    }
    nloc = mine > 0u ? mine : 1u; nx = cnt > 0u ? cnt : 1u;
}
__device__ __forceinline__ void xcd_barrier(const XcdBarrier& b) {
    asm volatile("s_waitcnt vmcnt(0)" ::: "memory");
    __syncthreads();
    if (threadIdx.x == 0) {
        unsigned* bar = b.bar;
        __builtin_amdgcn_s_waitcnt(0);
        unsigned nloc = b.st[0], nx = b.st[1];
        if (nloc == 0u) { xcd_barrier_complete(bar, b.x, nloc, nx); b.st[0] = nloc; b.st[1] = nx; }
        const unsigned old = xb_add(&bar[XB_XSUB(b.x)], 1u);
        const unsigned gen = old / nloc;
        if (old + 1u == (gen + 1u) * nloc) {
            __builtin_amdgcn_fence(__ATOMIC_RELEASE, "agent");
            asm volatile("s_waitcnt vmcnt(0)" ::: "memory");
            const unsigned og = xb_add(&bar[XB_TOP], 1u);
            const unsigned tg = og / nx;
            if (og + 1u == (tg + 1u) * nx) xb_add(&bar[XB_TOPGEN], 1u);
            else XB_SPIN(xb_ld(&bar[XB_TOPGEN]) == tg, bar);
            __builtin_amdgcn_fence(__ATOMIC_ACQUIRE, "agent");
            xb_add(&bar[XB_XGEN(b.x)], 1u);
            asm volatile("s_waitcnt vmcnt(0)" ::: "memory");
        } else {
            XB_SPIN(xb_ld(&bar[XB_XGEN(b.x)]) == gen, bar);
            __builtin_amdgcn_fence(__ATOMIC_ACQUIRE, "agent");
            asm volatile("s_waitcnt vmcnt(0)" ::: "memory");
        }
    }
    __syncthreads();
}

__device__ __forceinline__ unsigned char* lds_half(unsigned char* smem) { int h_ = threadIdx.x >> 8; asm volatile("" : "+v"(h_)); return smem + h_ * HALF_LDS; }
__global__ void __launch_bounds__(512, 2) hybrid_fwd(Params p) {
    cg::grid_group grid = cg::this_grid();
    extern __shared__ __attribute__((aligned(16))) unsigned char smem[];
    volatile LDSAS unsigned* bst = (volatile LDSAS unsigned*)(smem + LDS_TOTAL - 16);
    if (threadIdx.x < 4) bst[threadIdx.x] = 0u;
    __syncthreads();
    const XcdBarrier xbar = xcd_barrier_post((unsigned*)(p.ws + WS_BAR), bst);
    { const Params q = launder(p); phase0(q, lds_half(smem)); }
    grid.sync();
#pragma unroll 1
    for (int l = 0; l < DEPTH; ++l) {
#pragma unroll 1
        for (int hb = 0; hb < 2; ++hb) {
            { const Params q = launder(p); norm_phase(q, l, hb, (l == 0) ? q.x : q.out); }
            xcd_barrier(xbar);
            { const Params q = launder(p); gemm1_phase(q, l, hb, smem); }
            xcd_barrier(xbar);
            { const Params q = launder(p); conv_phase(q, l); }
            xcd_barrier(xbar);
            { const Params q = launder(p); unsigned char* smh = lds_half(smem);
#pragma unroll 1
              for (int it = VBLK; it < 512 + 1536; it += VGRID) { if (it < 512) ssd_item<1>(q, it, l, smh); else attn_b_item(q, it - 512, l, smh); } }
            xcd_barrier(xbar);
            { const Params q = launder(p); unsigned char* smh = lds_half(smem);
#pragma unroll 1
              for (int it = VBLK; it < 1024 + 512; it += VGRID) { if (it < 1024) attn_a_item(q, it, l, smh); else ssd_item<3>(q, it - 1024, l, smh); } }
            xcd_barrier(xbar);
            { const Params q = launder(p); post2_phase(q); }
            xcd_barrier(xbar);
            { const Params q = launder(p); merge_phase(q, l, smem); }
            xcd_barrier(xbar);
            { const Params q = launder(p); out_phase(q, l, hb, (l == 0) ? q.x : q.out, smem); }
        }
    }
}

extern "C" void kernel_launch(void* const* d_in, const int* in_sizes, int n_in, void* d_out, int out_size, void* d_ws, size_t ws_size, hipStream_t stream) {
    static int grid_blocks = 0;
    if (!grid_blocks) {
        int dev = 0, cus = 0, per_cu = 0;
        hipGetDevice(&dev);
        hipDeviceGetAttribute(&cus, hipDeviceAttributeMultiprocessorCount, dev);
        hipFuncSetAttribute((const void*)hybrid_fwd, hipFuncAttributeMaxDynamicSharedMemorySize, LDS_TOTAL);
        hipOccupancyMaxActiveBlocksPerMultiprocessor(&per_cu, hybrid_fwd, 512, LDS_TOTAL);
        if (per_cu > 1) per_cu = 1;
        if (per_cu < 1) per_cu = 1;
        grid_blocks = cus * per_cu;
    }
    Params p{};
    const float** pp = (const float**)&p;
    for (int i = 0; i < 22; ++i) pp[i] = (const float*)d_in[i];
    p.out = (float*)d_out; p.ws = (unsigned char*)d_ws;
    hipMemsetAsync((unsigned char*)d_ws + WS_BAR, 0, XCD_BAR_WORDS * 4, stream);
    void* args[] = {&p};
    hipError_t e = hipLaunchCooperativeKernel((void*)hybrid_fwd, dim3(grid_blocks), dim3(512), args, LDS_TOTAL, stream);
    if (e != hipSuccess) fprintf(stderr, "cooperative launch failed: %s (grid %d)\n", hipGetErrorString(e), grid_blocks);
}
```

```cpp
#include <hip/hip_runtime.h>
#include <hip/hip_cooperative_groups.h>
#include <cstdint>
#include <cstdio>
namespace cg = cooperative_groups;

typedef unsigned short bf16_t;
typedef short bf16x8 __attribute__((ext_vector_type(8)));
typedef short v4i16 __attribute__((ext_vector_type(4)));
typedef float f32x2 __attribute__((ext_vector_type(2)));
typedef float f32x4 __attribute__((ext_vector_type(4)));
typedef float f32x16 __attribute__((ext_vector_type(16)));
typedef unsigned u32x2 __attribute__((ext_vector_type(2)));
typedef unsigned u32x4 __attribute__((ext_vector_type(4)));
typedef __bf16 bf16x2_t __attribute__((ext_vector_type(2)));
#define LDSAS __attribute__((address_space(3)))
#define VTID ((int)(threadIdx.x & 255u))
__device__ __forceinline__ int vblk_() { int h_ = threadIdx.x >> 8; asm volatile("" : "+v"(h_)); return __builtin_amdgcn_readfirstlane(2 * (int)blockIdx.x + h_); }
#define VBLK vblk_()
#define VGRID ((int)(2u * gridDim.x))
constexpr int HALF_LDS = 73728, LDS_TOTAL = 147456;

constexpr int SEQ = 8192, DM = 1024, NBATCH = 4, NBH = 2, TP = NBH * SEQ, DEPTH = 2;
constexpr int NP = 8704;
constexpr float EPS = 1e-6f;
constexpr float LOG2E = 1.4426950408889634f, LN2 = 0.6931471805599453f;
constexpr int NSEG = 16, SEGLEN = 512, TSUB = 32, NSUB = SEGLEN / TSUB;

constexpr size_t MiB = 1u << 20;
constexpr size_t WS_WIN = 0;
constexpr size_t WS_WPA = 34 * MiB;
constexpr size_t WS_WPB = 36 * MiB;
constexpr size_t WS_WPC = 37 * MiB;
constexpr size_t WS_WOUT = 39 * MiB;
constexpr size_t WS_MOD = 43 * MiB;
constexpr size_t WS_ROPE = 43 * MiB + 128 * 1024;
constexpr size_t WS_BND = 43 * MiB + 160 * 1024;
constexpr size_t WS_RSTD = 43 * MiB + 256 * 1024;
constexpr size_t WS_SEGT = 43 * MiB + 512 * 1024;
constexpr size_t WS_LSE = 44 * MiB;
constexpr size_t WS_DT = 45 * MiB;
constexpr size_t WS_BAR = 46 * MiB;
constexpr size_t WS_H = 48 * MiB;
constexpr size_t WS_QA = 80 * MiB;
constexpr size_t WS_KA = 96 * MiB;
constexpr size_t WS_VA = 100 * MiB;
constexpr size_t WS_GA = 104 * MiB;
constexpr size_t WS_QB = 120 * MiB;
constexpr size_t WS_KB = 144 * MiB;
constexpr size_t WS_VB = 168 * MiB;
constexpr size_t WS_GB = 192 * MiB;
constexpr size_t WS_XBC = 200 * MiB;
constexpr size_t WS_ZS = 232 * MiB;
constexpr size_t WS_MG = 248 * MiB;
constexpr size_t WS_YF = 344 * MiB;
constexpr size_t WS_YS = 360 * MiB;
constexpr size_t WS_YBM = 376 * MiB;
constexpr size_t WS_YC = 384 * MiB;
constexpr size_t WS_MRG = 400 * MiB;
constexpr size_t WS_ST = 432 * MiB;
constexpr size_t WS_XBCC = 448 * MiB;

struct Params {
    const float *x, *c, *norm_w, *w_ada, *b_ada, *w_in, *b_gate, *q_norm_a, *k_norm_a, *q_norm_b, *k_norm_b, *rel_bias,
        *conv_w, *conv_b, *a_log, *dt_bias, *d_skip, *ssm_norm_w, *w_proj_a, *w_proj_b, *w_proj_c, *w_out;
    float* out;
    unsigned char* ws;
};


#define AS1 __attribute__((address_space(1)))
#define GLOBF(f) do { AS1 const float* g_ = (AS1 const float*)p.f; asm volatile("" : "+s"(g_)); q.f = (const float*)g_; } while (0)
__device__ __forceinline__ Params launder(const Params& p) {
    Params q;
    GLOBF(x); GLOBF(c); GLOBF(norm_w); GLOBF(w_ada); GLOBF(b_ada); GLOBF(w_in); GLOBF(b_gate); GLOBF(q_norm_a); GLOBF(k_norm_a); GLOBF(q_norm_b); GLOBF(k_norm_b); GLOBF(rel_bias);
    GLOBF(conv_w); GLOBF(conv_b); GLOBF(a_log); GLOBF(dt_bias); GLOBF(d_skip); GLOBF(ssm_norm_w); GLOBF(w_proj_a); GLOBF(w_proj_b); GLOBF(w_proj_c); GLOBF(w_out);
    { AS1 float* g_ = (AS1 float*)p.out; asm volatile("" : "+s"(g_)); q.out = (float*)g_; }
    { AS1 unsigned char* g_ = (AS1 unsigned char*)p.ws; asm volatile("" : "+s"(g_)); q.ws = (unsigned char*)g_; }
    return q;
}
__device__ __forceinline__ unsigned pk2(float lo, float hi) { f32x2 v = {lo, hi}; bf16x2_t b = __builtin_convertvector(v, bf16x2_t); return __builtin_bit_cast(unsigned, b); }
__device__ __forceinline__ float bf2f(unsigned short b) { return __uint_as_float(((unsigned)b) << 16); }
__device__ __forceinline__ float bflo(unsigned u) { return __uint_as_float(u << 16); }
__device__ __forceinline__ float bfhi(unsigned u) { return __uint_as_float(u & 0xffff0000u); }
__device__ __forceinline__ float siluf(float v) { return v * __builtin_amdgcn_rcpf(1.f + __builtin_amdgcn_exp2f(-1.4426950408889634f * v)); }
__device__ __forceinline__ float sigmf(float v) { return __builtin_amdgcn_rcpf(1.f + __builtin_amdgcn_exp2f(-1.4426950408889634f * v)); }
__device__ __forceinline__ float wave_sum(float v) {
#pragma unroll
    for (int o = 1; o < 64; o <<= 1) v += __shfl_xor(v, o);
    return v;
}
__device__ __forceinline__ v4i16 tr16(const unsigned char* p) { return __builtin_amdgcn_ds_read_tr16_b64_v4i16((LDSAS v4i16*)p); }
__device__ __forceinline__ bf16x8 cat8(v4i16 a, v4i16 b) { return (bf16x8){a[0], a[1], a[2], a[3], b[0], b[1], b[2], b[3]}; }
__device__ __forceinline__ int crow(int r, int hi) { return (r & 3) + 8 * (r >> 2) + 4 * hi; }

struct P0It { const float* W; bf16_t* Wt; const float* rs; int ldw, K, k0, n0, mode; };
__device__ __forceinline__ void p0_load(const P0It& t, float (&vv)[16]) {
    const int tid = VTID, tx = tid & 63, ty = tid >> 6;
    const int np = t.n0 + tx; int n = np; bool valid = true;
    if (t.mode == 1) {
        if (np < 4352) n = np; else if (np < 4864) n = np + 512; else if (np < 5376) n = np - 512;
        else if (np < 8448) n = np + 16; else if (np < 8464) n = np - 3072; else { valid = false; n = 0; }
    }
#pragma unroll
    for (int i = 0; i < 16; ++i) { const int k = ty + 4 * i; vv[i] = valid ? t.W[(size_t)(t.k0 + k) * t.ldw + n] : 0.f; }
}
__device__ __forceinline__ void p0_finish(const P0It& t, const float (&vv)[16], float* tile) {
    const int tid = VTID, tx = tid & 63, ty = tid >> 6;
#pragma unroll
    for (int i = 0; i < 16; ++i) { const int k = ty + 4 * i; float v = vv[i]; if (t.rs) v *= t.rs[t.k0 + k]; tile[k * 65 + tx] = v; }
    __syncthreads();
    const int r = tid >> 2, kc = (tid & 3) * 16;
    u32x4 o0, o1;
    o0.x = pk2(tile[(kc + 0) * 65 + r], tile[(kc + 1) * 65 + r]); o0.y = pk2(tile[(kc + 2) * 65 + r], tile[(kc + 3) * 65 + r]);
    o0.z = pk2(tile[(kc + 4) * 65 + r], tile[(kc + 5) * 65 + r]); o0.w = pk2(tile[(kc + 6) * 65 + r], tile[(kc + 7) * 65 + r]);
    o1.x = pk2(tile[(kc + 8) * 65 + r], tile[(kc + 9) * 65 + r]); o1.y = pk2(tile[(kc + 10) * 65 + r], tile[(kc + 11) * 65 + r]);
    o1.z = pk2(tile[(kc + 12) * 65 + r], tile[(kc + 13) * 65 + r]); o1.w = pk2(tile[(kc + 14) * 65 + r], tile[(kc + 15) * 65 + r]);
    bf16_t* dst = t.Wt + (size_t)(t.n0 + r) * t.K + t.k0 + kc;
    *(u32x4*)dst = o0; *(u32x4*)(dst + 8) = o1;
    __syncthreads();
}
constexpr int P0_IN = 16 * 136, P0_PA = 8 * 16, P0_PB = 4 * 16, P0_PC = 8 * 16, P0_OUT = 16 * 16, P0_L = P0_IN + P0_PA + P0_PB + P0_PC + P0_OUT;
__device__ __forceinline__ P0It p0_params(const Params& p, int item) {
    P0It t; const int l = item / P0_L; int r = item % P0_L; t.rs = nullptr; t.mode = 0;
    if (r < P0_IN) { t.W = p.w_in + (size_t)l * 1024 * 8464; t.ldw = 8464; t.K = 1024; t.Wt = (bf16_t*)(p.ws + WS_WIN) + (size_t)l * NP * 1024; t.k0 = (r / 136) * 64; t.n0 = (r % 136) * 64; t.mode = 1; return t; }
    r -= P0_IN;
    if (r < P0_PA) { t.W = p.w_proj_a + (size_t)l * 512 * 1024; t.ldw = 1024; t.K = 512; t.Wt = (bf16_t*)(p.ws + WS_WPA) + (size_t)l * 1024 * 512; t.k0 = (r / 16) * 64; t.n0 = (r % 16) * 64; return t; }
    r -= P0_PA;
    if (r < P0_PB) { t.W = p.w_proj_b + (size_t)l * 256 * 1024; t.ldw = 1024; t.K = 256; t.Wt = (bf16_t*)(p.ws + WS_WPB) + (size_t)l * 1024 * 256; t.k0 = (r / 16) * 64; t.n0 = (r % 16) * 64; return t; }
    r -= P0_PB;
    if (r < P0_PC) { t.W = p.w_proj_c + (size_t)l * 512 * 1024; t.ldw = 1024; t.K = 512; t.Wt = (bf16_t*)(p.ws + WS_WPC) + (size_t)l * 1024 * 512; t.k0 = (r / 16) * 64; t.n0 = (r % 16) * 64; t.rs = p.ssm_norm_w + l * 512; return t; }
    r -= P0_PC;
    t.W = p.w_out + (size_t)l * 1024 * 1024; t.ldw = 1024; t.K = 1024; t.Wt = (bf16_t*)(p.ws + WS_WOUT) + (size_t)l * 1024 * 1024; t.k0 = (r / 16) * 64; t.n0 = (r % 16) * 64; return t;
}

__device__ void phase0(const Params& p, unsigned char* smem) {
    const int tid = VTID;
    float* tile = (float*)smem;
    constexpr int I_T = 2 * P0_L, I_MOD = 192, I_ALL = I_T + I_MOD + 1;
    {
        int item = VBLK;
        if (item < I_T) {
            P0It cur = p0_params(p, item); float va[16], vb[16]; p0_load(cur, va);
            for (;;) {
                const int nx = item + VGRID; const bool more = nx < I_T; P0It nxt = cur;
                if (more) { nxt = p0_params(p, nx); p0_load(nxt, vb); }
                p0_finish(cur, va, tile);
                if (!more) break;
                item = nx; cur = nxt;
#pragma unroll
                for (int i = 0; i < 16; ++i) va[i] = vb[i];
            }
        }
    }
    for (int item = VBLK; item < I_ALL; item += VGRID) {
        if (item < I_T) {
            continue;
        } else if (item < I_T + I_MOD) {
            const int it = item - I_T, l = it / 96, col0 = (it % 96) * 32, cl = tid & 31, ks = tid >> 5;
            float a0 = 0.f, a1 = 0.f, a2 = 0.f, a3 = 0.f;
            const float* wp = p.w_ada + ((size_t)l * 1024 + ks * 128) * 3072 + col0 + cl;
#pragma unroll 8
            for (int k = 0; k < 128; ++k) {
                const float wv = wp[(size_t)k * 3072]; const int kk = ks * 128 + k;
                a0 += siluf(p.c[kk]) * wv; a1 += siluf(p.c[1024 + kk]) * wv; a2 += siluf(p.c[2048 + kk]) * wv; a3 += siluf(p.c[3072 + kk]) * wv;
            }
            float* red = (float*)smem;
            red[(ks * 32 + cl) * 4 + 0] = a0; red[(ks * 32 + cl) * 4 + 1] = a1; red[(ks * 32 + cl) * 4 + 2] = a2; red[(ks * 32 + cl) * 4 + 3] = a3;
            __syncthreads();
            if (tid < 128) { const int b = tid >> 5, c2 = tid & 31; float s = 0.f;
#pragma unroll
                for (int k = 0; k < 8; ++k) s += red[(k * 32 + c2) * 4 + b];
                ((float*)(p.ws + WS_MOD))[(l * 4 + b) * 3072 + col0 + c2] = s + p.b_ada[l * 3072 + col0 + c2]; }
            __syncthreads();
        } else {
            float* rc = (float*)(p.ws + WS_ROPE); float* rs = rc + 128 * 16;
            for (int e = tid; e < 2048; e += 256) {
                const int pos = e >> 4, i = e & 15;
                const float freq = powf(10000.0f, -(float)i / 16.0f);
                const float ang = (float)pos * freq;
                const double rev = (double)ang * 0.15915494309189535; const double fr = rev - rint(rev);
                const float a = (float)(fr * 6.283185307179586);
                rc[e] = cosf(a); rs[e] = sinf(a);
            }
            if (tid < 2) {
                const int l = tid; float mqa = 0.f, mka = 0.f, mqb = 0.f, mkb = 0.f, mb = 0.f;
                for (int i = 0; i < 64; ++i) { mqa = fmaxf(mqa, fabsf(p.q_norm_a[l * 64 + i])); mka = fmaxf(mka, fabsf(p.k_norm_a[l * 64 + i]));
                    mqb = fmaxf(mqb, fabsf(p.q_norm_b[l * 64 + i])); mkb = fmaxf(mkb, fabsf(p.k_norm_b[l * 64 + i])); }
                for (int i = 0; i < 32 * 12; ++i) mb = fmaxf(mb, p.rel_bias[i]);
                float* bd = (float*)(p.ws + WS_BND);
                bd[l] = 8.f * mqa * mka * LOG2E; bd[2 + l] = (8.f * mqb * mkb + mb) * LOG2E;
            }
        }
    }
}

__device__ void norm_phase(const Params& p, int l, int hb, const float* xsrc) {
    int tx_ = threadIdx.x; asm volatile("" : "+v"(tx_));
    const int lane = tx_ & 63, gw = blockIdx.x * 8 + (tx_ >> 6), nw = gridDim.x * 8;
    bf16_t* H = (bf16_t*)(p.ws + WS_H);
    const float* nwp = p.norm_w + l * 1024;
    for (int row0 = gw; row0 < TP; row0 += 4 * nw) {
        f32x4 v[4][4];
#pragma unroll
        for (int q = 0; q < 4; ++q) { const int row = row0 + q * nw;
            if (row < TP) { const f32x4* xr = (const f32x4*)(xsrc + ((size_t)hb * TP + row) * 1024);
#pragma unroll
                for (int j = 0; j < 4; ++j) v[q][j] = xr[lane + 64 * j]; } }
#pragma unroll
        for (int q = 0; q < 4; ++q) { const int row = row0 + q * nw;
            if (row < TP) {
                const size_t rg = (size_t)hb * TP + row; const int b = (int)(rg / SEQ);
                const float* md = (const float*)(p.ws + WS_MOD) + (size_t)(l * 4 + b) * 3072;
                float ss = 0.f;
#pragma unroll
                for (int j = 0; j < 4; ++j) ss += v[q][j].x * v[q][j].x + v[q][j].y * v[q][j].y + v[q][j].z * v[q][j].z + v[q][j].w * v[q][j].w;
                ss = wave_sum(ss); const float rstd = rsqrtf(ss * (1.f / 1024.f) + EPS);
#pragma unroll
                for (int j = 0; j < 4; ++j) {
                    const int col = 4 * (lane + 64 * j);
                    const f32x4 w4 = *(const f32x4*)(nwp + col), sh = *(const f32x4*)(md + col), sc = *(const f32x4*)(md + 1024 + col);
                    const f32x4 o = v[q][j] * rstd * w4 * (1.f + sc) + sh;
                    u32x2 pk; pk.x = pk2(o.x, o.y); pk.y = pk2(o.z, o.w);
                    *(u32x2*)(H + (size_t)row * 1024 + col) = pk;
                }
            } }
    }
}

constexpr int G_STAGE = 65536, G_AB = 32768;
template <bool LOWREG = false>
__device__ __forceinline__ void gemm_core(const bf16_t* __restrict__ A, int lda, const bf16_t* __restrict__ Bt, int ldb, int K, f32x4 (&acc)[8][4], unsigned char* smem, int tid) {
    asm volatile("" : "+v"(tid));
    const int lane = tid & 63, w = __builtin_amdgcn_readfirstlane(tid >> 6), wm = w >> 2, wn = w & 3, idx = lane & 15, kq = lane >> 4;
    unsigned offA[4], offB[4];
#pragma unroll
    for (int j = 0; j < 4; ++j) { const int row = (j * 8 + w) * 8 + (lane >> 3), c = (lane & 7) ^ ((row >> 1) & 7);
        offA[j] = (unsigned)(row * lda + c * 8) * 2u; offB[j] = (unsigned)(row * ldb + c * 8) * 2u; }
#pragma unroll
    for (int mi = 0; mi < 8; ++mi)
#pragma unroll
        for (int ni = 0; ni < 4; ++ni) acc[mi][ni] = (f32x4){0.f, 0.f, 0.f, 0.f};
    LDSAS unsigned char* lds = (LDSAS unsigned char*)smem;
#define G_ISSUE1(kt, st, j) do { \
        __builtin_amdgcn_global_load_lds((const unsigned*)((const char*)A + offA[j] + (kt) * 128), (LDSAS unsigned*)(lds + (st) * G_STAGE + ((j) * 8 + w) * 1024), 16, 0, 0); \
        __builtin_amdgcn_global_load_lds((const unsigned*)((const char*)Bt + offB[j] + (kt) * 128), (LDSAS unsigned*)(lds + (st) * G_STAGE + G_AB + ((j) * 8 + w) * 1024), 16, 0, 0); } while (0)
#define G_ISSUE(kt, st) do { G_ISSUE1(kt, st, 0); G_ISSUE1(kt, st, 1); G_ISSUE1(kt, st, 2); G_ISSUE1(kt, st, 3); } while (0)
    const int nk = K >> 6;
    G_ISSUE(0, 0);
    asm volatile("s_waitcnt vmcnt(0)" ::: "memory");
    __syncthreads();
    const int swz = (idx >> 1) & 7;
    const int aoff = (wm * 128 + idx) * 128, boff = G_AB + (wn * 64 + idx) * 128;
    for (int kt = 0; kt < nk; ++kt) {
        const int st = kt & 1;
        const bool more = kt + 1 < nk;
        const unsigned char* sb = smem + st * G_STAGE;
        if constexpr (!LOWREG) {
#pragma unroll
        for (int ks = 0; ks < 2; ++ks) {
            bf16x8 bfr[4], af[8];
            const int co = ((ks * 4 + kq) ^ swz) * 16;
#pragma unroll
            for (int ni = 0; ni < 4; ++ni) bfr[ni] = *(const bf16x8*)(sb + boff + ni * 2048 + co);
#pragma unroll
            for (int mi = 0; mi < 8; ++mi) af[mi] = *(const bf16x8*)(sb + aoff + mi * 2048 + co);
            if (more) { G_ISSUE1(kt + 1, st ^ 1, ks * 2); G_ISSUE1(kt + 1, st ^ 1, ks * 2 + 1); }
            __builtin_amdgcn_sched_barrier(0);
            __builtin_amdgcn_s_setprio(1);
#pragma unroll
            for (int mi = 0; mi < 8; ++mi)
#pragma unroll
                for (int ni = 0; ni < 4; ++ni) acc[mi][ni] = __builtin_amdgcn_mfma_f32_16x16x32_bf16(bfr[ni], af[mi], acc[mi][ni], 0, 0, 0);
            __builtin_amdgcn_s_setprio(0);
            __builtin_amdgcn_sched_barrier(0);
        }
        } else {
#pragma unroll
        for (int ks = 0; ks < 2; ++ks) {
            bf16x8 bfr[4];
            const int co = ((ks * 4 + kq) ^ swz) * 16;
#pragma unroll
            for (int ni = 0; ni < 4; ++ni) bfr[ni] = *(const bf16x8*)(sb + boff + ni * 2048 + co);
#pragma unroll
            for (int mh = 0; mh < 2; ++mh) {
                bf16x8 af[4];
#pragma unroll
                for (int mi = 0; mi < 4; ++mi) af[mi] = *(const bf16x8*)(sb + aoff + (mh * 4 + mi) * 2048 + co);
                if (more) G_ISSUE1(kt + 1, st ^ 1, ks * 2 + mh);
                __builtin_amdgcn_sched_barrier(0);
                __builtin_amdgcn_s_setprio(1);
#pragma unroll
                for (int mi = 0; mi < 4; ++mi)
#pragma unroll
                    for (int ni = 0; ni < 4; ++ni) acc[mh * 4 + mi][ni] = __builtin_amdgcn_mfma_f32_16x16x32_bf16(bfr[ni], af[mi], acc[mh * 4 + mi][ni], 0, 0, 0);
                __builtin_amdgcn_s_setprio(0);
                __builtin_amdgcn_sched_barrier(0);
            }
        }
        }
        asm volatile("s_waitcnt vmcnt(0)" ::: "memory");
        __syncthreads();
    }
#undef G_ISSUE1
#undef G_ISSUE
}

__device__ __forceinline__ void st4bf(bf16_t* dst, f32x4 v) { u32x2 pk; pk.x = pk2(v.x, v.y); pk.y = pk2(v.z, v.w); *(u32x2*)dst = pk; }

__device__ void gemm1_phase(const Params& p, int l, int hb, unsigned char* smem) {
    const bf16_t* H = (const bf16_t*)(p.ws + WS_H);
    const bf16_t* Wt = (const bf16_t*)(p.ws + WS_WIN) + (size_t)l * NP * 1024;
    const float* ropec = (const float*)(p.ws + WS_ROPE); const float* ropes = ropec + 2048;
    constexpr int NT = 34, NTILES = 64 * NT, GRP = 8 * NT;
    for (int t = blockIdx.x; t < NTILES; t += gridDim.x) {
        const int grp = t / GRP, r = t % GRP, jx = NT * (r & 7) + (r >> 3), mt = grp * 8 + (jx & 7), nt = jx >> 3;
        const int m0 = mt * 256, n0 = nt * 256;
        f32x4 acc[8][4];
        int tid = threadIdx.x;
        gemm_core(H + (size_t)m0 * 1024, 1024, Wt + (size_t)n0 * 1024, 1024, 1024, acc, smem, tid);
        asm volatile("" : "+v"(tid));
        const int lane = tid & 63, w = __builtin_amdgcn_readfirstlane(tid >> 6), wm = w >> 2, wn = w & 3, idx = lane & 15, kq = lane >> 4;
        const int cw = n0 + wn * 64;
        const int lc = 4 * kq;
        unsigned char* wl = smem + w * 16384;
#define G1_STG(mi_, ni_, v_) do { const int r_ = (mi_) * 16 + idx; const f32x4 t_ = (v_); u32x2 pk_; pk_.x = pk2(t_.x, t_.y); pk_.y = pk2(t_.z, t_.w); \
        *(u32x2*)(wl + r_ * 128 + ((((ni_) * 2 + (kq >> 1)) ^ (r_ & 7)) * 16) + (kq & 1) * 8) = pk_; } while (0)
        bf16_t* dbase = nullptr; int dpitch = 0, dc0 = 0, dsh = -1, dg = 0;
        if (cw < 768 && (cw < 640)) {
            const bool isq = cw < 512;
            const float* nwp = (isq ? p.q_norm_a : p.k_norm_a) + l * 64;
            dbase = isq ? (bf16_t*)(p.ws + WS_QA) : (bf16_t*)(p.ws + WS_KA);
            dpitch = isq ? 512 : 128; dc0 = isq ? cw : cw - 512;
            const float qs = isq ? 0.125f * LOG2E : 1.f;
#pragma unroll
            for (int mi = 0; mi < 8; ++mi) {
                const int row = m0 + wm * 128 + mi * 16 + idx;
                float ss = 0.f;
#pragma unroll
                for (int ni = 0; ni < 4; ++ni) { const f32x4 v = acc[mi][ni]; ss += v.x * v.x + v.y * v.y + v.z * v.z + v.w * v.w; }
                ss += __shfl_xor(ss, 16); ss += __shfl_xor(ss, 32);
                const float rstd = rsqrtf(ss * (1.f / 64.f) + EPS);
                f32x4 y[4];
#pragma unroll
                for (int ni = 0; ni < 4; ++ni) y[ni] = acc[mi][ni] * rstd * *(const f32x4*)(nwp + ni * 16 + lc);
                const int tt = row & (SEQ - 1), prow = tt >> 6, pcol = tt & 63;
#pragma unroll
                for (int hf = 0; hf < 2; ++hf) {
                    const int pos = hf ? pcol : prow;
                    const f32x4 cs = *(const f32x4*)(ropec + pos * 16 + lc), sn = *(const f32x4*)(ropes + pos * 16 + lc);
                    const f32x4 a = y[2 * hf], b = y[2 * hf + 1];
                    y[2 * hf] = a * cs - b * sn; y[2 * hf + 1] = b * cs + a * sn;
                }
#pragma unroll
                for (int ni = 0; ni < 4; ++ni) G1_STG(mi, ni, y[ni] * qs);
            }
        } else if (cw >= 1280 && cw < 2816) {
            const bool isq = cw < 2048;
            const float* nwp = (isq ? p.q_norm_b : p.k_norm_b) + l * 64;
            const int gc = isq ? cw - 1280 : cw - 2048;
            dg = gc >> 8; dc0 = gc & 255; dsh = 2 * dg; dpitch = 256;
            dbase = (bf16_t*)(p.ws + (isq ? WS_QB : WS_KB));
            const float qs = isq ? 0.125f * LOG2E : 1.f;
#pragma unroll
            for (int mi = 0; mi < 8; ++mi) {
                float ss = 0.f;
#pragma unroll
                for (int ni = 0; ni < 4; ++ni) { const f32x4 v = acc[mi][ni]; ss += v.x * v.x + v.y * v.y + v.z * v.z + v.w * v.w; }
                ss += __shfl_xor(ss, 16); ss += __shfl_xor(ss, 32);
                const float rstd = rsqrtf(ss * (1.f / 64.f) + EPS) * qs;
#pragma unroll
                for (int ni = 0; ni < 4; ++ni) G1_STG(mi, ni, acc[mi][ni] * rstd * *(const f32x4*)(nwp + ni * 16 + lc));
            }
        } else if (cw >= 2816 && cw < 3584) {
            const int gc = cw - 2816;
            dg = gc >> 8; dc0 = gc & 255; dsh = 2 * dg; dpitch = 256; dbase = (bf16_t*)(p.ws + WS_VB);
#pragma unroll
            for (int mi = 0; mi < 8; ++mi)
#pragma unroll
                for (int ni = 0; ni < 4; ++ni) G1_STG(mi, ni, acc[mi][ni]);
        } else if (cw >= 8448) {
            if (cw == 8448) {
                float* dst = (float*)(p.ws + WS_DT);
                const f32x4 bias = *(const f32x4*)(p.dt_bias + l * 16 + lc);
#pragma unroll
                for (int mi = 0; mi < 8; ++mi) {
                    const int row = m0 + wm * 128 + mi * 16 + idx;
                    f32x4 v = acc[mi][0] + bias, o;
                    o.x = v.x > 20.f ? v.x : log1pf(__expf(v.x)); o.y = v.y > 20.f ? v.y : log1pf(__expf(v.y));
                    o.z = v.z > 20.f ? v.z : log1pf(__expf(v.z)); o.w = v.w > 20.f ? v.w : log1pf(__expf(v.w));
                    *(f32x4*)(dst + (size_t)row * 16 + lc) = o;
                }
            }
        } else {
            int mode;
            if (cw < 768) { dbase = (bf16_t*)(p.ws + WS_VA); dpitch = 128; dc0 = cw - 640; mode = 0; }
            else if (cw < 1280) { dbase = (bf16_t*)(p.ws + WS_GA); dpitch = 512; dc0 = cw - 768; mode = 1; }
            else if (cw < 3840) { dbase = (bf16_t*)(p.ws + WS_GB); dpitch = 256; dc0 = cw - 3584; mode = 1; }
            else if (cw < 4864) { dbase = (bf16_t*)(p.ws + WS_XBC); dpitch = 1024; dc0 = cw - 3840; mode = 0; }
            else if (cw < 5376) { dbase = (bf16_t*)(p.ws + WS_ZS); dpitch = 512; dc0 = cw - 4864; mode = 1; }
            else { dbase = (bf16_t*)(p.ws + WS_MG); dpitch = 3072; dc0 = cw - 5376; mode = 2; }
            const float* bg = p.b_gate + l * 3072 + dc0 + lc;
#pragma unroll
            for (int mi = 0; mi < 8; ++mi) {
#pragma unroll
                for (int ni = 0; ni < 4; ++ni) {
                    f32x4 v = acc[mi][ni];
                    if (mode == 1) { v.x = siluf(v.x); v.y = siluf(v.y); v.z = siluf(v.z); v.w = siluf(v.w); }
                    else if (mode == 2) { const f32x4 bb = *(const f32x4*)(bg + ni * 16); v.x = sigmf(v.x + bb.x); v.y = sigmf(v.y + bb.y); v.z = sigmf(v.z + bb.z); v.w = sigmf(v.w + bb.w); }
                    G1_STG(mi, ni, v);
                }
            }
        }
#undef G1_STG
        if (dbase) {
            const int ch = lane & 7;
#pragma unroll
            for (int j = 0; j < 16; ++j) {
                const int rl = 8 * j + (lane >> 3), row = m0 + wm * 128 + rl;
                const u32x4 v = *(const u32x4*)(wl + rl * 128 + ((ch ^ (rl & 7)) * 16));
                size_t drow = (size_t)row;
                if (dsh >= 0) { const int bl = row >> 13, tt = row & (SEQ - 1); drow = (size_t)(bl * 3 + dg) * SEQ + (size_t)((tt & ((1 << dsh) - 1)) * (SEQ >> dsh) + (tt >> dsh)); }
                *(u32x4*)(dbase + drow * dpitch + dc0 + ch * 8) = v;
            }
        }
        __syncthreads();
    }
}

__device__ void merge_phase(const Params& p, int l, unsigned char* smem) {
    const bf16_t* MG = (const bf16_t*)(p.ws + WS_MG);
    const float* rstd = (const float*)(p.ws + WS_RSTD);
    bf16_t* MR = (bf16_t*)(p.ws + WS_MRG);
    for (int t = blockIdx.x; t < 64 * 4; t += gridDim.x) {
        const int xq = t >> 3, mt = (xq >> 2) * 8 + (t & 7), nt = xq & 3, m0 = mt * 256, n0 = nt * 256;
        u32x2 mpk[6][4];
#pragma unroll 1
        for (int br = 0; br < 3; ++br) {
            f32x4 acc[8][4];
            const bf16_t* A; const bf16_t* Bt; int K;
            if (br == 0) { A = (const bf16_t*)(p.ws + WS_QA); K = 512; Bt = (const bf16_t*)(p.ws + WS_WPA) + (size_t)l * 1024 * 512; }
            else if (br == 1) { A = (const bf16_t*)(p.ws + WS_YBM); K = 256; Bt = (const bf16_t*)(p.ws + WS_WPB) + (size_t)l * 1024 * 256; }
            else { A = (const bf16_t*)(p.ws + WS_YC); K = 512; Bt = (const bf16_t*)(p.ws + WS_WPC) + (size_t)l * 1024 * 512; }
            int tid = threadIdx.x;
            gemm_core<true>(A + (size_t)m0 * K, K, Bt + (size_t)n0 * K, K, K, acc, smem, tid);
            asm volatile("" : "+v"(tid));
            const int lane = tid & 63, w = tid >> 6, wm = w >> 2, wn = w & 3, idx = lane & 15, kq = lane >> 4;
#pragma unroll
            for (int mi = 0; mi < 8; ++mi) {
                const int row = m0 + wm * 128 + mi * 16 + idx;
                const float rs = (br == 2) ? rstd[row] : 1.f;
#pragma unroll
                for (int ni = 0; ni < 4; ++ni) {
                    const int col = n0 + wn * 64 + ni * 16 + 4 * kq;
                    const u32x2 g = *(const u32x2*)(MG + (size_t)row * 3072 + br * 1024 + col);
                    f32x4 gv; gv.x = bflo(g.x); gv.y = bfhi(g.x); gv.z = bflo(g.y); gv.w = bfhi(g.y);
                    f32x4 v = gv * rs * acc[mi][ni];
                    bf16_t* mp = MR + (size_t)row * 1024 + col;
                    if (mi < 6) {
                        if (br > 0) { const u32x2 o = mpk[mi < 6 ? mi : 0][ni]; v.x += bflo(o.x); v.y += bfhi(o.x); v.z += bflo(o.y); v.w += bfhi(o.y); }
                        u32x2 pk; pk.x = pk2(v.x, v.y); pk.y = pk2(v.z, v.w); mpk[mi < 6 ? mi : 0][ni] = pk;
                        if (br == 2) *(u32x2*)mp = pk;
                    } else {
                        if (br > 0) { const u32x2 o = *(const u32x2*)mp; v.x += bflo(o.x); v.y += bfhi(o.x); v.z += bflo(o.y); v.w += bfhi(o.y); }
                        st4bf(mp, v);
                    }
                }
            }
        }
    }
}

__device__ void out_phase(const Params& p, int l, int hb, const float* xsrc, unsigned char* smem) {
    const bf16_t* MR = (const bf16_t*)(p.ws + WS_MRG);
    const bf16_t* Wt = (const bf16_t*)(p.ws + WS_WOUT) + (size_t)l * 1024 * 1024;
    for (int t = blockIdx.x; t < 64 * 4; t += gridDim.x) {
        const int xq = t >> 3, mt = (xq >> 2) * 8 + (t & 7), nt = xq & 3, m0 = mt * 256, n0 = nt * 256;
        f32x4 acc[8][4];
        int tid = threadIdx.x;
        gemm_core(MR + (size_t)m0 * 1024, 1024, Wt + (size_t)n0 * 1024, 1024, 1024, acc, smem, tid);
        asm volatile("" : "+v"(tid));
        const int lane = tid & 63, w = tid >> 6, wm = w >> 2, wn = w & 3, idx = lane & 15, kq = lane >> 4;
#pragma unroll
        for (int mi = 0; mi < 8; ++mi) {
            const int row = m0 + wm * 128 + mi * 16 + idx; const size_t rg = (size_t)hb * TP + row; const int b = (int)(rg / SEQ);
            const float* gate = (const float*)(p.ws + WS_MOD) + (size_t)(l * 4 + b) * 3072 + 2048;
#pragma unroll
            for (int ni = 0; ni < 4; ++ni) {
                const int col = n0 + wn * 64 + ni * 16 + 4 * kq;
                const f32x4 xv = *(const f32x4*)(xsrc + rg * 1024 + col), gv = *(const f32x4*)(gate + col);
                *(f32x4*)(p.out + rg * 1024 + col) = xv + gv * acc[mi][ni];
            }
        }
    }
}

constexpr int AT_KS = 0, AT_VS = 9216, AT_LQ = 9216 + 8192, AT_LUT = AT_LQ + 512;

#define AT_STAGE_STORE() do { _Pragma("unroll") for (int i = 0; i < 2; ++i) { const int c = tid + 256 * i, row = c >> 3, ch = c & 7; \
        *(u32x4*)(Ks + row * 72 + ch * 8) = rk[i]; *(u32x4*)(Vs + (ch >> 2) * 4096 + row * 64 + (ch & 3) * 16) = rv[i]; } } while (0)

__device__ __forceinline__ void at_qk(f32x16& p0, f32x16& p1, const bf16_t* Ks, const bf16x8* qr, int r32, int hi) {
    bf16x8 kf[8];
#pragma unroll
    for (int ds = 0; ds < 4; ++ds) {
        kf[2 * ds] = *(const bf16x8*)(Ks + r32 * 72 + ds * 16 + hi * 8);
        kf[2 * ds + 1] = *(const bf16x8*)(Ks + (r32 + 32) * 72 + ds * 16 + hi * 8);
    }
    __builtin_amdgcn_sched_barrier(0);
    __builtin_amdgcn_s_setprio(1);
#pragma unroll
    for (int ds = 0; ds < 4; ++ds) {
        p0 = __builtin_amdgcn_mfma_f32_32x32x16_bf16(kf[2 * ds], qr[ds], p0, 0, 0, 0);
        p1 = __builtin_amdgcn_mfma_f32_32x32x16_bf16(kf[2 * ds + 1], qr[ds], p1, 0, 0, 0);
    }
    __builtin_amdgcn_s_setprio(0);
    __builtin_amdgcn_sched_barrier(0);
}
__device__ __forceinline__ void at_pv(f32x16& o0, f32x16& o1, const f32x16& p0, const f32x16& p1, const unsigned char* Vs, int lane) {
    const int hi = lane >> 5;
    const unsigned char* vb = Vs + ((lane >> 4) & 1) * 32 + (lane & 3) * 8 + (4 * hi + ((lane & 15) >> 2)) * 64;
    bf16x8 v0[4], v1[4], pa[4];
#pragma unroll
    for (int s = 0; s < 4; ++s) {
        v0[s] = cat8(tr16(vb + s * 1024), tr16(vb + s * 1024 + 512));
        v1[s] = cat8(tr16(vb + 4096 + s * 1024), tr16(vb + 4096 + s * 1024 + 512));
    }
#pragma unroll
    for (int s = 0; s < 4; ++s) {
        u32x4 pw;
        if (s < 2) { pw.x = pk2(p0[8 * s + 0], p0[8 * s + 1]); pw.y = pk2(p0[8 * s + 2], p0[8 * s + 3]); pw.z = pk2(p0[8 * s + 4], p0[8 * s + 5]); pw.w = pk2(p0[8 * s + 6], p0[8 * s + 7]); }
        else { const int q = s - 2; pw.x = pk2(p1[8 * q + 0], p1[8 * q + 1]); pw.y = pk2(p1[8 * q + 2], p1[8 * q + 3]); pw.z = pk2(p1[8 * q + 4], p1[8 * q + 5]); pw.w = pk2(p1[8 * q + 6], p1[8 * q + 7]); }
        pa[s] = __builtin_bit_cast(bf16x8, pw);
    }
    __builtin_amdgcn_sched_barrier(0);
    __builtin_amdgcn_s_setprio(1);
#pragma unroll
    for (int s = 0; s < 4; ++s) {
        o0 = __builtin_amdgcn_mfma_f32_32x32x16_bf16(pa[s], v0[s], o0, 0, 0, 0);
        o1 = __builtin_amdgcn_mfma_f32_32x32x16_bf16(pa[s], v1[s], o1, 0, 0, 0);
    }
    __builtin_amdgcn_s_setprio(0);
    __builtin_amdgcn_sched_barrier(0);
}

__device__ __forceinline__ void at_ldv(bf16x8 (&v0)[4], bf16x8 (&v1)[4], const unsigned char* Vs, int lane) {
    const int hi = lane >> 5;
    const unsigned char* vb = Vs + ((lane >> 4) & 1) * 32 + (lane & 3) * 8 + (4 * hi + ((lane & 15) >> 2)) * 64;
#pragma unroll
    for (int s = 0; s < 4; ++s) {
        v0[s] = cat8(tr16(vb + s * 1024), tr16(vb + s * 1024 + 512));
        v1[s] = cat8(tr16(vb + 4096 + s * 1024), tr16(vb + 4096 + s * 1024 + 512));
    }
}
__device__ __forceinline__ void at_pv2(f32x16& o0, f32x16& o1, const f32x16& p0, const f32x16& p1, const bf16x8 (&v0)[4], const bf16x8 (&v1)[4]) {
    bf16x8 pa[4];
#pragma unroll
    for (int s = 0; s < 4; ++s) {
        u32x4 pw;
        if (s < 2) { pw.x = pk2(p0[8 * s + 0], p0[8 * s + 1]); pw.y = pk2(p0[8 * s + 2], p0[8 * s + 3]); pw.z = pk2(p0[8 * s + 4], p0[8 * s + 5]); pw.w = pk2(p0[8 * s + 6], p0[8 * s + 7]); }
        else { const int q = s - 2; pw.x = pk2(p1[8 * q + 0], p1[8 * q + 1]); pw.y = pk2(p1[8 * q + 2], p1[8 * q + 3]); pw.z = pk2(p1[8 * q + 4], p1[8 * q + 5]); pw.w = pk2(p1[8 * q + 6], p1[8 * q + 7]); }
        pa[s] = __builtin_bit_cast(bf16x8, pw);
    }
    __builtin_amdgcn_sched_barrier(0);
    __builtin_amdgcn_s_setprio(1);
#pragma unroll
    for (int s = 0; s < 4; ++s) {
        o0 = __builtin_amdgcn_mfma_f32_32x32x16_bf16(pa[s], v0[s], o0, 0, 0, 0);
        o1 = __builtin_amdgcn_mfma_f32_32x32x16_bf16(pa[s], v1[s], o1, 0, 0, 0);
    }
    __builtin_amdgcn_s_setprio(0);
    __builtin_amdgcn_sched_barrier(0);
}

constexpr int ATA_STAGE = 17408, ATA_LQ = 2 * ATA_STAGE;
__device__ void attn_a_item(const Params& p, int item, int l, unsigned char* smem) {
    int tid_ = threadIdx.x; asm volatile("" : "+v"(tid_));
    const int tid = tid_, lane = tid & 63, w = tid >> 6, r32 = lane & 31, hi = lane >> 5;
    const int b = item >> 8, r = item & 255, kvh = r >> 7, qblk = (r >> 2) & 31, hq = kvh * 4 + (r & 3);
    float* lq = (float*)(smem + ATA_LQ) + w * 32;
    bf16_t* QA = (bf16_t*)(p.ws + WS_QA);
    const bf16_t* GA = (const bf16_t*)(p.ws + WS_GA);
    const size_t tokq = (size_t)b * SEQ + qblk * 256 + w * 32;
    bf16x8 qr[4];
#pragma unroll
    for (int ds = 0; ds < 4; ++ds) qr[ds] = *(const bf16x8*)(QA + (tokq + r32) * 512 + hq * 64 + ds * 16 + hi * 8);
    const bf16_t* Kb = (const bf16_t*)(p.ws + WS_KA) + (size_t)b * SEQ * 128 + kvh * 64;
    const bf16_t* Vb = (const bf16_t*)(p.ws + WS_VA) + (size_t)b * SEQ * 128 + kvh * 64;
    const float nshift = -((const float*)(p.ws + WS_BND))[l];
    f32x16 o0, o1;
#pragma unroll
    for (int i = 0; i < 16; ++i) { o0[i] = 0.f; o1[i] = 0.f; }
    f32x4 la4 = (f32x4){0.f, 0.f, 0.f, 0.f};
    constexpr int NT = SEQ / 64;
    const int row0 = tid >> 3, ch0 = tid & 7;
    const size_t goff0 = (size_t)row0 * 128 + ch0 * 8;
    const int ko0 = row0 * 144 + ch0 * 16;
    const int vo0 = 9216 + (ch0 >> 2) * 4096 + row0 * 64 + (ch0 & 3) * 16;
    u32x4 rkA[1], rvA[1], rkB[1], rvB[1];
#define ATA_LOAD(RK, RV, t) do { const size_t tb = (size_t)(t) * 64 * 128; RK[0] = *(const u32x4*)(Kb + tb + goff0); RV[0] = *(const u32x4*)(Vb + tb + goff0); } while (0)
#define ATA_STORE(RK, RV, st) do { unsigned char* sb_ = smem + (st) * ATA_STAGE; *(u32x4*)(sb_ + ko0) = RK[0]; *(u32x4*)(sb_ + vo0) = RV[0]; } while (0)
#define ATA_COMPUTE(st) do { const unsigned char* sb_ = smem + (st) * ATA_STAGE; f32x16 p0, p1; bf16x8 vf0[4], vf1[4]; \
        _Pragma("unroll") for (int i = 0; i < 16; ++i) { p0[i] = nshift; p1[i] = nshift; } \
        at_qk(p0, p1, (const bf16_t*)sb_, qr, r32, hi); \
        at_ldv(vf0, vf1, sb_ + 9216, lane); __builtin_amdgcn_sched_barrier(0); \
        _Pragma("unroll") for (int i = 0; i < 16; ++i) { p0[i] = __builtin_amdgcn_exp2f(p0[i]); p1[i] = __builtin_amdgcn_exp2f(p1[i]); } \
        _Pragma("unroll") for (int i = 0; i < 4; ++i) { la4 += (f32x4){p0[4 * i], p0[4 * i + 1], p0[4 * i + 2], p0[4 * i + 3]}; la4 += (f32x4){p1[4 * i], p1[4 * i + 1], p1[4 * i + 2], p1[4 * i + 3]}; } \
        at_pv2(o0, o1, p0, p1, vf0, vf1); } while (0)
    __syncthreads();
    ATA_LOAD(rkA, rvA, 0); ATA_LOAD(rkB, rvB, 1);
    ATA_STORE(rkA, rvA, 0);
    ATA_LOAD(rkA, rvA, 2);
    __syncthreads();
    for (int kt = 0; kt < NT; kt += 2) {
        ATA_COMPUTE(0);
        ATA_STORE(rkB, rvB, 1);
        if (kt + 3 < NT) ATA_LOAD(rkB, rvB, kt + 3);
        __syncthreads();
        ATA_COMPUTE(1);
        if (kt + 2 < NT) { ATA_STORE(rkA, rvA, 0); if (kt + 4 < NT) ATA_LOAD(rkA, rvA, kt + 4); }
        __syncthreads();
    }
#undef ATA_LOAD
#undef ATA_STORE
#undef ATA_COMPUTE
    float lacc = (la4.x + la4.y) + (la4.z + la4.w);
    lacc += __shfl_xor(lacc, 32);
    if (hi == 0) lq[r32] = lacc;
    asm volatile("s_waitcnt lgkmcnt(0)" ::: "memory");
#pragma unroll
    for (int rr = 0; rr < 16; ++rr) {
        const int q = crow(rr, hi); const float inv = 1.f / lq[q];
        const size_t off = (tokq + q) * 512 + hq * 64 + r32;
        const float g0 = bf2f(GA[off]), g1 = bf2f(GA[off + 32]);
        QA[off] = (bf16_t)(pk2(o0[rr] * inv * g0, 0.f) & 0xffffu);
        QA[off + 32] = (bf16_t)(pk2(o1[rr] * inv * g1, 0.f) & 0xffffu);
    }
}

__device__ void attn_b_item(const Params& p, int item, int l, unsigned char* smem) {
    int tid_ = VTID; asm volatile("" : "+v"(tid_));
    const int tid = tid_, lane = tid & 63, w = tid >> 6, r32 = lane & 31, hi = lane >> 5;
    const int blk = item & 63, j = (item >> 6) & 3, bg = item >> 8, g = bg % 3, b = bg / 3;
    const int sh = 2 * g, dil = 1 << sh, Mlen = SEQ >> sh;
    bf16_t* Ks = (bf16_t*)(smem + AT_KS); unsigned char* Vs = smem + AT_VS; float* lq = (float*)(smem + AT_LQ) + w * 32; float* lut = (float*)(smem + AT_LUT);
    bf16_t* QB = (bf16_t*)(p.ws + WS_QB) + (size_t)bg * SEQ * 256 + j * 64;
    const bf16_t* KB = (const bf16_t*)(p.ws + WS_KB) + (size_t)bg * SEQ * 256 + j * 64;
    const bf16_t* VB = (const bf16_t*)(p.ws + WS_VB) + (size_t)bg * SEQ * 256 + j * 64;
    float* LSE = (float*)(p.ws + WS_LSE) + (size_t)bg * SEQ * 4 + j;
    const int p0r = blk * 128, seq_lo = (p0r / Mlen) * Mlen, seq_hi = seq_lo + Mlen;
    __syncthreads();
    if (tid < 129) {
        const int rel = tid - 64, n = (rel < 0 ? -rel : rel) * dil;
        int bk;
        if (n < 8) bk = n; else { bk = 8 + (n >= 15) + (n >= 27) + (n >= 50) + (n >= 91) + (n >= 166) + (n >= 305) + (n >= 559); }
        if (rel > 0) bk += 16;
        lut[tid] = p.rel_bias[bk * 12 + g * 4 + j] * LOG2E;
    }
    const int qpos = p0r + w * 32 + r32;
    bf16x8 qr[4];
#pragma unroll
    for (int ds = 0; ds < 4; ++ds) qr[ds] = *(const bf16x8*)(QB + (size_t)qpos * 256 + ds * 16 + hi * 8);
    const float nshift = -((const float*)(p.ws + WS_BND))[2 + l];
    f32x16 o0, o1;
#pragma unroll
    for (int i = 0; i < 16; ++i) { o0[i] = 0.f; o1[i] = 0.f; }
    f32x4 la4 = (f32x4){0.f, 0.f, 0.f, 0.f};
    u32x4 rk[2], rv[2];
    for (int kt = 0; kt < 4; ++kt) {
        const int kbase = p0r - 64 + 64 * kt;
#pragma unroll
        for (int i = 0; i < 2; ++i) { const int c = tid + 256 * i, row = c >> 3, ch = c & 7;
            int pr = kbase + row; pr = pr < 0 ? 0 : (pr > SEQ - 1 ? SEQ - 1 : pr);
            rk[i] = *(const u32x4*)(KB + (size_t)pr * 256 + ch * 8); rv[i] = *(const u32x4*)(VB + (size_t)pr * 256 + ch * 8); }
        __syncthreads();
        AT_STAGE_STORE();
        __syncthreads();
        f32x16 p0, p1;
#pragma unroll
        for (int i = 0; i < 16; ++i) { p0[i] = nshift; p1[i] = nshift; }
        at_qk(p0, p1, Ks, qr, r32, hi);
#pragma unroll
        for (int i = 0; i < 16; ++i) {
            const int kv0 = kbase + crow(i, hi), kv1 = kv0 + 32;
            const int rel0 = kv0 - qpos, rel1 = kv1 - qpos;
            const bool ok0 = rel0 >= -64 && rel0 <= 64 && kv0 >= seq_lo && kv0 < seq_hi;
            const bool ok1 = rel1 >= -64 && rel1 <= 64 && kv1 >= seq_lo && kv1 < seq_hi;
            const float e0 = __builtin_amdgcn_exp2f(p0[i] + lut[ok0 ? rel0 + 64 : 64]);
            const float e1 = __builtin_amdgcn_exp2f(p1[i] + lut[ok1 ? rel1 + 64 : 64]);
            p0[i] = ok0 ? e0 : 0.f; p1[i] = ok1 ? e1 : 0.f;
        }
#pragma unroll
        for (int i = 0; i < 4; ++i) { la4 += (f32x4){p0[4 * i], p0[4 * i + 1], p0[4 * i + 2], p0[4 * i + 3]}; la4 += (f32x4){p1[4 * i], p1[4 * i + 1], p1[4 * i + 2], p1[4 * i + 3]}; }
        at_pv(o0, o1, p0, p1, Vs, lane);
    }
    float lacc = (la4.x + la4.y) + (la4.z + la4.w);
    lacc += __shfl_xor(lacc, 32);
    if (hi == 0) { lq[r32] = lacc; LSE[(size_t)qpos * 4] = (-nshift + log2f(lacc)) * LN2; }
    asm volatile("s_waitcnt lgkmcnt(0)" ::: "memory");
#pragma unroll
    for (int rr = 0; rr < 16; ++rr) {
        const int q = crow(rr, hi); const float inv = 1.f / lq[q];
        const size_t off = (size_t)(p0r + w * 32 + q) * 256 + r32;
        QB[off] = (bf16_t)(pk2(o0[rr] * inv, 0.f) & 0xffffu);
        QB[off + 32] = (bf16_t)(pk2(o1[rr] * inv, 0.f) & 0xffffu);
    }
}

__device__ void conv_phase(const Params& p, int l) {
    int tx_ = threadIdx.x; asm volatile("" : "+v"(tx_));
    const bf16_t* XBC = (const bf16_t*)(p.ws + WS_XBC);
    bf16_t* XC = (bf16_t*)(p.ws + WS_XBCC);
    const float* cw = p.conv_w + (size_t)l * 5 * 1024; const float* cb = p.conv_b + l * 1024;
    const int nthr = gridDim.x * 512;
    for (int u = blockIdx.x * 512 + tx_; u < (TP / 4) * 128; u += nthr) {
        const int ch = (u & 127) * 8, tg = u >> 7, tok0 = tg * 4, tt0 = tok0 & (SEQ - 1);
        u32x4 raw[8];
#pragma unroll
        for (int r = 0; r < 8; ++r) { const int tt = tt0 - 2 + r; raw[r] = (u32x4){0u, 0u, 0u, 0u};
            if (tt >= 0 && tt < SEQ) raw[r] = *(const u32x4*)(XBC + (size_t)(tok0 - 2 + r) * 1024 + ch); }
        float ac[4][8];
        { const f32x4 a = *(const f32x4*)(cb + ch), b2 = *(const f32x4*)(cb + ch + 4);
#pragma unroll
          for (int t = 0; t < 4; ++t) { ac[t][0] = a.x; ac[t][1] = a.y; ac[t][2] = a.z; ac[t][3] = a.w; ac[t][4] = b2.x; ac[t][5] = b2.y; ac[t][6] = b2.z; ac[t][7] = b2.w; } }
#pragma unroll
        for (int k = 0; k < 5; ++k) { const f32x4 wa = *(const f32x4*)(cw + k * 1024 + ch), wb = *(const f32x4*)(cw + k * 1024 + ch + 4);
#pragma unroll
            for (int t = 0; t < 4; ++t) { const u32x4 v = raw[t + k];
                ac[t][0] += bflo(v.x) * wa.x; ac[t][1] += bfhi(v.x) * wa.y; ac[t][2] += bflo(v.y) * wa.z; ac[t][3] += bfhi(v.y) * wa.w;
                ac[t][4] += bflo(v.z) * wb.x; ac[t][5] += bfhi(v.z) * wb.y; ac[t][6] += bflo(v.w) * wb.z; ac[t][7] += bfhi(v.w) * wb.w; } }
#pragma unroll
        for (int t = 0; t < 4; ++t) { u32x4 o;
            o.x = pk2(siluf(ac[t][0]), siluf(ac[t][1])); o.y = pk2(siluf(ac[t][2]), siluf(ac[t][3])); o.z = pk2(siluf(ac[t][4]), siluf(ac[t][5])); o.w = pk2(siluf(ac[t][6]), siluf(ac[t][7]));
            *(u32x4*)(XC + (size_t)(tok0 + t) * 1024 + ch) = o; }
    }
}

constexpr int SS_BS = 0, SS_CS = 8704, SS_XS = 17408, SS_XWS = 22016, SS_GS = 26624, SS_SB = 29184, SS_CW = 46592, SS_SC = 54272, SS_DTA = 55296, SS_END = 57344;

template <int PASS>
__device__ void ssd_item(const Params& p, int item, int l, unsigned char* smem) {
    int tid_ = VTID; asm volatile("" : "+v"(tid_));
    const int tid = tid_, lane = tid & 63, w = tid >> 6, idx = lane & 15, kq = lane >> 4;
    const int seg = item & 15, h = (item >> 4) & 7, dir = (item >> 7) & 1, b = item >> 8, grp = h >> 2;
    bf16_t* Bs = (bf16_t*)(smem + SS_BS); bf16_t* Cs = (bf16_t*)(smem + SS_CS); bf16_t* Xs = (bf16_t*)(smem + SS_XS); bf16_t* Xws = (bf16_t*)(smem + SS_XWS);
    bf16_t* Gs = (bf16_t*)(smem + SS_GS); bf16_t* Sb = (bf16_t*)(smem + SS_SB); float* sc = (float*)(smem + SS_SC);
    float* s_cA = (float*)(smem + SS_CW), *s_rsA = s_cA + SEGLEN, *s_wlA = s_rsA + SEGLEN, *s_totA = sc;
    const bf16_t* XBC = (const bf16_t*)(p.ws + WS_XBC);
    const float* DT = (const float*)(p.ws + WS_DT);
    float* ST = (float*)(p.ws + WS_ST); float* SEGT = (float*)(p.ws + WS_SEGT);
    bf16_t* Y = (bf16_t*)(p.ws + (dir ? WS_YS : WS_YF));
    const float Aneg = -__expf(p.a_log[l * 16 + dir * 8 + h]);
    const float Dh = p.d_skip[l * 8 + h];
    __syncthreads();
    f32x4 S[8];
#pragma unroll
    for (int nt = 0; nt < 8; ++nt) S[nt] = (f32x4){0.f, 0.f, 0.f, 0.f};
    const int ibase = item & ~15;
    if (PASS == 3) {
        if (dir == 0) {
            for (int e = 0; e < seg; ++e) { const float dc = __expf(SEGT[ibase + e]); const f32x4* src = (const f32x4*)(ST + (size_t)(ibase + e) * 8192);
#pragma unroll
                for (int nt = 0; nt < 8; ++nt) S[nt] = S[nt] * dc + src[(w * 8 + nt) * 64 + lane]; }
        } else {
            for (int e = NSEG - 1; e > seg; --e) { const float dc = __expf(SEGT[ibase + e]); const f32x4* src = (const f32x4*)(ST + (size_t)(ibase + e) * 8192);
#pragma unroll
                for (int nt = 0; nt < 8; ++nt) S[nt] = S[nt] * dc + src[(w * 8 + nt) * 64 + lane]; }
        }
#pragma unroll
        for (int nt = 0; nt < 8; ++nt) st4bf(Sb + (16 * w + idx) * 136 + 16 * nt + 4 * kq, S[nt]);
    }
    float* s_dta = (float*)(smem + SS_DTA);
#pragma unroll
    for (int i = 0; i < SEGLEN / 256; ++i) {
        const int e = tid + 256 * i, l32 = lane & 31;
        const float dtv = DT[((size_t)b * SEQ + seg * SEGLEN + e) * 16 + dir * 8 + h], av = dtv * Aneg;
        float pre = av;
#pragma unroll
        for (int o = 1; o < 32; o <<= 1) { const float t = __shfl_up(pre, o, 32); if (l32 >= o) pre += t; }
        const float tot = __shfl(pre, 31, 32);
        const float cc = dir ? (tot - pre + av) : pre;
        s_dta[e] = dtv; s_cA[e] = cc; s_rsA[e] = __expf(cc); s_wlA[e] = dtv * __expf(tot - cc);
        if (l32 == 0) s_totA[e >> 5] = tot;
    }
    float segtot = 0.f;
    const size_t tokb = (size_t)b * SEQ;
    const unsigned char* xb_ = (const unsigned char*)((const bf16_t*)(p.ws + WS_XBCC) + tokb * 1024);
    unsigned soff[5];
#pragma unroll
    for (int i = 0; i < 5; ++i) { const int u = tid + 256 * i, lrow = u / 40, ci = u % 40;
        const int scol = ci < 8 ? h * 64 + ci * 8 : (ci < 24 ? 512 + grp * 128 + (ci * 8 - 64) : 768 + grp * 128 + (ci * 8 - 192));
        soff[i] = (unsigned)((lrow * 1024 + scol) * 2); }
    for (int si = 0; si < NSUB; ++si) {
        const int scn = dir ? (NSUB - 1 - si) : si;
        const int t0 = seg * SEGLEN + scn * TSUB;
        __syncthreads();
        u32x4 raw[5];
#pragma unroll
        for (int i = 0; i < 5; ++i) raw[i] = *(const u32x4*)(xb_ + ((unsigned)(t0 * 2048) + soff[i]));
        const float* s_dt = s_dta + scn * TSUB; const float* s_c = s_cA + scn * TSUB; const float* s_rs = s_rsA + scn * TSUB; const float* s_wl = s_wlA + scn * TSUB;
        const float stot = s_totA[scn];
        segtot += stot;
#pragma unroll
        for (int i = 0; i < 5; ++i) { const int u = tid + 256 * i, lrow = u / 40, ci = u % 40, lc = ci * 8; const u32x4 o = raw[i];
            if (ci < 8) { *(u32x4*)(Xs + lrow * 72 + lc) = o; const float wl = s_wl[lrow];
                u32x4 o2; o2.x = pk2(bflo(o.x) * wl, bfhi(o.x) * wl); o2.y = pk2(bflo(o.y) * wl, bfhi(o.y) * wl); o2.z = pk2(bflo(o.z) * wl, bfhi(o.z) * wl); o2.w = pk2(bflo(o.w) * wl, bfhi(o.w) * wl);
                *(u32x4*)(Xws + lrow * 72 + lc) = o2; }
            else if (ci < 24) *(u32x4*)(Bs + lrow * 136 + (lc - 64)) = o;
            else *(u32x4*)(Cs + lrow * 136 + (lc - 192)) = o; }
        __syncthreads();
        if (PASS == 3) {
            const int it = w >> 1, jt = w & 1;
            f32x4 cb = (f32x4){0.f, 0.f, 0.f, 0.f};
            {
                bf16x8 fb[4], fc[4];
#pragma unroll
                for (int ks = 0; ks < 4; ++ks) { fb[ks] = *(const bf16x8*)(Bs + (16 * jt + idx) * 136 + ks * 32 + kq * 8); fc[ks] = *(const bf16x8*)(Cs + (16 * it + idx) * 136 + ks * 32 + kq * 8); }
                __builtin_amdgcn_sched_barrier(0);
#pragma unroll
                for (int ks = 0; ks < 4; ++ks) cb = __builtin_amdgcn_mfma_f32_16x16x32_bf16(fb[ks], fc[ks], cb, 0, 0, 0);
                __builtin_amdgcn_sched_barrier(0);
            }
            {
                const int ii = 16 * it + idx; const float ci_ = s_c[ii];
                f32x4 gv;
#pragma unroll
                for (int rg = 0; rg < 4; ++rg) {
                    const int jj = 16 * jt + 4 * kq + rg;
                    const bool ok = dir ? (jj >= ii) : (jj <= ii);
                    const float e = __expf(ci_ - s_c[jj]) * s_dt[jj];
                    gv[rg] = ok ? cb[rg] * e : 0.f;
                }
                st4bf(Gs + ii * 40 + 16 * jt + 4 * kq, gv);
            }
            __syncthreads();
            const unsigned char* xtr = (const unsigned char*)Xs + (8 * kq + (idx >> 2)) * 144 + (16 * w + 4 * (idx & 3)) * 2;
            const bf16x8 xf = cat8(tr16(xtr), tr16(xtr + 4 * 144));
#pragma unroll 1
            for (int it2 = 0; it2 < 2; ++it2) {
                const int ii = 16 * it2 + idx;
                const bf16x8 gf = *(const bf16x8*)(Gs + ii * 40 + 8 * kq);
                f32x4 yd = (f32x4){0.f, 0.f, 0.f, 0.f}, yo = (f32x4){0.f, 0.f, 0.f, 0.f};
                bf16x8 sf[4], cf[4];
#pragma unroll
                for (int ks = 0; ks < 4; ++ks) { sf[ks] = *(const bf16x8*)(Sb + (16 * w + idx) * 136 + ks * 32 + kq * 8); cf[ks] = *(const bf16x8*)(Cs + ii * 136 + ks * 32 + kq * 8); }
                __builtin_amdgcn_sched_barrier(0);
                yd = __builtin_amdgcn_mfma_f32_16x16x32_bf16(xf, gf, yd, 0, 0, 0);
#pragma unroll
                for (int ks = 0; ks < 4; ++ks) yo = __builtin_amdgcn_mfma_f32_16x16x32_bf16(sf[ks], cf[ks], yo, 0, 0, 0);
                __builtin_amdgcn_sched_barrier(0);
                f32x4 y = yd + yo * s_rs[ii];
                if (dir == 0) { const u32x2 xv = *(const u32x2*)(Xs + ii * 72 + 16 * w + 4 * kq);
                    y.x += Dh * bflo(xv.x); y.y += Dh * bfhi(xv.x); y.z += Dh * bflo(xv.y); y.w += Dh * bfhi(xv.y); }
                st4bf(Y + (tokb + t0 + ii) * 512 + h * 64 + 16 * w + 4 * kq, y);
            }
        }
        {
            const float dc = __expf(stot);
            const unsigned char* xw = (const unsigned char*)Xws + (8 * kq + (idx >> 2)) * 144 + (16 * w + 4 * (idx & 3)) * 2;
            const bf16x8 xwf = cat8(tr16(xw), tr16(xw + 4 * 144));
            bf16x8 bfv[8];
#pragma unroll
            for (int nt = 0; nt < 8; ++nt) {
                const unsigned char* bt = (const unsigned char*)Bs + (8 * kq + (idx >> 2)) * 272 + (16 * nt + 4 * (idx & 3)) * 2;
                bfv[nt] = cat8(tr16(bt), tr16(bt + 4 * 272));
            }
            __builtin_amdgcn_sched_barrier(0);
#pragma unroll
            for (int nt = 0; nt < 8; ++nt) S[nt] = __builtin_amdgcn_mfma_f32_16x16x32_bf16(bfv[nt], xwf, S[nt] * dc, 0, 0, 0);
            __builtin_amdgcn_sched_barrier(0);
            if (PASS == 3) {
#pragma unroll
                for (int nt = 0; nt < 8; ++nt) st4bf(Sb + (16 * w + idx) * 136 + 16 * nt + 4 * kq, S[nt]);
            }
        }
    }
    if (PASS == 1) {
        f32x4* dst = (f32x4*)(ST + (size_t)item * 8192);
#pragma unroll
        for (int nt = 0; nt < 8; ++nt) dst[(w * 8 + nt) * 64 + lane] = S[nt];
        if (tid == 0) SEGT[item] = segtot;
    }
}

__device__ void post2_phase(const Params& p) {
    int tx_ = threadIdx.x; asm volatile("" : "+v"(tx_));
    const int lane = tx_ & 63, gw = blockIdx.x * 8 + (tx_ >> 6), nw = gridDim.x * 8;
    const bf16_t* OB = (const bf16_t*)(p.ws + WS_QB); const float* LSE = (const float*)(p.ws + WS_LSE);
    const bf16_t* GB = (const bf16_t*)(p.ws + WS_GB);
    bf16_t* YBM = (bf16_t*)(p.ws + WS_YBM);
    const bf16_t* YF = (const bf16_t*)(p.ws + WS_YF); const bf16_t* YS = (const bf16_t*)(p.ws + WS_YS); const bf16_t* ZS = (const bf16_t*)(p.ws + WS_ZS);
    bf16_t* YC = (bf16_t*)(p.ws + WS_YC); float* RS = (float*)(p.ws + WS_RSTD);
    constexpr int R = 4;
    for (int row0 = gw; row0 < TP; row0 += R * nw) {
        float ls[R][3]; u32x2 ov[R][3], gt[R]; u32x4 a[R], bq[R], z[R];
        const int j = lane >> 4;
#pragma unroll
        for (int q = 0; q < R; ++q) { const int row = row0 + q * nw; if (row < TP) {
            const int bl = row >> 13, tt = row & (SEQ - 1);
#pragma unroll
            for (int g = 0; g < 3; ++g) { const int sh = 2 * g; const int pp = (tt & ((1 << sh) - 1)) * (SEQ >> sh) + (tt >> sh);
                const size_t ro = (size_t)(bl * 3 + g) * SEQ + pp; ls[q][g] = LSE[ro * 4 + j]; ov[q][g] = *(const u32x2*)(OB + ro * 256 + 4 * lane); }
            gt[q] = *(const u32x2*)(GB + (size_t)row * 256 + 4 * lane);
            a[q] = *(const u32x4*)(YF + (size_t)row * 512 + 8 * lane); bq[q] = *(const u32x4*)(YS + (size_t)row * 512 + 8 * lane); z[q] = *(const u32x4*)(ZS + (size_t)row * 512 + 8 * lane); } }
#pragma unroll
        for (int q = 0; q < R; ++q) { const int row = row0 + q * nw; if (row < TP) {
            const float mx = fmaxf(ls[q][0], fmaxf(ls[q][1], ls[q][2]));
            float wg[3]; float ws = 0.f;
#pragma unroll
            for (int g = 0; g < 3; ++g) { wg[g] = __expf(ls[q][g] - mx); ws += wg[g]; }
            const float inv = 1.f / ws;
            f32x4 acc = (f32x4){0.f, 0.f, 0.f, 0.f};
#pragma unroll
            for (int g = 0; g < 3; ++g) { const u32x2 v = ov[q][g]; const float wv = wg[g] * inv;
                acc.x += wv * bflo(v.x); acc.y += wv * bfhi(v.x); acc.z += wv * bflo(v.y); acc.w += wv * bfhi(v.y); }
            acc.x *= bflo(gt[q].x); acc.y *= bfhi(gt[q].x); acc.z *= bflo(gt[q].y); acc.w *= bfhi(gt[q].y);
            st4bf(YBM + (size_t)row * 256 + 4 * lane, acc);
            float y[8];
            y[0] = (bflo(a[q].x) + bflo(bq[q].x)) * bflo(z[q].x); y[1] = (bfhi(a[q].x) + bfhi(bq[q].x)) * bfhi(z[q].x);
            y[2] = (bflo(a[q].y) + bflo(bq[q].y)) * bflo(z[q].y); y[3] = (bfhi(a[q].y) + bfhi(bq[q].y)) * bfhi(z[q].y);
            y[4] = (bflo(a[q].z) + bflo(bq[q].z)) * bflo(z[q].z); y[5] = (bfhi(a[q].z) + bfhi(bq[q].z)) * bfhi(z[q].z);
            y[6] = (bflo(a[q].w) + bflo(bq[q].w)) * bflo(z[q].w); y[7] = (bfhi(a[q].w) + bfhi(bq[q].w)) * bfhi(z[q].w);
            float ss = 0.f;
#pragma unroll
            for (int e = 0; e < 8; ++e) ss += y[e] * y[e];
            ss = wave_sum(ss);
            u32x4 o; o.x = pk2(y[0], y[1]); o.y = pk2(y[2], y[3]); o.z = pk2(y[4], y[5]); o.w = pk2(y[6], y[7]);
            *(u32x4*)(YC + (size_t)row * 512 + 8 * lane) = o;
            if (lane == 0) RS[row] = rsqrtf(ss * (1.f / 512.f) + EPS);
        } }
    }
}


#define XB_TMO      128
#define XB_XCNT(j)  (256  + 64 * (j))
#define XB_XSUB(j)  (1280 + 64 * (j))
#define XB_XGEN(j)  (2304 + 64 * (j))
#define XB_TOP      3328
#define XB_TOPGEN   3392
#define XCD_BAR_WORDS 3456
#define XB_SPIN_CAP (1u << 20)
__device__ __forceinline__ unsigned xb_ld(unsigned* p)              { return __hip_atomic_load(p, __ATOMIC_RELAXED, __HIP_MEMORY_SCOPE_AGENT); }
__device__ __forceinline__ unsigned xb_add(unsigned* p, unsigned v) { return __hip_atomic_fetch_add(p, v, __ATOMIC_RELAXED, __HIP_MEMORY_SCOPE_AGENT); }
__device__ __forceinline__ unsigned xb_xcc_id() { return (unsigned)__builtin_amdgcn_s_getreg((3 << 11) | 20) & 0xFu; }
#define XB_SPIN(cond, bar) do { unsigned _sp = 0; while (cond) { __builtin_amdgcn_s_sleep(1); \
    if ((++_sp & 255u) == 0u) { if (xb_ld(&(bar)[XB_TMO])) break; if (_sp > XB_SPIN_CAP) { atomicAdd(&(bar)[XB_TMO], 1u); break; } } } } while (0)
struct XcdBarrier { unsigned* bar; unsigned x; volatile LDSAS unsigned* st; };
__device__ __forceinline__ XcdBarrier xcd_barrier_post(unsigned* bar, volatile LDSAS unsigned* st) {
    XcdBarrier b; b.bar = bar; b.x = xb_xcc_id(); b.st = st;
    if (threadIdx.x == 0) (void)xb_add(&bar[XB_XCNT(b.x)], 1u);
    return b;
}
__device__ __forceinline__ void xcd_barrier_complete(unsigned* bar, unsigned x, unsigned& nloc, unsigned& nx) {
    const unsigned G = gridDim.x * gridDim.y * gridDim.z;
    unsigned sum, cnt, mine, sp = 0u;
    for (;;) {
        sum = 0u; cnt = 0u; mine = 0u;
#pragma unroll
        for (unsigned j = 0; j < 16; ++j) { const unsigned c = xb_ld(&bar[XB_XCNT(j)]); sum += c; cnt += (c > 0u) ? 1u : 0u; mine = (j == x) ? c : mine; }
        if (sum == G) break;
        __builtin_amdgcn_s_sleep(1);
        if ((++sp & 255u) == 0u) { if (xb_ld(&bar[XB_TMO])) break; if (sp > XB_SPIN_CAP) { atomicAdd(&bar[XB_TMO], 1u); break; } }
    }
    nloc = mine > 0u ? mine : 1u; nx = cnt > 0u ? cnt : 1u;
}
__device__ __forceinline__ void xcd_barrier(const XcdBarrier& b) {
    asm volatile("s_waitcnt vmcnt(0)" ::: "memory");
    __syncthreads();
    if (threadIdx.x == 0) {
        unsigned* bar = b.bar;
        __builtin_amdgcn_s_waitcnt(0);
        unsigned nloc = b.st[0], nx = b.st[1];
        if (nloc == 0u) { xcd_barrier_complete(bar, b.x, nloc, nx); b.st[0] = nloc; b.st[1] = nx; }
        const unsigned old = xb_add(&bar[XB_XSUB(b.x)], 1u);
        const unsigned gen = old / nloc;
        if (old + 1u == (gen + 1u) * nloc) {
            __builtin_amdgcn_fence(__ATOMIC_RELEASE, "agent");
            asm volatile("s_waitcnt vmcnt(0)" ::: "memory");
            const unsigned og = xb_add(&bar[XB_TOP], 1u);
            const unsigned tg = og / nx;
            if (og + 1u == (tg + 1u) * nx) xb_add(&bar[XB_TOPGEN], 1u);
            else XB_SPIN(xb_ld(&bar[XB_TOPGEN]) == tg, bar);
            __builtin_amdgcn_fence(__ATOMIC_ACQUIRE, "agent");
            xb_add(&bar[XB_XGEN(b.x)], 1u);
            asm volatile("s_waitcnt vmcnt(0)" ::: "memory");
        } else {
            XB_SPIN(xb_ld(&bar[XB_XGEN(b.x)]) == gen, bar);
            __builtin_amdgcn_fence(__ATOMIC_ACQUIRE, "agent");
            asm volatile("s_waitcnt vmcnt(0)" ::: "memory");
        }
    }
    __syncthreads();
}

__device__ __forceinline__ unsigned char* lds_half(unsigned char* smem) { int h_ = threadIdx.x >> 8; asm volatile("" : "+v"(h_)); return smem + h_ * HALF_LDS; }
__global__ void __launch_bounds__(512, 2) hybrid_fwd(Params p) {
    cg::grid_group grid = cg::this_grid();
    extern __shared__ __attribute__((aligned(16))) unsigned char smem[];
    volatile LDSAS unsigned* bst = (volatile LDSAS unsigned*)(smem + LDS_TOTAL - 16);
    if (threadIdx.x < 4) bst[threadIdx.x] = 0u;
    __syncthreads();
    const XcdBarrier xbar = xcd_barrier_post((unsigned*)(p.ws + WS_BAR), bst);
    { const Params q = launder(p); phase0(q, lds_half(smem)); }
    grid.sync();
#pragma unroll 1
    for (int l = 0; l < DEPTH; ++l) {
#pragma unroll 1
        for (int hb = 0; hb < 2; ++hb) {
            { const Params q = launder(p); norm_phase(q, l, hb, (l == 0) ? q.x : q.out); }
            xcd_barrier(xbar);
            { const Params q = launder(p); gemm1_phase(q, l, hb, smem); }
            xcd_barrier(xbar);
            { const Params q = launder(p); conv_phase(q, l); }
            xcd_barrier(xbar);
            { const Params q = launder(p); unsigned char* smh = lds_half(smem);
#pragma unroll 1
              for (int it = VBLK; it < 512 + 1536; it += VGRID) { if (it < 512) ssd_item<1>(q, it, l, smh); else attn_b_item(q, it - 512, l, smh); } }
            xcd_barrier(xbar);
            { const Params q = launder(p);
#pragma unroll 1
              for (int it = blockIdx.x; it < 512; it += gridDim.x) attn_a_item(q, it, l, smem);
              unsigned char* smh = lds_half(smem);
#pragma unroll 1
              for (int it = VBLK; it < 512; it += VGRID) ssd_item<3>(q, it, l, smh); }
            xcd_barrier(xbar);
            { const Params q = launder(p); post2_phase(q); }
            xcd_barrier(xbar);
            { const Params q = launder(p); merge_phase(q, l, smem); }
            xcd_barrier(xbar);
            { const Params q = launder(p); out_phase(q, l, hb, (l == 0) ? q.x : q.out, smem); }
        }
    }
}

extern "C" void kernel_launch(void* const* d_in, const int* in_sizes, int n_in, void* d_out, int out_size, void* d_ws, size_t ws_size, hipStream_t stream) {
    static int grid_blocks = 0;
    if (!grid_blocks) {
        int dev = 0, cus = 0, per_cu = 0;
        hipGetDevice(&dev);
        hipDeviceGetAttribute(&cus, hipDeviceAttributeMultiprocessorCount, dev);
        hipFuncSetAttribute((const void*)hybrid_fwd, hipFuncAttributeMaxDynamicSharedMemorySize, LDS_TOTAL);
        hipOccupancyMaxActiveBlocksPerMultiprocessor(&per_cu, hybrid_fwd, 512, LDS_TOTAL);
        if (per_cu > 1) per_cu = 1;
        if (per_cu < 1) per_cu = 1;
        grid_blocks = cus * per_cu;
    }
    Params p{};
    const float** pp = (const float**)&p;
    for (int i = 0; i < 22; ++i) pp[i] = (const float*)d_in[i];
    p.out = (float*)d_out; p.ws = (unsigned char*)d_ws;
    hipMemsetAsync((unsigned char*)d_ws + WS_BAR, 0, XCD_BAR_WORDS * 4, stream);
    void* args[] = {&p};
    hipError_t e = hipLaunchCooperativeKernel((void*)hybrid_fwd, dim3(grid_blocks), dim3(512), args, LDS_TOTAL, stream);
    if (e != hipSuccess) fprintf(stderr, "cooperative launch failed: %s (grid %d)\n", hipGetErrorString(e), grid_blocks);
}
```

```cpp
#include <hip/hip_runtime.h>
#include <hip/hip_cooperative_groups.h>
#include <cstdint>
#include <cstdio>
namespace cg = cooperative_groups;

typedef unsigned short bf16_t;
typedef short bf16x8 __attribute__((ext_vector_type(8)));
typedef short v4i16 __attribute__((ext_vector_type(4)));
typedef float f32x2 __attribute__((ext_vector_type(2)));
typedef float f32x4 __attribute__((ext_vector_type(4)));
typedef float f32x16 __attribute__((ext_vector_type(16)));
typedef unsigned u32x2 __attribute__((ext_vector_type(2)));
typedef unsigned u32x4 __attribute__((ext_vector_type(4)));
typedef __bf16 bf16x2_t __attribute__((ext_vector_type(2)));
#define LDSAS __attribute__((address_space(3)))
#define VTID ((int)(threadIdx.x & 255u))
__device__ __forceinline__ int vblk_() { int h_ = threadIdx.x >> 8; asm volatile("" : "+v"(h_)); return __builtin_amdgcn_readfirstlane(2 * (int)blockIdx.x + h_); }
#define VBLK vblk_()
#define VGRID ((int)(2u * gridDim.x))
constexpr int HALF_LDS = 73728, LDS_TOTAL = 147456;

constexpr int SEQ = 8192, DM = 1024, NBATCH = 4, NBH = 2, TP = NBH * SEQ, DEPTH = 2;
constexpr int NP = 8704;
constexpr float EPS = 1e-6f;
constexpr float LOG2E = 1.4426950408889634f, LN2 = 0.6931471805599453f;
constexpr int NSEG = 16, SEGLEN = 512, TSUB = 32, NSUB = SEGLEN / TSUB;

constexpr size_t MiB = 1u << 20;
constexpr size_t WS_WIN = 0;
constexpr size_t WS_WPA = 34 * MiB;
constexpr size_t WS_WPB = 36 * MiB;
constexpr size_t WS_WPC = 37 * MiB;
constexpr size_t WS_WOUT = 39 * MiB;
constexpr size_t WS_MOD = 43 * MiB;
constexpr size_t WS_ROPE = 43 * MiB + 128 * 1024;
constexpr size_t WS_BND = 43 * MiB + 160 * 1024;
constexpr size_t WS_RSTD = 43 * MiB + 256 * 1024;
constexpr size_t WS_SEGT = 43 * MiB + 512 * 1024;
constexpr size_t WS_LSE = 44 * MiB;
constexpr size_t WS_DT = 45 * MiB;
constexpr size_t WS_BAR = 46 * MiB;
constexpr size_t WS_H = 48 * MiB;
constexpr size_t WS_QA = 80 * MiB;
constexpr size_t WS_KA = 96 * MiB;
constexpr size_t WS_VA = 100 * MiB;
constexpr size_t WS_GA = 104 * MiB;
constexpr size_t WS_QB = 120 * MiB;
constexpr size_t WS_KB = 144 * MiB;
constexpr size_t WS_VB = 168 * MiB;
constexpr size_t WS_GB = 192 * MiB;
constexpr size_t WS_XBC = 200 * MiB;
constexpr size_t WS_ZS = 232 * MiB;
constexpr size_t WS_MG = 248 * MiB;
constexpr size_t WS_YF = 344 * MiB;
constexpr size_t WS_YS = 360 * MiB;
constexpr size_t WS_YBM = 376 * MiB;
constexpr size_t WS_YC = 384 * MiB;
constexpr size_t WS_MRG = 400 * MiB;
constexpr size_t WS_ST = 432 * MiB;
constexpr size_t WS_XBCC = 448 * MiB;

struct Params {
    const float *x, *c, *norm_w, *w_ada, *b_ada, *w_in, *b_gate, *q_norm_a, *k_norm_a, *q_norm_b, *k_norm_b, *rel_bias,
        *conv_w, *conv_b, *a_log, *dt_bias, *d_skip, *ssm_norm_w, *w_proj_a, *w_proj_b, *w_proj_c, *w_out;
    float* out;
    unsigned char* ws;
};


#define AS1 __attribute__((address_space(1)))
#define GLOBF(f) do { AS1 const float* g_ = (AS1 const float*)p.f; asm volatile("" : "+s"(g_)); q.f = (const float*)g_; } while (0)
__device__ __forceinline__ Params launder(const Params& p) {
    Params q;
    GLOBF(x); GLOBF(c); GLOBF(norm_w); GLOBF(w_ada); GLOBF(b_ada); GLOBF(w_in); GLOBF(b_gate); GLOBF(q_norm_a); GLOBF(k_norm_a); GLOBF(q_norm_b); GLOBF(k_norm_b); GLOBF(rel_bias);
    GLOBF(conv_w); GLOBF(conv_b); GLOBF(a_log); GLOBF(dt_bias); GLOBF(d_skip); GLOBF(ssm_norm_w); GLOBF(w_proj_a); GLOBF(w_proj_b); GLOBF(w_proj_c); GLOBF(w_out);
    { AS1 float* g_ = (AS1 float*)p.out; asm volatile("" : "+s"(g_)); q.out = (float*)g_; }
    { AS1 unsigned char* g_ = (AS1 unsigned char*)p.ws; asm volatile("" : "+s"(g_)); q.ws = (unsigned char*)g_; }
    return q;
}
__device__ __forceinline__ unsigned pk2(float lo, float hi) { f32x2 v = {lo, hi}; bf16x2_t b = __builtin_convertvector(v, bf16x2_t); return __builtin_bit_cast(unsigned, b); }
__device__ __forceinline__ float bf2f(unsigned short b) { return __uint_as_float(((unsigned)b) << 16); }
__device__ __forceinline__ float bflo(unsigned u) { return __uint_as_float(u << 16); }
__device__ __forceinline__ float bfhi(unsigned u) { return __uint_as_float(u & 0xffff0000u); }
__device__ __forceinline__ float siluf(float v) { return v * __builtin_amdgcn_rcpf(1.f + __builtin_amdgcn_exp2f(-1.4426950408889634f * v)); }
__device__ __forceinline__ float sigmf(float v) { return __builtin_amdgcn_rcpf(1.f + __builtin_amdgcn_exp2f(-1.4426950408889634f * v)); }
__device__ __forceinline__ float wave_sum(float v) {
#pragma unroll
    for (int o = 1; o < 64; o <<= 1) v += __shfl_xor(v, o);
    return v;
}
__device__ __forceinline__ v4i16 tr16(const unsigned char* p) { return __builtin_amdgcn_ds_read_tr16_b64_v4i16((LDSAS v4i16*)p); }
__device__ __forceinline__ bf16x8 cat8(v4i16 a, v4i16 b) { return (bf16x8){a[0], a[1], a[2], a[3], b[0], b[1], b[2], b[3]}; }
__device__ __forceinline__ int crow(int r, int hi) { return (r & 3) + 8 * (r >> 2) + 4 * hi; }

struct P0It { const float* W; bf16_t* Wt; const float* rs; int ldw, K, k0, n0, mode; };
__device__ __forceinline__ void p0_load(const P0It& t, float (&vv)[16]) {
    const int tid = VTID, tx = tid & 63, ty = tid >> 6;
    const int np = t.n0 + tx; int n = np; bool valid = true;
    if (t.mode == 1) {
        if (np < 4352) n = np; else if (np < 4864) n = np + 512; else if (np < 5376) n = np - 512;
        else if (np < 8448) n = np + 16; else if (np < 8464) n = np - 3072; else { valid = false; n = 0; }
    }
#pragma unroll
    for (int i = 0; i < 16; ++i) { const int k = ty + 4 * i; vv[i] = valid ? t.W[(size_t)(t.k0 + k) * t.ldw + n] : 0.f; }
}
__device__ __forceinline__ void p0_finish(const P0It& t, const float (&vv)[16], float* tile) {
    const int tid = VTID, tx = tid & 63, ty = tid >> 6;
#pragma unroll
    for (int i = 0; i < 16; ++i) { const int k = ty + 4 * i; float v = vv[i]; if (t.rs) v *= t.rs[t.k0 + k]; tile[k * 65 + tx] = v; }
    __syncthreads();
    const int r = tid >> 2, kc = (tid & 3) * 16;
    u32x4 o0, o1;
    o0.x = pk2(tile[(kc + 0) * 65 + r], tile[(kc + 1) * 65 + r]); o0.y = pk2(tile[(kc + 2) * 65 + r], tile[(kc + 3) * 65 + r]);
    o0.z = pk2(tile[(kc + 4) * 65 + r], tile[(kc + 5) * 65 + r]); o0.w = pk2(tile[(kc + 6) * 65 + r], tile[(kc + 7) * 65 + r]);
    o1.x = pk2(tile[(kc + 8) * 65 + r], tile[(kc + 9) * 65 + r]); o1.y = pk2(tile[(kc + 10) * 65 + r], tile[(kc + 11) * 65 + r]);
    o1.z = pk2(tile[(kc + 12) * 65 + r], tile[(kc + 13) * 65 + r]); o1.w = pk2(tile[(kc + 14) * 65 + r], tile[(kc + 15) * 65 + r]);
    bf16_t* dst = t.Wt + (size_t)(t.n0 + r) * t.K + t.k0 + kc;
    *(u32x4*)dst = o0; *(u32x4*)(dst + 8) = o1;
    __syncthreads();
}
constexpr int P0_IN = 16 * 136, P0_PA = 8 * 16, P0_PB = 4 * 16, P0_PC = 8 * 16, P0_OUT = 16 * 16, P0_L = P0_IN + P0_PA + P0_PB + P0_PC + P0_OUT;
__device__ __forceinline__ P0It p0_params(const Params& p, int item) {
    P0It t; const int l = item / P0_L; int r = item % P0_L; t.rs = nullptr; t.mode = 0;
    if (r < P0_IN) { t.W = p.w_in + (size_t)l * 1024 * 8464; t.ldw = 8464; t.K = 1024; t.Wt = (bf16_t*)(p.ws + WS_WIN) + (size_t)l * NP * 1024; t.k0 = (r / 136) * 64; t.n0 = (r % 136) * 64; t.mode = 1; return t; }
    r -= P0_IN;
    if (r < P0_PA) { t.W = p.w_proj_a + (size_t)l * 512 * 1024; t.ldw = 1024; t.K = 512; t.Wt = (bf16_t*)(p.ws + WS_WPA) + (size_t)l * 1024 * 512; t.k0 = (r / 16) * 64; t.n0 = (r % 16) * 64; return t; }
    r -= P0_PA;
    if (r < P0_PB) { t.W = p.w_proj_b + (size_t)l * 256 * 1024; t.ldw = 1024; t.K = 256; t.Wt = (bf16_t*)(p.ws + WS_WPB) + (size_t)l * 1024 * 256; t.k0 = (r / 16) * 64; t.n0 = (r % 16) * 64; return t; }
    r -= P0_PB;
    if (r < P0_PC) { t.W = p.w_proj_c + (size_t)l * 512 * 1024; t.ldw = 1024; t.K = 512; t.Wt = (bf16_t*)(p.ws + WS_WPC) + (size_t)l * 1024 * 512; t.k0 = (r / 16) * 64; t.n0 = (r % 16) * 64; t.rs = p.ssm_norm_w + l * 512; return t; }
    r -= P0_PC;
    t.W = p.w_out + (size_t)l * 1024 * 1024; t.ldw = 1024; t.K = 1024; t.Wt = (bf16_t*)(p.ws + WS_WOUT) + (size_t)l * 1024 * 1024; t.k0 = (r / 16) * 64; t.n0 = (r % 16) * 64; return t;
}

__device__ void phase0(const Params& p, unsigned char* smem) {
    const int tid = VTID;
    float* tile = (float*)smem;
    constexpr int I_T = 2 * P0_L, I_MOD = 192, I_ALL = I_T + I_MOD + 1;
    {
        int item = VBLK;
        if (item < I_T) {
            P0It cur = p0_params(p, item); float va[16], vb[16]; p0_load(cur, va);
            for (;;) {
                const int nx = item + VGRID; const bool more = nx < I_T; P0It nxt = cur;
                if (more) { nxt = p0_params(p, nx); p0_load(nxt, vb); }
                p0_finish(cur, va, tile);
                if (!more) break;
                item = nx; cur = nxt;
#pragma unroll
                for (int i = 0; i < 16; ++i) va[i] = vb[i];
            }
        }
    }
    for (int item = VBLK; item < I_ALL; item += VGRID) {
        if (item < I_T) {
            continue;
        } else if (item < I_T + I_MOD) {
            const int it = item - I_T, l = it / 96, col0 = (it % 96) * 32, cl = tid & 31, ks = tid >> 5;
            float a0 = 0.f, a1 = 0.f, a2 = 0.f, a3 = 0.f;
            const float* wp = p.w_ada + ((size_t)l * 1024 + ks * 128) * 3072 + col0 + cl;
#pragma unroll 8
            for (int k = 0; k < 128; ++k) {
                const float wv = wp[(size_t)k * 3072]; const int kk = ks * 128 + k;
                a0 += siluf(p.c[kk]) * wv; a1 += siluf(p.c[1024 + kk]) * wv; a2 += siluf(p.c[2048 + kk]) * wv; a3 += siluf(p.c[3072 + kk]) * wv;
            }
            float* red = (float*)smem;
            red[(ks * 32 + cl) * 4 + 0] = a0; red[(ks * 32 + cl) * 4 + 1] = a1; red[(ks * 32 + cl) * 4 + 2] = a2; red[(ks * 32 + cl) * 4 + 3] = a3;
            __syncthreads();
            if (tid < 128) { const int b = tid >> 5, c2 = tid & 31; float s = 0.f;
#pragma unroll
                for (int k = 0; k < 8; ++k) s += red[(k * 32 + c2) * 4 + b];
                ((float*)(p.ws + WS_MOD))[(l * 4 + b) * 3072 + col0 + c2] = s + p.b_ada[l * 3072 + col0 + c2]; }
            __syncthreads();
        } else {
            float* rc = (float*)(p.ws + WS_ROPE); float* rs = rc + 128 * 16;
            for (int e = tid; e < 2048; e += 256) {
                const int pos = e >> 4, i = e & 15;
                const float freq = powf(10000.0f, -(float)i / 16.0f);
                const float ang = (float)pos * freq;
                const double rev = (double)ang * 0.15915494309189535; const double fr = rev - rint(rev);
                const float a = (float)(fr * 6.283185307179586);
                rc[e] = cosf(a); rs[e] = sinf(a);
            }
            if (tid < 2) {
                const int l = tid; float mqa = 0.f, mka = 0.f, mqb = 0.f, mkb = 0.f, mb = 0.f;
                for (int i = 0; i < 64; ++i) { mqa = fmaxf(mqa, fabsf(p.q_norm_a[l * 64 + i])); mka = fmaxf(mka, fabsf(p.k_norm_a[l * 64 + i]));
                    mqb = fmaxf(mqb, fabsf(p.q_norm_b[l * 64 + i])); mkb = fmaxf(mkb, fabsf(p.k_norm_b[l * 64 + i])); }
                for (int i = 0; i < 32 * 12; ++i) mb = fmaxf(mb, p.rel_bias[i]);
                float* bd = (float*)(p.ws + WS_BND);
                bd[l] = 8.f * mqa * mka * LOG2E; bd[2 + l] = (8.f * mqb * mkb + mb) * LOG2E;
            }
        }
    }
}

__device__ void norm_phase(const Params& p, int l, int hb, const float* xsrc) {
    int tx_ = threadIdx.x; asm volatile("" : "+v"(tx_));
    const int lane = tx_ & 63, gw = blockIdx.x * 8 + (tx_ >> 6), nw = gridDim.x * 8;
    bf16_t* H = (bf16_t*)(p.ws + WS_H);
    const float* nwp = p.norm_w + l * 1024;
    for (int row0 = gw; row0 < TP; row0 += 4 * nw) {
        f32x4 v[4][4];
#pragma unroll
        for (int q = 0; q < 4; ++q) { const int row = row0 + q * nw;
            if (row < TP) { const f32x4* xr = (const f32x4*)(xsrc + ((size_t)hb * TP + row) * 1024);
#pragma unroll
                for (int j = 0; j < 4; ++j) v[q][j] = xr[lane + 64 * j]; } }
#pragma unroll
        for (int q = 0; q < 4; ++q) { const int row = row0 + q * nw;
            if (row < TP) {
                const size_t rg = (size_t)hb * TP + row; const int b = (int)(rg / SEQ);
                const float* md = (const float*)(p.ws + WS_MOD) + (size_t)(l * 4 + b) * 3072;
                float ss = 0.f;
#pragma unroll
                for (int j = 0; j < 4; ++j) ss += v[q][j].x * v[q][j].x + v[q][j].y * v[q][j].y + v[q][j].z * v[q][j].z + v[q][j].w * v[q][j].w;
                ss = wave_sum(ss); const float rstd = rsqrtf(ss * (1.f / 1024.f) + EPS);
#pragma unroll
                for (int j = 0; j < 4; ++j) {
                    const int col = 4 * (lane + 64 * j);
                    const f32x4 w4 = *(const f32x4*)(nwp + col), sh = *(const f32x4*)(md + col), sc = *(const f32x4*)(md + 1024 + col);
                    const f32x4 o = v[q][j] * rstd * w4 * (1.f + sc) + sh;
                    u32x2 pk; pk.x = pk2(o.x, o.y); pk.y = pk2(o.z, o.w);
                    *(u32x2*)(H + (size_t)row * 1024 + col) = pk;
                }
            } }
    }
}

constexpr int G_STAGE = 65536, G_AB = 32768;
template <bool LOWREG = false>
__device__ __forceinline__ void gemm_core(const bf16_t* __restrict__ A, int lda, const bf16_t* __restrict__ Bt, int ldb, int K, f32x4 (&acc)[8][4], unsigned char* smem, int tid) {
    asm volatile("" : "+v"(tid));
    const int lane = tid & 63, w = __builtin_amdgcn_readfirstlane(tid >> 6), wm = w >> 2, wn = w & 3, idx = lane & 15, kq = lane >> 4;
    unsigned offA[4], offB[4];
#pragma unroll
    for (int j = 0; j < 4; ++j) { const int row = (j * 8 + w) * 8 + (lane >> 3), c = (lane & 7) ^ ((row >> 1) & 7);
        offA[j] = (unsigned)(row * lda + c * 8) * 2u; offB[j] = (unsigned)(row * ldb + c * 8) * 2u; }
#pragma unroll
    for (int mi = 0; mi < 8; ++mi)
#pragma unroll
        for (int ni = 0; ni < 4; ++ni) acc[mi][ni] = (f32x4){0.f, 0.f, 0.f, 0.f};
    LDSAS unsigned char* lds = (LDSAS unsigned char*)smem;
#define G_ISSUE1(kt, st, j) do { \
        __builtin_amdgcn_global_load_lds((const unsigned*)((const char*)A + offA[j] + (kt) * 128), (LDSAS unsigned*)(lds + (st) * G_STAGE + ((j) * 8 + w) * 1024), 16, 0, 0); \
        __builtin_amdgcn_global_load_lds((const unsigned*)((const char*)Bt + offB[j] + (kt) * 128), (LDSAS unsigned*)(lds + (st) * G_STAGE + G_AB + ((j) * 8 + w) * 1024), 16, 0, 0); } while (0)
#define G_ISSUE(kt, st) do { G_ISSUE1(kt, st, 0); G_ISSUE1(kt, st, 1); G_ISSUE1(kt, st, 2); G_ISSUE1(kt, st, 3); } while (0)
    const int nk = K >> 6;
    G_ISSUE(0, 0);
    asm volatile("s_waitcnt vmcnt(0)" ::: "memory");
    __syncthreads();
    const int swz = (idx >> 1) & 7;
    const int aoff = (wm * 128 + idx) * 128, boff = G_AB + (wn * 64 + idx) * 128;
    for (int kt = 0; kt < nk; ++kt) {
        const int st = kt & 1;
        const bool more = kt + 1 < nk;
        const unsigned char* sb = smem + st * G_STAGE;
        if constexpr (!LOWREG) {
#pragma unroll
        for (int ks = 0; ks < 2; ++ks) {
            bf16x8 bfr[4], af[8];
            const int co = ((ks * 4 + kq) ^ swz) * 16;
#pragma unroll
            for (int ni = 0; ni < 4; ++ni) bfr[ni] = *(const bf16x8*)(sb + boff + ni * 2048 + co);
#pragma unroll
            for (int mi = 0; mi < 8; ++mi) af[mi] = *(const bf16x8*)(sb + aoff + mi * 2048 + co);
            if (more) { G_ISSUE1(kt + 1, st ^ 1, ks * 2); G_ISSUE1(kt + 1, st ^ 1, ks * 2 + 1); }
            __builtin_amdgcn_sched_barrier(0);
            __builtin_amdgcn_s_setprio(1);
#pragma unroll
            for (int mi = 0; mi < 8; ++mi)
#pragma unroll
                for (int ni = 0; ni < 4; ++ni) acc[mi][ni] = __builtin_amdgcn_mfma_f32_16x16x32_bf16(bfr[ni], af[mi], acc[mi][ni], 0, 0, 0);
            __builtin_amdgcn_s_setprio(0);
            __builtin_amdgcn_sched_barrier(0);
        }
        } else {
#pragma unroll
        for (int ks = 0; ks < 2; ++ks) {
            bf16x8 bfr[4];
            const int co = ((ks * 4 + kq) ^ swz) * 16;
#pragma unroll
            for (int ni = 0; ni < 4; ++ni) bfr[ni] = *(const bf16x8*)(sb + boff + ni * 2048 + co);
#pragma unroll
            for (int mh = 0; mh < 2; ++mh) {
                bf16x8 af[4];
#pragma unroll
                for (int mi = 0; mi < 4; ++mi) af[mi] = *(const bf16x8*)(sb + aoff + (mh * 4 + mi) * 2048 + co);
                if (more) G_ISSUE1(kt + 1, st ^ 1, ks * 2 + mh);
                __builtin_amdgcn_sched_barrier(0);
                __builtin_amdgcn_s_setprio(1);
#pragma unroll
                for (int mi = 0; mi < 4; ++mi)
#pragma unroll
                    for (int ni = 0; ni < 4; ++ni) acc[mh * 4 + mi][ni] = __builtin_amdgcn_mfma_f32_16x16x32_bf16(bfr[ni], af[mi], acc[mh * 4 + mi][ni], 0, 0, 0);
                __builtin_amdgcn_s_setprio(0);
                __builtin_amdgcn_sched_barrier(0);
            }
        }
        }
        asm volatile("s_waitcnt vmcnt(0)" ::: "memory");
        __syncthreads();
    }
#undef G_ISSUE1
#undef G_ISSUE
}

__device__ __forceinline__ void st4bf(bf16_t* dst, f32x4 v) { u32x2 pk; pk.x = pk2(v.x, v.y); pk.y = pk2(v.z, v.w); *(u32x2*)dst = pk; }

__device__ void gemm1_phase(const Params& p, int l, int hb, unsigned char* smem) {
    const bf16_t* H = (const bf16_t*)(p.ws + WS_H);
    const bf16_t* Wt = (const bf16_t*)(p.ws + WS_WIN) + (size_t)l * NP * 1024;
    const float* ropec = (const float*)(p.ws + WS_ROPE); const float* ropes = ropec + 2048;
    constexpr int NT = 34, NTILES = 64 * NT, GRP = 8 * NT;
    for (int t = blockIdx.x; t < NTILES; t += gridDim.x) {
        const int grp = t / GRP, r = t % GRP, jx = NT * (r & 7) + (r >> 3), mt = grp * 8 + (jx & 7), nt = jx >> 3;
        const int m0 = mt * 256, n0 = nt * 256;
        f32x4 acc[8][4];
        int tid = threadIdx.x;
        gemm_core(H + (size_t)m0 * 1024, 1024, Wt + (size_t)n0 * 1024, 1024, 1024, acc, smem, tid);
        asm volatile("" : "+v"(tid));
        const int lane = tid & 63, w = __builtin_amdgcn_readfirstlane(tid >> 6), wm = w >> 2, wn = w & 3, idx = lane & 15, kq = lane >> 4;
        const int cw = n0 + wn * 64;
        const int lc = 4 * kq;
        unsigned char* wl = smem + w * 16384;
#define G1_STG(mi_, ni_, v_) do { const int r_ = (mi_) * 16 + idx; const f32x4 t_ = (v_); u32x2 pk_; pk_.x = pk2(t_.x, t_.y); pk_.y = pk2(t_.z, t_.w); \
        *(u32x2*)(wl + r_ * 128 + ((((ni_) * 2 + (kq >> 1)) ^ (r_ & 7)) * 16) + (kq & 1) * 8) = pk_; } while (0)
        bf16_t* dbase = nullptr; int dpitch = 0, dc0 = 0, dsh = -1, dg = 0;
        if (cw < 768 && (cw < 640)) {
            const bool isq = cw < 512;
            const float* nwp = (isq ? p.q_norm_a : p.k_norm_a) + l * 64;
            dbase = isq ? (bf16_t*)(p.ws + WS_QA) : (bf16_t*)(p.ws + WS_KA);
            dpitch = isq ? 512 : 128; dc0 = isq ? cw : cw - 512;
            const float qs = isq ? 0.125f * LOG2E : 1.f;
#pragma unroll
            for (int mi = 0; mi < 8; ++mi) {
                const int row = m0 + wm * 128 + mi * 16 + idx;
                float ss = 0.f;
#pragma unroll
                for (int ni = 0; ni < 4; ++ni) { const f32x4 v = acc[mi][ni]; ss += v.x * v.x + v.y * v.y + v.z * v.z + v.w * v.w; }
                ss += __shfl_xor(ss, 16); ss += __shfl_xor(ss, 32);
                const float rstd = rsqrtf(ss * (1.f / 64.f) + EPS);
                f32x4 y[4];
#pragma unroll
                for (int ni = 0; ni < 4; ++ni) y[ni] = acc[mi][ni] * rstd * *(const f32x4*)(nwp + ni * 16 + lc);
                const int tt = row & (SEQ - 1), prow = tt >> 6, pcol = tt & 63;
#pragma unroll
                for (int hf = 0; hf < 2; ++hf) {
                    const int pos = hf ? pcol : prow;
                    const f32x4 cs = *(const f32x4*)(ropec + pos * 16 + lc), sn = *(const f32x4*)(ropes + pos * 16 + lc);
                    const f32x4 a = y[2 * hf], b = y[2 * hf + 1];
                    y[2 * hf] = a * cs - b * sn; y[2 * hf + 1] = b * cs + a * sn;
                }
#pragma unroll
                for (int ni = 0; ni < 4; ++ni) G1_STG(mi, ni, y[ni] * qs);
            }
        } else if (cw >= 1280 && cw < 2816) {
            const bool isq = cw < 2048;
            const float* nwp = (isq ? p.q_norm_b : p.k_norm_b) + l * 64;
            const int gc = isq ? cw - 1280 : cw - 2048;
            dg = gc >> 8; dc0 = gc & 255; dsh = 2 * dg; dpitch = 256;
            dbase = (bf16_t*)(p.ws + (isq ? WS_QB : WS_KB));
            const float qs = isq ? 0.125f * LOG2E : 1.f;
#pragma unroll
            for (int mi = 0; mi < 8; ++mi) {
                float ss = 0.f;
#pragma unroll
                for (int ni = 0; ni < 4; ++ni) { const f32x4 v = acc[mi][ni]; ss += v.x * v.x + v.y * v.y + v.z * v.z + v.w * v.w; }
                ss += __shfl_xor(ss, 16); ss += __shfl_xor(ss, 32);
                const float rstd = rsqrtf(ss * (1.f / 64.f) + EPS) * qs;
#pragma unroll
                for (int ni = 0; ni < 4; ++ni) G1_STG(mi, ni, acc[mi][ni] * rstd * *(const f32x4*)(nwp + ni * 16 + lc));
            }
        } else if (cw >= 2816 && cw < 3584) {
            const int gc = cw - 2816;
            dg = gc >> 8; dc0 = gc & 255; dsh = 2 * dg; dpitch = 256; dbase = (bf16_t*)(p.ws + WS_VB);
#pragma unroll
            for (int mi = 0; mi < 8; ++mi)
#pragma unroll
                for (int ni = 0; ni < 4; ++ni) G1_STG(mi, ni, acc[mi][ni]);
        } else if (cw >= 8448) {
            if (cw == 8448) {
                float* dst = (float*)(p.ws + WS_DT);
                const f32x4 bias = *(const f32x4*)(p.dt_bias + l * 16 + lc);
#pragma unroll
                for (int mi = 0; mi < 8; ++mi) {
                    const int row = m0 + wm * 128 + mi * 16 + idx;
                    f32x4 v = acc[mi][0] + bias, o;
                    o.x = v.x > 20.f ? v.x : log1pf(__expf(v.x)); o.y = v.y > 20.f ? v.y : log1pf(__expf(v.y));
                    o.z = v.z > 20.f ? v.z : log1pf(__expf(v.z)); o.w = v.w > 20.f ? v.w : log1pf(__expf(v.w));
                    *(f32x4*)(dst + (size_t)row * 16 + lc) = o;
                }
            }
        } else {
            int mode;
            if (cw < 768) { dbase = (bf16_t*)(p.ws + WS_VA); dpitch = 128; dc0 = cw - 640; mode = 0; }
            else if (cw < 1280) { dbase = (bf16_t*)(p.ws + WS_GA); dpitch = 512; dc0 = cw - 768; mode = 1; }
            else if (cw < 3840) { dbase = (bf16_t*)(p.ws + WS_GB); dpitch = 256; dc0 = cw - 3584; mode = 1; }
            else if (cw < 4864) { dbase = (bf16_t*)(p.ws + WS_XBC); dpitch = 1024; dc0 = cw - 3840; mode = 0; }
            else if (cw < 5376) { dbase = (bf16_t*)(p.ws + WS_ZS); dpitch = 512; dc0 = cw - 4864; mode = 1; }
            else { dbase = (bf16_t*)(p.ws + WS_MG); dpitch = 3072; dc0 = cw - 5376; mode = 2; }
            const float* bg = p.b_gate + l * 3072 + dc0 + lc;
#pragma unroll
            for (int mi = 0; mi < 8; ++mi) {
#pragma unroll
                for (int ni = 0; ni < 4; ++ni) {
                    f32x4 v = acc[mi][ni];
                    if (mode == 1) { v.x = siluf(v.x); v.y = siluf(v.y); v.z = siluf(v.z); v.w = siluf(v.w); }
                    else if (mode == 2) { const f32x4 bb = *(const f32x4*)(bg + ni * 16); v.x = sigmf(v.x + bb.x); v.y = sigmf(v.y + bb.y); v.z = sigmf(v.z + bb.z); v.w = sigmf(v.w + bb.w); }
                    G1_STG(mi, ni, v);
                }
            }
        }
#undef G1_STG
        if (dbase) {
            const int ch = lane & 7;
#pragma unroll
            for (int j = 0; j < 16; ++j) {
                const int rl = 8 * j + (lane >> 3), row = m0 + wm * 128 + rl;
                const u32x4 v = *(const u32x4*)(wl + rl * 128 + ((ch ^ (rl & 7)) * 16));
                size_t drow = (size_t)row;
                if (dsh >= 0) { const int bl = row >> 13, tt = row & (SEQ - 1); drow = (size_t)(bl * 3 + dg) * SEQ + (size_t)((tt & ((1 << dsh) - 1)) * (SEQ >> dsh) + (tt >> dsh)); }
                *(u32x4*)(dbase + drow * dpitch + dc0 + ch * 8) = v;
            }
        }
        __syncthreads();
    }
}

__device__ void merge_phase(const Params& p, int l, unsigned char* smem) {
    const bf16_t* MG = (const bf16_t*)(p.ws + WS_MG);
    const float* rstd = (const float*)(p.ws + WS_RSTD);
    bf16_t* MR = (bf16_t*)(p.ws + WS_MRG);
    for (int t = blockIdx.x; t < 64 * 4; t += gridDim.x) {
        const int xq = t >> 3, mt = (xq >> 2) * 8 + (t & 7), nt = xq & 3, m0 = mt * 256, n0 = nt * 256;
        u32x2 mpk[6][4];
#pragma unroll 1
        for (int br = 0; br < 3; ++br) {
            f32x4 acc[8][4];
            const bf16_t* A; const bf16_t* Bt; int K;
            if (br == 0) { A = (const bf16_t*)(p.ws + WS_QA); K = 512; Bt = (const bf16_t*)(p.ws + WS_WPA) + (size_t)l * 1024 * 512; }
            else if (br == 1) { A = (const bf16_t*)(p.ws + WS_YBM); K = 256; Bt = (const bf16_t*)(p.ws + WS_WPB) + (size_t)l * 1024 * 256; }
            else { A = (const bf16_t*)(p.ws + WS_YC); K = 512; Bt = (const bf16_t*)(p.ws + WS_WPC) + (size_t)l * 1024 * 512; }
            int tid = threadIdx.x;
            gemm_core<true>(A + (size_t)m0 * K, K, Bt + (size_t)n0 * K, K, K, acc, smem, tid);
            asm volatile("" : "+v"(tid));
            const int lane = tid & 63, w = tid >> 6, wm = w >> 2, wn = w & 3, idx = lane & 15, kq = lane >> 4;
#pragma unroll
            for (int mi = 0; mi < 8; ++mi) {
                const int row = m0 + wm * 128 + mi * 16 + idx;
                const float rs = (br == 2) ? rstd[row] : 1.f;
#pragma unroll
                for (int ni = 0; ni < 4; ++ni) {
                    const int col = n0 + wn * 64 + ni * 16 + 4 * kq;
                    const u32x2 g = *(const u32x2*)(MG + (size_t)row * 3072 + br * 1024 + col);
                    f32x4 gv; gv.x = bflo(g.x); gv.y = bfhi(g.x); gv.z = bflo(g.y); gv.w = bfhi(g.y);
                    f32x4 v = gv * rs * acc[mi][ni];
                    bf16_t* mp = MR + (size_t)row * 1024 + col;
                    if (mi < 6) {
                        if (br > 0) { const u32x2 o = mpk[mi < 6 ? mi : 0][ni]; v.x += bflo(o.x); v.y += bfhi(o.x); v.z += bflo(o.y); v.w += bfhi(o.y); }
                        u32x2 pk; pk.x = pk2(v.x, v.y); pk.y = pk2(v.z, v.w); mpk[mi < 6 ? mi : 0][ni] = pk;
                        if (br == 2) *(u32x2*)mp = pk;
                    } else {
                        if (br > 0) { const u32x2 o = *(const u32x2*)mp; v.x += bflo(o.x); v.y += bfhi(o.x); v.z += bflo(o.y); v.w += bfhi(o.y); }
                        st4bf(mp, v);
                    }
                }
            }
        }
    }
}

__device__ void out_phase(const Params& p, int l, int hb, const float* xsrc, unsigned char* smem) {
    const bf16_t* MR = (const bf16_t*)(p.ws + WS_MRG);
    const bf16_t* Wt = (const bf16_t*)(p.ws + WS_WOUT) + (size_t)l * 1024 * 1024;
    for (int t = blockIdx.x; t < 64 * 4; t += gridDim.x) {
        const int xq = t >> 3, mt = (xq >> 2) * 8 + (t & 7), nt = xq & 3, m0 = mt * 256, n0 = nt * 256;
        f32x4 acc[8][4];
        int tid = threadIdx.x;
        gemm_core(MR + (size_t)m0 * 1024, 1024, Wt + (size_t)n0 * 1024, 1024, 1024, acc, smem, tid);
        asm volatile("" : "+v"(tid));
        const int lane = tid & 63, w = tid >> 6, wm = w >> 2, wn = w & 3, idx = lane & 15, kq = lane >> 4;
#pragma unroll
        for (int mi = 0; mi < 8; ++mi) {
            const int row = m0 + wm * 128 + mi * 16 + idx; const size_t rg = (size_t)hb * TP + row; const int b = (int)(rg / SEQ);
            const float* gate = (const float*)(p.ws + WS_MOD) + (size_t)(l * 4 + b) * 3072 + 2048;
#pragma unroll
            for (int ni = 0; ni < 4; ++ni) {
                const int col = n0 + wn * 64 + ni * 16 + 4 * kq;
                const f32x4 xv = *(const f32x4*)(xsrc + rg * 1024 + col), gv = *(const f32x4*)(gate + col);
                *(f32x4*)(p.out + rg * 1024 + col) = xv + gv * acc[mi][ni];
            }
        }
    }
}

constexpr int AT_KS = 0, AT_VS = 9216, AT_LQ = 9216 + 8192, AT_LUT = AT_LQ + 512;

#define AT_STAGE_STORE() do { _Pragma("unroll") for (int i = 0; i < 2; ++i) { const int c = tid + 256 * i, row = c >> 3, ch = c & 7; \
        *(u32x4*)(Ks + row * 72 + ch * 8) = rk[i]; *(u32x4*)(Vs + (ch >> 2) * 4096 + row * 64 + (ch & 3) * 16) = rv[i]; } } while (0)

__device__ __forceinline__ void at_qk(f32x16& p0, f32x16& p1, const bf16_t* Ks, const bf16x8* qr, int r32, int hi) {
    bf16x8 kf[8];
#pragma unroll
    for (int ds = 0; ds < 4; ++ds) {
        kf[2 * ds] = *(const bf16x8*)(Ks + r32 * 72 + ds * 16 + hi * 8);
        kf[2 * ds + 1] = *(const bf16x8*)(Ks + (r32 + 32) * 72 + ds * 16 + hi * 8);
    }
    __builtin_amdgcn_sched_barrier(0);
    __builtin_amdgcn_s_setprio(1);
#pragma unroll
    for (int ds = 0; ds < 4; ++ds) {
        p0 = __builtin_amdgcn_mfma_f32_32x32x16_bf16(kf[2 * ds], qr[ds], p0, 0, 0, 0);
        p1 = __builtin_amdgcn_mfma_f32_32x32x16_bf16(kf[2 * ds + 1], qr[ds], p1, 0, 0, 0);
    }
    __builtin_amdgcn_s_setprio(0);
    __builtin_amdgcn_sched_barrier(0);
}
__device__ __forceinline__ void at_pv(f32x16& o0, f32x16& o1, const f32x16& p0, const f32x16& p1, const unsigned char* Vs, int lane) {
    const int hi = lane >> 5;
    const unsigned char* vb = Vs + ((lane >> 4) & 1) * 32 + (lane & 3) * 8 + (4 * hi + ((lane & 15) >> 2)) * 64;
    bf16x8 v0[4], v1[4], pa[4];
#pragma unroll
    for (int s = 0; s < 4; ++s) {
        v0[s] = cat8(tr16(vb + s * 1024), tr16(vb + s * 1024 + 512));
        v1[s] = cat8(tr16(vb + 4096 + s * 1024), tr16(vb + 4096 + s * 1024 + 512));
    }
#pragma unroll
    for (int s = 0; s < 4; ++s) {
        u32x4 pw;
        if (s < 2) { pw.x = pk2(p0[8 * s + 0], p0[8 * s + 1]); pw.y = pk2(p0[8 * s + 2], p0[8 * s + 3]); pw.z = pk2(p0[8 * s + 4], p0[8 * s + 5]); pw.w = pk2(p0[8 * s + 6], p0[8 * s + 7]); }
        else { const int q = s - 2; pw.x = pk2(p1[8 * q + 0], p1[8 * q + 1]); pw.y = pk2(p1[8 * q + 2], p1[8 * q + 3]); pw.z = pk2(p1[8 * q + 4], p1[8 * q + 5]); pw.w = pk2(p1[8 * q + 6], p1[8 * q + 7]); }
        pa[s] = __builtin_bit_cast(bf16x8, pw);
    }
    __builtin_amdgcn_sched_barrier(0);
    __builtin_amdgcn_s_setprio(1);
#pragma unroll
    for (int s = 0; s < 4; ++s) {
        o0 = __builtin_amdgcn_mfma_f32_32x32x16_bf16(pa[s], v0[s], o0, 0, 0, 0);
        o1 = __builtin_amdgcn_mfma_f32_32x32x16_bf16(pa[s], v1[s], o1, 0, 0, 0);
    }
    __builtin_amdgcn_s_setprio(0);
    __builtin_amdgcn_sched_barrier(0);
}

__device__ __forceinline__ void at_ldv(bf16x8 (&v0)[4], bf16x8 (&v1)[4], const unsigned char* Vs, int lane) {
    const int hi = lane >> 5;
    const unsigned char* vb = Vs + ((lane >> 4) & 1) * 32 + (lane & 3) * 8 + (4 * hi + ((lane & 15) >> 2)) * 64;
#pragma unroll
    for (int s = 0; s < 4; ++s) {
        v0[s] = cat8(tr16(vb + s * 1024), tr16(vb + s * 1024 + 512));
        v1[s] = cat8(tr16(vb + 4096 + s * 1024), tr16(vb + 4096 + s * 1024 + 512));
    }
}
__device__ __forceinline__ void at_pv2(f32x16& o0, f32x16& o1, const f32x16& p0, const f32x16& p1, const bf16x8 (&v0)[4], const bf16x8 (&v1)[4]) {
    bf16x8 pa[4];
#pragma unroll
    for (int s = 0; s < 4; ++s) {
        u32x4 pw;
        if (s < 2) { pw.x = pk2(p0[8 * s + 0], p0[8 * s + 1]); pw.y = pk2(p0[8 * s + 2], p0[8 * s + 3]); pw.z = pk2(p0[8 * s + 4], p0[8 * s + 5]); pw.w = pk2(p0[8 * s + 6], p0[8 * s + 7]); }
        else { const int q = s - 2; pw.x = pk2(p1[8 * q + 0], p1[8 * q + 1]); pw.y = pk2(p1[8 * q + 2], p1[8 * q + 3]); pw.z = pk2(p1[8 * q + 4], p1[8 * q + 5]); pw.w = pk2(p1[8 * q + 6], p1[8 * q + 7]); }
        pa[s] = __builtin_bit_cast(bf16x8, pw);
    }
    __builtin_amdgcn_sched_barrier(0);
    __builtin_amdgcn_s_setprio(1);
#pragma unroll
    for (int s = 0; s < 4; ++s) {
        o0 = __builtin_amdgcn_mfma_f32_32x32x16_bf16(pa[s], v0[s], o0, 0, 0, 0);
        o1 = __builtin_amdgcn_mfma_f32_32x32x16_bf16(pa[s], v1[s], o1, 0, 0, 0);
    }
    __builtin_amdgcn_s_setprio(0);
    __builtin_amdgcn_sched_barrier(0);
}

constexpr int ATA_STAGE = 17408, ATA_LQ = 2 * ATA_STAGE;
__device__ void attn_a_item(const Params& p, int item, int l, unsigned char* smem) {
    int tid_ = threadIdx.x; asm volatile("" : "+v"(tid_));
    const int tid = tid_, lane = tid & 63, w = tid >> 6, r32 = lane & 31, hi = lane >> 5;
    const int b = item >> 8, r = item & 255, kvh = r >> 7, qblk = (r >> 2) & 31, hq = kvh * 4 + (r & 3);
    float* lq = (float*)(smem + ATA_LQ) + w * 32;
    bf16_t* QA = (bf16_t*)(p.ws + WS_QA);
    const bf16_t* GA = (const bf16_t*)(p.ws + WS_GA);
    const size_t tokq = (size_t)b * SEQ + qblk * 256 + w * 32;
    bf16x8 qr[4];
#pragma unroll
    for (int ds = 0; ds < 4; ++ds) qr[ds] = *(const bf16x8*)(QA + (tokq + r32) * 512 + hq * 64 + ds * 16 + hi * 8);
    const bf16_t* Kb = (const bf16_t*)(p.ws + WS_KA) + (size_t)b * SEQ * 128 + kvh * 64;
    const bf16_t* Vb = (const bf16_t*)(p.ws + WS_VA) + (size_t)b * SEQ * 128 + kvh * 64;
    const float nshift = -((const float*)(p.ws + WS_BND))[l];
    f32x16 o0, o1;
#pragma unroll
    for (int i = 0; i < 16; ++i) { o0[i] = 0.f; o1[i] = 0.f; }
    f32x4 la4 = (f32x4){0.f, 0.f, 0.f, 0.f};
    constexpr int NT = SEQ / 64;
    const int row0 = tid >> 3, ch0 = tid & 7;
    const size_t goff0 = (size_t)row0 * 128 + ch0 * 8;
    const int ko0 = row0 * 144 + ch0 * 16;
    const int vo0 = 9216 + (ch0 >> 2) * 4096 + row0 * 64 + (ch0 & 3) * 16;
    u32x4 rkA[1], rvA[1], rkB[1], rvB[1];
#define ATA_LOAD(RK, RV, t) do { const size_t tb = (size_t)(t) * 64 * 128; RK[0] = *(const u32x4*)(Kb + tb + goff0); RV[0] = *(const u32x4*)(Vb + tb + goff0); } while (0)
#define ATA_STORE(RK, RV, st) do { unsigned char* sb_ = smem + (st) * ATA_STAGE; *(u32x4*)(sb_ + ko0) = RK[0]; *(u32x4*)(sb_ + vo0) = RV[0]; } while (0)
#define ATA_COMPUTE(st) do { const unsigned char* sb_ = smem + (st) * ATA_STAGE; f32x16 p0, p1; bf16x8 vf0[4], vf1[4]; \
        _Pragma("unroll") for (int i = 0; i < 16; ++i) { p0[i] = nshift; p1[i] = nshift; } \
        at_qk(p0, p1, (const bf16_t*)sb_, qr, r32, hi); \
        at_ldv(vf0, vf1, sb_ + 9216, lane); __builtin_amdgcn_sched_barrier(0); \
        _Pragma("unroll") for (int i = 0; i < 16; ++i) { p0[i] = __builtin_amdgcn_exp2f(p0[i]); p1[i] = __builtin_amdgcn_exp2f(p1[i]); } \
        _Pragma("unroll") for (int i = 0; i < 4; ++i) { la4 += (f32x4){p0[4 * i], p0[4 * i + 1], p0[4 * i + 2], p0[4 * i + 3]}; la4 += (f32x4){p1[4 * i], p1[4 * i + 1], p1[4 * i + 2], p1[4 * i + 3]}; } \
        at_pv2(o0, o1, p0, p1, vf0, vf1); } while (0)
    __syncthreads();
    ATA_LOAD(rkA, rvA, 0); ATA_LOAD(rkB, rvB, 1);
    ATA_STORE(rkA, rvA, 0);
    ATA_LOAD(rkA, rvA, 2);
    __syncthreads();
    for (int kt = 0; kt < NT; kt += 2) {
        ATA_COMPUTE(0);
        ATA_STORE(rkB, rvB, 1);
        if (kt + 3 < NT) ATA_LOAD(rkB, rvB, kt + 3);
        __syncthreads();
        ATA_COMPUTE(1);
        if (kt + 2 < NT) { ATA_STORE(rkA, rvA, 0); if (kt + 4 < NT) ATA_LOAD(rkA, rvA, kt + 4); }
        __syncthreads();
    }
#undef ATA_LOAD
#undef ATA_STORE
#undef ATA_COMPUTE
    float lacc = (la4.x + la4.y) + (la4.z + la4.w);
    lacc += __shfl_xor(lacc, 32);
    if (hi == 0) lq[r32] = lacc;
    asm volatile("s_waitcnt lgkmcnt(0)" ::: "memory");
#pragma unroll
    for (int rr = 0; rr < 16; ++rr) {
        const int q = crow(rr, hi); const float inv = 1.f / lq[q];
        const size_t off = (tokq + q) * 512 + hq * 64 + r32;
        const float g0 = bf2f(GA[off]), g1 = bf2f(GA[off + 32]);
        QA[off] = (bf16_t)(pk2(o0[rr] * inv * g0, 0.f) & 0xffffu);
        QA[off + 32] = (bf16_t)(pk2(o1[rr] * inv * g1, 0.f) & 0xffffu);
    }
}

constexpr int ATB_LQ = 17408, ATB_LUT = 17408 + 1024;
__device__ void attn_b_item(const Params& p, int item, int l, unsigned char* smem) {
    int tid_ = threadIdx.x; asm volatile("" : "+v"(tid_));
    const int tid = tid_, lane = tid & 63, w = __builtin_amdgcn_readfirstlane(tid >> 6), r32 = lane & 31, hi = lane >> 5;
    const int blk = item & 31, j = (item >> 5) & 3, bg = item >> 7, g = bg % 3;
    const int sh = 2 * g, dil = 1 << sh, Mlen = SEQ >> sh;
    bf16_t* Ks = (bf16_t*)(smem + AT_KS); unsigned char* Vs = smem + AT_VS; float* lq = (float*)(smem + ATB_LQ) + w * 32; float* lut = (float*)(smem + ATB_LUT);
    bf16_t* QB = (bf16_t*)(p.ws + WS_QB) + (size_t)bg * SEQ * 256 + j * 64;
    const bf16_t* KB = (const bf16_t*)(p.ws + WS_KB) + (size_t)bg * SEQ * 256 + j * 64;
    const bf16_t* VB = (const bf16_t*)(p.ws + WS_VB) + (size_t)bg * SEQ * 256 + j * 64;
    float* LSE = (float*)(p.ws + WS_LSE) + (size_t)bg * SEQ * 4 + j;
    const int p0r = blk * 256, seq_lo = (p0r / Mlen) * Mlen, seq_hi = seq_lo + Mlen;
    __syncthreads();
    if (tid < 129) {
        const int rel = tid - 64, n = (rel < 0 ? -rel : rel) * dil;
        int bk;
        if (n < 8) bk = n; else { bk = 8 + (n >= 15) + (n >= 27) + (n >= 50) + (n >= 91) + (n >= 166) + (n >= 305) + (n >= 559); }
        if (rel > 0) bk += 16;
        lut[tid] = p.rel_bias[bk * 12 + g * 4 + j] * LOG2E;
    }
    const int qpos = p0r + w * 32 + r32;
    bf16x8 qr[4];
#pragma unroll
    for (int ds = 0; ds < 4; ++ds) qr[ds] = *(const bf16x8*)(QB + (size_t)qpos * 256 + ds * 16 + hi * 8);
    const float nshift = -((const float*)(p.ws + WS_BND))[2 + l];
    f32x16 o0, o1;
#pragma unroll
    for (int i = 0; i < 16; ++i) { o0[i] = 0.f; o1[i] = 0.f; }
    f32x4 la4 = (f32x4){0.f, 0.f, 0.f, 0.f};
    const int srow = tid >> 3, sch = tid & 7;
    for (int kt = 0; kt < 6; ++kt) {
        const int kbase = p0r - 64 + 64 * kt;
        int pr = kbase + srow; pr = pr < 0 ? 0 : (pr > SEQ - 1 ? SEQ - 1 : pr);
        const u32x4 rk = *(const u32x4*)(KB + (size_t)pr * 256 + sch * 8), rv = *(const u32x4*)(VB + (size_t)pr * 256 + sch * 8);
        __syncthreads();
        *(u32x4*)(Ks + srow * 72 + sch * 8) = rk; *(u32x4*)(Vs + (sch >> 2) * 4096 + srow * 64 + (sch & 3) * 16) = rv;
        __syncthreads();
        if (kt < (w >> 1) || kt > (w >> 1) + 2) continue;
        f32x16 p0, p1;
#pragma unroll
        for (int i = 0; i < 16; ++i) { p0[i] = nshift; p1[i] = nshift; }
        at_qk(p0, p1, Ks, qr, r32, hi);
#pragma unroll
        for (int i = 0; i < 16; ++i) {
            const int kv0 = kbase + crow(i, hi), kv1 = kv0 + 32;
            const int rel0 = kv0 - qpos, rel1 = kv1 - qpos;
            const bool ok0 = rel0 >= -64 && rel0 <= 64 && kv0 >= seq_lo && kv0 < seq_hi;
            const bool ok1 = rel1 >= -64 && rel1 <= 64 && kv1 >= seq_lo && kv1 < seq_hi;
            const float e0 = __builtin_amdgcn_exp2f(p0[i] + lut[ok0 ? rel0 + 64 : 64]);
            const float e1 = __builtin_amdgcn_exp2f(p1[i] + lut[ok1 ? rel1 + 64 : 64]);
            p0[i] = ok0 ? e0 : 0.f; p1[i] = ok1 ? e1 : 0.f;
        }
#pragma unroll
        for (int i = 0; i < 4; ++i) { la4 += (f32x4){p0[4 * i], p0[4 * i + 1], p0[4 * i + 2], p0[4 * i + 3]}; la4 += (f32x4){p1[4 * i], p1[4 * i + 1], p1[4 * i + 2], p1[4 * i + 3]}; }
        at_pv(o0, o1, p0, p1, Vs, lane);
    }
    float lacc = (la4.x + la4.y) + (la4.z + la4.w);
    lacc += __shfl_xor(lacc, 32);
    if (hi == 0) { lq[r32] = lacc; LSE[(size_t)qpos * 4] = (-nshift + log2f(lacc)) * LN2; }
    asm volatile("s_waitcnt lgkmcnt(0)" ::: "memory");
#pragma unroll
    for (int rr = 0; rr < 16; ++rr) {
        const int q = crow(rr, hi); const float inv = 1.f / lq[q];
        const size_t off = (size_t)(p0r + w * 32 + q) * 256 + r32;
        QB[off] = (bf16_t)(pk2(o0[rr] * inv, 0.f) & 0xffffu);
        QB[off + 32] = (bf16_t)(pk2(o1[rr] * inv, 0.f) & 0xffffu);
    }
}

__device__ void conv_phase(const Params& p, int l) {
    int tx_ = threadIdx.x; asm volatile("" : "+v"(tx_));
    const bf16_t* XBC = (const bf16_t*)(p.ws + WS_XBC);
    bf16_t* XC = (bf16_t*)(p.ws + WS_XBCC);
    const float* cw = p.conv_w + (size_t)l * 5 * 1024; const float* cb = p.conv_b + l * 1024;
    const int nthr = gridDim.x * 512;
    for (int u = blockIdx.x * 512 + tx_; u < (TP / 4) * 128; u += nthr) {
        const int ch = (u & 127) * 8, tg = u >> 7, tok0 = tg * 4, tt0 = tok0 & (SEQ - 1);
        u32x4 raw[8];
#pragma unroll
        for (int r = 0; r < 8; ++r) { const int tt = tt0 - 2 + r; raw[r] = (u32x4){0u, 0u, 0u, 0u};
            if (tt >= 0 && tt < SEQ) raw[r] = *(const u32x4*)(XBC + (size_t)(tok0 - 2 + r) * 1024 + ch); }
        float ac[4][8];
        { const f32x4 a = *(const f32x4*)(cb + ch), b2 = *(const f32x4*)(cb + ch + 4);
#pragma unroll
          for (int t = 0; t < 4; ++t) { ac[t][0] = a.x; ac[t][1] = a.y; ac[t][2] = a.z; ac[t][3] = a.w; ac[t][4] = b2.x; ac[t][5] = b2.y; ac[t][6] = b2.z; ac[t][7] = b2.w; } }
#pragma unroll
        for (int k = 0; k < 5; ++k) { const f32x4 wa = *(const f32x4*)(cw + k * 1024 + ch), wb = *(const f32x4*)(cw + k * 1024 + ch + 4);
#pragma unroll
            for (int t = 0; t < 4; ++t) { const u32x4 v = raw[t + k];
                ac[t][0] += bflo(v.x) * wa.x; ac[t][1] += bfhi(v.x) * wa.y; ac[t][2] += bflo(v.y) * wa.z; ac[t][3] += bfhi(v.y) * wa.w;
                ac[t][4] += bflo(v.z) * wb.x; ac[t][5] += bfhi(v.z) * wb.y; ac[t][6] += bflo(v.w) * wb.z; ac[t][7] += bfhi(v.w) * wb.w; } }
#pragma unroll
        for (int t = 0; t < 4; ++t) { u32x4 o;
            o.x = pk2(siluf(ac[t][0]), siluf(ac[t][1])); o.y = pk2(siluf(ac[t][2]), siluf(ac[t][3])); o.z = pk2(siluf(ac[t][4]), siluf(ac[t][5])); o.w = pk2(siluf(ac[t][6]), siluf(ac[t][7]));
            *(u32x4*)(XC + (size_t)(tok0 + t) * 1024 + ch) = o; }
    }
}

constexpr int SS_BS = 0, SS_CS = 8704, SS_XS = 17408, SS_XWS = 22016, SS_GS = 26624, SS_SB = 29184, SS_CW = 46592, SS_SC = 54272, SS_DTA = 55296, SS_END = 57344;

template <int PASS>
__device__ void ssd_item(const Params& p, int item, int l, unsigned char* smem) {
    int tid_ = VTID; asm volatile("" : "+v"(tid_));
    const int tid = tid_, lane = tid & 63, w = tid >> 6, idx = lane & 15, kq = lane >> 4;
    const int seg = item & 15, h = (item >> 4) & 7, dir = (item >> 7) & 1, b = item >> 8, grp = h >> 2;
    bf16_t* Bs = (bf16_t*)(smem + SS_BS); bf16_t* Cs = (bf16_t*)(smem + SS_CS); bf16_t* Xs = (bf16_t*)(smem + SS_XS); bf16_t* Xws = (bf16_t*)(smem + SS_XWS);
    bf16_t* Gs = (bf16_t*)(smem + SS_GS); bf16_t* Sb = (bf16_t*)(smem + SS_SB); float* sc = (float*)(smem + SS_SC);
    float* s_cA = (float*)(smem + SS_CW), *s_rsA = s_cA + SEGLEN, *s_wlA = s_rsA + SEGLEN, *s_totA = sc;
    const bf16_t* XBC = (const bf16_t*)(p.ws + WS_XBC);
    const float* DT = (const float*)(p.ws + WS_DT);
    float* ST = (float*)(p.ws + WS_ST); float* SEGT = (float*)(p.ws + WS_SEGT);
    bf16_t* Y = (bf16_t*)(p.ws + (dir ? WS_YS : WS_YF));
    const float Aneg = -__expf(p.a_log[l * 16 + dir * 8 + h]);
    const float Dh = p.d_skip[l * 8 + h];
    __syncthreads();
    f32x4 S[8];
#pragma unroll
    for (int nt = 0; nt < 8; ++nt) S[nt] = (f32x4){0.f, 0.f, 0.f, 0.f};
    const int ibase = item & ~15;
    if (PASS == 3) {
        if (dir == 0) {
            for (int e = 0; e < seg; ++e) { const float dc = __expf(SEGT[ibase + e]); const f32x4* src = (const f32x4*)(ST + (size_t)(ibase + e) * 8192);
#pragma unroll
                for (int nt = 0; nt < 8; ++nt) S[nt] = S[nt] * dc + src[(w * 8 + nt) * 64 + lane]; }
        } else {
            for (int e = NSEG - 1; e > seg; --e) { const float dc = __expf(SEGT[ibase + e]); const f32x4* src = (const f32x4*)(ST + (size_t)(ibase + e) * 8192);
#pragma unroll
                for (int nt = 0; nt < 8; ++nt) S[nt] = S[nt] * dc + src[(w * 8 + nt) * 64 + lane]; }
        }
#pragma unroll
        for (int nt = 0; nt < 8; ++nt) st4bf(Sb + (16 * w + idx) * 136 + 16 * nt + 4 * kq, S[nt]);
    }
    float* s_dta = (float*)(smem + SS_DTA);
#pragma unroll
    for (int i = 0; i < SEGLEN / 256; ++i) {
        const int e = tid + 256 * i, l32 = lane & 31;
        const float dtv = DT[((size_t)b * SEQ + seg * SEGLEN + e) * 16 + dir * 8 + h], av = dtv * Aneg;
        float pre = av;
#pragma unroll
        for (int o = 1; o < 32; o <<= 1) { const float t = __shfl_up(pre, o, 32); if (l32 >= o) pre += t; }
        const float tot = __shfl(pre, 31, 32);
        const float cc = dir ? (tot - pre + av) : pre;
        s_dta[e] = dtv; s_cA[e] = cc; s_rsA[e] = __expf(cc); s_wlA[e] = dtv * __expf(tot - cc);
        if (l32 == 0) s_totA[e >> 5] = tot;
    }
    float segtot = 0.f;
    const size_t tokb = (size_t)b * SEQ;
    const unsigned char* xb_ = (const unsigned char*)((const bf16_t*)(p.ws + WS_XBCC) + tokb * 1024);
    unsigned soff[5];
#pragma unroll
    for (int i = 0; i < 5; ++i) { const int u = tid + 256 * i, lrow = u / 40, ci = u % 40;
        const int scol = ci < 8 ? h * 64 + ci * 8 : (ci < 24 ? 512 + grp * 128 + (ci * 8 - 64) : 768 + grp * 128 + (ci * 8 - 192));
        soff[i] = (unsigned)((lrow * 1024 + scol) * 2); }
    for (int si = 0; si < NSUB; ++si) {
        const int scn = dir ? (NSUB - 1 - si) : si;
        const int t0 = seg * SEGLEN + scn * TSUB;
        __syncthreads();
        u32x4 raw[5];
#pragma unroll
        for (int i = 0; i < 5; ++i) raw[i] = *(const u32x4*)(xb_ + ((unsigned)(t0 * 2048) + soff[i]));
        const float* s_dt = s_dta + scn * TSUB; const float* s_c = s_cA + scn * TSUB; const float* s_rs = s_rsA + scn * TSUB; const float* s_wl = s_wlA + scn * TSUB;
        const float stot = s_totA[scn];
        segtot += stot;
#pragma unroll
        for (int i = 0; i < 5; ++i) { const int u = tid + 256 * i, lrow = u / 40, ci = u % 40, lc = ci * 8; const u32x4 o = raw[i];
            if (ci < 8) { *(u32x4*)(Xs + lrow * 72 + lc) = o; const float wl = s_wl[lrow];
                u32x4 o2; o2.x = pk2(bflo(o.x) * wl, bfhi(o.x) * wl); o2.y = pk2(bflo(o.y) * wl, bfhi(o.y) * wl); o2.z = pk2(bflo(o.z) * wl, bfhi(o.z) * wl); o2.w = pk2(bflo(o.w) * wl, bfhi(o.w) * wl);
                *(u32x4*)(Xws + lrow * 72 + lc) = o2; }
            else if (ci < 24) *(u32x4*)(Bs + lrow * 136 + (lc - 64)) = o;
            else *(u32x4*)(Cs + lrow * 136 + (lc - 192)) = o; }
        __syncthreads();
        if (PASS == 3) {
            const int it = w >> 1, jt = w & 1;
            f32x4 cb = (f32x4){0.f, 0.f, 0.f, 0.f};
            {
                bf16x8 fb[4], fc[4];
#pragma unroll
                for (int ks = 0; ks < 4; ++ks) { fb[ks] = *(const bf16x8*)(Bs + (16 * jt + idx) * 136 + ks * 32 + kq * 8); fc[ks] = *(const bf16x8*)(Cs + (16 * it + idx) * 136 + ks * 32 + kq * 8); }
                __builtin_amdgcn_sched_barrier(0);
#pragma unroll
                for (int ks = 0; ks < 4; ++ks) cb = __builtin_amdgcn_mfma_f32_16x16x32_bf16(fb[ks], fc[ks], cb, 0, 0, 0);
                __builtin_amdgcn_sched_barrier(0);
            }
            {
                const int ii = 16 * it + idx; const float ci_ = s_c[ii];
                f32x4 gv;
#pragma unroll
                for (int rg = 0; rg < 4; ++rg) {
                    const int jj = 16 * jt + 4 * kq + rg;
                    const bool ok = dir ? (jj >= ii) : (jj <= ii);
                    const float e = __expf(ci_ - s_c[jj]) * s_dt[jj];
                    gv[rg] = ok ? cb[rg] * e : 0.f;
                }
                st4bf(Gs + ii * 40 + 16 * jt + 4 * kq, gv);
            }
            __syncthreads();
            const unsigned char* xtr = (const unsigned char*)Xs + (8 * kq + (idx >> 2)) * 144 + (16 * w + 4 * (idx & 3)) * 2;
            const bf16x8 xf = cat8(tr16(xtr), tr16(xtr + 4 * 144));
#pragma unroll 1
            for (int it2 = 0; it2 < 2; ++it2) {
                const int ii = 16 * it2 + idx;
                const bf16x8 gf = *(const bf16x8*)(Gs + ii * 40 + 8 * kq);
                f32x4 yd = (f32x4){0.f, 0.f, 0.f, 0.f}, yo = (f32x4){0.f, 0.f, 0.f, 0.f};
                bf16x8 sf[4], cf[4];
#pragma unroll
                for (int ks = 0; ks < 4; ++ks) { sf[ks] = *(const bf16x8*)(Sb + (16 * w + idx) * 136 + ks * 32 + kq * 8); cf[ks] = *(const bf16x8*)(Cs + ii * 136 + ks * 32 + kq * 8); }
                __builtin_amdgcn_sched_barrier(0);
                yd = __builtin_amdgcn_mfma_f32_16x16x32_bf16(xf, gf, yd, 0, 0, 0);
#pragma unroll
                for (int ks = 0; ks < 4; ++ks) yo = __builtin_amdgcn_mfma_f32_16x16x32_bf16(sf[ks], cf[ks], yo, 0, 0, 0);
                __builtin_amdgcn_sched_barrier(0);
                f32x4 y = yd + yo * s_rs[ii];
                if (dir == 0) { const u32x2 xv = *(const u32x2*)(Xs + ii * 72 + 16 * w + 4 * kq);
                    y.x += Dh * bflo(xv.x); y.y += Dh * bfhi(xv.x); y.z += Dh * bflo(xv.y); y.w += Dh * bfhi(xv.y); }
                st4bf(Y + (tokb + t0 + ii) * 512 + h * 64 + 16 * w + 4 * kq, y);
            }
        }
        {
            const float dc = __expf(stot);
            const unsigned char* xw = (const unsigned char*)Xws + (8 * kq + (idx >> 2)) * 144 + (16 * w + 4 * (idx & 3)) * 2;
            const bf16x8 xwf = cat8(tr16(xw), tr16(xw + 4 * 144));
            bf16x8 bfv[8];
#pragma unroll
            for (int nt = 0; nt < 8; ++nt) {
                const unsigned char* bt = (const unsigned char*)Bs + (8 * kq + (idx >> 2)) * 272 + (16 * nt + 4 * (idx & 3)) * 2;
                bfv[nt] = cat8(tr16(bt), tr16(bt + 4 * 272));
            }
            __builtin_amdgcn_sched_barrier(0);
#pragma unroll
            for (int nt = 0; nt < 8; ++nt) S[nt] = __builtin_amdgcn_mfma_f32_16x16x32_bf16(bfv[nt], xwf, S[nt] * dc, 0, 0, 0);
            __builtin_amdgcn_sched_barrier(0);
            if (PASS == 3) {
#pragma unroll
                for (int nt = 0; nt < 8; ++nt) st4bf(Sb + (16 * w + idx) * 136 + 16 * nt + 4 * kq, S[nt]);
            }
        }
    }
    if (PASS == 1) {
        f32x4* dst = (f32x4*)(ST + (size_t)item * 8192);
#pragma unroll
        for (int nt = 0; nt < 8; ++nt) dst[(w * 8 + nt) * 64 + lane] = S[nt];
        if (tid == 0) SEGT[item] = segtot;
    }
}

__device__ void post2_phase(const Params& p) {
    int tx_ = threadIdx.x; asm volatile("" : "+v"(tx_));
    const int lane = tx_ & 63, gw = blockIdx.x * 8 + (tx_ >> 6), nw = gridDim.x * 8;
    const bf16_t* OB = (const bf16_t*)(p.ws + WS_QB); const float* LSE = (const float*)(p.ws + WS_LSE);
    const bf16_t* GB = (const bf16_t*)(p.ws + WS_GB);
    bf16_t* YBM = (bf16_t*)(p.ws + WS_YBM);
    const bf16_t* YF = (const bf16_t*)(p.ws + WS_YF); const bf16_t* YS = (const bf16_t*)(p.ws + WS_YS); const bf16_t* ZS = (const bf16_t*)(p.ws + WS_ZS);
    bf16_t* YC = (bf16_t*)(p.ws + WS_YC); float* RS = (float*)(p.ws + WS_RSTD);
    constexpr int R = 4;
    for (int row0 = gw; row0 < TP; row0 += R * nw) {
        float ls[R][3]; u32x2 ov[R][3], gt[R]; u32x4 a[R], bq[R], z[R];
        const int j = lane >> 4;
#pragma unroll
        for (int q = 0; q < R; ++q) { const int row = row0 + q * nw; if (row < TP) {
            const int bl = row >> 13, tt = row & (SEQ - 1);
#pragma unroll
            for (int g = 0; g < 3; ++g) { const int sh = 2 * g; const int pp = (tt & ((1 << sh) - 1)) * (SEQ >> sh) + (tt >> sh);
                const size_t ro = (size_t)(bl * 3 + g) * SEQ + pp; ls[q][g] = LSE[ro * 4 + j]; ov[q][g] = *(const u32x2*)(OB + ro * 256 + 4 * lane); }
            gt[q] = *(const u32x2*)(GB + (size_t)row * 256 + 4 * lane);
            a[q] = *(const u32x4*)(YF + (size_t)row * 512 + 8 * lane); bq[q] = *(const u32x4*)(YS + (size_t)row * 512 + 8 * lane); z[q] = *(const u32x4*)(ZS + (size_t)row * 512 + 8 * lane); } }
#pragma unroll
        for (int q = 0; q < R; ++q) { const int row = row0 + q * nw; if (row < TP) {
            const float mx = fmaxf(ls[q][0], fmaxf(ls[q][1], ls[q][2]));
            float wg[3]; float ws = 0.f;
#pragma unroll
            for (int g = 0; g < 3; ++g) { wg[g] = __expf(ls[q][g] - mx); ws += wg[g]; }
            const float inv = 1.f / ws;
            f32x4 acc = (f32x4){0.f, 0.f, 0.f, 0.f};
#pragma unroll
            for (int g = 0; g < 3; ++g) { const u32x2 v = ov[q][g]; const float wv = wg[g] * inv;
                acc.x += wv * bflo(v.x); acc.y += wv * bfhi(v.x); acc.z += wv * bflo(v.y); acc.w += wv * bfhi(v.y); }
            acc.x *= bflo(gt[q].x); acc.y *= bfhi(gt[q].x); acc.z *= bflo(gt[q].y); acc.w *= bfhi(gt[q].y);
            st4bf(YBM + (size_t)row * 256 + 4 * lane, acc);
            float y[8];
            y[0] = (bflo(a[q].x) + bflo(bq[q].x)) * bflo(z[q].x); y[1] = (bfhi(a[q].x) + bfhi(bq[q].x)) * bfhi(z[q].x);
            y[2] = (bflo(a[q].y) + bflo(bq[q].y)) * bflo(z[q].y); y[3] = (bfhi(a[q].y) + bfhi(bq[q].y)) * bfhi(z[q].y);
            y[4] = (bflo(a[q].z) + bflo(bq[q].z)) * bflo(z[q].z); y[5] = (bfhi(a[q].z) + bfhi(bq[q].z)) * bfhi(z[q].z);
            y[6] = (bflo(a[q].w) + bflo(bq[q].w)) * bflo(z[q].w); y[7] = (bfhi(a[q].w) + bfhi(bq[q].w)) * bfhi(z[q].w);
            float ss = 0.f;
#pragma unroll
            for (int e = 0; e < 8; ++e) ss += y[e] * y[e];
            ss = wave_sum(ss);
            u32x4 o; o.x = pk2(y[0], y[1]); o.y = pk2(y[2], y[3]); o.z = pk2(y[4], y[5]); o.w = pk2(y[6], y[7]);
            *(u32x4*)(YC + (size_t)row * 512 + 8 * lane) = o;
            if (lane == 0) RS[row] = rsqrtf(ss * (1.f / 512.f) + EPS);
        } }
    }
}


#define XB_TMO      128
#define XB_XCNT(j)  (256  + 64 * (j))
#define XB_XSUB(j)  (1280 + 64 * (j))
#define XB_XGEN(j)  (2304 + 64 * (j))
#define XB_TOP      3328
#define XB_TOPGEN   3392
#define XCD_BAR_WORDS 3456
#define XB_SPIN_CAP (1u << 20)
__device__ __forceinline__ unsigned xb_ld(unsigned* p)              { return __hip_atomic_load(p, __ATOMIC_RELAXED, __HIP_MEMORY_SCOPE_AGENT); }
__device__ __forceinline__ unsigned xb_add(unsigned* p, unsigned v) { return __hip_atomic_fetch_add(p, v, __ATOMIC_RELAXED, __HIP_MEMORY_SCOPE_AGENT); }
__device__ __forceinline__ unsigned xb_xcc_id() { return (unsigned)__builtin_amdgcn_s_getreg((3 << 11) | 20) & 0xFu; }
#define XB_SPIN(cond, bar) do { unsigned _sp = 0; while (cond) { __builtin_amdgcn_s_sleep(1); \
    if ((++_sp & 255u) == 0u) { if (xb_ld(&(bar)[XB_TMO])) break; if (_sp > XB_SPIN_CAP) { atomicAdd(&(bar)[XB_TMO], 1u); break; } } } } while (0)
struct XcdBarrier { unsigned* bar; unsigned x; volatile LDSAS unsigned* st; };
__device__ __forceinline__ XcdBarrier xcd_barrier_post(unsigned* bar, volatile LDSAS unsigned* st) {
    XcdBarrier b; b.bar = bar; b.x = xb_xcc_id(); b.st = st;
    if (threadIdx.x == 0) (void)xb_add(&bar[XB_XCNT(b.x)], 1u);
    return b;
}
__device__ __forceinline__ void xcd_barrier_complete(unsigned* bar, unsigned x, unsigned& nloc, unsigned& nx) {
    const unsigned G = gridDim.x * gridDim.y * gridDim.z;
    unsigned sum, cnt, mine, sp = 0u;
    for (;;) {
        sum = 0u; cnt = 0u; mine = 0u;
#pragma unroll
        for (unsigned j = 0; j < 16; ++j) { const unsigned c = xb_ld(&bar[XB_XCNT(j)]); sum += c; cnt += (c > 0u) ? 1u : 0u; mine = (j == x) ? c : mine; }
        if (sum == G) break;
        __builtin_amdgcn_s_sleep(1);
        if ((++sp & 255u) == 0u) { if (xb_ld(&bar[XB_TMO])) break; if (sp > XB_SPIN_CAP) { atomicAdd(&bar[XB_TMO], 1u); break; } }
    }
    nloc = mine > 0u ? mine : 1u; nx = cnt > 0u ? cnt : 1u;
}
__device__ __forceinline__ void xcd_barrier(const XcdBarrier& b) {
    asm volatile("s_waitcnt vmcnt(0)" ::: "memory");
    __syncthreads();
    if (threadIdx.x == 0) {
        unsigned* bar = b.bar;
        __builtin_amdgcn_s_waitcnt(0);
        unsigned nloc = b.st[0], nx = b.st[1];
        if (nloc == 0u) { xcd_barrier_complete(bar, b.x, nloc, nx); b.st[0] = nloc; b.st[1] = nx; }
        const unsigned old = xb_add(&bar[XB_XSUB(b.x)], 1u);
        const unsigned gen = old / nloc;
        if (old + 1u == (gen + 1u) * nloc) {
            __builtin_amdgcn_fence(__ATOMIC_RELEASE, "agent");
            asm volatile("s_waitcnt vmcnt(0)" ::: "memory");
            const unsigned og = xb_add(&bar[XB_TOP], 1u);
            const unsigned tg = og / nx;
            if (og + 1u == (tg + 1u) * nx) xb_add(&bar[XB_TOPGEN], 1u);
            else XB_SPIN(xb_ld(&bar[XB_TOPGEN]) == tg, bar);
            __builtin_amdgcn_fence(__ATOMIC_ACQUIRE, "agent");
            xb_add(&bar[XB_XGEN(b.x)], 1u);
            asm volatile("s_waitcnt vmcnt(0)" ::: "memory");
        } else {
            XB_SPIN(xb_ld(&bar[XB_XGEN(b.x)]) == gen, bar);
            __builtin_amdgcn_fence(__ATOMIC_ACQUIRE, "agent");
            asm volatile("s_waitcnt vmcnt(0)" ::: "memory");
        }
    }
    __syncthreads();
}

__device__ __forceinline__ unsigned char* lds_half(unsigned char* smem) { int h_ = threadIdx.x >> 8; asm volatile("" : "+v"(h_)); return smem + h_ * HALF_LDS; }
__global__ void __launch_bounds__(512, 2) hybrid_fwd(Params p) {
    cg::grid_group grid = cg::this_grid();
    extern __shared__ __attribute__((aligned(16))) unsigned char smem[];
    volatile LDSAS unsigned* bst = (volatile LDSAS unsigned*)(smem + LDS_TOTAL - 16);
    if (threadIdx.x < 4) bst[threadIdx.x] = 0u;
    __syncthreads();
    const XcdBarrier xbar = xcd_barrier_post((unsigned*)(p.ws + WS_BAR), bst);
    { const Params q = launder(p); phase0(q, lds_half(smem)); }
    grid.sync();
#pragma unroll 1
    for (int l = 0; l < DEPTH; ++l) {
#pragma unroll 1
        for (int hb = 0; hb < 2; ++hb) {
            { const Params q = launder(p); norm_phase(q, l, hb, (l == 0) ? q.x : q.out); }
            xcd_barrier(xbar);
            { const Params q = launder(p); gemm1_phase(q, l, hb, smem); }
            xcd_barrier(xbar);
            { const Params q = launder(p); conv_phase(q, l); }
            xcd_barrier(xbar);
            { const Params q = launder(p); unsigned char* smh = lds_half(smem);
#pragma unroll 1
              for (int it = VBLK; it < 512; it += VGRID) ssd_item<1>(q, it, l, smh);
#pragma unroll 1
              for (int it = blockIdx.x; it < 768; it += gridDim.x) attn_b_item(q, it, l, smem); }
            xcd_barrier(xbar);
            { const Params q = launder(p);
#pragma unroll 1
              for (int it = blockIdx.x; it < 512; it += gridDim.x) attn_a_item(q, it, l, smem);
              unsigned char* smh = lds_half(smem);
#pragma unroll 1
              for (int it = VBLK; it < 512; it += VGRID) ssd_item<3>(q, it, l, smh); }
            xcd_barrier(xbar);
            { const Params q = launder(p); post2_phase(q); }
            xcd_barrier(xbar);
            { const Params q = launder(p); merge_phase(q, l, smem); }
            xcd_barrier(xbar);
            { const Params q = launder(p); out_phase(q, l, hb, (l == 0) ? q.x : q.out, smem); }
        }
    }
}

extern "C" void kernel_launch(void* const* d_in, const int* in_sizes, int n_in, void* d_out, int out_size, void* d_ws, size_t ws_size, hipStream_t stream) {
    static int grid_blocks = 0;
    if (!grid_blocks) {
        int dev = 0, cus = 0, per_cu = 0;
        hipGetDevice(&dev);
        hipDeviceGetAttribute(&cus, hipDeviceAttributeMultiprocessorCount, dev);
        hipFuncSetAttribute((const void*)hybrid_fwd, hipFuncAttributeMaxDynamicSharedMemorySize, LDS_TOTAL);
        hipOccupancyMaxActiveBlocksPerMultiprocessor(&per_cu, hybrid_fwd, 512, LDS_TOTAL);
        if (per_cu > 1) per_cu = 1;
        if (per_cu < 1) per_cu = 1;
        grid_blocks = cus * per_cu;
    }
    Params p{};
    const float** pp = (const float**)&p;
    for (int i = 0; i < 22; ++i) pp[i] = (const float*)d_in[i];
    p.out = (float*)d_out; p.ws = (unsigned char*)d_ws;
    hipMemsetAsync((unsigned char*)d_ws + WS_BAR, 0, XCD_BAR_WORDS * 4, stream);
    void* args[] = {&p};
    hipError_t e = hipLaunchCooperativeKernel((void*)hybrid_fwd, dim3(grid_blocks), dim3(512), args, LDS_TOTAL, stream);
    if (e != hipSuccess) fprintf(stderr, "cooperative launch failed: %s (grid %d)\n", hipGetErrorString(e), grid_blocks);
}
```

```cpp
#include <hip/hip_runtime.h>
#include <hip/hip_cooperative_groups.h>
#include <cstdint>
#include <cstdio>
namespace cg = cooperative_groups;

typedef unsigned short bf16_t;
typedef short bf16x8 __attribute__((ext_vector_type(8)));
typedef short v4i16 __attribute__((ext_vector_type(4)));
typedef float f32x2 __attribute__((ext_vector_type(2)));
typedef float f32x4 __attribute__((ext_vector_type(4)));
typedef float f32x16 __attribute__((ext_vector_type(16)));
typedef unsigned u32x2 __attribute__((ext_vector_type(2)));
typedef unsigned u32x4 __attribute__((ext_vector_type(4)));
typedef __bf16 bf16x2_t __attribute__((ext_vector_type(2)));
#define LDSAS __attribute__((address_space(3)))
#define VTID ((int)(threadIdx.x & 255u))
__device__ __forceinline__ int vblk_() { int h_ = threadIdx.x >> 8; asm volatile("" : "+v"(h_)); return __builtin_amdgcn_readfirstlane(2 * (int)blockIdx.x + h_); }
#define VBLK vblk_()
#define VGRID ((int)(2u * gridDim.x))
constexpr int HALF_LDS = 73728, LDS_TOTAL = 147456;

constexpr int SEQ = 8192, DM = 1024, NBATCH = 4, NBH = 2, TP = NBH * SEQ, DEPTH = 2;
constexpr int NP = 8704;
constexpr float EPS = 1e-6f;
constexpr float LOG2E = 1.4426950408889634f, LN2 = 0.6931471805599453f;
constexpr int NSEG = 16, SEGLEN = 512, TSUB = 32, NSUB = SEGLEN / TSUB;

constexpr size_t MiB = 1u << 20;
constexpr size_t WS_WIN = 0;
constexpr size_t WS_WPA = 34 * MiB;
constexpr size_t WS_WPB = 36 * MiB;
constexpr size_t WS_WPC = 37 * MiB;
constexpr size_t WS_WOUT = 39 * MiB;
constexpr size_t WS_MOD = 43 * MiB;
constexpr size_t WS_ROPE = 43 * MiB + 128 * 1024;
constexpr size_t WS_BND = 43 * MiB + 160 * 1024;
constexpr size_t WS_RSTD = 43 * MiB + 256 * 1024;
constexpr size_t WS_SEGT = 43 * MiB + 512 * 1024;
constexpr size_t WS_LSE = 44 * MiB;
constexpr size_t WS_DT = 45 * MiB;
constexpr size_t WS_BAR = 46 * MiB;
constexpr size_t WS_H = 48 * MiB;
constexpr size_t WS_QA = 80 * MiB;
constexpr size_t WS_KA = 96 * MiB;
constexpr size_t WS_VA = 100 * MiB;
constexpr size_t WS_GA = 104 * MiB;
constexpr size_t WS_QB = 120 * MiB;
constexpr size_t WS_KB = 144 * MiB;
constexpr size_t WS_VB = 168 * MiB;
constexpr size_t WS_GB = 192 * MiB;
constexpr size_t WS_XBC = 200 * MiB;
constexpr size_t WS_ZS = 232 * MiB;
constexpr size_t WS_MG = 248 * MiB;
constexpr size_t WS_YF = 344 * MiB;
constexpr size_t WS_YS = 360 * MiB;
constexpr size_t WS_YBM = 376 * MiB;
constexpr size_t WS_YC = 384 * MiB;
constexpr size_t WS_MRG = 400 * MiB;
constexpr size_t WS_ST = 432 * MiB;
constexpr size_t WS_XBCC = 448 * MiB;

struct Params {
    const float *x, *c, *norm_w, *w_ada, *b_ada, *w_in, *b_gate, *q_norm_a, *k_norm_a, *q_norm_b, *k_norm_b, *rel_bias,
        *conv_w, *conv_b, *a_log, *dt_bias, *d_skip, *ssm_norm_w, *w_proj_a, *w_proj_b, *w_proj_c, *w_out;
    float* out;
    unsigned char* ws;
};


#define AS1 __attribute__((address_space(1)))
#define GLOBF(f) do { AS1 const float* g_ = (AS1 const float*)p.f; asm volatile("" : "+s"(g_)); q.f = (const float*)g_; } while (0)
__device__ __forceinline__ Params launder(const Params& p) {
    Params q;
    GLOBF(x); GLOBF(c); GLOBF(norm_w); GLOBF(w_ada); GLOBF(b_ada); GLOBF(w_in); GLOBF(b_gate); GLOBF(q_norm_a); GLOBF(k_norm_a); GLOBF(q_norm_b); GLOBF(k_norm_b); GLOBF(rel_bias);
    GLOBF(conv_w); GLOBF(conv_b); GLOBF(a_log); GLOBF(dt_bias); GLOBF(d_skip); GLOBF(ssm_norm_w); GLOBF(w_proj_a); GLOBF(w_proj_b); GLOBF(w_proj_c); GLOBF(w_out);
    { AS1 float* g_ = (AS1 float*)p.out; asm volatile("" : "+s"(g_)); q.out = (float*)g_; }
    { AS1 unsigned char* g_ = (AS1 unsigned char*)p.ws; asm volatile("" : "+s"(g_)); q.ws = (unsigned char*)g_; }
    return q;
}
__device__ __forceinline__ unsigned pk2(float lo, float hi) { f32x2 v = {lo, hi}; bf16x2_t b = __builtin_convertvector(v, bf16x2_t); return __builtin_bit_cast(unsigned, b); }
__device__ __forceinline__ float bf2f(unsigned short b) { return __uint_as_float(((unsigned)b) << 16); }
__device__ __forceinline__ float bflo(unsigned u) { return __uint_as_float(u << 16); }
__device__ __forceinline__ float bfhi(unsigned u) { return __uint_as_float(u & 0xffff0000u); }
__device__ __forceinline__ float siluf(float v) { return v * __builtin_amdgcn_rcpf(1.f + __builtin_amdgcn_exp2f(-1.4426950408889634f * v)); }
__device__ __forceinline__ float sigmf(float v) { return __builtin_amdgcn_rcpf(1.f + __builtin_amdgcn_exp2f(-1.4426950408889634f * v)); }
__device__ __forceinline__ float wave_sum(float v) {
#pragma unroll
    for (int o = 1; o < 64; o <<= 1) v += __shfl_xor(v, o);
    return v;
}
__device__ __forceinline__ v4i16 tr16(const unsigned char* p) { return __builtin_amdgcn_ds_read_tr16_b64_v4i16((LDSAS v4i16*)p); }
__device__ __forceinline__ bf16x8 cat8(v4i16 a, v4i16 b) { return (bf16x8){a[0], a[1], a[2], a[3], b[0], b[1], b[2], b[3]}; }
__device__ __forceinline__ int crow(int r, int hi) { return (r & 3) + 8 * (r >> 2) + 4 * hi; }

struct P0It { const float* W; bf16_t* Wt; const float* rs; int ldw, K, k0, n0, mode; };
__device__ __forceinline__ void p0_load(const P0It& t, float (&vv)[16]) {
    const int tid = VTID, tx = tid & 63, ty = tid >> 6;
    const int np = t.n0 + tx; int n = np; bool valid = true;
    if (t.mode == 1) {
        if (np < 4352) n = np; else if (np < 4864) n = np + 512; else if (np < 5376) n = np - 512;
        else if (np < 8448) n = np + 16; else if (np < 8464) n = np - 3072; else { valid = false; n = 0; }
    }
#pragma unroll
    for (int i = 0; i < 16; ++i) { const int k = ty + 4 * i; vv[i] = valid ? t.W[(size_t)(t.k0 + k) * t.ldw + n] : 0.f; }
}
__device__ __forceinline__ void p0_finish(const P0It& t, const float (&vv)[16], float* tile) {
    const int tid = VTID, tx = tid & 63, ty = tid >> 6;
#pragma unroll
    for (int i = 0; i < 16; ++i) { const int k = ty + 4 * i; float v = vv[i]; if (t.rs) v *= t.rs[t.k0 + k]; tile[k * 65 + tx] = v; }
    __syncthreads();
    const int r = tid >> 2, kc = (tid & 3) * 16;
    u32x4 o0, o1;
    o0.x = pk2(tile[(kc + 0) * 65 + r], tile[(kc + 1) * 65 + r]); o0.y = pk2(tile[(kc + 2) * 65 + r], tile[(kc + 3) * 65 + r]);
    o0.z = pk2(tile[(kc + 4) * 65 + r], tile[(kc + 5) * 65 + r]); o0.w = pk2(tile[(kc + 6) * 65 + r], tile[(kc + 7) * 65 + r]);
    o1.x = pk2(tile[(kc + 8) * 65 + r], tile[(kc + 9) * 65 + r]); o1.y = pk2(tile[(kc + 10) * 65 + r], tile[(kc + 11) * 65 + r]);
    o1.z = pk2(tile[(kc + 12) * 65 + r], tile[(kc + 13) * 65 + r]); o1.w = pk2(tile[(kc + 14) * 65 + r], tile[(kc + 15) * 65 + r]);
    bf16_t* dst = t.Wt + (size_t)(t.n0 + r) * t.K + t.k0 + kc;
    *(u32x4*)dst = o0; *(u32x4*)(dst + 8) = o1;
    __syncthreads();
}
constexpr int P0_IN = 16 * 136, P0_PA = 8 * 16, P0_PB = 4 * 16, P0_PC = 8 * 16, P0_OUT = 16 * 16, P0_L = P0_IN + P0_PA + P0_PB + P0_PC + P0_OUT;
__device__ __forceinline__ P0It p0_params(const Params& p, int item) {
    P0It t; const int l = item / P0_L; int r = item % P0_L; t.rs = nullptr; t.mode = 0;
    if (r < P0_IN) { t.W = p.w_in + (size_t)l * 1024 * 8464; t.ldw = 8464; t.K = 1024; t.Wt = (bf16_t*)(p.ws + WS_WIN) + (size_t)l * NP * 1024; t.k0 = (r / 136) * 64; t.n0 = (r % 136) * 64; t.mode = 1; return t; }
    r -= P0_IN;
    if (r < P0_PA) { t.W = p.w_proj_a + (size_t)l * 512 * 1024; t.ldw = 1024; t.K = 512; t.Wt = (bf16_t*)(p.ws + WS_WPA) + (size_t)l * 1024 * 512; t.k0 = (r / 16) * 64; t.n0 = (r % 16) * 64; return t; }
    r -= P0_PA;
    if (r < P0_PB) { t.W = p.w_proj_b + (size_t)l * 256 * 1024; t.ldw = 1024; t.K = 256; t.Wt = (bf16_t*)(p.ws + WS_WPB) + (size_t)l * 1024 * 256; t.k0 = (r / 16) * 64; t.n0 = (r % 16) * 64; return t; }
    r -= P0_PB;
    if (r < P0_PC) { t.W = p.w_proj_c + (size_t)l * 512 * 1024; t.ldw = 1024; t.K = 512; t.Wt = (bf16_t*)(p.ws + WS_WPC) + (size_t)l * 1024 * 512; t.k0 = (r / 16) * 64; t.n0 = (r % 16) * 64; t.rs = p.ssm_norm_w + l * 512; return t; }
    r -= P0_PC;
    t.W = p.w_out + (size_t)l * 1024 * 1024; t.ldw = 1024; t.K = 1024; t.Wt = (bf16_t*)(p.ws + WS_WOUT) + (size_t)l * 1024 * 1024; t.k0 = (r / 16) * 64; t.n0 = (r % 16) * 64; return t;
}

__device__ void phase0(const Params& p, unsigned char* smem) {
    const int tid = VTID;
    float* tile = (float*)smem;
    constexpr int I_T = 2 * P0_L, I_MOD = 192, I_ALL = I_T + I_MOD + 1;
    {
        int item = VBLK;
        if (item < I_T) {
            P0It cur = p0_params(p, item); float va[16], vb[16]; p0_load(cur, va);
            for (;;) {
                const int nx = item + VGRID; const bool more = nx < I_T; P0It nxt = cur;
                if (more) { nxt = p0_params(p, nx); p0_load(nxt, vb); }
                p0_finish(cur, va, tile);
                if (!more) break;
                item = nx; cur = nxt;
#pragma unroll
                for (int i = 0; i < 16; ++i) va[i] = vb[i];
            }
        }
    }
    for (int item = VBLK; item < I_ALL; item += VGRID) {
        if (item < I_T) {
            continue;
        } else if (item < I_T + I_MOD) {
            const int it = item - I_T, l = it / 96, col0 = (it % 96) * 32, cl = tid & 31, ks = tid >> 5;
            float a0 = 0.f, a1 = 0.f, a2 = 0.f, a3 = 0.f;
            const float* wp = p.w_ada + ((size_t)l * 1024 + ks * 128) * 3072 + col0 + cl;
#pragma unroll 8
            for (int k = 0; k < 128; ++k) {
                const float wv = wp[(size_t)k * 3072]; const int kk = ks * 128 + k;
                a0 += siluf(p.c[kk]) * wv; a1 += siluf(p.c[1024 + kk]) * wv; a2 += siluf(p.c[2048 + kk]) * wv; a3 += siluf(p.c[3072 + kk]) * wv;
            }
            float* red = (float*)smem;
            red[(ks * 32 + cl) * 4 + 0] = a0; red[(ks * 32 + cl) * 4 + 1] = a1; red[(ks * 32 + cl) * 4 + 2] = a2; red[(ks * 32 + cl) * 4 + 3] = a3;
            __syncthreads();
            if (tid < 128) { const int b = tid >> 5, c2 = tid & 31; float s = 0.f;
#pragma unroll
                for (int k = 0; k < 8; ++k) s += red[(k * 32 + c2) * 4 + b];
                ((float*)(p.ws + WS_MOD))[(l * 4 + b) * 3072 + col0 + c2] = s + p.b_ada[l * 3072 + col0 + c2]; }
            __syncthreads();
        } else {
            float* rc = (float*)(p.ws + WS_ROPE); float* rs = rc + 128 * 16;
            for (int e = tid; e < 2048; e += 256) {
                const int pos = e >> 4, i = e & 15;
                const float freq = powf(10000.0f, -(float)i / 16.0f);
                const float ang = (float)pos * freq;
                const double rev = (double)ang * 0.15915494309189535; const double fr = rev - rint(rev);
                const float a = (float)(fr * 6.283185307179586);
                rc[e] = cosf(a); rs[e] = sinf(a);
            }
            if (tid < 2) {
                const int l = tid; float mqa = 0.f, mka = 0.f, mqb = 0.f, mkb = 0.f, mb = 0.f;
                for (int i = 0; i < 64; ++i) { mqa = fmaxf(mqa, fabsf(p.q_norm_a[l * 64 + i])); mka = fmaxf(mka, fabsf(p.k_norm_a[l * 64 + i]));
                    mqb = fmaxf(mqb, fabsf(p.q_norm_b[l * 64 + i])); mkb = fmaxf(mkb, fabsf(p.k_norm_b[l * 64 + i])); }
                for (int i = 0; i < 32 * 12; ++i) mb = fmaxf(mb, p.rel_bias[i]);
                float* bd = (float*)(p.ws + WS_BND);
                bd[l] = 8.f * mqa * mka * LOG2E; bd[2 + l] = (8.f * mqb * mkb + mb) * LOG2E;
            }
        }
    }
}

__device__ void norm_phase(const Params& p, int l, int hb, const float* xsrc) {
    int tx_ = threadIdx.x; asm volatile("" : "+v"(tx_));
    const int lane = tx_ & 63, gw = blockIdx.x * 8 + (tx_ >> 6), nw = gridDim.x * 8;
    bf16_t* H = (bf16_t*)(p.ws + WS_H);
    const float* nwp = p.norm_w + l * 1024;
    for (int row0 = gw; row0 < TP; row0 += 4 * nw) {
        f32x4 v[4][4];
#pragma unroll
        for (int q = 0; q < 4; ++q) { const int row = row0 + q * nw;
            if (row < TP) { const f32x4* xr = (const f32x4*)(xsrc + ((size_t)hb * TP + row) * 1024);
#pragma unroll
                for (int j = 0; j < 4; ++j) v[q][j] = xr[lane + 64 * j]; } }
#pragma unroll
        for (int q = 0; q < 4; ++q) { const int row = row0 + q * nw;
            if (row < TP) {
                const size_t rg = (size_t)hb * TP + row; const int b = (int)(rg / SEQ);
                const float* md = (const float*)(p.ws + WS_MOD) + (size_t)(l * 4 + b) * 3072;
                float ss = 0.f;
#pragma unroll
                for (int j = 0; j < 4; ++j) ss += v[q][j].x * v[q][j].x + v[q][j].y * v[q][j].y + v[q][j].z * v[q][j].z + v[q][j].w * v[q][j].w;
                ss = wave_sum(ss); const float rstd = rsqrtf(ss * (1.f / 1024.f) + EPS);
#pragma unroll
                for (int j = 0; j < 4; ++j) {
                    const int col = 4 * (lane + 64 * j);
                    const f32x4 w4 = *(const f32x4*)(nwp + col), sh = *(const f32x4*)(md + col), sc = *(const f32x4*)(md + 1024 + col);
                    const f32x4 o = v[q][j] * rstd * w4 * (1.f + sc) + sh;
                    u32x2 pk; pk.x = pk2(o.x, o.y); pk.y = pk2(o.z, o.w);
                    *(u32x2*)(H + (size_t)row * 1024 + col) = pk;
                }
            } }
    }
}

constexpr int G_STAGE = 65536, G_AB = 32768;
template <bool LOWREG = false>
__device__ __forceinline__ void gemm_core(const bf16_t* __restrict__ A, int lda, const bf16_t* __restrict__ Bt, int ldb, int K, f32x4 (&acc)[8][4], unsigned char* smem, int tid) {
    asm volatile("" : "+v"(tid));
    const int lane = tid & 63, w = __builtin_amdgcn_readfirstlane(tid >> 6), wm = w >> 2, wn = w & 3, idx = lane & 15, kq = lane >> 4;
    unsigned offA[4], offB[4];
#pragma unroll
    for (int j = 0; j < 4; ++j) { const int row = (j * 8 + w) * 8 + (lane >> 3), c = (lane & 7) ^ ((row >> 1) & 7);
        offA[j] = (unsigned)(row * lda + c * 8) * 2u; offB[j] = (unsigned)(row * ldb + c * 8) * 2u; }
#pragma unroll
    for (int mi = 0; mi < 8; ++mi)
#pragma unroll
        for (int ni = 0; ni < 4; ++ni) acc[mi][ni] = (f32x4){0.f, 0.f, 0.f, 0.f};
    LDSAS unsigned char* lds = (LDSAS unsigned char*)smem;
#define G_ISSUE1(kt, st, j) do { \
        __builtin_amdgcn_global_load_lds((const unsigned*)((const char*)A + offA[j] + (kt) * 128), (LDSAS unsigned*)(lds + (st) * G_STAGE + ((j) * 8 + w) * 1024), 16, 0, 0); \
        __builtin_amdgcn_global_load_lds((const unsigned*)((const char*)Bt + offB[j] + (kt) * 128), (LDSAS unsigned*)(lds + (st) * G_STAGE + G_AB + ((j) * 8 + w) * 1024), 16, 0, 0); } while (0)
#define G_ISSUE(kt, st) do { G_ISSUE1(kt, st, 0); G_ISSUE1(kt, st, 1); G_ISSUE1(kt, st, 2); G_ISSUE1(kt, st, 3); } while (0)
    const int nk = K >> 6;
    G_ISSUE(0, 0);
    asm volatile("s_waitcnt vmcnt(0)" ::: "memory");
    __syncthreads();
    const int swz = (idx >> 1) & 7;
    const int aoff = (wm * 128 + idx) * 128, boff = G_AB + (wn * 64 + idx) * 128;
    for (int kt = 0; kt < nk; ++kt) {
        const int st = kt & 1;
        const bool more = kt + 1 < nk;
        const unsigned char* sb = smem + st * G_STAGE;
        if constexpr (!LOWREG) {
#pragma unroll
        for (int ks = 0; ks < 2; ++ks) {
            bf16x8 bfr[4], af[8];
            const int co = ((ks * 4 + kq) ^ swz) * 16;
#pragma unroll
            for (int ni = 0; ni < 4; ++ni) bfr[ni] = *(const bf16x8*)(sb + boff + ni * 2048 + co);
#pragma unroll
            for (int mi = 0; mi < 8; ++mi) af[mi] = *(const bf16x8*)(sb + aoff + mi * 2048 + co);
            if (more) { G_ISSUE1(kt + 1, st ^ 1, ks * 2); G_ISSUE1(kt + 1, st ^ 1, ks * 2 + 1); }
            __builtin_amdgcn_sched_barrier(0);
            __builtin_amdgcn_s_setprio(1);
#pragma unroll
            for (int mi = 0; mi < 8; ++mi)
#pragma unroll
                for (int ni = 0; ni < 4; ++ni) acc[mi][ni] = __builtin_amdgcn_mfma_f32_16x16x32_bf16(bfr[ni], af[mi], acc[mi][ni], 0, 0, 0);
            __builtin_amdgcn_s_setprio(0);
            __builtin_amdgcn_sched_barrier(0);
        }
        } else {
#pragma unroll
        for (int ks = 0; ks < 2; ++ks) {
            bf16x8 bfr[4];
            const int co = ((ks * 4 + kq) ^ swz) * 16;
#pragma unroll
            for (int ni = 0; ni < 4; ++ni) bfr[ni] = *(const bf16x8*)(sb + boff + ni * 2048 + co);
#pragma unroll
            for (int mh = 0; mh < 2; ++mh) {
                bf16x8 af[4];
#pragma unroll
                for (int mi = 0; mi < 4; ++mi) af[mi] = *(const bf16x8*)(sb + aoff + (mh * 4 + mi) * 2048 + co);
                if (more) G_ISSUE1(kt + 1, st ^ 1, ks * 2 + mh);
                __builtin_amdgcn_sched_barrier(0);
                __builtin_amdgcn_s_setprio(1);
#pragma unroll
                for (int mi = 0; mi < 4; ++mi)
#pragma unroll
                    for (int ni = 0; ni < 4; ++ni) acc[mh * 4 + mi][ni] = __builtin_amdgcn_mfma_f32_16x16x32_bf16(bfr[ni], af[mi], acc[mh * 4 + mi][ni], 0, 0, 0);
                __builtin_amdgcn_s_setprio(0);
                __builtin_amdgcn_sched_barrier(0);
            }
        }
        }
        asm volatile("s_waitcnt vmcnt(0)" ::: "memory");
        __syncthreads();
    }
#undef G_ISSUE1
#undef G_ISSUE
}

__device__ __forceinline__ void st4bf(bf16_t* dst, f32x4 v) { u32x2 pk; pk.x = pk2(v.x, v.y); pk.y = pk2(v.z, v.w); *(u32x2*)dst = pk; }

__device__ void gemm1_phase(const Params& p, int l, int hb, unsigned char* smem) {
    const bf16_t* H = (const bf16_t*)(p.ws + WS_H);
    const bf16_t* Wt = (const bf16_t*)(p.ws + WS_WIN) + (size_t)l * NP * 1024;
    const float* ropec = (const float*)(p.ws + WS_ROPE); const float* ropes = ropec + 2048;
    constexpr int NT = 34, NTILES = 64 * NT, GRP = 8 * NT;
    for (int t = blockIdx.x; t < NTILES; t += gridDim.x) {
        const int grp = t / GRP, r = t % GRP, jx = NT * (r & 7) + (r >> 3), mt = grp * 8 + (jx & 7), nt = jx >> 3;
        const int m0 = mt * 256, n0 = nt * 256;
        f32x4 acc[8][4];
        int tid = threadIdx.x;
        gemm_core(H + (size_t)m0 * 1024, 1024, Wt + (size_t)n0 * 1024, 1024, 1024, acc, smem, tid);
        asm volatile("" : "+v"(tid));
        const int lane = tid & 63, w = __builtin_amdgcn_readfirstlane(tid >> 6), wm = w >> 2, wn = w & 3, idx = lane & 15, kq = lane >> 4;
        const int cw = n0 + wn * 64;
        const int lc = 4 * kq;
        unsigned char* wl = smem + w * 16384;
#define G1_STG(mi_, ni_, v_) do { const int r_ = (mi_) * 16 + idx; const f32x4 t_ = (v_); u32x2 pk_; pk_.x = pk2(t_.x, t_.y); pk_.y = pk2(t_.z, t_.w); \
        *(u32x2*)(wl + r_ * 128 + ((((ni_) * 2 + (kq >> 1)) ^ (r_ & 7)) * 16) + (kq & 1) * 8) = pk_; } while (0)
        bf16_t* dbase = nullptr; int dpitch = 0, dc0 = 0, dsh = -1, dg = 0;
        if (cw < 768 && (cw < 640)) {
            const bool isq = cw < 512;
            const float* nwp = (isq ? p.q_norm_a : p.k_norm_a) + l * 64;
            dbase = isq ? (bf16_t*)(p.ws + WS_QA) : (bf16_t*)(p.ws + WS_KA);
            dpitch = isq ? 512 : 128; dc0 = isq ? cw : cw - 512;
            const float qs = isq ? 0.125f * LOG2E : 1.f;
#pragma unroll
            for (int mi = 0; mi < 8; ++mi) {
                const int row = m0 + wm * 128 + mi * 16 + idx;
                float ss = 0.f;
#pragma unroll
                for (int ni = 0; ni < 4; ++ni) { const f32x4 v = acc[mi][ni]; ss += v.x * v.x + v.y * v.y + v.z * v.z + v.w * v.w; }
                ss += __shfl_xor(ss, 16); ss += __shfl_xor(ss, 32);
                const float rstd = rsqrtf(ss * (1.f / 64.f) + EPS);
                f32x4 y[4];
#pragma unroll
                for (int ni = 0; ni < 4; ++ni) y[ni] = acc[mi][ni] * rstd * *(const f32x4*)(nwp + ni * 16 + lc);
                const int tt = row & (SEQ - 1), prow = tt >> 6, pcol = tt & 63;
#pragma unroll
                for (int hf = 0; hf < 2; ++hf) {
                    const int pos = hf ? pcol : prow;
                    const f32x4 cs = *(const f32x4*)(ropec + pos * 16 + lc), sn = *(const f32x4*)(ropes + pos * 16 + lc);
                    const f32x4 a = y[2 * hf], b = y[2 * hf + 1];
                    y[2 * hf] = a * cs - b * sn; y[2 * hf + 1] = b * cs + a * sn;
                }
#pragma unroll
                for (int ni = 0; ni < 4; ++ni) G1_STG(mi, ni, y[ni] * qs);
            }
        } else if (cw >= 1280 && cw < 2816) {
            const bool isq = cw < 2048;
            const float* nwp = (isq ? p.q_norm_b : p.k_norm_b) + l * 64;
            const int gc = isq ? cw - 1280 : cw - 2048;
            dg = gc >> 8; dc0 = gc & 255; dsh = 2 * dg; dpitch = 256;
            dbase = (bf16_t*)(p.ws + (isq ? WS_QB : WS_KB));
            const float qs = isq ? 0.125f * LOG2E : 1.f;
#pragma unroll
            for (int mi = 0; mi < 8; ++mi) {
                float ss = 0.f;
#pragma unroll
                for (int ni = 0; ni < 4; ++ni) { const f32x4 v = acc[mi][ni]; ss += v.x * v.x + v.y * v.y + v.z * v.z + v.w * v.w; }
                ss += __shfl_xor(ss, 16); ss += __shfl_xor(ss, 32);
                const float rstd = rsqrtf(ss * (1.f / 64.f) + EPS) * qs;
#pragma unroll
                for (int ni = 0; ni < 4; ++ni) G1_STG(mi, ni, acc[mi][ni] * rstd * *(const f32x4*)(nwp + ni * 16 + lc));
            }
        } else if (cw >= 2816 && cw < 3584) {
            const int gc = cw - 2816;
            dg = gc >> 8; dc0 = gc & 255; dsh = 2 * dg; dpitch = 256; dbase = (bf16_t*)(p.ws + WS_VB);
#pragma unroll
            for (int mi = 0; mi < 8; ++mi)
#pragma unroll
                for (int ni = 0; ni < 4; ++ni) G1_STG(mi, ni, acc[mi][ni]);
        } else if (cw >= 8448) {
            if (cw == 8448) {
                float* dst = (float*)(p.ws + WS_DT);
                const f32x4 bias = *(const f32x4*)(p.dt_bias + l * 16 + lc);
#pragma unroll
                for (int mi = 0; mi < 8; ++mi) {
                    const int row = m0 + wm * 128 + mi * 16 + idx;
                    f32x4 v = acc[mi][0] + bias, o;
                    o.x = v.x > 20.f ? v.x : log1pf(__expf(v.x)); o.y = v.y > 20.f ? v.y : log1pf(__expf(v.y));
                    o.z = v.z > 20.f ? v.z : log1pf(__expf(v.z)); o.w = v.w > 20.f ? v.w : log1pf(__expf(v.w));
                    *(f32x4*)(dst + (size_t)row * 16 + lc) = o;
                }
            }
        } else {
            int mode;
            if (cw < 768) { dbase = (bf16_t*)(p.ws + WS_VA); dpitch = 128; dc0 = cw - 640; mode = 0; }
            else if (cw < 1280) { dbase = (bf16_t*)(p.ws + WS_GA); dpitch = 512; dc0 = cw - 768; mode = 1; }
            else if (cw < 3840) { dbase = (bf16_t*)(p.ws + WS_GB); dpitch = 256; dc0 = cw - 3584; mode = 1; }
            else if (cw < 4864) { dbase = (bf16_t*)(p.ws + WS_XBC); dpitch = 1024; dc0 = cw - 3840; mode = 0; }
            else if (cw < 5376) { dbase = (bf16_t*)(p.ws + WS_ZS); dpitch = 512; dc0 = cw - 4864; mode = 1; }
            else { dbase = (bf16_t*)(p.ws + WS_MG); dpitch = 3072; dc0 = cw - 5376; mode = 2; }
            const float* bg = p.b_gate + l * 3072 + dc0 + lc;
#pragma unroll
            for (int mi = 0; mi < 8; ++mi) {
#pragma unroll
                for (int ni = 0; ni < 4; ++ni) {
                    f32x4 v = acc[mi][ni];
                    if (mode == 1) { v.x = siluf(v.x); v.y = siluf(v.y); v.z = siluf(v.z); v.w = siluf(v.w); }
                    else if (mode == 2) { const f32x4 bb = *(const f32x4*)(bg + ni * 16); v.x = sigmf(v.x + bb.x); v.y = sigmf(v.y + bb.y); v.z = sigmf(v.z + bb.z); v.w = sigmf(v.w + bb.w); }
                    G1_STG(mi, ni, v);
                }
            }
        }
#undef G1_STG
        if (dbase) {
            const int ch = lane & 7;
#pragma unroll
            for (int j = 0; j < 16; ++j) {
                const int rl = 8 * j + (lane >> 3), row = m0 + wm * 128 + rl;
                const u32x4 v = *(const u32x4*)(wl + rl * 128 + ((ch ^ (rl & 7)) * 16));
                size_t drow = (size_t)row;
                if (dsh >= 0) { const int bl = row >> 13, tt = row & (SEQ - 1); drow = (size_t)(bl * 3 + dg) * SEQ + (size_t)((tt & ((1 << dsh) - 1)) * (SEQ >> dsh) + (tt >> dsh)); }
                *(u32x4*)(dbase + drow * dpitch + dc0 + ch * 8) = v;
            }
        }
        __syncthreads();
    }
}

__device__ void merge_phase(const Params& p, int l, unsigned char* smem) {
    const bf16_t* MG = (const bf16_t*)(p.ws + WS_MG);
    const float* rstd = (const float*)(p.ws + WS_RSTD);
    bf16_t* MR = (bf16_t*)(p.ws + WS_MRG);
    for (int t = blockIdx.x; t < 64 * 4; t += gridDim.x) {
        const int xq = t >> 3, mt = (xq >> 2) * 8 + (t & 7), nt = xq & 3, m0 = mt * 256, n0 = nt * 256;
        u32x2 mpk[6][4];
#pragma unroll 1
        for (int br = 0; br < 3; ++br) {
            f32x4 acc[8][4];
            const bf16_t* A; const bf16_t* Bt; int K;
            if (br == 0) { A = (const bf16_t*)(p.ws + WS_QA); K = 512; Bt = (const bf16_t*)(p.ws + WS_WPA) + (size_t)l * 1024 * 512; }
            else if (br == 1) { A = (const bf16_t*)(p.ws + WS_YBM); K = 256; Bt = (const bf16_t*)(p.ws + WS_WPB) + (size_t)l * 1024 * 256; }
            else { A = (const bf16_t*)(p.ws + WS_YC); K = 512; Bt = (const bf16_t*)(p.ws + WS_WPC) + (size_t)l * 1024 * 512; }
            int tid = threadIdx.x;
            gemm_core<true>(A + (size_t)m0 * K, K, Bt + (size_t)n0 * K, K, K, acc, smem, tid);
            asm volatile("" : "+v"(tid));
            const int lane = tid & 63, w = tid >> 6, wm = w >> 2, wn = w & 3, idx = lane & 15, kq = lane >> 4;
#pragma unroll
            for (int mi = 0; mi < 8; ++mi) {
                const int row = m0 + wm * 128 + mi * 16 + idx;
                const float rs = (br == 2) ? rstd[row] : 1.f;
#pragma unroll
                for (int ni = 0; ni < 4; ++ni) {
                    const int col = n0 + wn * 64 + ni * 16 + 4 * kq;
                    const u32x2 g = *(const u32x2*)(MG + (size_t)row * 3072 + br * 1024 + col);
                    f32x4 gv; gv.x = bflo(g.x); gv.y = bfhi(g.x); gv.z = bflo(g.y); gv.w = bfhi(g.y);
                    f32x4 v = gv * rs * acc[mi][ni];
                    bf16_t* mp = MR + (size_t)row * 1024 + col;
                    if (mi < 6) {
                        if (br > 0) { const u32x2 o = mpk[mi < 6 ? mi : 0][ni]; v.x += bflo(o.x); v.y += bfhi(o.x); v.z += bflo(o.y); v.w += bfhi(o.y); }
                        u32x2 pk; pk.x = pk2(v.x, v.y); pk.y = pk2(v.z, v.w); mpk[mi < 6 ? mi : 0][ni] = pk;
                        if (br == 2) *(u32x2*)mp = pk;
                    } else {
                        if (br > 0) { const u32x2 o = *(const u32x2*)mp; v.x += bflo(o.x); v.y += bfhi(o.x); v.z += bflo(o.y); v.w += bfhi(o.y); }
                        st4bf(mp, v);
                    }
                }
            }
        }
    }
}

__device__ void out_phase(const Params& p, int l, int hb, const float* xsrc, unsigned char* smem) {
    const bf16_t* MR = (const bf16_t*)(p.ws + WS_MRG);
    const bf16_t* Wt = (const bf16_t*)(p.ws + WS_WOUT) + (size_t)l * 1024 * 1024;
    for (int t = blockIdx.x; t < 64 * 4; t += gridDim.x) {
        const int xq = t >> 3, mt = (xq >> 2) * 8 + (t & 7), nt = xq & 3, m0 = mt * 256, n0 = nt * 256;
        f32x4 acc[8][4];
        int tid = threadIdx.x;
        gemm_core(MR + (size_t)m0 * 1024, 1024, Wt + (size_t)n0 * 1024, 1024, 1024, acc, smem, tid);
        asm volatile("" : "+v"(tid));
        const int lane = tid & 63, w = tid >> 6, wm = w >> 2, wn = w & 3, idx = lane & 15, kq = lane >> 4;
#pragma unroll
        for (int mi = 0; mi < 8; ++mi) {
            const int row = m0 + wm * 128 + mi * 16 + idx; const size_t rg = (size_t)hb * TP + row; const int b = (int)(rg / SEQ);
            const float* gate = (const float*)(p.ws + WS_MOD) + (size_t)(l * 4 + b) * 3072 + 2048;
#pragma unroll
            for (int ni = 0; ni < 4; ++ni) {
                const int col = n0 + wn * 64 + ni * 16 + 4 * kq;
                const f32x4 xv = *(const f32x4*)(xsrc + rg * 1024 + col), gv = *(const f32x4*)(gate + col);
                *(f32x4*)(p.out + rg * 1024 + col) = xv + gv * acc[mi][ni];
            }
        }
    }
}

constexpr int AT_KS = 0, AT_VS = 9216, AT_LQ = 9216 + 8192, AT_LUT = AT_LQ + 512;

#define AT_STAGE_STORE() do { _Pragma("unroll") for (int i = 0; i < 2; ++i) { const int c = tid + 256 * i, row = c >> 3, ch = c & 7; \
        *(u32x4*)(Ks + row * 72 + ch * 8) = rk[i]; *(u32x4*)(Vs + (ch >> 2) * 4096 + row * 64 + (ch & 3) * 16) = rv[i]; } } while (0)

__device__ __forceinline__ void at_qk(f32x16& p0, f32x16& p1, const bf16_t* Ks, const bf16x8* qr, int r32, int hi) {
    bf16x8 kf[8];
#pragma unroll
    for (int ds = 0; ds < 4; ++ds) {
        kf[2 * ds] = *(const bf16x8*)(Ks + r32 * 72 + ds * 16 + hi * 8);
        kf[2 * ds + 1] = *(const bf16x8*)(Ks + (r32 + 32) * 72 + ds * 16 + hi * 8);
    }
    __builtin_amdgcn_sched_barrier(0);
    __builtin_amdgcn_s_setprio(1);
#pragma unroll
    for (int ds = 0; ds < 4; ++ds) {
        p0 = __builtin_amdgcn_mfma_f32_32x32x16_bf16(kf[2 * ds], qr[ds], p0, 0, 0, 0);
        p1 = __builtin_amdgcn_mfma_f32_32x32x16_bf16(kf[2 * ds + 1], qr[ds], p1, 0, 0, 0);
    }
    __builtin_amdgcn_s_setprio(0);
    __builtin_amdgcn_sched_barrier(0);
}
__device__ __forceinline__ void at_pv(f32x16& o0, f32x16& o1, const f32x16& p0, const f32x16& p1, const unsigned char* Vs, int lane) {
    const int hi = lane >> 5;
    const unsigned char* vb = Vs + ((lane >> 4) & 1) * 32 + (lane & 3) * 8 + (4 * hi + ((lane & 15) >> 2)) * 64;
    bf16x8 v0[4], v1[4], pa[4];
#pragma unroll
    for (int s = 0; s < 4; ++s) {
        v0[s] = cat8(tr16(vb + s * 1024), tr16(vb + s * 1024 + 512));
        v1[s] = cat8(tr16(vb + 4096 + s * 1024), tr16(vb + 4096 + s * 1024 + 512));
    }
#pragma unroll
    for (int s = 0; s < 4; ++s) {
        u32x4 pw;
        if (s < 2) { pw.x = pk2(p0[8 * s + 0], p0[8 * s + 1]); pw.y = pk2(p0[8 * s + 2], p0[8 * s + 3]); pw.z = pk2(p0[8 * s + 4], p0[8 * s + 5]); pw.w = pk2(p0[8 * s + 6], p0[8 * s + 7]); }
        else { const int q = s - 2; pw.x = pk2(p1[8 * q + 0], p1[8 * q + 1]); pw.y = pk2(p1[8 * q + 2], p1[8 * q + 3]); pw.z = pk2(p1[8 * q + 4], p1[8 * q + 5]); pw.w = pk2(p1[8 * q + 6], p1[8 * q + 7]); }
        pa[s] = __builtin_bit_cast(bf16x8, pw);
    }
    __builtin_amdgcn_sched_barrier(0);
    __builtin_amdgcn_s_setprio(1);
#pragma unroll
    for (int s = 0; s < 4; ++s) {
        o0 = __builtin_amdgcn_mfma_f32_32x32x16_bf16(pa[s], v0[s], o0, 0, 0, 0);
        o1 = __builtin_amdgcn_mfma_f32_32x32x16_bf16(pa[s], v1[s], o1, 0, 0, 0);
    }
    __builtin_amdgcn_s_setprio(0);
    __builtin_amdgcn_sched_barrier(0);
}

__device__ __forceinline__ void at_ldv(bf16x8 (&v0)[4], bf16x8 (&v1)[4], const unsigned char* Vs, int lane) {
    const int hi = lane >> 5;
    const unsigned char* vb = Vs + ((lane >> 4) & 1) * 32 + (lane & 3) * 8 + (4 * hi + ((lane & 15) >> 2)) * 64;
#pragma unroll
    for (int s = 0; s < 4; ++s) {
        v0[s] = cat8(tr16(vb + s * 1024), tr16(vb + s * 1024 + 512));
        v1[s] = cat8(tr16(vb + 4096 + s * 1024), tr16(vb + 4096 + s * 1024 + 512));
    }
}
__device__ __forceinline__ void at_pv2(f32x16& o0, f32x16& o1, const f32x16& p0, const f32x16& p1, const bf16x8 (&v0)[4], const bf16x8 (&v1)[4]) {
    bf16x8 pa[4];
#pragma unroll
    for (int s = 0; s < 4; ++s) {
        u32x4 pw;
        if (s < 2) { pw.x = pk2(p0[8 * s + 0], p0[8 * s + 1]); pw.y = pk2(p0[8 * s + 2], p0[8 * s + 3]); pw.z = pk2(p0[8 * s + 4], p0[8 * s + 5]); pw.w = pk2(p0[8 * s + 6], p0[8 * s + 7]); }
        else { const int q = s - 2; pw.x = pk2(p1[8 * q + 0], p1[8 * q + 1]); pw.y = pk2(p1[8 * q + 2], p1[8 * q + 3]); pw.z = pk2(p1[8 * q + 4], p1[8 * q + 5]); pw.w = pk2(p1[8 * q + 6], p1[8 * q + 7]); }
        pa[s] = __builtin_bit_cast(bf16x8, pw);
    }
    __builtin_amdgcn_sched_barrier(0);
    __builtin_amdgcn_s_setprio(1);
#pragma unroll
    for (int s = 0; s < 4; ++s) {
        o0 = __builtin_amdgcn_mfma_f32_32x32x16_bf16(pa[s], v0[s], o0, 0, 0, 0);
        o1 = __builtin_amdgcn_mfma_f32_32x32x16_bf16(pa[s], v1[s], o1, 0, 0, 0);
    }
    __builtin_amdgcn_s_setprio(0);
    __builtin_amdgcn_sched_barrier(0);
}

constexpr int ATA_STAGE = 17408, ATA_LQ = 2 * ATA_STAGE;
__device__ void attn_a_item(const Params& p, int item, int l, unsigned char* smem) {
    int tid_ = threadIdx.x; asm volatile("" : "+v"(tid_));
    const int tid = tid_, lane = tid & 63, w = __builtin_amdgcn_readfirstlane(tid >> 6), r32 = lane & 31, hi = lane >> 5;
    const int b = item >> 8, r = item & 255, kvh = r >> 7, qblk = (r >> 2) & 31, hq = kvh * 4 + (r & 3);
    float* lq = (float*)(smem + ATA_LQ) + w * 32;
    bf16_t* QA = (bf16_t*)(p.ws + WS_QA);
    const bf16_t* GA = (const bf16_t*)(p.ws + WS_GA);
    const size_t tokq = (size_t)b * SEQ + qblk * 256 + w * 32;
    bf16x8 qr[4];
#pragma unroll
    for (int ds = 0; ds < 4; ++ds) qr[ds] = *(const bf16x8*)(QA + (tokq + r32) * 512 + hq * 64 + ds * 16 + hi * 8);
    const bf16_t* Kb = (const bf16_t*)(p.ws + WS_KA) + (size_t)b * SEQ * 128 + kvh * 64;
    const bf16_t* Vb = (const bf16_t*)(p.ws + WS_VA) + (size_t)b * SEQ * 128 + kvh * 64;
    const float nshift = -((const float*)(p.ws + WS_BND))[l];
    f32x16 o0, o1;
#pragma unroll
    for (int i = 0; i < 16; ++i) { o0[i] = 0.f; o1[i] = 0.f; }
    f32x4 la4 = (f32x4){0.f, 0.f, 0.f, 0.f};
    constexpr int NT = SEQ / 64;
    const int row0 = tid >> 3, ch0 = tid & 7;
    const size_t goff0 = (size_t)row0 * 128 + ch0 * 8;
    const int ko0 = row0 * 144 + ch0 * 16;
    const int vo0 = 9216 + (ch0 >> 2) * 4096 + row0 * 64 + (ch0 & 3) * 16;
    u32x4 rkA[1], rvA[1], rkB[1], rvB[1];
#define ATA_LOAD(RK, RV, t) do { const size_t tb = (size_t)(t) * 64 * 128; RK[0] = *(const u32x4*)(Kb + tb + goff0); RV[0] = *(const u32x4*)(Vb + tb + goff0); } while (0)
#define ATA_STORE(RK, RV, st) do { unsigned char* sb_ = smem + (st) * ATA_STAGE; *(u32x4*)(sb_ + ko0) = RK[0]; *(u32x4*)(sb_ + vo0) = RV[0]; } while (0)
#define ATA_COMPUTE(st) do { const unsigned char* sb_ = smem + (st) * ATA_STAGE; f32x16 p0, p1; bf16x8 vf0[4], vf1[4]; \
        _Pragma("unroll") for (int i = 0; i < 16; ++i) { p0[i] = nshift; p1[i] = nshift; } \
        at_qk(p0, p1, (const bf16_t*)sb_, qr, r32, hi); \
        at_ldv(vf0, vf1, sb_ + 9216, lane); __builtin_amdgcn_sched_barrier(0); \
        _Pragma("unroll") for (int i = 0; i < 16; ++i) { p0[i] = __builtin_amdgcn_exp2f(p0[i]); p1[i] = __builtin_amdgcn_exp2f(p1[i]); } \
        _Pragma("unroll") for (int i = 0; i < 4; ++i) { la4 += (f32x4){p0[4 * i], p0[4 * i + 1], p0[4 * i + 2], p0[4 * i + 3]}; la4 += (f32x4){p1[4 * i], p1[4 * i + 1], p1[4 * i + 2], p1[4 * i + 3]}; } \
        at_pv2(o0, o1, p0, p1, vf0, vf1); } while (0)
    __syncthreads();
    ATA_LOAD(rkA, rvA, 0); ATA_LOAD(rkB, rvB, 1);
    ATA_STORE(rkA, rvA, 0);
    ATA_LOAD(rkA, rvA, 2);
    __syncthreads();
    for (int kt = 0; kt < NT; kt += 2) {
        ATA_COMPUTE(0);
        ATA_STORE(rkB, rvB, 1);
        if (kt + 3 < NT) ATA_LOAD(rkB, rvB, kt + 3);
        __syncthreads();
        ATA_COMPUTE(1);
        if (kt + 2 < NT) { ATA_STORE(rkA, rvA, 0); if (kt + 4 < NT) ATA_LOAD(rkA, rvA, kt + 4); }
        __syncthreads();
    }
#undef ATA_LOAD
#undef ATA_STORE
#undef ATA_COMPUTE
    float lacc = (la4.x + la4.y) + (la4.z + la4.w);
    lacc += __shfl_xor(lacc, 32);
    if (hi == 0) lq[r32] = lacc;
    asm volatile("s_waitcnt lgkmcnt(0)" ::: "memory");
#pragma unroll
    for (int rr = 0; rr < 16; ++rr) {
        const int q = crow(rr, hi); const float inv = 1.f / lq[q];
        const size_t off = (tokq + q) * 512 + hq * 64 + r32;
        const float g0 = bf2f(GA[off]), g1 = bf2f(GA[off + 32]);
        QA[off] = (bf16_t)(pk2(o0[rr] * inv * g0, 0.f) & 0xffffu);
        QA[off + 32] = (bf16_t)(pk2(o1[rr] * inv * g1, 0.f) & 0xffffu);
    }
}

constexpr int ATB_LQ = 17408, ATB_LUT = 17408 + 1024;
__device__ void attn_b_item(const Params& p, int item, int l, unsigned char* smem) {
    int tid_ = threadIdx.x; asm volatile("" : "+v"(tid_));
    const int tid = tid_, lane = tid & 63, w = __builtin_amdgcn_readfirstlane(tid >> 6), r32 = lane & 31, hi = lane >> 5;
    const int blk = item & 31, j = (item >> 5) & 3, bg = item >> 7, g = bg % 3;
    const int sh = 2 * g, dil = 1 << sh, Mlen = SEQ >> sh;
    bf16_t* Ks = (bf16_t*)(smem + AT_KS); unsigned char* Vs = smem + AT_VS; float* lq = (float*)(smem + ATB_LQ) + w * 32; float* lut = (float*)(smem + ATB_LUT);
    bf16_t* QB = (bf16_t*)(p.ws + WS_QB) + (size_t)bg * SEQ * 256 + j * 64;
    const bf16_t* KB = (const bf16_t*)(p.ws + WS_KB) + (size_t)bg * SEQ * 256 + j * 64;
    const bf16_t* VB = (const bf16_t*)(p.ws + WS_VB) + (size_t)bg * SEQ * 256 + j * 64;
    float* LSE = (float*)(p.ws + WS_LSE) + (size_t)bg * SEQ * 4 + j;
    const int p0r = blk * 256, seq_lo = (p0r / Mlen) * Mlen, seq_hi = seq_lo + Mlen;
    __syncthreads();
    if (tid < 129) {
        const int rel = tid - 64, n = (rel < 0 ? -rel : rel) * dil;
        int bk;
        if (n < 8) bk = n; else { bk = 8 + (n >= 15) + (n >= 27) + (n >= 50) + (n >= 91) + (n >= 166) + (n >= 305) + (n >= 559); }
        if (rel > 0) bk += 16;
        lut[tid] = p.rel_bias[bk * 12 + g * 4 + j] * LOG2E;
    }
    const int qpos = p0r + w * 32 + r32;
    bf16x8 qr[4];
#pragma unroll
    for (int ds = 0; ds < 4; ++ds) qr[ds] = *(const bf16x8*)(QB + (size_t)qpos * 256 + ds * 16 + hi * 8);
    const float nshift = -((const float*)(p.ws + WS_BND))[2 + l];
    f32x16 o0, o1;
#pragma unroll
    for (int i = 0; i < 16; ++i) { o0[i] = 0.f; o1[i] = 0.f; }
    f32x4 la4 = (f32x4){0.f, 0.f, 0.f, 0.f};
    const int srow = tid >> 3, sch = tid & 7;
    for (int kt = 0; kt < 6; ++kt) {
        const int kbase = p0r - 64 + 64 * kt;
        int pr = kbase + srow; pr = pr < 0 ? 0 : (pr > SEQ - 1 ? SEQ - 1 : pr);
        const u32x4 rk = *(const u32x4*)(KB + (size_t)pr * 256 + sch * 8), rv = *(const u32x4*)(VB + (size_t)pr * 256 + sch * 8);
        __syncthreads();
        *(u32x4*)(Ks + srow * 72 + sch * 8) = rk; *(u32x4*)(Vs + (sch >> 2) * 4096 + srow * 64 + (sch & 3) * 16) = rv;
        __syncthreads();
        if (kt < (w >> 1) || kt > (w >> 1) + 2) continue;
        f32x16 p0, p1;
#pragma unroll
        for (int i = 0; i < 16; ++i) { p0[i] = nshift; p1[i] = nshift; }
        at_qk(p0, p1, Ks, qr, r32, hi);
#pragma unroll
        for (int i = 0; i < 16; ++i) {
            const int kv0 = kbase + crow(i, hi), kv1 = kv0 + 32;
            const int rel0 = kv0 - qpos, rel1 = kv1 - qpos;
            const bool ok0 = rel0 >= -64 && rel0 <= 64 && kv0 >= seq_lo && kv0 < seq_hi;
            const bool ok1 = rel1 >= -64 && rel1 <= 64 && kv1 >= seq_lo && kv1 < seq_hi;
            const float e0 = __builtin_amdgcn_exp2f(p0[i] + lut[ok0 ? rel0 + 64 : 64]);
            const float e1 = __builtin_amdgcn_exp2f(p1[i] + lut[ok1 ? rel1 + 64 : 64]);
            p0[i] = ok0 ? e0 : 0.f; p1[i] = ok1 ? e1 : 0.f;
        }
#pragma unroll
        for (int i = 0; i < 4; ++i) { la4 += (f32x4){p0[4 * i], p0[4 * i + 1], p0[4 * i + 2], p0[4 * i + 3]}; la4 += (f32x4){p1[4 * i], p1[4 * i + 1], p1[4 * i + 2], p1[4 * i + 3]}; }
        at_pv(o0, o1, p0, p1, Vs, lane);
    }
    float lacc = (la4.x + la4.y) + (la4.z + la4.w);
    lacc += __shfl_xor(lacc, 32);
    if (hi == 0) { lq[r32] = lacc; LSE[(size_t)qpos * 4] = (-nshift + log2f(lacc)) * LN2; }
    asm volatile("s_waitcnt lgkmcnt(0)" ::: "memory");
#pragma unroll
    for (int rr = 0; rr < 16; ++rr) {
        const int q = crow(rr, hi); const float inv = 1.f / lq[q];
        const size_t off = (size_t)(p0r + w * 32 + q) * 256 + r32;
        QB[off] = (bf16_t)(pk2(o0[rr] * inv, 0.f) & 0xffffu);
        QB[off + 32] = (bf16_t)(pk2(o1[rr] * inv, 0.f) & 0xffffu);
    }
}

__device__ void conv_phase(const Params& p, int l) {
    int tx_ = threadIdx.x; asm volatile("" : "+v"(tx_));
    const bf16_t* XBC = (const bf16_t*)(p.ws + WS_XBC);
    bf16_t* XC = (bf16_t*)(p.ws + WS_XBCC);
    const float* cw = p.conv_w + (size_t)l * 5 * 1024; const float* cb = p.conv_b + l * 1024;
    const int nthr = gridDim.x * 512;
    for (int u = blockIdx.x * 512 + tx_; u < (TP / 4) * 128; u += nthr) {
        const int ch = (u & 127) * 8, tg = u >> 7, tok0 = tg * 4, tt0 = tok0 & (SEQ - 1);
        u32x4 raw[8];
#pragma unroll
        for (int r = 0; r < 8; ++r) { const int tt = tt0 - 2 + r; raw[r] = (u32x4){0u, 0u, 0u, 0u};
            if (tt >= 0 && tt < SEQ) raw[r] = *(const u32x4*)(XBC + (size_t)(tok0 - 2 + r) * 1024 + ch); }
        float ac[4][8];
        { const f32x4 a = *(const f32x4*)(cb + ch), b2 = *(const f32x4*)(cb + ch + 4);
#pragma unroll
          for (int t = 0; t < 4; ++t) { ac[t][0] = a.x; ac[t][1] = a.y; ac[t][2] = a.z; ac[t][3] = a.w; ac[t][4] = b2.x; ac[t][5] = b2.y; ac[t][6] = b2.z; ac[t][7] = b2.w; } }
#pragma unroll
        for (int k = 0; k < 5; ++k) { const f32x4 wa = *(const f32x4*)(cw + k * 1024 + ch), wb = *(const f32x4*)(cw + k * 1024 + ch + 4);
#pragma unroll
            for (int t = 0; t < 4; ++t) { const u32x4 v = raw[t + k];
                ac[t][0] += bflo(v.x) * wa.x; ac[t][1] += bfhi(v.x) * wa.y; ac[t][2] += bflo(v.y) * wa.z; ac[t][3] += bfhi(v.y) * wa.w;
                ac[t][4] += bflo(v.z) * wb.x; ac[t][5] += bfhi(v.z) * wb.y; ac[t][6] += bflo(v.w) * wb.z; ac[t][7] += bfhi(v.w) * wb.w; } }
#pragma unroll
        for (int t = 0; t < 4; ++t) { u32x4 o;
            o.x = pk2(siluf(ac[t][0]), siluf(ac[t][1])); o.y = pk2(siluf(ac[t][2]), siluf(ac[t][3])); o.z = pk2(siluf(ac[t][4]), siluf(ac[t][5])); o.w = pk2(siluf(ac[t][6]), siluf(ac[t][7]));
            *(u32x4*)(XC + (size_t)(tok0 + t) * 1024 + ch) = o; }
    }
}

constexpr int SS_BS = 0, SS_CS = 8704, SS_XS = 17408, SS_XWS = 22016, SS_GS = 26624, SS_SB = 29184, SS_CW = 46592, SS_SC = 54272, SS_DTA = 55296, SS_END = 57344;

template <int PASS>
__device__ void ssd_item(const Params& p, int item, int l, unsigned char* smem) {
    int tid_ = VTID; asm volatile("" : "+v"(tid_));
    const int tid = tid_, lane = tid & 63, w = tid >> 6, idx = lane & 15, kq = lane >> 4;
    const int seg = item & 15, h = (item >> 4) & 7, dir = (item >> 7) & 1, b = item >> 8, grp = h >> 2;
    bf16_t* Bs = (bf16_t*)(smem + SS_BS); bf16_t* Cs = (bf16_t*)(smem + SS_CS); bf16_t* Xs = (bf16_t*)(smem + SS_XS); bf16_t* Xws = (bf16_t*)(smem + SS_XWS);
    bf16_t* Gs = (bf16_t*)(smem + SS_GS); bf16_t* Sb = (bf16_t*)(smem + SS_SB); float* sc = (float*)(smem + SS_SC);
    float* s_cA = (float*)(smem + SS_CW), *s_rsA = s_cA + SEGLEN, *s_wlA = s_rsA + SEGLEN, *s_totA = sc;
    const bf16_t* XBC = (const bf16_t*)(p.ws + WS_XBC);
    const float* DT = (const float*)(p.ws + WS_DT);
    float* ST = (float*)(p.ws + WS_ST); float* SEGT = (float*)(p.ws + WS_SEGT);
    bf16_t* Y = (bf16_t*)(p.ws + (dir ? WS_YS : WS_YF));
    const float Aneg = -__expf(p.a_log[l * 16 + dir * 8 + h]);
    const float Dh = p.d_skip[l * 8 + h];
    __syncthreads();
    f32x4 S[8];
#pragma unroll
    for (int nt = 0; nt < 8; ++nt) S[nt] = (f32x4){0.f, 0.f, 0.f, 0.f};
    const int ibase = item & ~15;
    if (PASS == 3) {
        if (dir == 0) {
            for (int e = 0; e < seg; ++e) { const float dc = __expf(SEGT[ibase + e]); const f32x4* src = (const f32x4*)(ST + (size_t)(ibase + e) * 8192);
#pragma unroll
                for (int nt = 0; nt < 8; ++nt) S[nt] = S[nt] * dc + src[(w * 8 + nt) * 64 + lane]; }
        } else {
            for (int e = NSEG - 1; e > seg; --e) { const float dc = __expf(SEGT[ibase + e]); const f32x4* src = (const f32x4*)(ST + (size_t)(ibase + e) * 8192);
#pragma unroll
                for (int nt = 0; nt < 8; ++nt) S[nt] = S[nt] * dc + src[(w * 8 + nt) * 64 + lane]; }
        }
#pragma unroll
        for (int nt = 0; nt < 8; ++nt) st4bf(Sb + (16 * w + idx) * 136 + 16 * nt + 4 * kq, S[nt]);
    }
    float* s_dta = (float*)(smem + SS_DTA);
#pragma unroll
    for (int i = 0; i < SEGLEN / 256; ++i) {
        const int e = tid + 256 * i, l32 = lane & 31;
        const float dtv = DT[((size_t)b * SEQ + seg * SEGLEN + e) * 16 + dir * 8 + h], av = dtv * Aneg;
        float pre = av;
#pragma unroll
        for (int o = 1; o < 32; o <<= 1) { const float t = __shfl_up(pre, o, 32); if (l32 >= o) pre += t; }
        const float tot = __shfl(pre, 31, 32);
        const float cc = dir ? (tot - pre + av) : pre;
        s_dta[e] = dtv; s_cA[e] = cc; s_rsA[e] = __expf(cc); s_wlA[e] = dtv * __expf(tot - cc);
        if (l32 == 0) s_totA[e >> 5] = tot;
    }
    float segtot = 0.f;
    const size_t tokb = (size_t)b * SEQ;
    const unsigned char* xb_ = (const unsigned char*)((const bf16_t*)(p.ws + WS_XBCC) + tokb * 1024);
    unsigned soff[5];
#pragma unroll
    for (int i = 0; i < 5; ++i) { const int u = tid + 256 * i, lrow = u / 40, ci = u % 40;
        const int scol = ci < 8 ? h * 64 + ci * 8 : (ci < 24 ? 512 + grp * 128 + (ci * 8 - 64) : 768 + grp * 128 + (ci * 8 - 192));
        soff[i] = (unsigned)((lrow * 1024 + scol) * 2); }
    for (int si = 0; si < NSUB; ++si) {
        const int scn = dir ? (NSUB - 1 - si) : si;
        const int t0 = seg * SEGLEN + scn * TSUB;
        __syncthreads();
        u32x4 raw[5];
#pragma unroll
        for (int i = 0; i < 5; ++i) raw[i] = *(const u32x4*)(xb_ + ((unsigned)(t0 * 2048) + soff[i]));
        const float* s_dt = s_dta + scn * TSUB; const float* s_c = s_cA + scn * TSUB; const float* s_rs = s_rsA + scn * TSUB; const float* s_wl = s_wlA + scn * TSUB;
        const float stot = s_totA[scn];
        segtot += stot;
#pragma unroll
        for (int i = 0; i < 5; ++i) { const int u = tid + 256 * i, lrow = u / 40, ci = u % 40, lc = ci * 8; const u32x4 o = raw[i];
            if (ci < 8) { *(u32x4*)(Xs + lrow * 72 + lc) = o; const float wl = s_wl[lrow];
                u32x4 o2; o2.x = pk2(bflo(o.x) * wl, bfhi(o.x) * wl); o2.y = pk2(bflo(o.y) * wl, bfhi(o.y) * wl); o2.z = pk2(bflo(o.z) * wl, bfhi(o.z) * wl); o2.w = pk2(bflo(o.w) * wl, bfhi(o.w) * wl);
                *(u32x4*)(Xws + lrow * 72 + lc) = o2; }
            else if (ci < 24) *(u32x4*)(Bs + lrow * 136 + (lc - 64)) = o;
            else *(u32x4*)(Cs + lrow * 136 + (lc - 192)) = o; }
        __syncthreads();
        if (PASS == 3) {
            const int it = w >> 1, jt = w & 1;
            f32x4 cb = (f32x4){0.f, 0.f, 0.f, 0.f};
            {
                bf16x8 fb[4], fc[4];
#pragma unroll
                for (int ks = 0; ks < 4; ++ks) { fb[ks] = *(const bf16x8*)(Bs + (16 * jt + idx) * 136 + ks * 32 + kq * 8); fc[ks] = *(const bf16x8*)(Cs + (16 * it + idx) * 136 + ks * 32 + kq * 8); }
                __builtin_amdgcn_sched_barrier(0);
#pragma unroll
                for (int ks = 0; ks < 4; ++ks) cb = __builtin_amdgcn_mfma_f32_16x16x32_bf16(fb[ks], fc[ks], cb, 0, 0, 0);
                __builtin_amdgcn_sched_barrier(0);
            }
            {
                const int ii = 16 * it + idx; const float ci_ = s_c[ii];
                f32x4 gv;
#pragma unroll
                for (int rg = 0; rg < 4; ++rg) {
                    const int jj = 16 * jt + 4 * kq + rg;
                    const bool ok = dir ? (jj >= ii) : (jj <= ii);
                    const float e = __expf(ci_ - s_c[jj]) * s_dt[jj];
                    gv[rg] = ok ? cb[rg] * e : 0.f;
                }
                st4bf(Gs + ii * 40 + 16 * jt + 4 * kq, gv);
            }
            __syncthreads();
            const unsigned char* xtr = (const unsigned char*)Xs + (8 * kq + (idx >> 2)) * 144 + (16 * w + 4 * (idx & 3)) * 2;
            const bf16x8 xf = cat8(tr16(xtr), tr16(xtr + 4 * 144));
#pragma unroll 1
            for (int it2 = 0; it2 < 2; ++it2) {
                const int ii = 16 * it2 + idx;
                const bf16x8 gf = *(const bf16x8*)(Gs + ii * 40 + 8 * kq);
                f32x4 yd = (f32x4){0.f, 0.f, 0.f, 0.f}, yo = (f32x4){0.f, 0.f, 0.f, 0.f};
                bf16x8 sf[4], cf[4];
#pragma unroll
                for (int ks = 0; ks < 4; ++ks) { sf[ks] = *(const bf16x8*)(Sb + (16 * w + idx) * 136 + ks * 32 + kq * 8); cf[ks] = *(const bf16x8*)(Cs + ii * 136 + ks * 32 + kq * 8); }
                __builtin_amdgcn_sched_barrier(0);
                yd = __builtin_amdgcn_mfma_f32_16x16x32_bf16(xf, gf, yd, 0, 0, 0);
#pragma unroll
                for (int ks = 0; ks < 4; ++ks) yo = __builtin_amdgcn_mfma_f32_16x16x32_bf16(sf[ks], cf[ks], yo, 0, 0, 0);
                __builtin_amdgcn_sched_barrier(0);
                f32x4 y = yd + yo * s_rs[ii];
                if (dir == 0) { const u32x2 xv = *(const u32x2*)(Xs + ii * 72 + 16 * w + 4 * kq);
                    y.x += Dh * bflo(xv.x); y.y += Dh * bfhi(xv.x); y.z += Dh * bflo(xv.y); y.w += Dh * bfhi(xv.y); }
                st4bf(Y + (tokb + t0 + ii) * 512 + h * 64 + 16 * w + 4 * kq, y);
            }
        }
        {
            const float dc = __expf(stot);
            const unsigned char* xw = (const unsigned char*)Xws + (8 * kq + (idx >> 2)) * 144 + (16 * w + 4 * (idx & 3)) * 2;
            const bf16x8 xwf = cat8(tr16(xw), tr16(xw + 4 * 144));
            bf16x8 bfv[8];
#pragma unroll
            for (int nt = 0; nt < 8; ++nt) {
                const unsigned char* bt = (const unsigned char*)Bs + (8 * kq + (idx >> 2)) * 272 + (16 * nt + 4 * (idx & 3)) * 2;
                bfv[nt] = cat8(tr16(bt), tr16(bt + 4 * 272));
            }
            __builtin_amdgcn_sched_barrier(0);
#pragma unroll
            for (int nt = 0; nt < 8; ++nt) S[nt] = __builtin_amdgcn_mfma_f32_16x16x32_bf16(bfv[nt], xwf, S[nt] * dc, 0, 0, 0);
            __builtin_amdgcn_sched_barrier(0);
            if (PASS == 3) {
#pragma unroll
                for (int nt = 0; nt < 8; ++nt) st4bf(Sb + (16 * w + idx) * 136 + 16 * nt + 4 * kq, S[nt]);
            }
        }
    }
    if (PASS == 1) {
        f32x4* dst = (f32x4*)(ST + (size_t)item * 8192);
#pragma unroll
        for (int nt = 0; nt < 8; ++nt) dst[(w * 8 + nt) * 64 + lane] = S[nt];
        if (tid == 0) SEGT[item] = segtot;
    }
}

__device__ void post2_phase(const Params& p) {
    int tx_ = threadIdx.x; asm volatile("" : "+v"(tx_));
    const int lane = tx_ & 63, gw = blockIdx.x * 8 + (tx_ >> 6), nw = gridDim.x * 8;
    const bf16_t* OB = (const bf16_t*)(p.ws + WS_QB); const float* LSE = (const float*)(p.ws + WS_LSE);
    const bf16_t* GB = (const bf16_t*)(p.ws + WS_GB);
    bf16_t* YBM = (bf16_t*)(p.ws + WS_YBM);
    const bf16_t* YF = (const bf16_t*)(p.ws + WS_YF); const bf16_t* YS = (const bf16_t*)(p.ws + WS_YS); const bf16_t* ZS = (const bf16_t*)(p.ws + WS_ZS);
    bf16_t* YC = (bf16_t*)(p.ws + WS_YC); float* RS = (float*)(p.ws + WS_RSTD);
    constexpr int R = 4;
    for (int row0 = gw; row0 < TP; row0 += R * nw) {
        float ls[R][3]; u32x2 ov[R][3], gt[R]; u32x4 a[R], bq[R], z[R];
        const int j = lane >> 4;
#pragma unroll
        for (int q = 0; q < R; ++q) { const int row = row0 + q * nw; if (row < TP) {
            const int bl = row >> 13, tt = row & (SEQ - 1);
#pragma unroll
            for (int g = 0; g < 3; ++g) { const int sh = 2 * g; const int pp = (tt & ((1 << sh) - 1)) * (SEQ >> sh) + (tt >> sh);
                const size_t ro = (size_t)(bl * 3 + g) * SEQ + pp; ls[q][g] = LSE[ro * 4 + j]; ov[q][g] = *(const u32x2*)(OB + ro * 256 + 4 * lane); }
            gt[q] = *(const u32x2*)(GB + (size_t)row * 256 + 4 * lane);
            a[q] = *(const u32x4*)(YF + (size_t)row * 512 + 8 * lane); bq[q] = *(const u32x4*)(YS + (size_t)row * 512 + 8 * lane); z[q] = *(const u32x4*)(ZS + (size_t)row * 512 + 8 * lane); } }
#pragma unroll
        for (int q = 0; q < R; ++q) { const int row = row0 + q * nw; if (row < TP) {
            const float mx = fmaxf(ls[q][0], fmaxf(ls[q][1], ls[q][2]));
            float wg[3]; float ws = 0.f;
#pragma unroll
            for (int g = 0; g < 3; ++g) { wg[g] = __expf(ls[q][g] - mx); ws += wg[g]; }
            const float inv = 1.f / ws;
            f32x4 acc = (f32x4){0.f, 0.f, 0.f, 0.f};
#pragma unroll
            for (int g = 0; g < 3; ++g) { const u32x2 v = ov[q][g]; const float wv = wg[g] * inv;
                acc.x += wv * bflo(v.x); acc.y += wv * bfhi(v.x); acc.z += wv * bflo(v.y); acc.w += wv * bfhi(v.y); }
            acc.x *= bflo(gt[q].x); acc.y *= bfhi(gt[q].x); acc.z *= bflo(gt[q].y); acc.w *= bfhi(gt[q].y);
            st4bf(YBM + (size_t)row * 256 + 4 * lane, acc);
            float y[8];
            y[0] = (bflo(a[q].x) + bflo(bq[q].x)) * bflo(z[q].x); y[1] = (bfhi(a[q].x) + bfhi(bq[q].x)) * bfhi(z[q].x);
            y[2] = (bflo(a[q].y) + bflo(bq[q].y)) * bflo(z[q].y); y[3] = (bfhi(a[q].y) + bfhi(bq[q].y)) * bfhi(z[q].y);
            y[4] = (bflo(a[q].z) + bflo(bq[q].z)) * bflo(z[q].z); y[5] = (bfhi(a[q].z) + bfhi(bq[q].z)) * bfhi(z[q].z);
            y[6] = (bflo(a[q].w) + bflo(bq[q].w)) * bflo(z[q].w); y[7] = (bfhi(a[q].w) + bfhi(bq[q].w)) * bfhi(z[q].w);
            float ss = 0.f;
#pragma unroll
            for (int e = 0; e < 8; ++e) ss += y[e] * y[e];
            ss = wave_sum(ss);
            u32x4 o; o.x = pk2(y[0], y[1]); o.y = pk2(y[2], y[3]); o.z = pk2(y[4], y[5]); o.w = pk2(y[6], y[7]);
            *(u32x4*)(YC + (size_t)row * 512 + 8 * lane) = o;
            if (lane == 0) RS[row] = rsqrtf(ss * (1.f / 512.f) + EPS);
        } }
    }
}


#define XB_TMO      128
#define XB_XCNT(j)  (256  + 64 * (j))
#define XB_XSUB(j)  (1280 + 64 * (j))
#define XB_XGEN(j)  (2304 + 64 * (j))
#define XB_TOP      3328
#define XB_TOPGEN   3392
#define XCD_BAR_WORDS 3456
#define XB_SPIN_CAP (1u << 20)
__device__ __forceinline__ unsigned xb_ld(unsigned* p)              { return __hip_atomic_load(p, __ATOMIC_RELAXED, __HIP_MEMORY_SCOPE_AGENT); }
__device__ __forceinline__ unsigned xb_add(unsigned* p, unsigned v) { return __hip_atomic_fetch_add(p, v, __ATOMIC_RELAXED, __HIP_MEMORY_SCOPE_AGENT); }
__device__ __forceinline__ unsigned xb_xcc_id() { return (unsigned)__builtin_amdgcn_s_getreg((3 << 11) | 20) & 0xFu; }
#define XB_SPIN(cond, bar) do { unsigned _sp = 0; while (cond) { __builtin_amdgcn_s_sleep(1); \
    if ((++_sp & 255u) == 0u) { if (xb_ld(&(bar)[XB_TMO])) break; if (_sp > XB_SPIN_CAP) { atomicAdd(&(bar)[XB_TMO], 1u); break; } } } } while (0)
struct XcdBarrier { unsigned* bar; unsigned x; volatile LDSAS unsigned* st; };
__device__ __forceinline__ XcdBarrier xcd_barrier_post(unsigned* bar, volatile LDSAS unsigned* st) {
    XcdBarrier b; b.bar = bar; b.x = xb_xcc_id(); b.st = st;
    if (threadIdx.x == 0) (void)xb_add(&bar[XB_XCNT(b.x)], 1u);
    return b;
}
__device__ __forceinline__ void xcd_barrier_complete(unsigned* bar, unsigned x, unsigned& nloc, unsigned& nx) {
    const unsigned G = gridDim.x * gridDim.y * gridDim.z;
    unsigned sum, cnt, mine, sp = 0u;
    for (;;) {
        sum = 0u; cnt = 0u; mine = 0u;
#pragma unroll
        for (unsigned j = 0; j < 16; ++j) { const unsigned c = xb_ld(&bar[XB_XCNT(j)]); sum += c; cnt += (c > 0u) ? 1u : 0u; mine = (j == x) ? c : mine; }
        if (sum == G) break;
        __builtin_amdgcn_s_sleep(1);
        if ((++sp & 255u) == 0u) { if (xb_ld(&bar[XB_TMO])) break; if (sp > XB_SPIN_CAP) { atomicAdd(&bar[XB_TMO], 1u); break; } }
    }
    nloc = mine > 0u ? mine : 1u; nx = cnt > 0u ? cnt : 1u;
}
__device__ __forceinline__ void xcd_barrier(const XcdBarrier& b) {
    asm volatile("s_waitcnt vmcnt(0)" ::: "memory");
    __syncthreads();
    if (threadIdx.x == 0) {
        unsigned* bar = b.bar;
        __builtin_amdgcn_s_waitcnt(0);
        unsigned nloc = b.st[0], nx = b.st[1];
        if (nloc == 0u) { xcd_barrier_complete(bar, b.x, nloc, nx); b.st[0] = nloc; b.st[1] = nx; }
        const unsigned old = xb_add(&bar[XB_XSUB(b.x)], 1u);
        const unsigned gen = old / nloc;
        if (old + 1u == (gen + 1u) * nloc) {
            __builtin_amdgcn_fence(__ATOMIC_RELEASE, "agent");
            asm volatile("s_waitcnt vmcnt(0)" ::: "memory");
            const unsigned og = xb_add(&bar[XB_TOP], 1u);
            const unsigned tg = og / nx;
            if (og + 1u == (tg + 1u) * nx) xb_add(&bar[XB_TOPGEN], 1u);
            else XB_SPIN(xb_ld(&bar[XB_TOPGEN]) == tg, bar);
            __builtin_amdgcn_fence(__ATOMIC_ACQUIRE, "agent");
            xb_add(&bar[XB_XGEN(b.x)], 1u);
            asm volatile("s_waitcnt vmcnt(0)" ::: "memory");
        } else {
            XB_SPIN(xb_ld(&bar[XB_XGEN(b.x)]) == gen, bar);
            __builtin_amdgcn_fence(__ATOMIC_ACQUIRE, "agent");
            asm volatile("s_waitcnt vmcnt(0)" ::: "memory");
        }
    }
    __syncthreads();
}

__device__ __forceinline__ unsigned char* lds_half(unsigned char* smem) { int h_ = threadIdx.x >> 8; asm volatile("" : "+v"(h_)); return smem + h_ * HALF_LDS; }
__global__ void __launch_bounds__(512, 2) hybrid_fwd(Params p) {
    cg::grid_group grid = cg::this_grid();
    extern __shared__ __attribute__((aligned(16))) unsigned char smem[];
    volatile LDSAS unsigned* bst = (volatile LDSAS unsigned*)(smem + LDS_TOTAL - 16);
    if (threadIdx.x < 4) bst[threadIdx.x] = 0u;
    __syncthreads();
    const XcdBarrier xbar = xcd_barrier_post((unsigned*)(p.ws + WS_BAR), bst);
    { const Params q = launder(p); phase0(q, lds_half(smem)); }
    grid.sync();
#pragma unroll 1
    for (int l = 0; l < DEPTH; ++l) {
#pragma unroll 1
        for (int hb = 0; hb < 2; ++hb) {
            { const Params q = launder(p); norm_phase(q, l, hb, (l == 0) ? q.x : q.out); }
            xcd_barrier(xbar);
            { const Params q = launder(p); gemm1_phase(q, l, hb, smem); }
            xcd_barrier(xbar);
            { const Params q = launder(p); conv_phase(q, l); }
            xcd_barrier(xbar);
            { const Params q = launder(p); unsigned char* smh = lds_half(smem);
#pragma unroll 1
              for (int it = VBLK; it < 512; it += VGRID) ssd_item<1>(q, it, l, smh);
#pragma unroll 1
              for (int it = blockIdx.x; it < 768; it += gridDim.x) attn_b_item(q, it, l, smem); }
            xcd_barrier(xbar);
            { const Params q = launder(p);
#pragma unroll 1
              for (int it = blockIdx.x; it < 512; it += gridDim.x) attn_a_item(q, it, l, smem);
              unsigned char* smh = lds_half(smem);
#pragma unroll 1
              for (int it = VBLK; it < 512; it += VGRID) ssd_item<3>(q, it, l, smh); }
            xcd_barrier(xbar);
            { const Params q = launder(p); post2_phase(q); }
            xcd_barrier(xbar);
            { const Params q = launder(p); merge_phase(q, l, smem); }
            xcd_barrier(xbar);
            { const Params q = launder(p); out_phase(q, l, hb, (l == 0) ? q.x : q.out, smem); }
        }
    }
}

extern "C" void kernel_launch(void* const* d_in, const int* in_sizes, int n_in, void* d_out, int out_size, void* d_ws, size_t ws_size, hipStream_t stream) {
    static int grid_blocks = 0;
    if (!grid_blocks) {
        int dev = 0, cus = 0, per_cu = 0;
        hipGetDevice(&dev);
        hipDeviceGetAttribute(&cus, hipDeviceAttributeMultiprocessorCount, dev);
        hipFuncSetAttribute((const void*)hybrid_fwd, hipFuncAttributeMaxDynamicSharedMemorySize, LDS_TOTAL);
        hipOccupancyMaxActiveBlocksPerMultiprocessor(&per_cu, hybrid_fwd, 512, LDS_TOTAL);
        if (per_cu > 1) per_cu = 1;
        if (per_cu < 1) per_cu = 1;
        grid_blocks = cus * per_cu;
    }
    Params p{};
    const float** pp = (const float**)&p;
    for (int i = 0; i < 22; ++i) pp[i] = (const float*)d_in[i];
    p.out = (float*)d_out; p.ws = (unsigned char*)d_ws;
    hipMemsetAsync((unsigned char*)d_ws + WS_BAR, 0, XCD_BAR_WORDS * 4, stream);
    void* args[] = {&p};
    hipError_t e = hipLaunchCooperativeKernel((void*)hybrid_fwd, dim3(grid_blocks), dim3(512), args, LDS_TOTAL, stream);
    if (e != hipSuccess) fprintf(stderr, "cooperative launch failed: %s (grid %d)\n", hipGetErrorString(e), grid_blocks);
}
```

```cpp
#include <hip/hip_runtime.h>
#include <hip/hip_cooperative_groups.h>
#include <cstdint>
#include <cstdio>
namespace cg = cooperative_groups;

typedef unsigned short bf16_t;
typedef short bf16x8 __attribute__((ext_vector_type(8)));
typedef short v4i16 __attribute__((ext_vector_type(4)));
typedef float f32x2 __attribute__((ext_vector_type(2)));
typedef float f32x4 __attribute__((ext_vector_type(4)));
typedef float f32x16 __attribute__((ext_vector_type(16)));
typedef unsigned u32x2 __attribute__((ext_vector_type(2)));
typedef unsigned u32x4 __attribute__((ext_vector_type(4)));
typedef __bf16 bf16x2_t __attribute__((ext_vector_type(2)));
#define LDSAS __attribute__((address_space(3)))
#define VTID ((int)(threadIdx.x & 255u))
__device__ __forceinline__ int vblk_() { int h_ = threadIdx.x >> 8; asm volatile("" : "+v"(h_)); return __builtin_amdgcn_readfirstlane(2 * (int)blockIdx.x + h_); }
#define VBLK vblk_()
#define VGRID ((int)(2u * gridDim.x))
constexpr int HALF_LDS = 73728, LDS_TOTAL = 147456;

constexpr int SEQ = 8192, DM = 1024, NBATCH = 4, NBH = 2, TP = NBH * SEQ, DEPTH = 2;
constexpr int NP = 8704;
constexpr float EPS = 1e-6f;
constexpr float LOG2E = 1.4426950408889634f, LN2 = 0.6931471805599453f;
constexpr int NSEG = 16, SEGLEN = 512, TSUB = 32, NSUB = SEGLEN / TSUB;

constexpr size_t MiB = 1u << 20;
constexpr size_t WS_WIN = 0;
constexpr size_t WS_WPA = 34 * MiB;
constexpr size_t WS_WPB = 36 * MiB;
constexpr size_t WS_WPC = 37 * MiB;
constexpr size_t WS_WOUT = 39 * MiB;
constexpr size_t WS_MOD = 43 * MiB;
constexpr size_t WS_ROPE = 43 * MiB + 128 * 1024;
constexpr size_t WS_BND = 43 * MiB + 160 * 1024;
constexpr size_t WS_RSTD = 43 * MiB + 256 * 1024;
constexpr size_t WS_SEGT = 43 * MiB + 512 * 1024;
constexpr size_t WS_LSE = 44 * MiB;
constexpr size_t WS_DT = 45 * MiB;
constexpr size_t WS_BAR = 46 * MiB;
constexpr size_t WS_H = 48 * MiB;
constexpr size_t WS_QA = 80 * MiB;
constexpr size_t WS_KA = 96 * MiB;
constexpr size_t WS_VA = 100 * MiB;
constexpr size_t WS_GA = 104 * MiB;
constexpr size_t WS_QB = 120 * MiB;
constexpr size_t WS_KB = 144 * MiB;
constexpr size_t WS_VB = 168 * MiB;
constexpr size_t WS_GB = 192 * MiB;
constexpr size_t WS_XBC = 200 * MiB;
constexpr size_t WS_ZS = 232 * MiB;
constexpr size_t WS_MG = 248 * MiB;
constexpr size_t WS_YF = 344 * MiB;
constexpr size_t WS_YS = 360 * MiB;
constexpr size_t WS_YBM = 376 * MiB;
constexpr size_t WS_YC = 384 * MiB;
constexpr size_t WS_MRG = 400 * MiB;
constexpr size_t WS_ST = 432 * MiB;
constexpr size_t WS_XBCC = 448 * MiB;

struct Params {
    const float *x, *c, *norm_w, *w_ada, *b_ada, *w_in, *b_gate, *q_norm_a, *k_norm_a, *q_norm_b, *k_norm_b, *rel_bias,
        *conv_w, *conv_b, *a_log, *dt_bias, *d_skip, *ssm_norm_w, *w_proj_a, *w_proj_b, *w_proj_c, *w_out;
    float* out;
    unsigned char* ws;
};


#define AS1 __attribute__((address_space(1)))
#define GLOBF(f) do { AS1 const float* g_ = (AS1 const float*)p.f; asm volatile("" : "+s"(g_)); q.f = (const float*)g_; } while (0)
__device__ __forceinline__ Params launder(const Params& p) {
    Params q;
    GLOBF(x); GLOBF(c); GLOBF(norm_w); GLOBF(w_ada); GLOBF(b_ada); GLOBF(w_in); GLOBF(b_gate); GLOBF(q_norm_a); GLOBF(k_norm_a); GLOBF(q_norm_b); GLOBF(k_norm_b); GLOBF(rel_bias);
    GLOBF(conv_w); GLOBF(conv_b); GLOBF(a_log); GLOBF(dt_bias); GLOBF(d_skip); GLOBF(ssm_norm_w); GLOBF(w_proj_a); GLOBF(w_proj_b); GLOBF(w_proj_c); GLOBF(w_out);
    { AS1 float* g_ = (AS1 float*)p.out; asm volatile("" : "+s"(g_)); q.out = (float*)g_; }
    { AS1 unsigned char* g_ = (AS1 unsigned char*)p.ws; asm volatile("" : "+s"(g_)); q.ws = (unsigned char*)g_; }
    return q;
}
__device__ __forceinline__ unsigned pk2(float lo, float hi) { f32x2 v = {lo, hi}; bf16x2_t b = __builtin_convertvector(v, bf16x2_t); return __builtin_bit_cast(unsigned, b); }
__device__ __forceinline__ float bf2f(unsigned short b) { return __uint_as_float(((unsigned)b) << 16); }
__device__ __forceinline__ float bflo(unsigned u) { return __uint_as_float(u << 16); }
__device__ __forceinline__ float bfhi(unsigned u) { return __uint_as_float(u & 0xffff0000u); }
__device__ __forceinline__ float siluf(float v) { return v * __builtin_amdgcn_rcpf(1.f + __builtin_amdgcn_exp2f(-1.4426950408889634f * v)); }
__device__ __forceinline__ float sigmf(float v) { return __builtin_amdgcn_rcpf(1.f + __builtin_amdgcn_exp2f(-1.4426950408889634f * v)); }
__device__ __forceinline__ float wave_sum(float v) {
#pragma unroll
    for (int o = 1; o < 64; o <<= 1) v += __shfl_xor(v, o);
    return v;
}
__device__ __forceinline__ v4i16 tr16(const unsigned char* p) { return __builtin_amdgcn_ds_read_tr16_b64_v4i16((LDSAS v4i16*)p); }
__device__ __forceinline__ bf16x8 cat8(v4i16 a, v4i16 b) { return (bf16x8){a[0], a[1], a[2], a[3], b[0], b[1], b[2], b[3]}; }
__device__ __forceinline__ int crow(int r, int hi) { return (r & 3) + 8 * (r >> 2) + 4 * hi; }

struct P0It { const float* W; bf16_t* Wt; const float* rs; int ldw, K, k0, n0, mode; };
__device__ __forceinline__ void p0_load(const P0It& t, float (&vv)[16]) {
    const int tid = VTID, tx = tid & 63, ty = tid >> 6;
    const int np = t.n0 + tx; int n = np; bool valid = true;
    if (t.mode == 1) {
        if (np < 4352) n = np; else if (np < 4864) n = np + 512; else if (np < 5376) n = np - 512;
        else if (np < 8448) n = np + 16; else if (np < 8464) n = np - 3072; else { valid = false; n = 0; }
    }
#pragma unroll
    for (int i = 0; i < 16; ++i) { const int k = ty + 4 * i; vv[i] = valid ? t.W[(size_t)(t.k0 + k) * t.ldw + n] : 0.f; }
}
__device__ __forceinline__ void p0_finish(const P0It& t, const float (&vv)[16], float* tile) {
    const int tid = VTID, tx = tid & 63, ty = tid >> 6;
#pragma unroll
    for (int i = 0; i < 16; ++i) { const int k = ty + 4 * i; float v = vv[i]; if (t.rs) v *= t.rs[t.k0 + k]; tile[k * 65 + tx] = v; }
    __syncthreads();
    const int r = tid >> 2, kc = (tid & 3) * 16;
    u32x4 o0, o1;
    o0.x = pk2(tile[(kc + 0) * 65 + r], tile[(kc + 1) * 65 + r]); o0.y = pk2(tile[(kc + 2) * 65 + r], tile[(kc + 3) * 65 + r]);
    o0.z = pk2(tile[(kc + 4) * 65 + r], tile[(kc + 5) * 65 + r]); o0.w = pk2(tile[(kc + 6) * 65 + r], tile[(kc + 7) * 65 + r]);
    o1.x = pk2(tile[(kc + 8) * 65 + r], tile[(kc + 9) * 65 + r]); o1.y = pk2(tile[(kc + 10) * 65 + r], tile[(kc + 11) * 65 + r]);
    o1.z = pk2(tile[(kc + 12) * 65 + r], tile[(kc + 13) * 65 + r]); o1.w = pk2(tile[(kc + 14) * 65 + r], tile[(kc + 15) * 65 + r]);
    bf16_t* dst = t.Wt + (size_t)(t.n0 + r) * t.K + t.k0 + kc;
    *(u32x4*)dst = o0; *(u32x4*)(dst + 8) = o1;
    __syncthreads();
}
constexpr int P0_IN = 16 * 136, P0_PA = 8 * 16, P0_PB = 4 * 16, P0_PC = 8 * 16, P0_OUT = 16 * 16, P0_L = P0_IN + P0_PA + P0_PB + P0_PC + P0_OUT;
__device__ __forceinline__ P0It p0_params(const Params& p, int item) {
    P0It t; const int l = item / P0_L; int r = item % P0_L; t.rs = nullptr; t.mode = 0;
    if (r < P0_IN) { t.W = p.w_in + (size_t)l * 1024 * 8464; t.ldw = 8464; t.K = 1024; t.Wt = (bf16_t*)(p.ws + WS_WIN) + (size_t)l * NP * 1024; t.k0 = (r / 136) * 64; t.n0 = (r % 136) * 64; t.mode = 1; return t; }
    r -= P0_IN;
    if (r < P0_PA) { t.W = p.w_proj_a + (size_t)l * 512 * 1024; t.ldw = 1024; t.K = 512; t.Wt = (bf16_t*)(p.ws + WS_WPA) + (size_t)l * 1024 * 512; t.k0 = (r / 16) * 64; t.n0 = (r % 16) * 64; return t; }
    r -= P0_PA;
    if (r < P0_PB) { t.W = p.w_proj_b + (size_t)l * 256 * 1024; t.ldw = 1024; t.K = 256; t.Wt = (bf16_t*)(p.ws + WS_WPB) + (size_t)l * 1024 * 256; t.k0 = (r / 16) * 64; t.n0 = (r % 16) * 64; return t; }
    r -= P0_PB;
    if (r < P0_PC) { t.W = p.w_proj_c + (size_t)l * 512 * 1024; t.ldw = 1024; t.K = 512; t.Wt = (bf16_t*)(p.ws + WS_WPC) + (size_t)l * 1024 * 512; t.k0 = (r / 16) * 64; t.n0 = (r % 16) * 64; t.rs = p.ssm_norm_w + l * 512; return t; }
    r -= P0_PC;
    t.W = p.w_out + (size_t)l * 1024 * 1024; t.ldw = 1024; t.K = 1024; t.Wt = (bf16_t*)(p.ws + WS_WOUT) + (size_t)l * 1024 * 1024; t.k0 = (r / 16) * 64; t.n0 = (r % 16) * 64; return t;
}

__device__ void phase0(const Params& p, unsigned char* smem) {
    const int tid = VTID;
    float* tile = (float*)smem;
    constexpr int I_T = 2 * P0_L, I_MOD = 192, I_ALL = I_T + I_MOD + 1;
    {
        int item = VBLK;
        if (item < I_T) {
            P0It cur = p0_params(p, item); float va[16], vb[16]; p0_load(cur, va);
            for (;;) {
                const int nx = item + VGRID; const bool more = nx < I_T; P0It nxt = cur;
                if (more) { nxt = p0_params(p, nx); p0_load(nxt, vb); }
                p0_finish(cur, va, tile);
                if (!more) break;
                item = nx; cur = nxt;
#pragma unroll
                for (int i = 0; i < 16; ++i) va[i] = vb[i];
            }
        }
    }
    for (int item = VBLK; item < I_ALL; item += VGRID) {
        if (item < I_T) {
            continue;
        } else if (item < I_T + I_MOD) {
            const int it = item - I_T, l = it / 96, col0 = (it % 96) * 32, cl = tid & 31, ks = tid >> 5;
            float a0 = 0.f, a1 = 0.f, a2 = 0.f, a3 = 0.f;
            const float* wp = p.w_ada + ((size_t)l * 1024 + ks * 128) * 3072 + col0 + cl;
#pragma unroll 8
            for (int k = 0; k < 128; ++k) {
                const float wv = wp[(size_t)k * 3072]; const int kk = ks * 128 + k;
                a0 += siluf(p.c[kk]) * wv; a1 += siluf(p.c[1024 + kk]) * wv; a2 += siluf(p.c[2048 + kk]) * wv; a3 += siluf(p.c[3072 + kk]) * wv;
            }
            float* red = (float*)smem;
            red[(ks * 32 + cl) * 4 + 0] = a0; red[(ks * 32 + cl) * 4 + 1] = a1; red[(ks * 32 + cl) * 4 + 2] = a2; red[(ks * 32 + cl) * 4 + 3] = a3;
            __syncthreads();
            if (tid < 128) { const int b = tid >> 5, c2 = tid & 31; float s = 0.f;
#pragma unroll
                for (int k = 0; k < 8; ++k) s += red[(k * 32 + c2) * 4 + b];
                ((float*)(p.ws + WS_MOD))[(l * 4 + b) * 3072 + col0 + c2] = s + p.b_ada[l * 3072 + col0 + c2]; }
            __syncthreads();
        } else {
            float* rc = (float*)(p.ws + WS_ROPE); float* rs = rc + 128 * 16;
            for (int e = tid; e < 2048; e += 256) {
                const int pos = e >> 4, i = e & 15;
                const float freq = powf(10000.0f, -(float)i / 16.0f);
                const float ang = (float)pos * freq;
                const double rev = (double)ang * 0.15915494309189535; const double fr = rev - rint(rev);
                const float a = (float)(fr * 6.283185307179586);
                rc[e] = cosf(a); rs[e] = sinf(a);
            }
            if (tid < 2) {
                const int l = tid; float mqa = 0.f, mka = 0.f, mqb = 0.f, mkb = 0.f, mb = 0.f;
                for (int i = 0; i < 64; ++i) { mqa = fmaxf(mqa, fabsf(p.q_norm_a[l * 64 + i])); mka = fmaxf(mka, fabsf(p.k_norm_a[l * 64 + i]));
                    mqb = fmaxf(mqb, fabsf(p.q_norm_b[l * 64 + i])); mkb = fmaxf(mkb, fabsf(p.k_norm_b[l * 64 + i])); }
                for (int i = 0; i < 32 * 12; ++i) mb = fmaxf(mb, p.rel_bias[i]);
                float* bd = (float*)(p.ws + WS_BND);
                bd[l] = 8.f * mqa * mka * LOG2E; bd[2 + l] = (8.f * mqb * mkb + mb) * LOG2E;
            }
        }
    }
}

__device__ void norm_phase(const Params& p, int l, int hb, const float* xsrc) {
    int tx_ = threadIdx.x; asm volatile("" : "+v"(tx_));
    const int lane = tx_ & 63, gw = blockIdx.x * 8 + (tx_ >> 6), nw = gridDim.x * 8;
    bf16_t* H = (bf16_t*)(p.ws + WS_H);
    const float* nwp = p.norm_w + l * 1024;
    for (int row0 = gw; row0 < TP; row0 += 4 * nw) {
        f32x4 v[4][4];
#pragma unroll
        for (int q = 0; q < 4; ++q) { const int row = row0 + q * nw;
            if (row < TP) { const f32x4* xr = (const f32x4*)(xsrc + ((size_t)hb * TP + row) * 1024);
#pragma unroll
                for (int j = 0; j < 4; ++j) v[q][j] = xr[lane + 64 * j]; } }
#pragma unroll
        for (int q = 0; q < 4; ++q) { const int row = row0 + q * nw;
            if (row < TP) {
                const size_t rg = (size_t)hb * TP + row; const int b = (int)(rg / SEQ);
                const float* md = (const float*)(p.ws + WS_MOD) + (size_t)(l * 4 + b) * 3072;
                float ss = 0.f;
#pragma unroll
                for (int j = 0; j < 4; ++j) ss += v[q][j].x * v[q][j].x + v[q][j].y * v[q][j].y + v[q][j].z * v[q][j].z + v[q][j].w * v[q][j].w;
                ss = wave_sum(ss); const float rstd = rsqrtf(ss * (1.f / 1024.f) + EPS);
#pragma unroll
                for (int j = 0; j < 4; ++j) {
                    const int col = 4 * (lane + 64 * j);
                    const f32x4 w4 = *(const f32x4*)(nwp + col), sh = *(const f32x4*)(md + col), sc = *(const f32x4*)(md + 1024 + col);
                    const f32x4 o = v[q][j] * rstd * w4 * (1.f + sc) + sh;
                    u32x2 pk; pk.x = pk2(o.x, o.y); pk.y = pk2(o.z, o.w);
                    *(u32x2*)(H + (size_t)row * 1024 + col) = pk;
                }
            } }
    }
}

constexpr int G_STAGE = 65536, G_AB = 32768;
template <bool LOWREG = false>
__device__ __forceinline__ void gemm_core(const bf16_t* __restrict__ A, int lda, const bf16_t* __restrict__ Bt, int ldb, int K, f32x4 (&acc)[8][4], unsigned char* smem, int tid) {
    asm volatile("" : "+v"(tid));
    const int lane = tid & 63, w = __builtin_amdgcn_readfirstlane(tid >> 6), wm = w >> 2, wn = w & 3, idx = lane & 15, kq = lane >> 4;
    unsigned offA[4], offB[4];
#pragma unroll
    for (int j = 0; j < 4; ++j) { const int row = (j * 8 + w) * 8 + (lane >> 3), c = (lane & 7) ^ ((row >> 1) & 7);
        offA[j] = (unsigned)(row * lda + c * 8) * 2u; offB[j] = (unsigned)(row * ldb + c * 8) * 2u; }
#pragma unroll
    for (int mi = 0; mi < 8; ++mi)
#pragma unroll
        for (int ni = 0; ni < 4; ++ni) acc[mi][ni] = (f32x4){0.f, 0.f, 0.f, 0.f};
    LDSAS unsigned char* lds = (LDSAS unsigned char*)smem;
#define G_ISSUE1(kt, st, j) do { \
        __builtin_amdgcn_global_load_lds((const unsigned*)((const char*)A + offA[j] + (kt) * 128), (LDSAS unsigned*)(lds + (st) * G_STAGE + ((j) * 8 + w) * 1024), 16, 0, 0); \
        __builtin_amdgcn_global_load_lds((const unsigned*)((const char*)Bt + offB[j] + (kt) * 128), (LDSAS unsigned*)(lds + (st) * G_STAGE + G_AB + ((j) * 8 + w) * 1024), 16, 0, 0); } while (0)
#define G_ISSUE(kt, st) do { G_ISSUE1(kt, st, 0); G_ISSUE1(kt, st, 1); G_ISSUE1(kt, st, 2); G_ISSUE1(kt, st, 3); } while (0)
    const int nk = K >> 6;
    G_ISSUE(0, 0);
    asm volatile("s_waitcnt vmcnt(0)" ::: "memory");
    __syncthreads();
    const int swz = (idx >> 1) & 7;
    const int aoff = (wm * 128 + idx) * 128, boff = G_AB + (wn * 64 + idx) * 128;
    for (int kt = 0; kt < nk; ++kt) {
        const int st = kt & 1;
        const bool more = kt + 1 < nk;
        const unsigned char* sb = smem + st * G_STAGE;
        if constexpr (!LOWREG) {
#pragma unroll
        for (int ks = 0; ks < 2; ++ks) {
            bf16x8 bfr[4], af[8];
            const int co = ((ks * 4 + kq) ^ swz) * 16;
#pragma unroll
            for (int ni = 0; ni < 4; ++ni) bfr[ni] = *(const bf16x8*)(sb + boff + ni * 2048 + co);
#pragma unroll
            for (int mi = 0; mi < 8; ++mi) af[mi] = *(const bf16x8*)(sb + aoff + mi * 2048 + co);
            if (more) { G_ISSUE1(kt + 1, st ^ 1, ks * 2); G_ISSUE1(kt + 1, st ^ 1, ks * 2 + 1); }
            __builtin_amdgcn_sched_barrier(0);
            __builtin_amdgcn_s_setprio(1);
#pragma unroll
            for (int mi = 0; mi < 8; ++mi)
#pragma unroll
                for (int ni = 0; ni < 4; ++ni) acc[mi][ni] = __builtin_amdgcn_mfma_f32_16x16x32_bf16(bfr[ni], af[mi], acc[mi][ni], 0, 0, 0);
            __builtin_amdgcn_s_setprio(0);
            __builtin_amdgcn_sched_barrier(0);
        }
        } else {
#pragma unroll
        for (int ks = 0; ks < 2; ++ks) {
            bf16x8 bfr[4];
            const int co = ((ks * 4 + kq) ^ swz) * 16;
#pragma unroll
            for (int ni = 0; ni < 4; ++ni) bfr[ni] = *(const bf16x8*)(sb + boff + ni * 2048 + co);
#pragma unroll
            for (int mh = 0; mh < 2; ++mh) {
                bf16x8 af[4];
#pragma unroll
                for (int mi = 0; mi < 4; ++mi) af[mi] = *(const bf16x8*)(sb + aoff + (mh * 4 + mi) * 2048 + co);
                if (more) G_ISSUE1(kt + 1, st ^ 1, ks * 2 + mh);
                __builtin_amdgcn_sched_barrier(0);
                __builtin_amdgcn_s_setprio(1);
#pragma unroll
                for (int mi = 0; mi < 4; ++mi)
#pragma unroll
                    for (int ni = 0; ni < 4; ++ni) acc[mh * 4 + mi][ni] = __builtin_amdgcn_mfma_f32_16x16x32_bf16(bfr[ni], af[mi], acc[mh * 4 + mi][ni], 0, 0, 0);
                __builtin_amdgcn_s_setprio(0);
                __builtin_amdgcn_sched_barrier(0);
            }
        }
        }
        asm volatile("s_waitcnt vmcnt(0)" ::: "memory");
        __syncthreads();
    }
#undef G_ISSUE1
#undef G_ISSUE
}

__device__ __forceinline__ void st4bf(bf16_t* dst, f32x4 v) { u32x2 pk; pk.x = pk2(v.x, v.y); pk.y = pk2(v.z, v.w); *(u32x2*)dst = pk; }

__device__ void gemm1_phase(const Params& p, int l, int hb, unsigned char* smem) {
    const bf16_t* H = (const bf16_t*)(p.ws + WS_H);
    const bf16_t* Wt = (const bf16_t*)(p.ws + WS_WIN) + (size_t)l * NP * 1024;
    const float* ropec = (const float*)(p.ws + WS_ROPE); const float* ropes = ropec + 2048;
    constexpr int NT = 34, NTILES = 64 * NT, GRP = 8 * NT;
    for (int t = blockIdx.x; t < NTILES; t += gridDim.x) {
        const int grp = t / GRP, r = t % GRP, jx = NT * (r & 7) + (r >> 3), mt = grp * 8 + (jx & 7), nt = jx >> 3;
        const int m0 = mt * 256, n0 = nt * 256;
        f32x4 acc[8][4];
        int tid = threadIdx.x;
        gemm_core(H + (size_t)m0 * 1024, 1024, Wt + (size_t)n0 * 1024, 1024, 1024, acc, smem, tid);
        asm volatile("" : "+v"(tid));
        const int lane = tid & 63, w = __builtin_amdgcn_readfirstlane(tid >> 6), wm = w >> 2, wn = w & 3, idx = lane & 15, kq = lane >> 4;
        const int cw = n0 + wn * 64;
        const int lc = 4 * kq;
        unsigned char* wl = smem + w * 16384;
#define G1_STG(mi_, ni_, v_) do { const int r_ = (mi_) * 16 + idx; const f32x4 t_ = (v_); u32x2 pk_; pk_.x = pk2(t_.x, t_.y); pk_.y = pk2(t_.z, t_.w); \
        *(u32x2*)(wl + r_ * 128 + ((((ni_) * 2 + (kq >> 1)) ^ (r_ & 7)) * 16) + (kq & 1) * 8) = pk_; } while (0)
        bf16_t* dbase = nullptr; int dpitch = 0, dc0 = 0, dsh = -1, dg = 0;
        if (cw < 768 && (cw < 640)) {
            const bool isq = cw < 512;
            const float* nwp = (isq ? p.q_norm_a : p.k_norm_a) + l * 64;
            dbase = isq ? (bf16_t*)(p.ws + WS_QA) : (bf16_t*)(p.ws + WS_KA);
            dpitch = isq ? 512 : 128; dc0 = isq ? cw : cw - 512;
            const float qs = isq ? 0.125f * LOG2E : 1.f;
#pragma unroll
            for (int mi = 0; mi < 8; ++mi) {
                const int row = m0 + wm * 128 + mi * 16 + idx;
                float ss = 0.f;
#pragma unroll
                for (int ni = 0; ni < 4; ++ni) { const f32x4 v = acc[mi][ni]; ss += v.x * v.x + v.y * v.y + v.z * v.z + v.w * v.w; }
                ss += __shfl_xor(ss, 16); ss += __shfl_xor(ss, 32);
                const float rstd = rsqrtf(ss * (1.f / 64.f) + EPS);
                f32x4 y[4];
#pragma unroll
                for (int ni = 0; ni < 4; ++ni) y[ni] = acc[mi][ni] * rstd * *(const f32x4*)(nwp + ni * 16 + lc);
                const int tt = row & (SEQ - 1), prow = tt >> 6, pcol = tt & 63;
#pragma unroll
                for (int hf = 0; hf < 2; ++hf) {
                    const int pos = hf ? pcol : prow;
                    const f32x4 cs = *(const f32x4*)(ropec + pos * 16 + lc), sn = *(const f32x4*)(ropes + pos * 16 + lc);
                    const f32x4 a = y[2 * hf], b = y[2 * hf + 1];
                    y[2 * hf] = a * cs - b * sn; y[2 * hf + 1] = b * cs + a * sn;
                }
#pragma unroll
                for (int ni = 0; ni < 4; ++ni) G1_STG(mi, ni, y[ni] * qs);
            }
        } else if (cw >= 1280 && cw < 2816) {
            const bool isq = cw < 2048;
            const float* nwp = (isq ? p.q_norm_b : p.k_norm_b) + l * 64;
            const int gc = isq ? cw - 1280 : cw - 2048;
            dg = gc >> 8; dc0 = gc & 255; dsh = 2 * dg; dpitch = 256;
            dbase = (bf16_t*)(p.ws + (isq ? WS_QB : WS_KB));
            const float qs = isq ? 0.125f * LOG2E : 1.f;
#pragma unroll
            for (int mi = 0; mi < 8; ++mi) {
                float ss = 0.f;
#pragma unroll
                for (int ni = 0; ni < 4; ++ni) { const f32x4 v = acc[mi][ni]; ss += v.x * v.x + v.y * v.y + v.z * v.z + v.w * v.w; }
                ss += __shfl_xor(ss, 16); ss += __shfl_xor(ss, 32);
                const float rstd = rsqrtf(ss * (1.f / 64.f) + EPS) * qs;
#pragma unroll
                for (int ni = 0; ni < 4; ++ni) G1_STG(mi, ni, acc[mi][ni] * rstd * *(const f32x4*)(nwp + ni * 16 + lc));
            }
        } else if (cw >= 2816 && cw < 3584) {
            const int gc = cw - 2816;
            dg = gc >> 8; dc0 = gc & 255; dsh = 2 * dg; dpitch = 256; dbase = (bf16_t*)(p.ws + WS_VB);
#pragma unroll
            for (int mi = 0; mi < 8; ++mi)
#pragma unroll
                for (int ni = 0; ni < 4; ++ni) G1_STG(mi, ni, acc[mi][ni]);
        } else if (cw >= 8448) {
            if (cw == 8448) {
                float* dst = (float*)(p.ws + WS_DT);
                const f32x4 bias = *(const f32x4*)(p.dt_bias + l * 16 + lc);
#pragma unroll
                for (int mi = 0; mi < 8; ++mi) {
                    const int row = m0 + wm * 128 + mi * 16 + idx;
                    f32x4 v = acc[mi][0] + bias, o;
                    o.x = v.x > 20.f ? v.x : log1pf(__expf(v.x)); o.y = v.y > 20.f ? v.y : log1pf(__expf(v.y));
                    o.z = v.z > 20.f ? v.z : log1pf(__expf(v.z)); o.w = v.w > 20.f ? v.w : log1pf(__expf(v.w));
                    *(f32x4*)(dst + (size_t)row * 16 + lc) = o;
                }
            }
        } else {
            int mode;
            if (cw < 768) { dbase = (bf16_t*)(p.ws + WS_VA); dpitch = 128; dc0 = cw - 640; mode = 0; }
            else if (cw < 1280) { dbase = (bf16_t*)(p.ws + WS_GA); dpitch = 512; dc0 = cw - 768; mode = 1; }
            else if (cw < 3840) { dbase = (bf16_t*)(p.ws + WS_GB); dpitch = 256; dc0 = cw - 3584; mode = 1; }
            else if (cw < 4864) { dbase = (bf16_t*)(p.ws + WS_XBC); dpitch = 1024; dc0 = cw - 3840; mode = 0; }
            else if (cw < 5376) { dbase = (bf16_t*)(p.ws + WS_ZS); dpitch = 512; dc0 = cw - 4864; mode = 1; }
            else { dbase = (bf16_t*)(p.ws + WS_MG); dpitch = 3072; dc0 = cw - 5376; mode = 2; }
            const float* bg = p.b_gate + l * 3072 + dc0 + lc;
#pragma unroll
            for (int mi = 0; mi < 8; ++mi) {
#pragma unroll
                for (int ni = 0; ni < 4; ++ni) {
                    f32x4 v = acc[mi][ni];
                    if (mode == 1) { v.x = siluf(v.x); v.y = siluf(v.y); v.z = siluf(v.z); v.w = siluf(v.w); }
                    else if (mode == 2) { const f32x4 bb = *(const f32x4*)(bg + ni * 16); v.x = sigmf(v.x + bb.x); v.y = sigmf(v.y + bb.y); v.z = sigmf(v.z + bb.z); v.w = sigmf(v.w + bb.w); }
                    G1_STG(mi, ni, v);
                }
            }
        }
#undef G1_STG
        if (dbase) {
            const int ch = lane & 7;
#pragma unroll
            for (int j = 0; j < 16; ++j) {
                const int rl = 8 * j + (lane >> 3), row = m0 + wm * 128 + rl;
                const u32x4 v = *(const u32x4*)(wl + rl * 128 + ((ch ^ (rl & 7)) * 16));
                size_t drow = (size_t)row;
                if (dsh >= 0) { const int bl = row >> 13, tt = row & (SEQ - 1); drow = (size_t)(bl * 3 + dg) * SEQ + (size_t)((tt & ((1 << dsh) - 1)) * (SEQ >> dsh) + (tt >> dsh)); }
                *(u32x4*)(dbase + drow * dpitch + dc0 + ch * 8) = v;
            }
        }
        __syncthreads();
    }
}

__device__ void merge_phase(const Params& p, int l, unsigned char* smem) {
    const bf16_t* MG = (const bf16_t*)(p.ws + WS_MG);
    const float* rstd = (const float*)(p.ws + WS_RSTD);
    bf16_t* MR = (bf16_t*)(p.ws + WS_MRG);
    for (int t = blockIdx.x; t < 64 * 4; t += gridDim.x) {
        const int xq = t >> 3, mt = (xq >> 2) * 8 + (t & 7), nt = xq & 3, m0 = mt * 256, n0 = nt * 256;
        u32x2 mpk[6][4];
#pragma unroll 1
        for (int br = 0; br < 3; ++br) {
            f32x4 acc[8][4];
            const bf16_t* A; const bf16_t* Bt; int K;
            if (br == 0) { A = (const bf16_t*)(p.ws + WS_QA); K = 512; Bt = (const bf16_t*)(p.ws + WS_WPA) + (size_t)l * 1024 * 512; }
            else if (br == 1) { A = (const bf16_t*)(p.ws + WS_YBM); K = 256; Bt = (const bf16_t*)(p.ws + WS_WPB) + (size_t)l * 1024 * 256; }
            else { A = (const bf16_t*)(p.ws + WS_YC); K = 512; Bt = (const bf16_t*)(p.ws + WS_WPC) + (size_t)l * 1024 * 512; }
            int tid = threadIdx.x;
            gemm_core<true>(A + (size_t)m0 * K, K, Bt + (size_t)n0 * K, K, K, acc, smem, tid);
            asm volatile("" : "+v"(tid));
            const int lane = tid & 63, w = tid >> 6, wm = w >> 2, wn = w & 3, idx = lane & 15, kq = lane >> 4;
#pragma unroll
            for (int mi = 0; mi < 8; ++mi) {
                const int row = m0 + wm * 128 + mi * 16 + idx;
                const float rs = (br == 2) ? rstd[row] : 1.f;
#pragma unroll
                for (int ni = 0; ni < 4; ++ni) {
                    const int col = n0 + wn * 64 + ni * 16 + 4 * kq;
                    const u32x2 g = *(const u32x2*)(MG + (size_t)row * 3072 + br * 1024 + col);
                    f32x4 gv; gv.x = bflo(g.x); gv.y = bfhi(g.x); gv.z = bflo(g.y); gv.w = bfhi(g.y);
                    f32x4 v = gv * rs * acc[mi][ni];
                    bf16_t* mp = MR + (size_t)row * 1024 + col;
                    if (mi < 6) {
                        if (br > 0) { const u32x2 o = mpk[mi < 6 ? mi : 0][ni]; v.x += bflo(o.x); v.y += bfhi(o.x); v.z += bflo(o.y); v.w += bfhi(o.y); }
                        u32x2 pk; pk.x = pk2(v.x, v.y); pk.y = pk2(v.z, v.w); mpk[mi < 6 ? mi : 0][ni] = pk;
                        if (br == 2) *(u32x2*)mp = pk;
                    } else {
                        if (br > 0) { const u32x2 o = *(const u32x2*)mp; v.x += bflo(o.x); v.y += bfhi(o.x); v.z += bflo(o.y); v.w += bfhi(o.y); }
                        st4bf(mp, v);
                    }
                }
            }
        }
    }
}

__device__ void out_phase(const Params& p, int l, int hb, const float* xsrc, unsigned char* smem) {
    const bf16_t* MR = (const bf16_t*)(p.ws + WS_MRG);
    const bf16_t* Wt = (const bf16_t*)(p.ws + WS_WOUT) + (size_t)l * 1024 * 1024;
    for (int t = blockIdx.x; t < 64 * 4; t += gridDim.x) {
        const int xq = t >> 3, mt = (xq >> 2) * 8 + (t & 7), nt = xq & 3, m0 = mt * 256, n0 = nt * 256;
        f32x4 acc[8][4];
        int tid = threadIdx.x;
        gemm_core(MR + (size_t)m0 * 1024, 1024, Wt + (size_t)n0 * 1024, 1024, 1024, acc, smem, tid);
        asm volatile("" : "+v"(tid));
        const int lane = tid & 63, w = tid >> 6, wm = w >> 2, wn = w & 3, idx = lane & 15, kq = lane >> 4;
#pragma unroll
        for (int mi = 0; mi < 8; ++mi) {
            const int row = m0 + wm * 128 + mi * 16 + idx; const size_t rg = (size_t)hb * TP + row; const int b = (int)(rg / SEQ);
            const float* gate = (const float*)(p.ws + WS_MOD) + (size_t)(l * 4 + b) * 3072 + 2048;
#pragma unroll
            for (int ni = 0; ni < 4; ++ni) {
                const int col = n0 + wn * 64 + ni * 16 + 4 * kq;
                const f32x4 xv = *(const f32x4*)(xsrc + rg * 1024 + col), gv = *(const f32x4*)(gate + col);
                *(f32x4*)(p.out + rg * 1024 + col) = xv + gv * acc[mi][ni];
            }
        }
    }
}

constexpr int AT_KS = 0, AT_VS = 9216, AT_LQ = 9216 + 8192, AT_LUT = AT_LQ + 512;

#define AT_STAGE_STORE() do { _Pragma("unroll") for (int i = 0; i < 2; ++i) { const int c = tid + 256 * i, row = c >> 3, ch = c & 7; \
        *(u32x4*)(Ks + row * 72 + ch * 8) = rk[i]; *(u32x4*)(Vs + (ch >> 2) * 4096 + row * 64 + (ch & 3) * 16) = rv[i]; } } while (0)

__device__ __forceinline__ void at_qk(f32x16& p0, f32x16& p1, const bf16_t* Ks, const bf16x8* qr, int r32, int hi) {
    bf16x8 kf[8];
#pragma unroll
    for (int ds = 0; ds < 4; ++ds) {
        kf[2 * ds] = *(const bf16x8*)(Ks + r32 * 72 + ds * 16 + hi * 8);
        kf[2 * ds + 1] = *(const bf16x8*)(Ks + (r32 + 32) * 72 + ds * 16 + hi * 8);
    }
    __builtin_amdgcn_sched_barrier(0);
    __builtin_amdgcn_s_setprio(1);
#pragma unroll
    for (int ds = 0; ds < 4; ++ds) {
        p0 = __builtin_amdgcn_mfma_f32_32x32x16_bf16(kf[2 * ds], qr[ds], p0, 0, 0, 0);
        p1 = __builtin_amdgcn_mfma_f32_32x32x16_bf16(kf[2 * ds + 1], qr[ds], p1, 0, 0, 0);
    }
    __builtin_amdgcn_s_setprio(0);
    __builtin_amdgcn_sched_barrier(0);
}
__device__ __forceinline__ void at_pv(f32x16& o0, f32x16& o1, const f32x16& p0, const f32x16& p1, const unsigned char* Vs, int lane) {
    const int hi = lane >> 5;
    const unsigned char* vb = Vs + ((lane >> 4) & 1) * 32 + (lane & 3) * 8 + (4 * hi + ((lane & 15) >> 2)) * 64;
    bf16x8 v0[4], v1[4], pa[4];
#pragma unroll
    for (int s = 0; s < 4; ++s) {
        v0[s] = cat8(tr16(vb + s * 1024), tr16(vb + s * 1024 + 512));
        v1[s] = cat8(tr16(vb + 4096 + s * 1024), tr16(vb + 4096 + s * 1024 + 512));
    }
#pragma unroll
    for (int s = 0; s < 4; ++s) {
        u32x4 pw;
        if (s < 2) { pw.x = pk2(p0[8 * s + 0], p0[8 * s + 1]); pw.y = pk2(p0[8 * s + 2], p0[8 * s + 3]); pw.z = pk2(p0[8 * s + 4], p0[8 * s + 5]); pw.w = pk2(p0[8 * s + 6], p0[8 * s + 7]); }
        else { const int q = s - 2; pw.x = pk2(p1[8 * q + 0], p1[8 * q + 1]); pw.y = pk2(p1[8 * q + 2], p1[8 * q + 3]); pw.z = pk2(p1[8 * q + 4], p1[8 * q + 5]); pw.w = pk2(p1[8 * q + 6], p1[8 * q + 7]); }
        pa[s] = __builtin_bit_cast(bf16x8, pw);
    }
    __builtin_amdgcn_sched_barrier(0);
    __builtin_amdgcn_s_setprio(1);
#pragma unroll
    for (int s = 0; s < 4; ++s) {
        o0 = __builtin_amdgcn_mfma_f32_32x32x16_bf16(pa[s], v0[s], o0, 0, 0, 0);
        o1 = __builtin_amdgcn_mfma_f32_32x32x16_bf16(pa[s], v1[s], o1, 0, 0, 0);
    }
    __builtin_amdgcn_s_setprio(0);
    __builtin_amdgcn_sched_barrier(0);
}

__device__ __forceinline__ void at_ldv(bf16x8 (&v0)[4], bf16x8 (&v1)[4], const unsigned char* Vs, int lane) {
    const int hi = lane >> 5;
    const unsigned char* vb = Vs + ((lane >> 4) & 1) * 32 + (lane & 3) * 8 + (4 * hi + ((lane & 15) >> 2)) * 64;
#pragma unroll
    for (int s = 0; s < 4; ++s) {
        v0[s] = cat8(tr16(vb + s * 1024), tr16(vb + s * 1024 + 512));
        v1[s] = cat8(tr16(vb + 4096 + s * 1024), tr16(vb + 4096 + s * 1024 + 512));
    }
}
__device__ __forceinline__ void at_pv2(f32x16& o0, f32x16& o1, const f32x16& p0, const f32x16& p1, const bf16x8 (&v0)[4], const bf16x8 (&v1)[4]) {
    bf16x8 pa[4];
#pragma unroll
    for (int s = 0; s < 4; ++s) {
        u32x4 pw;
        if (s < 2) { pw.x = pk2(p0[8 * s + 0], p0[8 * s + 1]); pw.y = pk2(p0[8 * s + 2], p0[8 * s + 3]); pw.z = pk2(p0[8 * s + 4], p0[8 * s + 5]); pw.w = pk2(p0[8 * s + 6], p0[8 * s + 7]); }
        else { const int q = s - 2; pw.x = pk2(p1[8 * q + 0], p1[8 * q + 1]); pw.y = pk2(p1[8 * q + 2], p1[8 * q + 3]); pw.z = pk2(p1[8 * q + 4], p1[8 * q + 5]); pw.w = pk2(p1[8 * q + 6], p1[8 * q + 7]); }
        pa[s] = __builtin_bit_cast(bf16x8, pw);
    }
    __builtin_amdgcn_sched_barrier(0);
    __builtin_amdgcn_s_setprio(1);
#pragma unroll
    for (int s = 0; s < 4; ++s) {
        o0 = __builtin_amdgcn_mfma_f32_32x32x16_bf16(pa[s], v0[s], o0, 0, 0, 0);
        o1 = __builtin_amdgcn_mfma_f32_32x32x16_bf16(pa[s], v1[s], o1, 0, 0, 0);
    }
    __builtin_amdgcn_s_setprio(0);
    __builtin_amdgcn_sched_barrier(0);
}

constexpr int ATA_STAGE = 17408, ATA_LQ = 2 * ATA_STAGE;
__device__ void attn_a_item(const Params& p, int item, int l, unsigned char* smem) {
    int tid_ = threadIdx.x; asm volatile("" : "+v"(tid_));
    const int tid = tid_, lane = tid & 63, w = __builtin_amdgcn_readfirstlane(tid >> 6), r32 = lane & 31, hi = lane >> 5;
    const int b = item >> 8, r = item & 255, kvh = r >> 7, qblk = (r >> 2) & 31, hq = kvh * 4 + (r & 3);
    float* lq = (float*)(smem + ATA_LQ) + w * 32;
    bf16_t* QA = (bf16_t*)(p.ws + WS_QA);
    const bf16_t* GA = (const bf16_t*)(p.ws + WS_GA);
    const size_t tokq = (size_t)b * SEQ + qblk * 256 + w * 32;
    bf16x8 qr[4];
#pragma unroll
    for (int ds = 0; ds < 4; ++ds) qr[ds] = *(const bf16x8*)(QA + (tokq + r32) * 512 + hq * 64 + ds * 16 + hi * 8);
    const bf16_t* Kb = (const bf16_t*)(p.ws + WS_KA) + (size_t)b * SEQ * 128 + kvh * 64;
    const bf16_t* Vb = (const bf16_t*)(p.ws + WS_VA) + (size_t)b * SEQ * 128 + kvh * 64;
    const float nshift = -((const float*)(p.ws + WS_BND))[l];
    f32x16 o0, o1;
#pragma unroll
    for (int i = 0; i < 16; ++i) { o0[i] = 0.f; o1[i] = 0.f; }
    f32x4 la4 = (f32x4){0.f, 0.f, 0.f, 0.f};
    constexpr int NT = SEQ / 64;
    const int row0 = tid >> 3, ch0 = tid & 7;
    const size_t goff0 = (size_t)row0 * 128 + ch0 * 8;
    const int ko0 = row0 * 144 + ch0 * 16;
    const int vo0 = 9216 + (ch0 >> 2) * 4096 + row0 * 64 + (ch0 & 3) * 16;
    u32x4 rkA[1], rvA[1], rkB[1], rvB[1];
#define ATA_LOAD(RK, RV, t) do { const size_t tb = (size_t)(t) * 64 * 128; RK[0] = *(const u32x4*)(Kb + tb + goff0); RV[0] = *(const u32x4*)(Vb + tb + goff0); } while (0)
#define ATA_STORE(RK, RV, st) do { unsigned char* sb_ = smem + (st) * ATA_STAGE; *(u32x4*)(sb_ + ko0) = RK[0]; *(u32x4*)(sb_ + vo0) = RV[0]; } while (0)
#define ATA_COMPUTE(st) do { const unsigned char* sb_ = smem + (st) * ATA_STAGE; f32x16 p0, p1; bf16x8 vf0[4], vf1[4]; \
        _Pragma("unroll") for (int i = 0; i < 16; ++i) { p0[i] = nshift; p1[i] = nshift; } \
        at_qk(p0, p1, (const bf16_t*)sb_, qr, r32, hi); \
        at_ldv(vf0, vf1, sb_ + 9216, lane); __builtin_amdgcn_sched_barrier(0); \
        _Pragma("unroll") for (int i = 0; i < 16; ++i) { p0[i] = __builtin_amdgcn_exp2f(p0[i]); p1[i] = __builtin_amdgcn_exp2f(p1[i]); } \
        _Pragma("unroll") for (int i = 0; i < 4; ++i) { la4 += (f32x4){p0[4 * i], p0[4 * i + 1], p0[4 * i + 2], p0[4 * i + 3]}; la4 += (f32x4){p1[4 * i], p1[4 * i + 1], p1[4 * i + 2], p1[4 * i + 3]}; } \
        at_pv2(o0, o1, p0, p1, vf0, vf1); } while (0)
    __syncthreads();
    ATA_LOAD(rkA, rvA, 0); ATA_LOAD(rkB, rvB, 1);
    ATA_STORE(rkA, rvA, 0);
    ATA_LOAD(rkA, rvA, 2);
    __syncthreads();
    for (int kt = 0; kt < NT; kt += 2) {
        ATA_COMPUTE(0);
        ATA_STORE(rkB, rvB, 1);
        if (kt + 3 < NT) ATA_LOAD(rkB, rvB, kt + 3);
        __syncthreads();
        ATA_COMPUTE(1);
        if (kt + 2 < NT) { ATA_STORE(rkA, rvA, 0); if (kt + 4 < NT) ATA_LOAD(rkA, rvA, kt + 4); }
        __syncthreads();
    }
#undef ATA_LOAD
#undef ATA_STORE
#undef ATA_COMPUTE
    float lacc = (la4.x + la4.y) + (la4.z + la4.w);
    lacc += __shfl_xor(lacc, 32);
    if (hi == 0) lq[r32] = lacc;
    asm volatile("s_waitcnt lgkmcnt(0)" ::: "memory");
#pragma unroll
    for (int rr = 0; rr < 16; ++rr) {
        const int q = crow(rr, hi); const float inv = 1.f / lq[q];
        const size_t off = (tokq + q) * 512 + hq * 64 + r32;
        const float g0 = bf2f(GA[off]), g1 = bf2f(GA[off + 32]);
        QA[off] = (bf16_t)(pk2(o0[rr] * inv * g0, 0.f) & 0xffffu);
        QA[off + 32] = (bf16_t)(pk2(o1[rr] * inv * g1, 0.f) & 0xffffu);
    }
}

constexpr int ATB_TILE = 17408, ATB_LQ = 6 * ATB_TILE, ATB_LUT = ATB_LQ + 1024;
__device__ void attn_b_item(const Params& p, int item, int l, unsigned char* smem) {
    int tid_ = threadIdx.x; asm volatile("" : "+v"(tid_));
    const int tid = tid_, lane = tid & 63, w = __builtin_amdgcn_readfirstlane(tid >> 6), r32 = lane & 31, hi = lane >> 5;
    const int blk = item & 31, j = (item >> 5) & 3, bg = item >> 7, g = bg % 3;
    const int sh = 2 * g, dil = 1 << sh, Mlen = SEQ >> sh;
    float* lq = (float*)(smem + ATB_LQ) + w * 32; float* lut = (float*)(smem + ATB_LUT);
    bf16_t* QB = (bf16_t*)(p.ws + WS_QB) + (size_t)bg * SEQ * 256 + j * 64;
    const bf16_t* KB = (const bf16_t*)(p.ws + WS_KB) + (size_t)bg * SEQ * 256 + j * 64;
    const bf16_t* VB = (const bf16_t*)(p.ws + WS_VB) + (size_t)bg * SEQ * 256 + j * 64;
    float* LSE = (float*)(p.ws + WS_LSE) + (size_t)bg * SEQ * 4 + j;
    const int p0r = blk * 256, seq_lo = (p0r / Mlen) * Mlen, seq_hi = seq_lo + Mlen;
    const int srow = tid >> 3, sch = tid & 7;
    u32x4 rk[6], rv[6];
#pragma unroll
    for (int kt = 0; kt < 6; ++kt) { int pr = p0r - 64 + 64 * kt + srow; pr = pr < 0 ? 0 : (pr > SEQ - 1 ? SEQ - 1 : pr);
        rk[kt] = *(const u32x4*)(KB + (size_t)pr * 256 + sch * 8); rv[kt] = *(const u32x4*)(VB + (size_t)pr * 256 + sch * 8); }
    __syncthreads();
    if (tid < 129) {
        const int rel = tid - 64, n = (rel < 0 ? -rel : rel) * dil;
        int bk;
        if (n < 8) bk = n; else { bk = 8 + (n >= 15) + (n >= 27) + (n >= 50) + (n >= 91) + (n >= 166) + (n >= 305) + (n >= 559); }
        if (rel > 0) bk += 16;
        lut[tid] = p.rel_bias[bk * 12 + g * 4 + j] * LOG2E;
    }
#pragma unroll
    for (int kt = 0; kt < 6; ++kt) { unsigned char* tb = smem + kt * ATB_TILE;
        *(u32x4*)(tb + srow * 144 + sch * 16) = rk[kt]; *(u32x4*)(tb + 9216 + (sch >> 2) * 4096 + srow * 64 + (sch & 3) * 16) = rv[kt]; }
    const int qpos = p0r + w * 32 + r32;
    bf16x8 qr[4];
#pragma unroll
    for (int ds = 0; ds < 4; ++ds) qr[ds] = *(const bf16x8*)(QB + (size_t)qpos * 256 + ds * 16 + hi * 8);
    const float nshift = -((const float*)(p.ws + WS_BND))[2 + l];
    f32x16 o0, o1;
#pragma unroll
    for (int i = 0; i < 16; ++i) { o0[i] = 0.f; o1[i] = 0.f; }
    f32x4 la4 = (f32x4){0.f, 0.f, 0.f, 0.f};
    __syncthreads();
#pragma unroll 1
    for (int t3 = 0; t3 < 3; ++t3) {
        const int kt = (w >> 1) + t3, kbase = p0r - 64 + 64 * kt;
        const bf16_t* Ks = (const bf16_t*)(smem + kt * ATB_TILE); const unsigned char* Vs = smem + kt * ATB_TILE + 9216;
        f32x16 p0, p1;
#pragma unroll
        for (int i = 0; i < 16; ++i) { p0[i] = nshift; p1[i] = nshift; }
        at_qk(p0, p1, Ks, qr, r32, hi);
#pragma unroll
        for (int i = 0; i < 16; ++i) {
            const int kv0 = kbase + crow(i, hi), kv1 = kv0 + 32;
            const int rel0 = kv0 - qpos, rel1 = kv1 - qpos;
            const bool ok0 = rel0 >= -64 && rel0 <= 64 && kv0 >= seq_lo && kv0 < seq_hi;
            const bool ok1 = rel1 >= -64 && rel1 <= 64 && kv1 >= seq_lo && kv1 < seq_hi;
            const float e0 = __builtin_amdgcn_exp2f(p0[i] + lut[ok0 ? rel0 + 64 : 64]);
            const float e1 = __builtin_amdgcn_exp2f(p1[i] + lut[ok1 ? rel1 + 64 : 64]);
            p0[i] = ok0 ? e0 : 0.f; p1[i] = ok1 ? e1 : 0.f;
        }
#pragma unroll
        for (int i = 0; i < 4; ++i) { la4 += (f32x4){p0[4 * i], p0[4 * i + 1], p0[4 * i + 2], p0[4 * i + 3]}; la4 += (f32x4){p1[4 * i], p1[4 * i + 1], p1[4 * i + 2], p1[4 * i + 3]}; }
        at_pv(o0, o1, p0, p1, Vs, lane);
    }
    float lacc = (la4.x + la4.y) + (la4.z + la4.w);
    lacc += __shfl_xor(lacc, 32);
    if (hi == 0) { lq[r32] = lacc; LSE[(size_t)qpos * 4] = (-nshift + log2f(lacc)) * LN2; }
    asm volatile("s_waitcnt lgkmcnt(0)" ::: "memory");
#pragma unroll
    for (int rr = 0; rr < 16; ++rr) {
        const int q = crow(rr, hi); const float inv = 1.f / lq[q];
        const size_t off = (size_t)(p0r + w * 32 + q) * 256 + r32;
        QB[off] = (bf16_t)(pk2(o0[rr] * inv, 0.f) & 0xffffu);
        QB[off + 32] = (bf16_t)(pk2(o1[rr] * inv, 0.f) & 0xffffu);
    }
}

__device__ void conv_phase(const Params& p, int l) {
    int tx_ = threadIdx.x; asm volatile("" : "+v"(tx_));
    const bf16_t* XBC = (const bf16_t*)(p.ws + WS_XBC);
    bf16_t* XC = (bf16_t*)(p.ws + WS_XBCC);
    const float* cw = p.conv_w + (size_t)l * 5 * 1024; const float* cb = p.conv_b + l * 1024;
    const int nthr = gridDim.x * 512;
    for (int u = blockIdx.x * 512 + tx_; u < (TP / 4) * 128; u += nthr) {
        const int ch = (u & 127) * 8, tg = u >> 7, tok0 = tg * 4, tt0 = tok0 & (SEQ - 1);
        u32x4 raw[8];
#pragma unroll
        for (int r = 0; r < 8; ++r) { const int tt = tt0 - 2 + r; raw[r] = (u32x4){0u, 0u, 0u, 0u};
            if (tt >= 0 && tt < SEQ) raw[r] = *(const u32x4*)(XBC + (size_t)(tok0 - 2 + r) * 1024 + ch); }
        float ac[4][8];
        { const f32x4 a = *(const f32x4*)(cb + ch), b2 = *(const f32x4*)(cb + ch + 4);
#pragma unroll
          for (int t = 0; t < 4; ++t) { ac[t][0] = a.x; ac[t][1] = a.y; ac[t][2] = a.z; ac[t][3] = a.w; ac[t][4] = b2.x; ac[t][5] = b2.y; ac[t][6] = b2.z; ac[t][7] = b2.w; } }
#pragma unroll
        for (int k = 0; k < 5; ++k) { const f32x4 wa = *(const f32x4*)(cw + k * 1024 + ch), wb = *(const f32x4*)(cw + k * 1024 + ch + 4);
#pragma unroll
            for (int t = 0; t < 4; ++t) { const u32x4 v = raw[t + k];
                ac[t][0] += bflo(v.x) * wa.x; ac[t][1] += bfhi(v.x) * wa.y; ac[t][2] += bflo(v.y) * wa.z; ac[t][3] += bfhi(v.y) * wa.w;
                ac[t][4] += bflo(v.z) * wb.x; ac[t][5] += bfhi(v.z) * wb.y; ac[t][6] += bflo(v.w) * wb.z; ac[t][7] += bfhi(v.w) * wb.w; } }
#pragma unroll
        for (int t = 0; t < 4; ++t) { u32x4 o;
            o.x = pk2(siluf(ac[t][0]), siluf(ac[t][1])); o.y = pk2(siluf(ac[t][2]), siluf(ac[t][3])); o.z = pk2(siluf(ac[t][4]), siluf(ac[t][5])); o.w = pk2(siluf(ac[t][6]), siluf(ac[t][7]));
            *(u32x4*)(XC + (size_t)(tok0 + t) * 1024 + ch) = o; }
    }
}

constexpr int SS_BS = 0, SS_CS = 8704, SS_XS = 17408, SS_XWS = 22016, SS_GS = 26624, SS_SB = 29184, SS_CW = 46592, SS_SC = 54272, SS_DTA = 55296, SS_END = 57344;

template <int PASS>
__device__ void ssd_item(const Params& p, int item, int l, unsigned char* smem) {
    int tid_ = VTID; asm volatile("" : "+v"(tid_));
    const int tid = tid_, lane = tid & 63, w = tid >> 6, idx = lane & 15, kq = lane >> 4;
    const int seg = item & 15, h = (item >> 4) & 7, dir = (item >> 7) & 1, b = item >> 8, grp = h >> 2;
    bf16_t* Bs = (bf16_t*)(smem + SS_BS); bf16_t* Cs = (bf16_t*)(smem + SS_CS); bf16_t* Xs = (bf16_t*)(smem + SS_XS); bf16_t* Xws = (bf16_t*)(smem + SS_XWS);
    bf16_t* Gs = (bf16_t*)(smem + SS_GS); bf16_t* Sb = (bf16_t*)(smem + SS_SB); float* sc = (float*)(smem + SS_SC);
    float* s_cA = (float*)(smem + SS_CW), *s_rsA = s_cA + SEGLEN, *s_wlA = s_rsA + SEGLEN, *s_totA = sc;
    const bf16_t* XBC = (const bf16_t*)(p.ws + WS_XBC);
    const float* DT = (const float*)(p.ws + WS_DT);
    float* ST = (float*)(p.ws + WS_ST); float* SEGT = (float*)(p.ws + WS_SEGT);
    bf16_t* Y = (bf16_t*)(p.ws + (dir ? WS_YS : WS_YF));
    const float Aneg = -__expf(p.a_log[l * 16 + dir * 8 + h]);
    const float Dh = p.d_skip[l * 8 + h];
    __syncthreads();
    f32x4 S[8];
#pragma unroll
    for (int nt = 0; nt < 8; ++nt) S[nt] = (f32x4){0.f, 0.f, 0.f, 0.f};
    const int ibase = item & ~15;
    if (PASS == 3) {
        if (dir == 0) {
            for (int e = 0; e < seg; ++e) { const float dc = __expf(SEGT[ibase + e]); const f32x4* src = (const f32x4*)(ST + (size_t)(ibase + e) * 8192);
#pragma unroll
                for (int nt = 0; nt < 8; ++nt) S[nt] = S[nt] * dc + src[(w * 8 + nt) * 64 + lane]; }
        } else {
            for (int e = NSEG - 1; e > seg; --e) { const float dc = __expf(SEGT[ibase + e]); const f32x4* src = (const f32x4*)(ST + (size_t)(ibase + e) * 8192);
#pragma unroll
                for (int nt = 0; nt < 8; ++nt) S[nt] = S[nt] * dc + src[(w * 8 + nt) * 64 + lane]; }
        }
#pragma unroll
        for (int nt = 0; nt < 8; ++nt) st4bf(Sb + (16 * w + idx) * 136 + 16 * nt + 4 * kq, S[nt]);
    }
    float* s_dta = (float*)(smem + SS_DTA);
#pragma unroll
    for (int i = 0; i < SEGLEN / 256; ++i) {
        const int e = tid + 256 * i, l32 = lane & 31;
        const float dtv = DT[((size_t)b * SEQ + seg * SEGLEN + e) * 16 + dir * 8 + h], av = dtv * Aneg;
        float pre = av;
#pragma unroll
        for (int o = 1; o < 32; o <<= 1) { const float t = __shfl_up(pre, o, 32); if (l32 >= o) pre += t; }
        const float tot = __shfl(pre, 31, 32);
        const float cc = dir ? (tot - pre + av) : pre;
        s_dta[e] = dtv; s_cA[e] = cc; s_rsA[e] = __expf(cc); s_wlA[e] = dtv * __expf(tot - cc);
        if (l32 == 0) s_totA[e >> 5] = tot;
    }
    float segtot = 0.f;
    const size_t tokb = (size_t)b * SEQ;
    const unsigned char* xb_ = (const unsigned char*)((const bf16_t*)(p.ws + WS_XBCC) + tokb * 1024);
    unsigned soff[5];
#pragma unroll
    for (int i = 0; i < 5; ++i) { const int u = tid + 256 * i, lrow = u / 40, ci = u % 40;
        const int scol = ci < 8 ? h * 64 + ci * 8 : (ci < 24 ? 512 + grp * 128 + (ci * 8 - 64) : 768 + grp * 128 + (ci * 8 - 192));
        soff[i] = (unsigned)((lrow * 1024 + scol) * 2); }
    for (int si = 0; si < NSUB; ++si) {
        const int scn = dir ? (NSUB - 1 - si) : si;
        const int t0 = seg * SEGLEN + scn * TSUB;
        __syncthreads();
        u32x4 raw[5];
#pragma unroll
        for (int i = 0; i < 5; ++i) raw[i] = *(const u32x4*)(xb_ + ((unsigned)(t0 * 2048) + soff[i]));
        const float* s_dt = s_dta + scn * TSUB; const float* s_c = s_cA + scn * TSUB; const float* s_rs = s_rsA + scn * TSUB; const float* s_wl = s_wlA + scn * TSUB;
        const float stot = s_totA[scn];
        segtot += stot;
#pragma unroll
        for (int i = 0; i < 5; ++i) { const int u = tid + 256 * i, lrow = u / 40, ci = u % 40, lc = ci * 8; const u32x4 o = raw[i];
            if (ci < 8) { *(u32x4*)(Xs + lrow * 72 + lc) = o; const float wl = s_wl[lrow];
                u32x4 o2; o2.x = pk2(bflo(o.x) * wl, bfhi(o.x) * wl); o2.y = pk2(bflo(o.y) * wl, bfhi(o.y) * wl); o2.z = pk2(bflo(o.z) * wl, bfhi(o.z) * wl); o2.w = pk2(bflo(o.w) * wl, bfhi(o.w) * wl);
                *(u32x4*)(Xws + lrow * 72 + lc) = o2; }
            else if (ci < 24) *(u32x4*)(Bs + lrow * 136 + (lc - 64)) = o;
            else *(u32x4*)(Cs + lrow * 136 + (lc - 192)) = o; }
        __syncthreads();
        if (PASS == 3) {
            const int it = w >> 1, jt = w & 1;
            f32x4 cb = (f32x4){0.f, 0.f, 0.f, 0.f};
            {
                bf16x8 fb[4], fc[4];
#pragma unroll
                for (int ks = 0; ks < 4; ++ks) { fb[ks] = *(const bf16x8*)(Bs + (16 * jt + idx) * 136 + ks * 32 + kq * 8); fc[ks] = *(const bf16x8*)(Cs + (16 * it + idx) * 136 + ks * 32 + kq * 8); }
                __builtin_amdgcn_sched_barrier(0);
#pragma unroll
                for (int ks = 0; ks < 4; ++ks) cb = __builtin_amdgcn_mfma_f32_16x16x32_bf16(fb[ks], fc[ks], cb, 0, 0, 0);
                __builtin_amdgcn_sched_barrier(0);
            }
            {
                const int ii = 16 * it + idx; const float ci_ = s_c[ii];
                f32x4 gv;
#pragma unroll
                for (int rg = 0; rg < 4; ++rg) {
                    const int jj = 16 * jt + 4 * kq + rg;
                    const bool ok = dir ? (jj >= ii) : (jj <= ii);
                    const float e = __expf(ci_ - s_c[jj]) * s_dt[jj];
                    gv[rg] = ok ? cb[rg] * e : 0.f;
                }
                st4bf(Gs + ii * 40 + 16 * jt + 4 * kq, gv);
            }
            __syncthreads();
            const unsigned char* xtr = (const unsigned char*)Xs + (8 * kq + (idx >> 2)) * 144 + (16 * w + 4 * (idx & 3)) * 2;
            const bf16x8 xf = cat8(tr16(xtr), tr16(xtr + 4 * 144));
#pragma unroll 1
            for (int it2 = 0; it2 < 2; ++it2) {
                const int ii = 16 * it2 + idx;
                const bf16x8 gf = *(const bf16x8*)(Gs + ii * 40 + 8 * kq);
                f32x4 yd = (f32x4){0.f, 0.f, 0.f, 0.f}, yo = (f32x4){0.f, 0.f, 0.f, 0.f};
                bf16x8 sf[4], cf[4];
#pragma unroll
                for (int ks = 0; ks < 4; ++ks) { sf[ks] = *(const bf16x8*)(Sb + (16 * w + idx) * 136 + ks * 32 + kq * 8); cf[ks] = *(const bf16x8*)(Cs + ii * 136 + ks * 32 + kq * 8); }
                __builtin_amdgcn_sched_barrier(0);
                yd = __builtin_amdgcn_mfma_f32_16x16x32_bf16(xf, gf, yd, 0, 0, 0);
#pragma unroll
                for (int ks = 0; ks < 4; ++ks) yo = __builtin_amdgcn_mfma_f32_16x16x32_bf16(sf[ks], cf[ks], yo, 0, 0, 0);
                __builtin_amdgcn_sched_barrier(0);
                f32x4 y = yd + yo * s_rs[ii];
                if (dir == 0) { const u32x2 xv = *(const u32x2*)(Xs + ii * 72 + 16 * w + 4 * kq);
                    y.x += Dh * bflo(xv.x); y.y += Dh * bfhi(xv.x); y.z += Dh * bflo(xv.y); y.w += Dh * bfhi(xv.y); }
                st4bf(Y + (tokb + t0 + ii) * 512 + h * 64 + 16 * w + 4 * kq, y);
            }
        }
        {
            const float dc = __expf(stot);
            const unsigned char* xw = (const unsigned char*)Xws + (8 * kq + (idx >> 2)) * 144 + (16 * w + 4 * (idx & 3)) * 2;
            const bf16x8 xwf = cat8(tr16(xw), tr16(xw + 4 * 144));
            bf16x8 bfv[8];
#pragma unroll
            for (int nt = 0; nt < 8; ++nt) {
                const unsigned char* bt = (const unsigned char*)Bs + (8 * kq + (idx >> 2)) * 272 + (16 * nt + 4 * (idx & 3)) * 2;
                bfv[nt] = cat8(tr16(bt), tr16(bt + 4 * 272));
            }
            __builtin_amdgcn_sched_barrier(0);
#pragma unroll
            for (int nt = 0; nt < 8; ++nt) S[nt] = __builtin_amdgcn_mfma_f32_16x16x32_bf16(bfv[nt], xwf, S[nt] * dc, 0, 0, 0);
            __builtin_amdgcn_sched_barrier(0);
            if (PASS == 3) {
#pragma unroll
                for (int nt = 0; nt < 8; ++nt) st4bf(Sb + (16 * w + idx) * 136 + 16 * nt + 4 * kq, S[nt]);
            }
        }
    }
    if (PASS == 1) {
        f32x4* dst = (f32x4*)(ST + (size_t)item * 8192);
#pragma unroll
        for (int nt = 0; nt < 8; ++nt) dst[(w * 8 + nt) * 64 + lane] = S[nt];
        if (tid == 0) SEGT[item] = segtot;
    }
}

__device__ void post2_phase(const Params& p) {
    int tx_ = threadIdx.x; asm volatile("" : "+v"(tx_));
    const int lane = tx_ & 63, gw = blockIdx.x * 8 + (tx_ >> 6), nw = gridDim.x * 8;
    const bf16_t* OB = (const bf16_t*)(p.ws + WS_QB); const float* LSE = (const float*)(p.ws + WS_LSE);
    const bf16_t* GB = (const bf16_t*)(p.ws + WS_GB);
    bf16_t* YBM = (bf16_t*)(p.ws + WS_YBM);
    const bf16_t* YF = (const bf16_t*)(p.ws + WS_YF); const bf16_t* YS = (const bf16_t*)(p.ws + WS_YS); const bf16_t* ZS = (const bf16_t*)(p.ws + WS_ZS);
    bf16_t* YC = (bf16_t*)(p.ws + WS_YC); float* RS = (float*)(p.ws + WS_RSTD);
    constexpr int R = 4;
    for (int row0 = gw; row0 < TP; row0 += R * nw) {
        float ls[R][3]; u32x2 ov[R][3], gt[R]; u32x4 a[R], bq[R], z[R];
        const int j = lane >> 4;
#pragma unroll
        for (int q = 0; q < R; ++q) { const int row = row0 + q * nw; if (row < TP) {
            const int bl = row >> 13, tt = row & (SEQ - 1);
#pragma unroll
            for (int g = 0; g < 3; ++g) { const int sh = 2 * g; const int pp = (tt & ((1 << sh) - 1)) * (SEQ >> sh) + (tt >> sh);
                const size_t ro = (size_t)(bl * 3 + g) * SEQ + pp; ls[q][g] = LSE[ro * 4 + j]; ov[q][g] = *(const u32x2*)(OB + ro * 256 + 4 * lane); }
            gt[q] = *(const u32x2*)(GB + (size_t)row * 256 + 4 * lane);
            a[q] = *(const u32x4*)(YF + (size_t)row * 512 + 8 * lane); bq[q] = *(const u32x4*)(YS + (size_t)row * 512 + 8 * lane); z[q] = *(const u32x4*)(ZS + (size_t)row * 512 + 8 * lane); } }
#pragma unroll
        for (int q = 0; q < R; ++q) { const int row = row0 + q * nw; if (row < TP) {
            const float mx = fmaxf(ls[q][0], fmaxf(ls[q][1], ls[q][2]));
            float wg[3]; float ws = 0.f;
#pragma unroll
            for (int g = 0; g < 3; ++g) { wg[g] = __expf(ls[q][g] - mx); ws += wg[g]; }
            const float inv = 1.f / ws;
            f32x4 acc = (f32x4){0.f, 0.f, 0.f, 0.f};
#pragma unroll
            for (int g = 0; g < 3; ++g) { const u32x2 v = ov[q][g]; const float wv = wg[g] * inv;
                acc.x += wv * bflo(v.x); acc.y += wv * bfhi(v.x); acc.z += wv * bflo(v.y); acc.w += wv * bfhi(v.y); }
            acc.x *= bflo(gt[q].x); acc.y *= bfhi(gt[q].x); acc.z *= bflo(gt[q].y); acc.w *= bfhi(gt[q].y);
            st4bf(YBM + (size_t)row * 256 + 4 * lane, acc);
            float y[8];
            y[0] = (bflo(a[q].x) + bflo(bq[q].x)) * bflo(z[q].x); y[1] = (bfhi(a[q].x) + bfhi(bq[q].x)) * bfhi(z[q].x);
            y[2] = (bflo(a[q].y) + bflo(bq[q].y)) * bflo(z[q].y); y[3] = (bfhi(a[q].y) + bfhi(bq[q].y)) * bfhi(z[q].y);
            y[4] = (bflo(a[q].z) + bflo(bq[q].z)) * bflo(z[q].z); y[5] = (bfhi(a[q].z) + bfhi(bq[q].z)) * bfhi(z[q].z);
            y[6] = (bflo(a[q].w) + bflo(bq[q].w)) * bflo(z[q].w); y[7] = (bfhi(a[q].w) + bfhi(bq[q].w)) * bfhi(z[q].w);
            float ss = 0.f;
#pragma unroll
            for (int e = 0; e < 8; ++e) ss += y[e] * y[e];
            ss = wave_sum(ss);
            u32x4 o; o.x = pk2(y[0], y[1]); o.y = pk2(y[2], y[3]); o.z = pk2(y[4], y[5]); o.w = pk2(y[6], y[7]);
            *(u32x4*)(YC + (size_t)row * 512 + 8 * lane) = o;
            if (lane == 0) RS[row] = rsqrtf(ss * (1.f / 512.f) + EPS);
        } }
    }
}


#define XB_TMO      128
#define XB_XCNT(j)  (256  + 64 * (j))
#define XB_XSUB(j)  (1280 + 64 * (j))
#define XB_XGEN(j)  (2304 + 64 * (j))
#define XB_TOP      3328
#define XB_TOPGEN   3392
#define XCD_BAR_WORDS 3456
#define XB_SPIN_CAP (1u << 20)
__device__ __forceinline__ unsigned xb_ld(unsigned* p)              { return __hip_atomic_load(p, __ATOMIC_RELAXED, __HIP_MEMORY_SCOPE_AGENT); }
__device__ __forceinline__ unsigned xb_add(unsigned* p, unsigned v) { return __hip_atomic_fetch_add(p, v, __ATOMIC_RELAXED, __HIP_MEMORY_SCOPE_AGENT); }
__device__ __forceinline__ unsigned xb_xcc_id() { return (unsigned)__builtin_amdgcn_s_getreg((3 << 11) | 20) & 0xFu; }
#define XB_SPIN(cond, bar) do { unsigned _sp = 0; while (cond) { __builtin_amdgcn_s_sleep(1); \
    if ((++_sp & 255u) == 0u) { if (xb_ld(&(bar)[XB_TMO])) break; if (_sp > XB_SPIN_CAP) { atomicAdd(&(bar)[XB_TMO], 1u); break; } } } } while (0)
struct XcdBarrier { unsigned* bar; unsigned x; volatile LDSAS unsigned* st; };
__device__ __forceinline__ XcdBarrier xcd_barrier_post(unsigned* bar, volatile LDSAS unsigned* st) {
    XcdBarrier b; b.bar = bar; b.x = xb_xcc_id(); b.st = st;
    if (threadIdx.x == 0) (void)xb_add(&bar[XB_XCNT(b.x)], 1u);
    return b;
}
__device__ __forceinline__ void xcd_barrier_complete(unsigned* bar, unsigned x, unsigned& nloc, unsigned& nx) {
    const unsigned G = gridDim.x * gridDim.y * gridDim.z;
    unsigned sum, cnt, mine, sp = 0u;
    for (;;) {
        sum = 0u; cnt = 0u; mine = 0u;
#pragma unroll
        for (unsigned j = 0; j < 16; ++j) { const unsigned c = xb_ld(&bar[XB_XCNT(j)]); sum += c; cnt += (c > 0u) ? 1u : 0u; mine = (j == x) ? c : mine; }
        if (sum == G) break;
        __builtin_amdgcn_s_sleep(1);
        if ((++sp & 255u) == 0u) { if (xb_ld(&bar[XB_TMO])) break; if (sp > XB_SPIN_CAP) { atomicAdd(&bar[XB_TMO], 1u); break; } }
    }
    nloc = mine > 0u ? mine : 1u; nx = cnt > 0u ? cnt : 1u;
}
__device__ __forceinline__ void xcd_barrier(const XcdBarrier& b) {
    asm volatile("s_waitcnt vmcnt(0)" ::: "memory");
    __syncthreads();
    if (threadIdx.x == 0) {
        unsigned* bar = b.bar;
        __builtin_amdgcn_s_waitcnt(0);
        unsigned nloc = b.st[0], nx = b.st[1];
        if (nloc == 0u) { xcd_barrier_complete(bar, b.x, nloc, nx); b.st[0] = nloc; b.st[1] = nx; }
        const unsigned old = xb_add(&bar[XB_XSUB(b.x)], 1u);
        const unsigned gen = old / nloc;
        if (old + 1u == (gen + 1u) * nloc) {
            __builtin_amdgcn_fence(__ATOMIC_RELEASE, "agent");
            asm volatile("s_waitcnt vmcnt(0)" ::: "memory");
            const unsigned og = xb_add(&bar[XB_TOP], 1u);
            const unsigned tg = og / nx;
            if (og + 1u == (tg + 1u) * nx) xb_add(&bar[XB_TOPGEN], 1u);
            else XB_SPIN(xb_ld(&bar[XB_TOPGEN]) == tg, bar);
            __builtin_amdgcn_fence(__ATOMIC_ACQUIRE, "agent");
            xb_add(&bar[XB_XGEN(b.x)], 1u);
            asm volatile("s_waitcnt vmcnt(0)" ::: "memory");
        } else {
            XB_SPIN(xb_ld(&bar[XB_XGEN(b.x)]) == gen, bar);
            __builtin_amdgcn_fence(__ATOMIC_ACQUIRE, "agent");
            asm volatile("s_waitcnt vmcnt(0)" ::: "memory");
        }
    }
    __syncthreads();
}

__device__ __forceinline__ unsigned char* lds_half(unsigned char* smem) { int h_ = threadIdx.x >> 8; asm volatile("" : "+v"(h_)); return smem + h_ * HALF_LDS; }
__global__ void __launch_bounds__(512, 2) hybrid_fwd(Params p) {
    cg::grid_group grid = cg::this_grid();
    extern __shared__ __attribute__((aligned(16))) unsigned char smem[];
    volatile LDSAS unsigned* bst = (volatile LDSAS unsigned*)(smem + LDS_TOTAL - 16);
    if (threadIdx.x < 4) bst[threadIdx.x] = 0u;
    __syncthreads();
    const XcdBarrier xbar = xcd_barrier_post((unsigned*)(p.ws + WS_BAR), bst);
    { const Params q = launder(p); phase0(q, lds_half(smem)); }
    grid.sync();
#pragma unroll 1
    for (int l = 0; l < DEPTH; ++l) {
#pragma unroll 1
        for (int hb = 0; hb < 2; ++hb) {
            { const Params q = launder(p); norm_phase(q, l, hb, (l == 0) ? q.x : q.out); }
            xcd_barrier(xbar);
            { const Params q = launder(p); gemm1_phase(q, l, hb, smem); }
            xcd_barrier(xbar);
            { const Params q = launder(p); conv_phase(q, l); }
            xcd_barrier(xbar);
            { const Params q = launder(p); unsigned char* smh = lds_half(smem);
#pragma unroll 1
              for (int it = VBLK; it < 512; it += VGRID) ssd_item<1>(q, it, l, smh);
#pragma unroll 1
              for (int it = blockIdx.x; it < 768; it += gridDim.x) attn_b_item(q, it, l, smem); }
            xcd_barrier(xbar);
            { const Params q = launder(p);
#pragma unroll 1
              for (int it = blockIdx.x; it < 512; it += gridDim.x) attn_a_item(q, it, l, smem);
              unsigned char* smh = lds_half(smem);
#pragma unroll 1
              for (int it = VBLK; it < 512; it += VGRID) ssd_item<3>(q, it, l, smh); }
            xcd_barrier(xbar);
            { const Params q = launder(p); post2_phase(q); }
            xcd_barrier(xbar);
            { const Params q = launder(p); merge_phase(q, l, smem); }
            xcd_barrier(xbar);
            { const Params q = launder(p); out_phase(q, l, hb, (l == 0) ? q.x : q.out, smem); }
        }
    }
}

extern "C" void kernel_launch(void* const* d_in, const int* in_sizes, int n_in, void* d_out, int out_size, void* d_ws, size_t ws_size, hipStream_t stream) {
    static int grid_blocks = 0;
    if (!grid_blocks) {
        int dev = 0, cus = 0, per_cu = 0;
        hipGetDevice(&dev);
        hipDeviceGetAttribute(&cus, hipDeviceAttributeMultiprocessorCount, dev);
        hipFuncSetAttribute((const void*)hybrid_fwd, hipFuncAttributeMaxDynamicSharedMemorySize, LDS_TOTAL);
        hipOccupancyMaxActiveBlocksPerMultiprocessor(&per_cu, hybrid_fwd, 512, LDS_TOTAL);
        if (per_cu > 1) per_cu = 1;
        if (per_cu < 1) per_cu = 1;
        grid_blocks = cus * per_cu;
    }
    Params p{};
    const float** pp = (const float**)&p;
    for (int i = 0; i < 22; ++i) pp[i] = (const float*)d_in[i];
    p.out = (float*)d_out; p.ws = (unsigned char*)d_ws;
    hipMemsetAsync((unsigned char*)d_ws + WS_BAR, 0, XCD_BAR_WORDS * 4, stream);
    void* args[] = {&p};
    hipError_t e = hipLaunchCooperativeKernel((void*)hybrid_fwd, dim3(grid_blocks), dim3(512), args, LDS_TOTAL, stream);
    if (e != hipSuccess) fprintf(stderr, "cooperative launch failed: %s (grid %d)\n", hipGetErrorString(e), grid_blocks);
}
```

```cpp
#include <hip/hip_runtime.h>
#include <hip/hip_cooperative_groups.h>
#include <cstdint>
#include <cstdio>
namespace cg = cooperative_groups;

typedef unsigned short bf16_t;
typedef short bf16x8 __attribute__((ext_vector_type(8)));
typedef short v4i16 __attribute__((ext_vector_type(4)));
typedef float f32x2 __attribute__((ext_vector_type(2)));
typedef float f32x4 __attribute__((ext_vector_type(4)));
typedef float f32x16 __attribute__((ext_vector_type(16)));
typedef unsigned u32x2 __attribute__((ext_vector_type(2)));
typedef unsigned u32x4 __attribute__((ext_vector_type(4)));
typedef __bf16 bf16x2_t __attribute__((ext_vector_type(2)));
#define LDSAS __attribute__((address_space(3)))
#define VTID ((int)(threadIdx.x & 255u))
__device__ __forceinline__ int vblk_() { int h_ = threadIdx.x >> 8; asm volatile("" : "+v"(h_)); return __builtin_amdgcn_readfirstlane(2 * (int)blockIdx.x + h_); }
#define VBLK vblk_()
#define VGRID ((int)(2u * gridDim.x))
constexpr int HALF_LDS = 73728, LDS_TOTAL = 147456;

constexpr int SEQ = 8192, DM = 1024, NBATCH = 4, NBH = 2, TP = NBH * SEQ, DEPTH = 2;
constexpr int NP = 8704;
constexpr float EPS = 1e-6f;
constexpr float LOG2E = 1.4426950408889634f, LN2 = 0.6931471805599453f;
constexpr int NSEG = 16, SEGLEN = 512, TSUB = 32, NSUB = SEGLEN / TSUB;

constexpr size_t MiB = 1u << 20;
constexpr size_t WS_WIN = 0;
constexpr size_t WS_WPA = 34 * MiB;
constexpr size_t WS_WPB = 36 * MiB;
constexpr size_t WS_WPC = 37 * MiB;
constexpr size_t WS_WOUT = 39 * MiB;
constexpr size_t WS_MOD = 43 * MiB;
constexpr size_t WS_ROPE = 43 * MiB + 128 * 1024;
constexpr size_t WS_BND = 43 * MiB + 160 * 1024;
constexpr size_t WS_RSTD = 43 * MiB + 256 * 1024;
constexpr size_t WS_SEGT = 43 * MiB + 512 * 1024;
constexpr size_t WS_LSE = 44 * MiB;
constexpr size_t WS_DT = 45 * MiB;
constexpr size_t WS_BAR = 46 * MiB;
constexpr size_t WS_H = 48 * MiB;
constexpr size_t WS_QA = 80 * MiB;
constexpr size_t WS_KA = 96 * MiB;
constexpr size_t WS_VA = 100 * MiB;
constexpr size_t WS_GA = 104 * MiB;
constexpr size_t WS_QB = 120 * MiB;
constexpr size_t WS_KB = 144 * MiB;
constexpr size_t WS_VB = 168 * MiB;
constexpr size_t WS_GB = 192 * MiB;
constexpr size_t WS_XBC = 200 * MiB;
constexpr size_t WS_ZS = 232 * MiB;
constexpr size_t WS_MG = 248 * MiB;
constexpr size_t WS_YF = 344 * MiB;
constexpr size_t WS_YS = 360 * MiB;
constexpr size_t WS_YBM = 376 * MiB;
constexpr size_t WS_YC = 384 * MiB;
constexpr size_t WS_MRG = 400 * MiB;
constexpr size_t WS_ST = 432 * MiB;
constexpr size_t WS_XBCC = 448 * MiB;

struct Params {
    const float *x, *c, *norm_w, *w_ada, *b_ada, *w_in, *b_gate, *q_norm_a, *k_norm_a, *q_norm_b, *k_norm_b, *rel_bias,
        *conv_w, *conv_b, *a_log, *dt_bias, *d_skip, *ssm_norm_w, *w_proj_a, *w_proj_b, *w_proj_c, *w_out;
    float* out;
    unsigned char* ws;
};


#define AS1 __attribute__((address_space(1)))
#define GLOBF(f) do { AS1 const float* g_ = (AS1 const float*)p.f; asm volatile("" : "+s"(g_)); q.f = (const float*)g_; } while (0)
__device__ __forceinline__ Params launder(const Params& p) {
    Params q;
    GLOBF(x); GLOBF(c); GLOBF(norm_w); GLOBF(w_ada); GLOBF(b_ada); GLOBF(w_in); GLOBF(b_gate); GLOBF(q_norm_a); GLOBF(k_norm_a); GLOBF(q_norm_b); GLOBF(k_norm_b); GLOBF(rel_bias);
    GLOBF(conv_w); GLOBF(conv_b); GLOBF(a_log); GLOBF(dt_bias); GLOBF(d_skip); GLOBF(ssm_norm_w); GLOBF(w_proj_a); GLOBF(w_proj_b); GLOBF(w_proj_c); GLOBF(w_out);
    { AS1 float* g_ = (AS1 float*)p.out; asm volatile("" : "+s"(g_)); q.out = (float*)g_; }
    { AS1 unsigned char* g_ = (AS1 unsigned char*)p.ws; asm volatile("" : "+s"(g_)); q.ws = (unsigned char*)g_; }
    return q;
}
__device__ __forceinline__ unsigned pk2(float lo, float hi) { f32x2 v = {lo, hi}; bf16x2_t b = __builtin_convertvector(v, bf16x2_t); return __builtin_bit_cast(unsigned, b); }
__device__ __forceinline__ float bf2f(unsigned short b) { return __uint_as_float(((unsigned)b) << 16); }
__device__ __forceinline__ float bflo(unsigned u) { return __uint_as_float(u << 16); }
__device__ __forceinline__ float bfhi(unsigned u) { return __uint_as_float(u & 0xffff0000u); }
__device__ __forceinline__ float siluf(float v) { return v * __builtin_amdgcn_rcpf(1.f + __builtin_amdgcn_exp2f(-1.4426950408889634f * v)); }
__device__ __forceinline__ float sigmf(float v) { return __builtin_amdgcn_rcpf(1.f + __builtin_amdgcn_exp2f(-1.4426950408889634f * v)); }
__device__ __forceinline__ float wave_sum(float v) {
#pragma unroll
    for (int o = 1; o < 64; o <<= 1) v += __shfl_xor(v, o);
    return v;
}
__device__ __forceinline__ v4i16 tr16(const unsigned char* p) { return __builtin_amdgcn_ds_read_tr16_b64_v4i16((LDSAS v4i16*)p); }
__device__ __forceinline__ bf16x8 cat8(v4i16 a, v4i16 b) { return (bf16x8){a[0], a[1], a[2], a[3], b[0], b[1], b[2], b[3]}; }
__device__ __forceinline__ int crow(int r, int hi) { return (r & 3) + 8 * (r >> 2) + 4 * hi; }

struct P0It { const float* W; bf16_t* Wt; const float* rs; int ldw, K, k0, n0, mode; };
__device__ __forceinline__ void p0_load(const P0It& t, float (&vv)[16]) {
    const int tid = VTID, tx = tid & 63, ty = tid >> 6;
    const int np = t.n0 + tx; int n = np; bool valid = true;
    if (t.mode == 1) {
        if (np < 4352) n = np; else if (np < 4864) n = np + 512; else if (np < 5376) n = np - 512;
        else if (np < 8448) n = np + 16; else if (np < 8464) n = np - 3072; else { valid = false; n = 0; }
    }
#pragma unroll
    for (int i = 0; i < 16; ++i) { const int k = ty + 4 * i; vv[i] = valid ? t.W[(size_t)(t.k0 + k) * t.ldw + n] : 0.f; }
}
__device__ __forceinline__ void p0_finish(const P0It& t, const float (&vv)[16], float* tile) {
    const int tid = VTID, tx = tid & 63, ty = tid >> 6;
#pragma unroll
    for (int i = 0; i < 16; ++i) { const int k = ty + 4 * i; float v = vv[i]; if (t.rs) v *= t.rs[t.k0 + k]; tile[k * 65 + tx] = v; }
    __syncthreads();
    const int r = tid >> 2, kc = (tid & 3) * 16;
    u32x4 o0, o1;
    o0.x = pk2(tile[(kc + 0) * 65 + r], tile[(kc + 1) * 65 + r]); o0.y = pk2(tile[(kc + 2) * 65 + r], tile[(kc + 3) * 65 + r]);
    o0.z = pk2(tile[(kc + 4) * 65 + r], tile[(kc + 5) * 65 + r]); o0.w = pk2(tile[(kc + 6) * 65 + r], tile[(kc + 7) * 65 + r]);
    o1.x = pk2(tile[(kc + 8) * 65 + r], tile[(kc + 9) * 65 + r]); o1.y = pk2(tile[(kc + 10) * 65 + r], tile[(kc + 11) * 65 + r]);
    o1.z = pk2(tile[(kc + 12) * 65 + r], tile[(kc + 13) * 65 + r]); o1.w = pk2(tile[(kc + 14) * 65 + r], tile[(kc + 15) * 65 + r]);
    bf16_t* dst = t.Wt + (size_t)(t.n0 + r) * t.K + t.k0 + kc;
    *(u32x4*)dst = o0; *(u32x4*)(dst + 8) = o1;
    __syncthreads();
}
constexpr int P0_IN = 16 * 136, P0_PA = 8 * 16, P0_PB = 4 * 16, P0_PC = 8 * 16, P0_OUT = 16 * 16, P0_L = P0_IN + P0_PA + P0_PB + P0_PC + P0_OUT;
__device__ __forceinline__ P0It p0_params(const Params& p, int item) {
    P0It t; const int l = item / P0_L; int r = item % P0_L; t.rs = nullptr; t.mode = 0;
    if (r < P0_IN) { t.W = p.w_in + (size_t)l * 1024 * 8464; t.ldw = 8464; t.K = 1024; t.Wt = (bf16_t*)(p.ws + WS_WIN) + (size_t)l * NP * 1024; t.k0 = (r / 136) * 64; t.n0 = (r % 136) * 64; t.mode = 1; return t; }
    r -= P0_IN;
    if (r < P0_PA) { t.W = p.w_proj_a + (size_t)l * 512 * 1024; t.ldw = 1024; t.K = 512; t.Wt = (bf16_t*)(p.ws + WS_WPA) + (size_t)l * 1024 * 512; t.k0 = (r / 16) * 64; t.n0 = (r % 16) * 64; return t; }
    r -= P0_PA;
    if (r < P0_PB) { t.W = p.w_proj_b + (size_t)l * 256 * 1024; t.ldw = 1024; t.K = 256; t.Wt = (bf16_t*)(p.ws + WS_WPB) + (size_t)l * 1024 * 256; t.k0 = (r / 16) * 64; t.n0 = (r % 16) * 64; return t; }
    r -= P0_PB;
    if (r < P0_PC) { t.W = p.w_proj_c + (size_t)l * 512 * 1024; t.ldw = 1024; t.K = 512; t.Wt = (bf16_t*)(p.ws + WS_WPC) + (size_t)l * 1024 * 512; t.k0 = (r / 16) * 64; t.n0 = (r % 16) * 64; t.rs = p.ssm_norm_w + l * 512; return t; }
    r -= P0_PC;
    t.W = p.w_out + (size_t)l * 1024 * 1024; t.ldw = 1024; t.K = 1024; t.Wt = (bf16_t*)(p.ws + WS_WOUT) + (size_t)l * 1024 * 1024; t.k0 = (r / 16) * 64; t.n0 = (r % 16) * 64; return t;
}

__device__ void phase0(const Params& p, unsigned char* smem) {
    const int tid = VTID;
    float* tile = (float*)smem;
    constexpr int I_T = 2 * P0_L, I_MOD = 192, I_ALL = I_T + I_MOD + 1;
    {
        int item = VBLK;
        if (item < I_T) {
            P0It cur = p0_params(p, item); float va[16], vb[16]; p0_load(cur, va);
            for (;;) {
                const int nx = item + VGRID; const bool more = nx < I_T; P0It nxt = cur;
                if (more) { nxt = p0_params(p, nx); p0_load(nxt, vb); }
                p0_finish(cur, va, tile);
                if (!more) break;
                item = nx; cur = nxt;
#pragma unroll
                for (int i = 0; i < 16; ++i) va[i] = vb[i];
            }
        }
    }
    for (int item = VBLK; item < I_ALL; item += VGRID) {
        if (item < I_T) {
            continue;
        } else if (item < I_T + I_MOD) {
            const int it = item - I_T, l = it / 96, col0 = (it % 96) * 32, cl = tid & 31, ks = tid >> 5;
            float a0 = 0.f, a1 = 0.f, a2 = 0.f, a3 = 0.f;
            const float* wp = p.w_ada + ((size_t)l * 1024 + ks * 128) * 3072 + col0 + cl;
#pragma unroll 8
            for (int k = 0; k < 128; ++k) {
                const float wv = wp[(size_t)k * 3072]; const int kk = ks * 128 + k;
                a0 += siluf(p.c[kk]) * wv; a1 += siluf(p.c[1024 + kk]) * wv; a2 += siluf(p.c[2048 + kk]) * wv; a3 += siluf(p.c[3072 + kk]) * wv;
            }
            float* red = (float*)smem;
            red[(ks * 32 + cl) * 4 + 0] = a0; red[(ks * 32 + cl) * 4 + 1] = a1; red[(ks * 32 + cl) * 4 + 2] = a2; red[(ks * 32 + cl) * 4 + 3] = a3;
            __syncthreads();
            if (tid < 128) { const int b = tid >> 5, c2 = tid & 31; float s = 0.f;
#pragma unroll
                for (int k = 0; k < 8; ++k) s += red[(k * 32 + c2) * 4 + b];
                ((float*)(p.ws + WS_MOD))[(l * 4 + b) * 3072 + col0 + c2] = s + p.b_ada[l * 3072 + col0 + c2]; }
            __syncthreads();
        } else {
            float* rc = (float*)(p.ws + WS_ROPE); float* rs = rc + 128 * 16;
            for (int e = tid; e < 2048; e += 256) {
                const int pos = e >> 4, i = e & 15;
                const float freq = powf(10000.0f, -(float)i / 16.0f);
                const float ang = (float)pos * freq;
                const double rev = (double)ang * 0.15915494309189535; const double fr = rev - rint(rev);
                const float a = (float)(fr * 6.283185307179586);
                rc[e] = cosf(a); rs[e] = sinf(a);
            }
            if (tid < 2) {
                const int l = tid; float mqa = 0.f, mka = 0.f, mqb = 0.f, mkb = 0.f, mb = 0.f;
                for (int i = 0; i < 64; ++i) { mqa = fmaxf(mqa, fabsf(p.q_norm_a[l * 64 + i])); mka = fmaxf(mka, fabsf(p.k_norm_a[l * 64 + i]));
                    mqb = fmaxf(mqb, fabsf(p.q_norm_b[l * 64 + i])); mkb = fmaxf(mkb, fabsf(p.k_norm_b[l * 64 + i])); }
                for (int i = 0; i < 32 * 12; ++i) mb = fmaxf(mb, p.rel_bias[i]);
                float* bd = (float*)(p.ws + WS_BND);
                bd[l] = 8.f * mqa * mka * LOG2E; bd[2 + l] = (8.f * mqb * mkb + mb) * LOG2E;
            }
        }
    }
}

__device__ void norm_phase(const Params& p, int l, int hb, const float* xsrc) {
    int tx_ = threadIdx.x; asm volatile("" : "+v"(tx_));
    const int lane = tx_ & 63, gw = blockIdx.x * 8 + (tx_ >> 6), nw = gridDim.x * 8;
    bf16_t* H = (bf16_t*)(p.ws + WS_H);
    const float* nwp = p.norm_w + l * 1024;
    for (int row0 = gw; row0 < TP; row0 += 4 * nw) {
        f32x4 v[4][4];
#pragma unroll
        for (int q = 0; q < 4; ++q) { const int row = row0 + q * nw;
            if (row < TP) { const f32x4* xr = (const f32x4*)(xsrc + ((size_t)hb * TP + row) * 1024);
#pragma unroll
                for (int j = 0; j < 4; ++j) v[q][j] = xr[lane + 64 * j]; } }
#pragma unroll
        for (int q = 0; q < 4; ++q) { const int row = row0 + q * nw;
            if (row < TP) {
                const size_t rg = (size_t)hb * TP + row; const int b = (int)(rg / SEQ);
                const float* md = (const float*)(p.ws + WS_MOD) + (size_t)(l * 4 + b) * 3072;
                float ss = 0.f;
#pragma unroll
                for (int j = 0; j < 4; ++j) ss += v[q][j].x * v[q][j].x + v[q][j].y * v[q][j].y + v[q][j].z * v[q][j].z + v[q][j].w * v[q][j].w;
                ss = wave_sum(ss); const float rstd = rsqrtf(ss * (1.f / 1024.f) + EPS);
#pragma unroll
                for (int j = 0; j < 4; ++j) {
                    const int col = 4 * (lane + 64 * j);
                    const f32x4 w4 = *(const f32x4*)(nwp + col), sh = *(const f32x4*)(md + col), sc = *(const f32x4*)(md + 1024 + col);
                    const f32x4 o = v[q][j] * rstd * w4 * (1.f + sc) + sh;
                    u32x2 pk; pk.x = pk2(o.x, o.y); pk.y = pk2(o.z, o.w);
                    *(u32x2*)(H + (size_t)row * 1024 + col) = pk;
                }
            } }
    }
}

constexpr int G_STAGE = 65536, G_AB = 32768;
template <bool LOWREG = false>
__device__ __forceinline__ void gemm_core(const bf16_t* __restrict__ A, int lda, const bf16_t* __restrict__ Bt, int ldb, int K, f32x4 (&acc)[8][4], unsigned char* smem, int tid) {
    asm volatile("" : "+v"(tid));
    const int lane = tid & 63, w = __builtin_amdgcn_readfirstlane(tid >> 6), wm = w >> 2, wn = w & 3, idx = lane & 15, kq = lane >> 4;
    unsigned offA[4], offB[4];
#pragma unroll
    for (int j = 0; j < 4; ++j) { const int row = (j * 8 + w) * 8 + (lane >> 3), c = (lane & 7) ^ ((row >> 1) & 7);
        offA[j] = (unsigned)(row * lda + c * 8) * 2u; offB[j] = (unsigned)(row * ldb + c * 8) * 2u; }
#pragma unroll
    for (int mi = 0; mi < 8; ++mi)
#pragma unroll
        for (int ni = 0; ni < 4; ++ni) acc[mi][ni] = (f32x4){0.f, 0.f, 0.f, 0.f};
    LDSAS unsigned char* lds = (LDSAS unsigned char*)smem;
#define G_ISSUE1(kt, st, j) do { \
        __builtin_amdgcn_global_load_lds((const unsigned*)((const char*)A + offA[j] + (kt) * 128), (LDSAS unsigned*)(lds + (st) * G_STAGE + ((j) * 8 + w) * 1024), 16, 0, 0); \
        __builtin_amdgcn_global_load_lds((const unsigned*)((const char*)Bt + offB[j] + (kt) * 128), (LDSAS unsigned*)(lds + (st) * G_STAGE + G_AB + ((j) * 8 + w) * 1024), 16, 0, 0); } while (0)
#define G_ISSUE(kt, st) do { G_ISSUE1(kt, st, 0); G_ISSUE1(kt, st, 1); G_ISSUE1(kt, st, 2); G_ISSUE1(kt, st, 3); } while (0)
    const int nk = K >> 6;
    G_ISSUE(0, 0);
    asm volatile("s_waitcnt vmcnt(0)" ::: "memory");
    __syncthreads();
    const int swz = (idx >> 1) & 7;
    const int aoff = (wm * 128 + idx) * 128, boff = G_AB + (wn * 64 + idx) * 128;
    for (int kt = 0; kt < nk; ++kt) {
        const int st = kt & 1;
        const bool more = kt + 1 < nk;
        const unsigned char* sb = smem + st * G_STAGE;
        if constexpr (!LOWREG) {
#pragma unroll
        for (int ks = 0; ks < 2; ++ks) {
            bf16x8 bfr[4], af[8];
            const int co = ((ks * 4 + kq) ^ swz) * 16;
#pragma unroll
            for (int ni = 0; ni < 4; ++ni) bfr[ni] = *(const bf16x8*)(sb + boff + ni * 2048 + co);
#pragma unroll
            for (int mi = 0; mi < 8; ++mi) af[mi] = *(const bf16x8*)(sb + aoff + mi * 2048 + co);
            if (more) { G_ISSUE1(kt + 1, st ^ 1, ks * 2); G_ISSUE1(kt + 1, st ^ 1, ks * 2 + 1); }
            __builtin_amdgcn_sched_barrier(0);
            __builtin_amdgcn_s_setprio(1);
#pragma unroll
            for (int mi = 0; mi < 8; ++mi)
#pragma unroll
                for (int ni = 0; ni < 4; ++ni) acc[mi][ni] = __builtin_amdgcn_mfma_f32_16x16x32_bf16(bfr[ni], af[mi], acc[mi][ni], 0, 0, 0);
            __builtin_amdgcn_s_setprio(0);
            __builtin_amdgcn_sched_barrier(0);
        }
        } else {
#pragma unroll
        for (int ks = 0; ks < 2; ++ks) {
            bf16x8 bfr[4];
            const int co = ((ks * 4 + kq) ^ swz) * 16;
#pragma unroll
            for (int ni = 0; ni < 4; ++ni) bfr[ni] = *(const bf16x8*)(sb + boff + ni * 2048 + co);
#pragma unroll
            for (int mh = 0; mh < 2; ++mh) {
                bf16x8 af[4];
#pragma unroll
                for (int mi = 0; mi < 4; ++mi) af[mi] = *(const bf16x8*)(sb + aoff + (mh * 4 + mi) * 2048 + co);
                if (more) G_ISSUE1(kt + 1, st ^ 1, ks * 2 + mh);
                __builtin_amdgcn_sched_barrier(0);
                __builtin_amdgcn_s_setprio(1);
#pragma unroll
                for (int mi = 0; mi < 4; ++mi)
#pragma unroll
                    for (int ni = 0; ni < 4; ++ni) acc[mh * 4 + mi][ni] = __builtin_amdgcn_mfma_f32_16x16x32_bf16(bfr[ni], af[mi], acc[mh * 4 + mi][ni], 0, 0, 0);
                __builtin_amdgcn_s_setprio(0);
                __builtin_amdgcn_sched_barrier(0);
            }
        }
        }
        asm volatile("s_waitcnt vmcnt(0)" ::: "memory");
        __syncthreads();
    }
#undef G_ISSUE1
#undef G_ISSUE
}

__device__ __forceinline__ void st4bf(bf16_t* dst, f32x4 v) { u32x2 pk; pk.x = pk2(v.x, v.y); pk.y = pk2(v.z, v.w); *(u32x2*)dst = pk; }

__device__ void gemm1_phase(const Params& p, int l, int hb, unsigned char* smem) {
    const bf16_t* H = (const bf16_t*)(p.ws + WS_H);
    const bf16_t* Wt = (const bf16_t*)(p.ws + WS_WIN) + (size_t)l * NP * 1024;
    const float* ropec = (const float*)(p.ws + WS_ROPE); const float* ropes = ropec + 2048;
    constexpr int NT = 34, NTILES = 64 * NT, GRP = 8 * NT;
    for (int t = blockIdx.x; t < NTILES; t += gridDim.x) {
        const int grp = t / GRP, r = t % GRP, jx = NT * (r & 7) + (r >> 3), mt = grp * 8 + (jx & 7), nt = jx >> 3;
        const int m0 = mt * 256, n0 = nt * 256;
        f32x4 acc[8][4];
        int tid = threadIdx.x;
        gemm_core(H + (size_t)m0 * 1024, 1024, Wt + (size_t)n0 * 1024, 1024, 1024, acc, smem, tid);
        asm volatile("" : "+v"(tid));
        const int lane = tid & 63, w = __builtin_amdgcn_readfirstlane(tid >> 6), wm = w >> 2, wn = w & 3, idx = lane & 15, kq = lane >> 4;
        const int cw = n0 + wn * 64;
        const int lc = 4 * kq;
        unsigned char* wl = smem + w * 16384;
#define G1_STG(mi_, ni_, v_) do { const int r_ = (mi_) * 16 + idx; const f32x4 t_ = (v_); u32x2 pk_; pk_.x = pk2(t_.x, t_.y); pk_.y = pk2(t_.z, t_.w); \
        *(u32x2*)(wl + r_ * 128 + ((((ni_) * 2 + (kq >> 1)) ^ (r_ & 7)) * 16) + (kq & 1) * 8) = pk_; } while (0)
        bf16_t* dbase = nullptr; int dpitch = 0, dc0 = 0, dsh = -1, dg = 0;
        if (cw < 768 && (cw < 640)) {
            const bool isq = cw < 512;
            const float* nwp = (isq ? p.q_norm_a : p.k_norm_a) + l * 64;
            dbase = isq ? (bf16_t*)(p.ws + WS_QA) : (bf16_t*)(p.ws + WS_KA);
            dpitch = isq ? 512 : 128; dc0 = isq ? cw : cw - 512;
            const float qs = isq ? 0.125f * LOG2E : 1.f;
#pragma unroll
            for (int mi = 0; mi < 8; ++mi) {
                const int row = m0 + wm * 128 + mi * 16 + idx;
                float ss = 0.f;
#pragma unroll
                for (int ni = 0; ni < 4; ++ni) { const f32x4 v = acc[mi][ni]; ss += v.x * v.x + v.y * v.y + v.z * v.z + v.w * v.w; }
                ss += __shfl_xor(ss, 16); ss += __shfl_xor(ss, 32);
                const float rstd = rsqrtf(ss * (1.f / 64.f) + EPS);
                f32x4 y[4];
#pragma unroll
                for (int ni = 0; ni < 4; ++ni) y[ni] = acc[mi][ni] * rstd * *(const f32x4*)(nwp + ni * 16 + lc);
                const int tt = row & (SEQ - 1), prow = tt >> 6, pcol = tt & 63;
#pragma unroll
                for (int hf = 0; hf < 2; ++hf) {
                    const int pos = hf ? pcol : prow;
                    const f32x4 cs = *(const f32x4*)(ropec + pos * 16 + lc), sn = *(const f32x4*)(ropes + pos * 16 + lc);
                    const f32x4 a = y[2 * hf], b = y[2 * hf + 1];
                    y[2 * hf] = a * cs - b * sn; y[2 * hf + 1] = b * cs + a * sn;
                }
#pragma unroll
                for (int ni = 0; ni < 4; ++ni) G1_STG(mi, ni, y[ni] * qs);
            }
        } else if (cw >= 1280 && cw < 2816) {
            const bool isq = cw < 2048;
            const float* nwp = (isq ? p.q_norm_b : p.k_norm_b) + l * 64;
            const int gc = isq ? cw - 1280 : cw - 2048;
            dg = gc >> 8; dc0 = gc & 255; dsh = 2 * dg; dpitch = 256;
            dbase = (bf16_t*)(p.ws + (isq ? WS_QB : WS_KB));
            const float qs = isq ? 0.125f * LOG2E : 1.f;
#pragma unroll
            for (int mi = 0; mi < 8; ++mi) {
                float ss = 0.f;
#pragma unroll
                for (int ni = 0; ni < 4; ++ni) { const f32x4 v = acc[mi][ni]; ss += v.x * v.x + v.y * v.y + v.z * v.z + v.w * v.w; }
                ss += __shfl_xor(ss, 16); ss += __shfl_xor(ss, 32);
                const float rstd = rsqrtf(ss * (1.f / 64.f) + EPS) * qs;
#pragma unroll
                for (int ni = 0; ni < 4; ++ni) G1_STG(mi, ni, acc[mi][ni] * rstd * *(const f32x4*)(nwp + ni * 16 + lc));
            }
        } else if (cw >= 2816 && cw < 3584) {
            const int gc = cw - 2816;
            dg = gc >> 8; dc0 = gc & 255; dsh = 2 * dg; dpitch = 256; dbase = (bf16_t*)(p.ws + WS_VB);
#pragma unroll
            for (int mi = 0; mi < 8; ++mi)
#pragma unroll
                for (int ni = 0; ni < 4; ++ni) G1_STG(mi, ni, acc[mi][ni]);
        } else if (cw >= 8448) {
            if (cw == 8448) {
                float* dst = (float*)(p.ws + WS_DT);
                const f32x4 bias = *(const f32x4*)(p.dt_bias + l * 16 + lc);
#pragma unroll
                for (int mi = 0; mi < 8; ++mi) {
                    const int row = m0 + wm * 128 + mi * 16 + idx;
                    f32x4 v = acc[mi][0] + bias, o;
                    o.x = v.x > 20.f ? v.x : log1pf(__expf(v.x)); o.y = v.y > 20.f ? v.y : log1pf(__expf(v.y));
                    o.z = v.z > 20.f ? v.z : log1pf(__expf(v.z)); o.w = v.w > 20.f ? v.w : log1pf(__expf(v.w));
                    *(f32x4*)(dst + (size_t)row * 16 + lc) = o;
                }
            }
        } else {
            int mode;
            if (cw < 768) { dbase = (bf16_t*)(p.ws + WS_VA); dpitch = 128; dc0 = cw - 640; mode = 0; }
            else if (cw < 1280) { dbase = (bf16_t*)(p.ws + WS_GA); dpitch = 512; dc0 = cw - 768; mode = 1; }
            else if (cw < 3840) { dbase = (bf16_t*)(p.ws + WS_GB); dpitch = 256; dc0 = cw - 3584; mode = 1; }
            else if (cw < 4864) { dbase = (bf16_t*)(p.ws + WS_XBC); dpitch = 1024; dc0 = cw - 3840; mode = 0; }
            else if (cw < 5376) { dbase = (bf16_t*)(p.ws + WS_ZS); dpitch = 512; dc0 = cw - 4864; mode = 1; }
            else { dbase = (bf16_t*)(p.ws + WS_MG); dpitch = 3072; dc0 = cw - 5376; mode = 2; }
            const float* bg = p.b_gate + l * 3072 + dc0 + lc;
#pragma unroll
            for (int mi = 0; mi < 8; ++mi) {
#pragma unroll
                for (int ni = 0; ni < 4; ++ni) {
                    f32x4 v = acc[mi][ni];
                    if (mode == 1) { v.x = siluf(v.x); v.y = siluf(v.y); v.z = siluf(v.z); v.w = siluf(v.w); }
                    else if (mode == 2) { const f32x4 bb = *(const f32x4*)(bg + ni * 16); v.x = sigmf(v.x + bb.x); v.y = sigmf(v.y + bb.y); v.z = sigmf(v.z + bb.z); v.w = sigmf(v.w + bb.w); }
                    G1_STG(mi, ni, v);
                }
            }
        }
#undef G1_STG
        if (dbase) {
            const int ch = lane & 7;
#pragma unroll
            for (int j = 0; j < 16; ++j) {
                const int rl = 8 * j + (lane >> 3), row = m0 + wm * 128 + rl;
                const u32x4 v = *(const u32x4*)(wl + rl * 128 + ((ch ^ (rl & 7)) * 16));
                size_t drow = (size_t)row;
                if (dsh >= 0) { const int bl = row >> 13, tt = row & (SEQ - 1); drow = (size_t)(bl * 3 + dg) * SEQ + (size_t)((tt & ((1 << dsh) - 1)) * (SEQ >> dsh) + (tt >> dsh)); }
                *(u32x4*)(dbase + drow * dpitch + dc0 + ch * 8) = v;
            }
        }
        __syncthreads();
    }
}

__device__ void merge_phase(const Params& p, int l, unsigned char* smem) {
    const bf16_t* MG = (const bf16_t*)(p.ws + WS_MG);
    const float* rstd = (const float*)(p.ws + WS_RSTD);
    bf16_t* MR = (bf16_t*)(p.ws + WS_MRG);
    for (int t = blockIdx.x; t < 64 * 4; t += gridDim.x) {
        const int xq = t >> 3, mt = (xq >> 2) * 8 + (t & 7), nt = xq & 3, m0 = mt * 256, n0 = nt * 256;
        u32x2 mpk[6][4];
#pragma unroll 1
        for (int br = 0; br < 3; ++br) {
            f32x4 acc[8][4];
            const bf16_t* A; const bf16_t* Bt; int K;
            if (br == 0) { A = (const bf16_t*)(p.ws + WS_QA); K = 512; Bt = (const bf16_t*)(p.ws + WS_WPA) + (size_t)l * 1024 * 512; }
            else if (br == 1) { A = (const bf16_t*)(p.ws + WS_YBM); K = 256; Bt = (const bf16_t*)(p.ws + WS_WPB) + (size_t)l * 1024 * 256; }
            else { A = (const bf16_t*)(p.ws + WS_YC); K = 512; Bt = (const bf16_t*)(p.ws + WS_WPC) + (size_t)l * 1024 * 512; }
            int tid = threadIdx.x;
            gemm_core<true>(A + (size_t)m0 * K, K, Bt + (size_t)n0 * K, K, K, acc, smem, tid);
            asm volatile("" : "+v"(tid));
            const int lane = tid & 63, w = tid >> 6, wm = w >> 2, wn = w & 3, idx = lane & 15, kq = lane >> 4;
#pragma unroll
            for (int mi = 0; mi < 8; ++mi) {
                const int row = m0 + wm * 128 + mi * 16 + idx;
                const float rs = (br == 2) ? rstd[row] : 1.f;
#pragma unroll
                for (int ni = 0; ni < 4; ++ni) {
                    const int col = n0 + wn * 64 + ni * 16 + 4 * kq;
                    const u32x2 g = *(const u32x2*)(MG + (size_t)row * 3072 + br * 1024 + col);
                    f32x4 gv; gv.x = bflo(g.x); gv.y = bfhi(g.x); gv.z = bflo(g.y); gv.w = bfhi(g.y);
                    f32x4 v = gv * rs * acc[mi][ni];
                    bf16_t* mp = MR + (size_t)row * 1024 + col;
                    if (mi < 6) {
                        if (br > 0) { const u32x2 o = mpk[mi < 6 ? mi : 0][ni]; v.x += bflo(o.x); v.y += bfhi(o.x); v.z += bflo(o.y); v.w += bfhi(o.y); }
                        u32x2 pk; pk.x = pk2(v.x, v.y); pk.y = pk2(v.z, v.w); mpk[mi < 6 ? mi : 0][ni] = pk;
                        if (br == 2) *(u32x2*)mp = pk;
                    } else {
                        if (br > 0) { const u32x2 o = *(const u32x2*)mp; v.x += bflo(o.x); v.y += bfhi(o.x); v.z += bflo(o.y); v.w += bfhi(o.y); }
                        st4bf(mp, v);
                    }
                }
            }
        }
    }
}

__device__ void out_phase(const Params& p, int l, int hb, const float* xsrc, unsigned char* smem) {
    const bf16_t* MR = (const bf16_t*)(p.ws + WS_MRG);
    const bf16_t* Wt = (const bf16_t*)(p.ws + WS_WOUT) + (size_t)l * 1024 * 1024;
    for (int t = blockIdx.x; t < 64 * 4; t += gridDim.x) {
        const int xq = t >> 3, mt = (xq >> 2) * 8 + (t & 7), nt = xq & 3, m0 = mt * 256, n0 = nt * 256;
        f32x4 acc[8][4];
        int tid = threadIdx.x;
        gemm_core(MR + (size_t)m0 * 1024, 1024, Wt + (size_t)n0 * 1024, 1024, 1024, acc, smem, tid);
        asm volatile("" : "+v"(tid));
        const int lane = tid & 63, w = tid >> 6, wm = w >> 2, wn = w & 3, idx = lane & 15, kq = lane >> 4;
#pragma unroll
        for (int mi = 0; mi < 8; ++mi) {
            const int row = m0 + wm * 128 + mi * 16 + idx; const size_t rg = (size_t)hb * TP + row; const int b = (int)(rg / SEQ);
            const float* gate = (const float*)(p.ws + WS_MOD) + (size_t)(l * 4 + b) * 3072 + 2048;
#pragma unroll
            for (int ni = 0; ni < 4; ++ni) {
                const int col = n0 + wn * 64 + ni * 16 + 4 * kq;
                const f32x4 xv = *(const f32x4*)(xsrc + rg * 1024 + col), gv = *(const f32x4*)(gate + col);
                *(f32x4*)(p.out + rg * 1024 + col) = xv + gv * acc[mi][ni];
            }
        }
    }
}

constexpr int AT_KS = 0, AT_VS = 9216, AT_LQ = 9216 + 8192, AT_LUT = AT_LQ + 512;

#define AT_STAGE_STORE() do { _Pragma("unroll") for (int i = 0; i < 2; ++i) { const int c = tid + 256 * i, row = c >> 3, ch = c & 7; \
        *(u32x4*)(Ks + row * 72 + ch * 8) = rk[i]; *(u32x4*)(Vs + (ch >> 2) * 4096 + row * 64 + (ch & 3) * 16) = rv[i]; } } while (0)

__device__ __forceinline__ void at_qk(f32x16& p0, f32x16& p1, const bf16_t* Ks, const bf16x8* qr, int r32, int hi) {
    bf16x8 kf[8];
#pragma unroll
    for (int ds = 0; ds < 4; ++ds) {
        kf[2 * ds] = *(const bf16x8*)(Ks + r32 * 72 + ds * 16 + hi * 8);
        kf[2 * ds + 1] = *(const bf16x8*)(Ks + (r32 + 32) * 72 + ds * 16 + hi * 8);
    }
    __builtin_amdgcn_sched_barrier(0);
    __builtin_amdgcn_s_setprio(1);
#pragma unroll
    for (int ds = 0; ds < 4; ++ds) {
        p0 = __builtin_amdgcn_mfma_f32_32x32x16_bf16(kf[2 * ds], qr[ds], p0, 0, 0, 0);
        p1 = __builtin_amdgcn_mfma_f32_32x32x16_bf16(kf[2 * ds + 1], qr[ds], p1, 0, 0, 0);
    }
    __builtin_amdgcn_s_setprio(0);
    __builtin_amdgcn_sched_barrier(0);
}
__device__ __forceinline__ void at_pv(f32x16& o0, f32x16& o1, const f32x16& p0, const f32x16& p1, const unsigned char* Vs, int lane) {
    const int hi = lane >> 5;
    const unsigned char* vb = Vs + ((lane >> 4) & 1) * 32 + (lane & 3) * 8 + (4 * hi + ((lane & 15) >> 2)) * 64;
    bf16x8 v0[4], v1[4], pa[4];
#pragma unroll
    for (int s = 0; s < 4; ++s) {
        v0[s] = cat8(tr16(vb + s * 1024), tr16(vb + s * 1024 + 512));
        v1[s] = cat8(tr16(vb + 4096 + s * 1024), tr16(vb + 4096 + s * 1024 + 512));
    }
#pragma unroll
    for (int s = 0; s < 4; ++s) {
        u32x4 pw;
        if (s < 2) { pw.x = pk2(p0[8 * s + 0], p0[8 * s + 1]); pw.y = pk2(p0[8 * s + 2], p0[8 * s + 3]); pw.z = pk2(p0[8 * s + 4], p0[8 * s + 5]); pw.w = pk2(p0[8 * s + 6], p0[8 * s + 7]); }
        else { const int q = s - 2; pw.x = pk2(p1[8 * q + 0], p1[8 * q + 1]); pw.y = pk2(p1[8 * q + 2], p1[8 * q + 3]); pw.z = pk2(p1[8 * q + 4], p1[8 * q + 5]); pw.w = pk2(p1[8 * q + 6], p1[8 * q + 7]); }
        pa[s] = __builtin_bit_cast(bf16x8, pw);
    }
    __builtin_amdgcn_sched_barrier(0);
    __builtin_amdgcn_s_setprio(1);
#pragma unroll
    for (int s = 0; s < 4; ++s) {
        o0 = __builtin_amdgcn_mfma_f32_32x32x16_bf16(pa[s], v0[s], o0, 0, 0, 0);
        o1 = __builtin_amdgcn_mfma_f32_32x32x16_bf16(pa[s], v1[s], o1, 0, 0, 0);
    }
    __builtin_amdgcn_s_setprio(0);
    __builtin_amdgcn_sched_barrier(0);
}

__device__ __forceinline__ void at_ldv(bf16x8 (&v0)[4], bf16x8 (&v1)[4], const unsigned char* Vs, int lane) {
    const int hi = lane >> 5;
    const unsigned char* vb = Vs + ((lane >> 4) & 1) * 32 + (lane & 3) * 8 + (4 * hi + ((lane & 15) >> 2)) * 64;
#pragma unroll
    for (int s = 0; s < 4; ++s) {
        v0[s] = cat8(tr16(vb + s * 1024), tr16(vb + s * 1024 + 512));
        v1[s] = cat8(tr16(vb + 4096 + s * 1024), tr16(vb + 4096 + s * 1024 + 512));
    }
}
__device__ __forceinline__ void at_pv2(f32x16& o0, f32x16& o1, const f32x16& p0, const f32x16& p1, const bf16x8 (&v0)[4], const bf16x8 (&v1)[4]) {
    bf16x8 pa[4];
#pragma unroll
    for (int s = 0; s < 4; ++s) {
        u32x4 pw;
        if (s < 2) { pw.x = pk2(p0[8 * s + 0], p0[8 * s + 1]); pw.y = pk2(p0[8 * s + 2], p0[8 * s + 3]); pw.z = pk2(p0[8 * s + 4], p0[8 * s + 5]); pw.w = pk2(p0[8 * s + 6], p0[8 * s + 7]); }
        else { const int q = s - 2; pw.x = pk2(p1[8 * q + 0], p1[8 * q + 1]); pw.y = pk2(p1[8 * q + 2], p1[8 * q + 3]); pw.z = pk2(p1[8 * q + 4], p1[8 * q + 5]); pw.w = pk2(p1[8 * q + 6], p1[8 * q + 7]); }
        pa[s] = __builtin_bit_cast(bf16x8, pw);
    }
    __builtin_amdgcn_sched_barrier(0);
    __builtin_amdgcn_s_setprio(1);
#pragma unroll
    for (int s = 0; s < 4; ++s) {
        o0 = __builtin_amdgcn_mfma_f32_32x32x16_bf16(pa[s], v0[s], o0, 0, 0, 0);
        o1 = __builtin_amdgcn_mfma_f32_32x32x16_bf16(pa[s], v1[s], o1, 0, 0, 0);
    }
    __builtin_amdgcn_s_setprio(0);
    __builtin_amdgcn_sched_barrier(0);
}

constexpr int ATA_STAGE = 17408, ATA_LQ = 2 * ATA_STAGE;
__device__ void attn_a_item(const Params& p, int item, int l, unsigned char* smem) {
    int tid_ = threadIdx.x; asm volatile("" : "+v"(tid_));
    const int tid = tid_, lane = tid & 63, w = __builtin_amdgcn_readfirstlane(tid >> 6), r32 = lane & 31, hi = lane >> 5;
    const int b = item >> 8, r = item & 255, kvh = r >> 7, qblk = (r >> 2) & 31, hq = kvh * 4 + (r & 3);
    float* lq = (float*)(smem + ATA_LQ) + w * 32;
    bf16_t* QA = (bf16_t*)(p.ws + WS_QA);
    const bf16_t* GA = (const bf16_t*)(p.ws + WS_GA);
    const size_t tokq = (size_t)b * SEQ + qblk * 256 + w * 32;
    bf16x8 qr[4];
#pragma unroll
    for (int ds = 0; ds < 4; ++ds) qr[ds] = *(const bf16x8*)(QA + (tokq + r32) * 512 + hq * 64 + ds * 16 + hi * 8);
    const bf16_t* Kb = (const bf16_t*)(p.ws + WS_KA) + (size_t)b * SEQ * 128 + kvh * 64;
    const bf16_t* Vb = (const bf16_t*)(p.ws + WS_VA) + (size_t)b * SEQ * 128 + kvh * 64;
    const float nshift = -((const float*)(p.ws + WS_BND))[l];
    f32x16 o0, o1;
#pragma unroll
    for (int i = 0; i < 16; ++i) { o0[i] = 0.f; o1[i] = 0.f; }
    f32x4 la4 = (f32x4){0.f, 0.f, 0.f, 0.f};
    constexpr int NT = SEQ / 64;
    const int row0 = tid >> 3, ch0 = tid & 7;
    const size_t goff0 = (size_t)row0 * 128 + ch0 * 8;
    const int ko0 = row0 * 144 + ch0 * 16;
    const int vo0 = 9216 + (ch0 >> 2) * 4096 + row0 * 64 + (ch0 & 3) * 16;
    u32x4 rkA[1], rvA[1], rkB[1], rvB[1];
#define ATA_LOAD(RK, RV, t) do { const size_t tb = (size_t)(t) * 64 * 128; RK[0] = *(const u32x4*)(Kb + tb + goff0); RV[0] = *(const u32x4*)(Vb + tb + goff0); } while (0)
#define ATA_STORE(RK, RV, st) do { unsigned char* sb_ = smem + (st) * ATA_STAGE; *(u32x4*)(sb_ + ko0) = RK[0]; *(u32x4*)(sb_ + vo0) = RV[0]; } while (0)
#define ATA_COMPUTE(st) do { const unsigned char* sb_ = smem + (st) * ATA_STAGE; f32x16 p0, p1; bf16x8 vf0[4], vf1[4]; \
        _Pragma("unroll") for (int i = 0; i < 16; ++i) { p0[i] = nshift; p1[i] = nshift; } \
        at_qk(p0, p1, (const bf16_t*)sb_, qr, r32, hi); \
        at_ldv(vf0, vf1, sb_ + 9216, lane); __builtin_amdgcn_sched_barrier(0); \
        _Pragma("unroll") for (int i = 0; i < 16; ++i) { p0[i] = __builtin_amdgcn_exp2f(p0[i]); p1[i] = __builtin_amdgcn_exp2f(p1[i]); } \
        _Pragma("unroll") for (int i = 0; i < 4; ++i) { la4 += (f32x4){p0[4 * i], p0[4 * i + 1], p0[4 * i + 2], p0[4 * i + 3]}; la4 += (f32x4){p1[4 * i], p1[4 * i + 1], p1[4 * i + 2], p1[4 * i + 3]}; } \
        at_pv2(o0, o1, p0, p1, vf0, vf1); } while (0)
    __syncthreads();
    ATA_LOAD(rkA, rvA, 0); ATA_LOAD(rkB, rvB, 1);
    ATA_STORE(rkA, rvA, 0);
    ATA_LOAD(rkA, rvA, 2);
    __syncthreads();
    for (int kt = 0; kt < NT; kt += 2) {
        ATA_COMPUTE(0);
        ATA_STORE(rkB, rvB, 1);
        if (kt + 3 < NT) ATA_LOAD(rkB, rvB, kt + 3);
        __syncthreads();
        ATA_COMPUTE(1);
        if (kt + 2 < NT) { ATA_STORE(rkA, rvA, 0); if (kt + 4 < NT) ATA_LOAD(rkA, rvA, kt + 4); }
        __syncthreads();
    }
#undef ATA_LOAD
#undef ATA_STORE
#undef ATA_COMPUTE
    float lacc = (la4.x + la4.y) + (la4.z + la4.w);
    lacc += __shfl_xor(lacc, 32);
    if (hi == 0) lq[r32] = lacc;
    asm volatile("s_waitcnt lgkmcnt(0)" ::: "memory");
#pragma unroll
    for (int rr = 0; rr < 16; ++rr) {
        const int q = crow(rr, hi); const float inv = 1.f / lq[q];
        const size_t off = (tokq + q) * 512 + hq * 64 + r32;
        const float g0 = bf2f(GA[off]), g1 = bf2f(GA[off + 32]);
        QA[off] = (bf16_t)(pk2(o0[rr] * inv * g0, 0.f) & 0xffffu);
        QA[off + 32] = (bf16_t)(pk2(o1[rr] * inv * g1, 0.f) & 0xffffu);
    }
}

constexpr int ATB_TILE = 17408, ATB_LQ = 6 * ATB_TILE, ATB_LUT = ATB_LQ + 1024;
__device__ void attn_b_item(const Params& p, int item, int l, unsigned char* smem) {
    int tid_ = threadIdx.x; asm volatile("" : "+v"(tid_));
    const int tid = tid_, lane = tid & 63, w = __builtin_amdgcn_readfirstlane(tid >> 6), r32 = lane & 31, hi = lane >> 5;
    const int blk = item & 31, j = (item >> 5) & 3, bg = item >> 7, g = bg % 3;
    const int sh = 2 * g, dil = 1 << sh, Mlen = SEQ >> sh;
    float* lq = (float*)(smem + ATB_LQ) + w * 32; float* lut = (float*)(smem + ATB_LUT);
    bf16_t* QB = (bf16_t*)(p.ws + WS_QB) + (size_t)bg * SEQ * 256 + j * 64;
    const bf16_t* KB = (const bf16_t*)(p.ws + WS_KB) + (size_t)bg * SEQ * 256 + j * 64;
    const bf16_t* VB = (const bf16_t*)(p.ws + WS_VB) + (size_t)bg * SEQ * 256 + j * 64;
    float* LSE = (float*)(p.ws + WS_LSE) + (size_t)bg * SEQ * 4 + j;
    const int p0r = blk * 256, seq_lo = (p0r / Mlen) * Mlen, seq_hi = seq_lo + Mlen;
    const int srow = tid >> 3, sch = tid & 7;
    u32x4 rk[6], rv[6];
#pragma unroll
    for (int kt = 0; kt < 6; ++kt) { int pr = p0r - 64 + 64 * kt + srow; pr = pr < 0 ? 0 : (pr > SEQ - 1 ? SEQ - 1 : pr);
        rk[kt] = *(const u32x4*)(KB + (size_t)pr * 256 + sch * 8); rv[kt] = *(const u32x4*)(VB + (size_t)pr * 256 + sch * 8); }
    __syncthreads();
    if (tid < 129) {
        const int rel = tid - 64, n = (rel < 0 ? -rel : rel) * dil;
        int bk;
        if (n < 8) bk = n; else { bk = 8 + (n >= 15) + (n >= 27) + (n >= 50) + (n >= 91) + (n >= 166) + (n >= 305) + (n >= 559); }
        if (rel > 0) bk += 16;
        lut[tid] = p.rel_bias[bk * 12 + g * 4 + j] * LOG2E;
    }
#pragma unroll
    for (int kt = 0; kt < 6; ++kt) { unsigned char* tb = smem + kt * ATB_TILE;
        *(u32x4*)(tb + srow * 144 + sch * 16) = rk[kt]; *(u32x4*)(tb + 9216 + (sch >> 2) * 4096 + srow * 64 + (sch & 3) * 16) = rv[kt]; }
    const int qpos = p0r + w * 32 + r32;
    bf16x8 qr[4];
#pragma unroll
    for (int ds = 0; ds < 4; ++ds) qr[ds] = *(const bf16x8*)(QB + (size_t)qpos * 256 + ds * 16 + hi * 8);
    const float nshift = -((const float*)(p.ws + WS_BND))[2 + l];
    f32x16 o0, o1;
#pragma unroll
    for (int i = 0; i < 16; ++i) { o0[i] = 0.f; o1[i] = 0.f; }
    f32x4 la4 = (f32x4){0.f, 0.f, 0.f, 0.f};
    __syncthreads();
#pragma unroll 1
    for (int t3 = 0; t3 < 3; ++t3) {
        const int kt = (w >> 1) + t3, kbase = p0r - 64 + 64 * kt;
        const bf16_t* Ks = (const bf16_t*)(smem + kt * ATB_TILE); const unsigned char* Vs = smem + kt * ATB_TILE + 9216;
        f32x16 p0, p1;
#pragma unroll
        for (int i = 0; i < 16; ++i) { p0[i] = nshift; p1[i] = nshift; }
        at_qk(p0, p1, Ks, qr, r32, hi);
        bf16x8 vf0[4], vf1[4];
        at_ldv(vf0, vf1, Vs, lane); __builtin_amdgcn_sched_barrier(0);
#pragma unroll
        for (int i = 0; i < 16; ++i) {
            const int kv0 = kbase + crow(i, hi), kv1 = kv0 + 32;
            const int rel0 = kv0 - qpos, rel1 = kv1 - qpos;
            const bool ok0 = rel0 >= -64 && rel0 <= 64 && kv0 >= seq_lo && kv0 < seq_hi;
            const bool ok1 = rel1 >= -64 && rel1 <= 64 && kv1 >= seq_lo && kv1 < seq_hi;
            const float e0 = __builtin_amdgcn_exp2f(p0[i] + lut[ok0 ? rel0 + 64 : 64]);
            const float e1 = __builtin_amdgcn_exp2f(p1[i] + lut[ok1 ? rel1 + 64 : 64]);
            p0[i] = ok0 ? e0 : 0.f; p1[i] = ok1 ? e1 : 0.f;
        }
#pragma unroll
        for (int i = 0; i < 4; ++i) { la4 += (f32x4){p0[4 * i], p0[4 * i + 1], p0[4 * i + 2], p0[4 * i + 3]}; la4 += (f32x4){p1[4 * i], p1[4 * i + 1], p1[4 * i + 2], p1[4 * i + 3]}; }
        at_pv2(o0, o1, p0, p1, vf0, vf1);
    }
    float lacc = (la4.x + la4.y) + (la4.z + la4.w);
    lacc += __shfl_xor(lacc, 32);
    if (hi == 0) { lq[r32] = lacc; LSE[(size_t)qpos * 4] = (-nshift + log2f(lacc)) * LN2; }
    asm volatile("s_waitcnt lgkmcnt(0)" ::: "memory");
#pragma unroll
    for (int rr = 0; rr < 16; ++rr) {
        const int q = crow(rr, hi); const float inv = 1.f / lq[q];
        const size_t off = (size_t)(p0r + w * 32 + q) * 256 + r32;
        QB[off] = (bf16_t)(pk2(o0[rr] * inv, 0.f) & 0xffffu);
        QB[off + 32] = (bf16_t)(pk2(o1[rr] * inv, 0.f) & 0xffffu);
    }
}

__device__ void conv_phase(const Params& p, int l) {
    int tx_ = threadIdx.x; asm volatile("" : "+v"(tx_));
    const bf16_t* XBC = (const bf16_t*)(p.ws + WS_XBC);
    bf16_t* XC = (bf16_t*)(p.ws + WS_XBCC);
    const float* cw = p.conv_w + (size_t)l * 5 * 1024; const float* cb = p.conv_b + l * 1024;
    const int nthr = gridDim.x * 512;
    for (int u = blockIdx.x * 512 + tx_; u < (TP / 4) * 128; u += nthr) {
        const int ch = (u & 127) * 8, tg = u >> 7, tok0 = tg * 4, tt0 = tok0 & (SEQ - 1);
        u32x4 raw[8];
#pragma unroll
        for (int r = 0; r < 8; ++r) { const int tt = tt0 - 2 + r; raw[r] = (u32x4){0u, 0u, 0u, 0u};
            if (tt >= 0 && tt < SEQ) raw[r] = *(const u32x4*)(XBC + (size_t)(tok0 - 2 + r) * 1024 + ch); }
        float ac[4][8];
        { const f32x4 a = *(const f32x4*)(cb + ch), b2 = *(const f32x4*)(cb + ch + 4);
#pragma unroll
          for (int t = 0; t < 4; ++t) { ac[t][0] = a.x; ac[t][1] = a.y; ac[t][2] = a.z; ac[t][3] = a.w; ac[t][4] = b2.x; ac[t][5] = b2.y; ac[t][6] = b2.z; ac[t][7] = b2.w; } }
#pragma unroll
        for (int k = 0; k < 5; ++k) { const f32x4 wa = *(const f32x4*)(cw + k * 1024 + ch), wb = *(const f32x4*)(cw + k * 1024 + ch + 4);
#pragma unroll
            for (int t = 0; t < 4; ++t) { const u32x4 v = raw[t + k];
                ac[t][0] += bflo(v.x) * wa.x; ac[t][1] += bfhi(v.x) * wa.y; ac[t][2] += bflo(v.y) * wa.z; ac[t][3] += bfhi(v.y) * wa.w;
                ac[t][4] += bflo(v.z) * wb.x; ac[t][5] += bfhi(v.z) * wb.y; ac[t][6] += bflo(v.w) * wb.z; ac[t][7] += bfhi(v.w) * wb.w; } }
#pragma unroll
        for (int t = 0; t < 4; ++t) { u32x4 o;
            o.x = pk2(siluf(ac[t][0]), siluf(ac[t][1])); o.y = pk2(siluf(ac[t][2]), siluf(ac[t][3])); o.z = pk2(siluf(ac[t][4]), siluf(ac[t][5])); o.w = pk2(siluf(ac[t][6]), siluf(ac[t][7]));
            *(u32x4*)(XC + (size_t)(tok0 + t) * 1024 + ch) = o; }
    }
}

constexpr int SS_BS = 0, SS_CS = 8704, SS_XS = 17408, SS_XWS = 22016, SS_GS = 26624, SS_SB = 29184, SS_CW = 46592, SS_SC = 54272, SS_DTA = 55296, SS_END = 57344;

template <int PASS>
__device__ void ssd_item(const Params& p, int item, int l, unsigned char* smem) {
    int tid_ = VTID; asm volatile("" : "+v"(tid_));
    const int tid = tid_, lane = tid & 63, w = tid >> 6, idx = lane & 15, kq = lane >> 4;
    const int seg = item & 15, h = (item >> 4) & 7, dir = (item >> 7) & 1, b = item >> 8, grp = h >> 2;
    bf16_t* Bs = (bf16_t*)(smem + SS_BS); bf16_t* Cs = (bf16_t*)(smem + SS_CS); bf16_t* Xs = (bf16_t*)(smem + SS_XS); bf16_t* Xws = (bf16_t*)(smem + SS_XWS);
    bf16_t* Gs = (bf16_t*)(smem + SS_GS); bf16_t* Sb = (bf16_t*)(smem + SS_SB); float* sc = (float*)(smem + SS_SC);
    float* s_cA = (float*)(smem + SS_CW), *s_rsA = s_cA + SEGLEN, *s_wlA = s_rsA + SEGLEN, *s_totA = sc;
    const bf16_t* XBC = (const bf16_t*)(p.ws + WS_XBC);
    const float* DT = (const float*)(p.ws + WS_DT);
    float* ST = (float*)(p.ws + WS_ST); float* SEGT = (float*)(p.ws + WS_SEGT);
    bf16_t* Y = (bf16_t*)(p.ws + (dir ? WS_YS : WS_YF));
    const float Aneg = -__expf(p.a_log[l * 16 + dir * 8 + h]);
    const float Dh = p.d_skip[l * 8 + h];
    __syncthreads();
    f32x4 S[8];
#pragma unroll
    for (int nt = 0; nt < 8; ++nt) S[nt] = (f32x4){0.f, 0.f, 0.f, 0.f};
    const int ibase = item & ~15;
    if (PASS == 3) {
        if (dir == 0) {
            for (int e = 0; e < seg; ++e) { const float dc = __expf(SEGT[ibase + e]); const f32x4* src = (const f32x4*)(ST + (size_t)(ibase + e) * 8192);
#pragma unroll
                for (int nt = 0; nt < 8; ++nt) S[nt] = S[nt] * dc + src[(w * 8 + nt) * 64 + lane]; }
        } else {
            for (int e = NSEG - 1; e > seg; --e) { const float dc = __expf(SEGT[ibase + e]); const f32x4* src = (const f32x4*)(ST + (size_t)(ibase + e) * 8192);
#pragma unroll
                for (int nt = 0; nt < 8; ++nt) S[nt] = S[nt] * dc + src[(w * 8 + nt) * 64 + lane]; }
        }
#pragma unroll
        for (int nt = 0; nt < 8; ++nt) st4bf(Sb + (16 * w + idx) * 136 + 16 * nt + 4 * kq, S[nt]);
    }
    float* s_dta = (float*)(smem + SS_DTA);
#pragma unroll
    for (int i = 0; i < SEGLEN / 256; ++i) {
        const int e = tid + 256 * i, l32 = lane & 31;
        const float dtv = DT[((size_t)b * SEQ + seg * SEGLEN + e) * 16 + dir * 8 + h], av = dtv * Aneg;
        float pre = av;
#pragma unroll
        for (int o = 1; o < 32; o <<= 1) { const float t = __shfl_up(pre, o, 32); if (l32 >= o) pre += t; }
        const float tot = __shfl(pre, 31, 32);
        const float cc = dir ? (tot - pre + av) : pre;
        s_dta[e] = dtv; s_cA[e] = cc; s_rsA[e] = __expf(cc); s_wlA[e] = dtv * __expf(tot - cc);
        if (l32 == 0) s_totA[e >> 5] = tot;
    }
    float segtot = 0.f;
    const size_t tokb = (size_t)b * SEQ;
    const unsigned char* xb_ = (const unsigned char*)((const bf16_t*)(p.ws + WS_XBCC) + tokb * 1024);
    unsigned soff[5];
#pragma unroll
    for (int i = 0; i < 5; ++i) { const int u = tid + 256 * i, lrow = u / 40, ci = u % 40;
        const int scol = ci < 8 ? h * 64 + ci * 8 : (ci < 24 ? 512 + grp * 128 + (ci * 8 - 64) : 768 + grp * 128 + (ci * 8 - 192));
        soff[i] = (unsigned)((lrow * 1024 + scol) * 2); }
    for (int si = 0; si < NSUB; ++si) {
        const int scn = dir ? (NSUB - 1 - si) : si;
        const int t0 = seg * SEGLEN + scn * TSUB;
        __syncthreads();
        u32x4 raw[5];
#pragma unroll
        for (int i = 0; i < 5; ++i) raw[i] = *(const u32x4*)(xb_ + ((unsigned)(t0 * 2048) + soff[i]));
        const float* s_dt = s_dta + scn * TSUB; const float* s_c = s_cA + scn * TSUB; const float* s_rs = s_rsA + scn * TSUB; const float* s_wl = s_wlA + scn * TSUB;
        const float stot = s_totA[scn];
        segtot += stot;
#pragma unroll
        for (int i = 0; i < 5; ++i) { const int u = tid + 256 * i, lrow = u / 40, ci = u % 40, lc = ci * 8; const u32x4 o = raw[i];
            if (ci < 8) { *(u32x4*)(Xs + lrow * 72 + lc) = o; const float wl = s_wl[lrow];
                u32x4 o2; o2.x = pk2(bflo(o.x) * wl, bfhi(o.x) * wl); o2.y = pk2(bflo(o.y) * wl, bfhi(o.y) * wl); o2.z = pk2(bflo(o.z) * wl, bfhi(o.z) * wl); o2.w = pk2(bflo(o.w) * wl, bfhi(o.w) * wl);
                *(u32x4*)(Xws + lrow * 72 + lc) = o2; }
            else if (ci < 24) *(u32x4*)(Bs + lrow * 136 + (lc - 64)) = o;
            else *(u32x4*)(Cs + lrow * 136 + (lc - 192)) = o; }
        __syncthreads();
        if (PASS == 3) {
            const int it = w >> 1, jt = w & 1;
            f32x4 cb = (f32x4){0.f, 0.f, 0.f, 0.f};
            {
                bf16x8 fb[4], fc[4];
#pragma unroll
                for (int ks = 0; ks < 4; ++ks) { fb[ks] = *(const bf16x8*)(Bs + (16 * jt + idx) * 136 + ks * 32 + kq * 8); fc[ks] = *(const bf16x8*)(Cs + (16 * it + idx) * 136 + ks * 32 + kq * 8); }
                __builtin_amdgcn_sched_barrier(0);
#pragma unroll
                for (int ks = 0; ks < 4; ++ks) cb = __builtin_amdgcn_mfma_f32_16x16x32_bf16(fb[ks], fc[ks], cb, 0, 0, 0);
                __builtin_amdgcn_sched_barrier(0);
            }
            {
                const int ii = 16 * it + idx; const float ci_ = s_c[ii];
                f32x4 gv;
#pragma unroll
                for (int rg = 0; rg < 4; ++rg) {
                    const int jj = 16 * jt + 4 * kq + rg;
                    const bool ok = dir ? (jj >= ii) : (jj <= ii);
                    const float e = __expf(ci_ - s_c[jj]) * s_dt[jj];
                    gv[rg] = ok ? cb[rg] * e : 0.f;
                }
                st4bf(Gs + ii * 40 + 16 * jt + 4 * kq, gv);
            }
            __syncthreads();
            const unsigned char* xtr = (const unsigned char*)Xs + (8 * kq + (idx >> 2)) * 144 + (16 * w + 4 * (idx & 3)) * 2;
            const bf16x8 xf = cat8(tr16(xtr), tr16(xtr + 4 * 144));
#pragma unroll 1
            for (int it2 = 0; it2 < 2; ++it2) {
                const int ii = 16 * it2 + idx;
                const bf16x8 gf = *(const bf16x8*)(Gs + ii * 40 + 8 * kq);
                f32x4 yd = (f32x4){0.f, 0.f, 0.f, 0.f}, yo = (f32x4){0.f, 0.f, 0.f, 0.f};
                bf16x8 sf[4], cf[4];
#pragma unroll
                for (int ks = 0; ks < 4; ++ks) { sf[ks] = *(const bf16x8*)(Sb + (16 * w + idx) * 136 + ks * 32 + kq * 8); cf[ks] = *(const bf16x8*)(Cs + ii * 136 + ks * 32 + kq * 8); }
                __builtin_amdgcn_sched_barrier(0);
                yd = __builtin_amdgcn_mfma_f32_16x16x32_bf16(xf, gf, yd, 0, 0, 0);
#pragma unroll
                for (int ks = 0; ks < 4; ++ks) yo = __builtin_amdgcn_mfma_f32_16x16x32_bf16(sf[ks], cf[ks], yo, 0, 0, 0);
                __builtin_amdgcn_sched_barrier(0);
                f32x4 y = yd + yo * s_rs[ii];
                if (dir == 0) { const u32x2 xv = *(const u32x2*)(Xs + ii * 72 + 16 * w + 4 * kq);
                    y.x += Dh * bflo(xv.x); y.y += Dh * bfhi(xv.x); y.z += Dh * bflo(xv.y); y.w += Dh * bfhi(xv.y); }
                st4bf(Y + (tokb + t0 + ii) * 512 + h * 64 + 16 * w + 4 * kq, y);
            }
        }
        {
            const float dc = __expf(stot);
            const unsigned char* xw = (const unsigned char*)Xws + (8 * kq + (idx >> 2)) * 144 + (16 * w + 4 * (idx & 3)) * 2;
            const bf16x8 xwf = cat8(tr16(xw), tr16(xw + 4 * 144));
            bf16x8 bfv[8];
#pragma unroll
            for (int nt = 0; nt < 8; ++nt) {
                const unsigned char* bt = (const unsigned char*)Bs + (8 * kq + (idx >> 2)) * 272 + (16 * nt + 4 * (idx & 3)) * 2;
                bfv[nt] = cat8(tr16(bt), tr16(bt + 4 * 272));
            }
            __builtin_amdgcn_sched_barrier(0);
#pragma unroll
            for (int nt = 0; nt < 8; ++nt) S[nt] = __builtin_amdgcn_mfma_f32_16x16x32_bf16(bfv[nt], xwf, S[nt] * dc, 0, 0, 0);
            __builtin_amdgcn_sched_barrier(0);
            if (PASS == 3) {
#pragma unroll
                for (int nt = 0; nt < 8; ++nt) st4bf(Sb + (16 * w + idx) * 136 + 16 * nt + 4 * kq, S[nt]);
            }
        }
    }
    if (PASS == 1) {
        f32x4* dst = (f32x4*)(ST + (size_t)item * 8192);
#pragma unroll
        for (int nt = 0; nt < 8; ++nt) dst[(w * 8 + nt) * 64 + lane] = S[nt];
        if (tid == 0) SEGT[item] = segtot;
    }
}

__device__ void post2_phase(const Params& p) {
    int tx_ = threadIdx.x; asm volatile("" : "+v"(tx_));
    const int lane = tx_ & 63, gw = blockIdx.x * 8 + (tx_ >> 6), nw = gridDim.x * 8;
    const bf16_t* OB = (const bf16_t*)(p.ws + WS_QB); const float* LSE = (const float*)(p.ws + WS_LSE);
    const bf16_t* GB = (const bf16_t*)(p.ws + WS_GB);
    bf16_t* YBM = (bf16_t*)(p.ws + WS_YBM);
    const bf16_t* YF = (const bf16_t*)(p.ws + WS_YF); const bf16_t* YS = (const bf16_t*)(p.ws + WS_YS); const bf16_t* ZS = (const bf16_t*)(p.ws + WS_ZS);
    bf16_t* YC = (bf16_t*)(p.ws + WS_YC); float* RS = (float*)(p.ws + WS_RSTD);
    constexpr int R = 4;
    for (int row0 = gw; row0 < TP; row0 += R * nw) {
        float ls[R][3]; u32x2 ov[R][3], gt[R]; u32x4 a[R], bq[R], z[R];
        const int j = lane >> 4;
#pragma unroll
        for (int q = 0; q < R; ++q) { const int row = row0 + q * nw; if (row < TP) {
            const int bl = row >> 13, tt = row & (SEQ - 1);
#pragma unroll
            for (int g = 0; g < 3; ++g) { const int sh = 2 * g; const int pp = (tt & ((1 << sh) - 1)) * (SEQ >> sh) + (tt >> sh);
                const size_t ro = (size_t)(bl * 3 + g) * SEQ + pp; ls[q][g] = LSE[ro * 4 + j]; ov[q][g] = *(const u32x2*)(OB + ro * 256 + 4 * lane); }
            gt[q] = *(const u32x2*)(GB + (size_t)row * 256 + 4 * lane);
            a[q] = *(const u32x4*)(YF + (size_t)row * 512 + 8 * lane); bq[q] = *(const u32x4*)(YS + (size_t)row * 512 + 8 * lane); z[q] = *(const u32x4*)(ZS + (size_t)row * 512 + 8 * lane); } }
#pragma unroll
        for (int q = 0; q < R; ++q) { const int row = row0 + q * nw; if (row < TP) {
            const float mx = fmaxf(ls[q][0], fmaxf(ls[q][1], ls[q][2]));
            float wg[3]; float ws = 0.f;
#pragma unroll
            for (int g = 0; g < 3; ++g) { wg[g] = __expf(ls[q][g] - mx); ws += wg[g]; }
            const float inv = 1.f / ws;
            f32x4 acc = (f32x4){0.f, 0.f, 0.f, 0.f};
#pragma unroll
            for (int g = 0; g < 3; ++g) { const u32x2 v = ov[q][g]; const float wv = wg[g] * inv;
                acc.x += wv * bflo(v.x); acc.y += wv * bfhi(v.x); acc.z += wv * bflo(v.y); acc.w += wv * bfhi(v.y); }
            acc.x *= bflo(gt[q].x); acc.y *= bfhi(gt[q].x); acc.z *= bflo(gt[q].y); acc.w *= bfhi(gt[q].y);
            st4bf(YBM + (size_t)row * 256 + 4 * lane, acc);
            float y[8];
            y[0] = (bflo(a[q].x) + bflo(bq[q].x)) * bflo(z[q].x); y[1] = (bfhi(a[q].x) + bfhi(bq[q].x)) * bfhi(z[q].x);
            y[2] = (bflo(a[q].y) + bflo(bq[q].y)) * bflo(z[q].y); y[3] = (bfhi(a[q].y) + bfhi(bq[q].y)) * bfhi(z[q].y);
            y[4] = (bflo(a[q].z) + bflo(bq[q].z)) * bflo(z[q].z); y[5] = (bfhi(a[q].z) + bfhi(bq[q].z)) * bfhi(z[q].z);
            y[6] = (bflo(a[q].w) + bflo(bq[q].w)) * bflo(z[q].w); y[7] = (bfhi(a[q].w) + bfhi(bq[q].w)) * bfhi(z[q].w);
            float ss = 0.f;
#pragma unroll
            for (int e = 0; e < 8; ++e) ss += y[e] * y[e];
            ss = wave_sum(ss);
            u32x4 o; o.x = pk2(y[0], y[1]); o.y = pk2(y[2], y[3]); o.z = pk2(y[4], y[5]); o.w = pk2(y[6], y[7]);
            *(u32x4*)(YC + (size_t)row * 512 + 8 * lane) = o;
            if (lane == 0) RS[row] = rsqrtf(ss * (1.f / 512.f) + EPS);
        } }
    }
}


#define XB_TMO      128
#define XB_XCNT(j)  (256  + 64 * (j))
#define XB_XSUB(j)  (1280 + 64 * (j))
#define XB_XGEN(j)  (2304 + 64 * (j))
#define XB_TOP      3328
#define XB_TOPGEN   3392
#define XCD_BAR_WORDS 3456
#define XB_SPIN_CAP (1u << 20)
__device__ __forceinline__ unsigned xb_ld(unsigned* p)              { return __hip_atomic_load(p, __ATOMIC_RELAXED, __HIP_MEMORY_SCOPE_AGENT); }
__device__ __forceinline__ unsigned xb_add(unsigned* p, unsigned v) { return __hip_atomic_fetch_add(p, v, __ATOMIC_RELAXED, __HIP_MEMORY_SCOPE_AGENT); }
__device__ __forceinline__ unsigned xb_xcc_id() { return (unsigned)__builtin_amdgcn_s_getreg((3 << 11) | 20) & 0xFu; }
#define XB_SPIN(cond, bar) do { unsigned _sp = 0; while (cond) { __builtin_amdgcn_s_sleep(1); \
    if ((++_sp & 255u) == 0u) { if (xb_ld(&(bar)[XB_TMO])) break; if (_sp > XB_SPIN_CAP) { atomicAdd(&(bar)[XB_TMO], 1u); break; } } } } while (0)
struct XcdBarrier { unsigned* bar; unsigned x; volatile LDSAS unsigned* st; };
__device__ __forceinline__ XcdBarrier xcd_barrier_post(unsigned* bar, volatile LDSAS unsigned* st) {
    XcdBarrier b; b.bar = bar; b.x = xb_xcc_id(); b.st = st;
    if (threadIdx.x == 0) (void)xb_add(&bar[XB_XCNT(b.x)], 1u);
    return b;
}
__device__ __forceinline__ void xcd_barrier_complete(unsigned* bar, unsigned x, unsigned& nloc, unsigned& nx) {
    const unsigned G = gridDim.x * gridDim.y * gridDim.z;
    unsigned sum, cnt, mine, sp = 0u;
    for (;;) {
        sum = 0u; cnt = 0u; mine = 0u;
#pragma unroll
        for (unsigned j = 0; j < 16; ++j) { const unsigned c = xb_ld(&bar[XB_XCNT(j)]); sum += c; cnt += (c > 0u) ? 1u : 0u; mine = (j == x) ? c : mine; }
        if (sum == G) break;
        __builtin_amdgcn_s_sleep(1);
        if ((++sp & 255u) == 0u) { if (xb_ld(&bar[XB_TMO])) break; if (sp > XB_SPIN_CAP) { atomicAdd(&bar[XB_TMO], 1u); break; } }
    }
    nloc = mine > 0u ? mine : 1u; nx = cnt > 0u ? cnt : 1u;
}
__device__ __forceinline__ void xcd_barrier(const XcdBarrier& b) {
    asm volatile("s_waitcnt vmcnt(0)" ::: "memory");
    __syncthreads();
    if (threadIdx.x == 0) {
        unsigned* bar = b.bar;
        __builtin_amdgcn_s_waitcnt(0);
        unsigned nloc = b.st[0], nx = b.st[1];
        if (nloc == 0u) { xcd_barrier_complete(bar, b.x, nloc, nx); b.st[0] = nloc; b.st[1] = nx; }
        const unsigned old = xb_add(&bar[XB_XSUB(b.x)], 1u);
        const unsigned gen = old / nloc;
        if (old + 1u == (gen + 1u) * nloc) {
            __builtin_amdgcn_fence(__ATOMIC_RELEASE, "agent");
            asm volatile("s_waitcnt vmcnt(0)" ::: "memory");
            const unsigned og = xb_add(&bar[XB_TOP], 1u);
            const unsigned tg = og / nx;
            if (og + 1u == (tg + 1u) * nx) xb_add(&bar[XB_TOPGEN], 1u);
            else XB_SPIN(xb_ld(&bar[XB_TOPGEN]) == tg, bar);
            __builtin_amdgcn_fence(__ATOMIC_ACQUIRE, "agent");
            xb_add(&bar[XB_XGEN(b.x)], 1u);
            asm volatile("s_waitcnt vmcnt(0)" ::: "memory");
        } else {
            XB_SPIN(xb_ld(&bar[XB_XGEN(b.x)]) == gen, bar);
            __builtin_amdgcn_fence(__ATOMIC_ACQUIRE, "agent");
            asm volatile("s_waitcnt vmcnt(0)" ::: "memory");
        }
    }
    __syncthreads();
}

__device__ __forceinline__ unsigned char* lds_half(unsigned char* smem) { int h_ = threadIdx.x >> 8; asm volatile("" : "+v"(h_)); return smem + h_ * HALF_LDS; }
__global__ void __launch_bounds__(512, 2) hybrid_fwd(Params p) {
    cg::grid_group grid = cg::this_grid();
    extern __shared__ __attribute__((aligned(16))) unsigned char smem[];
    volatile LDSAS unsigned* bst = (volatile LDSAS unsigned*)(smem + LDS_TOTAL - 16);
    if (threadIdx.x < 4) bst[threadIdx.x] = 0u;
    __syncthreads();
    const XcdBarrier xbar = xcd_barrier_post((unsigned*)(p.ws + WS_BAR), bst);
    { const Params q = launder(p); phase0(q, lds_half(smem)); }
    grid.sync();
#pragma unroll 1
    for (int l = 0; l < DEPTH; ++l) {
#pragma unroll 1
        for (int hb = 0; hb < 2; ++hb) {
            { const Params q = launder(p); norm_phase(q, l, hb, (l == 0) ? q.x : q.out); }
            xcd_barrier(xbar);
            { const Params q = launder(p); gemm1_phase(q, l, hb, smem); }
            xcd_barrier(xbar);
            { const Params q = launder(p); conv_phase(q, l); }
            xcd_barrier(xbar);
            { const Params q = launder(p); unsigned char* smh = lds_half(smem);
#pragma unroll 1
              for (int it = VBLK; it < 512; it += VGRID) ssd_item<1>(q, it, l, smh);
#pragma unroll 1
              for (int it = blockIdx.x; it < 768; it += gridDim.x) attn_b_item(q, it, l, smem); }
            xcd_barrier(xbar);
            { const Params q = launder(p);
#pragma unroll 1
              for (int it = blockIdx.x; it < 512; it += gridDim.x) attn_a_item(q, it, l, smem);
              unsigned char* smh = lds_half(smem);
#pragma unroll 1
              for (int it = VBLK; it < 512; it += VGRID) ssd_item<3>(q, it, l, smh); }
            xcd_barrier(xbar);
            { const Params q = launder(p); post2_phase(q); }
            xcd_barrier(xbar);
            { const Params q = launder(p); merge_phase(q, l, smem); }
            xcd_barrier(xbar);
            { const Params q = launder(p); out_phase(q, l, hb, (l == 0) ? q.x : q.out, smem); }
        }
    }
}

extern "C" void kernel_launch(void* const* d_in, const int* in_sizes, int n_in, void* d_out, int out_size, void* d_ws, size_t ws_size, hipStream_t stream) {
    static int grid_blocks = 0;
    if (!grid_blocks) {
        int dev = 0, cus = 0, per_cu = 0;
        hipGetDevice(&dev);
        hipDeviceGetAttribute(&cus, hipDeviceAttributeMultiprocessorCount, dev);
        hipFuncSetAttribute((const void*)hybrid_fwd, hipFuncAttributeMaxDynamicSharedMemorySize, LDS_TOTAL);
        hipOccupancyMaxActiveBlocksPerMultiprocessor(&per_cu, hybrid_fwd, 512, LDS_TOTAL);
        if (per_cu > 1) per_cu = 1;
        if (per_cu < 1) per_cu = 1;
        grid_blocks = cus * per_cu;
    }
    Params p{};
    const float** pp = (const float**)&p;
    for (int i = 0; i < 22; ++i) pp[i] = (const float*)d_in[i];
    p.out = (float*)d_out; p.ws = (unsigned char*)d_ws;
    hipMemsetAsync((unsigned char*)d_ws + WS_BAR, 0, XCD_BAR_WORDS * 4, stream);
    void* args[] = {&p};
    hipError_t e = hipLaunchCooperativeKernel((void*)hybrid_fwd, dim3(grid_blocks), dim3(512), args, LDS_TOTAL, stream);
    if (e != hipSuccess) fprintf(stderr, "cooperative launch failed: %s (grid %d)\n", hipGetErrorString(e), grid_blocks);
}
```
